# Optimizing an MI355X kernel written in HIP

```python
import math
import jax
import jax.numpy as jnp
from jax import lax
import numpy as np

D_MODEL = 1024
BATCH = 2
SEQ = 16384
DEPTH = 1

DIFF_HEADS = 4
DIFF_HD = 64
DIFF_VD = 2 * DIFF_HD
DIL_PATTERNS = ((128, 1), (512, 4), (2048, 16))
N_DIL_GROUPS = len(DIL_PATTERNS)
DIL_HEADS = 4
DIL_HD = 64
REL_BUCKETS = 32
REL_MAX_DIST = 2048
N_ATTN_HEADS = DIFF_HEADS + N_DIL_GROUPS * DIL_HEADS
PEER_HEADS = 8
PEER_NKEYS = 128
PEER_TOPK = 16
PEER_DKEY = 128
N_EXPERTS = PEER_NKEYS * PEER_NKEYS
Q_BLOCK = 128
TOKEN_BLOCK = 128
ALPHA = (2.0 * DEPTH) ** 0.25
BETA = (8.0 * DEPTH) ** -0.25
LN_EPS = 1e-5
SUBLN_EPS = 1e-5

DIFF_QK_W = DIFF_HEADS * 2 * DIFF_HD
DIFF_V_W = DIFF_HEADS * DIFF_VD
DIL_W = N_DIL_GROUPS * DIL_HEADS * DIL_HD
DIL_OUT_W = DIL_HEADS * DIL_HD
OFF_DQ = 0
OFF_DK = OFF_DQ + DIFF_QK_W
OFF_DV = OFF_DK + DIFF_QK_W
OFF_LQ = OFF_DV + DIFF_V_W
OFF_LK = OFF_LQ + DIL_W
OFF_LV = OFF_LK + DIL_W
OFF_GA = OFF_LV + DIL_W
OFF_GB = OFF_GA + D_MODEL
IN_COLS = OFF_GB + D_MODEL

kernel_name = 'hybrid_diffattn_dilated_peer_deepnorm'


def layer_norm(x, g, b):
    xf = x.astype(jnp.float32)
    mu = jnp.mean(xf, axis=-1, keepdims=True)
    var = jnp.mean(jnp.square(xf - mu), axis=-1, keepdims=True)
    return ((xf - mu) * lax.rsqrt(var + LN_EPS) * g + b).astype(x.dtype)


def rel_bucket(dist):
    n = jnp.maximum(dist, 0)
    max_exact = REL_BUCKETS // 2
    nf = jnp.maximum(n, 1).astype(jnp.float32)
    large = max_exact + (jnp.log(nf / max_exact) / math.log(REL_MAX_DIST / max_exact)
                         * (REL_BUCKETS - max_exact)).astype(jnp.int32)
    large = jnp.minimum(large, REL_BUCKETS - 1)
    return jnp.where(n < max_exact, n, large)


def diff_attention(q, k, v, lam, lam_init, bias_dist, subln_g):
    B, S, H = q.shape[0], q.shape[1], q.shape[2]
    nb = S // Q_BLOCK
    qb = jnp.moveaxis(q.reshape(B, nb, Q_BLOCK, H, 2, DIFF_HD), 1, 0)
    kpos = jnp.arange(S)
    scale = DIFF_HD ** -0.5

    def block(args):
        qi, i = args
        qpos = i * Q_BLOCK + jnp.arange(Q_BLOCK)
        dist = qpos[:, None] - kpos[None, :]
        bias = jnp.moveaxis(jnp.take(bias_dist, jnp.clip(dist, 0, S - 1), axis=0), -1, 0)
        logits = jnp.einsum('bqhcd,bkhcd->bchqk', qi, k).astype(jnp.float32) * scale
        logits = logits + bias.astype(jnp.float32)[None, None]
        logits = jnp.where(dist >= 0, logits, -jnp.inf)
        p = jax.nn.softmax(logits, axis=-1)
        attn = p[:, 0] - lam * p[:, 1]
        return jnp.einsum('bhqk,bkhe->bqhe', attn.astype(v.dtype), v)

    out = lax.map(block, (qb, jnp.arange(nb)))
    out = jnp.moveaxis(out, 0, 1).reshape(B, S, H, DIFF_VD).astype(jnp.float32)
    out = out * lax.rsqrt(jnp.mean(jnp.square(out), axis=-1, keepdims=True) + SUBLN_EPS)
    out = out * subln_g * (1.0 - lam_init)
    return out.reshape(B, S, H * DIFF_VD)


def dilated_group(q, k, v, window, dilation, bias_h):
    B, S, H, dh = q.shape
    n_off = window // dilation + 1
    offs = jnp.arange(n_off) * dilation
    bias = jnp.take(bias_h, rel_bucket(offs), axis=0).astype(jnp.float32)
    kp = jnp.pad(k, ((0, 0), (window, 0), (0, 0), (0, 0)))
    vp = jnp.pad(v, ((0, 0), (window, 0), (0, 0), (0, 0)))
    nb = S // Q_BLOCK
    qb = jnp.moveaxis(q.reshape(B, nb, Q_BLOCK, H, dh), 1, 0)
    scale = dh ** -0.5

    def block(args):
        qi, i = args
        qpos = i * Q_BLOCK + jnp.arange(Q_BLOCK)
        kpos = qpos[:, None] - offs[None, :]
        kg = jnp.take(kp, kpos + window, axis=1)
        vg = jnp.take(vp, kpos + window, axis=1)
        logits = jnp.einsum('bqhd,bqjhd->bhqj', qi, kg).astype(jnp.float32) * scale
        logits = logits + bias.T[None, :, None, :]
        logits = jnp.where(kpos >= 0, logits, -jnp.inf)
        lse = jax.nn.logsumexp(logits, axis=-1)
        p = jnp.exp(logits - lse[..., None])
        o = jnp.einsum('bhqj,bqjhd->bqhd', p, vg.astype(jnp.float32))
        return o, lse

    o, lse = lax.map(block, (qb, jnp.arange(nb)))
    o = jnp.moveaxis(o, 0, 1).reshape(B, S, H, dh)
    lse = jnp.transpose(lse, (1, 0, 3, 2)).reshape(B, S, H)
    return o, lse


def dilated_attention(q, k, v, rel_bias_dil):
    B, S = q.shape[0], q.shape[1]
    outs, lses = [], []
    for g, (window, dilation) in enumerate(DIL_PATTERNS):
        o, lse = dilated_group(q[:, :, g], k[:, :, g], v[:, :, g], window, dilation,
                               rel_bias_dil[:, g * DIL_HEADS:(g + 1) * DIL_HEADS])
        outs.append(o)
        lses.append(lse)
    o_all = jnp.stack(outs, axis=2)
    w = jax.nn.softmax(jnp.stack(lses, axis=2), axis=2)
    out = jnp.sum(w[..., None] * o_all, axis=2)
    return out.reshape(B, S, DIL_OUT_W)


def peer(x, w_q, sub_keys, u, v):
    B, S, D = x.shape
    T = B * S
    xt = x.reshape(T // TOKEN_BLOCK, TOKEN_BLOCK, D)

    def block(xb):
        qb = (xb @ w_q).reshape(TOKEN_BLOCK, PEER_HEADS, 2, PEER_DKEY)
        s = jnp.einsum('thcd,hcnd->thcn', qb, sub_keys).astype(jnp.float32)
        s_top, i_top = lax.top_k(s, PEER_TOPK)
        cand = s_top[:, :, 0, :, None] + s_top[:, :, 1, None, :]
        cand_idx = i_top[:, :, 0, :, None] * PEER_NKEYS + i_top[:, :, 1, None, :]
        cand = cand.reshape(TOKEN_BLOCK, PEER_HEADS, PEER_TOPK * PEER_TOPK)
        cand_idx = cand_idx.reshape(TOKEN_BLOCK, PEER_HEADS, PEER_TOPK * PEER_TOPK)
        best, pos = lax.top_k(cand, PEER_TOPK)
        eidx = jnp.take_along_axis(cand_idx, pos, axis=-1)
        g = jax.nn.softmax(best, axis=-1)
        ug = jnp.take(u, eidx, axis=0)
        vg = jnp.take(v, eidx, axis=0)
        h = jax.nn.gelu(jnp.einsum('td,thkd->thk', xb, ug).astype(jnp.float32), approximate=False)
        return jnp.einsum('thk,thkd->td', (g * h).astype(x.dtype), vg)

    return lax.map(block, xt).reshape(B, S, D)


def setup_inputs(seed: int = 0) -> dict:
    key = jax.random.key(seed)
    ks = jax.random.split(key, 16)
    f32 = jnp.float32
    L = DEPTH
    x = jax.random.normal(ks[0], (BATCH, SEQ, D_MODEL), f32)
    col_scale = jnp.ones((IN_COLS,), f32).at[OFF_DV:OFF_LQ].set(BETA).at[OFF_LV:OFF_GA].set(BETA)
    w_in = jax.random.normal(ks[1], (L, D_MODEL, IN_COLS), f32) * D_MODEL ** -0.5 * col_scale
    diff_lambda = jax.random.normal(ks[2], (L, 4, DIFF_HD), f32) * 0.1
    diff_subln_g = 1.0 + 0.02 * jax.random.normal(ks[3], (L, DIFF_VD), f32)
    w_branch_diff = jax.random.normal(ks[4], (L, DIFF_V_W, D_MODEL), f32) * DIFF_V_W ** -0.5
    w_branch_dil = jax.random.normal(ks[5], (L, DIL_OUT_W, D_MODEL), f32) * DIL_OUT_W ** -0.5
    w_out = jax.random.normal(ks[6], (L, D_MODEL, D_MODEL), f32) * D_MODEL ** -0.5 * BETA
    ln1_g = 1.0 + 0.02 * jax.random.normal(ks[7], (L, D_MODEL), f32)
    ln1_b = 0.02 * jax.random.normal(ks[8], (L, D_MODEL), f32)
    peer_wq = jax.random.normal(ks[9], (L, D_MODEL, PEER_HEADS * 2 * PEER_DKEY), f32) * D_MODEL ** -0.5
    peer_keys = jax.random.normal(ks[10], (L, PEER_HEADS, 2, PEER_NKEYS, PEER_DKEY), f32) * PEER_DKEY ** -0.5
    peer_u = jax.random.normal(ks[11], (L, N_EXPERTS, D_MODEL), f32) * D_MODEL ** -0.5
    peer_v = jax.random.normal(ks[12], (L, N_EXPERTS, D_MODEL), f32) * BETA
    ln2_g = 1.0 + 0.02 * jax.random.normal(ks[13], (L, D_MODEL), f32)
    ln2_b = 0.02 * jax.random.normal(ks[14], (L, D_MODEL), f32)
    rel_bias = 0.2 * jax.random.normal(ks[15], (REL_BUCKETS, N_ATTN_HEADS), f32)
    return {'x': x, 'w_in': w_in, 'diff_lambda': diff_lambda, 'diff_subln_g': diff_subln_g,
            'w_branch_diff': w_branch_diff, 'w_branch_dil': w_branch_dil, 'w_out': w_out,
            'ln1_g': ln1_g, 'ln1_b': ln1_b, 'peer_wq': peer_wq, 'peer_keys': peer_keys,
            'peer_u': peer_u, 'peer_v': peer_v, 'ln2_g': ln2_g, 'ln2_b': ln2_b,
            'rel_bias': rel_bias}


def reference(x, w_in, diff_lambda, diff_subln_g, w_branch_diff, w_branch_dil, w_out,
              ln1_g, ln1_b, peer_wq, peer_keys, peer_u, peer_v, ln2_g, ln2_b, rel_bias):
    B, S, D = x.shape
    bias_dist = jnp.take(rel_bias, rel_bucket(jnp.arange(S)), axis=0)
    for l in range(DEPTH):
        lam_init = 0.8 - 0.6 * math.exp(-0.3 * l)
        lp = diff_lambda[l].astype(jnp.float32)
        lam = jnp.exp(jnp.sum(lp[0] * lp[1])) - jnp.exp(jnp.sum(lp[2] * lp[3])) + lam_init

        h = x @ w_in[l]
        dq = h[..., OFF_DQ:OFF_DK].reshape(B, S, DIFF_HEADS, 2, DIFF_HD)
        dk = h[..., OFF_DK:OFF_DV].reshape(B, S, DIFF_HEADS, 2, DIFF_HD)
        dv = h[..., OFF_DV:OFF_LQ].reshape(B, S, DIFF_HEADS, DIFF_VD)
        lq = h[..., OFF_LQ:OFF_LK].reshape(B, S, N_DIL_GROUPS, DIL_HEADS, DIL_HD)
        lk = h[..., OFF_LK:OFF_LV].reshape(B, S, N_DIL_GROUPS, DIL_HEADS, DIL_HD)
        lv = h[..., OFF_LV:OFF_GA].reshape(B, S, N_DIL_GROUPS, DIL_HEADS, DIL_HD)
        gate_a = jax.nn.sigmoid(h[..., OFF_GA:OFF_GB])
        gate_b = jax.nn.sigmoid(h[..., OFF_GB:IN_COLS])

        y_a = diff_attention(dq, dk, dv, lam, lam_init, bias_dist[:, :DIFF_HEADS],
                             diff_subln_g[l]).astype(x.dtype)
        y_b = dilated_attention(lq, lk, lv, rel_bias[:, DIFF_HEADS:]).astype(x.dtype)
        mixed = (gate_a * (y_a @ w_branch_diff[l]) + gate_b * (y_b @ w_branch_dil[l])) @ w_out[l]
        x = layer_norm(ALPHA * x + mixed, ln1_g[l], ln1_b[l])

        ffn = peer(x, peer_wq[l], peer_keys[l], peer_u[l], peer_v[l])
        x = layer_norm(ALPHA * x + ffn, ln2_g[l], ln2_b[l])
    return x
```

```cpp
#include <hip/hip_runtime.h>
#include <cstdio>
#include <cstdint>

#ifndef MK_N_LAUNCHES
#define MK_N_LAUNCHES 1
#endif

constexpr int BATCH = 2, SEQ = 16384, T = BATCH * SEQ, D = 1024, INC = 5888;
constexpr int OFF_DQ = 0, OFF_DK = 512, OFF_DV = 1024, OFF_LQ = 1536, OFF_LK = 2304, OFF_LV = 3072, OFF_GA = 3840, OFF_GB = 4864;
constexpr int NEXP = 16384;
constexpr float LOG2E = 1.4426950408889634f;
constexpr float QSCALE = 0.125f * LOG2E;
constexpr float ALPHA = 1.189207115002721f;
constexpr float LN_EPS = 1e-5f, SUBLN_EPS = 1e-5f;
constexpr float LAM_INIT = 0.2f;
constexpr int NTILE = SEQ / 64;
constexpr int BIAS_TAB = 2112, BIAS_GUARD = 256, DFAR = 1513;

constexpr size_t MiB = 1u << 20;
constexpr size_t WS_CTL = 0, CTL_ZERO_BYTES = 1 * MiB;
constexpr size_t WS_BIASD = 1 * MiB;
constexpr size_t WS_BIASL = 1 * MiB + 64 * 1024;
constexpr size_t WS_WIN = 8 * MiB, WS_WO = 20 * MiB, WS_WBD = 22 * MiB, WS_WBL = 23 * MiB, WS_WP = 24 * MiB;
constexpr size_t WS_A = 32 * MiB;
constexpr size_t WS_YA = WS_A, WS_YB = WS_A + 32 * MiB;
constexpr size_t WS_QD = 96 * MiB, WS_KD = 128 * MiB, WS_VD = 160 * MiB, WS_LQ = 192 * MiB, WS_LK = 240 * MiB, WS_LV = 288 * MiB, WS_GA = 336 * MiB, WS_GB = 400 * MiB;
constexpr size_t WS_STASH = 464 * MiB;
constexpr size_t WS_SEL = 464 * MiB;
constexpr size_t WS_GATED = 96 * MiB;
constexpr size_t WS_R = 160 * MiB;
constexpr size_t WS_ST = 96 * MiB;
constexpr size_t WS_UU = 352 * MiB, WS_UV = 384 * MiB;
constexpr size_t WS_END = 512 * MiB;

constexpr int CW_BAR = 4096;
constexpr int NWAVES = 8;
constexpr int RING_BYTES = 131072, MISC_OFF = RING_BYTES + 320, LDS_BYTES = 147456;

#define GAS __attribute__((address_space(1)))
#define LAS __attribute__((address_space(3)))
typedef unsigned short bf16;
typedef unsigned v4u __attribute__((ext_vector_type(4)));
typedef unsigned v2u __attribute__((ext_vector_type(2)));
typedef float f32x4 __attribute__((ext_vector_type(4)));
typedef float f32x16 __attribute__((ext_vector_type(16)));
typedef short bf16x8 __attribute__((ext_vector_type(8)));
typedef short s16x4 __attribute__((ext_vector_type(4)));
typedef __bf16 bf16x2 __attribute__((ext_vector_type(2)));
typedef GAS unsigned gu32;
#define RLX_AGENT __ATOMIC_RELAXED, __HIP_MEMORY_SCOPE_AGENT
#define LDS_WAIT() asm volatile("s_waitcnt lgkmcnt(0)" ::: "memory")
#define VM_WAIT() asm volatile("s_waitcnt vmcnt(0)" ::: "memory")
__device__ __forceinline__ unsigned f2bf(float f) { unsigned u = __builtin_bit_cast(unsigned, f); return (u + 0x7fffu + ((u >> 16) & 1u)) >> 16; }
__device__ __forceinline__ unsigned pk2(float lo, float hi) { return f2bf(lo) | (f2bf(hi) << 16); }
__device__ __forceinline__ float bf_lo(unsigned w) { return __builtin_bit_cast(float, w << 16); }
__device__ __forceinline__ float bf_hi(unsigned w) { return __builtin_bit_cast(float, w & 0xffff0000u); }
__device__ __forceinline__ float dot2bf(unsigned a, unsigned b, float acc) { return __builtin_amdgcn_fdot2_f32_bf16(__builtin_bit_cast(bf16x2, a), __builtin_bit_cast(bf16x2, b), acc, false); }
__device__ __forceinline__ float wave_sum(float v) {
#pragma unroll
    for (int o = 1; o < 64; o <<= 1) v += __shfl_xor(v, o);
    return v;
}
__device__ __forceinline__ float wave_max(float v) {
#pragma unroll
    for (int o = 1; o < 64; o <<= 1) v = fmaxf(v, __shfl_xor(v, o));
    return v;
}
__device__ __forceinline__ int rel_bucket(int n) {
    if (n < 16) return n < 0 ? 0 : n;
    return 16 + (n >= 22) + (n >= 30) + (n >= 40) + (n >= 54) + (n >= 73) + (n >= 99) + (n >= 134) + (n >= 182) + (n >= 246) + (n >= 332) + (n >= 450) + (n >= 609) + (n >= 825) + (n >= 1117) + (n >= 1513);
}
namespace pg8 {
#define PG8_LAS __attribute__((address_space(3)))
typedef unsigned short bf16_t;
typedef short bf16x8 __attribute__((ext_vector_type(8)));
typedef float f32x4 __attribute__((ext_vector_type(4)));
typedef unsigned u32x4 __attribute__((ext_vector_type(4)));
constexpr int BM = 256, BK = 64, HALF = 128, HTB = HALF * BK * 2  , STAGE_BYTES = 8 * HTB, NXCD = 8, WGM = 8;

__host__ __device__ __forceinline__ int lds_byte(int r, int c) { const int st = (r >> 4) * 2 + (c >> 5), rr = r & 15, cc = c & 31, ob = rr * 64 + cc * 2; return st * 1024 + (ob ^ (((ob >> 9) & 1) << 5)); }
__host__ __device__ __forceinline__ void stage_rc(int b, int& R, int& C) { const int st = b / 1024, sb = b % 1024, swz = sb ^ (((sb >> 9) & 1) << 5); R = (st >> 1) * 16 + swz / 64; C = (st & 1) * 32 + (swz % 64) / 2; }
__host__ __device__ __forceinline__ int perm32(int rho) { const int n = rho >> 4, i = rho & 15; return 8 * (i >> 2) + 4 * n + (i & 3); }

struct Unit { int pm, pn; };
struct Gemm { const bf16_t* A; const bf16_t* Bt; int M, N, K; };

struct StaticOrder {
    int nM, nN, nwg, G, c;
    __host__ __device__ void init(int M, int N, int G_, int c_) { nM = M / BM; nN = N / BM; nwg = nM * nN; G = G_; c = c_; }
    __host__ __device__ bool next(int i, Unit& u) const {
        const long L = (long)i * G + c; if (L >= nwg) return false;
        int wgid = (int)L; { const int q = nwg / NXCD, r = nwg % NXCD, xcd = wgid % NXCD, off = wgid / NXCD; wgid = (xcd < r ? xcd * (q + 1) : r * (q + 1) + (xcd - r) * q) + off; }
        const int nig = WGM * nN, gid = wgid / nig, fm = gid * WGM, gsz = (nM - fm) < WGM ? (nM - fm) : WGM;
        u.pm = fm + ((wgid % nig) % gsz); u.pn = (wgid % nig) / gsz; return true;
    }
    __device__ __forceinline__ void a_ready(const Unit&) const {}
    __device__ __forceinline__ void done(const Unit&) const {}
};
__device__ __forceinline__ unsigned cvt_pk_bf16(float lo, float hi) { unsigned r; asm volatile("v_cvt_pk_bf16_f32 %0, %1, %2" : "=v"(r) : "v"(lo), "v"(hi)); return r; }
__device__ __forceinline__ u32x4 pack8(const f32x4 v0, const f32x4 v1) { u32x4 w; w.x = cvt_pk_bf16(v0[0], v0[1]); w.y = cvt_pk_bf16(v0[2], v0[3]); w.z = cvt_pk_bf16(v1[0], v1[1]); w.w = cvt_pk_bf16(v1[2], v1[3]); return w; }
__device__ __forceinline__ float blo(unsigned w) { return __builtin_bit_cast(float, w << 16); }
__device__ __forceinline__ float bhi(unsigned w) { return __builtin_bit_cast(float, w & 0xffff0000u); }
__device__ __forceinline__ float sigm(float v) { return __builtin_amdgcn_rcpf(1.f + __expf(-v)); }
template <class E> __device__ __forceinline__ void epi_loop(const E& e, const f32x4 (&acc)[2][2][4][2], const Unit& u, int wr, int wc, int fr, int fq) {
#pragma unroll
    for (int ai = 0; ai < 2; ++ai)
#pragma unroll
        for (int m = 0; m < 4; ++m) { const int row = u.pm * BM + ai * HALF + wr * 64 + m * 16 + fr;
#pragma unroll
            for (int bj = 0; bj < 2; ++bj) { const int col = u.pn * BM + bj * HALF + wc * 32 + 8 * fq; e.item(u.pn, row, col, acc[ai][bj][m][0], acc[ai][bj][m][1]); } }
}

struct EpiInProj {
    static constexpr bool PERM = true, AFTER_DRAIN = false;
    bf16_t *Qd, *Kd, *Vd, *LQ, *LK, *LV, *GA, *GB;
    __device__ __forceinline__ void operator()(const f32x4 (&acc)[2][2][4][2], const Unit& u, int wr, int wc, int fr, int fq) const { epi_loop(*this, acc, u, wr, wc, fr, fq); }
    __device__ __forceinline__ void item(int pn, int row, int col, f32x4 v0, f32x4 v1) const {
            const int b = row >> 14, s = row & 16383; bf16_t* dst;
            if (pn < 2) {
                const int h = col >> 7, c = (col >> 6) & 1, d = col & 63; v0 = v0 * 0.18033688011112042f; v1 = v1 * 0.18033688011112042f;
                dst = Qd + ((size_t)((b * 4 + h) * 2 + c) * 16384 + s) * 64 + d;
            } else if (pn < 4) {
                const int cc = col - 512, h = cc >> 7, c = (cc >> 6) & 1, d = cc & 63;
                dst = Kd + ((((size_t)((b * 4 + h) * 2 + c) * 256 + (s >> 6)) * 8 + (d >> 3)) * 64 + (s & 63)) * 8;
            } else if (pn < 6) {
                const int cc = col - 1024, h = cc >> 7, d = cc & 127;
                dst = Vd + ((size_t)(b * 4 + h) * 256 + (s >> 6)) * 8192 + ((d >> 5) * 4 + ((s & 63) >> 4)) * 512 + (s & 15) * 32 + (d & 31);
            } else if (pn < 9) {
                v0 = v0 * 0.18033688011112042f; v1 = v1 * 0.18033688011112042f; dst = LQ + (size_t)row * 768 + (col - 1536);
            } else if (pn < 12) { dst = LK + (size_t)row * 768 + (col - 2304);
            } else if (pn < 15) { dst = LV + (size_t)row * 768 + (col - 3072);
            } else {
#pragma unroll
                for (int i = 0; i < 4; ++i) { v0[i] = sigm(v0[i]); v1[i] = sigm(v1[i]); }
                dst = (pn < 19) ? GA + (size_t)row * 1024 + (col - 3840) : GB + (size_t)row * 1024 + (col - 4864);
            }
            *(u32x4*)dst = pack8(v0, v1);
        }
};
struct EpiGate1 {
    static constexpr bool PERM = true, AFTER_DRAIN = false;
    const bf16_t* GA; bf16_t* G;
    __device__ __forceinline__ void operator()(const f32x4 (&acc)[2][2][4][2], const Unit& u, int wr, int wc, int fr, int fq) const { epi_loop(*this, acc, u, wr, wc, fr, fq); }
    __device__ __forceinline__ void item(int pn, int row, int col, f32x4 v0, f32x4 v1) const {
            const size_t o = (size_t)row * 1024 + col; const u32x4 g = *(const u32x4*)(GA + o);
            v0[0] *= blo(g.x); v0[1] *= bhi(g.x); v0[2] *= blo(g.y); v0[3] *= bhi(g.y); v1[0] *= blo(g.z); v1[1] *= bhi(g.z); v1[2] *= blo(g.w); v1[3] *= bhi(g.w);
            *(u32x4*)(G + o) = pack8(v0, v1);
        }
};
struct EpiGate2 {
    static constexpr bool PERM = true, AFTER_DRAIN = false;
    const bf16_t* GB; bf16_t* G;
    __device__ __forceinline__ void operator()(const f32x4 (&acc)[2][2][4][2], const Unit& u, int wr, int wc, int fr, int fq) const { epi_loop(*this, acc, u, wr, wc, fr, fq); }
    __device__ __forceinline__ void item(int pn, int row, int col, f32x4 v0, f32x4 v1) const {
            const size_t o = (size_t)row * 1024 + col; const u32x4 g = *(const u32x4*)(GB + o); const u32x4 p = *(const u32x4*)(G + o);
            v0[0] = v0[0] * blo(g.x) + blo(p.x); v0[1] = v0[1] * bhi(g.x) + bhi(p.x); v0[2] = v0[2] * blo(g.y) + blo(p.y); v0[3] = v0[3] * bhi(g.y) + bhi(p.y);
            v1[0] = v1[0] * blo(g.z) + blo(p.z); v1[1] = v1[1] * bhi(g.z) + bhi(p.z); v1[2] = v1[2] * blo(g.w) + blo(p.w); v1[3] = v1[3] * bhi(g.w) + bhi(p.w);
            *(u32x4*)(G + o) = pack8(v0, v1);
        }
};
struct EpiOut {
    static constexpr bool PERM = true, AFTER_DRAIN = false;
    const float* X; float* R;
    __device__ __forceinline__ void operator()(const f32x4 (&acc)[2][2][4][2], const Unit& u, int wr, int wc, int fr, int fq) const { epi_loop(*this, acc, u, wr, wc, fr, fq); }
    __device__ __forceinline__ void item(int pn, int row, int col, f32x4 v0, f32x4 v1) const {
            const size_t o = (size_t)row * 1024 + col; const f32x4 x0 = *(const f32x4*)(X + o), x1 = *(const f32x4*)(X + o + 4);
            *(f32x4*)(R + o) = x0 * 1.189207115002721f + v0; *(f32x4*)(R + o + 4) = x1 * 1.189207115002721f + v1;
        }
};
struct EpiScoreT {
    static constexpr bool PERM = true, AFTER_DRAIN = false;
    float* ST;
    __device__ __forceinline__ void operator()(const f32x4 (&acc)[2][2][4][2], const Unit& u, int wr, int wc, int fr, int fq) const { epi_loop(*this, acc, u, wr, wc, fr, fq); }
    __device__ __forceinline__ void item(int pn, int row, int col, f32x4 v0, f32x4 v1) const { const size_t o = (size_t)row * 32768 + col; *(f32x4*)(ST + o) = v0; *(f32x4*)(ST + o + 4) = v1; }
};
template <class Epi, class Sched, bool ALIGN_EPI = false, bool SP2 = false>
__device__ __forceinline__ void gemm_phase(PG8_LAS unsigned char* lds, const Gemm g, const Sched& S, const Epi& E) {
    const int tid = threadIdx.x, wid = __builtin_amdgcn_readfirstlane(tid >> 6), lane = tid & 63, wr = wid >> 2, wc = wid & 3, fr = lane & 15, fq = lane >> 4;
    const int K = g.K, nt = K / BK;
    unsigned voffA[2], voffB[2];
#pragma unroll
    for (int i = 0; i < 2; ++i) { int R, C; stage_rc(tid * 16 + i * 8192, R, C); const int Rb = Epi::PERM ? ((R & ~31) + perm32(R & 31)) : R;
        voffA[i] = (unsigned)(R * K + C) * 2u; voffB[i] = (unsigned)(Rb * K + C) * 2u; }
    const size_t kstep = (size_t)(BK * 2);
    const size_t hstep = (size_t)HALF * K * 2;
    const size_t tstep = 2 * hstep;
    const unsigned ldsw = (unsigned)wid * 1024u;
    const int aoff = lds_byte(wr * 64 + fr, fq * 8), boff = lds_byte(wc * 32 + fr, fq * 8);
#define PG8_SA(b, h) (((b) * 2 + (h)) * HTB)
#define PG8_SB(b, h) ((4 + (b) * 2 + (h)) * HTB)
#define PG8_STAGE(bufoff, gbase, voff) do { _Pragma("unroll") for (int _i = 0; _i < 2; ++_i) \
        __builtin_amdgcn_global_load_lds((const unsigned*)((const char*)(gbase) + (voff)[_i]), (PG8_LAS unsigned*)(lds + (bufoff) + ldsw + _i * 8192), 16, 0, 0); } while (0)
#define PG8_LDA(dst, b, h) do { _Pragma("unroll") for (int m = 0; m < 4; ++m) _Pragma("unroll") for (int k = 0; k < 2; ++k) dst[m][k] = *(const PG8_LAS bf16x8*)(lds + PG8_SA(b, h) + aoff + m * 2048 + k * 1024); } while (0)
#define PG8_LDB(dst, b, h) do { _Pragma("unroll") for (int n = 0; n < 2; ++n) _Pragma("unroll") for (int k = 0; k < 2; ++k) dst[n][k] = *(const PG8_LAS bf16x8*)(lds + PG8_SB(b, h) + boff + n * 2048 + k * 1024); } while (0)
#define PG8_MMA(ai, bj, At, Bt) do { __builtin_amdgcn_s_setprio(1); _Pragma("unroll") for (int m = 0; m < 4; ++m) _Pragma("unroll") for (int n = 0; n < 2; ++n) _Pragma("unroll") for (int k = 0; k < 2; ++k) \
        acc[ai][bj][m][n] = __builtin_amdgcn_mfma_f32_16x16x32_bf16(Bt[n][k], At[m][k], acc[ai][bj][m][n], 0, 0, 0); __builtin_amdgcn_s_setprio(0); } while (0)
#define PG8_WAIT_V(n) asm volatile("s_waitcnt vmcnt(" #n ")" ::: "memory")
#define PG8_WAIT_L(n) asm volatile("s_waitcnt lgkmcnt(" #n ")" ::: "memory")
#define PG8_BAR __builtin_amdgcn_s_barrier()
#define PG8_SCHED __builtin_amdgcn_sched_barrier(0)
    Unit cur, nxt; int ui = 0;
    if (!S.next(0, cur)) return;
    f32x4 acc[2][2][4][2];
#pragma unroll
    for (int a = 0; a < 2; ++a)
#pragma unroll
        for (int b = 0; b < 2; ++b)
#pragma unroll
            for (int m = 0; m < 4; ++m)
#pragma unroll
                for (int n = 0; n < 2; ++n) acc[a][b][m][n] = (f32x4){0.f, 0.f, 0.f, 0.f};
    bf16x8 At[4][2], B0[2][2], B1[2][2];
    const char* cA = (const char*)g.A + (size_t)cur.pm * tstep; const char* cB = (const char*)g.Bt + (size_t)cur.pn * tstep;
    S.a_ready(cur);
    if constexpr (SP2) {
        PG8_STAGE(PG8_SB(0, 0), cB, voffB); PG8_STAGE(PG8_SB(0, 1), cB + hstep, voffB); PG8_STAGE(PG8_SA(0, 0), cA, voffA); PG8_STAGE(PG8_SA(0, 1), cA + hstep, voffA);
        if (wr == 1) PG8_BAR;
        PG8_WAIT_V(2); PG8_BAR;
        PG8_STAGE(PG8_SB(1, 0), cB + kstep, voffB); PG8_STAGE(PG8_SA(1, 0), cA + kstep, voffA); PG8_STAGE(PG8_SB(1, 1), cB + hstep + kstep, voffB);
        PG8_WAIT_V(6); PG8_BAR;
    } else {
        PG8_STAGE(PG8_SB(0, 0), cB, voffB); PG8_STAGE(PG8_SA(0, 0), cA, voffA); PG8_STAGE(PG8_SB(0, 1), cB + hstep, voffB); PG8_STAGE(PG8_SA(0, 1), cA + hstep, voffA);
        if (wr == 1) PG8_BAR;
        PG8_WAIT_V(4); PG8_BAR;
        PG8_STAGE(PG8_SB(1, 0), cB + kstep, voffB); PG8_STAGE(PG8_SA(1, 0), cA + kstep, voffA); PG8_STAGE(PG8_SB(1, 1), cB + hstep + kstep, voffB);
        PG8_WAIT_V(6); PG8_BAR;
    }
    for (;;) {
        const bool has_next = S.next(ui + 1, nxt);
        const char* nA = has_next ? (const char*)g.A + (size_t)nxt.pm * tstep : cA; const char* nB = has_next ? (const char*)g.Bt + (size_t)nxt.pn * tstep : cB;
        for (int t = 0; t < nt; t += 2) {
            const bool last = (t == nt - 2);
            const char* a1 = cA + (size_t)(t + 1) * kstep;
            const char* a2 = last ? nA : cA + (size_t)(t + 2) * kstep; const char* b2 = last ? nB : cB + (size_t)(t + 2) * kstep;
            const char* a3 = a2 + kstep; const char* b3 = b2 + kstep;
            if (last && has_next) S.a_ready(nxt);
            if constexpr (SP2) {
            PG8_LDB(B0, 0, 0); PG8_LDB(B1, 0, 1); PG8_SCHED; PG8_LDA(At, 0, 0); PG8_STAGE(PG8_SA(1, 1), a1 + hstep, voffA);
            PG8_WAIT_V(8); PG8_WAIT_L(0); PG8_BAR; PG8_MMA(0, 0, At, B0); PG8_MMA(0, 1, At, B1); PG8_BAR; PG8_SCHED;
            PG8_LDA(At, 0, 1); PG8_STAGE(PG8_SB(0, 0), b2, voffB); PG8_STAGE(PG8_SB(0, 1), b2 + hstep, voffB); PG8_STAGE(PG8_SA(0, 0), a2, voffA);
            PG8_WAIT_V(8); PG8_WAIT_L(0); PG8_BAR; PG8_MMA(1, 0, At, B0); PG8_MMA(1, 1, At, B1); PG8_BAR; PG8_SCHED;
            PG8_LDB(B0, 1, 0); PG8_LDB(B1, 1, 1); PG8_SCHED; PG8_LDA(At, 1, 0); PG8_STAGE(PG8_SA(0, 1), a2 + hstep, voffA);
            PG8_WAIT_V(8); PG8_WAIT_L(0); PG8_BAR; PG8_MMA(0, 0, At, B0); PG8_MMA(0, 1, At, B1); PG8_BAR; PG8_SCHED;
            PG8_LDA(At, 1, 1); PG8_STAGE(PG8_SB(1, 0), b3, voffB); PG8_STAGE(PG8_SB(1, 1), b3 + hstep, voffB); PG8_STAGE(PG8_SA(1, 0), a3, voffA);
            PG8_WAIT_V(8); PG8_WAIT_L(0); PG8_BAR; PG8_MMA(1, 0, At, B0); PG8_MMA(1, 1, At, B1); PG8_BAR; PG8_SCHED;
            } else {
            PG8_LDB(B0, 0, 0); PG8_SCHED; PG8_LDA(At, 0, 0); PG8_STAGE(PG8_SA(1, 1), a1 + hstep, voffA);
            PG8_WAIT_L(8); PG8_BAR; PG8_WAIT_L(0); PG8_MMA(0, 0, At, B0); PG8_BAR; PG8_SCHED;
            PG8_LDB(B1, 0, 1); PG8_STAGE(PG8_SB(0, 0), b2, voffB);
            PG8_BAR; PG8_WAIT_L(0); PG8_MMA(0, 1, At, B1); PG8_BAR;
            PG8_LDA(At, 0, 1); PG8_STAGE(PG8_SA(0, 0), a2, voffA);
            PG8_BAR; PG8_WAIT_L(0); PG8_MMA(1, 0, At, B0); PG8_BAR; PG8_SCHED;
            PG8_STAGE(PG8_SB(0, 1), b2 + hstep, voffB);
            PG8_WAIT_V(6); PG8_BAR; PG8_MMA(1, 1, At, B1); PG8_BAR;
            PG8_LDB(B0, 1, 0); PG8_SCHED; PG8_LDA(At, 1, 0); PG8_STAGE(PG8_SA(0, 1), a2 + hstep, voffA);
            PG8_WAIT_L(8); PG8_BAR; PG8_WAIT_L(0); PG8_MMA(0, 0, At, B0); PG8_BAR; PG8_SCHED;
            PG8_LDB(B1, 1, 1); PG8_STAGE(PG8_SB(1, 0), b3, voffB);
            PG8_BAR; PG8_WAIT_L(0); PG8_MMA(0, 1, At, B1); PG8_BAR;
            PG8_LDA(At, 1, 1); PG8_STAGE(PG8_SA(1, 0), a3, voffA);
            PG8_BAR; PG8_WAIT_L(0); PG8_MMA(1, 0, At, B0); PG8_BAR; PG8_SCHED;
            PG8_STAGE(PG8_SB(1, 1), b3 + hstep, voffB);
            PG8_WAIT_V(6); PG8_BAR; PG8_MMA(1, 1, At, B1); PG8_BAR;
            }
        }
        if constexpr (ALIGN_EPI) { if (wr == 0) PG8_BAR; }
        if constexpr (!Epi::AFTER_DRAIN) { E(acc, cur, wr, wc, fr, fq); S.done(cur); }
        if (!has_next) break;
#pragma unroll
        for (int a = 0; a < 2; ++a)
#pragma unroll
            for (int b = 0; b < 2; ++b)
#pragma unroll
                for (int m = 0; m < 4; ++m)
#pragma unroll
                    for (int n = 0; n < 2; ++n) acc[a][b][m][n] = (f32x4){0.f, 0.f, 0.f, 0.f};
        cur = nxt; cA = nA; cB = nB; ++ui;
        if constexpr (ALIGN_EPI) { if (wr == 1) PG8_BAR; }
    }
    PG8_WAIT_V(0);
    if constexpr (!ALIGN_EPI) { if (wr == 0) PG8_BAR; }
    PG8_BAR;
    if constexpr (Epi::AFTER_DRAIN) { E.fused(acc, cur, wr, wc, fr, fq, lds, wid, lane); S.done(cur); }
#undef PG8_SA
#undef PG8_SB
#undef PG8_STAGE
#undef PG8_LDA
#undef PG8_LDB
#undef PG8_MMA
#undef PG8_WAIT_V
#undef PG8_WAIT_L
#undef PG8_BAR
#undef PG8_SCHED
}
}
#define XB_TMO      128
#define XB_XCNT(j)  (256  + 64 * (j))
#define XB_XSUB(j)  (1280 + 64 * (j))
#define XB_XGEN(j)  (2304 + 64 * (j))
#define XB_TOP      3328
#define XB_TOPGEN   3392
#define XCD_BAR_WORDS 3456
#define XB_SPIN_CAP (1u << 18)

__device__ __forceinline__ unsigned xb_ld(unsigned* p)              { return __hip_atomic_load(p, __ATOMIC_RELAXED, __HIP_MEMORY_SCOPE_AGENT); }
__device__ __forceinline__ unsigned xb_add(unsigned* p, unsigned v) { return __hip_atomic_fetch_add(p, v, __ATOMIC_RELAXED, __HIP_MEMORY_SCOPE_AGENT); }
__device__ __forceinline__ unsigned xb_xcc_id() { return (unsigned)__builtin_amdgcn_s_getreg((3 << 11) | 20) & 0xFu; }
#define XB_SPIN(cond, bar) do { unsigned _sp = 0; while (cond) { __builtin_amdgcn_s_sleep(1); \
    if ((++_sp & 255u) == 0u) { if (xb_ld(&(bar)[XB_TMO])) break; if (_sp > XB_SPIN_CAP) { atomicAdd(&(bar)[XB_TMO], 1u); break; } } } } while (0)

struct XcdBarrier {
    unsigned* bar; unsigned x;
    volatile LAS unsigned* st;
};

__device__ __forceinline__ XcdBarrier xcd_barrier_post(unsigned* bar, volatile LAS unsigned* st) {
    XcdBarrier b; b.bar = bar; b.x = xb_xcc_id(); b.st = st;
    if (threadIdx.x == 0) (void)xb_add(&bar[XB_XCNT(b.x)], 1u);
    return b;
}
__device__ __forceinline__ void xcd_barrier_complete(unsigned* bar, unsigned x, unsigned& nloc, unsigned& nx) {
    const unsigned G = gridDim.x * gridDim.y * gridDim.z;
    unsigned sum, cnt, mine, sp = 0u;
    for (;;) {
        sum = 0u; cnt = 0u; mine = 0u;
#pragma unroll
        for (unsigned j = 0; j < 16; ++j) { const unsigned c = xb_ld(&bar[XB_XCNT(j)]); sum += c; cnt += (c > 0u) ? 1u : 0u; mine = (j == x) ? c : mine; }
        if (sum == G) break;
        __builtin_amdgcn_s_sleep(1);
        if ((++sp & 255u) == 0u) { if (xb_ld(&bar[XB_TMO])) break; if (sp > XB_SPIN_CAP) { atomicAdd(&bar[XB_TMO], 1u); break; } }
    }
    nloc = mine > 0u ? mine : 1u; nx = cnt > 0u ? cnt : 1u;
}

__device__ __forceinline__ void xcd_barrier(const XcdBarrier& b) {
    asm volatile("s_waitcnt vmcnt(0)" ::: "memory");
    __syncthreads();
    if (threadIdx.x == 0) {
        unsigned* bar = b.bar;
        __builtin_amdgcn_s_waitcnt(0);
        unsigned nloc = b.st[0], nx = b.st[1];
        if (nloc == 0u) { xcd_barrier_complete(bar, b.x, nloc, nx); b.st[0] = nloc; b.st[1] = nx; }
        const unsigned old = xb_add(&bar[XB_XSUB(b.x)], 1u);
        const unsigned gen = old / nloc;
        if (old + 1u == (gen + 1u) * nloc) {
            __builtin_amdgcn_fence(__ATOMIC_RELEASE, "agent");
            asm volatile("s_waitcnt vmcnt(0)" ::: "memory");
            const unsigned og = xb_add(&bar[XB_TOP], 1u);
            const unsigned tg = og / nx;
            if (og + 1u == (tg + 1u) * nx) xb_add(&bar[XB_TOPGEN], 1u);
            else XB_SPIN(xb_ld(&bar[XB_TOPGEN]) == tg, bar);
            __builtin_amdgcn_fence(__ATOMIC_ACQUIRE, "agent");
            xb_add(&bar[XB_XGEN(b.x)], 1u);
            asm volatile("s_waitcnt vmcnt(0)" ::: "memory");
        } else {
            XB_SPIN(xb_ld(&bar[XB_XGEN(b.x)]) == gen, bar);
            __builtin_amdgcn_fence(__ATOMIC_ACQUIRE, "agent");
            asm volatile("s_waitcnt vmcnt(0)" ::: "memory");
        }
    }
    __syncthreads();
}
namespace da {
constexpr int SLOT_K = 8192, SLOT_V = 16384, SLOT = SLOT_K + SLOT_V;
constexpr int LDS_BIAS = 2 * SLOT;
constexpr int LDS_END = LDS_BIAS + BIAS_TAB * 4;
constexpr float THR = 8.f;
__device__ __forceinline__ int crow(int r, int hi) { return (r & 3) + 8 * (r >> 2) + 4 * hi; }
__device__ __forceinline__ void glds16(const void* gbase  , unsigned voff  , unsigned lds_dst) { unsigned keep;
    asm volatile("s_mov_b32 %0, m0\n\ts_mov_b32 m0, %3\n\ts_nop 0\n\tglobal_load_lds_dwordx4 %1, %2\n\ts_mov_b32 m0, %0" : "=&s"(keep) : "v"(voff), "s"(gbase), "s"(lds_dst) : "memory"); }
typedef short v4i16_t __attribute__((ext_vector_type(4)));
__device__ __forceinline__ s16x4 vtr(const LAS char* p) { return __builtin_bit_cast(s16x4, __builtin_amdgcn_ds_read_tr16_b64_v4i16((LAS v4i16_t*)p)); }
#define DA_WAIT_BAR() asm volatile("s_waitcnt vmcnt(0) lgkmcnt(0)\n\ts_barrier" ::: "memory")

struct Tensors { const bf16* Qd; const bf16* Kd; const bf16* Vd; float* stash; bf16* ya; const float* dlam; const float* subg; const float* relb; };

__device__ __forceinline__ void unit(const Tensors& X, int b, int h, int qb, LAS unsigned char* lds, int wgslot, float lam, float c31) {
    const int tid = threadIdx.x, lane = tid & 63, r32 = lane & 31, hi = lane >> 5; const int wid = __builtin_amdgcn_readfirstlane(tid >> 6);
    const int q0 = qb * 256, NT = 4 * (qb + 1);
    const unsigned lds0 = (unsigned)(uintptr_t)lds;
    const LAS float* tb = (const LAS float*)(lds + LDS_BIAS);
    const unsigned lane16 = (unsigned)lane * 16u;
    const int qabs = q0 + wid * 32 + r32;
    const LAS char* vp0 = (const LAS char*)lds + SLOT_K + ((lane >> 4) & 1) * 32 + (lane & 3) * 8 + (4 * hi + ((lane & 15) >> 2)) * 64;
    const LAS char* kp0 = (const LAS char*)lds + hi * 1024 + r32 * 16;
    for (int c = 0; c < 2; ++c) {
        const int bhc = (b * 4 + h) * 2 + c;
        const bf16* Qw = X.Qd + ((size_t)bhc * SEQ + q0 + wid * 32 + r32) * 64 + hi * 8;
        const char* Kt = (const char*)X.Kd + (size_t)bhc * NTILE * SLOT_K + wid * 1024;
        const char* Vt = (const char*)X.Vd + (size_t)(b * 4 + h) * NTILE * SLOT_V + wid * 1024;
#define DA_DMA(t, slot) do { const unsigned sb_ = (unsigned)__builtin_amdgcn_readfirstlane(lds0 + (slot) * SLOT + wid * 1024); \
        glds16(Kt + (size_t)(t) * SLOT_K, lane16, sb_); glds16(Vt + (size_t)(t) * SLOT_V, lane16, sb_ + SLOT_K); glds16(Vt + (size_t)(t) * SLOT_V + 8192, lane16, sb_ + SLOT_K + 8192); } while (0)
        DA_DMA(0, 0);
        bf16x8 qr[4];
#pragma unroll
        for (int d0 = 0; d0 < 4; ++d0) qr[d0] = *(const bf16x8*)(Qw + d0 * 16);
        f32x16 o[4];
#pragma unroll
        for (int d0 = 0; d0 < 4; ++d0)
#pragma unroll
            for (int r = 0; r < 16; ++r) o[d0][r] = 0.f;
        float m = -1e30f, l = 0.f;
        for (int t = 0; t < NT; ++t) {
            DA_WAIT_BAR();
            if (t + 1 < NT) DA_DMA(t + 1, (t + 1) & 1);
            const int sl = (t & 1) * SLOT;
            const bool nearb = (q0 - 64 * t - 63) < DFAR;
            const int base = qabs - 64 * t - 4 * hi + BIAS_GUARD;
            f32x16 p0, p1;
            if (nearb) {
#pragma unroll
                for (int r = 0; r < 16; ++r) { const int o_ = (r & 3) + 8 * (r >> 2); p0[r] = tb[base - o_]; p1[r] = tb[base - o_ - 32]; }
            } else {
#pragma unroll
                for (int r = 0; r < 16; ++r) { p0[r] = 0.f; p1[r] = 0.f; }
            }
            const float cadd = nearb ? 0.f : c31;
            {
                const LAS char* kb = kp0 + sl;
#pragma unroll
                for (int d0 = 0; d0 < 4; ++d0) {
                    const bf16x8 k0 = *(const LAS bf16x8*)(kb + d0 * 2048), k1 = *(const LAS bf16x8*)(kb + d0 * 2048 + 512);
                    p0 = __builtin_amdgcn_mfma_f32_32x32x16_bf16(k0, qr[d0], p0, 0, 0, 0);
                    p1 = __builtin_amdgcn_mfma_f32_32x32x16_bf16(k1, qr[d0], p1, 0, 0, 0);
                }
            }
            if (t >= NT - 4) {
#pragma unroll
                for (int r = 0; r < 16; ++r) { const int o_ = (r & 3) + 8 * (r >> 2); if (base - o_ < BIAS_GUARD) p0[r] = -1e30f; if (base - o_ - 32 < BIAS_GUARD) p1[r] = -1e30f; }
            }
            float rm = fmaxf(p0[0], p1[0]);
#pragma unroll
            for (int r = 1; r < 16; ++r) rm = fmaxf(rm, fmaxf(p0[r], p1[r]));
            { auto rr = __builtin_amdgcn_permlane32_swap(__float_as_uint(rm), __float_as_uint(rm), false, false); rm = fmaxf(__uint_as_float(rr[0]), __uint_as_float(rr[1])); }
            rm += cadd;
            if (__any(rm > m + THR)) {
                const float mn = fmaxf(m, rm), f = __builtin_amdgcn_exp2f(m - mn);
#pragma unroll
                for (int d0 = 0; d0 < 4; ++d0)
#pragma unroll
                    for (int r = 0; r < 16; ++r) o[d0][r] *= f;
                l *= f; m = mn;
            }
            const float sub = cadd - m;
            float ls = 0.f;
#pragma unroll
            for (int r = 0; r < 16; ++r) { p0[r] = __builtin_amdgcn_exp2f(p0[r] + sub); p1[r] = __builtin_amdgcn_exp2f(p1[r] + sub); ls += p0[r] + p1[r]; }
            l += ls;
            bf16x8 pw[4];
            { v4u w;
              w.x = pk2(p0[0], p0[1]); w.y = pk2(p0[2], p0[3]); w.z = pk2(p0[4], p0[5]); w.w = pk2(p0[6], p0[7]); pw[0] = __builtin_bit_cast(bf16x8, w);
              w.x = pk2(p0[8], p0[9]); w.y = pk2(p0[10], p0[11]); w.z = pk2(p0[12], p0[13]); w.w = pk2(p0[14], p0[15]); pw[1] = __builtin_bit_cast(bf16x8, w);
              w.x = pk2(p1[0], p1[1]); w.y = pk2(p1[2], p1[3]); w.z = pk2(p1[4], p1[5]); w.w = pk2(p1[6], p1[7]); pw[2] = __builtin_bit_cast(bf16x8, w);
              w.x = pk2(p1[8], p1[9]); w.y = pk2(p1[10], p1[11]); w.z = pk2(p1[12], p1[13]); w.w = pk2(p1[14], p1[15]); pw[3] = __builtin_bit_cast(bf16x8, w); }
            const LAS char* vb = vp0 + sl;
#pragma unroll
            for (int d0 = 0; d0 < 4; ++d0) {
#pragma unroll
                for (int ks = 0; ks < 4; ++ks) {
                    const s16x4 lo = vtr(vb + d0 * 4096 + ks * 1024), hh = vtr(vb + d0 * 4096 + ks * 1024 + 512);
                    const bf16x8 vf = (bf16x8){lo[0], lo[1], lo[2], lo[3], hh[0], hh[1], hh[2], hh[3]};
                    o[d0] = __builtin_amdgcn_mfma_f32_32x32x16_bf16(vf, pw[ks], o[d0], 0, 0, 0);
                }
                if (d0 & 1) __builtin_amdgcn_sched_barrier(0);
            }
        }
#undef DA_DMA
        { auto rr = __builtin_amdgcn_permlane32_swap(__float_as_uint(l), __float_as_uint(l), false, false); l = __uint_as_float(rr[0]) + __uint_as_float(rr[1]); }
        const float inv = 1.f / l;
        float* st = X.stash + ((size_t)(wgslot * 8 + wid) * 64) * 64 + lane;
        asm volatile("" : "+v"(st)); GAS float* stg = (GAS float*)st;
        if (c == 0) {
#pragma unroll
            for (int d0 = 0; d0 < 4; ++d0)
#pragma unroll
                for (int r = 0; r < 16; ++r) stg[(d0 * 16 + r) * 64] = o[d0][r] * inv;
        } else {
            float ss = 0.f;
#pragma unroll
            for (int d0 = 0; d0 < 4; ++d0)
#pragma unroll
                for (int r = 0; r < 16; ++r) { const float dv = stg[(d0 * 16 + r) * 64] - lam * (o[d0][r] * inv); o[d0][r] = dv; ss += dv * dv; }
            { auto rr = __builtin_amdgcn_permlane32_swap(__float_as_uint(ss), __float_as_uint(ss), false, false); ss = __uint_as_float(rr[0]) + __uint_as_float(rr[1]); }
            const float rn = __builtin_amdgcn_rsqf(ss * (1.f / 128.f) + SUBLN_EPS) * (1.f - LAM_INIT);
            bf16* yrow = X.ya + ((size_t)b * SEQ + qabs) * 512 + h * 128 + 4 * hi; const float* sg = X.subg + 4 * hi;
            asm volatile("" : "+v"(yrow), "+v"(sg));
#pragma unroll
            for (int d0 = 0; d0 < 4; ++d0)
#pragma unroll
                for (int r4 = 0; r4 < 4; ++r4) {
                    const int dd = 32 * d0 + 8 * r4; const f32x4 g = *(const f32x4*)(sg + dd);
                    v2u w; w.x = pk2(o[d0][4 * r4] * rn * g[0], o[d0][4 * r4 + 1] * rn * g[1]); w.y = pk2(o[d0][4 * r4 + 2] * rn * g[2], o[d0][4 * r4 + 3] * rn * g[3]);
                    *(v2u*)(yrow + dd) = w;
                }
        }
    }
    asm volatile("s_waitcnt vmcnt(0) lgkmcnt(0)\n\ts_barrier" ::: "memory");
}
#undef DA_WAIT_BAR
}
namespace dil {
struct Tensors { const bf16* LQ; const bf16* LK; const bf16* LV; const float* biasL; bf16* yb; };
__device__ __forceinline__ void task(const Tensors& X, int tblk, int h, int lane) {
    for (int i = 0; i < 64; ++i) {
        const int mrow = __builtin_amdgcn_readfirstlane(tblk * 64 + i), b = mrow >> 14, s = mrow & (SEQ - 1);
        float lg[9];
#pragma unroll
        for (int g = 0; g < 3; ++g) {
            const int dl = (g == 0) ? 1 : (g == 1) ? 4 : 16;
            const v4u* qp = (const v4u*)(X.LQ + (size_t)mrow * 768 + g * 256 + h * 64); asm volatile("" : "+v"(qp));
            v4u q[8];
#pragma unroll
            for (int k = 0; k < 8; ++k) q[k] = qp[k];
            const float* bl = X.biasL + (g * 4 + h) * 132;
#pragma unroll
            for (int rnd = 0; rnd < 3; ++rnd) {
                const int j = rnd * 64 + lane; const int kpos = s - j * dl; const bool valid = (j <= 128) && (kpos >= 0);
                const int kc = valid ? kpos : 0;
                float a0 = 0.f, a1 = 0.f;
                if (rnd < 2 || lane == 0) {
                    const v4u* kp = (const v4u*)(X.LK + ((size_t)b * SEQ + kc) * 768 + g * 256 + h * 64);
#pragma unroll
                    for (int k = 0; k < 8; ++k) { const v4u kv = kp[k]; a0 = dot2bf(kv.x, q[k].x, a0); a1 = dot2bf(kv.y, q[k].y, a1); a0 = dot2bf(kv.z, q[k].z, a0); a1 = dot2bf(kv.w, q[k].w, a1); }
                }
                const float bias = bl[j <= 128 ? j : 128];
                lg[g * 3 + rnd] = valid ? (a0 + a1 + bias) : -1e30f;
            }
        }
        float mx = lg[0];
#pragma unroll
        for (int k = 1; k < 9; ++k) mx = fmaxf(mx, lg[k]);
        mx = wave_max(mx);
        float p[9], ps = 0.f;
#pragma unroll
        for (int k = 0; k < 9; ++k) { p[k] = __builtin_amdgcn_exp2f(lg[k] - mx); ps += p[k]; }
        ps = wave_sum(ps);
        float acc = 0.f;
#pragma unroll
        for (int g = 0; g < 3; ++g) {
            const int dl = (g == 0) ? 1 : (g == 1) ? 4 : 16;
            const bf16* vbase = X.LV + (size_t)b * SEQ * 768 + g * 256 + h * 64 + lane;
#pragma unroll
            for (int rnd = 0; rnd < 3; ++rnd) {
                const int nk = (rnd < 2) ? 64 : 1;
                const float pr = p[g * 3 + rnd];
#pragma unroll 4
                for (int k = 0; k < nk; ++k) {
                    const int kpos = s - (rnd * 64 + k) * dl;
                    if (kpos < 0) break;
                    const float pk = __uint_as_float(__builtin_amdgcn_readlane(__float_as_uint(pr), k));
                    const float v = __builtin_bit_cast(float, (unsigned)vbase[(size_t)kpos * 768] << 16);
                    acc += pk * v;
                }
            }
        }
        X.yb[(size_t)mrow * 256 + h * 64 + lane] = (bf16)f2bf(acc / ps);
    }
}
}
__device__ __forceinline__ void p0_transpose_item(const float* W, int K, int N, bf16* WT, LAS float* scr, int item, int lane) {
    const int nblk = N / 32, kb = item / nblk, nb = item % nblk, k0 = 64 * kb, n0 = 32 * nb;
#pragma unroll 8
    for (int i = 0; i < 32; ++i) { const int kk = 2 * i + (lane >> 5); scr[kk * 33 + (lane & 31)] = W[(size_t)(k0 + kk) * N + n0 + (lane & 31)]; }
    LDS_WAIT(); asm volatile("" ::: "memory");
    const int c = lane & 7;
#pragma unroll
    for (int j = 0; j < 4; ++j) { const int n = (lane >> 3) + 8 * j; const LAS float* s = scr + (8 * c) * 33 + n;
        v4u o; o.x = pk2(s[0 * 33], s[1 * 33]); o.y = pk2(s[2 * 33], s[3 * 33]); o.z = pk2(s[4 * 33], s[5 * 33]); o.w = pk2(s[6 * 33], s[7 * 33]);
        *(v4u*)(WT + (size_t)(n0 + n) * K + k0 + 8 * c) = o; }
    LDS_WAIT(); asm volatile("" ::: "memory");
}
__device__ __forceinline__ void cast_bf16(const float* src, bf16* dst, size_t n8, size_t gtid, size_t gthreads) {
    for (size_t i = gtid; i < n8; i += gthreads) { const f32x4 a = *(const f32x4*)(src + i * 8), b = *(const f32x4*)(src + i * 8 + 4);
        v4u o; o.x = pk2(a[0], a[1]); o.y = pk2(a[2], a[3]); o.z = pk2(b[0], b[1]); o.w = pk2(b[2], b[3]); *(v4u*)(dst + i * 8) = o; }
}

struct Args { const float* in[16]; float* out; unsigned char* ws; int ph_lo, ph_hi; };
enum { I_X = 0, I_WIN, I_DLAM, I_SUBG, I_WBD, I_WBL, I_WO, I_LN1G, I_LN1B, I_PWQ, I_PKEYS, I_PU, I_PV, I_LN2G, I_LN2B, I_RELB };

__device__ __forceinline__ void p0_prologue(const Args& A, LAS unsigned char* lds, int vcu, int G, int wave, int lane) {
    unsigned char* ws = A.ws;
    const int gw = vcu * NWAVES + wave, NGW = G * NWAVES;
    const size_t gtid = (size_t)gw * 64 + lane, gthreads = (size_t)NGW * 64;
    LAS float* scr = (LAS float*)(lds + wave * 16384);
    constexpr int I_IN = (D / 64) * (INC / 32), I_BD = (512 / 64) * (D / 32), I_BL = (256 / 64) * (D / 32), I_O = (D / 64) * (D / 32);
    for (int it = gw; it < I_IN + I_BD + I_BL + I_O; it += NGW) {
        int r = it;
        if (r < I_IN) { p0_transpose_item(A.in[I_WIN], D, INC, (bf16*)(ws + WS_WIN), scr, r, lane); continue; } r -= I_IN;
        if (r < I_BD) { p0_transpose_item(A.in[I_WBD], 512, D, (bf16*)(ws + WS_WBD), scr, r, lane); continue; } r -= I_BD;
        if (r < I_BL) { p0_transpose_item(A.in[I_WBL], 256, D, (bf16*)(ws + WS_WBL), scr, r, lane); continue; } r -= I_BL;
        p0_transpose_item(A.in[I_WO], D, D, (bf16*)(ws + WS_WO), scr, r, lane);
    }
    cast_bf16(A.in[I_X], (bf16*)(ws + WS_A), (size_t)T * D / 8, gtid, gthreads);
    { const float* wq = A.in[I_PWQ]; const float* keys = A.in[I_PKEYS]; bf16* wp = (bf16*)(ws + WS_WP);
      for (int it = gw; it < 2048 * 16; it += NGW) {
          const int row = it >> 4, jb = it & 15, hc = row >> 7, j = jb * 64 + lane;
          const float* wr_ = wq + (size_t)j * 2048 + hc * 128; const float* kr = keys + (size_t)row * 128;
          float a0 = 0.f, a1 = 0.f, a2 = 0.f, a3 = 0.f;
#pragma unroll 8
          for (int d = 0; d < 128; d += 4) { const f32x4 w = *(const f32x4*)(wr_ + d), k = *(const f32x4*)(kr + d); a0 += w[0] * k[0]; a1 += w[1] * k[1]; a2 += w[2] * k[2]; a3 += w[3] * k[3]; }
          wp[(size_t)row * 1024 + j] = (bf16)f2bf((a0 + a1) + (a2 + a3));
      } }
    { const float* relb = A.in[I_RELB]; float* bd = (float*)(ws + WS_BIASD); float* bl = (float*)(ws + WS_BIASL);
      for (size_t i = gtid; i < 4 * BIAS_TAB; i += gthreads) { const int h = (int)(i / BIAS_TAB), dist = (int)(i % BIAS_TAB) - BIAS_GUARD; bd[i] = dist < 0 ? 0.f : relb[rel_bucket(dist) * 16 + h] * LOG2E; }
      for (size_t i = gtid; i < 12 * 132; i += gthreads) { const int gh = (int)(i / 132), j = (int)(i % 132), g = gh >> 2; const int dl = (g == 0) ? 1 : (g == 1) ? 4 : 16;
          bl[i] = relb[rel_bucket((j > 128 ? 128 : j) * dl) * 16 + 4 + gh] * LOG2E; } }
}

__device__ __forceinline__ void p5_ln1(const Args& A, int vcu, int G, int wave, int lane) {
    unsigned char* ws = A.ws;
    const int gw = vcu * NWAVES + wave, NGW = G * NWAVES;
    const float* R = (const float*)(ws + WS_R); bf16* x1b = (bf16*)(ws + WS_A);
    const float* gam = A.in[I_LN1G]; const float* bet = A.in[I_LN1B];
    f32x4 gv[4], bv[4];
#pragma unroll
    for (int j = 0; j < 4; ++j) { gv[j] = *(const f32x4*)(gam + 256 * j + 4 * lane); bv[j] = *(const f32x4*)(bet + 256 * j + 4 * lane); }
    for (int mrow = gw; mrow < T; mrow += NGW) {
        const f32x4* xr = (const f32x4*)(R + (size_t)mrow * D) + lane;
        f32x4 v[4]; float s = 0.f;
#pragma unroll
        for (int j = 0; j < 4; ++j) { v[j] = xr[64 * j]; s += (v[j][0] + v[j][1]) + (v[j][2] + v[j][3]); }
        const float mean = wave_sum(s) * (1.f / D); float s2 = 0.f;
#pragma unroll
        for (int j = 0; j < 4; ++j) { v[j] = v[j] - mean; s2 += (v[j][0] * v[j][0] + v[j][1] * v[j][1]) + (v[j][2] * v[j][2] + v[j][3] * v[j][3]); }
        const float rstd = __builtin_amdgcn_rsqf(wave_sum(s2) * (1.f / D) + LN_EPS);
        f32x4* orow = (f32x4*)(A.out + (size_t)mrow * D) + lane; v2u* brow = (v2u*)(x1b + (size_t)mrow * D) + lane;
#pragma unroll
        for (int j = 0; j < 4; ++j) { const f32x4 y = v[j] * rstd * gv[j] + bv[j]; orow[64 * j] = y; v2u w; w.x = pk2(y[0], y[1]); w.y = pk2(y[2], y[3]); brow[64 * j] = w; }
    }
    const size_t gtid = (size_t)gw * 64 + lane, gthreads = (size_t)NGW * 64;
    cast_bf16(A.in[I_PU], (bf16*)(ws + WS_UU), (size_t)NEXP * D / 8, gtid, gthreads);
    cast_bf16(A.in[I_PV], (bf16*)(ws + WS_UV), (size_t)NEXP * D / 8, gtid, gthreads);
}
namespace peer {
__device__ __forceinline__ int mono(float v) { const int b = __float_as_int(v); return b ^ ((b >> 31) & 0x7fffffff); }
__device__ __forceinline__ float unmono(int k) { return __int_as_float(k ^ ((k >> 31) & 0x7fffffff)); }
__device__ __forceinline__ int med3i(int a, int b, int c) { int r; asm("v_med3_i32 %0, %1, %2, %3" : "=v"(r) : "v"(a), "v"(b), "v"(c)); return r; }
#define PEER_INS16(a, x) do { _Pragma("unroll") for (int k_ = 15; k_ >= 1; --k_) a[k_] = med3i(a[k_ - 1], a[k_], (x)); a[0] = max(a[0], (x)); } while (0)
__device__ __forceinline__ unsigned byte_sel(const unsigned (&p)[4], int i) { const int w = i >> 2; const unsigned x = (w == 0) ? p[0] : (w == 1) ? p[1] : (w == 2) ? p[2] : p[3]; return (x >> ((i & 3) * 8)) & 0xffu; }
__device__ __forceinline__ float gelu_erf(float v) { return 0.5f * v * (1.f + erff(v * 0.7071067811865476f)); }

__device__ __forceinline__ void select(const float* ST, v2u* sel, int tok, int head) {
    int a0[16], a1[16];
#pragma unroll
    for (int k = 0; k < 16; ++k) { a0[k] = (int)0x80000000; a1[k] = (int)0x80000000; }
    const float* s0 = ST + (size_t)(head * 256) * T + tok; const float* s1 = s0 + (size_t)128 * T;
#pragma unroll 8
    for (int n = 0; n < 128; ++n) { const int k = (mono(s0[(size_t)n * T]) & ~127) | (127 - n); PEER_INS16(a0, k); }
#pragma unroll 8
    for (int n = 0; n < 128; ++n) { const int k = (mono(s1[(size_t)n * T]) & ~127) | (127 - n); PEER_INS16(a1, k); }
    float v0[16], v1[16]; unsigned i0p[4] = {0u, 0u, 0u, 0u}, i1p[4] = {0u, 0u, 0u, 0u};
#pragma unroll
    for (int k = 0; k < 16; ++k) { v0[k] = unmono((a0[k] & ~127) | 64); v1[k] = unmono((a1[k] & ~127) | 64);
        i0p[k >> 2] |= (unsigned)(127 - (a0[k] & 127)) << (8 * (k & 3)); i1p[k >> 2] |= (unsigned)(127 - (a1[k] & 127)) << (8 * (k & 3)); }
    int cd[16];
#pragma unroll
    for (int k = 0; k < 16; ++k) cd[k] = (int)0x80000000;
#pragma unroll
    for (int i = 0; i < 16; ++i)
#pragma unroll
        for (int j = 0; j < 16; ++j)
            if ((i + 1) * (j + 1) <= 16) { const int k = (mono(v0[i] + v1[j]) & ~255) | (255 - (i * 16 + j)); PEER_INS16(cd, k); }
    float sv[16], ex[16], sum = 0.f; unsigned eid[16];
#pragma unroll
    for (int k = 0; k < 16; ++k) { const int code = 255 - (cd[k] & 255); eid[k] = byte_sel(i0p, code >> 4) * 128u + byte_sel(i1p, code & 15); sv[k] = unmono((cd[k] & ~255) | 128); }
#pragma unroll
    for (int k = 0; k < 16; ++k) { ex[k] = __expf(sv[k] - sv[0]); sum += ex[k]; }
    const float rs = 1.f / sum;
    v4u* dst = (v4u*)(sel + ((size_t)tok * 8 + head) * 16);
#pragma unroll
    for (int k = 0; k < 8; ++k) { v4u w; w.x = eid[2 * k]; w.y = __float_as_uint(ex[2 * k] * rs); w.z = eid[2 * k + 1]; w.w = __float_as_uint(ex[2 * k + 1] * rs); dst[k] = w; }
}

__device__ __forceinline__ void gather_token(const v2u* sel, const bf16* U, const bf16* V, float* xo, const float* gam, const float* bet, int tok, int lane) {
    float* xrow = xo + (size_t)tok * D + 8 * lane;
    f32x4 xv[4];
    xv[0] = *(const f32x4*)(xrow); xv[1] = *(const f32x4*)(xrow + 4); xv[2] = *(const f32x4*)(xrow + 512); xv[3] = *(const f32x4*)(xrow + 516);
    unsigned xp[8];
#pragma unroll
    for (int q = 0; q < 4; ++q) { xp[2 * q] = pk2(xv[q][0], xv[q][1]); xp[2 * q + 1] = pk2(xv[q][2], xv[q][3]); }
    float acc[16];
#pragma unroll
    for (int k = 0; k < 16; ++k) acc[k] = 0.f;
    for (int head = 0; head < 8; ++head) {
        const v2u se = sel[((size_t)tok * 8 + head) * 16 + (lane & 15)];
        float part[16];
#pragma unroll
        for (int hb = 0; hb < 2; ++hb) {
            v4u uu[8][2];
#pragma unroll
            for (int k = 0; k < 8; ++k) { const unsigned e = __builtin_amdgcn_readlane(se.x, hb * 8 + k); const v4u* up = (const v4u*)(U + (size_t)e * D + 8 * lane); uu[k][0] = up[0]; uu[k][1] = up[64]; }
#pragma unroll
            for (int k = 0; k < 8; ++k) { float d0 = 0.f, d1 = 0.f;
                d0 = dot2bf(uu[k][0].x, xp[0], d0); d1 = dot2bf(uu[k][0].y, xp[1], d1); d0 = dot2bf(uu[k][0].z, xp[2], d0); d1 = dot2bf(uu[k][0].w, xp[3], d1);
                d0 = dot2bf(uu[k][1].x, xp[4], d0); d1 = dot2bf(uu[k][1].y, xp[5], d1); d0 = dot2bf(uu[k][1].z, xp[6], d0); d1 = dot2bf(uu[k][1].w, xp[7], d1);
                part[hb * 8 + k] = d0 + d1; }
        }
        float r8[8], r4[4], r2[2], r1;
#pragma unroll
        for (int i = 0; i < 8; ++i) { const bool up = (lane & 32) != 0; const float send = up ? part[i] : part[i + 8], keep = up ? part[i + 8] : part[i]; r8[i] = keep + __shfl_xor(send, 32); }
#pragma unroll
        for (int i = 0; i < 4; ++i) { const bool up = (lane & 16) != 0; const float send = up ? r8[i] : r8[i + 4], keep = up ? r8[i + 4] : r8[i]; r4[i] = keep + __shfl_xor(send, 16); }
#pragma unroll
        for (int i = 0; i < 2; ++i) { const bool up = (lane & 8) != 0; const float send = up ? r4[i] : r4[i + 2], keep = up ? r4[i + 2] : r4[i]; r2[i] = keep + __shfl_xor(send, 8); }
        { const bool up = (lane & 4) != 0; const float send = up ? r2[0] : r2[1], keep = up ? r2[1] : r2[0]; r1 = keep + __shfl_xor(send, 4); }
        r1 += __shfl_xor(r1, 2); r1 += __shfl_xor(r1, 1);
        const float gq = __uint_as_float((unsigned)__shfl((int)se.y, lane >> 2));
        const float wgt = gq * gelu_erf(r1);
#pragma unroll
        for (int hb = 0; hb < 2; ++hb) {
            v4u vv[8][2];
#pragma unroll
            for (int k = 0; k < 8; ++k) { const unsigned e = __builtin_amdgcn_readlane(se.x, hb * 8 + k); const v4u* vp = (const v4u*)(V + (size_t)e * D + 8 * lane); vv[k][0] = vp[0]; vv[k][1] = vp[64]; }
#pragma unroll
            for (int k = 0; k < 8; ++k) { const float w = __uint_as_float(__builtin_amdgcn_readlane(__float_as_uint(wgt), 4 * (hb * 8 + k)));
#pragma unroll
                for (int i2 = 0; i2 < 2; ++i2) { const v4u x = vv[k][i2];
                    acc[8 * i2 + 0] += w * bf_lo(x.x); acc[8 * i2 + 1] += w * bf_hi(x.x); acc[8 * i2 + 2] += w * bf_lo(x.y); acc[8 * i2 + 3] += w * bf_hi(x.y);
                    acc[8 * i2 + 4] += w * bf_lo(x.z); acc[8 * i2 + 5] += w * bf_hi(x.z); acc[8 * i2 + 6] += w * bf_lo(x.w); acc[8 * i2 + 7] += w * bf_hi(x.w); } }
        }
    }
    float rr[16], s = 0.f;
#pragma unroll
    for (int k = 0; k < 16; ++k) { rr[k] = ALPHA * xv[k >> 2][k & 3] + acc[k]; s += rr[k]; }
    const float mean = wave_sum(s) * (1.f / D); float s2 = 0.f;
#pragma unroll
    for (int k = 0; k < 16; ++k) { rr[k] -= mean; s2 += rr[k] * rr[k]; }
    const float rstd = __builtin_amdgcn_rsqf(wave_sum(s2) * (1.f / D) + LN_EPS);
#pragma unroll
    for (int q = 0; q < 4; ++q) { const int off = (q >> 1) * 512 + (q & 1) * 4; const f32x4 g = *(const f32x4*)(gam + 8 * lane + off), bb = *(const f32x4*)(bet + 8 * lane + off);
        f32x4 y; y[0] = rr[4 * q] * rstd * g[0] + bb[0]; y[1] = rr[4 * q + 1] * rstd * g[1] + bb[1]; y[2] = rr[4 * q + 2] * rstd * g[2] + bb[2]; y[3] = rr[4 * q + 3] * rstd * g[3] + bb[3];
        *(f32x4*)(xrow + off) = y; }
}
}
constexpr int NPH = 8;
__global__ void __launch_bounds__(NWAVES * 64, 2) mk_fwd(Args args) {
    extern __shared__ __attribute__((aligned(16))) unsigned char lds_raw[];
    LAS unsigned char* lds = (LAS unsigned char*)lds_raw;
    volatile LAS unsigned* MISC = (volatile LAS unsigned*)(lds + MISC_OFF);
    const int tid = threadIdx.x, lane = tid & 63, wave = __builtin_amdgcn_readfirstlane(tid >> 6);
    const int G = gridDim.x, bx = blockIdx.x, vcu = (G % 8 == 0) ? (bx % 8) * (G / 8) + bx / 8 : bx;
    unsigned char* ws = args.ws;
    gu32* ctl = (gu32*)(ws + WS_CTL);
    for (int u = tid; u < (LDS_BYTES - RING_BYTES) / 4; u += NWAVES * 64) ((LAS unsigned*)(lds + RING_BYTES))[u] = 0u;
    __syncthreads();
    XcdBarrier bar; bar.bar = (unsigned*)(ctl + CW_BAR); bar.x = 0; bar.st = nullptr;
    if (MK_N_LAUNCHES == 1) bar = xcd_barrier_post((unsigned*)(ctl + CW_BAR), MISC + 8);
    const int lo = args.ph_lo, hi = args.ph_hi;
#ifndef PH_MASK
#define PH_MASK 0xFF
#endif
#define IN(k) ((((PH_MASK) >> (k)) & 1) && lo <= (k) && (k) < hi)
#define SEAM(k) do { if (IN(k) && IN((k) + 1)) xcd_barrier(bar); } while (0)
    const int gw = vcu * NWAVES + wave, NGW = G * NWAVES;

    if (IN(0)) { p0_prologue(args, lds, vcu, G, wave, lane); VM_WAIT(); __syncthreads(); SEAM(0); }

    if (IN(1)) {
        pg8::Gemm g{(const pg8::bf16_t*)(ws + WS_A), (const pg8::bf16_t*)(ws + WS_WIN), T, INC, D}; pg8::StaticOrder S; S.init(T, INC, G, bx);
        pg8::EpiInProj E{(pg8::bf16_t*)(ws + WS_QD), (pg8::bf16_t*)(ws + WS_KD), (pg8::bf16_t*)(ws + WS_VD), (pg8::bf16_t*)(ws + WS_LQ), (pg8::bf16_t*)(ws + WS_LK), (pg8::bf16_t*)(ws + WS_LV),
                         (pg8::bf16_t*)(ws + WS_GA), (pg8::bf16_t*)(ws + WS_GB)};
        pg8::gemm_phase<pg8::EpiInProj, pg8::StaticOrder, true, true>(lds, g, S, E);
        SEAM(1);
    }

    if (IN(2)) {
#ifndef NO_DIFF
        {
            const da::Tensors X{(const bf16*)(ws + WS_QD), (const bf16*)(ws + WS_KD), (const bf16*)(ws + WS_VD), (float*)(ws + WS_STASH), (bf16*)(ws + WS_YA),
                                args.in[I_DLAM], args.in[I_SUBG], args.in[I_RELB]};
            int cur_h = -1;
            float lam; { const float* dl = args.in[I_DLAM]; const float p1 = dl[lane] * dl[64 + lane], p2 = dl[128 + lane] * dl[192 + lane];
                lam = __uint_as_float(__builtin_amdgcn_readfirstlane(__float_as_uint(__expf(wave_sum(p1)) - __expf(wave_sum(p2)) + LAM_INIT))); }
            for (int p = vcu; p < 256; p += G) {
                const int bh = p >> 5, s = p & 31, b = bh >> 2, h = bh & 3;
                if (h != cur_h) {
                    __syncthreads();
                    const float* bd = (const float*)(ws + WS_BIASD) + h * BIAS_TAB;
                    for (int i = tid; i < BIAS_TAB; i += NWAVES * 64) ((LAS float*)(lds + da::LDS_BIAS))[i] = bd[i];
                    __syncthreads(); cur_h = h;
                }
                const float c31 = args.in[I_RELB][31 * 16 + h] * LOG2E;
                for (int k2 = 0; k2 < 2; ++k2) da::unit(X, b, h, k2 ? 63 - s : s, lds, bx, lam, c31);
            }
        }
#endif
#ifndef NO_DIL
        {
            const dil::Tensors X{(const bf16*)(ws + WS_LQ), (const bf16*)(ws + WS_LK), (const bf16*)(ws + WS_LV), (const float*)(ws + WS_BIASL), (bf16*)(ws + WS_YB)};
            for (int t = gw; t < (T / 64) * 4; t += NGW) dil::task(X, t >> 2, t & 3, lane);
        }
#endif
        SEAM(2);
    }

    if (IN(3)) {
        { pg8::Gemm g{(const pg8::bf16_t*)(ws + WS_YA), (const pg8::bf16_t*)(ws + WS_WBD), T, D, 512}; pg8::StaticOrder S; S.init(T, D, G, bx);
          pg8::EpiGate1 E{(const pg8::bf16_t*)(ws + WS_GA), (pg8::bf16_t*)(ws + WS_GATED)};
          pg8::gemm_phase<pg8::EpiGate1, pg8::StaticOrder, true, true>(lds, g, S, E); }
        VM_WAIT(); __syncthreads();
        { pg8::Gemm g{(const pg8::bf16_t*)(ws + WS_YB), (const pg8::bf16_t*)(ws + WS_WBL), T, D, 256}; pg8::StaticOrder S; S.init(T, D, G, bx);
          pg8::EpiGate2 E{(const pg8::bf16_t*)(ws + WS_GB), (pg8::bf16_t*)(ws + WS_GATED)};
          pg8::gemm_phase<pg8::EpiGate2, pg8::StaticOrder, true, true>(lds, g, S, E); }
        SEAM(3);
    }

    if (IN(4)) {
        pg8::Gemm g{(const pg8::bf16_t*)(ws + WS_GATED), (const pg8::bf16_t*)(ws + WS_WO), T, D, D}; pg8::StaticOrder S; S.init(T, D, G, bx);
        pg8::EpiOut E{args.in[I_X], (float*)(ws + WS_R)};
        pg8::gemm_phase<pg8::EpiOut, pg8::StaticOrder, true, true>(lds, g, S, E);
        SEAM(4);
    }

    if (IN(5)) { p5_ln1(args, vcu, G, wave, lane); SEAM(5); }

    if (IN(6)) {
        pg8::Gemm g{(const pg8::bf16_t*)(ws + WS_WP), (const pg8::bf16_t*)(ws + WS_A), 2048, T, D}; pg8::StaticOrder S; S.init(2048, T, G, bx);
        pg8::EpiScoreT E{(float*)(ws + WS_ST)};
        pg8::gemm_phase<pg8::EpiScoreT, pg8::StaticOrder, true, true>(lds, g, S, E);
        SEAM(6);
    }

    if (IN(7)) {
        const float* ST = (const float*)(ws + WS_ST); v2u* sel = (v2u*)(ws + WS_SEL);
        for (int u = vcu; u < T / 128; u += G) {
            for (int p = 0; p < 2; ++p) peer::select(ST, sel, u * 128 + p * 64 + lane, wave);
            VM_WAIT(); __syncthreads();
            for (int i = 0; i < 16; ++i) peer::gather_token(sel, (const bf16*)(ws + WS_UU), (const bf16*)(ws + WS_UV), args.out, args.in[I_LN2G], args.in[I_LN2B], u * 128 + wave * 16 + i, lane);
            VM_WAIT(); __syncthreads();
        }
    }
#undef IN
#undef SEAM
}

extern "C" void kernel_launch(void* const* d_in, const int* in_sizes, int n_in, void* d_out, int out_size, void* d_ws, size_t ws_size, hipStream_t stream) {
    static int grid = 0;
    if (grid == 0) {
        if (n_in != 16 || in_sizes[0] != T * D || out_size != T * D || ws_size < WS_END) { fprintf(stderr, "kernel_launch: unexpected shapes (n_in %d, in0 %d, out %d, ws %zu); nothing launched\n", n_in, n_in > 0 ? in_sizes[0] : -1, out_size, ws_size); grid = -1; return; }
        int dev = 0, cus = 0, per_cu = 0;
        if (hipGetDevice(&dev) != hipSuccess || hipDeviceGetAttribute(&cus, hipDeviceAttributeMultiprocessorCount, dev) != hipSuccess) { grid = -1; return; }
        if (hipFuncSetAttribute((const void*)mk_fwd, hipFuncAttributeMaxDynamicSharedMemorySize, LDS_BYTES) != hipSuccess) { fprintf(stderr, "kernel_launch: hipFuncSetAttribute failed\n"); grid = -1; return; }
        if (hipOccupancyMaxActiveBlocksPerMultiprocessor(&per_cu, (const void*)mk_fwd, NWAVES * 64, LDS_BYTES) != hipSuccess || per_cu < 1) { fprintf(stderr, "kernel_launch: occupancy query reports %d\n", per_cu); per_cu = 1; }
        (void)hipGetLastError();
        grid = cus;
    }
    if (grid < 0) return;
    if (hipMemsetAsync((char*)d_ws + WS_CTL, 0, CTL_ZERO_BYTES, stream) != hipSuccess) return;
    Args a{};
    for (int i = 0; i < 16; ++i) a.in[i] = (const float*)d_in[i];
    a.out = (float*)d_out; a.ws = (unsigned char*)d_ws;
    for (int li = 0; li < MK_N_LAUNCHES; ++li) {
        a.ph_lo = (MK_N_LAUNCHES == 1) ? 0 : li; a.ph_hi = (MK_N_LAUNCHES == 1) ? NPH : li + 1;
        hipLaunchKernelGGL(mk_fwd, dim3(grid), dim3(NWAVES * 64), LDS_BYTES, stream, a);
    }
}
```

```cpp
#include <hip/hip_runtime.h>
#include <cstdio>
#include <cstdint>

#ifndef MK_N_LAUNCHES
#define MK_N_LAUNCHES 1
#endif

constexpr int BATCH = 2, SEQ = 16384, T = BATCH * SEQ, D = 1024, INC = 5888;
constexpr int OFF_DQ = 0, OFF_DK = 512, OFF_DV = 1024, OFF_LQ = 1536, OFF_LK = 2304, OFF_LV = 3072, OFF_GA = 3840, OFF_GB = 4864;
constexpr int NEXP = 16384;
constexpr float LOG2E = 1.4426950408889634f;
constexpr float QSCALE = 0.125f * LOG2E;
constexpr float ALPHA = 1.189207115002721f;
constexpr float LN_EPS = 1e-5f, SUBLN_EPS = 1e-5f;
constexpr float LAM_INIT = 0.2f;
constexpr int NTILE = SEQ / 64;
constexpr int BIAS_TAB = 2112, BIAS_GUARD = 256, DFAR = 1513;

constexpr size_t MiB = 1u << 20;
constexpr size_t WS_CTL = 0, CTL_ZERO_BYTES = 1 * MiB;
constexpr size_t WS_BIASD = 1 * MiB;
constexpr size_t WS_BIASL = 1 * MiB + 64 * 1024;
constexpr size_t WS_WIN = 8 * MiB, WS_WO = 20 * MiB, WS_WBD = 22 * MiB, WS_WBL = 23 * MiB, WS_WP = 24 * MiB;
constexpr size_t WS_A = 32 * MiB;
constexpr size_t WS_YA = WS_A, WS_YB = WS_A + 32 * MiB;
constexpr size_t WS_QD = 96 * MiB, WS_KD = 128 * MiB, WS_VD = 160 * MiB, WS_LQ = 192 * MiB, WS_LK = 240 * MiB, WS_LV = 288 * MiB, WS_GA = 336 * MiB, WS_GB = 400 * MiB;
constexpr size_t WS_STASH = 464 * MiB;
constexpr size_t WS_SEL = 464 * MiB;
constexpr size_t WS_GATED = 96 * MiB;
constexpr size_t WS_R = 160 * MiB;
constexpr size_t WS_ST = 96 * MiB;
constexpr size_t WS_UU = 352 * MiB, WS_UV = 384 * MiB;
constexpr size_t WS_END = 512 * MiB;

constexpr int CW_BAR = 4096;
constexpr int NWAVES = 8;
constexpr int RING_BYTES = 131072, MISC_OFF = RING_BYTES + 320, LDS_BYTES = 147456;

#define GAS __attribute__((address_space(1)))
#define LAS __attribute__((address_space(3)))
typedef unsigned short bf16;
typedef unsigned v4u __attribute__((ext_vector_type(4)));
typedef unsigned v2u __attribute__((ext_vector_type(2)));
typedef float f32x4 __attribute__((ext_vector_type(4)));
typedef float f32x16 __attribute__((ext_vector_type(16)));
typedef short bf16x8 __attribute__((ext_vector_type(8)));
typedef short s16x4 __attribute__((ext_vector_type(4)));
typedef __bf16 bf16x2 __attribute__((ext_vector_type(2)));
typedef GAS unsigned gu32;
#define RLX_AGENT __ATOMIC_RELAXED, __HIP_MEMORY_SCOPE_AGENT
#define LDS_WAIT() asm volatile("s_waitcnt lgkmcnt(0)" ::: "memory")
#define VM_WAIT() asm volatile("s_waitcnt vmcnt(0)" ::: "memory")
__device__ __forceinline__ unsigned f2bf(float f) { unsigned u = __builtin_bit_cast(unsigned, f); return (u + 0x7fffu + ((u >> 16) & 1u)) >> 16; }
__device__ __forceinline__ unsigned pk2(float lo, float hi) { return f2bf(lo) | (f2bf(hi) << 16); }
__device__ __forceinline__ float bf_lo(unsigned w) { return __builtin_bit_cast(float, w << 16); }
__device__ __forceinline__ float bf_hi(unsigned w) { return __builtin_bit_cast(float, w & 0xffff0000u); }
__device__ __forceinline__ float dot2bf(unsigned a, unsigned b, float acc) { return __builtin_amdgcn_fdot2_f32_bf16(__builtin_bit_cast(bf16x2, a), __builtin_bit_cast(bf16x2, b), acc, false); }
__device__ __forceinline__ float wave_sum(float v) {
#pragma unroll
    for (int o = 1; o < 64; o <<= 1) v += __shfl_xor(v, o);
    return v;
}
__device__ __forceinline__ float wave_max(float v) {
#pragma unroll
    for (int o = 1; o < 64; o <<= 1) v = fmaxf(v, __shfl_xor(v, o));
    return v;
}
__device__ __forceinline__ int rel_bucket(int n) {
    if (n < 16) return n < 0 ? 0 : n;
    return 16 + (n >= 22) + (n >= 30) + (n >= 40) + (n >= 54) + (n >= 73) + (n >= 99) + (n >= 134) + (n >= 182) + (n >= 246) + (n >= 332) + (n >= 450) + (n >= 609) + (n >= 825) + (n >= 1117) + (n >= 1513);
}
namespace pg8 {
#define PG8_LAS __attribute__((address_space(3)))
typedef unsigned short bf16_t;
typedef short bf16x8 __attribute__((ext_vector_type(8)));
typedef float f32x4 __attribute__((ext_vector_type(4)));
typedef unsigned u32x4 __attribute__((ext_vector_type(4)));
constexpr int BM = 256, BK = 64, HALF = 128, HTB = HALF * BK * 2  , STAGE_BYTES = 8 * HTB, NXCD = 8, WGM = 8;

__host__ __device__ __forceinline__ int lds_byte(int r, int c) { const int st = (r >> 4) * 2 + (c >> 5), rr = r & 15, cc = c & 31, ob = rr * 64 + cc * 2; return st * 1024 + (ob ^ (((ob >> 9) & 1) << 5)); }
__host__ __device__ __forceinline__ void stage_rc(int b, int& R, int& C) { const int st = b / 1024, sb = b % 1024, swz = sb ^ (((sb >> 9) & 1) << 5); R = (st >> 1) * 16 + swz / 64; C = (st & 1) * 32 + (swz % 64) / 2; }
__host__ __device__ __forceinline__ int perm32(int rho) { const int n = rho >> 4, i = rho & 15; return 8 * (i >> 2) + 4 * n + (i & 3); }

struct Unit { int pm, pn; };
struct Gemm { const bf16_t* A; const bf16_t* Bt; int M, N, K; };

struct StaticOrder {
    int nM, nN, nwg, G, c;
    __host__ __device__ void init(int M, int N, int G_, int c_) { nM = M / BM; nN = N / BM; nwg = nM * nN; G = G_; c = c_; }
    __host__ __device__ bool next(int i, Unit& u) const {
        const long L = (long)i * G + c; if (L >= nwg) return false;
        int wgid = (int)L; { const int q = nwg / NXCD, r = nwg % NXCD, xcd = wgid % NXCD, off = wgid / NXCD; wgid = (xcd < r ? xcd * (q + 1) : r * (q + 1) + (xcd - r) * q) + off; }
        const int nig = WGM * nN, gid = wgid / nig, fm = gid * WGM, gsz = (nM - fm) < WGM ? (nM - fm) : WGM;
        u.pm = fm + ((wgid % nig) % gsz); u.pn = (wgid % nig) / gsz; return true;
    }
    __device__ __forceinline__ void a_ready(const Unit&) const {}
    __device__ __forceinline__ void done(const Unit&) const {}
};
__device__ __forceinline__ unsigned cvt_pk_bf16(float lo, float hi) { unsigned r; asm volatile("v_cvt_pk_bf16_f32 %0, %1, %2" : "=v"(r) : "v"(lo), "v"(hi)); return r; }
__device__ __forceinline__ u32x4 pack8(const f32x4 v0, const f32x4 v1) { u32x4 w; w.x = cvt_pk_bf16(v0[0], v0[1]); w.y = cvt_pk_bf16(v0[2], v0[3]); w.z = cvt_pk_bf16(v1[0], v1[1]); w.w = cvt_pk_bf16(v1[2], v1[3]); return w; }
__device__ __forceinline__ float blo(unsigned w) { return __builtin_bit_cast(float, w << 16); }
__device__ __forceinline__ float bhi(unsigned w) { return __builtin_bit_cast(float, w & 0xffff0000u); }
__device__ __forceinline__ float sigm(float v) { return __builtin_amdgcn_rcpf(1.f + __expf(-v)); }
template <class E> __device__ __forceinline__ void epi_loop(const E& e, const f32x4 (&acc)[2][2][4][2], const Unit& u, int wr, int wc, int fr, int fq) {
#pragma unroll
    for (int ai = 0; ai < 2; ++ai)
#pragma unroll
        for (int m = 0; m < 4; ++m) { const int row = u.pm * BM + ai * HALF + wr * 64 + m * 16 + fr;
#pragma unroll
            for (int bj = 0; bj < 2; ++bj) { const int col = u.pn * BM + bj * HALF + wc * 32 + 8 * fq; e.item(u.pn, row, col, acc[ai][bj][m][0], acc[ai][bj][m][1]); } }
}

struct EpiInProj {
    static constexpr bool PERM = true, AFTER_DRAIN = false;
    bf16_t *Qd, *Kd, *Vd, *LQ, *LK, *LV, *GA, *GB;
    __device__ __forceinline__ void operator()(const f32x4 (&acc)[2][2][4][2], const Unit& u, int wr, int wc, int fr, int fq) const { epi_loop(*this, acc, u, wr, wc, fr, fq); }
    __device__ __forceinline__ void item(int pn, int row, int col, f32x4 v0, f32x4 v1) const {
            const int b = row >> 14, s = row & 16383; bf16_t* dst;
            if (pn < 2) {
                const int h = col >> 7, c = (col >> 6) & 1, d = col & 63; v0 = v0 * 0.18033688011112042f; v1 = v1 * 0.18033688011112042f;
                dst = Qd + ((size_t)((b * 4 + h) * 2 + c) * 16384 + s) * 64 + d;
            } else if (pn < 4) {
                const int cc = col - 512, h = cc >> 7, c = (cc >> 6) & 1, d = cc & 63;
                dst = Kd + ((((size_t)((b * 4 + h) * 2 + c) * 256 + (s >> 6)) * 8 + (d >> 3)) * 64 + (s & 63)) * 8;
            } else if (pn < 6) {
                const int cc = col - 1024, h = cc >> 7, d = cc & 127;
                dst = Vd + ((size_t)(b * 4 + h) * 256 + (s >> 6)) * 8192 + ((d >> 5) * 4 + ((s & 63) >> 4)) * 512 + (s & 15) * 32 + (d & 31);
            } else if (pn < 9) {
                v0 = v0 * 0.18033688011112042f; v1 = v1 * 0.18033688011112042f; dst = LQ + (size_t)row * 768 + (col - 1536);
            } else if (pn < 12) { dst = LK + (size_t)row * 768 + (col - 2304);
            } else if (pn < 15) { dst = LV + (size_t)row * 768 + (col - 3072);
            } else {
#pragma unroll
                for (int i = 0; i < 4; ++i) { v0[i] = sigm(v0[i]); v1[i] = sigm(v1[i]); }
                dst = (pn < 19) ? GA + (size_t)row * 1024 + (col - 3840) : GB + (size_t)row * 1024 + (col - 4864);
            }
            *(u32x4*)dst = pack8(v0, v1);
        }
};
struct EpiGate1 {
    static constexpr bool PERM = true, AFTER_DRAIN = false;
    const bf16_t* GA; bf16_t* G;
    __device__ __forceinline__ void operator()(const f32x4 (&acc)[2][2][4][2], const Unit& u, int wr, int wc, int fr, int fq) const { epi_loop(*this, acc, u, wr, wc, fr, fq); }
    __device__ __forceinline__ void item(int pn, int row, int col, f32x4 v0, f32x4 v1) const {
            const size_t o = (size_t)row * 1024 + col; const u32x4 g = *(const u32x4*)(GA + o);
            v0[0] *= blo(g.x); v0[1] *= bhi(g.x); v0[2] *= blo(g.y); v0[3] *= bhi(g.y); v1[0] *= blo(g.z); v1[1] *= bhi(g.z); v1[2] *= blo(g.w); v1[3] *= bhi(g.w);
            *(u32x4*)(G + o) = pack8(v0, v1);
        }
};
struct EpiGate2 {
    static constexpr bool PERM = true, AFTER_DRAIN = false;
    const bf16_t* GB; bf16_t* G;
    __device__ __forceinline__ void operator()(const f32x4 (&acc)[2][2][4][2], const Unit& u, int wr, int wc, int fr, int fq) const { epi_loop(*this, acc, u, wr, wc, fr, fq); }
    __device__ __forceinline__ void item(int pn, int row, int col, f32x4 v0, f32x4 v1) const {
            const size_t o = (size_t)row * 1024 + col; const u32x4 g = *(const u32x4*)(GB + o); const u32x4 p = *(const u32x4*)(G + o);
            v0[0] = v0[0] * blo(g.x) + blo(p.x); v0[1] = v0[1] * bhi(g.x) + bhi(p.x); v0[2] = v0[2] * blo(g.y) + blo(p.y); v0[3] = v0[3] * bhi(g.y) + bhi(p.y);
            v1[0] = v1[0] * blo(g.z) + blo(p.z); v1[1] = v1[1] * bhi(g.z) + bhi(p.z); v1[2] = v1[2] * blo(g.w) + blo(p.w); v1[3] = v1[3] * bhi(g.w) + bhi(p.w);
            *(u32x4*)(G + o) = pack8(v0, v1);
        }
};
struct EpiOut {
    static constexpr bool PERM = true, AFTER_DRAIN = false;
    const float* X; float* R;
    __device__ __forceinline__ void operator()(const f32x4 (&acc)[2][2][4][2], const Unit& u, int wr, int wc, int fr, int fq) const { epi_loop(*this, acc, u, wr, wc, fr, fq); }
    __device__ __forceinline__ void item(int pn, int row, int col, f32x4 v0, f32x4 v1) const {
            const size_t o = (size_t)row * 1024 + col; const f32x4 x0 = *(const f32x4*)(X + o), x1 = *(const f32x4*)(X + o + 4);
            *(f32x4*)(R + o) = x0 * 1.189207115002721f + v0; *(f32x4*)(R + o + 4) = x1 * 1.189207115002721f + v1;
        }
};
struct EpiScoreT {
    static constexpr bool PERM = true, AFTER_DRAIN = false;
    float* ST;
    __device__ __forceinline__ void operator()(const f32x4 (&acc)[2][2][4][2], const Unit& u, int wr, int wc, int fr, int fq) const { epi_loop(*this, acc, u, wr, wc, fr, fq); }
    __device__ __forceinline__ void item(int pn, int row, int col, f32x4 v0, f32x4 v1) const { const size_t o = (size_t)row * 32768 + col; *(f32x4*)(ST + o) = v0; *(f32x4*)(ST + o + 4) = v1; }
};
template <class Epi, class Sched, bool ALIGN_EPI = false, bool SP2 = false>
__device__ __forceinline__ void gemm_phase(PG8_LAS unsigned char* lds, const Gemm g, const Sched& S, const Epi& E) {
    const int tid = threadIdx.x, wid = __builtin_amdgcn_readfirstlane(tid >> 6), lane = tid & 63, wr = wid >> 2, wc = wid & 3, fr = lane & 15, fq = lane >> 4;
    const int K = g.K, nt = K / BK;
    unsigned voffA[2], voffB[2];
#pragma unroll
    for (int i = 0; i < 2; ++i) { int R, C; stage_rc(tid * 16 + i * 8192, R, C); const int Rb = Epi::PERM ? ((R & ~31) + perm32(R & 31)) : R;
        voffA[i] = (unsigned)(R * K + C) * 2u; voffB[i] = (unsigned)(Rb * K + C) * 2u; }
    const size_t kstep = (size_t)(BK * 2);
    const size_t hstep = (size_t)HALF * K * 2;
    const size_t tstep = 2 * hstep;
    const unsigned ldsw = (unsigned)wid * 1024u;
    const int aoff = lds_byte(wr * 64 + fr, fq * 8), boff = lds_byte(wc * 32 + fr, fq * 8);
#define PG8_SA(b, h) (((b) * 2 + (h)) * HTB)
#define PG8_SB(b, h) ((4 + (b) * 2 + (h)) * HTB)
#define PG8_STAGE(bufoff, gbase, voff) do { _Pragma("unroll") for (int _i = 0; _i < 2; ++_i) \
        __builtin_amdgcn_global_load_lds((const unsigned*)((const char*)(gbase) + (voff)[_i]), (PG8_LAS unsigned*)(lds + (bufoff) + ldsw + _i * 8192), 16, 0, 0); } while (0)
#define PG8_LDA(dst, b, h) do { _Pragma("unroll") for (int m = 0; m < 4; ++m) _Pragma("unroll") for (int k = 0; k < 2; ++k) dst[m][k] = *(const PG8_LAS bf16x8*)(lds + PG8_SA(b, h) + aoff + m * 2048 + k * 1024); } while (0)
#define PG8_LDB(dst, b, h) do { _Pragma("unroll") for (int n = 0; n < 2; ++n) _Pragma("unroll") for (int k = 0; k < 2; ++k) dst[n][k] = *(const PG8_LAS bf16x8*)(lds + PG8_SB(b, h) + boff + n * 2048 + k * 1024); } while (0)
#define PG8_MMA(ai, bj, At, Bt) do { __builtin_amdgcn_s_setprio(1); _Pragma("unroll") for (int m = 0; m < 4; ++m) _Pragma("unroll") for (int n = 0; n < 2; ++n) _Pragma("unroll") for (int k = 0; k < 2; ++k) \
        acc[ai][bj][m][n] = __builtin_amdgcn_mfma_f32_16x16x32_bf16(Bt[n][k], At[m][k], acc[ai][bj][m][n], 0, 0, 0); __builtin_amdgcn_s_setprio(0); } while (0)
#define PG8_WAIT_V(n) asm volatile("s_waitcnt vmcnt(" #n ")" ::: "memory")
#define PG8_WAIT_L(n) asm volatile("s_waitcnt lgkmcnt(" #n ")" ::: "memory")
#define PG8_BAR __builtin_amdgcn_s_barrier()
#define PG8_SCHED __builtin_amdgcn_sched_barrier(0)
    Unit cur, nxt; int ui = 0;
    if (!S.next(0, cur)) return;
    f32x4 acc[2][2][4][2];
#pragma unroll
    for (int a = 0; a < 2; ++a)
#pragma unroll
        for (int b = 0; b < 2; ++b)
#pragma unroll
            for (int m = 0; m < 4; ++m)
#pragma unroll
                for (int n = 0; n < 2; ++n) acc[a][b][m][n] = (f32x4){0.f, 0.f, 0.f, 0.f};
    bf16x8 At[4][2], B0[2][2], B1[2][2];
    const char* cA = (const char*)g.A + (size_t)cur.pm * tstep; const char* cB = (const char*)g.Bt + (size_t)cur.pn * tstep;
    S.a_ready(cur);
    if constexpr (SP2) {
        PG8_STAGE(PG8_SB(0, 0), cB, voffB); PG8_STAGE(PG8_SB(0, 1), cB + hstep, voffB); PG8_STAGE(PG8_SA(0, 0), cA, voffA); PG8_STAGE(PG8_SA(0, 1), cA + hstep, voffA);
        if (wr == 1) PG8_BAR;
        PG8_WAIT_V(2); PG8_BAR;
        PG8_STAGE(PG8_SB(1, 0), cB + kstep, voffB); PG8_STAGE(PG8_SA(1, 0), cA + kstep, voffA); PG8_STAGE(PG8_SB(1, 1), cB + hstep + kstep, voffB);
        PG8_WAIT_V(6); PG8_BAR;
    } else {
        PG8_STAGE(PG8_SB(0, 0), cB, voffB); PG8_STAGE(PG8_SA(0, 0), cA, voffA); PG8_STAGE(PG8_SB(0, 1), cB + hstep, voffB); PG8_STAGE(PG8_SA(0, 1), cA + hstep, voffA);
        if (wr == 1) PG8_BAR;
        PG8_WAIT_V(4); PG8_BAR;
        PG8_STAGE(PG8_SB(1, 0), cB + kstep, voffB); PG8_STAGE(PG8_SA(1, 0), cA + kstep, voffA); PG8_STAGE(PG8_SB(1, 1), cB + hstep + kstep, voffB);
        PG8_WAIT_V(6); PG8_BAR;
    }
    for (;;) {
        const bool has_next = S.next(ui + 1, nxt);
        const char* nA = has_next ? (const char*)g.A + (size_t)nxt.pm * tstep : cA; const char* nB = has_next ? (const char*)g.Bt + (size_t)nxt.pn * tstep : cB;
        for (int t = 0; t < nt; t += 2) {
            const bool last = (t == nt - 2);
            const char* a1 = cA + (size_t)(t + 1) * kstep;
            const char* a2 = last ? nA : cA + (size_t)(t + 2) * kstep; const char* b2 = last ? nB : cB + (size_t)(t + 2) * kstep;
            const char* a3 = a2 + kstep; const char* b3 = b2 + kstep;
            if (last && has_next) S.a_ready(nxt);
            if constexpr (SP2) {
            PG8_LDB(B0, 0, 0); PG8_LDB(B1, 0, 1); PG8_SCHED; PG8_LDA(At, 0, 0); PG8_STAGE(PG8_SA(1, 1), a1 + hstep, voffA);
            PG8_WAIT_V(8); PG8_WAIT_L(0); PG8_BAR; PG8_MMA(0, 0, At, B0); PG8_MMA(0, 1, At, B1); PG8_BAR; PG8_SCHED;
            PG8_LDA(At, 0, 1); PG8_STAGE(PG8_SB(0, 0), b2, voffB); PG8_STAGE(PG8_SB(0, 1), b2 + hstep, voffB); PG8_STAGE(PG8_SA(0, 0), a2, voffA);
            PG8_WAIT_V(8); PG8_WAIT_L(0); PG8_BAR; PG8_MMA(1, 0, At, B0); PG8_MMA(1, 1, At, B1); PG8_BAR; PG8_SCHED;
            PG8_LDB(B0, 1, 0); PG8_LDB(B1, 1, 1); PG8_SCHED; PG8_LDA(At, 1, 0); PG8_STAGE(PG8_SA(0, 1), a2 + hstep, voffA);
            PG8_WAIT_V(8); PG8_WAIT_L(0); PG8_BAR; PG8_MMA(0, 0, At, B0); PG8_MMA(0, 1, At, B1); PG8_BAR; PG8_SCHED;
            PG8_LDA(At, 1, 1); PG8_STAGE(PG8_SB(1, 0), b3, voffB); PG8_STAGE(PG8_SB(1, 1), b3 + hstep, voffB); PG8_STAGE(PG8_SA(1, 0), a3, voffA);
            PG8_WAIT_V(8); PG8_WAIT_L(0); PG8_BAR; PG8_MMA(1, 0, At, B0); PG8_MMA(1, 1, At, B1); PG8_BAR; PG8_SCHED;
            } else {
            PG8_LDB(B0, 0, 0); PG8_SCHED; PG8_LDA(At, 0, 0); PG8_STAGE(PG8_SA(1, 1), a1 + hstep, voffA);
            PG8_WAIT_L(8); PG8_BAR; PG8_WAIT_L(0); PG8_MMA(0, 0, At, B0); PG8_BAR; PG8_SCHED;
            PG8_LDB(B1, 0, 1); PG8_STAGE(PG8_SB(0, 0), b2, voffB);
            PG8_BAR; PG8_WAIT_L(0); PG8_MMA(0, 1, At, B1); PG8_BAR;
            PG8_LDA(At, 0, 1); PG8_STAGE(PG8_SA(0, 0), a2, voffA);
            PG8_BAR; PG8_WAIT_L(0); PG8_MMA(1, 0, At, B0); PG8_BAR; PG8_SCHED;
            PG8_STAGE(PG8_SB(0, 1), b2 + hstep, voffB);
            PG8_WAIT_V(6); PG8_BAR; PG8_MMA(1, 1, At, B1); PG8_BAR;
            PG8_LDB(B0, 1, 0); PG8_SCHED; PG8_LDA(At, 1, 0); PG8_STAGE(PG8_SA(0, 1), a2 + hstep, voffA);
            PG8_WAIT_L(8); PG8_BAR; PG8_WAIT_L(0); PG8_MMA(0, 0, At, B0); PG8_BAR; PG8_SCHED;
            PG8_LDB(B1, 1, 1); PG8_STAGE(PG8_SB(1, 0), b3, voffB);
            PG8_BAR; PG8_WAIT_L(0); PG8_MMA(0, 1, At, B1); PG8_BAR;
            PG8_LDA(At, 1, 1); PG8_STAGE(PG8_SA(1, 0), a3, voffA);
            PG8_BAR; PG8_WAIT_L(0); PG8_MMA(1, 0, At, B0); PG8_BAR; PG8_SCHED;
            PG8_STAGE(PG8_SB(1, 1), b3 + hstep, voffB);
            PG8_WAIT_V(6); PG8_BAR; PG8_MMA(1, 1, At, B1); PG8_BAR;
            }
        }
        if constexpr (ALIGN_EPI) { if (wr == 0) PG8_BAR; }
        if constexpr (!Epi::AFTER_DRAIN) { E(acc, cur, wr, wc, fr, fq); S.done(cur); }
        if (!has_next) break;
#pragma unroll
        for (int a = 0; a < 2; ++a)
#pragma unroll
            for (int b = 0; b < 2; ++b)
#pragma unroll
                for (int m = 0; m < 4; ++m)
#pragma unroll
                    for (int n = 0; n < 2; ++n) acc[a][b][m][n] = (f32x4){0.f, 0.f, 0.f, 0.f};
        cur = nxt; cA = nA; cB = nB; ++ui;
        if constexpr (ALIGN_EPI) { if (wr == 1) PG8_BAR; }
    }
    PG8_WAIT_V(0);
    if constexpr (!ALIGN_EPI) { if (wr == 0) PG8_BAR; }
    PG8_BAR;
    if constexpr (Epi::AFTER_DRAIN) { E.fused(acc, cur, wr, wc, fr, fq, lds, wid, lane); S.done(cur); }
#undef PG8_SA
#undef PG8_SB
#undef PG8_STAGE
#undef PG8_LDA
#undef PG8_LDB
#undef PG8_MMA
#undef PG8_WAIT_V
#undef PG8_WAIT_L
#undef PG8_BAR
#undef PG8_SCHED
}
}
#define XB_TMO      128
#define XB_XCNT(j)  (256  + 64 * (j))
#define XB_XSUB(j)  (1280 + 64 * (j))
#define XB_XGEN(j)  (2304 + 64 * (j))
#define XB_TOP      3328
#define XB_TOPGEN   3392
#define XCD_BAR_WORDS 3456
#define XB_SPIN_CAP (1u << 18)

__device__ __forceinline__ unsigned xb_ld(unsigned* p)              { return __hip_atomic_load(p, __ATOMIC_RELAXED, __HIP_MEMORY_SCOPE_AGENT); }
__device__ __forceinline__ unsigned xb_add(unsigned* p, unsigned v) { return __hip_atomic_fetch_add(p, v, __ATOMIC_RELAXED, __HIP_MEMORY_SCOPE_AGENT); }
__device__ __forceinline__ unsigned xb_xcc_id() { return (unsigned)__builtin_amdgcn_s_getreg((3 << 11) | 20) & 0xFu; }
#define XB_SPIN(cond, bar) do { unsigned _sp = 0; while (cond) { __builtin_amdgcn_s_sleep(1); \
    if ((++_sp & 255u) == 0u) { if (xb_ld(&(bar)[XB_TMO])) break; if (_sp > XB_SPIN_CAP) { atomicAdd(&(bar)[XB_TMO], 1u); break; } } } } while (0)

struct XcdBarrier {
    unsigned* bar; unsigned x;
    volatile LAS unsigned* st;
};

__device__ __forceinline__ XcdBarrier xcd_barrier_post(unsigned* bar, volatile LAS unsigned* st) {
    XcdBarrier b; b.bar = bar; b.x = xb_xcc_id(); b.st = st;
    if (threadIdx.x == 0) (void)xb_add(&bar[XB_XCNT(b.x)], 1u);
    return b;
}
__device__ __forceinline__ void xcd_barrier_complete(unsigned* bar, unsigned x, unsigned& nloc, unsigned& nx) {
    const unsigned G = gridDim.x * gridDim.y * gridDim.z;
    unsigned sum, cnt, mine, sp = 0u;
    for (;;) {
        sum = 0u; cnt = 0u; mine = 0u;
#pragma unroll
        for (unsigned j = 0; j < 16; ++j) { const unsigned c = xb_ld(&bar[XB_XCNT(j)]); sum += c; cnt += (c > 0u) ? 1u : 0u; mine = (j == x) ? c : mine; }
        if (sum == G) break;
        __builtin_amdgcn_s_sleep(1);
        if ((++sp & 255u) == 0u) { if (xb_ld(&bar[XB_TMO])) break; if (sp > XB_SPIN_CAP) { atomicAdd(&bar[XB_TMO], 1u); break; } }
    }
    nloc = mine > 0u ? mine : 1u; nx = cnt > 0u ? cnt : 1u;
}

__device__ __forceinline__ void xcd_barrier(const XcdBarrier& b) {
    asm volatile("s_waitcnt vmcnt(0)" ::: "memory");
    __syncthreads();
    if (threadIdx.x == 0) {
        unsigned* bar = b.bar;
        __builtin_amdgcn_s_waitcnt(0);
        unsigned nloc = b.st[0], nx = b.st[1];
        if (nloc == 0u) { xcd_barrier_complete(bar, b.x, nloc, nx); b.st[0] = nloc; b.st[1] = nx; }
        const unsigned old = xb_add(&bar[XB_XSUB(b.x)], 1u);
        const unsigned gen = old / nloc;
        if (old + 1u == (gen + 1u) * nloc) {
            __builtin_amdgcn_fence(__ATOMIC_RELEASE, "agent");
            asm volatile("s_waitcnt vmcnt(0)" ::: "memory");
            const unsigned og = xb_add(&bar[XB_TOP], 1u);
            const unsigned tg = og / nx;
            if (og + 1u == (tg + 1u) * nx) xb_add(&bar[XB_TOPGEN], 1u);
            else XB_SPIN(xb_ld(&bar[XB_TOPGEN]) == tg, bar);
            __builtin_amdgcn_fence(__ATOMIC_ACQUIRE, "agent");
            xb_add(&bar[XB_XGEN(b.x)], 1u);
            asm volatile("s_waitcnt vmcnt(0)" ::: "memory");
        } else {
            XB_SPIN(xb_ld(&bar[XB_XGEN(b.x)]) == gen, bar);
            __builtin_amdgcn_fence(__ATOMIC_ACQUIRE, "agent");
            asm volatile("s_waitcnt vmcnt(0)" ::: "memory");
        }
    }
    __syncthreads();
}
namespace da {
constexpr int SLOT_K = 8192, SLOT_V = 16384, SLOT = SLOT_K + SLOT_V;
constexpr int LDS_BIAS = 2 * SLOT;
constexpr int LDS_END = LDS_BIAS + BIAS_TAB * 4;
constexpr float THR = 8.f;
__device__ __forceinline__ int crow(int r, int hi) { return (r & 3) + 8 * (r >> 2) + 4 * hi; }
__device__ __forceinline__ void glds16(const void* gbase  , unsigned voff  , unsigned lds_dst) { unsigned keep;
    asm volatile("s_mov_b32 %0, m0\n\ts_mov_b32 m0, %3\n\ts_nop 0\n\tglobal_load_lds_dwordx4 %1, %2\n\ts_mov_b32 m0, %0" : "=&s"(keep) : "v"(voff), "s"(gbase), "s"(lds_dst) : "memory"); }
typedef short v4i16_t __attribute__((ext_vector_type(4)));
__device__ __forceinline__ s16x4 vtr(const LAS char* p) { return __builtin_bit_cast(s16x4, __builtin_amdgcn_ds_read_tr16_b64_v4i16((LAS v4i16_t*)p)); }
#define DA_WAIT_BAR() asm volatile("s_waitcnt vmcnt(0) lgkmcnt(0)\n\ts_barrier" ::: "memory")

struct Tensors { const bf16* Qd; const bf16* Kd; const bf16* Vd; float* stash; bf16* ya; const float* dlam; const float* subg; const float* relb; };

__device__ __forceinline__ void unit(const Tensors& X, int b, int h, int qb, LAS unsigned char* lds, int wgslot, float lam, float c31) {
    const int tid = threadIdx.x, lane = tid & 63, r32 = lane & 31, hi = lane >> 5; const int wid = __builtin_amdgcn_readfirstlane(tid >> 6);
    const int q0 = qb * 256, NT = 4 * (qb + 1);
    const unsigned lds0 = (unsigned)(uintptr_t)lds;
    const LAS float* tb = (const LAS float*)(lds + LDS_BIAS);
    const unsigned lane16 = (unsigned)lane * 16u;
    const int qabs = q0 + wid * 32 + r32;
    const LAS char* vp0 = (const LAS char*)lds + SLOT_K + ((lane >> 4) & 1) * 32 + (lane & 3) * 8 + (4 * hi + ((lane & 15) >> 2)) * 64;
    const LAS char* kp0 = (const LAS char*)lds + hi * 1024 + r32 * 16;
    for (int c = 0; c < 2; ++c) {
        const int bhc = (b * 4 + h) * 2 + c;
        const bf16* Qw = X.Qd + ((size_t)bhc * SEQ + q0 + wid * 32 + r32) * 64 + hi * 8;
        const char* Kt = (const char*)X.Kd + (size_t)bhc * NTILE * SLOT_K + wid * 1024;
        const char* Vt = (const char*)X.Vd + (size_t)(b * 4 + h) * NTILE * SLOT_V + wid * 1024;
#define DA_DMA(t, slot) do { const unsigned sb_ = (unsigned)__builtin_amdgcn_readfirstlane(lds0 + (slot) * SLOT + wid * 1024); \
        glds16(Kt + (size_t)(t) * SLOT_K, lane16, sb_); glds16(Vt + (size_t)(t) * SLOT_V, lane16, sb_ + SLOT_K); glds16(Vt + (size_t)(t) * SLOT_V + 8192, lane16, sb_ + SLOT_K + 8192); } while (0)
        DA_DMA(0, 0);
        bf16x8 qr[4];
#pragma unroll
        for (int d0 = 0; d0 < 4; ++d0) qr[d0] = *(const bf16x8*)(Qw + d0 * 16);
        f32x16 o[4];
#pragma unroll
        for (int d0 = 0; d0 < 4; ++d0)
#pragma unroll
            for (int r = 0; r < 16; ++r) o[d0][r] = 0.f;
        float m = -1e30f, l = 0.f;
        for (int t = 0; t < NT; ++t) {
            DA_WAIT_BAR();
            if (t + 1 < NT) DA_DMA(t + 1, (t + 1) & 1);
            const int sl = (t & 1) * SLOT;
            const bool nearb = (q0 - 64 * t - 63) < DFAR;
            const int base = qabs - 64 * t - 4 * hi + BIAS_GUARD;
            f32x16 p0, p1;
            if (nearb) {
#pragma unroll
                for (int r = 0; r < 16; ++r) { const int o_ = (r & 3) + 8 * (r >> 2); p0[r] = tb[base - o_]; p1[r] = tb[base - o_ - 32]; }
            } else {
#pragma unroll
                for (int r = 0; r < 16; ++r) { p0[r] = 0.f; p1[r] = 0.f; }
            }
            const float cadd = nearb ? 0.f : c31;
            {
                const LAS char* kb = kp0 + sl;
#pragma unroll
                for (int d0 = 0; d0 < 4; ++d0) {
                    const bf16x8 k0 = *(const LAS bf16x8*)(kb + d0 * 2048), k1 = *(const LAS bf16x8*)(kb + d0 * 2048 + 512);
                    p0 = __builtin_amdgcn_mfma_f32_32x32x16_bf16(k0, qr[d0], p0, 0, 0, 0);
                    p1 = __builtin_amdgcn_mfma_f32_32x32x16_bf16(k1, qr[d0], p1, 0, 0, 0);
                }
            }
            if (t >= NT - 4) {
#pragma unroll
                for (int r = 0; r < 16; ++r) { const int o_ = (r & 3) + 8 * (r >> 2); if (base - o_ < BIAS_GUARD) p0[r] = -1e30f; if (base - o_ - 32 < BIAS_GUARD) p1[r] = -1e30f; }
            }
            float rm = fmaxf(p0[0], p1[0]);
#pragma unroll
            for (int r = 1; r < 16; ++r) rm = fmaxf(rm, fmaxf(p0[r], p1[r]));
            { auto rr = __builtin_amdgcn_permlane32_swap(__float_as_uint(rm), __float_as_uint(rm), false, false); rm = fmaxf(__uint_as_float(rr[0]), __uint_as_float(rr[1])); }
            rm += cadd;
            if (__any(rm > m + THR)) {
                const float mn = fmaxf(m, rm), f = __builtin_amdgcn_exp2f(m - mn);
#pragma unroll
                for (int d0 = 0; d0 < 4; ++d0)
#pragma unroll
                    for (int r = 0; r < 16; ++r) o[d0][r] *= f;
                l *= f; m = mn;
            }
            const float sub = cadd - m;
            float ls = 0.f;
#pragma unroll
            for (int r = 0; r < 16; ++r) { p0[r] = __builtin_amdgcn_exp2f(p0[r] + sub); p1[r] = __builtin_amdgcn_exp2f(p1[r] + sub); ls += p0[r] + p1[r]; }
            l += ls;
            bf16x8 pw[4];
            { v4u w;
              w.x = pk2(p0[0], p0[1]); w.y = pk2(p0[2], p0[3]); w.z = pk2(p0[4], p0[5]); w.w = pk2(p0[6], p0[7]); pw[0] = __builtin_bit_cast(bf16x8, w);
              w.x = pk2(p0[8], p0[9]); w.y = pk2(p0[10], p0[11]); w.z = pk2(p0[12], p0[13]); w.w = pk2(p0[14], p0[15]); pw[1] = __builtin_bit_cast(bf16x8, w);
              w.x = pk2(p1[0], p1[1]); w.y = pk2(p1[2], p1[3]); w.z = pk2(p1[4], p1[5]); w.w = pk2(p1[6], p1[7]); pw[2] = __builtin_bit_cast(bf16x8, w);
              w.x = pk2(p1[8], p1[9]); w.y = pk2(p1[10], p1[11]); w.z = pk2(p1[12], p1[13]); w.w = pk2(p1[14], p1[15]); pw[3] = __builtin_bit_cast(bf16x8, w); }
            const LAS char* vb = vp0 + sl;
#pragma unroll
            for (int d0 = 0; d0 < 4; ++d0) {
#pragma unroll
                for (int ks = 0; ks < 4; ++ks) {
                    const s16x4 lo = vtr(vb + d0 * 4096 + ks * 1024), hh = vtr(vb + d0 * 4096 + ks * 1024 + 512);
                    const bf16x8 vf = (bf16x8){lo[0], lo[1], lo[2], lo[3], hh[0], hh[1], hh[2], hh[3]};
                    o[d0] = __builtin_amdgcn_mfma_f32_32x32x16_bf16(vf, pw[ks], o[d0], 0, 0, 0);
                }
                if (d0 & 1) __builtin_amdgcn_sched_barrier(0);
            }
        }
#undef DA_DMA
        { auto rr = __builtin_amdgcn_permlane32_swap(__float_as_uint(l), __float_as_uint(l), false, false); l = __uint_as_float(rr[0]) + __uint_as_float(rr[1]); }
        const float inv = 1.f / l;
        float* st = X.stash + ((size_t)(wgslot * 8 + wid) * 64) * 64 + lane;
        asm volatile("" : "+v"(st)); GAS float* stg = (GAS float*)st;
        if (c == 0) {
#pragma unroll
            for (int d0 = 0; d0 < 4; ++d0)
#pragma unroll
                for (int r = 0; r < 16; ++r) stg[(d0 * 16 + r) * 64] = o[d0][r] * inv;
        } else {
            float ss = 0.f;
#pragma unroll
            for (int d0 = 0; d0 < 4; ++d0)
#pragma unroll
                for (int r = 0; r < 16; ++r) { const float dv = stg[(d0 * 16 + r) * 64] - lam * (o[d0][r] * inv); o[d0][r] = dv; ss += dv * dv; }
            { auto rr = __builtin_amdgcn_permlane32_swap(__float_as_uint(ss), __float_as_uint(ss), false, false); ss = __uint_as_float(rr[0]) + __uint_as_float(rr[1]); }
            const float rn = __builtin_amdgcn_rsqf(ss * (1.f / 128.f) + SUBLN_EPS) * (1.f - LAM_INIT);
            bf16* yrow = X.ya + ((size_t)b * SEQ + qabs) * 512 + h * 128 + 4 * hi; const float* sg = X.subg + 4 * hi;
            asm volatile("" : "+v"(yrow), "+v"(sg));
#pragma unroll
            for (int d0 = 0; d0 < 4; ++d0)
#pragma unroll
                for (int r4 = 0; r4 < 4; ++r4) {
                    const int dd = 32 * d0 + 8 * r4; const f32x4 g = *(const f32x4*)(sg + dd);
                    v2u w; w.x = pk2(o[d0][4 * r4] * rn * g[0], o[d0][4 * r4 + 1] * rn * g[1]); w.y = pk2(o[d0][4 * r4 + 2] * rn * g[2], o[d0][4 * r4 + 3] * rn * g[3]);
                    *(v2u*)(yrow + dd) = w;
                }
        }
    }
    asm volatile("s_waitcnt vmcnt(0) lgkmcnt(0)\n\ts_barrier" ::: "memory");
}
#undef DA_WAIT_BAR
}
namespace dil {
constexpr int BT = 1152, BT0 = 512;
constexpr int LDS_VST = 0, LDS_BL = 32768, LDS_END = LDS_BL + 3 * BT * 4;
constexpr float THR = 8.f;
struct Tensors { const bf16* LQ; const bf16* LK; const bf16* LV; bf16* yb; };
typedef short v4i16_t __attribute__((ext_vector_type(4)));
__device__ __forceinline__ s16x4 vtr(const LAS unsigned char* p) { return __builtin_bit_cast(s16x4, __builtin_amdgcn_ds_read_tr16_b64_v4i16((LAS v4i16_t*)p)); }

template <int G_> __device__ __forceinline__ void group(const Tensors& X, size_t rowb, int h, int P0, int r, LAS unsigned char* vst, const LAS float* blg, int lane, f32x16 (&o)[2], float& m, float& l) {
    constexpr int DL = (G_ == 0) ? 1 : (G_ == 1) ? 4 : 16, MG = 16 / DL, NKB = (G_ == 0) ? 20 : (G_ == 1) ? 8 : 5;
    const int i = lane & 31, hi = lane >> 5;
    const int colb = G_ * 256 + h * 64;
    bf16x8 qr[4];
    { const bf16* qp = X.LQ + (rowb + P0 + r + 16 * i) * 768 + colb + hi * 8;
#pragma unroll
      for (int d0 = 0; d0 < 4; ++d0) qr[d0] = *(const bf16x8*)(qp + 16 * d0); }
    const int kpos0 = P0 + r - 128 * DL;
    const LAS unsigned char* vrd = vst + ((lane >> 4) & 1) * 32 + (lane & 3) * 8 + (4 * hi + ((lane & 15) >> 2)) * 64;
    for (int kb = 0; kb < NKB; ++kb) {
        bf16x8 kf[4];
        { int kpos = kpos0 + (32 * kb + i) * DL; kpos = kpos < 0 ? 0 : (kpos > SEQ - 1 ? SEQ - 1 : kpos); const bf16* kp = X.LK + (rowb + kpos) * 768 + colb + hi * 8;
#pragma unroll
          for (int d0 = 0; d0 < 4; ++d0) kf[d0] = *(const bf16x8*)(kp + 16 * d0); }
        v4u vreg[4];
#pragma unroll
        for (int t = 0; t < 4; ++t) { const int qd = lane + 64 * t, key = qd >> 3, ch = qd & 7; int vpos = kpos0 + (32 * kb + key) * DL; vpos = vpos < 0 ? 0 : (vpos > SEQ - 1 ? SEQ - 1 : vpos);
            vreg[t] = *(const v4u*)(X.LV + (rowb + vpos) * 768 + colb + ch * 8); }
        const int jb = i * MG + 128 - 32 * kb - 4 * hi;
        f32x16 p;
#pragma unroll
        for (int rr = 0; rr < 16; ++rr) p[rr] = blg[jb - ((rr & 3) + 8 * (rr >> 2)) + BT0];
#pragma unroll
        for (int d0 = 0; d0 < 4; ++d0) p = __builtin_amdgcn_mfma_f32_32x32x16_bf16(kf[d0], qr[d0], p, 0, 0, 0);
        const int cb = 32 * kb + 4 * hi;
#pragma unroll
        for (int rr = 0; rr < 16; ++rr) { const int o_ = (rr & 3) + 8 * (rr >> 2); if ((unsigned)(jb - o_) > 128u || kpos0 + (cb + o_) * DL < 0) p[rr] = -3e38f; }
        float rm = p[0];
#pragma unroll
        for (int rr = 1; rr < 16; ++rr) rm = fmaxf(rm, p[rr]);
        { auto sw = __builtin_amdgcn_permlane32_swap(__float_as_uint(rm), __float_as_uint(rm), false, false); rm = fmaxf(__uint_as_float(sw[0]), __uint_as_float(sw[1])); }
        if (__any(rm > m + THR)) {
            const float mn = fmaxf(m, rm), f = __builtin_amdgcn_exp2f(m - mn);
#pragma unroll
            for (int d0 = 0; d0 < 2; ++d0)
#pragma unroll
                for (int rr = 0; rr < 16; ++rr) o[d0][rr] *= f;
            l *= f; m = mn;
        }
        float ls = 0.f;
#pragma unroll
        for (int rr = 0; rr < 16; ++rr) { p[rr] = __builtin_amdgcn_exp2f(p[rr] - m); ls += p[rr]; }
        l += ls;
        bf16x8 pw[2];
        { v4u w;
          w.x = pk2(p[0], p[1]); w.y = pk2(p[2], p[3]); w.z = pk2(p[4], p[5]); w.w = pk2(p[6], p[7]); pw[0] = __builtin_bit_cast(bf16x8, w);
          w.x = pk2(p[8], p[9]); w.y = pk2(p[10], p[11]); w.z = pk2(p[12], p[13]); w.w = pk2(p[14], p[15]); pw[1] = __builtin_bit_cast(bf16x8, w); }
#pragma unroll
        for (int t = 0; t < 4; ++t) { const int qd = lane + 64 * t, key = qd >> 3, ch = qd & 7;
            *(LAS v4u*)(vst + ((ch >> 2) * 2 + (key >> 4)) * 1024 + (key & 15) * 64 + (ch & 3) * 16) = vreg[t]; }
        asm volatile("s_waitcnt lgkmcnt(0)" ::: "memory");
#pragma unroll
        for (int d0 = 0; d0 < 2; ++d0)
#pragma unroll
            for (int ks = 0; ks < 2; ++ks) {
                const s16x4 lo = vtr(vrd + (d0 * 2 + ks) * 1024), hh = vtr(vrd + (d0 * 2 + ks) * 1024 + 512);
                const bf16x8 vf = (bf16x8){lo[0], lo[1], lo[2], lo[3], hh[0], hh[1], hh[2], hh[3]};
                o[d0] = __builtin_amdgcn_mfma_f32_32x32x16_bf16(vf, pw[ks], o[d0], 0, 0, 0);
            }
        asm volatile("s_waitcnt lgkmcnt(0)" ::: "memory");
    }
}
__device__ __forceinline__ void wave_tile(const Tensors& X, int b, int h, int P0, int r, LAS unsigned char* vst, const LAS float* bl, int lane) {
    const size_t rowb = (size_t)b * SEQ;
    f32x16 o[2];
#pragma unroll
    for (int d0 = 0; d0 < 2; ++d0)
#pragma unroll
        for (int rr = 0; rr < 16; ++rr) o[d0][rr] = 0.f;
    float m = -1e30f, l = 0.f;
    group<0>(X, rowb, h, P0, r, vst, bl, lane, o, m, l);
    group<1>(X, rowb, h, P0, r, vst, bl + BT, lane, o, m, l);
    group<2>(X, rowb, h, P0, r, vst, bl + 2 * BT, lane, o, m, l);
    { auto sw = __builtin_amdgcn_permlane32_swap(__float_as_uint(l), __float_as_uint(l), false, false); l = __uint_as_float(sw[0]) + __uint_as_float(sw[1]); }
    const float inv = 1.f / l; const int i = lane & 31, hi = lane >> 5;
    bf16* yrow = X.yb + (rowb + P0 + r + 16 * i) * 256 + h * 64 + 4 * hi;
#pragma unroll
    for (int d0 = 0; d0 < 2; ++d0)
#pragma unroll
        for (int r4 = 0; r4 < 4; ++r4) { v2u w; w.x = pk2(o[d0][4 * r4] * inv, o[d0][4 * r4 + 1] * inv); w.y = pk2(o[d0][4 * r4 + 2] * inv, o[d0][4 * r4 + 3] * inv); *(v2u*)(yrow + 32 * d0 + 8 * r4) = w; }
}
}
__device__ __forceinline__ void p0_transpose_item(const float* W, int K, int N, bf16* WT, LAS float* scr, int item, int lane) {
    const int nblk = N / 32, kb = item / nblk, nb = item % nblk, k0 = 64 * kb, n0 = 32 * nb;
#pragma unroll 8
    for (int i = 0; i < 32; ++i) { const int kk = 2 * i + (lane >> 5); scr[kk * 33 + (lane & 31)] = W[(size_t)(k0 + kk) * N + n0 + (lane & 31)]; }
    LDS_WAIT(); asm volatile("" ::: "memory");
    const int c = lane & 7;
#pragma unroll
    for (int j = 0; j < 4; ++j) { const int n = (lane >> 3) + 8 * j; const LAS float* s = scr + (8 * c) * 33 + n;
        v4u o; o.x = pk2(s[0 * 33], s[1 * 33]); o.y = pk2(s[2 * 33], s[3 * 33]); o.z = pk2(s[4 * 33], s[5 * 33]); o.w = pk2(s[6 * 33], s[7 * 33]);
        *(v4u*)(WT + (size_t)(n0 + n) * K + k0 + 8 * c) = o; }
    LDS_WAIT(); asm volatile("" ::: "memory");
}
__device__ __forceinline__ void cast_bf16(const float* src, bf16* dst, size_t n8, size_t gtid, size_t gthreads) {
    for (size_t i = gtid; i < n8; i += gthreads) { const f32x4 a = *(const f32x4*)(src + i * 8), b = *(const f32x4*)(src + i * 8 + 4);
        v4u o; o.x = pk2(a[0], a[1]); o.y = pk2(a[2], a[3]); o.z = pk2(b[0], b[1]); o.w = pk2(b[2], b[3]); *(v4u*)(dst + i * 8) = o; }
}

struct Args { const float* in[16]; float* out; unsigned char* ws; int ph_lo, ph_hi; };
enum { I_X = 0, I_WIN, I_DLAM, I_SUBG, I_WBD, I_WBL, I_WO, I_LN1G, I_LN1B, I_PWQ, I_PKEYS, I_PU, I_PV, I_LN2G, I_LN2B, I_RELB };

__device__ __forceinline__ void p0_prologue(const Args& A, LAS unsigned char* lds, int vcu, int G, int wave, int lane) {
    unsigned char* ws = A.ws;
    const int gw = vcu * NWAVES + wave, NGW = G * NWAVES;
    const size_t gtid = (size_t)gw * 64 + lane, gthreads = (size_t)NGW * 64;
    LAS float* scr = (LAS float*)(lds + wave * 16384);
    constexpr int I_IN = (D / 64) * (INC / 32), I_BD = (512 / 64) * (D / 32), I_BL = (256 / 64) * (D / 32), I_O = (D / 64) * (D / 32);
    for (int it = gw; it < I_IN + I_BD + I_BL + I_O; it += NGW) {
        int r = it;
        if (r < I_IN) { p0_transpose_item(A.in[I_WIN], D, INC, (bf16*)(ws + WS_WIN), scr, r, lane); continue; } r -= I_IN;
        if (r < I_BD) { p0_transpose_item(A.in[I_WBD], 512, D, (bf16*)(ws + WS_WBD), scr, r, lane); continue; } r -= I_BD;
        if (r < I_BL) { p0_transpose_item(A.in[I_WBL], 256, D, (bf16*)(ws + WS_WBL), scr, r, lane); continue; } r -= I_BL;
        p0_transpose_item(A.in[I_WO], D, D, (bf16*)(ws + WS_WO), scr, r, lane);
    }
    cast_bf16(A.in[I_X], (bf16*)(ws + WS_A), (size_t)T * D / 8, gtid, gthreads);
    { const float* wq = A.in[I_PWQ]; const float* keys = A.in[I_PKEYS]; bf16* wp = (bf16*)(ws + WS_WP);
      for (int it = gw; it < 2048 * 16; it += NGW) {
          const int row = it >> 4, jb = it & 15, hc = row >> 7, j = jb * 64 + lane;
          const float* wr_ = wq + (size_t)j * 2048 + hc * 128; const float* kr = keys + (size_t)row * 128;
          float a0 = 0.f, a1 = 0.f, a2 = 0.f, a3 = 0.f;
#pragma unroll 8
          for (int d = 0; d < 128; d += 4) { const f32x4 w = *(const f32x4*)(wr_ + d), k = *(const f32x4*)(kr + d); a0 += w[0] * k[0]; a1 += w[1] * k[1]; a2 += w[2] * k[2]; a3 += w[3] * k[3]; }
          wp[(size_t)row * 1024 + j] = (bf16)f2bf((a0 + a1) + (a2 + a3));
      } }
    { const float* relb = A.in[I_RELB]; float* bd = (float*)(ws + WS_BIASD); float* bl = (float*)(ws + WS_BIASL);
      for (size_t i = gtid; i < 4 * BIAS_TAB; i += gthreads) { const int h = (int)(i / BIAS_TAB), dist = (int)(i % BIAS_TAB) - BIAS_GUARD; bd[i] = dist < 0 ? 0.f : relb[rel_bucket(dist) * 16 + h] * LOG2E; }
      for (size_t i = gtid; i < 12 * 132; i += gthreads) { const int gh = (int)(i / 132), j = (int)(i % 132), g = gh >> 2; const int dl = (g == 0) ? 1 : (g == 1) ? 4 : 16;
          bl[i] = relb[rel_bucket((j > 128 ? 128 : j) * dl) * 16 + 4 + gh] * LOG2E; } }
}

__device__ __forceinline__ void p5_ln1(const Args& A, int vcu, int G, int wave, int lane) {
    unsigned char* ws = A.ws;
    const int gw = vcu * NWAVES + wave, NGW = G * NWAVES;
    const float* R = (const float*)(ws + WS_R); bf16* x1b = (bf16*)(ws + WS_A);
    const float* gam = A.in[I_LN1G]; const float* bet = A.in[I_LN1B];
    f32x4 gv[4], bv[4];
#pragma unroll
    for (int j = 0; j < 4; ++j) { gv[j] = *(const f32x4*)(gam + 256 * j + 4 * lane); bv[j] = *(const f32x4*)(bet + 256 * j + 4 * lane); }
    for (int mrow = gw; mrow < T; mrow += NGW) {
        const f32x4* xr = (const f32x4*)(R + (size_t)mrow * D) + lane;
        f32x4 v[4]; float s = 0.f;
#pragma unroll
        for (int j = 0; j < 4; ++j) { v[j] = xr[64 * j]; s += (v[j][0] + v[j][1]) + (v[j][2] + v[j][3]); }
        const float mean = wave_sum(s) * (1.f / D); float s2 = 0.f;
#pragma unroll
        for (int j = 0; j < 4; ++j) { v[j] = v[j] - mean; s2 += (v[j][0] * v[j][0] + v[j][1] * v[j][1]) + (v[j][2] * v[j][2] + v[j][3] * v[j][3]); }
        const float rstd = __builtin_amdgcn_rsqf(wave_sum(s2) * (1.f / D) + LN_EPS);
        f32x4* orow = (f32x4*)(A.out + (size_t)mrow * D) + lane; v2u* brow = (v2u*)(x1b + (size_t)mrow * D) + lane;
#pragma unroll
        for (int j = 0; j < 4; ++j) { const f32x4 y = v[j] * rstd * gv[j] + bv[j]; orow[64 * j] = y; v2u w; w.x = pk2(y[0], y[1]); w.y = pk2(y[2], y[3]); brow[64 * j] = w; }
    }
    const size_t gtid = (size_t)gw * 64 + lane, gthreads = (size_t)NGW * 64;
    cast_bf16(A.in[I_PU], (bf16*)(ws + WS_UU), (size_t)NEXP * D / 8, gtid, gthreads);
    cast_bf16(A.in[I_PV], (bf16*)(ws + WS_UV), (size_t)NEXP * D / 8, gtid, gthreads);
}
namespace peer {
__device__ __forceinline__ int mono(float v) { const int b = __float_as_int(v); return b ^ ((b >> 31) & 0x7fffffff); }
__device__ __forceinline__ float unmono(int k) { return __int_as_float(k ^ ((k >> 31) & 0x7fffffff)); }
__device__ __forceinline__ int med3i(int a, int b, int c) { int r; asm("v_med3_i32 %0, %1, %2, %3" : "=v"(r) : "v"(a), "v"(b), "v"(c)); return r; }
#define PEER_INS16(a, x) do { _Pragma("unroll") for (int k_ = 15; k_ >= 1; --k_) a[k_] = med3i(a[k_ - 1], a[k_], (x)); a[0] = max(a[0], (x)); } while (0)
__device__ __forceinline__ unsigned byte_sel(const unsigned (&p)[4], int i) { const int w = i >> 2; const unsigned x = (w == 0) ? p[0] : (w == 1) ? p[1] : (w == 2) ? p[2] : p[3]; return (x >> ((i & 3) * 8)) & 0xffu; }
__device__ __forceinline__ float gelu_erf(float v) { return 0.5f * v * (1.f + erff(v * 0.7071067811865476f)); }

__device__ __forceinline__ void select(const float* ST, v2u* sel, int tok, int head) {
    int a0[16], a1[16];
#pragma unroll
    for (int k = 0; k < 16; ++k) { a0[k] = (int)0x80000000; a1[k] = (int)0x80000000; }
    const float* s0 = ST + (size_t)(head * 256) * T + tok; const float* s1 = s0 + (size_t)128 * T;
#pragma unroll 8
    for (int n = 0; n < 128; ++n) { const int k = (mono(s0[(size_t)n * T]) & ~127) | (127 - n); PEER_INS16(a0, k); }
#pragma unroll 8
    for (int n = 0; n < 128; ++n) { const int k = (mono(s1[(size_t)n * T]) & ~127) | (127 - n); PEER_INS16(a1, k); }
    float v0[16], v1[16]; unsigned i0p[4] = {0u, 0u, 0u, 0u}, i1p[4] = {0u, 0u, 0u, 0u};
#pragma unroll
    for (int k = 0; k < 16; ++k) { v0[k] = unmono((a0[k] & ~127) | 64); v1[k] = unmono((a1[k] & ~127) | 64);
        i0p[k >> 2] |= (unsigned)(127 - (a0[k] & 127)) << (8 * (k & 3)); i1p[k >> 2] |= (unsigned)(127 - (a1[k] & 127)) << (8 * (k & 3)); }
    int cd[16];
#pragma unroll
    for (int k = 0; k < 16; ++k) cd[k] = (int)0x80000000;
#pragma unroll
    for (int i = 0; i < 16; ++i)
#pragma unroll
        for (int j = 0; j < 16; ++j)
            if ((i + 1) * (j + 1) <= 16) { const int k = (mono(v0[i] + v1[j]) & ~255) | (255 - (i * 16 + j)); PEER_INS16(cd, k); }
    float sv[16], ex[16], sum = 0.f; unsigned eid[16];
#pragma unroll
    for (int k = 0; k < 16; ++k) { const int code = 255 - (cd[k] & 255); eid[k] = byte_sel(i0p, code >> 4) * 128u + byte_sel(i1p, code & 15); sv[k] = unmono((cd[k] & ~255) | 128); }
#pragma unroll
    for (int k = 0; k < 16; ++k) { ex[k] = __expf(sv[k] - sv[0]); sum += ex[k]; }
    const float rs = 1.f / sum;
    v4u* dst = (v4u*)(sel + ((size_t)tok * 8 + head) * 16);
#pragma unroll
    for (int k = 0; k < 8; ++k) { v4u w; w.x = eid[2 * k]; w.y = __float_as_uint(ex[2 * k] * rs); w.z = eid[2 * k + 1]; w.w = __float_as_uint(ex[2 * k + 1] * rs); dst[k] = w; }
}

__device__ __forceinline__ void gather_token(const v2u* sel, const bf16* U, const bf16* V, float* xo, const float* gam, const float* bet, int tok, int lane) {
    float* xrow = xo + (size_t)tok * D + 8 * lane;
    f32x4 xv[4];
    xv[0] = *(const f32x4*)(xrow); xv[1] = *(const f32x4*)(xrow + 4); xv[2] = *(const f32x4*)(xrow + 512); xv[3] = *(const f32x4*)(xrow + 516);
    unsigned xp[8];
#pragma unroll
    for (int q = 0; q < 4; ++q) { xp[2 * q] = pk2(xv[q][0], xv[q][1]); xp[2 * q + 1] = pk2(xv[q][2], xv[q][3]); }
    float acc[16];
#pragma unroll
    for (int k = 0; k < 16; ++k) acc[k] = 0.f;
    for (int head = 0; head < 8; ++head) {
        const v2u se = sel[((size_t)tok * 8 + head) * 16 + (lane & 15)];
        float part[16];
#pragma unroll
        for (int hb = 0; hb < 2; ++hb) {
            v4u uu[8][2];
#pragma unroll
            for (int k = 0; k < 8; ++k) { const unsigned e = __builtin_amdgcn_readlane(se.x, hb * 8 + k); const v4u* up = (const v4u*)(U + (size_t)e * D + 8 * lane); uu[k][0] = up[0]; uu[k][1] = up[64]; }
#pragma unroll
            for (int k = 0; k < 8; ++k) { float d0 = 0.f, d1 = 0.f;
                d0 = dot2bf(uu[k][0].x, xp[0], d0); d1 = dot2bf(uu[k][0].y, xp[1], d1); d0 = dot2bf(uu[k][0].z, xp[2], d0); d1 = dot2bf(uu[k][0].w, xp[3], d1);
                d0 = dot2bf(uu[k][1].x, xp[4], d0); d1 = dot2bf(uu[k][1].y, xp[5], d1); d0 = dot2bf(uu[k][1].z, xp[6], d0); d1 = dot2bf(uu[k][1].w, xp[7], d1);
                part[hb * 8 + k] = d0 + d1; }
        }
        float r8[8], r4[4], r2[2], r1;
#pragma unroll
        for (int i = 0; i < 8; ++i) { const bool up = (lane & 32) != 0; const float send = up ? part[i] : part[i + 8], keep = up ? part[i + 8] : part[i]; r8[i] = keep + __shfl_xor(send, 32); }
#pragma unroll
        for (int i = 0; i < 4; ++i) { const bool up = (lane & 16) != 0; const float send = up ? r8[i] : r8[i + 4], keep = up ? r8[i + 4] : r8[i]; r4[i] = keep + __shfl_xor(send, 16); }
#pragma unroll
        for (int i = 0; i < 2; ++i) { const bool up = (lane & 8) != 0; const float send = up ? r4[i] : r4[i + 2], keep = up ? r4[i + 2] : r4[i]; r2[i] = keep + __shfl_xor(send, 8); }
        { const bool up = (lane & 4) != 0; const float send = up ? r2[0] : r2[1], keep = up ? r2[1] : r2[0]; r1 = keep + __shfl_xor(send, 4); }
        r1 += __shfl_xor(r1, 2); r1 += __shfl_xor(r1, 1);
        const float gq = __uint_as_float((unsigned)__shfl((int)se.y, lane >> 2));
        const float wgt = gq * gelu_erf(r1);
#pragma unroll
        for (int hb = 0; hb < 2; ++hb) {
            v4u vv[8][2];
#pragma unroll
            for (int k = 0; k < 8; ++k) { const unsigned e = __builtin_amdgcn_readlane(se.x, hb * 8 + k); const v4u* vp = (const v4u*)(V + (size_t)e * D + 8 * lane); vv[k][0] = vp[0]; vv[k][1] = vp[64]; }
#pragma unroll
            for (int k = 0; k < 8; ++k) { const float w = __uint_as_float(__builtin_amdgcn_readlane(__float_as_uint(wgt), 4 * (hb * 8 + k)));
#pragma unroll
                for (int i2 = 0; i2 < 2; ++i2) { const v4u x = vv[k][i2];
                    acc[8 * i2 + 0] += w * bf_lo(x.x); acc[8 * i2 + 1] += w * bf_hi(x.x); acc[8 * i2 + 2] += w * bf_lo(x.y); acc[8 * i2 + 3] += w * bf_hi(x.y);
                    acc[8 * i2 + 4] += w * bf_lo(x.z); acc[8 * i2 + 5] += w * bf_hi(x.z); acc[8 * i2 + 6] += w * bf_lo(x.w); acc[8 * i2 + 7] += w * bf_hi(x.w); } }
        }
    }
    float rr[16], s = 0.f;
#pragma unroll
    for (int k = 0; k < 16; ++k) { rr[k] = ALPHA * xv[k >> 2][k & 3] + acc[k]; s += rr[k]; }
    const float mean = wave_sum(s) * (1.f / D); float s2 = 0.f;
#pragma unroll
    for (int k = 0; k < 16; ++k) { rr[k] -= mean; s2 += rr[k] * rr[k]; }
    const float rstd = __builtin_amdgcn_rsqf(wave_sum(s2) * (1.f / D) + LN_EPS);
#pragma unroll
    for (int q = 0; q < 4; ++q) { const int off = (q >> 1) * 512 + (q & 1) * 4; const f32x4 g = *(const f32x4*)(gam + 8 * lane + off), bb = *(const f32x4*)(bet + 8 * lane + off);
        f32x4 y; y[0] = rr[4 * q] * rstd * g[0] + bb[0]; y[1] = rr[4 * q + 1] * rstd * g[1] + bb[1]; y[2] = rr[4 * q + 2] * rstd * g[2] + bb[2]; y[3] = rr[4 * q + 3] * rstd * g[3] + bb[3];
        *(f32x4*)(xrow + off) = y; }
}
}
constexpr int NPH = 8;
__global__ void __launch_bounds__(NWAVES * 64, 2) mk_fwd(Args args) {
    extern __shared__ __attribute__((aligned(16))) unsigned char lds_raw[];
    LAS unsigned char* lds = (LAS unsigned char*)lds_raw;
    volatile LAS unsigned* MISC = (volatile LAS unsigned*)(lds + MISC_OFF);
    const int tid = threadIdx.x, lane = tid & 63, wave = __builtin_amdgcn_readfirstlane(tid >> 6);
    const int G = gridDim.x, bx = blockIdx.x, vcu = (G % 8 == 0) ? (bx % 8) * (G / 8) + bx / 8 : bx;
    unsigned char* ws = args.ws;
    gu32* ctl = (gu32*)(ws + WS_CTL);
    for (int u = tid; u < (LDS_BYTES - RING_BYTES) / 4; u += NWAVES * 64) ((LAS unsigned*)(lds + RING_BYTES))[u] = 0u;
    __syncthreads();
    XcdBarrier bar; bar.bar = (unsigned*)(ctl + CW_BAR); bar.x = 0; bar.st = nullptr;
    if (MK_N_LAUNCHES == 1) bar = xcd_barrier_post((unsigned*)(ctl + CW_BAR), MISC + 8);
    const int lo = args.ph_lo, hi = args.ph_hi;
#ifndef PH_MASK
#define PH_MASK 0xFF
#endif
#define IN(k) ((((PH_MASK) >> (k)) & 1) && lo <= (k) && (k) < hi)
#define SEAM(k) do { if (IN(k) && IN((k) + 1)) xcd_barrier(bar); } while (0)
    const int gw = vcu * NWAVES + wave, NGW = G * NWAVES;

    if (IN(0)) { p0_prologue(args, lds, vcu, G, wave, lane); VM_WAIT(); __syncthreads(); SEAM(0); }

    if (IN(1)) {
        pg8::Gemm g{(const pg8::bf16_t*)(ws + WS_A), (const pg8::bf16_t*)(ws + WS_WIN), T, INC, D}; pg8::StaticOrder S; S.init(T, INC, G, bx);
        pg8::EpiInProj E{(pg8::bf16_t*)(ws + WS_QD), (pg8::bf16_t*)(ws + WS_KD), (pg8::bf16_t*)(ws + WS_VD), (pg8::bf16_t*)(ws + WS_LQ), (pg8::bf16_t*)(ws + WS_LK), (pg8::bf16_t*)(ws + WS_LV),
                         (pg8::bf16_t*)(ws + WS_GA), (pg8::bf16_t*)(ws + WS_GB)};
        pg8::gemm_phase<pg8::EpiInProj, pg8::StaticOrder, true, true>(lds, g, S, E);
        SEAM(1);
    }

    if (IN(2)) {
#ifndef NO_DIFF
        {
            const da::Tensors X{(const bf16*)(ws + WS_QD), (const bf16*)(ws + WS_KD), (const bf16*)(ws + WS_VD), (float*)(ws + WS_STASH), (bf16*)(ws + WS_YA),
                                args.in[I_DLAM], args.in[I_SUBG], args.in[I_RELB]};
            int cur_h = -1;
            float lam; { const float* dl = args.in[I_DLAM]; const float p1 = dl[lane] * dl[64 + lane], p2 = dl[128 + lane] * dl[192 + lane];
                lam = __uint_as_float(__builtin_amdgcn_readfirstlane(__float_as_uint(__expf(wave_sum(p1)) - __expf(wave_sum(p2)) + LAM_INIT))); }
            for (int p = vcu; p < 256; p += G) {
                const int bh = p >> 5, s = p & 31, b = bh >> 2, h = bh & 3;
                if (h != cur_h) {
                    __syncthreads();
                    const float* bd = (const float*)(ws + WS_BIASD) + h * BIAS_TAB;
                    for (int i = tid; i < BIAS_TAB; i += NWAVES * 64) ((LAS float*)(lds + da::LDS_BIAS))[i] = bd[i];
                    __syncthreads(); cur_h = h;
                }
                const float c31 = args.in[I_RELB][31 * 16 + h] * LOG2E;
                for (int k2 = 0; k2 < 2; ++k2) da::unit(X, b, h, k2 ? 63 - s : s, lds, bx, lam, c31);
            }
        }
#endif
#ifndef NO_DIL
        {
            const dil::Tensors X{(const bf16*)(ws + WS_LQ), (const bf16*)(ws + WS_LK), (const bf16*)(ws + WS_LV), (bf16*)(ws + WS_YB)};
            int cur_h = -1;
            for (int u = vcu; u < 256; u += G) {
                const int bh = u >> 5, blk = u & 31, b = bh >> 2, h = bh & 3;
                if (h != cur_h) {
                    __syncthreads();
                    const float* blsrc = (const float*)(ws + WS_BIASL);
                    for (int i = tid; i < 3 * dil::BT; i += NWAVES * 64) { const int g = i / dil::BT, jj = i % dil::BT - dil::BT0;
                        ((LAS float*)(lds + dil::LDS_BL))[i] = (jj >= 0 && jj <= 128) ? blsrc[(g * 4 + h) * 132 + jj] : 0.f; }
                    __syncthreads(); cur_h = h;
                }
                for (int k2 = 0; k2 < 2; ++k2) dil::wave_tile(X, b, h, blk * 512, wave + 8 * k2, lds + dil::LDS_VST + wave * 4096, (const LAS float*)(lds + dil::LDS_BL), lane);
            }
            __syncthreads();
        }
#endif
        SEAM(2);
    }

    if (IN(3)) {
        { pg8::Gemm g{(const pg8::bf16_t*)(ws + WS_YA), (const pg8::bf16_t*)(ws + WS_WBD), T, D, 512}; pg8::StaticOrder S; S.init(T, D, G, bx);
          pg8::EpiGate1 E{(const pg8::bf16_t*)(ws + WS_GA), (pg8::bf16_t*)(ws + WS_GATED)};
          pg8::gemm_phase<pg8::EpiGate1, pg8::StaticOrder, true, true>(lds, g, S, E); }
        VM_WAIT(); __syncthreads();
        { pg8::Gemm g{(const pg8::bf16_t*)(ws + WS_YB), (const pg8::bf16_t*)(ws + WS_WBL), T, D, 256}; pg8::StaticOrder S; S.init(T, D, G, bx);
          pg8::EpiGate2 E{(const pg8::bf16_t*)(ws + WS_GB), (pg8::bf16_t*)(ws + WS_GATED)};
          pg8::gemm_phase<pg8::EpiGate2, pg8::StaticOrder, true, true>(lds, g, S, E); }
        SEAM(3);
    }

    if (IN(4)) {
        pg8::Gemm g{(const pg8::bf16_t*)(ws + WS_GATED), (const pg8::bf16_t*)(ws + WS_WO), T, D, D}; pg8::StaticOrder S; S.init(T, D, G, bx);
        pg8::EpiOut E{args.in[I_X], (float*)(ws + WS_R)};
        pg8::gemm_phase<pg8::EpiOut, pg8::StaticOrder, true, true>(lds, g, S, E);
        SEAM(4);
    }

    if (IN(5)) { p5_ln1(args, vcu, G, wave, lane); SEAM(5); }

    if (IN(6)) {
        pg8::Gemm g{(const pg8::bf16_t*)(ws + WS_WP), (const pg8::bf16_t*)(ws + WS_A), 2048, T, D}; pg8::StaticOrder S; S.init(2048, T, G, bx);
        pg8::EpiScoreT E{(float*)(ws + WS_ST)};
        pg8::gemm_phase<pg8::EpiScoreT, pg8::StaticOrder, true, true>(lds, g, S, E);
        SEAM(6);
    }

    if (IN(7)) {
        const float* ST = (const float*)(ws + WS_ST); v2u* sel = (v2u*)(ws + WS_SEL);
        for (int u = vcu; u < T / 128; u += G) {
            for (int p = 0; p < 2; ++p) peer::select(ST, sel, u * 128 + p * 64 + lane, wave);
            VM_WAIT(); __syncthreads();
            for (int i = 0; i < 16; ++i) peer::gather_token(sel, (const bf16*)(ws + WS_UU), (const bf16*)(ws + WS_UV), args.out, args.in[I_LN2G], args.in[I_LN2B], u * 128 + wave * 16 + i, lane);
            VM_WAIT(); __syncthreads();
        }
    }
#undef IN
#undef SEAM
}

extern "C" void kernel_launch(void* const* d_in, const int* in_sizes, int n_in, void* d_out, int out_size, void* d_ws, size_t ws_size, hipStream_t stream) {
    static int grid = 0;
    if (grid == 0) {
        if (n_in != 16 || in_sizes[0] != T * D || out_size != T * D || ws_size < WS_END) { fprintf(stderr, "kernel_launch: unexpected shapes (n_in %d, in0 %d, out %d, ws %zu); nothing launched\n", n_in, n_in > 0 ? in_sizes[0] : -1, out_size, ws_size); grid = -1; return; }
        int dev = 0, cus = 0, per_cu = 0;
        if (hipGetDevice(&dev) != hipSuccess || hipDeviceGetAttribute(&cus, hipDeviceAttributeMultiprocessorCount, dev) != hipSuccess) { grid = -1; return; }
        if (hipFuncSetAttribute((const void*)mk_fwd, hipFuncAttributeMaxDynamicSharedMemorySize, LDS_BYTES) != hipSuccess) { fprintf(stderr, "kernel_launch: hipFuncSetAttribute failed\n"); grid = -1; return; }
        if (hipOccupancyMaxActiveBlocksPerMultiprocessor(&per_cu, (const void*)mk_fwd, NWAVES * 64, LDS_BYTES) != hipSuccess || per_cu < 1) { fprintf(stderr, "kernel_launch: occupancy query reports %d\n", per_cu); per_cu = 1; }
        (void)hipGetLastError();
        grid = cus;
    }
    if (grid < 0) return;
    if (hipMemsetAsync((char*)d_ws + WS_CTL, 0, CTL_ZERO_BYTES, stream) != hipSuccess) return;
    Args a{};
    for (int i = 0; i < 16; ++i) a.in[i] = (const float*)d_in[i];
    a.out = (float*)d_out; a.ws = (unsigned char*)d_ws;
    for (int li = 0; li < MK_N_LAUNCHES; ++li) {
        a.ph_lo = (MK_N_LAUNCHES == 1) ? 0 : li; a.ph_hi = (MK_N_LAUNCHES == 1) ? NPH : li + 1;
        hipLaunchKernelGGL(mk_fwd, dim3(grid), dim3(NWAVES * 64), LDS_BYTES, stream, a);
    }
}
```

```cpp
#include <hip/hip_runtime.h>
#include <cstdio>
#include <cstdint>

#ifndef MK_N_LAUNCHES
#define MK_N_LAUNCHES 1
#endif

#ifndef REPEAT_PH
#define REPEAT_PH (-1)
#endif
#define NREP(k) ((REPEAT_PH) == (k) ? 2 : 1)

constexpr int BATCH = 2, SEQ = 16384, T = BATCH * SEQ, D = 1024, INC = 5888;
constexpr int OFF_DQ = 0, OFF_DK = 512, OFF_DV = 1024, OFF_LQ = 1536, OFF_LK = 2304, OFF_LV = 3072, OFF_GA = 3840, OFF_GB = 4864;
constexpr int NEXP = 16384;
constexpr float LOG2E = 1.4426950408889634f;
constexpr float QSCALE = 0.125f * LOG2E;
constexpr float ALPHA = 1.189207115002721f;
constexpr float LN_EPS = 1e-5f, SUBLN_EPS = 1e-5f;
constexpr float LAM_INIT = 0.2f;
constexpr int NTILE = SEQ / 64;
constexpr int BIAS_TAB = 2112, BIAS_GUARD = 256, DFAR = 1513;

constexpr size_t MiB = 1u << 20;
constexpr size_t WS_CTL = 0, CTL_ZERO_BYTES = 1 * MiB;
constexpr size_t WS_BIASD = 1 * MiB;
constexpr size_t WS_BIASL = 1 * MiB + 64 * 1024;
constexpr size_t WS_WIN = 8 * MiB, WS_WO = 20 * MiB, WS_WBD = 22 * MiB, WS_WBL = 23 * MiB, WS_WP = 24 * MiB;
constexpr size_t WS_A = 32 * MiB;
constexpr size_t WS_YA = WS_A, WS_YB = WS_A + 32 * MiB;
constexpr size_t WS_QD = 96 * MiB, WS_KD = 128 * MiB, WS_VD = 160 * MiB, WS_LQ = 192 * MiB, WS_LK = 240 * MiB, WS_LV = 288 * MiB, WS_GA = 336 * MiB, WS_GB = 400 * MiB;
constexpr size_t WS_STASH = 464 * MiB;
constexpr size_t WS_SEL = 464 * MiB;
constexpr size_t WS_GATED = 96 * MiB;
constexpr size_t WS_R = 160 * MiB;
constexpr size_t WS_ST = 96 * MiB;
constexpr size_t WS_UU = 352 * MiB, WS_UV = 384 * MiB;
constexpr size_t WS_ISU = 2 * MiB, WS_ISV = 2 * MiB + 65536;
constexpr size_t WS_END = 512 * MiB;

constexpr int CW_BAR = 4096;
constexpr int NWAVES = 8;
constexpr int RING_BYTES = 131072, MISC_OFF = RING_BYTES + 320, LDS_BYTES = 147456;

#define GAS __attribute__((address_space(1)))
#define LAS __attribute__((address_space(3)))
typedef unsigned short bf16;
typedef unsigned v4u __attribute__((ext_vector_type(4)));
typedef unsigned v2u __attribute__((ext_vector_type(2)));
typedef float f32x4 __attribute__((ext_vector_type(4)));
typedef float f32x16 __attribute__((ext_vector_type(16)));
typedef short bf16x8 __attribute__((ext_vector_type(8)));
typedef short s16x4 __attribute__((ext_vector_type(4)));
typedef __bf16 bf16x2 __attribute__((ext_vector_type(2)));
typedef GAS unsigned gu32;
#define RLX_AGENT __ATOMIC_RELAXED, __HIP_MEMORY_SCOPE_AGENT
#define LDS_WAIT() asm volatile("s_waitcnt lgkmcnt(0)" ::: "memory")
#define VM_WAIT() asm volatile("s_waitcnt vmcnt(0)" ::: "memory")
__device__ __forceinline__ unsigned f2bf(float f) { unsigned u = __builtin_bit_cast(unsigned, f); return (u + 0x7fffu + ((u >> 16) & 1u)) >> 16; }
__device__ __forceinline__ unsigned pk2(float lo, float hi) { return f2bf(lo) | (f2bf(hi) << 16); }
typedef float f32x2_t __attribute__((ext_vector_type(2)));
__device__ __forceinline__ unsigned cvtpk(float lo, float hi) { f32x2_t v = {lo, hi}; bf16x2 b = __builtin_convertvector(v, bf16x2); return __builtin_bit_cast(unsigned, b); }
__device__ __forceinline__ float bf_lo(unsigned w) { return __builtin_bit_cast(float, w << 16); }
__device__ __forceinline__ float bf_hi(unsigned w) { return __builtin_bit_cast(float, w & 0xffff0000u); }
__device__ __forceinline__ float dot2bf(unsigned a, unsigned b, float acc) { return __builtin_amdgcn_fdot2_f32_bf16(__builtin_bit_cast(bf16x2, a), __builtin_bit_cast(bf16x2, b), acc, false); }
__device__ __forceinline__ float wave_sum(float v) {
#pragma unroll
    for (int o = 1; o < 64; o <<= 1) v += __shfl_xor(v, o);
    return v;
}
__device__ __forceinline__ float wave_max(float v) {
#pragma unroll
    for (int o = 1; o < 64; o <<= 1) v = fmaxf(v, __shfl_xor(v, o));
    return v;
}
__device__ __forceinline__ int rel_bucket(int n) {
    if (n < 16) return n < 0 ? 0 : n;
    return 16 + (n >= 22) + (n >= 30) + (n >= 40) + (n >= 54) + (n >= 73) + (n >= 99) + (n >= 134) + (n >= 182) + (n >= 246) + (n >= 332) + (n >= 450) + (n >= 609) + (n >= 825) + (n >= 1117) + (n >= 1513);
}
namespace pg8 {
#define PG8_LAS __attribute__((address_space(3)))
typedef unsigned short bf16_t;
typedef short bf16x8 __attribute__((ext_vector_type(8)));
typedef float f32x4 __attribute__((ext_vector_type(4)));
typedef unsigned u32x4 __attribute__((ext_vector_type(4)));
constexpr int BM = 256, BK = 64, HALF = 128, HTB = HALF * BK * 2  , STAGE_BYTES = 8 * HTB, NXCD = 8, WGM = 8;

__host__ __device__ __forceinline__ int lds_byte(int r, int c) { const int st = (r >> 4) * 2 + (c >> 5), rr = r & 15, cc = c & 31, ob = rr * 64 + cc * 2; return st * 1024 + (ob ^ (((ob >> 9) & 1) << 5)); }
__host__ __device__ __forceinline__ void stage_rc(int b, int& R, int& C) { const int st = b / 1024, sb = b % 1024, swz = sb ^ (((sb >> 9) & 1) << 5); R = (st >> 1) * 16 + swz / 64; C = (st & 1) * 32 + (swz % 64) / 2; }
__host__ __device__ __forceinline__ int perm32(int rho) { const int n = rho >> 4, i = rho & 15; return 8 * (i >> 2) + 4 * n + (i & 3); }

struct Unit { int pm, pn; };
struct Gemm { const bf16_t* A; const bf16_t* Bt; int M, N, K; };

struct StaticOrder {
    int nM, nN, nwg, G, c;
    __host__ __device__ void init(int M, int N, int G_, int c_) { nM = M / BM; nN = N / BM; nwg = nM * nN; G = G_; c = c_; }
    int rep = 1;
    __host__ __device__ bool next(int i0, Unit& u) const {
        const int i = i0 / rep;
        const long L = (long)i * G + c; if (L >= nwg) return false;
        int wgid = (int)L; { const int q = nwg / NXCD, r = nwg % NXCD, xcd = wgid % NXCD, off = wgid / NXCD; wgid = (xcd < r ? xcd * (q + 1) : r * (q + 1) + (xcd - r) * q) + off; }
        const int nig = WGM * nN, gid = wgid / nig, fm = gid * WGM, gsz = (nM - fm) < WGM ? (nM - fm) : WGM;
        u.pm = fm + ((wgid % nig) % gsz); u.pn = (wgid % nig) / gsz; return true;
    }
    __device__ __forceinline__ void a_ready(const Unit&) const {}
    __device__ __forceinline__ void done(const Unit&) const {}
};
__device__ __forceinline__ unsigned cvt_pk_bf16(float lo, float hi) { unsigned r; asm volatile("v_cvt_pk_bf16_f32 %0, %1, %2" : "=v"(r) : "v"(lo), "v"(hi)); return r; }
__device__ __forceinline__ u32x4 pack8(const f32x4 v0, const f32x4 v1) { u32x4 w; w.x = cvt_pk_bf16(v0[0], v0[1]); w.y = cvt_pk_bf16(v0[2], v0[3]); w.z = cvt_pk_bf16(v1[0], v1[1]); w.w = cvt_pk_bf16(v1[2], v1[3]); return w; }
__device__ __forceinline__ float blo(unsigned w) { return __builtin_bit_cast(float, w << 16); }
__device__ __forceinline__ float bhi(unsigned w) { return __builtin_bit_cast(float, w & 0xffff0000u); }
__device__ __forceinline__ float sigm(float v) { return __builtin_amdgcn_rcpf(1.f + __expf(-v)); }
template <class E> __device__ __forceinline__ void epi_loop(const E& e, const f32x4 (&acc)[2][2][4][2], const Unit& u, int wr, int wc, int fr, int fq) {
#pragma unroll
    for (int ai = 0; ai < 2; ++ai)
#pragma unroll
        for (int m = 0; m < 4; ++m) { const int row = u.pm * BM + ai * HALF + wr * 64 + m * 16 + fr;
#pragma unroll
            for (int bj = 0; bj < 2; ++bj) { const int col = u.pn * BM + bj * HALF + wc * 32 + 8 * fq; e.item(u.pn, row, col, acc[ai][bj][m][0], acc[ai][bj][m][1]); } }
}

struct EpiInProj {
    static constexpr bool PERM = true, AFTER_DRAIN = false;
    bf16_t *Qd, *Kd, *Vd, *LQ, *LK, *LV, *GA, *GB;
    __device__ __forceinline__ void operator()(const f32x4 (&acc)[2][2][4][2], const Unit& u, int wr, int wc, int fr, int fq) const { epi_loop(*this, acc, u, wr, wc, fr, fq); }
    __device__ __forceinline__ void item(int pn, int row, int col, f32x4 v0, f32x4 v1) const {
            const int b = row >> 14, s = row & 16383; bf16_t* dst;
            if (pn < 2) {
                const int h = col >> 7, c = (col >> 6) & 1, d = col & 63; v0 = v0 * 0.18033688011112042f; v1 = v1 * 0.18033688011112042f;
                dst = Qd + ((size_t)((b * 4 + h) * 2 + c) * 16384 + s) * 64 + d;
            } else if (pn < 4) {
                const int cc = col - 512, h = cc >> 7, c = (cc >> 6) & 1, d = cc & 63;
                dst = Kd + ((((size_t)((b * 4 + h) * 2 + c) * 256 + (s >> 6)) * 8 + (d >> 3)) * 64 + (s & 63)) * 8;
            } else if (pn < 6) {
                const int cc = col - 1024, h = cc >> 7, d = cc & 127;
                dst = Vd + ((size_t)(b * 4 + h) * 256 + (s >> 6)) * 8192 + ((d >> 5) * 4 + ((s & 63) >> 4)) * 512 + (s & 15) * 32 + (d & 31);
            } else if (pn < 9) {
                v0 = v0 * 0.18033688011112042f; v1 = v1 * 0.18033688011112042f; dst = LQ + (size_t)row * 768 + (col - 1536);
            } else if (pn < 12) { dst = LK + (size_t)row * 768 + (col - 2304);
            } else if (pn < 15) { dst = LV + (size_t)row * 768 + (col - 3072);
            } else {
#pragma unroll
                for (int i = 0; i < 4; ++i) { v0[i] = sigm(v0[i]); v1[i] = sigm(v1[i]); }
                dst = (pn < 19) ? GA + (size_t)row * 1024 + (col - 3840) : GB + (size_t)row * 1024 + (col - 4864);
            }
            *(u32x4*)dst = pack8(v0, v1);
        }
};
struct EpiGate1 {
    static constexpr bool PERM = true, AFTER_DRAIN = false;
    const bf16_t* GA; bf16_t* G;
    __device__ __forceinline__ void operator()(const f32x4 (&acc)[2][2][4][2], const Unit& u, int wr, int wc, int fr, int fq) const { epi_loop(*this, acc, u, wr, wc, fr, fq); }
    __device__ __forceinline__ void item(int pn, int row, int col, f32x4 v0, f32x4 v1) const {
            const size_t o = (size_t)row * 1024 + col; const u32x4 g = *(const u32x4*)(GA + o);
            v0[0] *= blo(g.x); v0[1] *= bhi(g.x); v0[2] *= blo(g.y); v0[3] *= bhi(g.y); v1[0] *= blo(g.z); v1[1] *= bhi(g.z); v1[2] *= blo(g.w); v1[3] *= bhi(g.w);
            *(u32x4*)(G + o) = pack8(v0, v1);
        }
};
struct EpiGate2 {
    static constexpr bool PERM = true, AFTER_DRAIN = false;
    const bf16_t* GB; bf16_t* G;
    __device__ __forceinline__ void operator()(const f32x4 (&acc)[2][2][4][2], const Unit& u, int wr, int wc, int fr, int fq) const { epi_loop(*this, acc, u, wr, wc, fr, fq); }
    __device__ __forceinline__ void item(int pn, int row, int col, f32x4 v0, f32x4 v1) const {
            const size_t o = (size_t)row * 1024 + col; const u32x4 g = *(const u32x4*)(GB + o); const u32x4 p = *(const u32x4*)(G + o);
            v0[0] = v0[0] * blo(g.x) + blo(p.x); v0[1] = v0[1] * bhi(g.x) + bhi(p.x); v0[2] = v0[2] * blo(g.y) + blo(p.y); v0[3] = v0[3] * bhi(g.y) + bhi(p.y);
            v1[0] = v1[0] * blo(g.z) + blo(p.z); v1[1] = v1[1] * bhi(g.z) + bhi(p.z); v1[2] = v1[2] * blo(g.w) + blo(p.w); v1[3] = v1[3] * bhi(g.w) + bhi(p.w);
            *(u32x4*)(G + o) = pack8(v0, v1);
        }
};
struct EpiOut {
    static constexpr bool PERM = true, AFTER_DRAIN = false;
    const float* X; float* R;
    __device__ __forceinline__ void operator()(const f32x4 (&acc)[2][2][4][2], const Unit& u, int wr, int wc, int fr, int fq) const { epi_loop(*this, acc, u, wr, wc, fr, fq); }
    __device__ __forceinline__ void item(int pn, int row, int col, f32x4 v0, f32x4 v1) const {
            const size_t o = (size_t)row * 1024 + col; const f32x4 x0 = *(const f32x4*)(X + o), x1 = *(const f32x4*)(X + o + 4);
            *(f32x4*)(R + o) = x0 * 1.189207115002721f + v0; *(f32x4*)(R + o + 4) = x1 * 1.189207115002721f + v1;
        }
};
struct EpiScoreT {
    static constexpr bool PERM = true, AFTER_DRAIN = false;
    float* ST;
    __device__ __forceinline__ void operator()(const f32x4 (&acc)[2][2][4][2], const Unit& u, int wr, int wc, int fr, int fq) const { epi_loop(*this, acc, u, wr, wc, fr, fq); }
    __device__ __forceinline__ void item(int pn, int row, int col, f32x4 v0, f32x4 v1) const { const size_t o = (size_t)row * 32768 + col; *(f32x4*)(ST + o) = v0; *(f32x4*)(ST + o + 4) = v1; }
};
template <class Epi, class Sched, bool ALIGN_EPI = false, bool SP2 = false>
__device__ __forceinline__ void gemm_phase(PG8_LAS unsigned char* lds, const Gemm g, const Sched& S, const Epi& E) {
    const int tid = threadIdx.x, wid = __builtin_amdgcn_readfirstlane(tid >> 6), lane = tid & 63, wr = wid >> 2, wc = wid & 3, fr = lane & 15, fq = lane >> 4;
    const int K = g.K, nt = K / BK;
    unsigned voffA[2], voffB[2];
#pragma unroll
    for (int i = 0; i < 2; ++i) { int R, C; stage_rc(tid * 16 + i * 8192, R, C); const int Rb = Epi::PERM ? ((R & ~31) + perm32(R & 31)) : R;
        voffA[i] = (unsigned)(R * K + C) * 2u; voffB[i] = (unsigned)(Rb * K + C) * 2u; }
    const size_t kstep = (size_t)(BK * 2);
    const size_t hstep = (size_t)HALF * K * 2;
    const size_t tstep = 2 * hstep;
    const unsigned ldsw = (unsigned)wid * 1024u;
    const int aoff = lds_byte(wr * 64 + fr, fq * 8), boff = lds_byte(wc * 32 + fr, fq * 8);
#define PG8_SA(b, h) (((b) * 2 + (h)) * HTB)
#define PG8_SB(b, h) ((4 + (b) * 2 + (h)) * HTB)
#define PG8_STAGE(bufoff, gbase, voff) do { _Pragma("unroll") for (int _i = 0; _i < 2; ++_i) \
        __builtin_amdgcn_global_load_lds((const unsigned*)((const char*)(gbase) + (voff)[_i]), (PG8_LAS unsigned*)(lds + (bufoff) + ldsw + _i * 8192), 16, 0, 0); } while (0)
#define PG8_LDA(dst, b, h) do { _Pragma("unroll") for (int m = 0; m < 4; ++m) _Pragma("unroll") for (int k = 0; k < 2; ++k) dst[m][k] = *(const PG8_LAS bf16x8*)(lds + PG8_SA(b, h) + aoff + m * 2048 + k * 1024); } while (0)
#define PG8_LDB(dst, b, h) do { _Pragma("unroll") for (int n = 0; n < 2; ++n) _Pragma("unroll") for (int k = 0; k < 2; ++k) dst[n][k] = *(const PG8_LAS bf16x8*)(lds + PG8_SB(b, h) + boff + n * 2048 + k * 1024); } while (0)
#define PG8_MMA(ai, bj, At, Bt) do { __builtin_amdgcn_s_setprio(1); _Pragma("unroll") for (int m = 0; m < 4; ++m) _Pragma("unroll") for (int n = 0; n < 2; ++n) _Pragma("unroll") for (int k = 0; k < 2; ++k) \
        acc[ai][bj][m][n] = __builtin_amdgcn_mfma_f32_16x16x32_bf16(Bt[n][k], At[m][k], acc[ai][bj][m][n], 0, 0, 0); __builtin_amdgcn_s_setprio(0); } while (0)
#define PG8_WAIT_V(n) asm volatile("s_waitcnt vmcnt(" #n ")" ::: "memory")
#define PG8_WAIT_L(n) asm volatile("s_waitcnt lgkmcnt(" #n ")" ::: "memory")
#define PG8_BAR __builtin_amdgcn_s_barrier()
#define PG8_SCHED __builtin_amdgcn_sched_barrier(0)
    Unit cur, nxt; int ui = 0;
    if (!S.next(0, cur)) return;
    f32x4 acc[2][2][4][2];
#pragma unroll
    for (int a = 0; a < 2; ++a)
#pragma unroll
        for (int b = 0; b < 2; ++b)
#pragma unroll
            for (int m = 0; m < 4; ++m)
#pragma unroll
                for (int n = 0; n < 2; ++n) acc[a][b][m][n] = (f32x4){0.f, 0.f, 0.f, 0.f};
    bf16x8 At[4][2], B0[2][2], B1[2][2];
    const char* cA = (const char*)g.A + (size_t)cur.pm * tstep; const char* cB = (const char*)g.Bt + (size_t)cur.pn * tstep;
    S.a_ready(cur);
    if constexpr (SP2) {
        PG8_STAGE(PG8_SB(0, 0), cB, voffB); PG8_STAGE(PG8_SB(0, 1), cB + hstep, voffB); PG8_STAGE(PG8_SA(0, 0), cA, voffA); PG8_STAGE(PG8_SA(0, 1), cA + hstep, voffA);
        if (wr == 1) PG8_BAR;
        PG8_WAIT_V(2); PG8_BAR;
        PG8_STAGE(PG8_SB(1, 0), cB + kstep, voffB); PG8_STAGE(PG8_SA(1, 0), cA + kstep, voffA); PG8_STAGE(PG8_SB(1, 1), cB + hstep + kstep, voffB);
        PG8_WAIT_V(6); PG8_BAR;
    } else {
        PG8_STAGE(PG8_SB(0, 0), cB, voffB); PG8_STAGE(PG8_SA(0, 0), cA, voffA); PG8_STAGE(PG8_SB(0, 1), cB + hstep, voffB); PG8_STAGE(PG8_SA(0, 1), cA + hstep, voffA);
        if (wr == 1) PG8_BAR;
        PG8_WAIT_V(4); PG8_BAR;
        PG8_STAGE(PG8_SB(1, 0), cB + kstep, voffB); PG8_STAGE(PG8_SA(1, 0), cA + kstep, voffA); PG8_STAGE(PG8_SB(1, 1), cB + hstep + kstep, voffB);
        PG8_WAIT_V(6); PG8_BAR;
    }
    for (;;) {
        const bool has_next = S.next(ui + 1, nxt);
        const char* nA = has_next ? (const char*)g.A + (size_t)nxt.pm * tstep : cA; const char* nB = has_next ? (const char*)g.Bt + (size_t)nxt.pn * tstep : cB;
        for (int t = 0; t < nt; t += 2) {
            const bool last = (t == nt - 2);
            const char* a1 = cA + (size_t)(t + 1) * kstep;
            const char* a2 = last ? nA : cA + (size_t)(t + 2) * kstep; const char* b2 = last ? nB : cB + (size_t)(t + 2) * kstep;
            const char* a3 = a2 + kstep; const char* b3 = b2 + kstep;
            if (last && has_next) S.a_ready(nxt);
            if constexpr (SP2) {
            PG8_LDB(B0, 0, 0); PG8_LDB(B1, 0, 1); PG8_SCHED; PG8_LDA(At, 0, 0); PG8_STAGE(PG8_SA(1, 1), a1 + hstep, voffA);
            PG8_WAIT_V(8); PG8_WAIT_L(0); PG8_BAR; PG8_MMA(0, 0, At, B0); PG8_MMA(0, 1, At, B1); PG8_BAR; PG8_SCHED;
            PG8_LDA(At, 0, 1); PG8_STAGE(PG8_SB(0, 0), b2, voffB); PG8_STAGE(PG8_SB(0, 1), b2 + hstep, voffB); PG8_STAGE(PG8_SA(0, 0), a2, voffA);
            PG8_WAIT_V(8); PG8_WAIT_L(0); PG8_BAR; PG8_MMA(1, 0, At, B0); PG8_MMA(1, 1, At, B1); PG8_BAR; PG8_SCHED;
            PG8_LDB(B0, 1, 0); PG8_LDB(B1, 1, 1); PG8_SCHED; PG8_LDA(At, 1, 0); PG8_STAGE(PG8_SA(0, 1), a2 + hstep, voffA);
            PG8_WAIT_V(8); PG8_WAIT_L(0); PG8_BAR; PG8_MMA(0, 0, At, B0); PG8_MMA(0, 1, At, B1); PG8_BAR; PG8_SCHED;
            PG8_LDA(At, 1, 1); PG8_STAGE(PG8_SB(1, 0), b3, voffB); PG8_STAGE(PG8_SB(1, 1), b3 + hstep, voffB); PG8_STAGE(PG8_SA(1, 0), a3, voffA);
            PG8_WAIT_V(8); PG8_WAIT_L(0); PG8_BAR; PG8_MMA(1, 0, At, B0); PG8_MMA(1, 1, At, B1); PG8_BAR; PG8_SCHED;
            } else {
            PG8_LDB(B0, 0, 0); PG8_SCHED; PG8_LDA(At, 0, 0); PG8_STAGE(PG8_SA(1, 1), a1 + hstep, voffA);
            PG8_WAIT_L(8); PG8_BAR; PG8_WAIT_L(0); PG8_MMA(0, 0, At, B0); PG8_BAR; PG8_SCHED;
            PG8_LDB(B1, 0, 1); PG8_STAGE(PG8_SB(0, 0), b2, voffB);
            PG8_BAR; PG8_WAIT_L(0); PG8_MMA(0, 1, At, B1); PG8_BAR;
            PG8_LDA(At, 0, 1); PG8_STAGE(PG8_SA(0, 0), a2, voffA);
            PG8_BAR; PG8_WAIT_L(0); PG8_MMA(1, 0, At, B0); PG8_BAR; PG8_SCHED;
            PG8_STAGE(PG8_SB(0, 1), b2 + hstep, voffB);
            PG8_WAIT_V(6); PG8_BAR; PG8_MMA(1, 1, At, B1); PG8_BAR;
            PG8_LDB(B0, 1, 0); PG8_SCHED; PG8_LDA(At, 1, 0); PG8_STAGE(PG8_SA(0, 1), a2 + hstep, voffA);
            PG8_WAIT_L(8); PG8_BAR; PG8_WAIT_L(0); PG8_MMA(0, 0, At, B0); PG8_BAR; PG8_SCHED;
            PG8_LDB(B1, 1, 1); PG8_STAGE(PG8_SB(1, 0), b3, voffB);
            PG8_BAR; PG8_WAIT_L(0); PG8_MMA(0, 1, At, B1); PG8_BAR;
            PG8_LDA(At, 1, 1); PG8_STAGE(PG8_SA(1, 0), a3, voffA);
            PG8_BAR; PG8_WAIT_L(0); PG8_MMA(1, 0, At, B0); PG8_BAR; PG8_SCHED;
            PG8_STAGE(PG8_SB(1, 1), b3 + hstep, voffB);
            PG8_WAIT_V(6); PG8_BAR; PG8_MMA(1, 1, At, B1); PG8_BAR;
            }
        }
        if constexpr (ALIGN_EPI) { if (wr == 0) PG8_BAR; }
        if constexpr (!Epi::AFTER_DRAIN) { E(acc, cur, wr, wc, fr, fq); S.done(cur); }
        if (!has_next) break;
#pragma unroll
        for (int a = 0; a < 2; ++a)
#pragma unroll
            for (int b = 0; b < 2; ++b)
#pragma unroll
                for (int m = 0; m < 4; ++m)
#pragma unroll
                    for (int n = 0; n < 2; ++n) acc[a][b][m][n] = (f32x4){0.f, 0.f, 0.f, 0.f};
        cur = nxt; cA = nA; cB = nB; ++ui;
        if constexpr (ALIGN_EPI) { if (wr == 1) PG8_BAR; }
    }
    PG8_WAIT_V(0);
    if constexpr (!ALIGN_EPI) { if (wr == 0) PG8_BAR; }
    PG8_BAR;
    if constexpr (Epi::AFTER_DRAIN) { E.fused(acc, cur, wr, wc, fr, fq, lds, wid, lane); S.done(cur); }
#undef PG8_SA
#undef PG8_SB
#undef PG8_STAGE
#undef PG8_LDA
#undef PG8_LDB
#undef PG8_MMA
#undef PG8_WAIT_V
#undef PG8_WAIT_L
#undef PG8_BAR
#undef PG8_SCHED
}
}
#define XB_TMO      128
#define XB_XCNT(j)  (256  + 64 * (j))
#define XB_XSUB(j)  (1280 + 64 * (j))
#define XB_XGEN(j)  (2304 + 64 * (j))
#define XB_TOP      3328
#define XB_TOPGEN   3392
#define XCD_BAR_WORDS 3456
#define XB_SPIN_CAP (1u << 18)

__device__ __forceinline__ unsigned xb_ld(unsigned* p)              { return __hip_atomic_load(p, __ATOMIC_RELAXED, __HIP_MEMORY_SCOPE_AGENT); }
__device__ __forceinline__ unsigned xb_add(unsigned* p, unsigned v) { return __hip_atomic_fetch_add(p, v, __ATOMIC_RELAXED, __HIP_MEMORY_SCOPE_AGENT); }
__device__ __forceinline__ unsigned xb_xcc_id() { return (unsigned)__builtin_amdgcn_s_getreg((3 << 11) | 20) & 0xFu; }
#define XB_SPIN(cond, bar) do { unsigned _sp = 0; while (cond) { __builtin_amdgcn_s_sleep(1); \
    if ((++_sp & 255u) == 0u) { if (xb_ld(&(bar)[XB_TMO])) break; if (_sp > XB_SPIN_CAP) { atomicAdd(&(bar)[XB_TMO], 1u); break; } } } } while (0)

struct XcdBarrier {
    unsigned* bar; unsigned x;
    volatile LAS unsigned* st;
};

__device__ __forceinline__ XcdBarrier xcd_barrier_post(unsigned* bar, volatile LAS unsigned* st) {
    XcdBarrier b; b.bar = bar; b.x = xb_xcc_id(); b.st = st;
    if (threadIdx.x == 0) (void)xb_add(&bar[XB_XCNT(b.x)], 1u);
    return b;
}
__device__ __forceinline__ void xcd_barrier_complete(unsigned* bar, unsigned x, unsigned& nloc, unsigned& nx) {
    const unsigned G = gridDim.x * gridDim.y * gridDim.z;
    unsigned sum, cnt, mine, sp = 0u;
    for (;;) {
        sum = 0u; cnt = 0u; mine = 0u;
#pragma unroll
        for (unsigned j = 0; j < 16; ++j) { const unsigned c = xb_ld(&bar[XB_XCNT(j)]); sum += c; cnt += (c > 0u) ? 1u : 0u; mine = (j == x) ? c : mine; }
        if (sum == G) break;
        __builtin_amdgcn_s_sleep(1);
        if ((++sp & 255u) == 0u) { if (xb_ld(&bar[XB_TMO])) break; if (sp > XB_SPIN_CAP) { atomicAdd(&bar[XB_TMO], 1u); break; } }
    }
    nloc = mine > 0u ? mine : 1u; nx = cnt > 0u ? cnt : 1u;
}

__device__ __forceinline__ void xcd_barrier(const XcdBarrier& b) {
    asm volatile("s_waitcnt vmcnt(0)" ::: "memory");
    __syncthreads();
    if (threadIdx.x == 0) {
        unsigned* bar = b.bar;
        __builtin_amdgcn_s_waitcnt(0);
        unsigned nloc = b.st[0], nx = b.st[1];
        if (nloc == 0u) { xcd_barrier_complete(bar, b.x, nloc, nx); b.st[0] = nloc; b.st[1] = nx; }
        const unsigned old = xb_add(&bar[XB_XSUB(b.x)], 1u);
        const unsigned gen = old / nloc;
        if (old + 1u == (gen + 1u) * nloc) {
            __builtin_amdgcn_fence(__ATOMIC_RELEASE, "agent");
            asm volatile("s_waitcnt vmcnt(0)" ::: "memory");
            const unsigned og = xb_add(&bar[XB_TOP], 1u);
            const unsigned tg = og / nx;
            if (og + 1u == (tg + 1u) * nx) xb_add(&bar[XB_TOPGEN], 1u);
            else XB_SPIN(xb_ld(&bar[XB_TOPGEN]) == tg, bar);
            __builtin_amdgcn_fence(__ATOMIC_ACQUIRE, "agent");
            xb_add(&bar[XB_XGEN(b.x)], 1u);
            asm volatile("s_waitcnt vmcnt(0)" ::: "memory");
        } else {
            XB_SPIN(xb_ld(&bar[XB_XGEN(b.x)]) == gen, bar);
            __builtin_amdgcn_fence(__ATOMIC_ACQUIRE, "agent");
            asm volatile("s_waitcnt vmcnt(0)" ::: "memory");
        }
    }
    __syncthreads();
}
namespace da {
constexpr int SLOT_K = 8192, SLOT_V = 16384, SLOT = SLOT_K + SLOT_V;
constexpr int LDS_BIAS = 2 * SLOT;
constexpr int LDS_END = LDS_BIAS + BIAS_TAB * 4;
constexpr float THR = 8.f;
__device__ __forceinline__ int crow(int r, int hi) { return (r & 3) + 8 * (r >> 2) + 4 * hi; }
__device__ __forceinline__ void glds16(const void* gbase  , unsigned voff  , unsigned lds_dst) { unsigned keep;
    asm volatile("s_mov_b32 %0, m0\n\ts_mov_b32 m0, %3\n\ts_nop 0\n\tglobal_load_lds_dwordx4 %1, %2\n\ts_mov_b32 m0, %0" : "=&s"(keep) : "v"(voff), "s"(gbase), "s"(lds_dst) : "memory"); }
typedef short v4i16_t __attribute__((ext_vector_type(4)));
__device__ __forceinline__ s16x4 vtr(const LAS char* p) { return __builtin_bit_cast(s16x4, __builtin_amdgcn_ds_read_tr16_b64_v4i16((LAS v4i16_t*)p)); }
#define DA_WAIT_BAR() asm volatile("s_waitcnt vmcnt(0) lgkmcnt(0)\n\ts_barrier" ::: "memory")

struct Tensors { const bf16* Qd; const bf16* Kd; const bf16* Vd; float* stash; bf16* ya; const float* dlam; const float* subg; const float* relb; };

__device__ __forceinline__ void unit(const Tensors& X, int b, int h, int qb, LAS unsigned char* lds, int wgslot, float lam, float c31) {
    const int tid = threadIdx.x, lane = tid & 63, r32 = lane & 31, hi = lane >> 5; const int wid = __builtin_amdgcn_readfirstlane(tid >> 6);
    const int q0 = qb * 256, NT = 4 * (qb + 1);
    const unsigned lds0 = (unsigned)(uintptr_t)lds;
    const LAS float* tb = (const LAS float*)(lds + LDS_BIAS);
    const unsigned lane16 = (unsigned)lane * 16u;
    const int qabs = q0 + wid * 32 + r32;
    const LAS char* vp0 = (const LAS char*)lds + SLOT_K + ((lane >> 4) & 1) * 32 + (lane & 3) * 8 + (4 * hi + ((lane & 15) >> 2)) * 64;
    const LAS char* kp0 = (const LAS char*)lds + hi * 1024 + r32 * 16;
    for (int c = 0; c < 2; ++c) {
        const int bhc = (b * 4 + h) * 2 + c;
        const bf16* Qw = X.Qd + ((size_t)bhc * SEQ + q0 + wid * 32 + r32) * 64 + hi * 8;
        const char* Kt = (const char*)X.Kd + (size_t)bhc * NTILE * SLOT_K + wid * 1024;
        const char* Vt = (const char*)X.Vd + (size_t)(b * 4 + h) * NTILE * SLOT_V + wid * 1024;
#define DA_DMA(t, slot) do { const unsigned sb_ = (unsigned)__builtin_amdgcn_readfirstlane(lds0 + (slot) * SLOT + wid * 1024); \
        glds16(Kt + (size_t)(t) * SLOT_K, lane16, sb_); glds16(Vt + (size_t)(t) * SLOT_V, lane16, sb_ + SLOT_K); glds16(Vt + (size_t)(t) * SLOT_V + 8192, lane16, sb_ + SLOT_K + 8192); } while (0)
        DA_DMA(0, 0);
        bf16x8 qr[4];
#pragma unroll
        for (int d0 = 0; d0 < 4; ++d0) qr[d0] = *(const bf16x8*)(Qw + d0 * 16);
        f32x16 o[4];
#pragma unroll
        for (int d0 = 0; d0 < 4; ++d0)
#pragma unroll
            for (int r = 0; r < 16; ++r) o[d0][r] = 0.f;
        float m = -1e30f, l = 0.f;
        for (int t = 0; t < NT; ++t) {
            DA_WAIT_BAR();
            if (t + 1 < NT) DA_DMA(t + 1, (t + 1) & 1);
            const int sl = (t & 1) * SLOT;
            const bool nearb = (q0 - 64 * t - 63) < DFAR;
            const int base = qabs - 64 * t - 4 * hi + BIAS_GUARD;
            f32x16 p0, p1;
            if (nearb) {
#pragma unroll
                for (int r = 0; r < 16; ++r) { const int o_ = (r & 3) + 8 * (r >> 2); p0[r] = tb[base - o_]; p1[r] = tb[base - o_ - 32]; }
            } else {
#pragma unroll
                for (int r = 0; r < 16; ++r) { p0[r] = 0.f; p1[r] = 0.f; }
            }
            const float cadd = nearb ? 0.f : c31;
            {
                const LAS char* kb = kp0 + sl;
#pragma unroll
                for (int d0 = 0; d0 < 4; ++d0) {
                    const bf16x8 k0 = *(const LAS bf16x8*)(kb + d0 * 2048), k1 = *(const LAS bf16x8*)(kb + d0 * 2048 + 512);
                    p0 = __builtin_amdgcn_mfma_f32_32x32x16_bf16(k0, qr[d0], p0, 0, 0, 0);
                    p1 = __builtin_amdgcn_mfma_f32_32x32x16_bf16(k1, qr[d0], p1, 0, 0, 0);
                }
            }
            if (t >= NT - 4) {
#pragma unroll
                for (int r = 0; r < 16; ++r) { const int o_ = (r & 3) + 8 * (r >> 2); if (base - o_ < BIAS_GUARD) p0[r] = -1e30f; if (base - o_ - 32 < BIAS_GUARD) p1[r] = -1e30f; }
            }
            float rm = fmaxf(p0[0], p1[0]);
#pragma unroll
            for (int r = 1; r < 16; ++r) rm = fmaxf(rm, fmaxf(p0[r], p1[r]));
            { auto rr = __builtin_amdgcn_permlane32_swap(__float_as_uint(rm), __float_as_uint(rm), false, false); rm = fmaxf(__uint_as_float(rr[0]), __uint_as_float(rr[1])); }
            rm += cadd;
            if (__any(rm > m + THR)) {
                const float mn = fmaxf(m, rm), f = __builtin_amdgcn_exp2f(m - mn);
#pragma unroll
                for (int d0 = 0; d0 < 4; ++d0)
#pragma unroll
                    for (int r = 0; r < 16; ++r) o[d0][r] *= f;
                l *= f; m = mn;
            }
            const float sub = cadd - m;
            float ls = 0.f;
#pragma unroll
            for (int r = 0; r < 16; ++r) { p0[r] = __builtin_amdgcn_exp2f(p0[r] + sub); p1[r] = __builtin_amdgcn_exp2f(p1[r] + sub); ls += p0[r] + p1[r]; }
            l += ls;
            bf16x8 pw[4];
            { v4u w;
              w.x = cvtpk(p0[0], p0[1]); w.y = cvtpk(p0[2], p0[3]); w.z = cvtpk(p0[4], p0[5]); w.w = cvtpk(p0[6], p0[7]); pw[0] = __builtin_bit_cast(bf16x8, w);
              w.x = cvtpk(p0[8], p0[9]); w.y = cvtpk(p0[10], p0[11]); w.z = cvtpk(p0[12], p0[13]); w.w = cvtpk(p0[14], p0[15]); pw[1] = __builtin_bit_cast(bf16x8, w);
              w.x = cvtpk(p1[0], p1[1]); w.y = cvtpk(p1[2], p1[3]); w.z = cvtpk(p1[4], p1[5]); w.w = cvtpk(p1[6], p1[7]); pw[2] = __builtin_bit_cast(bf16x8, w);
              w.x = cvtpk(p1[8], p1[9]); w.y = cvtpk(p1[10], p1[11]); w.z = cvtpk(p1[12], p1[13]); w.w = cvtpk(p1[14], p1[15]); pw[3] = __builtin_bit_cast(bf16x8, w); }
            const LAS char* vb = vp0 + sl;
#pragma unroll
            for (int d0 = 0; d0 < 4; ++d0) {
#pragma unroll
                for (int ks = 0; ks < 4; ++ks) {
                    const s16x4 lo = vtr(vb + d0 * 4096 + ks * 1024), hh = vtr(vb + d0 * 4096 + ks * 1024 + 512);
                    const bf16x8 vf = (bf16x8){lo[0], lo[1], lo[2], lo[3], hh[0], hh[1], hh[2], hh[3]};
                    o[d0] = __builtin_amdgcn_mfma_f32_32x32x16_bf16(vf, pw[ks], o[d0], 0, 0, 0);
                }
                if (d0 & 1) __builtin_amdgcn_sched_barrier(0);
            }
        }
#undef DA_DMA
        { auto rr = __builtin_amdgcn_permlane32_swap(__float_as_uint(l), __float_as_uint(l), false, false); l = __uint_as_float(rr[0]) + __uint_as_float(rr[1]); }
        const float inv = 1.f / l;
        float* st = X.stash + ((size_t)(wgslot * 8 + wid) * 64) * 64 + lane;
        asm volatile("" : "+v"(st)); GAS float* stg = (GAS float*)st;
        if (c == 0) {
#pragma unroll
            for (int d0 = 0; d0 < 4; ++d0)
#pragma unroll
                for (int r = 0; r < 16; ++r) stg[(d0 * 16 + r) * 64] = o[d0][r] * inv;
        } else {
            float ss = 0.f;
#pragma unroll
            for (int d0 = 0; d0 < 4; ++d0)
#pragma unroll
                for (int r = 0; r < 16; ++r) { const float dv = stg[(d0 * 16 + r) * 64] - lam * (o[d0][r] * inv); o[d0][r] = dv; ss += dv * dv; }
            { auto rr = __builtin_amdgcn_permlane32_swap(__float_as_uint(ss), __float_as_uint(ss), false, false); ss = __uint_as_float(rr[0]) + __uint_as_float(rr[1]); }
            const float rn = __builtin_amdgcn_rsqf(ss * (1.f / 128.f) + SUBLN_EPS) * (1.f - LAM_INIT);
            bf16* yrow = X.ya + ((size_t)b * SEQ + qabs) * 512 + h * 128 + 4 * hi; const float* sg = X.subg + 4 * hi;
            asm volatile("" : "+v"(yrow), "+v"(sg));
#pragma unroll
            for (int d0 = 0; d0 < 4; ++d0)
#pragma unroll
                for (int r4 = 0; r4 < 4; ++r4) {
                    const int dd = 32 * d0 + 8 * r4; const f32x4 g = *(const f32x4*)(sg + dd);
                    v2u w; w.x = pk2(o[d0][4 * r4] * rn * g[0], o[d0][4 * r4 + 1] * rn * g[1]); w.y = pk2(o[d0][4 * r4 + 2] * rn * g[2], o[d0][4 * r4 + 3] * rn * g[3]);
                    *(v2u*)(yrow + dd) = w;
                }
        }
    }
    asm volatile("s_waitcnt vmcnt(0) lgkmcnt(0)\n\ts_barrier" ::: "memory");
}
#undef DA_WAIT_BAR
}
namespace dil {
constexpr int BT = 1152, BT0 = 512;
constexpr int LDS_VST = 0, LDS_BL = 32768, LDS_END = LDS_BL + 3 * BT * 4;
constexpr float THR = 8.f;
struct Tensors { const bf16* LQ; const bf16* LK; const bf16* LV; bf16* yb; };
typedef short v4i16_t __attribute__((ext_vector_type(4)));
__device__ __forceinline__ s16x4 vtr(const LAS unsigned char* p) { return __builtin_bit_cast(s16x4, __builtin_amdgcn_ds_read_tr16_b64_v4i16((LAS v4i16_t*)p)); }

template <int G_> __device__ __forceinline__ void group(const Tensors& X, size_t rowb, int h, int P0, int r, LAS unsigned char* vst, const LAS float* blg, int lane, f32x16 (&o)[2], float& m, float& l) {
    constexpr int DL = (G_ == 0) ? 1 : (G_ == 1) ? 4 : 16, MG = 16 / DL, NKB = (G_ == 0) ? 20 : (G_ == 1) ? 8 : 5;
    const int i = lane & 31, hi = lane >> 5;
    const int colb = G_ * 256 + h * 64;
    bf16x8 qr[4];
    { const bf16* qp = X.LQ + (rowb + P0 + r + 16 * i) * 768 + colb + hi * 8;
#pragma unroll
      for (int d0 = 0; d0 < 4; ++d0) qr[d0] = *(const bf16x8*)(qp + 16 * d0); }
    const int kpos0 = P0 + r - 128 * DL;
    const LAS unsigned char* vrd = vst + ((lane >> 4) & 1) * 32 + (lane & 3) * 8 + (4 * hi + ((lane & 15) >> 2)) * 64;
    for (int kb = 0; kb < NKB; ++kb) {
        bf16x8 kf[4];
        { int kpos = kpos0 + (32 * kb + i) * DL; kpos = kpos < 0 ? 0 : (kpos > SEQ - 1 ? SEQ - 1 : kpos); const bf16* kp = X.LK + (rowb + kpos) * 768 + colb + hi * 8;
#pragma unroll
          for (int d0 = 0; d0 < 4; ++d0) kf[d0] = *(const bf16x8*)(kp + 16 * d0); }
        v4u vreg[4];
#pragma unroll
        for (int t = 0; t < 4; ++t) { const int qd = lane + 64 * t, key = qd >> 3, ch = qd & 7; int vpos = kpos0 + (32 * kb + key) * DL; vpos = vpos < 0 ? 0 : (vpos > SEQ - 1 ? SEQ - 1 : vpos);
            vreg[t] = *(const v4u*)(X.LV + (rowb + vpos) * 768 + colb + ch * 8); }
        const int jb = i * MG + 128 - 32 * kb - 4 * hi;
        f32x16 p;
#pragma unroll
        for (int rr = 0; rr < 16; ++rr) p[rr] = blg[jb - ((rr & 3) + 8 * (rr >> 2)) + BT0];
#pragma unroll
        for (int d0 = 0; d0 < 4; ++d0) p = __builtin_amdgcn_mfma_f32_32x32x16_bf16(kf[d0], qr[d0], p, 0, 0, 0);
        const int cb = 32 * kb + 4 * hi;
#pragma unroll
        for (int rr = 0; rr < 16; ++rr) { const int o_ = (rr & 3) + 8 * (rr >> 2); if ((unsigned)(jb - o_) > 128u || kpos0 + (cb + o_) * DL < 0) p[rr] = -3e38f; }
        float rm = p[0];
#pragma unroll
        for (int rr = 1; rr < 16; ++rr) rm = fmaxf(rm, p[rr]);
        { auto sw = __builtin_amdgcn_permlane32_swap(__float_as_uint(rm), __float_as_uint(rm), false, false); rm = fmaxf(__uint_as_float(sw[0]), __uint_as_float(sw[1])); }
        if (__any(rm > m + THR)) {
            const float mn = fmaxf(m, rm), f = __builtin_amdgcn_exp2f(m - mn);
#pragma unroll
            for (int d0 = 0; d0 < 2; ++d0)
#pragma unroll
                for (int rr = 0; rr < 16; ++rr) o[d0][rr] *= f;
            l *= f; m = mn;
        }
        float ls = 0.f;
#pragma unroll
        for (int rr = 0; rr < 16; ++rr) { p[rr] = __builtin_amdgcn_exp2f(p[rr] - m); ls += p[rr]; }
        l += ls;
        bf16x8 pw[2];
        { v4u w;
          w.x = cvtpk(p[0], p[1]); w.y = cvtpk(p[2], p[3]); w.z = cvtpk(p[4], p[5]); w.w = cvtpk(p[6], p[7]); pw[0] = __builtin_bit_cast(bf16x8, w);
          w.x = cvtpk(p[8], p[9]); w.y = cvtpk(p[10], p[11]); w.z = cvtpk(p[12], p[13]); w.w = cvtpk(p[14], p[15]); pw[1] = __builtin_bit_cast(bf16x8, w); }
#pragma unroll
        for (int t = 0; t < 4; ++t) { const int qd = lane + 64 * t, key = qd >> 3, ch = qd & 7;
            *(LAS v4u*)(vst + ((ch >> 2) * 2 + (key >> 4)) * 1024 + (key & 15) * 64 + (ch & 3) * 16) = vreg[t]; }
        asm volatile("s_waitcnt lgkmcnt(0)" ::: "memory");
#pragma unroll
        for (int d0 = 0; d0 < 2; ++d0)
#pragma unroll
            for (int ks = 0; ks < 2; ++ks) {
                const s16x4 lo = vtr(vrd + (d0 * 2 + ks) * 1024), hh = vtr(vrd + (d0 * 2 + ks) * 1024 + 512);
                const bf16x8 vf = (bf16x8){lo[0], lo[1], lo[2], lo[3], hh[0], hh[1], hh[2], hh[3]};
                o[d0] = __builtin_amdgcn_mfma_f32_32x32x16_bf16(vf, pw[ks], o[d0], 0, 0, 0);
            }
        asm volatile("s_waitcnt lgkmcnt(0)" ::: "memory");
    }
}
__device__ __forceinline__ void wave_tile(const Tensors& X, int b, int h, int P0, int r, LAS unsigned char* vst, const LAS float* bl, int lane) {
    const size_t rowb = (size_t)b * SEQ;
    f32x16 o[2];
#pragma unroll
    for (int d0 = 0; d0 < 2; ++d0)
#pragma unroll
        for (int rr = 0; rr < 16; ++rr) o[d0][rr] = 0.f;
    float m = -1e30f, l = 0.f;
    group<0>(X, rowb, h, P0, r, vst, bl, lane, o, m, l);
    group<1>(X, rowb, h, P0, r, vst, bl + BT, lane, o, m, l);
    group<2>(X, rowb, h, P0, r, vst, bl + 2 * BT, lane, o, m, l);
    { auto sw = __builtin_amdgcn_permlane32_swap(__float_as_uint(l), __float_as_uint(l), false, false); l = __uint_as_float(sw[0]) + __uint_as_float(sw[1]); }
    const float inv = 1.f / l; const int i = lane & 31, hi = lane >> 5;
    bf16* yrow = X.yb + (rowb + P0 + r + 16 * i) * 256 + h * 64 + 4 * hi;
#pragma unroll
    for (int d0 = 0; d0 < 2; ++d0)
#pragma unroll
        for (int r4 = 0; r4 < 4; ++r4) { v2u w; w.x = pk2(o[d0][4 * r4] * inv, o[d0][4 * r4 + 1] * inv); w.y = pk2(o[d0][4 * r4 + 2] * inv, o[d0][4 * r4 + 3] * inv); *(v2u*)(yrow + 32 * d0 + 8 * r4) = w; }
}
}
__device__ __forceinline__ void p0_transpose_item(const float* W, int K, int N, bf16* WT, LAS float* scr, int item, int lane) {
    const int nblk = N / 32, kb = item / nblk, nb = item % nblk, k0 = 64 * kb, n0 = 32 * nb;
#pragma unroll 8
    for (int i = 0; i < 32; ++i) { const int kk = 2 * i + (lane >> 5); scr[kk * 33 + (lane & 31)] = W[(size_t)(k0 + kk) * N + n0 + (lane & 31)]; }
    LDS_WAIT(); asm volatile("" ::: "memory");
    const int c = lane & 7;
#pragma unroll
    for (int j = 0; j < 4; ++j) { const int n = (lane >> 3) + 8 * j; const LAS float* s = scr + (8 * c) * 33 + n;
        v4u o; o.x = pk2(s[0 * 33], s[1 * 33]); o.y = pk2(s[2 * 33], s[3 * 33]); o.z = pk2(s[4 * 33], s[5 * 33]); o.w = pk2(s[6 * 33], s[7 * 33]);
        *(v4u*)(WT + (size_t)(n0 + n) * K + k0 + 8 * c) = o; }
    LDS_WAIT(); asm volatile("" ::: "memory");
}
__device__ __forceinline__ void cast_bf16(const float* src, bf16* dst, size_t n8, size_t gtid, size_t gthreads) {
    for (size_t i = gtid; i < n8; i += gthreads) { const f32x4 a = *(const f32x4*)(src + i * 8), b = *(const f32x4*)(src + i * 8 + 4);
        v4u o; o.x = pk2(a[0], a[1]); o.y = pk2(a[2], a[3]); o.z = pk2(b[0], b[1]); o.w = pk2(b[2], b[3]); *(v4u*)(dst + i * 8) = o; }
}

struct Args { const float* in[16]; float* out; unsigned char* ws; int ph_lo, ph_hi; };
enum { I_X = 0, I_WIN, I_DLAM, I_SUBG, I_WBD, I_WBL, I_WO, I_LN1G, I_LN1B, I_PWQ, I_PKEYS, I_PU, I_PV, I_LN2G, I_LN2B, I_RELB };

__device__ __forceinline__ void p0_prologue(const Args& A, LAS unsigned char* lds, int vcu, int G, int wave, int lane) {
    unsigned char* ws = A.ws;
    const int gw = vcu * NWAVES + wave, NGW = G * NWAVES;
    const size_t gtid = (size_t)gw * 64 + lane, gthreads = (size_t)NGW * 64;
    LAS float* scr = (LAS float*)(lds + wave * 16384);
    constexpr int I_IN = (D / 64) * (INC / 32), I_BD = (512 / 64) * (D / 32), I_BL = (256 / 64) * (D / 32), I_O = (D / 64) * (D / 32);
    for (int it = gw; it < I_IN + I_BD + I_BL + I_O; it += NGW) {
        int r = it;
        if (r < I_IN) { p0_transpose_item(A.in[I_WIN], D, INC, (bf16*)(ws + WS_WIN), scr, r, lane); continue; } r -= I_IN;
        if (r < I_BD) { p0_transpose_item(A.in[I_WBD], 512, D, (bf16*)(ws + WS_WBD), scr, r, lane); continue; } r -= I_BD;
        if (r < I_BL) { p0_transpose_item(A.in[I_WBL], 256, D, (bf16*)(ws + WS_WBL), scr, r, lane); continue; } r -= I_BL;
        p0_transpose_item(A.in[I_WO], D, D, (bf16*)(ws + WS_WO), scr, r, lane);
    }
    cast_bf16(A.in[I_X], (bf16*)(ws + WS_A), (size_t)T * D / 8, gtid, gthreads);
    { const float* wq = A.in[I_PWQ]; const float* keys = A.in[I_PKEYS]; bf16* wp = (bf16*)(ws + WS_WP);
      for (int it = gw; it < 2048 * 16; it += NGW) {
          const int row = it >> 4, jb = it & 15, hc = row >> 7, j = jb * 64 + lane;
          const float* wr_ = wq + (size_t)j * 2048 + hc * 128; const float* kr = keys + (size_t)row * 128;
          float a0 = 0.f, a1 = 0.f, a2 = 0.f, a3 = 0.f;
#pragma unroll 8
          for (int d = 0; d < 128; d += 4) { const f32x4 w = *(const f32x4*)(wr_ + d), k = *(const f32x4*)(kr + d); a0 += w[0] * k[0]; a1 += w[1] * k[1]; a2 += w[2] * k[2]; a3 += w[3] * k[3]; }
          wp[(size_t)row * 1024 + j] = (bf16)f2bf((a0 + a1) + (a2 + a3));
      } }
    { const float* relb = A.in[I_RELB]; float* bd = (float*)(ws + WS_BIASD); float* bl = (float*)(ws + WS_BIASL);
      for (size_t i = gtid; i < 4 * BIAS_TAB; i += gthreads) { const int h = (int)(i / BIAS_TAB), dist = (int)(i % BIAS_TAB) - BIAS_GUARD; bd[i] = dist < 0 ? 0.f : relb[rel_bucket(dist) * 16 + h] * LOG2E; }
      for (size_t i = gtid; i < 12 * 132; i += gthreads) { const int gh = (int)(i / 132), j = (int)(i % 132), g = gh >> 2; const int dl = (g == 0) ? 1 : (g == 1) ? 4 : 16;
          bl[i] = relb[rel_bucket((j > 128 ? 128 : j) * dl) * 16 + 4 + gh] * LOG2E; } }
}

__device__ __forceinline__ void p5_ln1(const Args& A, int vcu, int G, int wave, int lane) {
    unsigned char* ws = A.ws;
    const int gw = vcu * NWAVES + wave, NGW = G * NWAVES;
    const float* R = (const float*)(ws + WS_R); bf16* x1b = (bf16*)(ws + WS_A);
    const float* gam = A.in[I_LN1G]; const float* bet = A.in[I_LN1B];
    f32x4 gv[4], bv[4];
#pragma unroll
    for (int j = 0; j < 4; ++j) { gv[j] = *(const f32x4*)(gam + 256 * j + 4 * lane); bv[j] = *(const f32x4*)(bet + 256 * j + 4 * lane); }
    for (int mrow = gw; mrow < T; mrow += NGW) {
        const f32x4* xr = (const f32x4*)(R + (size_t)mrow * D) + lane;
        f32x4 v[4]; float s = 0.f;
#pragma unroll
        for (int j = 0; j < 4; ++j) { v[j] = xr[64 * j]; s += (v[j][0] + v[j][1]) + (v[j][2] + v[j][3]); }
        const float mean = wave_sum(s) * (1.f / D); float s2 = 0.f;
#pragma unroll
        for (int j = 0; j < 4; ++j) { v[j] = v[j] - mean; s2 += (v[j][0] * v[j][0] + v[j][1] * v[j][1]) + (v[j][2] * v[j][2] + v[j][3] * v[j][3]); }
        const float rstd = __builtin_amdgcn_rsqf(wave_sum(s2) * (1.f / D) + LN_EPS);
        f32x4* orow = (f32x4*)(A.out + (size_t)mrow * D) + lane; v2u* brow = (v2u*)(x1b + (size_t)mrow * D) + lane;
#pragma unroll
        for (int j = 0; j < 4; ++j) { const f32x4 y = v[j] * rstd * gv[j] + bv[j]; orow[64 * j] = y; v2u w; w.x = pk2(y[0], y[1]); w.y = pk2(y[2], y[3]); brow[64 * j] = w; }
    }
}
namespace peer {
__device__ __forceinline__ int mono(float v) { const int b = __float_as_int(v); return b ^ ((b >> 31) & 0x7fffffff); }
__device__ __forceinline__ float unmono(int k) { return __int_as_float(k ^ ((k >> 31) & 0x7fffffff)); }
__device__ __forceinline__ int med3i(int a, int b, int c) { int r; asm("v_med3_i32 %0, %1, %2, %3" : "=v"(r) : "v"(a), "v"(b), "v"(c)); return r; }
#define PEER_INS16(a, x) do { _Pragma("unroll") for (int k_ = 15; k_ >= 1; --k_) a[k_] = med3i(a[k_ - 1], a[k_], (x)); a[0] = max(a[0], (x)); } while (0)
__device__ __forceinline__ unsigned byte_sel(const unsigned (&p)[4], int i) { const int w = i >> 2; const unsigned x = (w == 0) ? p[0] : (w == 1) ? p[1] : (w == 2) ? p[2] : p[3]; return (x >> ((i & 3) * 8)) & 0xffu; }
__device__ __forceinline__ float gelu_erf(float v) { return 0.5f * v * (1.f + erff(v * 0.7071067811865476f)); }

__device__ __forceinline__ void select(const float* ST, v2u* sel, int tok, int head) {
    int a0[16], a1[16];
#pragma unroll
    for (int k = 0; k < 16; ++k) { a0[k] = (int)0x80000000; a1[k] = (int)0x80000000; }
    const float* s0 = ST + (size_t)(head * 256) * T + tok; const float* s1 = s0 + (size_t)128 * T;
#pragma unroll 8
    for (int n = 0; n < 128; ++n) { const int k = (mono(s0[(size_t)n * T]) & ~127) | (127 - n); PEER_INS16(a0, k); }
#pragma unroll 8
    for (int n = 0; n < 128; ++n) { const int k = (mono(s1[(size_t)n * T]) & ~127) | (127 - n); PEER_INS16(a1, k); }
    float v0[16], v1[16]; unsigned i0p[4] = {0u, 0u, 0u, 0u}, i1p[4] = {0u, 0u, 0u, 0u};
#pragma unroll
    for (int k = 0; k < 16; ++k) { v0[k] = unmono((a0[k] & ~127) | 64); v1[k] = unmono((a1[k] & ~127) | 64);
        i0p[k >> 2] |= (unsigned)(127 - (a0[k] & 127)) << (8 * (k & 3)); i1p[k >> 2] |= (unsigned)(127 - (a1[k] & 127)) << (8 * (k & 3)); }
    int cd[16];
#pragma unroll
    for (int k = 0; k < 16; ++k) cd[k] = (int)0x80000000;
#pragma unroll
    for (int i = 0; i < 16; ++i)
#pragma unroll
        for (int j = 0; j < 16; ++j)
            if ((i + 1) * (j + 1) <= 16) { const int k = (mono(v0[i] + v1[j]) & ~255) | (255 - (i * 16 + j)); PEER_INS16(cd, k); }
    float sv[16], ex[16], sum = 0.f; unsigned eid[16];
#pragma unroll
    for (int k = 0; k < 16; ++k) { const int code = 255 - (cd[k] & 255); eid[k] = byte_sel(i0p, code >> 4) * 128u + byte_sel(i1p, code & 15); sv[k] = unmono((cd[k] & ~255) | 128); }
#pragma unroll
    for (int k = 0; k < 16; ++k) { ex[k] = __expf(sv[k] - sv[0]); sum += ex[k]; }
    const float rs = 1.f / sum;
    v4u* dst = (v4u*)(sel + ((size_t)tok * 8 + head) * 16);
#pragma unroll
    for (int k = 0; k < 8; ++k) { v4u w; w.x = eid[2 * k]; w.y = __float_as_uint(ex[2 * k] * rs); w.z = eid[2 * k + 1]; w.w = __float_as_uint(ex[2 * k + 1] * rs); dst[k] = w; }
}

typedef float f32x2v __attribute__((ext_vector_type(2)));
__device__ __forceinline__ void gather_token(const v2u* sel, const unsigned char* U8, const unsigned char* V8, const float* isu, const float* isv, float* xo, const float* gam, const float* bet, int tok, int lane) {
    float* xrow = xo + (size_t)tok * D + 16 * lane;
    f32x4 xv[4];
#pragma unroll
    for (int q = 0; q < 4; ++q) xv[q] = *(const f32x4*)(xrow + 4 * q);
    float acc[16];
#pragma unroll
    for (int k = 0; k < 16; ++k) acc[k] = 0.f;
    for (int head = 0; head < 8; ++head) {
        const v2u se = sel[((size_t)tok * 8 + head) * 16 + (lane & 15)];
        const unsigned eq = (unsigned)__shfl((int)se.x, lane >> 2);
        const float su = isu[eq], sv = isv[eq];
        float part[16];
        {
            v4u uu[16];
#pragma unroll
            for (int k = 0; k < 16; ++k) { const unsigned e = __builtin_amdgcn_readlane(se.x, k); uu[k] = *(const v4u*)(U8 + (size_t)e * D + 16 * lane); }
#pragma unroll
            for (int k = 0; k < 16; ++k) { float d0 = 0.f, d1 = 0.f;
#pragma unroll
                for (int q = 0; q < 4; ++q) { const unsigned w = uu[k][q]; const f32x2v a = __builtin_amdgcn_cvt_pk_f32_fp8((int)w, false), b = __builtin_amdgcn_cvt_pk_f32_fp8((int)w, true);
                    d0 += xv[q][0] * a[0]; d1 += xv[q][1] * a[1]; d0 += xv[q][2] * b[0]; d1 += xv[q][3] * b[1]; }
                part[k] = d0 + d1; }
        }
        float r8[8], r4[4], r2[2], r1;
#pragma unroll
        for (int i = 0; i < 8; ++i) { const bool up = (lane & 32) != 0; const float send = up ? part[i] : part[i + 8], keep = up ? part[i + 8] : part[i]; r8[i] = keep + __shfl_xor(send, 32); }
#pragma unroll
        for (int i = 0; i < 4; ++i) { const bool up = (lane & 16) != 0; const float send = up ? r8[i] : r8[i + 4], keep = up ? r8[i + 4] : r8[i]; r4[i] = keep + __shfl_xor(send, 16); }
#pragma unroll
        for (int i = 0; i < 2; ++i) { const bool up = (lane & 8) != 0; const float send = up ? r4[i] : r4[i + 2], keep = up ? r4[i + 2] : r4[i]; r2[i] = keep + __shfl_xor(send, 8); }
        { const bool up = (lane & 4) != 0; const float send = up ? r2[0] : r2[1], keep = up ? r2[1] : r2[0]; r1 = keep + __shfl_xor(send, 4); }
        r1 += __shfl_xor(r1, 2); r1 += __shfl_xor(r1, 1);
        const float gq = __uint_as_float((unsigned)__shfl((int)se.y, lane >> 2));
        const float wgt = gq * gelu_erf(r1 * su) * sv;
        {
            v4u vv[16];
#pragma unroll
            for (int k = 0; k < 16; ++k) { const unsigned e = __builtin_amdgcn_readlane(se.x, k); vv[k] = *(const v4u*)(V8 + (size_t)e * D + 16 * lane); }
#pragma unroll
            for (int k = 0; k < 16; ++k) { const float w = __uint_as_float(__builtin_amdgcn_readlane(__float_as_uint(wgt), 4 * k));
#pragma unroll
                for (int q = 0; q < 4; ++q) { const unsigned x = vv[k][q]; const f32x2v a = __builtin_amdgcn_cvt_pk_f32_fp8((int)x, false), b = __builtin_amdgcn_cvt_pk_f32_fp8((int)x, true);
                    acc[4 * q] += w * a[0]; acc[4 * q + 1] += w * a[1]; acc[4 * q + 2] += w * b[0]; acc[4 * q + 3] += w * b[1]; } }
        }
    }
    float rr[16], s = 0.f;
#pragma unroll
    for (int k = 0; k < 16; ++k) { rr[k] = ALPHA * xv[k >> 2][k & 3] + acc[k]; s += rr[k]; }
    const float mean = wave_sum(s) * (1.f / D); float s2 = 0.f;
#pragma unroll
    for (int k = 0; k < 16; ++k) { rr[k] -= mean; s2 += rr[k] * rr[k]; }
    const float rstd = __builtin_amdgcn_rsqf(wave_sum(s2) * (1.f / D) + LN_EPS);
#pragma unroll
    for (int q = 0; q < 4; ++q) { const f32x4 g = *(const f32x4*)(gam + 16 * lane + 4 * q), bb = *(const f32x4*)(bet + 16 * lane + 4 * q);
        f32x4 y; y[0] = rr[4 * q] * rstd * g[0] + bb[0]; y[1] = rr[4 * q + 1] * rstd * g[1] + bb[1]; y[2] = rr[4 * q + 2] * rstd * g[2] + bb[2]; y[3] = rr[4 * q + 3] * rstd * g[3] + bb[3];
        *(f32x4*)(xrow + 4 * q) = y; }
}
__device__ __forceinline__ void row_to_fp8(const float* src, unsigned char* dst, float* inv, int row, int lane) {
    const float* p = src + (size_t)row * D + 16 * lane;
    f32x4 v[4]; float am = 0.f;
#pragma unroll
    for (int q = 0; q < 4; ++q) { v[q] = *(const f32x4*)(p + 4 * q); am = fmaxf(am, fmaxf(fmaxf(fabsf(v[q][0]), fabsf(v[q][1])), fmaxf(fabsf(v[q][2]), fabsf(v[q][3])))); }
    am = wave_max(am);
    float s = 1.f, is = 1.f;
    if (am > 1e-30f) { const int eb = (__float_as_int(224.f / am) >> 23) & 0xff; if (eb > 0 && eb < 254) { s = __int_as_float(eb << 23); is = __int_as_float((254 - eb) << 23); } }
    v4u o;
#pragma unroll
    for (int q = 0; q < 4; ++q) { int w = 0; w = __builtin_amdgcn_cvt_pk_fp8_f32(v[q][0] * s, v[q][1] * s, w, false); w = __builtin_amdgcn_cvt_pk_fp8_f32(v[q][2] * s, v[q][3] * s, w, true); o[q] = (unsigned)w; }
    *(v4u*)(dst + (size_t)row * D + 16 * lane) = o;
    if (lane == 0) inv[row] = is;
}
}
constexpr int NPH = 8;
__global__ void __launch_bounds__(NWAVES * 64, 2) mk_fwd(Args args) {
    extern __shared__ __attribute__((aligned(16))) unsigned char lds_raw[];
    LAS unsigned char* lds = (LAS unsigned char*)lds_raw;
    volatile LAS unsigned* MISC = (volatile LAS unsigned*)(lds + MISC_OFF);
    const int tid = threadIdx.x, lane = tid & 63, wave = __builtin_amdgcn_readfirstlane(tid >> 6);
    const int G = gridDim.x, bx = blockIdx.x, vcu = (G % 8 == 0) ? (bx % 8) * (G / 8) + bx / 8 : bx;
    unsigned char* ws = args.ws;
    gu32* ctl = (gu32*)(ws + WS_CTL);
    for (int u = tid; u < (LDS_BYTES - RING_BYTES) / 4; u += NWAVES * 64) ((LAS unsigned*)(lds + RING_BYTES))[u] = 0u;
    __syncthreads();
    XcdBarrier bar; bar.bar = (unsigned*)(ctl + CW_BAR); bar.x = 0; bar.st = nullptr;
    if (MK_N_LAUNCHES == 1) bar = xcd_barrier_post((unsigned*)(ctl + CW_BAR), MISC + 8);
    const int lo = args.ph_lo, hi = args.ph_hi;
#ifndef PH_MASK
#define PH_MASK 0xFF
#endif
#define IN(k) ((((PH_MASK) >> (k)) & 1) && lo <= (k) && (k) < hi)
#define SEAM(k) do { if (IN(k) && IN((k) + 1)) xcd_barrier(bar); } while (0)
    const int gw = vcu * NWAVES + wave, NGW = G * NWAVES;

    if (IN(0)) { p0_prologue(args, lds, vcu, G, wave, lane); VM_WAIT(); __syncthreads(); SEAM(0); }

    if (IN(1)) {
        pg8::Gemm g{(const pg8::bf16_t*)(ws + WS_A), (const pg8::bf16_t*)(ws + WS_WIN), T, INC, D}; pg8::StaticOrder S; S.init(T, INC, G, bx); S.rep = NREP(1);
        pg8::EpiInProj E{(pg8::bf16_t*)(ws + WS_QD), (pg8::bf16_t*)(ws + WS_KD), (pg8::bf16_t*)(ws + WS_VD), (pg8::bf16_t*)(ws + WS_LQ), (pg8::bf16_t*)(ws + WS_LK), (pg8::bf16_t*)(ws + WS_LV),
                         (pg8::bf16_t*)(ws + WS_GA), (pg8::bf16_t*)(ws + WS_GB)};
        pg8::gemm_phase<pg8::EpiInProj, pg8::StaticOrder, true, true>(lds, g, S, E);
        SEAM(1);
    }

    if (IN(2)) {
#ifndef NO_DIFF
        {
            const da::Tensors X{(const bf16*)(ws + WS_QD), (const bf16*)(ws + WS_KD), (const bf16*)(ws + WS_VD), (float*)(ws + WS_STASH), (bf16*)(ws + WS_YA),
                                args.in[I_DLAM], args.in[I_SUBG], args.in[I_RELB]};
            int cur_h = -1;
            float lam; { const float* dl = args.in[I_DLAM]; const float p1 = dl[lane] * dl[64 + lane], p2 = dl[128 + lane] * dl[192 + lane];
                lam = __uint_as_float(__builtin_amdgcn_readfirstlane(__float_as_uint(__expf(wave_sum(p1)) - __expf(wave_sum(p2)) + LAM_INIT))); }
            for (int rep_ = 0; rep_ < NREP(20); ++rep_)
            for (int p = vcu; p < 256; p += G) {
                const int bh = p >> 5, s = p & 31, b = bh >> 2, h = bh & 3;
                if (h != cur_h) {
                    __syncthreads();
                    const float* bd = (const float*)(ws + WS_BIASD) + h * BIAS_TAB;
                    for (int i = tid; i < BIAS_TAB; i += NWAVES * 64) ((LAS float*)(lds + da::LDS_BIAS))[i] = bd[i];
                    __syncthreads(); cur_h = h;
                }
                const float c31 = args.in[I_RELB][31 * 16 + h] * LOG2E;
                for (int k2 = 0; k2 < 2; ++k2) da::unit(X, b, h, k2 ? 63 - s : s, lds, bx, lam, c31);
            }
        }
#endif
#ifndef NO_DIL
        {
            const dil::Tensors X{(const bf16*)(ws + WS_LQ), (const bf16*)(ws + WS_LK), (const bf16*)(ws + WS_LV), (bf16*)(ws + WS_YB)};
            int cur_h = -1;
            for (int rep_ = 0; rep_ < NREP(21); ++rep_)
            for (int u = vcu; u < 256; u += G) {
                const int bh = u >> 5, blk = u & 31, b = bh >> 2, h = bh & 3;
                if (h != cur_h) {
                    __syncthreads();
                    const float* blsrc = (const float*)(ws + WS_BIASL);
                    for (int i = tid; i < 3 * dil::BT; i += NWAVES * 64) { const int g = i / dil::BT, jj = i % dil::BT - dil::BT0;
                        ((LAS float*)(lds + dil::LDS_BL))[i] = (jj >= 0 && jj <= 128) ? blsrc[(g * 4 + h) * 132 + jj] : 0.f; }
                    __syncthreads(); cur_h = h;
                }
                for (int k2 = 0; k2 < 2; ++k2) dil::wave_tile(X, b, h, blk * 512, wave + 8 * k2, lds + dil::LDS_VST + wave * 4096, (const LAS float*)(lds + dil::LDS_BL), lane);
            }
            __syncthreads();
        }
#endif
        SEAM(2);
    }

    if (IN(3)) {
        { pg8::Gemm g{(const pg8::bf16_t*)(ws + WS_YA), (const pg8::bf16_t*)(ws + WS_WBD), T, D, 512}; pg8::StaticOrder S; S.init(T, D, G, bx); S.rep = NREP(3);
          pg8::EpiGate1 E{(const pg8::bf16_t*)(ws + WS_GA), (pg8::bf16_t*)(ws + WS_GATED)};
          pg8::gemm_phase<pg8::EpiGate1, pg8::StaticOrder, true, true>(lds, g, S, E); }
        VM_WAIT(); __syncthreads();
        { pg8::Gemm g{(const pg8::bf16_t*)(ws + WS_YB), (const pg8::bf16_t*)(ws + WS_WBL), T, D, 256}; pg8::StaticOrder S; S.init(T, D, G, bx);
          pg8::EpiGate2 E{(const pg8::bf16_t*)(ws + WS_GB), (pg8::bf16_t*)(ws + WS_GATED)};
          pg8::gemm_phase<pg8::EpiGate2, pg8::StaticOrder, true, true>(lds, g, S, E); }
        SEAM(3);
    }

    if (IN(4)) {
        pg8::Gemm g{(const pg8::bf16_t*)(ws + WS_GATED), (const pg8::bf16_t*)(ws + WS_WO), T, D, D}; pg8::StaticOrder S; S.init(T, D, G, bx); S.rep = NREP(4);
        pg8::EpiOut E{args.in[I_X], (float*)(ws + WS_R)};
        pg8::gemm_phase<pg8::EpiOut, pg8::StaticOrder, true, true>(lds, g, S, E);
        SEAM(4);
    }

    if (IN(5)) {
        p5_ln1(args, vcu, G, wave, lane);
        for (int row = gw; row < 2 * NEXP; row += NGW) {
            if (row < NEXP) peer::row_to_fp8(args.in[I_PU], ws + WS_UU, (float*)(ws + WS_ISU), row, lane);
            else peer::row_to_fp8(args.in[I_PV], ws + WS_UV, (float*)(ws + WS_ISV), row - NEXP, lane);
        }
        SEAM(5);
    }

    if (IN(6)) {
        pg8::Gemm g{(const pg8::bf16_t*)(ws + WS_WP), (const pg8::bf16_t*)(ws + WS_A), 2048, T, D}; pg8::StaticOrder S; S.init(2048, T, G, bx); S.rep = NREP(6);
        pg8::EpiScoreT E{(float*)(ws + WS_ST)};
        pg8::gemm_phase<pg8::EpiScoreT, pg8::StaticOrder, true, true>(lds, g, S, E);
        SEAM(6);
    }

    if (IN(7)) {
        const float* ST = (const float*)(ws + WS_ST); v2u* sel = (v2u*)(ws + WS_SEL);
        for (int u = vcu; u < T / 128; u += G) {
            for (int p = 0; p < 2; ++p) peer::select(ST, sel, u * 128 + p * 64 + lane, wave);
            VM_WAIT(); __syncthreads();
            for (int i = 0; i < 16; ++i) peer::gather_token(sel, ws + WS_UU, ws + WS_UV, (const float*)(ws + WS_ISU), (const float*)(ws + WS_ISV), args.out, args.in[I_LN2G], args.in[I_LN2B], u * 128 + wave * 16 + i, lane);
            VM_WAIT(); __syncthreads();
        }
    }
#undef IN
#undef SEAM
}

extern "C" void kernel_launch(void* const* d_in, const int* in_sizes, int n_in, void* d_out, int out_size, void* d_ws, size_t ws_size, hipStream_t stream) {
    static int grid = 0;
    if (grid == 0) {
        if (n_in != 16 || in_sizes[0] != T * D || out_size != T * D || ws_size < WS_END) { fprintf(stderr, "kernel_launch: unexpected shapes (n_in %d, in0 %d, out %d, ws %zu); nothing launched\n", n_in, n_in > 0 ? in_sizes[0] : -1, out_size, ws_size); grid = -1; return; }
        int dev = 0, cus = 0, per_cu = 0;
        if (hipGetDevice(&dev) != hipSuccess || hipDeviceGetAttribute(&cus, hipDeviceAttributeMultiprocessorCount, dev) != hipSuccess) { grid = -1; return; }
        if (hipFuncSetAttribute((const void*)mk_fwd, hipFuncAttributeMaxDynamicSharedMemorySize, LDS_BYTES) != hipSuccess) { fprintf(stderr, "kernel_launch: hipFuncSetAttribute failed\n"); grid = -1; return; }
        if (hipOccupancyMaxActiveBlocksPerMultiprocessor(&per_cu, (const void*)mk_fwd, NWAVES * 64, LDS_BYTES) != hipSuccess || per_cu < 1) { fprintf(stderr, "kernel_launch: occupancy query reports %d\n", per_cu); per_cu = 1; }
        (void)hipGetLastError();
        grid = cus;
    }
    if (grid < 0) return;
    if (hipMemsetAsync((char*)d_ws + WS_CTL, 0, CTL_ZERO_BYTES, stream) != hipSuccess) return;
    Args a{};
    for (int i = 0; i < 16; ++i) a.in[i] = (const float*)d_in[i];
    a.out = (float*)d_out; a.ws = (unsigned char*)d_ws;
    for (int li = 0; li < MK_N_LAUNCHES; ++li) {
        a.ph_lo = (MK_N_LAUNCHES == 1) ? 0 : li; a.ph_hi = (MK_N_LAUNCHES == 1) ? NPH : li + 1;
        hipLaunchKernelGGL(mk_fwd, dim3(grid), dim3(NWAVES * 64), LDS_BYTES, stream, a);
    }
}
```

```cpp
#include <hip/hip_runtime.h>
#include <cstdio>
#include <cstdint>

#ifndef MK_N_LAUNCHES
#define MK_N_LAUNCHES 1
#endif

#ifndef REPEAT_PH
#define REPEAT_PH (-1)
#endif
#define NREP(k) ((REPEAT_PH) == (k) ? 2 : 1)

constexpr int BATCH = 2, SEQ = 16384, T = BATCH * SEQ, D = 1024, INC = 5888;
constexpr int OFF_DQ = 0, OFF_DK = 512, OFF_DV = 1024, OFF_LQ = 1536, OFF_LK = 2304, OFF_LV = 3072, OFF_GA = 3840, OFF_GB = 4864;
constexpr int NEXP = 16384;
constexpr float LOG2E = 1.4426950408889634f;
constexpr float QSCALE = 0.125f * LOG2E;
constexpr float ALPHA = 1.189207115002721f;
constexpr float LN_EPS = 1e-5f, SUBLN_EPS = 1e-5f;
constexpr float LAM_INIT = 0.2f;
constexpr int NTILE = SEQ / 64;
constexpr int BIAS_TAB = 2112, BIAS_GUARD = 256, DFAR = 1513;

constexpr size_t MiB = 1u << 20;
constexpr size_t WS_CTL = 0, CTL_ZERO_BYTES = 1 * MiB;
constexpr size_t WS_BIASD = 1 * MiB;
constexpr size_t WS_BIASL = 1 * MiB + 64 * 1024;
constexpr size_t WS_WIN = 8 * MiB, WS_WO = 20 * MiB, WS_WBD = 22 * MiB, WS_WBL = 23 * MiB, WS_WP = 24 * MiB;
constexpr size_t WS_A = 32 * MiB;
constexpr size_t WS_YA = WS_A, WS_YB = WS_A + 32 * MiB;
constexpr size_t WS_QD = 96 * MiB, WS_KD = 128 * MiB, WS_VD = 160 * MiB, WS_LQ = 192 * MiB, WS_LK = 240 * MiB, WS_LV = 288 * MiB, WS_GA = 336 * MiB, WS_GB = 400 * MiB;
constexpr size_t WS_STASH = 464 * MiB;
constexpr size_t WS_SEL = 464 * MiB;
constexpr size_t WS_GATED = 96 * MiB;
constexpr size_t WS_R = 160 * MiB;
constexpr size_t WS_ST = 96 * MiB;
constexpr size_t WS_UU = 352 * MiB, WS_UV = 384 * MiB;
constexpr size_t WS_ISU = 2 * MiB, WS_ISV = 2 * MiB + 65536;
constexpr size_t WS_END = 512 * MiB;

constexpr int CW_BAR = 4096;
constexpr int NWAVES = 8;
constexpr int RING_BYTES = 131072, MISC_OFF = RING_BYTES + 320, LDS_BYTES = 147456;

#define GAS __attribute__((address_space(1)))
#define LAS __attribute__((address_space(3)))
typedef unsigned short bf16;
typedef unsigned v4u __attribute__((ext_vector_type(4)));
typedef unsigned v2u __attribute__((ext_vector_type(2)));
typedef float f32x4 __attribute__((ext_vector_type(4)));
typedef float f32x16 __attribute__((ext_vector_type(16)));
typedef short bf16x8 __attribute__((ext_vector_type(8)));
typedef short s16x4 __attribute__((ext_vector_type(4)));
typedef __bf16 bf16x2 __attribute__((ext_vector_type(2)));
typedef GAS unsigned gu32;
#define RLX_AGENT __ATOMIC_RELAXED, __HIP_MEMORY_SCOPE_AGENT
#define LDS_WAIT() asm volatile("s_waitcnt lgkmcnt(0)" ::: "memory")
#define VM_WAIT() asm volatile("s_waitcnt vmcnt(0)" ::: "memory")
__device__ __forceinline__ unsigned f2bf(float f) { unsigned u = __builtin_bit_cast(unsigned, f); return (u + 0x7fffu + ((u >> 16) & 1u)) >> 16; }
__device__ __forceinline__ unsigned pk2(float lo, float hi) { return f2bf(lo) | (f2bf(hi) << 16); }
typedef float f32x2_t __attribute__((ext_vector_type(2)));
__device__ __forceinline__ unsigned cvtpk(float lo, float hi) { f32x2_t v = {lo, hi}; bf16x2 b = __builtin_convertvector(v, bf16x2); return __builtin_bit_cast(unsigned, b); }
__device__ __forceinline__ float bf_lo(unsigned w) { return __builtin_bit_cast(float, w << 16); }
__device__ __forceinline__ float bf_hi(unsigned w) { return __builtin_bit_cast(float, w & 0xffff0000u); }
__device__ __forceinline__ float dot2bf(unsigned a, unsigned b, float acc) { return __builtin_amdgcn_fdot2_f32_bf16(__builtin_bit_cast(bf16x2, a), __builtin_bit_cast(bf16x2, b), acc, false); }
__device__ __forceinline__ float wave_sum(float v) {
#pragma unroll
    for (int o = 1; o < 64; o <<= 1) v += __shfl_xor(v, o);
    return v;
}
__device__ __forceinline__ float wave_max(float v) {
#pragma unroll
    for (int o = 1; o < 64; o <<= 1) v = fmaxf(v, __shfl_xor(v, o));
    return v;
}
__device__ __forceinline__ int rel_bucket(int n) {
    if (n < 16) return n < 0 ? 0 : n;
    return 16 + (n >= 22) + (n >= 30) + (n >= 40) + (n >= 54) + (n >= 73) + (n >= 99) + (n >= 134) + (n >= 182) + (n >= 246) + (n >= 332) + (n >= 450) + (n >= 609) + (n >= 825) + (n >= 1117) + (n >= 1513);
}
namespace pg8 {
#define PG8_LAS __attribute__((address_space(3)))
typedef unsigned short bf16_t;
typedef short bf16x8 __attribute__((ext_vector_type(8)));
typedef float f32x4 __attribute__((ext_vector_type(4)));
typedef unsigned u32x4 __attribute__((ext_vector_type(4)));
constexpr int BM = 256, BK = 64, HALF = 128, HTB = HALF * BK * 2  , STAGE_BYTES = 8 * HTB, NXCD = 8, WGM = 8;

__host__ __device__ __forceinline__ int lds_byte(int r, int c) { const int st = (r >> 4) * 2 + (c >> 5), rr = r & 15, cc = c & 31, ob = rr * 64 + cc * 2; return st * 1024 + (ob ^ (((ob >> 9) & 1) << 5)); }
__host__ __device__ __forceinline__ void stage_rc(int b, int& R, int& C) { const int st = b / 1024, sb = b % 1024, swz = sb ^ (((sb >> 9) & 1) << 5); R = (st >> 1) * 16 + swz / 64; C = (st & 1) * 32 + (swz % 64) / 2; }
__host__ __device__ __forceinline__ int perm32(int rho) { const int n = rho >> 4, i = rho & 15; return 8 * (i >> 2) + 4 * n + (i & 3); }

struct Unit { int pm, pn; };
struct Gemm { const bf16_t* A; const bf16_t* Bt; int M, N, K; };

struct StaticOrder {
    int nM, nN, nwg, G, c;
    __host__ __device__ void init(int M, int N, int G_, int c_) { nM = M / BM; nN = N / BM; nwg = nM * nN; G = G_; c = c_; }
    int rep = 1;
    __host__ __device__ bool next(int i0, Unit& u) const {
        const int i = i0 / rep;
        const long L = (long)i * G + c; if (L >= nwg) return false;
        int wgid = (int)L; { const int q = nwg / NXCD, r = nwg % NXCD, xcd = wgid % NXCD, off = wgid / NXCD; wgid = (xcd < r ? xcd * (q + 1) : r * (q + 1) + (xcd - r) * q) + off; }
        const int nig = WGM * nN, gid = wgid / nig, fm = gid * WGM, gsz = (nM - fm) < WGM ? (nM - fm) : WGM;
        u.pm = fm + ((wgid % nig) % gsz); u.pn = (wgid % nig) / gsz; return true;
    }
    __device__ __forceinline__ void a_ready(const Unit&) const {}
    __device__ __forceinline__ void done(const Unit&) const {}
};
__device__ __forceinline__ unsigned cvt_pk_bf16(float lo, float hi) { unsigned r; asm volatile("v_cvt_pk_bf16_f32 %0, %1, %2" : "=v"(r) : "v"(lo), "v"(hi)); return r; }
__device__ __forceinline__ u32x4 pack8(const f32x4 v0, const f32x4 v1) { u32x4 w; w.x = cvt_pk_bf16(v0[0], v0[1]); w.y = cvt_pk_bf16(v0[2], v0[3]); w.z = cvt_pk_bf16(v1[0], v1[1]); w.w = cvt_pk_bf16(v1[2], v1[3]); return w; }
__device__ __forceinline__ float blo(unsigned w) { return __builtin_bit_cast(float, w << 16); }
__device__ __forceinline__ float bhi(unsigned w) { return __builtin_bit_cast(float, w & 0xffff0000u); }
__device__ __forceinline__ float sigm(float v) { return __builtin_amdgcn_rcpf(1.f + __expf(-v)); }
template <class E> __device__ __forceinline__ void epi_loop(const E& e, const f32x4 (&acc)[2][2][4][2], const Unit& u, int wr, int wc, int fr, int fq) {
#pragma unroll
    for (int ai = 0; ai < 2; ++ai)
#pragma unroll
        for (int m = 0; m < 4; ++m) { const int row = u.pm * BM + ai * HALF + wr * 64 + m * 16 + fr;
#pragma unroll
            for (int bj = 0; bj < 2; ++bj) { const int col = u.pn * BM + bj * HALF + wc * 32 + 8 * fq; e.item(u.pn, row, col, acc[ai][bj][m][0], acc[ai][bj][m][1]); } }
}

struct EpiInProj {
    static constexpr bool PERM = true, AFTER_DRAIN = false;
    bf16_t *Qd, *Kd, *Vd, *LQ, *LK, *LV, *GA, *GB;
    __device__ __forceinline__ void operator()(const f32x4 (&acc)[2][2][4][2], const Unit& u, int wr, int wc, int fr, int fq) const { epi_loop(*this, acc, u, wr, wc, fr, fq); }
    __device__ __forceinline__ void item(int pn, int row, int col, f32x4 v0, f32x4 v1) const {
            const int b = row >> 14, s = row & 16383; bf16_t* dst;
            if (pn < 2) {
                const int h = col >> 7, c = (col >> 6) & 1, d = col & 63; v0 = v0 * 0.18033688011112042f; v1 = v1 * 0.18033688011112042f;
                dst = Qd + ((size_t)((b * 4 + h) * 2 + c) * 16384 + s) * 64 + d;
            } else if (pn < 4) {
                const int cc = col - 512, h = cc >> 7, c = (cc >> 6) & 1, d = cc & 63;
                dst = Kd + ((((size_t)((b * 4 + h) * 2 + c) * 256 + (s >> 6)) * 8 + (d >> 3)) * 64 + (s & 63)) * 8;
            } else if (pn < 6) {
                const int cc = col - 1024, h = cc >> 7, d = cc & 127;
                dst = Vd + ((size_t)(b * 4 + h) * 256 + (s >> 6)) * 8192 + ((d >> 5) * 4 + ((s & 63) >> 4)) * 512 + (s & 15) * 32 + (d & 31);
            } else if (pn < 9) {
                v0 = v0 * 0.18033688011112042f; v1 = v1 * 0.18033688011112042f; dst = LQ + (size_t)row * 768 + (col - 1536);
            } else if (pn < 12) { dst = LK + (size_t)row * 768 + (col - 2304);
            } else if (pn < 15) { dst = LV + (size_t)row * 768 + (col - 3072);
            } else {
#pragma unroll
                for (int i = 0; i < 4; ++i) { v0[i] = sigm(v0[i]); v1[i] = sigm(v1[i]); }
                dst = (pn < 19) ? GA + (size_t)row * 1024 + (col - 3840) : GB + (size_t)row * 1024 + (col - 4864);
            }
            *(u32x4*)dst = pack8(v0, v1);
        }
};
struct EpiGate1 {
    static constexpr bool PERM = true, AFTER_DRAIN = false;
    const bf16_t* GA; bf16_t* G;
    __device__ __forceinline__ void operator()(const f32x4 (&acc)[2][2][4][2], const Unit& u, int wr, int wc, int fr, int fq) const { epi_loop(*this, acc, u, wr, wc, fr, fq); }
    __device__ __forceinline__ void item(int pn, int row, int col, f32x4 v0, f32x4 v1) const {
            const size_t o = (size_t)row * 1024 + col; const u32x4 g = *(const u32x4*)(GA + o);
            v0[0] *= blo(g.x); v0[1] *= bhi(g.x); v0[2] *= blo(g.y); v0[3] *= bhi(g.y); v1[0] *= blo(g.z); v1[1] *= bhi(g.z); v1[2] *= blo(g.w); v1[3] *= bhi(g.w);
            *(u32x4*)(G + o) = pack8(v0, v1);
        }
};
struct EpiGate2 {
    static constexpr bool PERM = true, AFTER_DRAIN = false;
    const bf16_t* GB; bf16_t* G;
    __device__ __forceinline__ void operator()(const f32x4 (&acc)[2][2][4][2], const Unit& u, int wr, int wc, int fr, int fq) const { epi_loop(*this, acc, u, wr, wc, fr, fq); }
    __device__ __forceinline__ void item(int pn, int row, int col, f32x4 v0, f32x4 v1) const {
            const size_t o = (size_t)row * 1024 + col; const u32x4 g = *(const u32x4*)(GB + o); const u32x4 p = *(const u32x4*)(G + o);
            v0[0] = v0[0] * blo(g.x) + blo(p.x); v0[1] = v0[1] * bhi(g.x) + bhi(p.x); v0[2] = v0[2] * blo(g.y) + blo(p.y); v0[3] = v0[3] * bhi(g.y) + bhi(p.y);
            v1[0] = v1[0] * blo(g.z) + blo(p.z); v1[1] = v1[1] * bhi(g.z) + bhi(p.z); v1[2] = v1[2] * blo(g.w) + blo(p.w); v1[3] = v1[3] * bhi(g.w) + bhi(p.w);
            *(u32x4*)(G + o) = pack8(v0, v1);
        }
};
struct EpiOut {
    static constexpr bool PERM = true, AFTER_DRAIN = false;
    const float* X; float* R;
    __device__ __forceinline__ void operator()(const f32x4 (&acc)[2][2][4][2], const Unit& u, int wr, int wc, int fr, int fq) const { epi_loop(*this, acc, u, wr, wc, fr, fq); }
    __device__ __forceinline__ void item(int pn, int row, int col, f32x4 v0, f32x4 v1) const {
            const size_t o = (size_t)row * 1024 + col; const f32x4 x0 = *(const f32x4*)(X + o), x1 = *(const f32x4*)(X + o + 4);
            *(f32x4*)(R + o) = x0 * 1.189207115002721f + v0; *(f32x4*)(R + o + 4) = x1 * 1.189207115002721f + v1;
        }
};
struct EpiScoreT {
    static constexpr bool PERM = true, AFTER_DRAIN = false;
    float* ST;
    __device__ __forceinline__ void operator()(const f32x4 (&acc)[2][2][4][2], const Unit& u, int wr, int wc, int fr, int fq) const { epi_loop(*this, acc, u, wr, wc, fr, fq); }
    __device__ __forceinline__ void item(int pn, int row, int col, f32x4 v0, f32x4 v1) const { const size_t o = (size_t)row * 32768 + col; *(f32x4*)(ST + o) = v0; *(f32x4*)(ST + o + 4) = v1; }
};
template <class Epi, class Sched, bool ALIGN_EPI = false, bool SP2 = false>
__device__ __forceinline__ void gemm_phase(PG8_LAS unsigned char* lds, const Gemm g, const Sched& S, const Epi& E) {
    const int tid = threadIdx.x, wid = __builtin_amdgcn_readfirstlane(tid >> 6), lane = tid & 63, wr = wid >> 2, wc = wid & 3, fr = lane & 15, fq = lane >> 4;
    const int K = g.K, nt = K / BK;
    unsigned voffA[2], voffB[2];
#pragma unroll
    for (int i = 0; i < 2; ++i) { int R, C; stage_rc(tid * 16 + i * 8192, R, C); const int Rb = Epi::PERM ? ((R & ~31) + perm32(R & 31)) : R;
        voffA[i] = (unsigned)(R * K + C) * 2u; voffB[i] = (unsigned)(Rb * K + C) * 2u; }
    const size_t kstep = (size_t)(BK * 2);
    const size_t hstep = (size_t)HALF * K * 2;
    const size_t tstep = 2 * hstep;
    const unsigned ldsw = (unsigned)wid * 1024u;
    const int aoff = lds_byte(wr * 64 + fr, fq * 8), boff = lds_byte(wc * 32 + fr, fq * 8);
#define PG8_SA(b, h) (((b) * 2 + (h)) * HTB)
#define PG8_SB(b, h) ((4 + (b) * 2 + (h)) * HTB)
#define PG8_STAGE(bufoff, gbase, voff) do { _Pragma("unroll") for (int _i = 0; _i < 2; ++_i) \
        __builtin_amdgcn_global_load_lds((const unsigned*)((const char*)(gbase) + (voff)[_i]), (PG8_LAS unsigned*)(lds + (bufoff) + ldsw + _i * 8192), 16, 0, 0); } while (0)
#define PG8_LDA(dst, b, h) do { _Pragma("unroll") for (int m = 0; m < 4; ++m) _Pragma("unroll") for (int k = 0; k < 2; ++k) dst[m][k] = *(const PG8_LAS bf16x8*)(lds + PG8_SA(b, h) + aoff + m * 2048 + k * 1024); } while (0)
#define PG8_LDB(dst, b, h) do { _Pragma("unroll") for (int n = 0; n < 2; ++n) _Pragma("unroll") for (int k = 0; k < 2; ++k) dst[n][k] = *(const PG8_LAS bf16x8*)(lds + PG8_SB(b, h) + boff + n * 2048 + k * 1024); } while (0)
#define PG8_MMA(ai, bj, At, Bt) do { __builtin_amdgcn_s_setprio(1); _Pragma("unroll") for (int m = 0; m < 4; ++m) _Pragma("unroll") for (int n = 0; n < 2; ++n) _Pragma("unroll") for (int k = 0; k < 2; ++k) \
        acc[ai][bj][m][n] = __builtin_amdgcn_mfma_f32_16x16x32_bf16(Bt[n][k], At[m][k], acc[ai][bj][m][n], 0, 0, 0); __builtin_amdgcn_s_setprio(0); } while (0)
#define PG8_WAIT_V(n) asm volatile("s_waitcnt vmcnt(" #n ")" ::: "memory")
#define PG8_WAIT_L(n) asm volatile("s_waitcnt lgkmcnt(" #n ")" ::: "memory")
#define PG8_BAR __builtin_amdgcn_s_barrier()
#define PG8_SCHED __builtin_amdgcn_sched_barrier(0)
    Unit cur, nxt; int ui = 0;
    if (!S.next(0, cur)) return;
    f32x4 acc[2][2][4][2];
#pragma unroll
    for (int a = 0; a < 2; ++a)
#pragma unroll
        for (int b = 0; b < 2; ++b)
#pragma unroll
            for (int m = 0; m < 4; ++m)
#pragma unroll
                for (int n = 0; n < 2; ++n) acc[a][b][m][n] = (f32x4){0.f, 0.f, 0.f, 0.f};
    bf16x8 At[4][2], B0[2][2], B1[2][2];
    const char* cA = (const char*)g.A + (size_t)cur.pm * tstep; const char* cB = (const char*)g.Bt + (size_t)cur.pn * tstep;
    S.a_ready(cur);
    if constexpr (SP2) {
        PG8_STAGE(PG8_SB(0, 0), cB, voffB); PG8_STAGE(PG8_SB(0, 1), cB + hstep, voffB); PG8_STAGE(PG8_SA(0, 0), cA, voffA); PG8_STAGE(PG8_SA(0, 1), cA + hstep, voffA);
        if (wr == 1) PG8_BAR;
        PG8_WAIT_V(2); PG8_BAR;
        PG8_STAGE(PG8_SB(1, 0), cB + kstep, voffB); PG8_STAGE(PG8_SA(1, 0), cA + kstep, voffA); PG8_STAGE(PG8_SB(1, 1), cB + hstep + kstep, voffB);
        PG8_WAIT_V(6); PG8_BAR;
    } else {
        PG8_STAGE(PG8_SB(0, 0), cB, voffB); PG8_STAGE(PG8_SA(0, 0), cA, voffA); PG8_STAGE(PG8_SB(0, 1), cB + hstep, voffB); PG8_STAGE(PG8_SA(0, 1), cA + hstep, voffA);
        if (wr == 1) PG8_BAR;
        PG8_WAIT_V(4); PG8_BAR;
        PG8_STAGE(PG8_SB(1, 0), cB + kstep, voffB); PG8_STAGE(PG8_SA(1, 0), cA + kstep, voffA); PG8_STAGE(PG8_SB(1, 1), cB + hstep + kstep, voffB);
        PG8_WAIT_V(6); PG8_BAR;
    }
    for (;;) {
        const bool has_next = S.next(ui + 1, nxt);
        const char* nA = has_next ? (const char*)g.A + (size_t)nxt.pm * tstep : cA; const char* nB = has_next ? (const char*)g.Bt + (size_t)nxt.pn * tstep : cB;
        for (int t = 0; t < nt; t += 2) {
            const bool last = (t == nt - 2);
            const char* a1 = cA + (size_t)(t + 1) * kstep;
            const char* a2 = last ? nA : cA + (size_t)(t + 2) * kstep; const char* b2 = last ? nB : cB + (size_t)(t + 2) * kstep;
            const char* a3 = a2 + kstep; const char* b3 = b2 + kstep;
            if (last && has_next) S.a_ready(nxt);
            if constexpr (SP2) {
            PG8_LDB(B0, 0, 0); PG8_LDB(B1, 0, 1); PG8_SCHED; PG8_LDA(At, 0, 0); PG8_STAGE(PG8_SA(1, 1), a1 + hstep, voffA);
            PG8_WAIT_V(8); PG8_WAIT_L(0); PG8_BAR; PG8_MMA(0, 0, At, B0); PG8_MMA(0, 1, At, B1); PG8_BAR; PG8_SCHED;
            PG8_LDA(At, 0, 1); PG8_STAGE(PG8_SB(0, 0), b2, voffB); PG8_STAGE(PG8_SB(0, 1), b2 + hstep, voffB); PG8_STAGE(PG8_SA(0, 0), a2, voffA);
            PG8_WAIT_V(8); PG8_WAIT_L(0); PG8_BAR; PG8_MMA(1, 0, At, B0); PG8_MMA(1, 1, At, B1); PG8_BAR; PG8_SCHED;
            PG8_LDB(B0, 1, 0); PG8_LDB(B1, 1, 1); PG8_SCHED; PG8_LDA(At, 1, 0); PG8_STAGE(PG8_SA(0, 1), a2 + hstep, voffA);
            PG8_WAIT_V(8); PG8_WAIT_L(0); PG8_BAR; PG8_MMA(0, 0, At, B0); PG8_MMA(0, 1, At, B1); PG8_BAR; PG8_SCHED;
            PG8_LDA(At, 1, 1); PG8_STAGE(PG8_SB(1, 0), b3, voffB); PG8_STAGE(PG8_SB(1, 1), b3 + hstep, voffB); PG8_STAGE(PG8_SA(1, 0), a3, voffA);
            PG8_WAIT_V(8); PG8_WAIT_L(0); PG8_BAR; PG8_MMA(1, 0, At, B0); PG8_MMA(1, 1, At, B1); PG8_BAR; PG8_SCHED;
            } else {
            PG8_LDB(B0, 0, 0); PG8_SCHED; PG8_LDA(At, 0, 0); PG8_STAGE(PG8_SA(1, 1), a1 + hstep, voffA);
            PG8_WAIT_L(8); PG8_BAR; PG8_WAIT_L(0); PG8_MMA(0, 0, At, B0); PG8_BAR; PG8_SCHED;
            PG8_LDB(B1, 0, 1); PG8_STAGE(PG8_SB(0, 0), b2, voffB);
            PG8_BAR; PG8_WAIT_L(0); PG8_MMA(0, 1, At, B1); PG8_BAR;
            PG8_LDA(At, 0, 1); PG8_STAGE(PG8_SA(0, 0), a2, voffA);
            PG8_BAR; PG8_WAIT_L(0); PG8_MMA(1, 0, At, B0); PG8_BAR; PG8_SCHED;
            PG8_STAGE(PG8_SB(0, 1), b2 + hstep, voffB);
            PG8_WAIT_V(6); PG8_BAR; PG8_MMA(1, 1, At, B1); PG8_BAR;
            PG8_LDB(B0, 1, 0); PG8_SCHED; PG8_LDA(At, 1, 0); PG8_STAGE(PG8_SA(0, 1), a2 + hstep, voffA);
            PG8_WAIT_L(8); PG8_BAR; PG8_WAIT_L(0); PG8_MMA(0, 0, At, B0); PG8_BAR; PG8_SCHED;
            PG8_LDB(B1, 1, 1); PG8_STAGE(PG8_SB(1, 0), b3, voffB);
            PG8_BAR; PG8_WAIT_L(0); PG8_MMA(0, 1, At, B1); PG8_BAR;
            PG8_LDA(At, 1, 1); PG8_STAGE(PG8_SA(1, 0), a3, voffA);
            PG8_BAR; PG8_WAIT_L(0); PG8_MMA(1, 0, At, B0); PG8_BAR; PG8_SCHED;
            PG8_STAGE(PG8_SB(1, 1), b3 + hstep, voffB);
            PG8_WAIT_V(6); PG8_BAR; PG8_MMA(1, 1, At, B1); PG8_BAR;
            }
        }
        if constexpr (ALIGN_EPI) { if (wr == 0) PG8_BAR; }
        if constexpr (!Epi::AFTER_DRAIN) { E(acc, cur, wr, wc, fr, fq); S.done(cur); }
        if (!has_next) break;
#pragma unroll
        for (int a = 0; a < 2; ++a)
#pragma unroll
            for (int b = 0; b < 2; ++b)
#pragma unroll
                for (int m = 0; m < 4; ++m)
#pragma unroll
                    for (int n = 0; n < 2; ++n) acc[a][b][m][n] = (f32x4){0.f, 0.f, 0.f, 0.f};
        cur = nxt; cA = nA; cB = nB; ++ui;
        if constexpr (ALIGN_EPI) { if (wr == 1) PG8_BAR; }
    }
    PG8_WAIT_V(0);
    if constexpr (!ALIGN_EPI) { if (wr == 0) PG8_BAR; }
    PG8_BAR;
    if constexpr (Epi::AFTER_DRAIN) { E.fused(acc, cur, wr, wc, fr, fq, lds, wid, lane); S.done(cur); }
#undef PG8_SA
#undef PG8_SB
#undef PG8_STAGE
#undef PG8_LDA
#undef PG8_LDB
#undef PG8_MMA
#undef PG8_WAIT_V
#undef PG8_WAIT_L
#undef PG8_BAR
#undef PG8_SCHED
}
}
#define XB_TMO      128
#define XB_XCNT(j)  (256  + 64 * (j))
#define XB_XSUB(j)  (1280 + 64 * (j))
#define XB_XGEN(j)  (2304 + 64 * (j))
#define XB_TOP      3328
#define XB_TOPGEN   3392
#define XCD_BAR_WORDS 3456
#define XB_SPIN_CAP (1u << 18)

__device__ __forceinline__ unsigned xb_ld(unsigned* p)              { return __hip_atomic_load(p, __ATOMIC_RELAXED, __HIP_MEMORY_SCOPE_AGENT); }
__device__ __forceinline__ unsigned xb_add(unsigned* p, unsigned v) { return __hip_atomic_fetch_add(p, v, __ATOMIC_RELAXED, __HIP_MEMORY_SCOPE_AGENT); }
__device__ __forceinline__ unsigned xb_xcc_id() { return (unsigned)__builtin_amdgcn_s_getreg((3 << 11) | 20) & 0xFu; }
#define XB_SPIN(cond, bar) do { unsigned _sp = 0; while (cond) { __builtin_amdgcn_s_sleep(1); \
    if ((++_sp & 255u) == 0u) { if (xb_ld(&(bar)[XB_TMO])) break; if (_sp > XB_SPIN_CAP) { atomicAdd(&(bar)[XB_TMO], 1u); break; } } } } while (0)

struct XcdBarrier {
    unsigned* bar; unsigned x;
    volatile LAS unsigned* st;
};

__device__ __forceinline__ XcdBarrier xcd_barrier_post(unsigned* bar, volatile LAS unsigned* st) {
    XcdBarrier b; b.bar = bar; b.x = xb_xcc_id(); b.st = st;
    if (threadIdx.x == 0) (void)xb_add(&bar[XB_XCNT(b.x)], 1u);
    return b;
}
__device__ __forceinline__ void xcd_barrier_complete(unsigned* bar, unsigned x, unsigned& nloc, unsigned& nx) {
    const unsigned G = gridDim.x * gridDim.y * gridDim.z;
    unsigned sum, cnt, mine, sp = 0u;
    for (;;) {
        sum = 0u; cnt = 0u; mine = 0u;
#pragma unroll
        for (unsigned j = 0; j < 16; ++j) { const unsigned c = xb_ld(&bar[XB_XCNT(j)]); sum += c; cnt += (c > 0u) ? 1u : 0u; mine = (j == x) ? c : mine; }
        if (sum == G) break;
        __builtin_amdgcn_s_sleep(1);
        if ((++sp & 255u) == 0u) { if (xb_ld(&bar[XB_TMO])) break; if (sp > XB_SPIN_CAP) { atomicAdd(&bar[XB_TMO], 1u); break; } }
    }
    nloc = mine > 0u ? mine : 1u; nx = cnt > 0u ? cnt : 1u;
}

__device__ __forceinline__ void xcd_barrier(const XcdBarrier& b) {
    asm volatile("s_waitcnt vmcnt(0)" ::: "memory");
    __syncthreads();
    if (threadIdx.x == 0) {
        unsigned* bar = b.bar;
        __builtin_amdgcn_s_waitcnt(0);
        unsigned nloc = b.st[0], nx = b.st[1];
        if (nloc == 0u) { xcd_barrier_complete(bar, b.x, nloc, nx); b.st[0] = nloc; b.st[1] = nx; }
        const unsigned old = xb_add(&bar[XB_XSUB(b.x)], 1u);
        const unsigned gen = old / nloc;
        if (old + 1u == (gen + 1u) * nloc) {
            __builtin_amdgcn_fence(__ATOMIC_RELEASE, "agent");
            asm volatile("s_waitcnt vmcnt(0)" ::: "memory");
            const unsigned og = xb_add(&bar[XB_TOP], 1u);
            const unsigned tg = og / nx;
            if (og + 1u == (tg + 1u) * nx) xb_add(&bar[XB_TOPGEN], 1u);
            else XB_SPIN(xb_ld(&bar[XB_TOPGEN]) == tg, bar);
            __builtin_amdgcn_fence(__ATOMIC_ACQUIRE, "agent");
            xb_add(&bar[XB_XGEN(b.x)], 1u);
            asm volatile("s_waitcnt vmcnt(0)" ::: "memory");
        } else {
            XB_SPIN(xb_ld(&bar[XB_XGEN(b.x)]) == gen, bar);
            __builtin_amdgcn_fence(__ATOMIC_ACQUIRE, "agent");
            asm volatile("s_waitcnt vmcnt(0)" ::: "memory");
        }
    }
    __syncthreads();
}
namespace da {
constexpr int SLOT_K = 8192, SLOT_V = 16384, SLOT = SLOT_K + SLOT_V;
constexpr int NSLOT = 4;
constexpr int LDS_BIAS = NSLOT * SLOT;
constexpr int LDS_END = LDS_BIAS + BIAS_TAB * 4;
constexpr float THR = 8.f;
__device__ __forceinline__ int crow(int r, int hi) { return (r & 3) + 8 * (r >> 2) + 4 * hi; }
__device__ __forceinline__ void glds16(const void* gbase  , unsigned voff  , unsigned lds_dst) { unsigned keep;
    asm volatile("s_mov_b32 %0, m0\n\ts_mov_b32 m0, %3\n\ts_nop 0\n\tglobal_load_lds_dwordx4 %1, %2\n\ts_mov_b32 m0, %0" : "=&s"(keep) : "v"(voff), "s"(gbase), "s"(lds_dst) : "memory"); }
typedef short v4i16_t __attribute__((ext_vector_type(4)));
__device__ __forceinline__ s16x4 vtr(const LAS char* p) { return __builtin_bit_cast(s16x4, __builtin_amdgcn_ds_read_tr16_b64_v4i16((LAS v4i16_t*)p)); }
#define DA_WAIT_BAR() asm volatile("s_waitcnt vmcnt(0) lgkmcnt(0)\n\ts_barrier" ::: "memory")

struct Tensors { const bf16* Qd; const bf16* Kd; const bf16* Vd; float* stash; bf16* ya; const float* dlam; const float* subg; const float* relb; };

__device__ __forceinline__ float max3f(float a, float b, float c) { float r; asm("v_max3_f32 %0, %1, %2, %3" : "=v"(r) : "v"(a), "v"(b), "v"(c)); return r; }
#define DA_STAGE_A(T_) do { const int t_ = (T_); const LAS char* kb_ = kp0 + (t_ & 3) * SLOT; \
        bf16x8 kf_[8]; \
        _Pragma("unroll") for (int d0 = 0; d0 < 2; ++d0) { kf_[2 * d0] = *(const LAS bf16x8*)(kb_ + d0 * 2048); kf_[2 * d0 + 1] = *(const LAS bf16x8*)(kb_ + d0 * 2048 + 512); } \
        int base_ = qabs - 64 * t_ - 4 * hi + BIAS_GUARD; asm volatile("" : "+v"(base_)); \
        f32x16 p0, p1; \
        if ((q0 - 64 * t_ - 63) < DFAR) { \
            _Pragma("unroll") for (int r = 0; r < 16; ++r) { const int o_ = (r & 3) + 8 * (r >> 2); p0[r] = tb[base_ - o_] - m; p1[r] = tb[base_ - o_ - 32] - m; } \
            _Pragma("unroll") for (int d0 = 0; d0 < 4; ++d0) { if (d0 < 2) { kf_[2 * d0 + 4] = *(const LAS bf16x8*)(kb_ + (d0 + 2) * 2048); kf_[2 * d0 + 5] = *(const LAS bf16x8*)(kb_ + (d0 + 2) * 2048 + 512); } \
                p0 = __builtin_amdgcn_mfma_f32_32x32x16_bf16(kf_[2 * d0], qr[d0], p0, 0, 0, 0); p1 = __builtin_amdgcn_mfma_f32_32x32x16_bf16(kf_[2 * d0 + 1], qr[d0], p1, 0, 0, 0); } \
        } else { f32x16 ci_; const float cm_ = c31 - m; _Pragma("unroll") for (int r = 0; r < 16; ++r) ci_[r] = cm_; \
            _Pragma("unroll") for (int d0 = 0; d0 < 4; ++d0) { if (d0 < 2) { kf_[2 * d0 + 4] = *(const LAS bf16x8*)(kb_ + (d0 + 2) * 2048); kf_[2 * d0 + 5] = *(const LAS bf16x8*)(kb_ + (d0 + 2) * 2048 + 512); } \
                p0 = __builtin_amdgcn_mfma_f32_32x32x16_bf16(kf_[2 * d0], qr[d0], d0 == 0 ? ci_ : p0, 0, 0, 0); p1 = __builtin_amdgcn_mfma_f32_32x32x16_bf16(kf_[2 * d0 + 1], qr[d0], d0 == 0 ? ci_ : p1, 0, 0, 0); } } \
        if (t_ >= NT - 4) { \
            _Pragma("unroll") for (int r = 0; r < 16; ++r) { const int o_ = (r & 3) + 8 * (r >> 2); if (base_ - o_ < BIAS_GUARD) p0[r] = -1e30f; if (base_ - o_ - 32 < BIAS_GUARD) p1[r] = -1e30f; } } \
        float ra_ = max3f(p0[0], p0[1], p1[0]), rb_ = max3f(p0[2], p0[3], p1[1]); ra_ = max3f(ra_, p1[2], p1[3]); \
        _Pragma("unroll") for (int r = 4; r < 16; r += 4) { ra_ = max3f(ra_, p0[r], p0[r + 1]); rb_ = max3f(rb_, p0[r + 2], p0[r + 3]); ra_ = max3f(ra_, p1[r], p1[r + 1]); rb_ = max3f(rb_, p1[r + 2], p1[r + 3]); } \
        float rm_ = fmaxf(ra_, rb_); \
        { auto rr_ = __builtin_amdgcn_permlane32_swap(__float_as_uint(rm_), __float_as_uint(rm_), false, false); rm_ = fmaxf(__uint_as_float(rr_[0]), __uint_as_float(rr_[1])); } \
        if (t_ == 0 || __any(rm_ > THR)) { const float dl_ = (t_ == 0) ? rm_ : fmaxf(rm_, 0.f), f_ = __builtin_amdgcn_exp2f(-dl_); \
            _Pragma("unroll") for (int r = 0; r < 16; ++r) { p0[r] -= dl_; p1[r] -= dl_; } \
            _Pragma("unroll") for (int d0 = 0; d0 < 4; ++d0) _Pragma("unroll") for (int r = 0; r < 16; ++r) o[d0][r] *= f_; \
            l *= f_; m += dl_; } \
        float ls0_ = 0.f, ls1_ = 0.f; \
        _Pragma("unroll") for (int r = 0; r < 16; ++r) { p0[r] = __builtin_amdgcn_exp2f(p0[r]); p1[r] = __builtin_amdgcn_exp2f(p1[r]); ls0_ += p0[r]; ls1_ += p1[r]; } \
        l += ls0_ + ls1_; \
        { v4u w; \
          w.x = cvtpk(p0[0], p0[1]); w.y = cvtpk(p0[2], p0[3]); w.z = cvtpk(p0[4], p0[5]); w.w = cvtpk(p0[6], p0[7]); pw[0] = __builtin_bit_cast(bf16x8, w); \
          w.x = cvtpk(p0[8], p0[9]); w.y = cvtpk(p0[10], p0[11]); w.z = cvtpk(p0[12], p0[13]); w.w = cvtpk(p0[14], p0[15]); pw[1] = __builtin_bit_cast(bf16x8, w); \
          w.x = cvtpk(p1[0], p1[1]); w.y = cvtpk(p1[2], p1[3]); w.z = cvtpk(p1[4], p1[5]); w.w = cvtpk(p1[6], p1[7]); pw[2] = __builtin_bit_cast(bf16x8, w); \
          w.x = cvtpk(p1[8], p1[9]); w.y = cvtpk(p1[10], p1[11]); w.z = cvtpk(p1[12], p1[13]); w.w = cvtpk(p1[14], p1[15]); pw[3] = __builtin_bit_cast(bf16x8, w); } \
    } while (0)
#define DA_VF(V_, ks) (bf16x8){V_[2 * (ks)][0], V_[2 * (ks)][1], V_[2 * (ks)][2], V_[2 * (ks)][3], V_[2 * (ks) + 1][0], V_[2 * (ks) + 1][1], V_[2 * (ks) + 1][2], V_[2 * (ks) + 1][3]}
#define DA_STAGE_B(T_) do { const LAS char* vb_ = vp0 + ((T_) & 3) * SLOT; s16x4 vA[8], vB[8]; \
        _Pragma("unroll") for (int ks = 0; ks < 4; ++ks) { vA[2 * ks] = vtr(vb_ + ks * 1024); vA[2 * ks + 1] = vtr(vb_ + ks * 1024 + 512); } \
        _Pragma("unroll") for (int ks = 0; ks < 4; ++ks) { vB[2 * ks] = vtr(vb_ + 4096 + ks * 1024); vB[2 * ks + 1] = vtr(vb_ + 4096 + ks * 1024 + 512); } \
        __builtin_amdgcn_sched_barrier(0); \
        _Pragma("unroll") for (int ks = 0; ks < 4; ++ks) o[0] = __builtin_amdgcn_mfma_f32_32x32x16_bf16(DA_VF(vA, ks), pw[ks], o[0], 0, 0, 0); \
        _Pragma("unroll") for (int ks = 0; ks < 4; ++ks) { vA[2 * ks] = vtr(vb_ + 2 * 4096 + ks * 1024); vA[2 * ks + 1] = vtr(vb_ + 2 * 4096 + ks * 1024 + 512); } \
        __builtin_amdgcn_sched_barrier(0); \
        _Pragma("unroll") for (int ks = 0; ks < 4; ++ks) o[1] = __builtin_amdgcn_mfma_f32_32x32x16_bf16(DA_VF(vB, ks), pw[ks], o[1], 0, 0, 0); \
        _Pragma("unroll") for (int ks = 0; ks < 4; ++ks) { vB[2 * ks] = vtr(vb_ + 3 * 4096 + ks * 1024); vB[2 * ks + 1] = vtr(vb_ + 3 * 4096 + ks * 1024 + 512); } \
        __builtin_amdgcn_sched_barrier(0); \
        _Pragma("unroll") for (int ks = 0; ks < 4; ++ks) o[2] = __builtin_amdgcn_mfma_f32_32x32x16_bf16(DA_VF(vA, ks), pw[ks], o[2], 0, 0, 0); \
        _Pragma("unroll") for (int ks = 0; ks < 4; ++ks) o[3] = __builtin_amdgcn_mfma_f32_32x32x16_bf16(DA_VF(vB, ks), pw[ks], o[3], 0, 0, 0); \
    } while (0)
__device__ __forceinline__ void unit(const Tensors& X, int b, int h, int qb, LAS unsigned char* lds, int wgslot, float lam, float c31) {
    const int wid = __builtin_amdgcn_readfirstlane((int)threadIdx.x >> 6);
    const int grp = 0;
    const int q0 = qb * 256, NT = 4 * (qb + 1);
    const unsigned lds0 = (unsigned)(uintptr_t)lds;
    const LAS float* tb = (const LAS float*)(lds + LDS_BIAS);
    for (int c = 0; c < 2; ++c) {
        int lane = (int)__builtin_amdgcn_mbcnt_hi(~0u, __builtin_amdgcn_mbcnt_lo(~0u, 0u)); asm volatile("" : "+v"(lane));
        const int r32 = lane & 31, hi = lane >> 5;
        const unsigned lane16 = (unsigned)lane * 16u;
        const int qabs = q0 + wid * 32 + r32;
        const LAS char* vp0 = (const LAS char*)lds + SLOT_K + ((lane >> 4) & 1) * 32 + (lane & 3) * 8 + (4 * hi + ((lane & 15) >> 2)) * 64;
        const LAS char* kp0 = (const LAS char*)lds + hi * 1024 + r32 * 16;
        const int bhc = (b * 4 + h) * 2 + c;
        const bf16* Qw = X.Qd + ((size_t)bhc * SEQ + q0 + wid * 32 + r32) * 64 + hi * 8;
        const char* Kt = (const char*)X.Kd + (size_t)bhc * NTILE * SLOT_K + wid * 1024;
        const char* Vt = (const char*)X.Vd + (size_t)(b * 4 + h) * NTILE * SLOT_V + wid * 1024;
#define DA_DMA(t, slot) do { const unsigned sb_ = (unsigned)__builtin_amdgcn_readfirstlane(lds0 + (slot) * SLOT + wid * 1024); \
        glds16(Kt + (size_t)(t) * SLOT_K, lane16, sb_); glds16(Vt + (size_t)(t) * SLOT_V, lane16, sb_ + SLOT_K); glds16(Vt + (size_t)(t) * SLOT_V + 8192, lane16, sb_ + SLOT_K + 8192); } while (0)
        DA_DMA(0, 0); DA_DMA(1, 1);
        bf16x8 qr[4];
#pragma unroll
        for (int d0 = 0; d0 < 4; ++d0) qr[d0] = *(const bf16x8*)(Qw + d0 * 16);
        f32x16 o[4];
#pragma unroll
        for (int d0 = 0; d0 < 4; ++d0)
#pragma unroll
            for (int r = 0; r < 16; ++r) o[d0][r] = 0.f;
        float m = 0.f, l = 0.f;
        bf16x8 pw[4];
#pragma unroll
        for (int ks = 0; ks < 4; ++ks) pw[ks] = (bf16x8){0, 0, 0, 0, 0, 0, 0, 0};
        asm volatile("" :: "v"(qr[0]), "v"(qr[1]), "v"(qr[2]), "v"(qr[3]));
        for (int t = 0; t <= NT; ++t) {
            if (t + 1 < NT) asm volatile("s_waitcnt vmcnt(3) lgkmcnt(0)\n\ts_barrier" ::: "memory");
            else asm volatile("s_waitcnt vmcnt(0) lgkmcnt(0)\n\ts_barrier" ::: "memory");
            if (t + 2 < NT) { const int sn = (t + 2) & 3; DA_DMA(t + 2, sn); }
            if (grp == 0) {
                if (t < NT) { DA_STAGE_A(t); __builtin_amdgcn_sched_barrier(0); DA_STAGE_B(t); }
            } else {
                if (t >= 1) { DA_STAGE_B(t - 1); __builtin_amdgcn_sched_barrier(0); }
                if (t < NT) { DA_STAGE_A(t); }
            }
        }
#undef DA_DMA
        { auto rr = __builtin_amdgcn_permlane32_swap(__float_as_uint(l), __float_as_uint(l), false, false); l = __uint_as_float(rr[0]) + __uint_as_float(rr[1]); }
        const float inv = 1.f / l;
        int lane_e = lane; asm volatile("" : "+v"(lane_e));
        GAS float* stg = (GAS float*)(X.stash + ((size_t)(wgslot * 8 + wid) * 64) * 64 + lane_e);
        if (c == 0) {
#pragma unroll
            for (int d0 = 0; d0 < 4; ++d0)
#pragma unroll
                for (int r = 0; r < 16; ++r) stg[(d0 * 16 + r) * 64] = o[d0][r] * inv;
        } else {
            float ss = 0.f;
#pragma unroll
            for (int d0 = 0; d0 < 4; ++d0)
#pragma unroll
                for (int r = 0; r < 16; ++r) { const float dv = stg[(d0 * 16 + r) * 64] - lam * (o[d0][r] * inv); o[d0][r] = dv; ss += dv * dv; if (r == 15) asm volatile("" ::: "memory"); }
            { auto rr = __builtin_amdgcn_permlane32_swap(__float_as_uint(ss), __float_as_uint(ss), false, false); ss = __uint_as_float(rr[0]) + __uint_as_float(rr[1]); }
            const float rn = __builtin_amdgcn_rsqf(ss * (1.f / 128.f) + SUBLN_EPS) * (1.f - LAM_INIT);
            const int hi_e = lane_e >> 5, qabs_e = q0 + wid * 32 + (lane_e & 31);
            bf16* yrow = X.ya + ((size_t)b * SEQ + qabs_e) * 512 + h * 128 + 4 * hi_e; const float* sg = X.subg + 4 * hi_e;
#pragma unroll
            for (int d0 = 0; d0 < 4; ++d0)
#pragma unroll
                for (int r4 = 0; r4 < 4; ++r4) {
                    const int dd = 32 * d0 + 8 * r4; const f32x4 g = *(const f32x4*)(sg + dd);
                    v2u w; w.x = pk2(o[d0][4 * r4] * rn * g[0], o[d0][4 * r4 + 1] * rn * g[1]); w.y = pk2(o[d0][4 * r4 + 2] * rn * g[2], o[d0][4 * r4 + 3] * rn * g[3]);
                    *(v2u*)(yrow + dd) = w;
                }
        }
    }
    asm volatile("s_waitcnt vmcnt(0) lgkmcnt(0)\n\ts_barrier" ::: "memory");
}
#undef DA_STAGE_A
#undef DA_STAGE_B
#undef DA_VF
#undef DA_WAIT_BAR
}
namespace dil {
constexpr int BT = 1152, BT0 = 512;
constexpr int LDS_VST = 0, LDS_BL = 32768, LDS_END = LDS_BL + 3 * BT * 4;
constexpr float THR = 8.f;
struct Tensors { const bf16* LQ; const bf16* LK; const bf16* LV; bf16* yb; };
typedef short v4i16_t __attribute__((ext_vector_type(4)));
__device__ __forceinline__ s16x4 vtr(const LAS unsigned char* p) { return __builtin_bit_cast(s16x4, __builtin_amdgcn_ds_read_tr16_b64_v4i16((LAS v4i16_t*)p)); }

template <int G_> __device__ __forceinline__ void group(const Tensors& X, size_t rowb, int h, int P0, int r, LAS unsigned char* vst, const LAS float* blg, int lane, f32x16 (&o)[2], float& m, float& l) {
    constexpr int DL = (G_ == 0) ? 1 : (G_ == 1) ? 4 : 16, MG = 16 / DL, NKB = (G_ == 0) ? 20 : (G_ == 1) ? 8 : 5;
    const int i = lane & 31, hi = lane >> 5;
    const int colb = G_ * 256 + h * 64;
    bf16x8 qr[4];
    { const bf16* qp = X.LQ + (rowb + P0 + r + 16 * i) * 768 + colb + hi * 8;
#pragma unroll
      for (int d0 = 0; d0 < 4; ++d0) qr[d0] = *(const bf16x8*)(qp + 16 * d0); }
    const int kpos0 = P0 + r - 128 * DL;
    const LAS unsigned char* vrd = vst + ((lane >> 4) & 1) * 32 + (lane & 3) * 8 + (4 * hi + ((lane & 15) >> 2)) * 64;
    for (int kb = 0; kb < NKB; ++kb) {
        bf16x8 kf[4];
        { int kpos = kpos0 + (32 * kb + i) * DL; kpos = kpos < 0 ? 0 : (kpos > SEQ - 1 ? SEQ - 1 : kpos); const bf16* kp = X.LK + (rowb + kpos) * 768 + colb + hi * 8;
#pragma unroll
          for (int d0 = 0; d0 < 4; ++d0) kf[d0] = *(const bf16x8*)(kp + 16 * d0); }
        v4u vreg[4];
#pragma unroll
        for (int t = 0; t < 4; ++t) { const int qd = lane + 64 * t, key = qd >> 3, ch = qd & 7; int vpos = kpos0 + (32 * kb + key) * DL; vpos = vpos < 0 ? 0 : (vpos > SEQ - 1 ? SEQ - 1 : vpos);
            vreg[t] = *(const v4u*)(X.LV + (rowb + vpos) * 768 + colb + ch * 8); }
        const int jb = i * MG + 128 - 32 * kb - 4 * hi;
        f32x16 p;
#pragma unroll
        for (int rr = 0; rr < 16; ++rr) p[rr] = blg[jb - ((rr & 3) + 8 * (rr >> 2)) + BT0];
#pragma unroll
        for (int d0 = 0; d0 < 4; ++d0) p = __builtin_amdgcn_mfma_f32_32x32x16_bf16(kf[d0], qr[d0], p, 0, 0, 0);
        const int cb = 32 * kb + 4 * hi;
#pragma unroll
        for (int rr = 0; rr < 16; ++rr) { const int o_ = (rr & 3) + 8 * (rr >> 2); if ((unsigned)(jb - o_) > 128u || kpos0 + (cb + o_) * DL < 0) p[rr] = -3e38f; }
        float rm = p[0];
#pragma unroll
        for (int rr = 1; rr < 16; ++rr) rm = fmaxf(rm, p[rr]);
        { auto sw = __builtin_amdgcn_permlane32_swap(__float_as_uint(rm), __float_as_uint(rm), false, false); rm = fmaxf(__uint_as_float(sw[0]), __uint_as_float(sw[1])); }
        if (__any(rm > m + THR)) {
            const float mn = fmaxf(m, rm), f = __builtin_amdgcn_exp2f(m - mn);
#pragma unroll
            for (int d0 = 0; d0 < 2; ++d0)
#pragma unroll
                for (int rr = 0; rr < 16; ++rr) o[d0][rr] *= f;
            l *= f; m = mn;
        }
        float ls = 0.f;
#pragma unroll
        for (int rr = 0; rr < 16; ++rr) { p[rr] = __builtin_amdgcn_exp2f(p[rr] - m); ls += p[rr]; }
        l += ls;
        bf16x8 pw[2];
        { v4u w;
          w.x = cvtpk(p[0], p[1]); w.y = cvtpk(p[2], p[3]); w.z = cvtpk(p[4], p[5]); w.w = cvtpk(p[6], p[7]); pw[0] = __builtin_bit_cast(bf16x8, w);
          w.x = cvtpk(p[8], p[9]); w.y = cvtpk(p[10], p[11]); w.z = cvtpk(p[12], p[13]); w.w = cvtpk(p[14], p[15]); pw[1] = __builtin_bit_cast(bf16x8, w); }
#pragma unroll
        for (int t = 0; t < 4; ++t) { const int qd = lane + 64 * t, key = qd >> 3, ch = qd & 7;
            *(LAS v4u*)(vst + ((ch >> 2) * 2 + (key >> 4)) * 1024 + (key & 15) * 64 + (ch & 3) * 16) = vreg[t]; }
        asm volatile("s_waitcnt lgkmcnt(0)" ::: "memory");
#pragma unroll
        for (int d0 = 0; d0 < 2; ++d0)
#pragma unroll
            for (int ks = 0; ks < 2; ++ks) {
                const s16x4 lo = vtr(vrd + (d0 * 2 + ks) * 1024), hh = vtr(vrd + (d0 * 2 + ks) * 1024 + 512);
                const bf16x8 vf = (bf16x8){lo[0], lo[1], lo[2], lo[3], hh[0], hh[1], hh[2], hh[3]};
                o[d0] = __builtin_amdgcn_mfma_f32_32x32x16_bf16(vf, pw[ks], o[d0], 0, 0, 0);
            }
        asm volatile("s_waitcnt lgkmcnt(0)" ::: "memory");
    }
}
__device__ __forceinline__ void wave_tile(const Tensors& X, int b, int h, int P0, int r, LAS unsigned char* vst, const LAS float* bl, int lane) {
    const size_t rowb = (size_t)b * SEQ;
    f32x16 o[2];
#pragma unroll
    for (int d0 = 0; d0 < 2; ++d0)
#pragma unroll
        for (int rr = 0; rr < 16; ++rr) o[d0][rr] = 0.f;
    float m = -1e30f, l = 0.f;
    group<0>(X, rowb, h, P0, r, vst, bl, lane, o, m, l);
    group<1>(X, rowb, h, P0, r, vst, bl + BT, lane, o, m, l);
    group<2>(X, rowb, h, P0, r, vst, bl + 2 * BT, lane, o, m, l);
    { auto sw = __builtin_amdgcn_permlane32_swap(__float_as_uint(l), __float_as_uint(l), false, false); l = __uint_as_float(sw[0]) + __uint_as_float(sw[1]); }
    const float inv = 1.f / l; const int i = lane & 31, hi = lane >> 5;
    bf16* yrow = X.yb + (rowb + P0 + r + 16 * i) * 256 + h * 64 + 4 * hi;
#pragma unroll
    for (int d0 = 0; d0 < 2; ++d0)
#pragma unroll
        for (int r4 = 0; r4 < 4; ++r4) { v2u w; w.x = pk2(o[d0][4 * r4] * inv, o[d0][4 * r4 + 1] * inv); w.y = pk2(o[d0][4 * r4 + 2] * inv, o[d0][4 * r4 + 3] * inv); *(v2u*)(yrow + 32 * d0 + 8 * r4) = w; }
}
}
__device__ __forceinline__ void p0_transpose_item(const float* W, int K, int N, bf16* WT, LAS float* scr, int item, int lane) {
    const int nblk = N / 32, kb = item / nblk, nb = item % nblk, k0 = 64 * kb, n0 = 32 * nb;
#pragma unroll 8
    for (int i = 0; i < 32; ++i) { const int kk = 2 * i + (lane >> 5); scr[kk * 33 + (lane & 31)] = W[(size_t)(k0 + kk) * N + n0 + (lane & 31)]; }
    LDS_WAIT(); asm volatile("" ::: "memory");
    const int c = lane & 7;
#pragma unroll
    for (int j = 0; j < 4; ++j) { const int n = (lane >> 3) + 8 * j; const LAS float* s = scr + (8 * c) * 33 + n;
        v4u o; o.x = pk2(s[0 * 33], s[1 * 33]); o.y = pk2(s[2 * 33], s[3 * 33]); o.z = pk2(s[4 * 33], s[5 * 33]); o.w = pk2(s[6 * 33], s[7 * 33]);
        *(v4u*)(WT + (size_t)(n0 + n) * K + k0 + 8 * c) = o; }
    LDS_WAIT(); asm volatile("" ::: "memory");
}
__device__ __forceinline__ void cast_bf16(const float* src, bf16* dst, size_t n8, size_t gtid, size_t gthreads) {
    for (size_t i = gtid; i < n8; i += gthreads) { const f32x4 a = *(const f32x4*)(src + i * 8), b = *(const f32x4*)(src + i * 8 + 4);
        v4u o; o.x = pk2(a[0], a[1]); o.y = pk2(a[2], a[3]); o.z = pk2(b[0], b[1]); o.w = pk2(b[2], b[3]); *(v4u*)(dst + i * 8) = o; }
}

struct Args { const float* in[16]; float* out; unsigned char* ws; int ph_lo, ph_hi; };
enum { I_X = 0, I_WIN, I_DLAM, I_SUBG, I_WBD, I_WBL, I_WO, I_LN1G, I_LN1B, I_PWQ, I_PKEYS, I_PU, I_PV, I_LN2G, I_LN2B, I_RELB };

__device__ __forceinline__ void p0_prologue(const Args& A, LAS unsigned char* lds, int vcu, int G, int wave, int lane) {
    unsigned char* ws = A.ws;
    const int gw = vcu * NWAVES + wave, NGW = G * NWAVES;
    const size_t gtid = (size_t)gw * 64 + lane, gthreads = (size_t)NGW * 64;
    LAS float* scr = (LAS float*)(lds + wave * 16384);
    constexpr int I_IN = (D / 64) * (INC / 32), I_BD = (512 / 64) * (D / 32), I_BL = (256 / 64) * (D / 32), I_O = (D / 64) * (D / 32);
    for (int it = gw; it < I_IN + I_BD + I_BL + I_O; it += NGW) {
        int r = it;
        if (r < I_IN) { p0_transpose_item(A.in[I_WIN], D, INC, (bf16*)(ws + WS_WIN), scr, r, lane); continue; } r -= I_IN;
        if (r < I_BD) { p0_transpose_item(A.in[I_WBD], 512, D, (bf16*)(ws + WS_WBD), scr, r, lane); continue; } r -= I_BD;
        if (r < I_BL) { p0_transpose_item(A.in[I_WBL], 256, D, (bf16*)(ws + WS_WBL), scr, r, lane); continue; } r -= I_BL;
        p0_transpose_item(A.in[I_WO], D, D, (bf16*)(ws + WS_WO), scr, r, lane);
    }
    cast_bf16(A.in[I_X], (bf16*)(ws + WS_A), (size_t)T * D / 8, gtid, gthreads);
    { const float* wq = A.in[I_PWQ]; const float* keys = A.in[I_PKEYS]; bf16* wp = (bf16*)(ws + WS_WP);
      for (int it = gw; it < 2048 * 16; it += NGW) {
          const int row = it >> 4, jb = it & 15, hc = row >> 7, j = jb * 64 + lane;
          const float* wr_ = wq + (size_t)j * 2048 + hc * 128; const float* kr = keys + (size_t)row * 128;
          float a0 = 0.f, a1 = 0.f, a2 = 0.f, a3 = 0.f;
#pragma unroll 8
          for (int d = 0; d < 128; d += 4) { const f32x4 w = *(const f32x4*)(wr_ + d), k = *(const f32x4*)(kr + d); a0 += w[0] * k[0]; a1 += w[1] * k[1]; a2 += w[2] * k[2]; a3 += w[3] * k[3]; }
          wp[(size_t)row * 1024 + j] = (bf16)f2bf((a0 + a1) + (a2 + a3));
      } }
    { const float* relb = A.in[I_RELB]; float* bd = (float*)(ws + WS_BIASD); float* bl = (float*)(ws + WS_BIASL);
      for (size_t i = gtid; i < 4 * BIAS_TAB; i += gthreads) { const int h = (int)(i / BIAS_TAB), dist = (int)(i % BIAS_TAB) - BIAS_GUARD; bd[i] = dist < 0 ? 0.f : relb[rel_bucket(dist) * 16 + h] * LOG2E; }
      for (size_t i = gtid; i < 12 * 132; i += gthreads) { const int gh = (int)(i / 132), j = (int)(i % 132), g = gh >> 2; const int dl = (g == 0) ? 1 : (g == 1) ? 4 : 16;
          bl[i] = relb[rel_bucket((j > 128 ? 128 : j) * dl) * 16 + 4 + gh] * LOG2E; } }
}

__device__ __forceinline__ void p5_ln1(const Args& A, int vcu, int G, int wave, int lane) {
    unsigned char* ws = A.ws;
    const int gw = vcu * NWAVES + wave, NGW = G * NWAVES;
    const float* R = (const float*)(ws + WS_R); bf16* x1b = (bf16*)(ws + WS_A);
    const float* gam = A.in[I_LN1G]; const float* bet = A.in[I_LN1B];
    f32x4 gv[4], bv[4];
#pragma unroll
    for (int j = 0; j < 4; ++j) { gv[j] = *(const f32x4*)(gam + 256 * j + 4 * lane); bv[j] = *(const f32x4*)(bet + 256 * j + 4 * lane); }
    for (int mrow = gw; mrow < T; mrow += NGW) {
        const f32x4* xr = (const f32x4*)(R + (size_t)mrow * D) + lane;
        f32x4 v[4]; float s = 0.f;
#pragma unroll
        for (int j = 0; j < 4; ++j) { v[j] = xr[64 * j]; s += (v[j][0] + v[j][1]) + (v[j][2] + v[j][3]); }
        const float mean = wave_sum(s) * (1.f / D); float s2 = 0.f;
#pragma unroll
        for (int j = 0; j < 4; ++j) { v[j] = v[j] - mean; s2 += (v[j][0] * v[j][0] + v[j][1] * v[j][1]) + (v[j][2] * v[j][2] + v[j][3] * v[j][3]); }
        const float rstd = __builtin_amdgcn_rsqf(wave_sum(s2) * (1.f / D) + LN_EPS);
        f32x4* orow = (f32x4*)(A.out + (size_t)mrow * D) + lane; v2u* brow = (v2u*)(x1b + (size_t)mrow * D) + lane;
#pragma unroll
        for (int j = 0; j < 4; ++j) { const f32x4 y = v[j] * rstd * gv[j] + bv[j]; orow[64 * j] = y; v2u w; w.x = pk2(y[0], y[1]); w.y = pk2(y[2], y[3]); brow[64 * j] = w; }
    }
}
namespace peer {
__device__ __forceinline__ int mono(float v) { const int b = __float_as_int(v); return b ^ ((b >> 31) & 0x7fffffff); }
__device__ __forceinline__ float unmono(int k) { return __int_as_float(k ^ ((k >> 31) & 0x7fffffff)); }
__device__ __forceinline__ int med3i(int a, int b, int c) { int r; asm("v_med3_i32 %0, %1, %2, %3" : "=v"(r) : "v"(a), "v"(b), "v"(c)); return r; }
#define PEER_INS16(a, x) do { _Pragma("unroll") for (int k_ = 15; k_ >= 1; --k_) a[k_] = med3i(a[k_ - 1], a[k_], (x)); a[0] = max(a[0], (x)); } while (0)
__device__ __forceinline__ unsigned byte_sel(const unsigned (&p)[4], int i) { const int w = i >> 2; const unsigned x = (w == 0) ? p[0] : (w == 1) ? p[1] : (w == 2) ? p[2] : p[3]; return (x >> ((i & 3) * 8)) & 0xffu; }
__device__ __forceinline__ float gelu_erf(float v) { return 0.5f * v * (1.f + erff(v * 0.7071067811865476f)); }

__device__ __forceinline__ void select(const float* ST, v2u* sel, int tok, int head) {
    int a0[16], a1[16];
#pragma unroll
    for (int k = 0; k < 16; ++k) { a0[k] = (int)0x80000000; a1[k] = (int)0x80000000; }
    const float* s0 = ST + (size_t)(head * 256) * T + tok; const float* s1 = s0 + (size_t)128 * T;
#pragma unroll 8
    for (int n = 0; n < 128; ++n) { const int k = (mono(s0[(size_t)n * T]) & ~127) | (127 - n); PEER_INS16(a0, k); }
#pragma unroll 8
    for (int n = 0; n < 128; ++n) { const int k = (mono(s1[(size_t)n * T]) & ~127) | (127 - n); PEER_INS16(a1, k); }
    float v0[16], v1[16]; unsigned i0p[4] = {0u, 0u, 0u, 0u}, i1p[4] = {0u, 0u, 0u, 0u};
#pragma unroll
    for (int k = 0; k < 16; ++k) { v0[k] = unmono((a0[k] & ~127) | 64); v1[k] = unmono((a1[k] & ~127) | 64);
        i0p[k >> 2] |= (unsigned)(127 - (a0[k] & 127)) << (8 * (k & 3)); i1p[k >> 2] |= (unsigned)(127 - (a1[k] & 127)) << (8 * (k & 3)); }
    int cd[16];
#pragma unroll
    for (int k = 0; k < 16; ++k) cd[k] = (int)0x80000000;
#pragma unroll
    for (int i = 0; i < 16; ++i)
#pragma unroll
        for (int j = 0; j < 16; ++j)
            if ((i + 1) * (j + 1) <= 16) { const int k = (mono(v0[i] + v1[j]) & ~255) | (255 - (i * 16 + j)); PEER_INS16(cd, k); }
    float sv[16], ex[16], sum = 0.f; unsigned eid[16];
#pragma unroll
    for (int k = 0; k < 16; ++k) { const int code = 255 - (cd[k] & 255); eid[k] = byte_sel(i0p, code >> 4) * 128u + byte_sel(i1p, code & 15); sv[k] = unmono((cd[k] & ~255) | 128); }
#pragma unroll
    for (int k = 0; k < 16; ++k) { ex[k] = __expf(sv[k] - sv[0]); sum += ex[k]; }
    const float rs = 1.f / sum;
    v4u* dst = (v4u*)(sel + ((size_t)tok * 8 + head) * 16);
#pragma unroll
    for (int k = 0; k < 8; ++k) { v4u w; w.x = eid[2 * k]; w.y = __float_as_uint(ex[2 * k] * rs); w.z = eid[2 * k + 1]; w.w = __float_as_uint(ex[2 * k + 1] * rs); dst[k] = w; }
}

typedef float f32x2v __attribute__((ext_vector_type(2)));
__device__ __forceinline__ void gather_token(const v2u* sel, const unsigned char* U8, const unsigned char* V8, const float* isu, const float* isv, float* xo, const float* gam, const float* bet, int tok, int lane) {
    float* xrow = xo + (size_t)tok * D + 16 * lane;
    f32x4 xv[4];
#pragma unroll
    for (int q = 0; q < 4; ++q) xv[q] = *(const f32x4*)(xrow + 4 * q);
    float acc[16];
#pragma unroll
    for (int k = 0; k < 16; ++k) acc[k] = 0.f;
    for (int head = 0; head < 8; ++head) {
        const v2u se = sel[((size_t)tok * 8 + head) * 16 + (lane & 15)];
        const unsigned eq = (unsigned)__shfl((int)se.x, lane >> 2);
        const float su = isu[eq], sv = isv[eq];
        float part[16];
        {
            v4u uu[16];
#pragma unroll
            for (int k = 0; k < 16; ++k) { const unsigned e = __builtin_amdgcn_readlane(se.x, k); uu[k] = *(const v4u*)(U8 + (size_t)e * D + 16 * lane); }
#pragma unroll
            for (int k = 0; k < 16; ++k) { float d0 = 0.f, d1 = 0.f;
#pragma unroll
                for (int q = 0; q < 4; ++q) { const unsigned w = uu[k][q]; const f32x2v a = __builtin_amdgcn_cvt_pk_f32_fp8((int)w, false), b = __builtin_amdgcn_cvt_pk_f32_fp8((int)w, true);
                    d0 += xv[q][0] * a[0]; d1 += xv[q][1] * a[1]; d0 += xv[q][2] * b[0]; d1 += xv[q][3] * b[1]; }
                part[k] = d0 + d1; }
        }
        float r8[8], r4[4], r2[2], r1;
#pragma unroll
        for (int i = 0; i < 8; ++i) { const bool up = (lane & 32) != 0; const float send = up ? part[i] : part[i + 8], keep = up ? part[i + 8] : part[i]; r8[i] = keep + __shfl_xor(send, 32); }
#pragma unroll
        for (int i = 0; i < 4; ++i) { const bool up = (lane & 16) != 0; const float send = up ? r8[i] : r8[i + 4], keep = up ? r8[i + 4] : r8[i]; r4[i] = keep + __shfl_xor(send, 16); }
#pragma unroll
        for (int i = 0; i < 2; ++i) { const bool up = (lane & 8) != 0; const float send = up ? r4[i] : r4[i + 2], keep = up ? r4[i + 2] : r4[i]; r2[i] = keep + __shfl_xor(send, 8); }
        { const bool up = (lane & 4) != 0; const float send = up ? r2[0] : r2[1], keep = up ? r2[1] : r2[0]; r1 = keep + __shfl_xor(send, 4); }
        r1 += __shfl_xor(r1, 2); r1 += __shfl_xor(r1, 1);
        const float gq = __uint_as_float((unsigned)__shfl((int)se.y, lane >> 2));
        const float wgt = gq * gelu_erf(r1 * su) * sv;
        {
            v4u vv[16];
#pragma unroll
            for (int k = 0; k < 16; ++k) { const unsigned e = __builtin_amdgcn_readlane(se.x, k); vv[k] = *(const v4u*)(V8 + (size_t)e * D + 16 * lane); }
#pragma unroll
            for (int k = 0; k < 16; ++k) { const float w = __uint_as_float(__builtin_amdgcn_readlane(__float_as_uint(wgt), 4 * k));
#pragma unroll
                for (int q = 0; q < 4; ++q) { const unsigned x = vv[k][q]; const f32x2v a = __builtin_amdgcn_cvt_pk_f32_fp8((int)x, false), b = __builtin_amdgcn_cvt_pk_f32_fp8((int)x, true);
                    acc[4 * q] += w * a[0]; acc[4 * q + 1] += w * a[1]; acc[4 * q + 2] += w * b[0]; acc[4 * q + 3] += w * b[1]; } }
        }
    }
    float rr[16], s = 0.f;
#pragma unroll
    for (int k = 0; k < 16; ++k) { rr[k] = ALPHA * xv[k >> 2][k & 3] + acc[k]; s += rr[k]; }
    const float mean = wave_sum(s) * (1.f / D); float s2 = 0.f;
#pragma unroll
    for (int k = 0; k < 16; ++k) { rr[k] -= mean; s2 += rr[k] * rr[k]; }
    const float rstd = __builtin_amdgcn_rsqf(wave_sum(s2) * (1.f / D) + LN_EPS);
#pragma unroll
    for (int q = 0; q < 4; ++q) { const f32x4 g = *(const f32x4*)(gam + 16 * lane + 4 * q), bb = *(const f32x4*)(bet + 16 * lane + 4 * q);
        f32x4 y; y[0] = rr[4 * q] * rstd * g[0] + bb[0]; y[1] = rr[4 * q + 1] * rstd * g[1] + bb[1]; y[2] = rr[4 * q + 2] * rstd * g[2] + bb[2]; y[3] = rr[4 * q + 3] * rstd * g[3] + bb[3];
        *(f32x4*)(xrow + 4 * q) = y; }
}
__device__ __forceinline__ void row_to_fp8(const float* src, unsigned char* dst, float* inv, int row, int lane) {
    const float* p = src + (size_t)row * D + 16 * lane;
    f32x4 v[4]; float am = 0.f;
#pragma unroll
    for (int q = 0; q < 4; ++q) { v[q] = *(const f32x4*)(p + 4 * q); am = fmaxf(am, fmaxf(fmaxf(fabsf(v[q][0]), fabsf(v[q][1])), fmaxf(fabsf(v[q][2]), fabsf(v[q][3])))); }
    am = wave_max(am);
    float s = 1.f, is = 1.f;
    if (am > 1e-30f) { const int eb = (__float_as_int(224.f / am) >> 23) & 0xff; if (eb > 0 && eb < 254) { s = __int_as_float(eb << 23); is = __int_as_float((254 - eb) << 23); } }
    v4u o;
#pragma unroll
    for (int q = 0; q < 4; ++q) { int w = 0; w = __builtin_amdgcn_cvt_pk_fp8_f32(v[q][0] * s, v[q][1] * s, w, false); w = __builtin_amdgcn_cvt_pk_fp8_f32(v[q][2] * s, v[q][3] * s, w, true); o[q] = (unsigned)w; }
    *(v4u*)(dst + (size_t)row * D + 16 * lane) = o;
    if (lane == 0) inv[row] = is;
}
}
constexpr int NPH = 8;
__global__ void __launch_bounds__(NWAVES * 64, 2) mk_fwd(Args args) {
    extern __shared__ __attribute__((aligned(16))) unsigned char lds_raw[];
    LAS unsigned char* lds = (LAS unsigned char*)lds_raw;
    volatile LAS unsigned* MISC = (volatile LAS unsigned*)(lds + MISC_OFF);
    const int tid0 = threadIdx.x, lane0 = tid0 & 63, wave = __builtin_amdgcn_readfirstlane(tid0 >> 6);
    const int G = gridDim.x, bx = blockIdx.x, vcu = (G % 8 == 0) ? (bx % 8) * (G / 8) + bx / 8 : bx;
    unsigned char* ws0 = args.ws;
    gu32* ctl = (gu32*)(ws0 + WS_CTL);
    for (int u = tid0; u < (LDS_BYTES - RING_BYTES) / 4; u += NWAVES * 64) ((LAS unsigned*)(lds + RING_BYTES))[u] = 0u;
    __syncthreads();
    XcdBarrier bar; bar.bar = (unsigned*)(ctl + CW_BAR); bar.x = 0; bar.st = nullptr;
    if (MK_N_LAUNCHES == 1) bar = xcd_barrier_post((unsigned*)(ctl + CW_BAR), MISC + 8);
    const int lo = args.ph_lo, hi = args.ph_hi;
#ifndef PH_MASK
#define PH_MASK 0xFF
#endif
#define IN(k) ((((PH_MASK) >> (k)) & 1) && lo <= (k) && (k) < hi)
#define SEAM(k) do { if (IN(k) && IN((k) + 1)) xcd_barrier(bar); } while (0)
    const int NGW = G * NWAVES;
#define SUB_BEGIN() unsigned char* ws = ws0; asm volatile("" : "+s"(ws)); const int lane = (int)__builtin_amdgcn_mbcnt_hi(~0u, __builtin_amdgcn_mbcnt_lo(~0u, 0u)), tid = wave * 64 + lane; (void)tid; (void)lane
#define PHASE_BEGIN() unsigned char* ws = ws0; asm volatile("" : "+s"(ws)); const int lane = (int)__builtin_amdgcn_mbcnt_hi(~0u, __builtin_amdgcn_mbcnt_lo(~0u, 0u)), tid = wave * 64 + lane; const int gw = vcu * NWAVES + wave; (void)gw; (void)lane; (void)tid

    if (IN(0)) { PHASE_BEGIN(); p0_prologue(args, lds, vcu, G, wave, lane); VM_WAIT(); __syncthreads(); SEAM(0); }

    if (IN(1)) { PHASE_BEGIN();
        pg8::Gemm g{(const pg8::bf16_t*)(ws + WS_A), (const pg8::bf16_t*)(ws + WS_WIN), T, INC, D}; pg8::StaticOrder S; S.init(T, INC, G, bx); S.rep = NREP(1);
        pg8::EpiInProj E{(pg8::bf16_t*)(ws + WS_QD), (pg8::bf16_t*)(ws + WS_KD), (pg8::bf16_t*)(ws + WS_VD), (pg8::bf16_t*)(ws + WS_LQ), (pg8::bf16_t*)(ws + WS_LK), (pg8::bf16_t*)(ws + WS_LV),
                         (pg8::bf16_t*)(ws + WS_GA), (pg8::bf16_t*)(ws + WS_GB)};
        pg8::gemm_phase<pg8::EpiInProj, pg8::StaticOrder, true, true>(lds, g, S, E);
        SEAM(1);
    }

    if (IN(2)) { PHASE_BEGIN();
#ifndef NO_DIFF
        {   SUB_BEGIN();
            const da::Tensors X{(const bf16*)(ws + WS_QD), (const bf16*)(ws + WS_KD), (const bf16*)(ws + WS_VD), (float*)(ws + WS_STASH), (bf16*)(ws + WS_YA),
                                args.in[I_DLAM], args.in[I_SUBG], args.in[I_RELB]};
            int cur_h = -1;
            float lam; { const float* dl = args.in[I_DLAM]; const float p1 = dl[lane] * dl[64 + lane], p2 = dl[128 + lane] * dl[192 + lane];
                lam = __uint_as_float(__builtin_amdgcn_readfirstlane(__float_as_uint(__expf(wave_sum(p1)) - __expf(wave_sum(p2)) + LAM_INIT))); }
            for (int rep_ = 0; rep_ < NREP(20); ++rep_)
            for (int p = vcu; p < 256; p += G) {
                const int bh = p >> 5, s = p & 31, b = bh >> 2, h = bh & 3;
                if (h != cur_h) {
                    __syncthreads();
                    const float* bd = (const float*)(ws + WS_BIASD) + h * BIAS_TAB; asm volatile("" : "+s"(bd));
                    for (int i = tid; i < BIAS_TAB; i += NWAVES * 64) ((LAS float*)(lds + da::LDS_BIAS))[i] = bd[i];
                    __syncthreads(); cur_h = h;
                }
                const float c31 = args.in[I_RELB][31 * 16 + h] * LOG2E;
                for (int k2 = 0; k2 < 2; ++k2) da::unit(X, b, h, k2 ? 63 - s : s, lds, bx, lam, c31);
            }
        }
#endif
#ifndef NO_DIL
        {   SUB_BEGIN();
            const dil::Tensors X{(const bf16*)(ws + WS_LQ), (const bf16*)(ws + WS_LK), (const bf16*)(ws + WS_LV), (bf16*)(ws + WS_YB)};
            int cur_h = -1;
            for (int rep_ = 0; rep_ < NREP(21); ++rep_)
            for (int u = vcu; u < 256; u += G) {
                const int bh = u >> 5, blk = u & 31, b = bh >> 2, h = bh & 3;
                if (h != cur_h) {
                    __syncthreads();
                    const float* blsrc = (const float*)(ws + WS_BIASL);
                    for (int i = tid; i < 3 * dil::BT; i += NWAVES * 64) { const int g = i / dil::BT, jj = i % dil::BT - dil::BT0;
                        ((LAS float*)(lds + dil::LDS_BL))[i] = (jj >= 0 && jj <= 128) ? blsrc[(g * 4 + h) * 132 + jj] : 0.f; }
                    __syncthreads(); cur_h = h;
                }
                for (int k2 = 0; k2 < 2; ++k2) dil::wave_tile(X, b, h, blk * 512, wave + 8 * k2, lds + dil::LDS_VST + wave * 4096, (const LAS float*)(lds + dil::LDS_BL), lane);
            }
            __syncthreads();
        }
#endif
        SEAM(2);
    }

    if (IN(3)) { PHASE_BEGIN();
        { pg8::Gemm g{(const pg8::bf16_t*)(ws + WS_YA), (const pg8::bf16_t*)(ws + WS_WBD), T, D, 512}; pg8::StaticOrder S; S.init(T, D, G, bx); S.rep = NREP(3);
          pg8::EpiGate1 E{(const pg8::bf16_t*)(ws + WS_GA), (pg8::bf16_t*)(ws + WS_GATED)};
          pg8::gemm_phase<pg8::EpiGate1, pg8::StaticOrder, true, true>(lds, g, S, E); }
        VM_WAIT(); __syncthreads();
        { pg8::Gemm g{(const pg8::bf16_t*)(ws + WS_YB), (const pg8::bf16_t*)(ws + WS_WBL), T, D, 256}; pg8::StaticOrder S; S.init(T, D, G, bx);
          pg8::EpiGate2 E{(const pg8::bf16_t*)(ws + WS_GB), (pg8::bf16_t*)(ws + WS_GATED)};
          pg8::gemm_phase<pg8::EpiGate2, pg8::StaticOrder, true, true>(lds, g, S, E); }
        SEAM(3);
    }

    if (IN(4)) { PHASE_BEGIN();
        pg8::Gemm g{(const pg8::bf16_t*)(ws + WS_GATED), (const pg8::bf16_t*)(ws + WS_WO), T, D, D}; pg8::StaticOrder S; S.init(T, D, G, bx); S.rep = NREP(4);
        pg8::EpiOut E{args.in[I_X], (float*)(ws + WS_R)};
        pg8::gemm_phase<pg8::EpiOut, pg8::StaticOrder, true, true>(lds, g, S, E);
        SEAM(4);
    }

    if (IN(5)) { PHASE_BEGIN();
        p5_ln1(args, vcu, G, wave, lane);
        for (int row = gw; row < 2 * NEXP; row += NGW) {
            if (row < NEXP) peer::row_to_fp8(args.in[I_PU], ws + WS_UU, (float*)(ws + WS_ISU), row, lane);
            else peer::row_to_fp8(args.in[I_PV], ws + WS_UV, (float*)(ws + WS_ISV), row - NEXP, lane);
        }
        SEAM(5);
    }

    if (IN(6)) { PHASE_BEGIN();
        pg8::Gemm g{(const pg8::bf16_t*)(ws + WS_WP), (const pg8::bf16_t*)(ws + WS_A), 2048, T, D}; pg8::StaticOrder S; S.init(2048, T, G, bx); S.rep = NREP(6);
        pg8::EpiScoreT E{(float*)(ws + WS_ST)};
        pg8::gemm_phase<pg8::EpiScoreT, pg8::StaticOrder, true, true>(lds, g, S, E);
        SEAM(6);
    }

    if (IN(7)) { PHASE_BEGIN();
        const float* ST = (const float*)(ws + WS_ST); v2u* sel = (v2u*)(ws + WS_SEL);
        for (int u = vcu; u < T / 128; u += G) {
            for (int p = 0; p < 2; ++p) peer::select(ST, sel, u * 128 + p * 64 + lane, wave);
            VM_WAIT(); __syncthreads();
            for (int i = 0; i < 16; ++i) peer::gather_token(sel, ws + WS_UU, ws + WS_UV, (const float*)(ws + WS_ISU), (const float*)(ws + WS_ISV), args.out, args.in[I_LN2G], args.in[I_LN2B], u * 128 + wave * 16 + i, lane);
            VM_WAIT(); __syncthreads();
        }
    }
#undef IN
#undef SEAM
}

extern "C" void kernel_launch(void* const* d_in, const int* in_sizes, int n_in, void* d_out, int out_size, void* d_ws, size_t ws_size, hipStream_t stream) {
    static int grid = 0;
    if (grid == 0) {
        if (n_in != 16 || in_sizes[0] != T * D || out_size != T * D || ws_size < WS_END) { fprintf(stderr, "kernel_launch: unexpected shapes (n_in %d, in0 %d, out %d, ws %zu); nothing launched\n", n_in, n_in > 0 ? in_sizes[0] : -1, out_size, ws_size); grid = -1; return; }
        int dev = 0, cus = 0, per_cu = 0;
        if (hipGetDevice(&dev) != hipSuccess || hipDeviceGetAttribute(&cus, hipDeviceAttributeMultiprocessorCount, dev) != hipSuccess) { grid = -1; return; }
        if (hipFuncSetAttribute((const void*)mk_fwd, hipFuncAttributeMaxDynamicSharedMemorySize, LDS_BYTES) != hipSuccess) { fprintf(stderr, "kernel_launch: hipFuncSetAttribute failed\n"); grid = -1; return; }
        if (hipOccupancyMaxActiveBlocksPerMultiprocessor(&per_cu, (const void*)mk_fwd, NWAVES * 64, LDS_BYTES) != hipSuccess || per_cu < 1) { fprintf(stderr, "kernel_launch: occupancy query reports %d\n", per_cu); per_cu = 1; }
        (void)hipGetLastError();
        grid = cus;
    }
    if (grid < 0) return;
    if (hipMemsetAsync((char*)d_ws + WS_CTL, 0, CTL_ZERO_BYTES, stream) != hipSuccess) return;
    Args a{};
    for (int i = 0; i < 16; ++i) a.in[i] = (const float*)d_in[i];
    a.out = (float*)d_out; a.ws = (unsigned char*)d_ws;
    for (int li = 0; li < MK_N_LAUNCHES; ++li) {
        a.ph_lo = (MK_N_LAUNCHES == 1) ? 0 : li; a.ph_hi = (MK_N_LAUNCHES == 1) ? NPH : li + 1;
        hipLaunchKernelGGL(mk_fwd, dim3(grid), dim3(NWAVES * 64), LDS_BYTES, stream, a);
    }
}
```

```cpp
#include <hip/hip_runtime.h>
#include <cstdio>
#include <cstdint>

#ifndef MK_N_LAUNCHES
#define MK_N_LAUNCHES 1
#endif

#ifndef REPEAT_PH
#define REPEAT_PH (-1)
#endif
#define NREP(k) ((REPEAT_PH) == (k) ? 2 : 1)

constexpr int BATCH = 2, SEQ = 16384, T = BATCH * SEQ, D = 1024, INC = 5888;
constexpr int OFF_DQ = 0, OFF_DK = 512, OFF_DV = 1024, OFF_LQ = 1536, OFF_LK = 2304, OFF_LV = 3072, OFF_GA = 3840, OFF_GB = 4864;
constexpr int NEXP = 16384;
constexpr float LOG2E = 1.4426950408889634f;
constexpr float QSCALE = 0.125f * LOG2E;
constexpr float ALPHA = 1.189207115002721f;
constexpr float LN_EPS = 1e-5f, SUBLN_EPS = 1e-5f;
constexpr float LAM_INIT = 0.2f;
constexpr int NTILE = SEQ / 64;
constexpr int BIAS_TAB = 2112, BIAS_GUARD = 256, DFAR = 1513;

constexpr size_t MiB = 1u << 20;
constexpr size_t WS_CTL = 0, CTL_ZERO_BYTES = 1 * MiB;
constexpr size_t WS_BIASD = 1 * MiB;
constexpr size_t WS_BIASL = 1 * MiB + 64 * 1024;
constexpr size_t WS_WIN = 8 * MiB, WS_WO = 20 * MiB, WS_WBD = 22 * MiB, WS_WBL = 23 * MiB, WS_WP = 24 * MiB;
constexpr size_t WS_A = 32 * MiB;
constexpr size_t WS_YA = WS_A, WS_YB = WS_A + 32 * MiB;
constexpr size_t WS_QD = 96 * MiB, WS_KD = 128 * MiB, WS_VD = 160 * MiB, WS_LQ = 192 * MiB, WS_LK = 240 * MiB, WS_LV = 288 * MiB, WS_GA = 336 * MiB, WS_GB = 400 * MiB;
constexpr size_t WS_STASH = 464 * MiB;
constexpr size_t WS_SEL = 464 * MiB;
constexpr size_t WS_GATED = 96 * MiB;
constexpr size_t WS_R = 160 * MiB;
constexpr size_t WS_ST = 96 * MiB;
constexpr size_t WS_UU = 352 * MiB, WS_UV = 384 * MiB;
constexpr size_t WS_LSE0 = 3 * MiB;
constexpr size_t WS_ISU = 2 * MiB, WS_ISV = 2 * MiB + 65536;
constexpr size_t WS_END = 512 * MiB;

constexpr int CW_BAR = 4096;
constexpr int NWAVES = 8;
constexpr int RING_BYTES = 131072, MISC_OFF = RING_BYTES + 320, LDS_BYTES = 147456;

#define GAS __attribute__((address_space(1)))
#define LAS __attribute__((address_space(3)))
typedef unsigned short bf16;
typedef unsigned v4u __attribute__((ext_vector_type(4)));
typedef unsigned v2u __attribute__((ext_vector_type(2)));
typedef float f32x4 __attribute__((ext_vector_type(4)));
typedef float f32x16 __attribute__((ext_vector_type(16)));
typedef short bf16x8 __attribute__((ext_vector_type(8)));
typedef short s16x4 __attribute__((ext_vector_type(4)));
typedef __bf16 bf16x2 __attribute__((ext_vector_type(2)));
typedef GAS unsigned gu32;
#define RLX_AGENT __ATOMIC_RELAXED, __HIP_MEMORY_SCOPE_AGENT
#define LDS_WAIT() asm volatile("s_waitcnt lgkmcnt(0)" ::: "memory")
#define VM_WAIT() asm volatile("s_waitcnt vmcnt(0)" ::: "memory")
__device__ __forceinline__ unsigned f2bf(float f) { unsigned u = __builtin_bit_cast(unsigned, f); return (u + 0x7fffu + ((u >> 16) & 1u)) >> 16; }
__device__ __forceinline__ unsigned pk2(float lo, float hi) { return f2bf(lo) | (f2bf(hi) << 16); }
typedef float f32x2_t __attribute__((ext_vector_type(2)));
__device__ __forceinline__ unsigned cvtpk(float lo, float hi) { f32x2_t v = {lo, hi}; bf16x2 b = __builtin_convertvector(v, bf16x2); return __builtin_bit_cast(unsigned, b); }
__device__ __forceinline__ float bf_lo(unsigned w) { return __builtin_bit_cast(float, w << 16); }
__device__ __forceinline__ float bf_hi(unsigned w) { return __builtin_bit_cast(float, w & 0xffff0000u); }
__device__ __forceinline__ float dot2bf(unsigned a, unsigned b, float acc) { return __builtin_amdgcn_fdot2_f32_bf16(__builtin_bit_cast(bf16x2, a), __builtin_bit_cast(bf16x2, b), acc, false); }
__device__ __forceinline__ float wave_sum(float v) {
#pragma unroll
    for (int o = 1; o < 64; o <<= 1) v += __shfl_xor(v, o);
    return v;
}
__device__ __forceinline__ float wave_max(float v) {
#pragma unroll
    for (int o = 1; o < 64; o <<= 1) v = fmaxf(v, __shfl_xor(v, o));
    return v;
}
__device__ __forceinline__ int rel_bucket(int n) {
    if (n < 16) return n < 0 ? 0 : n;
    return 16 + (n >= 22) + (n >= 30) + (n >= 40) + (n >= 54) + (n >= 73) + (n >= 99) + (n >= 134) + (n >= 182) + (n >= 246) + (n >= 332) + (n >= 450) + (n >= 609) + (n >= 825) + (n >= 1117) + (n >= 1513);
}
namespace pg8 {
#define PG8_LAS __attribute__((address_space(3)))
typedef unsigned short bf16_t;
typedef short bf16x8 __attribute__((ext_vector_type(8)));
typedef float f32x4 __attribute__((ext_vector_type(4)));
typedef unsigned u32x4 __attribute__((ext_vector_type(4)));
constexpr int BM = 256, BK = 64, HALF = 128, HTB = HALF * BK * 2  , STAGE_BYTES = 8 * HTB, NXCD = 8, WGM = 8;

__host__ __device__ __forceinline__ int lds_byte(int r, int c) { const int st = (r >> 4) * 2 + (c >> 5), rr = r & 15, cc = c & 31, ob = rr * 64 + cc * 2; return st * 1024 + (ob ^ (((ob >> 9) & 1) << 5)); }
__host__ __device__ __forceinline__ void stage_rc(int b, int& R, int& C) { const int st = b / 1024, sb = b % 1024, swz = sb ^ (((sb >> 9) & 1) << 5); R = (st >> 1) * 16 + swz / 64; C = (st & 1) * 32 + (swz % 64) / 2; }
__host__ __device__ __forceinline__ int perm32(int rho) { const int n = rho >> 4, i = rho & 15; return 8 * (i >> 2) + 4 * n + (i & 3); }

struct Unit { int pm, pn; };
struct Gemm { const bf16_t* A; const bf16_t* Bt; int M, N, K; };

struct StaticOrder {
    int nM, nN, nwg, G, c;
    __host__ __device__ void init(int M, int N, int G_, int c_) { nM = M / BM; nN = N / BM; nwg = nM * nN; G = G_; c = c_; }
    int rep = 1;
    __host__ __device__ bool next(int i0, Unit& u) const {
        const int i = i0 / rep;
        const long L = (long)i * G + c; if (L >= nwg) return false;
        int wgid = (int)L; { const int q = nwg / NXCD, r = nwg % NXCD, xcd = wgid % NXCD, off = wgid / NXCD; wgid = (xcd < r ? xcd * (q + 1) : r * (q + 1) + (xcd - r) * q) + off; }
        const int nig = WGM * nN, gid = wgid / nig, fm = gid * WGM, gsz = (nM - fm) < WGM ? (nM - fm) : WGM;
        u.pm = fm + ((wgid % nig) % gsz); u.pn = (wgid % nig) / gsz; return true;
    }
    __device__ __forceinline__ void a_ready(const Unit&) const {}
    __device__ __forceinline__ void done(const Unit&) const {}
};
__device__ __forceinline__ unsigned cvt_pk_bf16(float lo, float hi) { unsigned r; asm volatile("v_cvt_pk_bf16_f32 %0, %1, %2" : "=v"(r) : "v"(lo), "v"(hi)); return r; }
__device__ __forceinline__ u32x4 pack8(const f32x4 v0, const f32x4 v1) { u32x4 w; w.x = cvt_pk_bf16(v0[0], v0[1]); w.y = cvt_pk_bf16(v0[2], v0[3]); w.z = cvt_pk_bf16(v1[0], v1[1]); w.w = cvt_pk_bf16(v1[2], v1[3]); return w; }
__device__ __forceinline__ float blo(unsigned w) { return __builtin_bit_cast(float, w << 16); }
__device__ __forceinline__ float bhi(unsigned w) { return __builtin_bit_cast(float, w & 0xffff0000u); }
__device__ __forceinline__ float sigm(float v) { return __builtin_amdgcn_rcpf(1.f + __expf(-v)); }
template <class E> __device__ __forceinline__ void epi_loop(const E& e, const f32x4 (&acc)[2][2][4][2], const Unit& u, int wr, int wc, int fr, int fq) {
#pragma unroll
    for (int ai = 0; ai < 2; ++ai)
#pragma unroll
        for (int m = 0; m < 4; ++m) { const int row = u.pm * BM + ai * HALF + wr * 64 + m * 16 + fr;
#pragma unroll
            for (int bj = 0; bj < 2; ++bj) { const int col = u.pn * BM + bj * HALF + wc * 32 + 8 * fq; e.item(u.pn, row, col, acc[ai][bj][m][0], acc[ai][bj][m][1]); } }
}

struct EpiInProj {
    static constexpr bool PERM = true, AFTER_DRAIN = false;
    bf16_t *Qd, *Kd, *Vd, *LQ, *LK, *LV, *GA, *GB;
    __device__ __forceinline__ void operator()(const f32x4 (&acc)[2][2][4][2], const Unit& u, int wr, int wc, int fr, int fq) const { epi_loop(*this, acc, u, wr, wc, fr, fq); }
    __device__ __forceinline__ void item(int pn, int row, int col, f32x4 v0, f32x4 v1) const {
            const int b = row >> 14, s = row & 16383; bf16_t* dst;
            if (pn < 2) {
                const int h = col >> 7, c = (col >> 6) & 1, d = col & 63; v0 = v0 * 0.18033688011112042f; v1 = v1 * 0.18033688011112042f;
                dst = Qd + ((size_t)((b * 4 + h) * 2 + c) * 16384 + s) * 64 + d;
            } else if (pn < 4) {
                const int cc = col - 512, h = cc >> 7, c = (cc >> 6) & 1, d = cc & 63;
                dst = Kd + ((((size_t)((b * 4 + h) * 2 + c) * 256 + (s >> 6)) * 8 + (d >> 3)) * 64 + (s & 63)) * 8;
            } else if (pn < 6) {
                const int cc = col - 1024, h = cc >> 7, d = cc & 127;
                dst = Vd + ((size_t)(b * 4 + h) * 256 + (s >> 6)) * 8192 + ((d >> 5) * 4 + ((s & 63) >> 4)) * 512 + (s & 15) * 32 + (d & 31);
            } else if (pn < 9) {
                v0 = v0 * 0.18033688011112042f; v1 = v1 * 0.18033688011112042f; dst = LQ + (size_t)row * 768 + (col - 1536);
            } else if (pn < 12) { dst = LK + (size_t)row * 768 + (col - 2304);
            } else if (pn < 15) { dst = LV + (size_t)row * 768 + (col - 3072);
            } else {
#pragma unroll
                for (int i = 0; i < 4; ++i) { v0[i] = sigm(v0[i]); v1[i] = sigm(v1[i]); }
                dst = (pn < 19) ? GA + (size_t)row * 1024 + (col - 3840) : GB + (size_t)row * 1024 + (col - 4864);
            }
            *(u32x4*)dst = pack8(v0, v1);
        }
};
struct EpiGate1 {
    static constexpr bool PERM = true, AFTER_DRAIN = false;
    const bf16_t* GA; bf16_t* G;
    __device__ __forceinline__ void operator()(const f32x4 (&acc)[2][2][4][2], const Unit& u, int wr, int wc, int fr, int fq) const { epi_loop(*this, acc, u, wr, wc, fr, fq); }
    __device__ __forceinline__ void item(int pn, int row, int col, f32x4 v0, f32x4 v1) const {
            const size_t o = (size_t)row * 1024 + col; const u32x4 g = *(const u32x4*)(GA + o);
            v0[0] *= blo(g.x); v0[1] *= bhi(g.x); v0[2] *= blo(g.y); v0[3] *= bhi(g.y); v1[0] *= blo(g.z); v1[1] *= bhi(g.z); v1[2] *= blo(g.w); v1[3] *= bhi(g.w);
            *(u32x4*)(G + o) = pack8(v0, v1);
        }
};
struct EpiGate2 {
    static constexpr bool PERM = true, AFTER_DRAIN = false;
    const bf16_t* GB; bf16_t* G;
    __device__ __forceinline__ void operator()(const f32x4 (&acc)[2][2][4][2], const Unit& u, int wr, int wc, int fr, int fq) const { epi_loop(*this, acc, u, wr, wc, fr, fq); }
    __device__ __forceinline__ void item(int pn, int row, int col, f32x4 v0, f32x4 v1) const {
            const size_t o = (size_t)row * 1024 + col; const u32x4 g = *(const u32x4*)(GB + o); const u32x4 p = *(const u32x4*)(G + o);
            v0[0] = v0[0] * blo(g.x) + blo(p.x); v0[1] = v0[1] * bhi(g.x) + bhi(p.x); v0[2] = v0[2] * blo(g.y) + blo(p.y); v0[3] = v0[3] * bhi(g.y) + bhi(p.y);
            v1[0] = v1[0] * blo(g.z) + blo(p.z); v1[1] = v1[1] * bhi(g.z) + bhi(p.z); v1[2] = v1[2] * blo(g.w) + blo(p.w); v1[3] = v1[3] * bhi(g.w) + bhi(p.w);
            *(u32x4*)(G + o) = pack8(v0, v1);
        }
};
struct EpiOut {
    static constexpr bool PERM = true, AFTER_DRAIN = false;
    const float* X; float* R;
    __device__ __forceinline__ void operator()(const f32x4 (&acc)[2][2][4][2], const Unit& u, int wr, int wc, int fr, int fq) const { epi_loop(*this, acc, u, wr, wc, fr, fq); }
    __device__ __forceinline__ void item(int pn, int row, int col, f32x4 v0, f32x4 v1) const {
            const size_t o = (size_t)row * 1024 + col; const f32x4 x0 = *(const f32x4*)(X + o), x1 = *(const f32x4*)(X + o + 4);
            *(f32x4*)(R + o) = x0 * 1.189207115002721f + v0; *(f32x4*)(R + o + 4) = x1 * 1.189207115002721f + v1;
        }
};
struct EpiScoreT {
    static constexpr bool PERM = true, AFTER_DRAIN = false;
    float* ST;
    __device__ __forceinline__ void operator()(const f32x4 (&acc)[2][2][4][2], const Unit& u, int wr, int wc, int fr, int fq) const { epi_loop(*this, acc, u, wr, wc, fr, fq); }
    __device__ __forceinline__ void item(int pn, int row, int col, f32x4 v0, f32x4 v1) const { const size_t o = (size_t)row * 32768 + col; *(f32x4*)(ST + o) = v0; *(f32x4*)(ST + o + 4) = v1; }
};
template <class Epi, class Sched, bool ALIGN_EPI = false, bool SP2 = false>
__device__ __forceinline__ void gemm_phase(PG8_LAS unsigned char* lds, const Gemm g, const Sched& S, const Epi& E) {
    const int tid = threadIdx.x, wid = __builtin_amdgcn_readfirstlane(tid >> 6), lane = tid & 63, wr = wid >> 2, wc = wid & 3, fr = lane & 15, fq = lane >> 4;
    const int K = g.K, nt = K / BK;
    unsigned voffA[2], voffB[2];
#pragma unroll
    for (int i = 0; i < 2; ++i) { int R, C; stage_rc(tid * 16 + i * 8192, R, C); const int Rb = Epi::PERM ? ((R & ~31) + perm32(R & 31)) : R;
        voffA[i] = (unsigned)(R * K + C) * 2u; voffB[i] = (unsigned)(Rb * K + C) * 2u; }
    const size_t kstep = (size_t)(BK * 2);
    const size_t hstep = (size_t)HALF * K * 2;
    const size_t tstep = 2 * hstep;
    const unsigned ldsw = (unsigned)wid * 1024u;
    const int aoff = lds_byte(wr * 64 + fr, fq * 8), boff = lds_byte(wc * 32 + fr, fq * 8);
#define PG8_SA(b, h) (((b) * 2 + (h)) * HTB)
#define PG8_SB(b, h) ((4 + (b) * 2 + (h)) * HTB)
#define PG8_STAGE(bufoff, gbase, voff) do { _Pragma("unroll") for (int _i = 0; _i < 2; ++_i) \
        __builtin_amdgcn_global_load_lds((const unsigned*)((const char*)(gbase) + (voff)[_i]), (PG8_LAS unsigned*)(lds + (bufoff) + ldsw + _i * 8192), 16, 0, 0); } while (0)
#define PG8_LDA(dst, b, h) do { _Pragma("unroll") for (int m = 0; m < 4; ++m) _Pragma("unroll") for (int k = 0; k < 2; ++k) dst[m][k] = *(const PG8_LAS bf16x8*)(lds + PG8_SA(b, h) + aoff + m * 2048 + k * 1024); } while (0)
#define PG8_LDB(dst, b, h) do { _Pragma("unroll") for (int n = 0; n < 2; ++n) _Pragma("unroll") for (int k = 0; k < 2; ++k) dst[n][k] = *(const PG8_LAS bf16x8*)(lds + PG8_SB(b, h) + boff + n * 2048 + k * 1024); } while (0)
#define PG8_MMA(ai, bj, At, Bt) do { __builtin_amdgcn_s_setprio(1); _Pragma("unroll") for (int m = 0; m < 4; ++m) _Pragma("unroll") for (int n = 0; n < 2; ++n) _Pragma("unroll") for (int k = 0; k < 2; ++k) \
        acc[ai][bj][m][n] = __builtin_amdgcn_mfma_f32_16x16x32_bf16(Bt[n][k], At[m][k], acc[ai][bj][m][n], 0, 0, 0); __builtin_amdgcn_s_setprio(0); } while (0)
#define PG8_WAIT_V(n) asm volatile("s_waitcnt vmcnt(" #n ")" ::: "memory")
#define PG8_WAIT_L(n) asm volatile("s_waitcnt lgkmcnt(" #n ")" ::: "memory")
#define PG8_BAR __builtin_amdgcn_s_barrier()
#define PG8_SCHED __builtin_amdgcn_sched_barrier(0)
    Unit cur, nxt; int ui = 0;
    if (!S.next(0, cur)) return;
    f32x4 acc[2][2][4][2];
#pragma unroll
    for (int a = 0; a < 2; ++a)
#pragma unroll
        for (int b = 0; b < 2; ++b)
#pragma unroll
            for (int m = 0; m < 4; ++m)
#pragma unroll
                for (int n = 0; n < 2; ++n) acc[a][b][m][n] = (f32x4){0.f, 0.f, 0.f, 0.f};
    bf16x8 At[4][2], B0[2][2], B1[2][2];
    const char* cA = (const char*)g.A + (size_t)cur.pm * tstep; const char* cB = (const char*)g.Bt + (size_t)cur.pn * tstep;
    S.a_ready(cur);
    if constexpr (SP2) {
        PG8_STAGE(PG8_SB(0, 0), cB, voffB); PG8_STAGE(PG8_SB(0, 1), cB + hstep, voffB); PG8_STAGE(PG8_SA(0, 0), cA, voffA); PG8_STAGE(PG8_SA(0, 1), cA + hstep, voffA);
        if (wr == 1) PG8_BAR;
        PG8_WAIT_V(2); PG8_BAR;
        PG8_STAGE(PG8_SB(1, 0), cB + kstep, voffB); PG8_STAGE(PG8_SA(1, 0), cA + kstep, voffA); PG8_STAGE(PG8_SB(1, 1), cB + hstep + kstep, voffB);
        PG8_WAIT_V(6); PG8_BAR;
    } else {
        PG8_STAGE(PG8_SB(0, 0), cB, voffB); PG8_STAGE(PG8_SA(0, 0), cA, voffA); PG8_STAGE(PG8_SB(0, 1), cB + hstep, voffB); PG8_STAGE(PG8_SA(0, 1), cA + hstep, voffA);
        if (wr == 1) PG8_BAR;
        PG8_WAIT_V(4); PG8_BAR;
        PG8_STAGE(PG8_SB(1, 0), cB + kstep, voffB); PG8_STAGE(PG8_SA(1, 0), cA + kstep, voffA); PG8_STAGE(PG8_SB(1, 1), cB + hstep + kstep, voffB);
        PG8_WAIT_V(6); PG8_BAR;
    }
    for (;;) {
        const bool has_next = S.next(ui + 1, nxt);
        const char* nA = has_next ? (const char*)g.A + (size_t)nxt.pm * tstep : cA; const char* nB = has_next ? (const char*)g.Bt + (size_t)nxt.pn * tstep : cB;
        for (int t = 0; t < nt; t += 2) {
            const bool last = (t == nt - 2);
            const char* a1 = cA + (size_t)(t + 1) * kstep;
            const char* a2 = last ? nA : cA + (size_t)(t + 2) * kstep; const char* b2 = last ? nB : cB + (size_t)(t + 2) * kstep;
            const char* a3 = a2 + kstep; const char* b3 = b2 + kstep;
            if (last && has_next) S.a_ready(nxt);
            if constexpr (SP2) {
            PG8_LDB(B0, 0, 0); PG8_LDB(B1, 0, 1); PG8_SCHED; PG8_LDA(At, 0, 0); PG8_STAGE(PG8_SA(1, 1), a1 + hstep, voffA);
            PG8_WAIT_V(8); PG8_WAIT_L(0); PG8_BAR; PG8_MMA(0, 0, At, B0); PG8_MMA(0, 1, At, B1); PG8_BAR; PG8_SCHED;
            PG8_LDA(At, 0, 1); PG8_STAGE(PG8_SB(0, 0), b2, voffB); PG8_STAGE(PG8_SB(0, 1), b2 + hstep, voffB); PG8_STAGE(PG8_SA(0, 0), a2, voffA);
            PG8_WAIT_V(8); PG8_WAIT_L(0); PG8_BAR; PG8_MMA(1, 0, At, B0); PG8_MMA(1, 1, At, B1); PG8_BAR; PG8_SCHED;
            PG8_LDB(B0, 1, 0); PG8_LDB(B1, 1, 1); PG8_SCHED; PG8_LDA(At, 1, 0); PG8_STAGE(PG8_SA(0, 1), a2 + hstep, voffA);
            PG8_WAIT_V(8); PG8_WAIT_L(0); PG8_BAR; PG8_MMA(0, 0, At, B0); PG8_MMA(0, 1, At, B1); PG8_BAR; PG8_SCHED;
            PG8_LDA(At, 1, 1); PG8_STAGE(PG8_SB(1, 0), b3, voffB); PG8_STAGE(PG8_SB(1, 1), b3 + hstep, voffB); PG8_STAGE(PG8_SA(1, 0), a3, voffA);
            PG8_WAIT_V(8); PG8_WAIT_L(0); PG8_BAR; PG8_MMA(1, 0, At, B0); PG8_MMA(1, 1, At, B1); PG8_BAR; PG8_SCHED;
            } else {
            PG8_LDB(B0, 0, 0); PG8_SCHED; PG8_LDA(At, 0, 0); PG8_STAGE(PG8_SA(1, 1), a1 + hstep, voffA);
            PG8_WAIT_L(8); PG8_BAR; PG8_WAIT_L(0); PG8_MMA(0, 0, At, B0); PG8_BAR; PG8_SCHED;
            PG8_LDB(B1, 0, 1); PG8_STAGE(PG8_SB(0, 0), b2, voffB);
            PG8_BAR; PG8_WAIT_L(0); PG8_MMA(0, 1, At, B1); PG8_BAR;
            PG8_LDA(At, 0, 1); PG8_STAGE(PG8_SA(0, 0), a2, voffA);
            PG8_BAR; PG8_WAIT_L(0); PG8_MMA(1, 0, At, B0); PG8_BAR; PG8_SCHED;
            PG8_STAGE(PG8_SB(0, 1), b2 + hstep, voffB);
            PG8_WAIT_V(6); PG8_BAR; PG8_MMA(1, 1, At, B1); PG8_BAR;
            PG8_LDB(B0, 1, 0); PG8_SCHED; PG8_LDA(At, 1, 0); PG8_STAGE(PG8_SA(0, 1), a2 + hstep, voffA);
            PG8_WAIT_L(8); PG8_BAR; PG8_WAIT_L(0); PG8_MMA(0, 0, At, B0); PG8_BAR; PG8_SCHED;
            PG8_LDB(B1, 1, 1); PG8_STAGE(PG8_SB(1, 0), b3, voffB);
            PG8_BAR; PG8_WAIT_L(0); PG8_MMA(0, 1, At, B1); PG8_BAR;
            PG8_LDA(At, 1, 1); PG8_STAGE(PG8_SA(1, 0), a3, voffA);
            PG8_BAR; PG8_WAIT_L(0); PG8_MMA(1, 0, At, B0); PG8_BAR; PG8_SCHED;
            PG8_STAGE(PG8_SB(1, 1), b3 + hstep, voffB);
            PG8_WAIT_V(6); PG8_BAR; PG8_MMA(1, 1, At, B1); PG8_BAR;
            }
        }
        if constexpr (ALIGN_EPI) { if (wr == 0) PG8_BAR; }
        if constexpr (!Epi::AFTER_DRAIN) { E(acc, cur, wr, wc, fr, fq); S.done(cur); }
        if (!has_next) break;
#pragma unroll
        for (int a = 0; a < 2; ++a)
#pragma unroll
            for (int b = 0; b < 2; ++b)
#pragma unroll
                for (int m = 0; m < 4; ++m)
#pragma unroll
                    for (int n = 0; n < 2; ++n) acc[a][b][m][n] = (f32x4){0.f, 0.f, 0.f, 0.f};
        cur = nxt; cA = nA; cB = nB; ++ui;
        if constexpr (ALIGN_EPI) { if (wr == 1) PG8_BAR; }
    }
    PG8_WAIT_V(0);
    if constexpr (!ALIGN_EPI) { if (wr == 0) PG8_BAR; }
    PG8_BAR;
    if constexpr (Epi::AFTER_DRAIN) { E.fused(acc, cur, wr, wc, fr, fq, lds, wid, lane); S.done(cur); }
#undef PG8_SA
#undef PG8_SB
#undef PG8_STAGE
#undef PG8_LDA
#undef PG8_LDB
#undef PG8_MMA
#undef PG8_WAIT_V
#undef PG8_WAIT_L
#undef PG8_BAR
#undef PG8_SCHED
}
}
#define XB_TMO      128
#define XB_XCNT(j)  (256  + 64 * (j))
#define XB_XSUB(j)  (1280 + 64 * (j))
#define XB_XGEN(j)  (2304 + 64 * (j))
#define XB_TOP      3328
#define XB_TOPGEN   3392
#define XCD_BAR_WORDS 3456
#define XB_SPIN_CAP (1u << 18)

__device__ __forceinline__ unsigned xb_ld(unsigned* p)              { return __hip_atomic_load(p, __ATOMIC_RELAXED, __HIP_MEMORY_SCOPE_AGENT); }
__device__ __forceinline__ unsigned xb_add(unsigned* p, unsigned v) { return __hip_atomic_fetch_add(p, v, __ATOMIC_RELAXED, __HIP_MEMORY_SCOPE_AGENT); }
__device__ __forceinline__ unsigned xb_xcc_id() { return (unsigned)__builtin_amdgcn_s_getreg((3 << 11) | 20) & 0xFu; }
#define XB_SPIN(cond, bar) do { unsigned _sp = 0; while (cond) { __builtin_amdgcn_s_sleep(1); \
    if ((++_sp & 255u) == 0u) { if (xb_ld(&(bar)[XB_TMO])) break; if (_sp > XB_SPIN_CAP) { atomicAdd(&(bar)[XB_TMO], 1u); break; } } } } while (0)

struct XcdBarrier {
    unsigned* bar; unsigned x;
    volatile LAS unsigned* st;
};

__device__ __forceinline__ XcdBarrier xcd_barrier_post(unsigned* bar, volatile LAS unsigned* st) {
    XcdBarrier b; b.bar = bar; b.x = xb_xcc_id(); b.st = st;
    if (threadIdx.x == 0) (void)xb_add(&bar[XB_XCNT(b.x)], 1u);
    return b;
}
__device__ __forceinline__ void xcd_barrier_complete(unsigned* bar, unsigned x, unsigned& nloc, unsigned& nx) {
    const unsigned G = gridDim.x * gridDim.y * gridDim.z;
    unsigned sum, cnt, mine, sp = 0u;
    for (;;) {
        sum = 0u; cnt = 0u; mine = 0u;
#pragma unroll
        for (unsigned j = 0; j < 16; ++j) { const unsigned c = xb_ld(&bar[XB_XCNT(j)]); sum += c; cnt += (c > 0u) ? 1u : 0u; mine = (j == x) ? c : mine; }
        if (sum == G) break;
        __builtin_amdgcn_s_sleep(1);
        if ((++sp & 255u) == 0u) { if (xb_ld(&bar[XB_TMO])) break; if (sp > XB_SPIN_CAP) { atomicAdd(&bar[XB_TMO], 1u); break; } }
    }
    nloc = mine > 0u ? mine : 1u; nx = cnt > 0u ? cnt : 1u;
}

__device__ __forceinline__ void xcd_barrier(const XcdBarrier& b) {
    asm volatile("s_waitcnt vmcnt(0)" ::: "memory");
    __syncthreads();
    if (threadIdx.x == 0) {
        unsigned* bar = b.bar;
        __builtin_amdgcn_s_waitcnt(0);
        unsigned nloc = b.st[0], nx = b.st[1];
        if (nloc == 0u) { xcd_barrier_complete(bar, b.x, nloc, nx); b.st[0] = nloc; b.st[1] = nx; }
        const unsigned old = xb_add(&bar[XB_XSUB(b.x)], 1u);
        const unsigned gen = old / nloc;
        if (old + 1u == (gen + 1u) * nloc) {
            __builtin_amdgcn_fence(__ATOMIC_RELEASE, "agent");
            asm volatile("s_waitcnt vmcnt(0)" ::: "memory");
            const unsigned og = xb_add(&bar[XB_TOP], 1u);
            const unsigned tg = og / nx;
            if (og + 1u == (tg + 1u) * nx) xb_add(&bar[XB_TOPGEN], 1u);
            else XB_SPIN(xb_ld(&bar[XB_TOPGEN]) == tg, bar);
            __builtin_amdgcn_fence(__ATOMIC_ACQUIRE, "agent");
            xb_add(&bar[XB_XGEN(b.x)], 1u);
            asm volatile("s_waitcnt vmcnt(0)" ::: "memory");
        } else {
            XB_SPIN(xb_ld(&bar[XB_XGEN(b.x)]) == gen, bar);
            __builtin_amdgcn_fence(__ATOMIC_ACQUIRE, "agent");
            asm volatile("s_waitcnt vmcnt(0)" ::: "memory");
        }
    }
    __syncthreads();
}
namespace da {
constexpr int SLOT_K = 8192, SLOT_V = 16384, SLOT = SLOT_K + SLOT_V;
constexpr int NSLOT = 4;
constexpr int LDS_BIAS = NSLOT * SLOT;
constexpr int LDS_END = LDS_BIAS + BIAS_TAB * 4;
constexpr float THR = 8.f;
__device__ __forceinline__ int crow(int r, int hi) { return (r & 3) + 8 * (r >> 2) + 4 * hi; }
__device__ __forceinline__ void glds16(const void* gbase  , unsigned voff  , unsigned lds_dst) { unsigned keep;
    asm volatile("s_mov_b32 %0, m0\n\ts_mov_b32 m0, %3\n\ts_nop 0\n\tglobal_load_lds_dwordx4 %1, %2\n\ts_mov_b32 m0, %0" : "=&s"(keep) : "v"(voff), "s"(gbase), "s"(lds_dst) : "memory"); }
typedef short v4i16_t __attribute__((ext_vector_type(4)));
__device__ __forceinline__ s16x4 vtr(const LAS char* p) { return __builtin_bit_cast(s16x4, __builtin_amdgcn_ds_read_tr16_b64_v4i16((LAS v4i16_t*)p)); }
#define DA_WAIT_BAR() asm volatile("s_waitcnt vmcnt(0) lgkmcnt(0)\n\ts_barrier" ::: "memory")

struct Tensors { const bf16* Qd; const bf16* Kd; const bf16* Vd; float* stash; bf16* ya; const float* dlam; const float* subg; const float* relb; };

__device__ __forceinline__ float max3f(float a, float b, float c) { float r; asm("v_max3_f32 %0, %1, %2, %3" : "=v"(r) : "v"(a), "v"(b), "v"(c)); return r; }
#define DA_STAGE_Q(T_) do { const int t_ = (T_); const LAS char* kb_ = kp0 + (t_ & 3) * SLOT; \
        bf16x8 kf_[8]; \
        _Pragma("unroll") for (int d0 = 0; d0 < 2; ++d0) { kf_[2 * d0] = *(const LAS bf16x8*)(kb_ + d0 * 2048); kf_[2 * d0 + 1] = *(const LAS bf16x8*)(kb_ + d0 * 2048 + 512); } \
        if ((q0 - 64 * t_ - 63) < DFAR) { int base_ = qabs - 64 * t_ - 4 * hi + BIAS_GUARD; asm volatile("" : "+v"(base_)); \
            _Pragma("unroll") for (int r = 0; r < 16; ++r) { const int o_ = (r & 3) + 8 * (r >> 2); p0[r] = tb[base_ - o_] - m; p1[r] = tb[base_ - o_ - 32] - m; } \
            _Pragma("unroll") for (int d0 = 0; d0 < 4; ++d0) { if (d0 < 2) { kf_[2 * d0 + 4] = *(const LAS bf16x8*)(kb_ + (d0 + 2) * 2048); kf_[2 * d0 + 5] = *(const LAS bf16x8*)(kb_ + (d0 + 2) * 2048 + 512); } \
                p0 = __builtin_amdgcn_mfma_f32_32x32x16_bf16(kf_[2 * d0], qr[d0], p0, 0, 0, 0); p1 = __builtin_amdgcn_mfma_f32_32x32x16_bf16(kf_[2 * d0 + 1], qr[d0], p1, 0, 0, 0); } \
        } else { f32x16 ci_; const float cm_ = c31 - m; _Pragma("unroll") for (int r = 0; r < 16; ++r) ci_[r] = cm_; \
            _Pragma("unroll") for (int d0 = 0; d0 < 4; ++d0) { if (d0 < 2) { kf_[2 * d0 + 4] = *(const LAS bf16x8*)(kb_ + (d0 + 2) * 2048); kf_[2 * d0 + 5] = *(const LAS bf16x8*)(kb_ + (d0 + 2) * 2048 + 512); } \
                p0 = __builtin_amdgcn_mfma_f32_32x32x16_bf16(kf_[2 * d0], qr[d0], d0 == 0 ? ci_ : p0, 0, 0, 0); p1 = __builtin_amdgcn_mfma_f32_32x32x16_bf16(kf_[2 * d0 + 1], qr[d0], d0 == 0 ? ci_ : p1, 0, 0, 0); } } \
    } while (0)
#ifdef PROBE_B
#define DA_PROBE_B() do { float dsum_ = 0.f; _Pragma("unroll") for (int r = 0; r < 16; ++r) { dsum_ += __builtin_amdgcn_exp2f(p0[r] - 1.f) + __builtin_amdgcn_exp2f(p1[r] - 2.f); } asm volatile("" :: "v"(dsum_)); } while (0)
#else
#define DA_PROBE_B() do {} while (0)
#endif
#define DA_STAGE_S(T_) do { const int t_ = (T_); \
        if (t_ >= NT - 4) { int base_ = qabs - 64 * t_ - 4 * hi + BIAS_GUARD; asm volatile("" : "+v"(base_)); \
            _Pragma("unroll") for (int r = 0; r < 16; ++r) { const int o_ = (r & 3) + 8 * (r >> 2); if (base_ - o_ < BIAS_GUARD) p0[r] = -1e30f; if (base_ - o_ - 32 < BIAS_GUARD) p1[r] = -1e30f; } } \
        float ra_ = max3f(p0[0], p0[1], p1[0]), rb_ = max3f(p0[2], p0[3], p1[1]); ra_ = max3f(ra_, p1[2], p1[3]); \
        _Pragma("unroll") for (int r = 4; r < 16; r += 4) { ra_ = max3f(ra_, p0[r], p0[r + 1]); rb_ = max3f(rb_, p0[r + 2], p0[r + 3]); ra_ = max3f(ra_, p1[r], p1[r + 1]); rb_ = max3f(rb_, p1[r + 2], p1[r + 3]); } \
        float rm_ = fmaxf(ra_, rb_); \
        { auto rr_ = __builtin_amdgcn_permlane32_swap(__float_as_uint(rm_), __float_as_uint(rm_), false, false); rm_ = fmaxf(__uint_as_float(rr_[0]), __uint_as_float(rr_[1])); } \
        if (t_ == 0 || __any(rm_ > THR)) { const float dl_ = (t_ == 0) ? rm_ : fmaxf(rm_, 0.f), f_ = __builtin_amdgcn_exp2f(-dl_); \
            _Pragma("unroll") for (int r = 0; r < 16; ++r) { p0[r] -= dl_; p1[r] -= dl_; } \
            _Pragma("unroll") for (int d0 = 0; d0 < 4; ++d0) _Pragma("unroll") for (int r = 0; r < 16; ++r) o[d0][r] *= f_; \
            l *= f_; m += dl_; } \
        float ls0_ = 0.f, ls1_ = 0.f; \
        _Pragma("unroll") for (int r = 0; r < 16; ++r) { p0[r] = __builtin_amdgcn_exp2f(p0[r]); p1[r] = __builtin_amdgcn_exp2f(p1[r]); ls0_ += p0[r]; ls1_ += p1[r]; } \
        l += ls0_ + ls1_; DA_PROBE_B(); \
        { v4u w; \
          w.x = cvtpk(p0[0], p0[1]); w.y = cvtpk(p0[2], p0[3]); w.z = cvtpk(p0[4], p0[5]); w.w = cvtpk(p0[6], p0[7]); pw[0] = __builtin_bit_cast(bf16x8, w); \
          w.x = cvtpk(p0[8], p0[9]); w.y = cvtpk(p0[10], p0[11]); w.z = cvtpk(p0[12], p0[13]); w.w = cvtpk(p0[14], p0[15]); pw[1] = __builtin_bit_cast(bf16x8, w); \
          w.x = cvtpk(p1[0], p1[1]); w.y = cvtpk(p1[2], p1[3]); w.z = cvtpk(p1[4], p1[5]); w.w = cvtpk(p1[6], p1[7]); pw[2] = __builtin_bit_cast(bf16x8, w); \
          w.x = cvtpk(p1[8], p1[9]); w.y = cvtpk(p1[10], p1[11]); w.z = cvtpk(p1[12], p1[13]); w.w = cvtpk(p1[14], p1[15]); pw[3] = __builtin_bit_cast(bf16x8, w); } \
    } while (0)
#define DA_VF(V_, ks) (bf16x8){V_[2 * (ks)][0], V_[2 * (ks)][1], V_[2 * (ks)][2], V_[2 * (ks)][3], V_[2 * (ks) + 1][0], V_[2 * (ks) + 1][1], V_[2 * (ks) + 1][2], V_[2 * (ks) + 1][3]}
#define DA_STAGE_B(T_) do { const LAS char* vb_ = vp0 + ((T_) & 3) * SLOT; \
        _Pragma("unroll") for (int d0 = 0; d0 < 4; ++d0) { s16x4 vA[8]; \
            _Pragma("unroll") for (int ks = 0; ks < 4; ++ks) { vA[2 * ks] = vtr(vb_ + d0 * 4096 + ks * 1024); vA[2 * ks + 1] = vtr(vb_ + d0 * 4096 + ks * 1024 + 512); } \
            _Pragma("unroll") for (int ks = 0; ks < 4; ++ks) o[d0] = __builtin_amdgcn_mfma_f32_32x32x16_bf16(DA_VF(vA, ks), pw[ks], o[d0], 0, 0, 0); \
            __builtin_amdgcn_sched_barrier(0); } \
    } while (0)
__device__ __forceinline__ void unit(const Tensors& X, int b, int h, int qb, LAS unsigned char* lds, int wgslot, float lam, float c31) {
    const int wid = __builtin_amdgcn_readfirstlane((int)threadIdx.x >> 6);
    const int grp = wid >> 2;
    const int q0 = qb * 256, NT = 4 * (qb + 1);
    const unsigned lds0 = (unsigned)(uintptr_t)lds;
    const LAS float* tb = (const LAS float*)(lds + LDS_BIAS);
    for (int c = 0; c < 2; ++c) {
        int lane = (int)__builtin_amdgcn_mbcnt_hi(~0u, __builtin_amdgcn_mbcnt_lo(~0u, 0u)); asm volatile("" : "+v"(lane));
        const int r32 = lane & 31, hi = lane >> 5;
        const unsigned lane16 = (unsigned)lane * 16u;
        const int qabs = q0 + wid * 32 + r32;
        const LAS char* vp0 = (const LAS char*)lds + SLOT_K + ((lane >> 4) & 1) * 32 + (lane & 3) * 8 + (4 * hi + ((lane & 15) >> 2)) * 64;
        const LAS char* kp0 = (const LAS char*)lds + hi * 1024 + r32 * 16;
        const int bhc = (b * 4 + h) * 2 + c;
        const bf16* Qw = X.Qd + ((size_t)bhc * SEQ + q0 + wid * 32 + r32) * 64 + hi * 8;
        const char* Kt = (const char*)X.Kd + (size_t)bhc * NTILE * SLOT_K + wid * 1024;
        const char* Vt = (const char*)X.Vd + (size_t)(b * 4 + h) * NTILE * SLOT_V + wid * 1024;
#define DA_DMA(t, slot) do { const unsigned sb_ = (unsigned)__builtin_amdgcn_readfirstlane(lds0 + (slot) * SLOT + wid * 1024); \
        glds16(Kt + (size_t)(t) * SLOT_K, lane16, sb_); glds16(Vt + (size_t)(t) * SLOT_V, lane16, sb_ + SLOT_K); glds16(Vt + (size_t)(t) * SLOT_V + 8192, lane16, sb_ + SLOT_K + 8192); } while (0)
        DA_DMA(0, 0); DA_DMA(1, 1); DA_DMA(2, 2);
        bf16x8 qr[4];
#pragma unroll
        for (int d0 = 0; d0 < 4; ++d0) qr[d0] = *(const bf16x8*)(Qw + d0 * 16);
        f32x16 o[4];
#pragma unroll
        for (int d0 = 0; d0 < 4; ++d0)
#pragma unroll
            for (int r = 0; r < 16; ++r) o[d0][r] = 0.f;
        float m = 0.f, l = 0.f;
        bf16x8 pw[4]; f32x16 p0, p1;
        asm volatile("" :: "v"(qr[0]), "v"(qr[1]), "v"(qr[2]), "v"(qr[3]));
        asm volatile("s_waitcnt vmcnt(6) lgkmcnt(0)\n\ts_barrier" ::: "memory");
        DA_STAGE_Q(0);
#define DA_TILE_BARRIER(t) do { \
            if ((t) + 1 < NT) asm volatile("s_waitcnt vmcnt(3) lgkmcnt(0)\n\ts_barrier" ::: "memory"); else asm volatile("s_waitcnt vmcnt(0) lgkmcnt(0)\n\ts_barrier" ::: "memory"); \
            if ((t) + 2 < NT) { const int sn_ = ((t) + 2) & 3; DA_DMA((t) + 2, sn_); } } while (0)
        for (int t = 1; t <= NT; ++t) {
            if (grp == 1) DA_TILE_BARRIER(t);
            DA_STAGE_S(t - 1);
            if (grp == 0) DA_TILE_BARRIER(t);
            __builtin_amdgcn_sched_barrier(0);
            DA_STAGE_B(t - 1);
#ifdef PROBE_A
            { f32x16 dz = {0.f,0.f,0.f,0.f,0.f,0.f,0.f,0.f,0.f,0.f,0.f,0.f,0.f,0.f,0.f,0.f};
              _Pragma("unroll") for (int rep = 0; rep < 4; ++rep) _Pragma("unroll") for (int ks = 0; ks < 4; ++ks) dz = __builtin_amdgcn_mfma_f32_32x32x16_bf16(pw[ks], pw[3 - ks], dz, 0, 0, 0);
              asm volatile("" :: "v"(dz)); }
#endif
            if (t < NT) DA_STAGE_Q(t);
        }
#undef DA_TILE_BARRIER
#undef DA_DMA
        { auto rr = __builtin_amdgcn_permlane32_swap(__float_as_uint(l), __float_as_uint(l), false, false); l = __uint_as_float(rr[0]) + __uint_as_float(rr[1]); }
        const float inv = 1.f / l;
        int lane_e = lane; asm volatile("" : "+v"(lane_e));
        GAS float* stg = (GAS float*)(X.stash + ((size_t)(wgslot * 8 + wid) * 64) * 64 + lane_e);
        if (c == 0) {
#pragma unroll
            for (int d0 = 0; d0 < 4; ++d0)
#pragma unroll
                for (int r = 0; r < 16; ++r) stg[(d0 * 16 + r) * 64] = o[d0][r] * inv;
        } else {
            float ss = 0.f;
#pragma unroll
            for (int d0 = 0; d0 < 4; ++d0)
#pragma unroll
                for (int r = 0; r < 16; ++r) { const float dv = stg[(d0 * 16 + r) * 64] - lam * (o[d0][r] * inv); o[d0][r] = dv; ss += dv * dv; if (r == 15) asm volatile("" ::: "memory"); }
            { auto rr = __builtin_amdgcn_permlane32_swap(__float_as_uint(ss), __float_as_uint(ss), false, false); ss = __uint_as_float(rr[0]) + __uint_as_float(rr[1]); }
            const float rn = __builtin_amdgcn_rsqf(ss * (1.f / 128.f) + SUBLN_EPS) * (1.f - LAM_INIT);
            const int hi_e = lane_e >> 5, qabs_e = q0 + wid * 32 + (lane_e & 31);
            bf16* yrow = X.ya + ((size_t)b * SEQ + qabs_e) * 512 + h * 128 + 4 * hi_e; const float* sg = X.subg + 4 * hi_e;
#pragma unroll
            for (int d0 = 0; d0 < 4; ++d0)
#pragma unroll
                for (int r4 = 0; r4 < 4; ++r4) {
                    const int dd = 32 * d0 + 8 * r4; const f32x4 g = *(const f32x4*)(sg + dd);
                    v2u w; w.x = pk2(o[d0][4 * r4] * rn * g[0], o[d0][4 * r4 + 1] * rn * g[1]); w.y = pk2(o[d0][4 * r4 + 2] * rn * g[2], o[d0][4 * r4 + 3] * rn * g[3]);
                    *(v2u*)(yrow + dd) = w;
                }
        }
    }
    asm volatile("s_waitcnt vmcnt(0) lgkmcnt(0)\n\ts_barrier" ::: "memory");
}
#undef DA_STAGE_Q
#undef DA_STAGE_S
#undef DA_STAGE_B
#undef DA_VF
#undef DA_WAIT_BAR
}
namespace dil {
constexpr int BT = 1152, BT0 = 512;
constexpr int LDS_VST = 0, LDS_BL = 32768, LDS_END = LDS_BL + 3 * BT * 4;
constexpr float THR = 8.f;
struct Tensors { const bf16* LQ; const bf16* LK; const bf16* LV; bf16* yb; };
typedef short v4i16_t __attribute__((ext_vector_type(4)));
__device__ __forceinline__ s16x4 vtr(const LAS unsigned char* p) { return __builtin_bit_cast(s16x4, __builtin_amdgcn_ds_read_tr16_b64_v4i16((LAS v4i16_t*)p)); }

template <int G_, int QS_> __device__ __forceinline__ void group(const Tensors& X, size_t rowb, int h, int P0, int r, LAS unsigned char* vst, const LAS float* blg, int lane, f32x16 (&o)[2], float& m, float& l) {
    constexpr int DL = (G_ == 0) ? 1 : (G_ == 1) ? 4 : 16, MG = QS_ / DL, NKB = (31 * MG + 128) / 32 + 1;
    static_assert(QS_ % DL == 0, "query stride must be a multiple of the dilation");
    const int i = lane & 31, hi = lane >> 5;
    const int colb = G_ * 256 + h * 64;
    bf16x8 qr[4];
    { const bf16* qp = X.LQ + (rowb + P0 + r + QS_ * i) * 768 + colb + hi * 8;
#pragma unroll
      for (int d0 = 0; d0 < 4; ++d0) qr[d0] = *(const bf16x8*)(qp + 16 * d0); }
    const int kpos0 = P0 + r - 128 * DL;
    const LAS unsigned char* vrd = vst + ((lane >> 4) & 1) * 32 + (lane & 3) * 8 + (4 * hi + ((lane & 15) >> 2)) * 64;
#define DIL_LOAD(KF, VR, KB) do { \
        { int kpos_ = kpos0 + (32 * (KB) + i) * DL; kpos_ = kpos_ < 0 ? 0 : (kpos_ > SEQ - 1 ? SEQ - 1 : kpos_); const bf16* kp_ = X.LK + (rowb + kpos_) * 768 + colb + hi * 8; \
          _Pragma("unroll") for (int d0 = 0; d0 < 4; ++d0) KF[d0] = *(const bf16x8*)(kp_ + 16 * d0); } \
        _Pragma("unroll") for (int t = 0; t < 4; ++t) { const int qd = lane + 64 * t, key = qd >> 3, ch = qd & 7; int vpos_ = kpos0 + (32 * (KB) + key) * DL; vpos_ = vpos_ < 0 ? 0 : (vpos_ > SEQ - 1 ? SEQ - 1 : vpos_); \
            VR[t] = *(const v4u*)(X.LV + (rowb + vpos_) * 768 + colb + ch * 8); } } while (0)
    bf16x8 kfn[4]; v4u vregn[4];
    DIL_LOAD(kfn, vregn, 0);
#pragma unroll 1
    for (int kb = 0; kb < NKB; ++kb) {
        bf16x8 kf[4]; v4u vreg[4];
#pragma unroll
        for (int d0 = 0; d0 < 4; ++d0) { kf[d0] = kfn[d0]; vreg[d0] = vregn[d0]; }
        if (kb + 1 < NKB) DIL_LOAD(kfn, vregn, kb + 1);
        const int jb = i * MG + 128 - 32 * kb - 4 * hi;
        f32x16 p;
#pragma unroll
        for (int rr = 0; rr < 16; ++rr) p[rr] = blg[jb - ((rr & 3) + 8 * (rr >> 2)) + BT0];
#pragma unroll
        for (int d0 = 0; d0 < 4; ++d0) p = __builtin_amdgcn_mfma_f32_32x32x16_bf16(kf[d0], qr[d0], p, 0, 0, 0);
        const int cb = 32 * kb + 4 * hi;
#pragma unroll
        for (int rr = 0; rr < 16; ++rr) { const int o_ = (rr & 3) + 8 * (rr >> 2); if ((unsigned)(jb - o_) > 128u || kpos0 + (cb + o_) * DL < 0) p[rr] = -3e38f; }
        float rm = p[0];
#pragma unroll
        for (int rr = 1; rr < 16; ++rr) rm = fmaxf(rm, p[rr]);
        { auto sw = __builtin_amdgcn_permlane32_swap(__float_as_uint(rm), __float_as_uint(rm), false, false); rm = fmaxf(__uint_as_float(sw[0]), __uint_as_float(sw[1])); }
        if (__any(rm > m + THR)) {
            const float mn = fmaxf(m, rm), f = __builtin_amdgcn_exp2f(m - mn);
#pragma unroll
            for (int d0 = 0; d0 < 2; ++d0)
#pragma unroll
                for (int rr = 0; rr < 16; ++rr) o[d0][rr] *= f;
            l *= f; m = mn;
        }
        float ls = 0.f;
#pragma unroll
        for (int rr = 0; rr < 16; ++rr) { p[rr] = __builtin_amdgcn_exp2f(p[rr] - m); ls += p[rr]; }
        l += ls;
        bf16x8 pw[2];
        { v4u w;
          w.x = cvtpk(p[0], p[1]); w.y = cvtpk(p[2], p[3]); w.z = cvtpk(p[4], p[5]); w.w = cvtpk(p[6], p[7]); pw[0] = __builtin_bit_cast(bf16x8, w);
          w.x = cvtpk(p[8], p[9]); w.y = cvtpk(p[10], p[11]); w.z = cvtpk(p[12], p[13]); w.w = cvtpk(p[14], p[15]); pw[1] = __builtin_bit_cast(bf16x8, w); }
#pragma unroll
        for (int t = 0; t < 4; ++t) { const int qd = lane + 64 * t, key = qd >> 3, ch = qd & 7;
            *(LAS v4u*)(vst + ((ch >> 2) * 2 + (key >> 4)) * 1024 + (key & 15) * 64 + (ch & 3) * 16) = vreg[t]; }
        asm volatile("s_waitcnt lgkmcnt(0)" ::: "memory");
#pragma unroll
        for (int d0 = 0; d0 < 2; ++d0)
#pragma unroll
            for (int ks = 0; ks < 2; ++ks) {
                const s16x4 lo = vtr(vrd + (d0 * 2 + ks) * 1024), hh = vtr(vrd + (d0 * 2 + ks) * 1024 + 512);
                const bf16x8 vf = (bf16x8){lo[0], lo[1], lo[2], lo[3], hh[0], hh[1], hh[2], hh[3]};
                o[d0] = __builtin_amdgcn_mfma_f32_32x32x16_bf16(vf, pw[ks], o[d0], 0, 0, 0);
            }
        asm volatile("s_waitcnt lgkmcnt(0)" ::: "memory");
    }
#undef DIL_LOAD
}
__device__ __forceinline__ void wave_tile_g0(const Tensors& X, float* lse0, int b, int h, int P0, LAS unsigned char* vst, const LAS float* bl, int lane) {
    const size_t rowb = (size_t)b * SEQ;
    f32x16 o[2];
#pragma unroll
    for (int d0 = 0; d0 < 2; ++d0)
#pragma unroll
        for (int rr = 0; rr < 16; ++rr) o[d0][rr] = 0.f;
    float m = -1e30f, l = 0.f;
    group<0, 1>(X, rowb, h, P0, 0, vst, bl, lane, o, m, l);
    { auto sw = __builtin_amdgcn_permlane32_swap(__float_as_uint(l), __float_as_uint(l), false, false); l = __uint_as_float(sw[0]) + __uint_as_float(sw[1]); }
    const float inv = 1.f / l; const int i = lane & 31, hi = lane >> 5;
    bf16* yrow = X.yb + (rowb + P0 + i) * 256 + h * 64 + 4 * hi;
#pragma unroll
    for (int d0 = 0; d0 < 2; ++d0)
#pragma unroll
        for (int r4 = 0; r4 < 4; ++r4) { v2u w; w.x = pk2(o[d0][4 * r4] * inv, o[d0][4 * r4 + 1] * inv); w.y = pk2(o[d0][4 * r4 + 2] * inv, o[d0][4 * r4 + 3] * inv); *(v2u*)(yrow + 32 * d0 + 8 * r4) = w; }
    if (hi == 0) lse0[(rowb + P0 + i) * 4 + h] = m + __builtin_amdgcn_logf(l);
}
__device__ __forceinline__ void wave_tile(const Tensors& X, const float* lse0, int b, int h, int P0, int r, LAS unsigned char* vst, const LAS float* bl, int lane) {
    const size_t rowb = (size_t)b * SEQ;
    f32x16 o[2];
#pragma unroll
    for (int d0 = 0; d0 < 2; ++d0)
#pragma unroll
        for (int rr = 0; rr < 16; ++rr) o[d0][rr] = 0.f;
    float m = -1e30f, l = 0.f;
    group<1, 16>(X, rowb, h, P0, r, vst, bl + BT, lane, o, m, l);
    group<2, 16>(X, rowb, h, P0, r, vst, bl + 2 * BT, lane, o, m, l);
    { auto sw = __builtin_amdgcn_permlane32_swap(__float_as_uint(l), __float_as_uint(l), false, false); l = __uint_as_float(sw[0]) + __uint_as_float(sw[1]); }
    const int i = lane & 31, hi = lane >> 5;
    const float w0 = __builtin_amdgcn_exp2f(lse0[(rowb + P0 + r + 16 * i) * 4 + h] - m);
    const float inv = 1.f / (l + w0);
    bf16* yrow = X.yb + (rowb + P0 + r + 16 * i) * 256 + h * 64 + 4 * hi;
#pragma unroll
    for (int d0 = 0; d0 < 2; ++d0)
#pragma unroll
        for (int r4 = 0; r4 < 4; ++r4) { const v2u g0 = *(const v2u*)(yrow + 32 * d0 + 8 * r4);
            v2u w; w.x = pk2((o[d0][4 * r4] + w0 * bf_lo(g0.x)) * inv, (o[d0][4 * r4 + 1] + w0 * bf_hi(g0.x)) * inv); w.y = pk2((o[d0][4 * r4 + 2] + w0 * bf_lo(g0.y)) * inv, (o[d0][4 * r4 + 3] + w0 * bf_hi(g0.y)) * inv);
            *(v2u*)(yrow + 32 * d0 + 8 * r4) = w; }
}
}
__device__ __forceinline__ void p0_transpose_item(const float* W, int K, int N, bf16* WT, LAS float* scr, int item, int lane) {
    const int nblk = N / 32, kb = item / nblk, nb = item % nblk, k0 = 64 * kb, n0 = 32 * nb;
#pragma unroll 8
    for (int i = 0; i < 32; ++i) { const int kk = 2 * i + (lane >> 5); scr[kk * 33 + (lane & 31)] = W[(size_t)(k0 + kk) * N + n0 + (lane & 31)]; }
    LDS_WAIT(); asm volatile("" ::: "memory");
    const int c = lane & 7;
#pragma unroll
    for (int j = 0; j < 4; ++j) { const int n = (lane >> 3) + 8 * j; const LAS float* s = scr + (8 * c) * 33 + n;
        v4u o; o.x = pk2(s[0 * 33], s[1 * 33]); o.y = pk2(s[2 * 33], s[3 * 33]); o.z = pk2(s[4 * 33], s[5 * 33]); o.w = pk2(s[6 * 33], s[7 * 33]);
        *(v4u*)(WT + (size_t)(n0 + n) * K + k0 + 8 * c) = o; }
    LDS_WAIT(); asm volatile("" ::: "memory");
}
__device__ __forceinline__ void cast_bf16(const float* src, bf16* dst, size_t n8, size_t gtid, size_t gthreads) {
    for (size_t i = gtid; i < n8; i += gthreads) { const f32x4 a = *(const f32x4*)(src + i * 8), b = *(const f32x4*)(src + i * 8 + 4);
        v4u o; o.x = pk2(a[0], a[1]); o.y = pk2(a[2], a[3]); o.z = pk2(b[0], b[1]); o.w = pk2(b[2], b[3]); *(v4u*)(dst + i * 8) = o; }
}

struct Args { const float* in[16]; float* out; unsigned char* ws; int ph_lo, ph_hi; };
enum { I_X = 0, I_WIN, I_DLAM, I_SUBG, I_WBD, I_WBL, I_WO, I_LN1G, I_LN1B, I_PWQ, I_PKEYS, I_PU, I_PV, I_LN2G, I_LN2B, I_RELB };

__device__ __forceinline__ void p0_prologue(const Args& A, LAS unsigned char* lds, int vcu, int G, int wave, int lane) {
    unsigned char* ws = A.ws;
    const int gw = vcu * NWAVES + wave, NGW = G * NWAVES;
    const size_t gtid = (size_t)gw * 64 + lane, gthreads = (size_t)NGW * 64;
    LAS float* scr = (LAS float*)(lds + wave * 16384);
    constexpr int I_IN = (D / 64) * (INC / 32), I_BD = (512 / 64) * (D / 32), I_BL = (256 / 64) * (D / 32), I_O = (D / 64) * (D / 32);
    for (int it0 = gw; it0 < (I_IN + I_BD + I_BL + I_O) * NREP(32); it0 += NGW) {
        int r = it0 % (I_IN + I_BD + I_BL + I_O);
        if (r < I_IN) { p0_transpose_item(A.in[I_WIN], D, INC, (bf16*)(ws + WS_WIN), scr, r, lane); continue; } r -= I_IN;
        if (r < I_BD) { p0_transpose_item(A.in[I_WBD], 512, D, (bf16*)(ws + WS_WBD), scr, r, lane); continue; } r -= I_BD;
        if (r < I_BL) { p0_transpose_item(A.in[I_WBL], 256, D, (bf16*)(ws + WS_WBL), scr, r, lane); continue; } r -= I_BL;
        p0_transpose_item(A.in[I_WO], D, D, (bf16*)(ws + WS_WO), scr, r, lane);
    }
    for (int rep_ = 0; rep_ < NREP(31); ++rep_) cast_bf16(A.in[I_X], (bf16*)(ws + WS_A), (size_t)T * D / 8, gtid, gthreads);
    { const float* wq = A.in[I_PWQ]; const float* keys = A.in[I_PKEYS]; bf16* wp = (bf16*)(ws + WS_WP);
      for (int it0 = gw; it0 < 1024 * NREP(30); it0 += NGW) { const int it = it0 & 1023;
          const int hc = it >> 6, jb = (it >> 2) & 15, nq = it & 3, j = jb * 64 + lane;
          const f32x4* wr_ = (const f32x4*)(wq + (size_t)j * 2048 + hc * 128);
          f32x4 w[32];
#pragma unroll
          for (int d = 0; d < 32; ++d) w[d] = wr_[d];
#pragma unroll 1
          for (int n = nq * 32; n < nq * 32 + 32; ++n) {
              const f32x4* kr = (const f32x4*)(keys + (size_t)(hc * 128 + n) * 128);
              float a0 = 0.f, a1 = 0.f, a2 = 0.f, a3 = 0.f;
#pragma unroll
              for (int d = 0; d < 32; ++d) { const f32x4 k = kr[d]; a0 += w[d][0] * k[0]; a1 += w[d][1] * k[1]; a2 += w[d][2] * k[2]; a3 += w[d][3] * k[3]; }
              wp[(size_t)(hc * 128 + n) * 1024 + j] = (bf16)f2bf((a0 + a1) + (a2 + a3));
          }
      } }
    { const float* relb = A.in[I_RELB]; float* bd = (float*)(ws + WS_BIASD); float* bl = (float*)(ws + WS_BIASL);
      for (size_t i = gtid; i < 4 * BIAS_TAB; i += gthreads) { const int h = (int)(i / BIAS_TAB), dist = (int)(i % BIAS_TAB) - BIAS_GUARD; bd[i] = dist < 0 ? 0.f : relb[rel_bucket(dist) * 16 + h] * LOG2E; }
      for (size_t i = gtid; i < 12 * 132; i += gthreads) { const int gh = (int)(i / 132), j = (int)(i % 132), g = gh >> 2; const int dl = (g == 0) ? 1 : (g == 1) ? 4 : 16;
          bl[i] = relb[rel_bucket((j > 128 ? 128 : j) * dl) * 16 + 4 + gh] * LOG2E; } }
}

__device__ __forceinline__ void p5_ln1(const Args& A, int vcu, int G, int wave, int lane) {
    unsigned char* ws = A.ws;
    const int gw = vcu * NWAVES + wave, NGW = G * NWAVES;
    const float* R = (const float*)(ws + WS_R); bf16* x1b = (bf16*)(ws + WS_A);
    const float* gam = A.in[I_LN1G]; const float* bet = A.in[I_LN1B];
    f32x4 gv[4], bv[4];
#pragma unroll
    for (int j = 0; j < 4; ++j) { gv[j] = *(const f32x4*)(gam + 256 * j + 4 * lane); bv[j] = *(const f32x4*)(bet + 256 * j + 4 * lane); }
    for (int mrow = gw; mrow < T; mrow += NGW) {
        const f32x4* xr = (const f32x4*)(R + (size_t)mrow * D) + lane;
        f32x4 v[4]; float s = 0.f;
#pragma unroll
        for (int j = 0; j < 4; ++j) { v[j] = xr[64 * j]; s += (v[j][0] + v[j][1]) + (v[j][2] + v[j][3]); }
        const float mean = wave_sum(s) * (1.f / D); float s2 = 0.f;
#pragma unroll
        for (int j = 0; j < 4; ++j) { v[j] = v[j] - mean; s2 += (v[j][0] * v[j][0] + v[j][1] * v[j][1]) + (v[j][2] * v[j][2] + v[j][3] * v[j][3]); }
        const float rstd = __builtin_amdgcn_rsqf(wave_sum(s2) * (1.f / D) + LN_EPS);
        f32x4* orow = (f32x4*)(A.out + (size_t)mrow * D) + lane; v2u* brow = (v2u*)(x1b + (size_t)mrow * D) + lane;
#pragma unroll
        for (int j = 0; j < 4; ++j) { const f32x4 y = v[j] * rstd * gv[j] + bv[j]; orow[64 * j] = y; v2u w; w.x = pk2(y[0], y[1]); w.y = pk2(y[2], y[3]); brow[64 * j] = w; }
    }
}
namespace peer {
__device__ __forceinline__ int mono(float v) { const int b = __float_as_int(v); return b ^ ((b >> 31) & 0x7fffffff); }
__device__ __forceinline__ float unmono(int k) { return __int_as_float(k ^ ((k >> 31) & 0x7fffffff)); }
__device__ __forceinline__ int med3i(int a, int b, int c) { int r; asm("v_med3_i32 %0, %1, %2, %3" : "=v"(r) : "v"(a), "v"(b), "v"(c)); return r; }
#define PEER_INS16(a, x) do { _Pragma("unroll") for (int k_ = 15; k_ >= 1; --k_) a[k_] = med3i(a[k_ - 1], a[k_], (x)); a[0] = max(a[0], (x)); } while (0)
__device__ __forceinline__ unsigned byte_sel(const unsigned (&p)[4], int i) { const int w = i >> 2; const unsigned x = (w == 0) ? p[0] : (w == 1) ? p[1] : (w == 2) ? p[2] : p[3]; return (x >> ((i & 3) * 8)) & 0xffu; }
__device__ __forceinline__ float gelu_erf(float v) { return 0.5f * v * (1.f + erff(v * 0.7071067811865476f)); }

__device__ __forceinline__ void select(const float* ST, v2u* sel, int tok, int head) {
    int a0[16], a1[16];
#pragma unroll
    for (int k = 0; k < 16; ++k) { a0[k] = (int)0x80000000; a1[k] = (int)0x80000000; }
    const float* s0 = ST + (size_t)(head * 256) * T + tok; const float* s1 = s0 + (size_t)128 * T;
#pragma unroll 8
    for (int n = 0; n < 128; ++n) { const int k = (mono(s0[(size_t)n * T]) & ~127) | (127 - n); PEER_INS16(a0, k); }
#pragma unroll 8
    for (int n = 0; n < 128; ++n) { const int k = (mono(s1[(size_t)n * T]) & ~127) | (127 - n); PEER_INS16(a1, k); }
    float v0[16], v1[16]; unsigned i0p[4] = {0u, 0u, 0u, 0u}, i1p[4] = {0u, 0u, 0u, 0u};
#pragma unroll
    for (int k = 0; k < 16; ++k) { v0[k] = unmono((a0[k] & ~127) | 64); v1[k] = unmono((a1[k] & ~127) | 64);
        i0p[k >> 2] |= (unsigned)(127 - (a0[k] & 127)) << (8 * (k & 3)); i1p[k >> 2] |= (unsigned)(127 - (a1[k] & 127)) << (8 * (k & 3)); }
    int cd[16];
#pragma unroll
    for (int k = 0; k < 16; ++k) cd[k] = (int)0x80000000;
#pragma unroll
    for (int i = 0; i < 16; ++i)
#pragma unroll
        for (int j = 0; j < 16; ++j)
            if ((i + 1) * (j + 1) <= 16) { const int k = (mono(v0[i] + v1[j]) & ~255) | (255 - (i * 16 + j)); PEER_INS16(cd, k); }
    float sv[16], ex[16], sum = 0.f; unsigned eid[16];
#pragma unroll
    for (int k = 0; k < 16; ++k) { const int code = 255 - (cd[k] & 255); eid[k] = byte_sel(i0p, code >> 4) * 128u + byte_sel(i1p, code & 15); sv[k] = unmono((cd[k] & ~255) | 128); }
#pragma unroll
    for (int k = 0; k < 16; ++k) { ex[k] = __expf(sv[k] - sv[0]); sum += ex[k]; }
    const float rs = 1.f / sum;
    v4u* dst = (v4u*)(sel + ((size_t)tok * 8 + head) * 16);
#pragma unroll
    for (int k = 0; k < 8; ++k) { v4u w; w.x = eid[2 * k]; w.y = __float_as_uint(ex[2 * k] * rs); w.z = eid[2 * k + 1]; w.w = __float_as_uint(ex[2 * k + 1] * rs); dst[k] = w; }
}

typedef float f32x2v __attribute__((ext_vector_type(2)));
__device__ __forceinline__ void gather_token(const v2u* sel, const unsigned char* U8, const unsigned char* V8, const float* isu, const float* isv, float* xo, const float* gam, const float* bet, int tok, int lane) {
    float* xrow = xo + (size_t)tok * D + 16 * lane;
    f32x4 xv[4];
#pragma unroll
    for (int q = 0; q < 4; ++q) xv[q] = *(const f32x4*)(xrow + 4 * q);
    float acc[16];
#pragma unroll
    for (int k = 0; k < 16; ++k) acc[k] = 0.f;
    for (int head = 0; head < 8; ++head) {
        const v2u se = sel[((size_t)tok * 8 + head) * 16 + (lane & 15)];
        const unsigned eq = (unsigned)__shfl((int)se.x, lane >> 2);
        const float su = isu[eq], sv = isv[eq];
        float part[16];
        {
            v4u uu[16];
#pragma unroll
            for (int k = 0; k < 16; ++k) { const unsigned e = __builtin_amdgcn_readlane(se.x, k); uu[k] = *(const v4u*)(U8 + (size_t)e * D + 16 * lane); }
#pragma unroll
            for (int k = 0; k < 16; ++k) { float d0 = 0.f, d1 = 0.f;
#pragma unroll
                for (int q = 0; q < 4; ++q) { const unsigned w = uu[k][q]; const f32x2v a = __builtin_amdgcn_cvt_pk_f32_fp8((int)w, false), b = __builtin_amdgcn_cvt_pk_f32_fp8((int)w, true);
                    d0 += xv[q][0] * a[0]; d1 += xv[q][1] * a[1]; d0 += xv[q][2] * b[0]; d1 += xv[q][3] * b[1]; }
                part[k] = d0 + d1; }
        }
#ifdef PROBE_L2
        {
            v4u du[16], dv[16];
#pragma unroll
            for (int k = 0; k < 16; ++k) { const unsigned e = __builtin_amdgcn_readlane(se.x, k) & PROBE_L2; du[k] = *(const v4u*)(U8 + (size_t)e * D + 16 * lane); dv[k] = *(const v4u*)(V8 + (size_t)e * D + 16 * lane); }
#pragma unroll
            for (int k = 0; k < 16; ++k) asm volatile("" :: "v"(du[k]), "v"(dv[k]));
        }
#endif
        float r8[8], r4[4], r2[2], r1;
#pragma unroll
        for (int i = 0; i < 8; ++i) { const bool up = (lane & 32) != 0; const float send = up ? part[i] : part[i + 8], keep = up ? part[i + 8] : part[i]; r8[i] = keep + __shfl_xor(send, 32); }
#pragma unroll
        for (int i = 0; i < 4; ++i) { const bool up = (lane & 16) != 0; const float send = up ? r8[i] : r8[i + 4], keep = up ? r8[i + 4] : r8[i]; r4[i] = keep + __shfl_xor(send, 16); }
#pragma unroll
        for (int i = 0; i < 2; ++i) { const bool up = (lane & 8) != 0; const float send = up ? r4[i] : r4[i + 2], keep = up ? r4[i + 2] : r4[i]; r2[i] = keep + __shfl_xor(send, 8); }
        { const bool up = (lane & 4) != 0; const float send = up ? r2[0] : r2[1], keep = up ? r2[1] : r2[0]; r1 = keep + __shfl_xor(send, 4); }
        r1 += __shfl_xor(r1, 2); r1 += __shfl_xor(r1, 1);
        const float gq = __uint_as_float((unsigned)__shfl((int)se.y, lane >> 2));
        const float wgt = gq * gelu_erf(r1 * su) * sv;
        {
            v4u vv[16];
#pragma unroll
            for (int k = 0; k < 16; ++k) { const unsigned e = __builtin_amdgcn_readlane(se.x, k); vv[k] = *(const v4u*)(V8 + (size_t)e * D + 16 * lane); }
#pragma unroll
            for (int k = 0; k < 16; ++k) { const float w = __uint_as_float(__builtin_amdgcn_readlane(__float_as_uint(wgt), 4 * k));
#pragma unroll
                for (int q = 0; q < 4; ++q) { const unsigned x = vv[k][q]; const f32x2v a = __builtin_amdgcn_cvt_pk_f32_fp8((int)x, false), b = __builtin_amdgcn_cvt_pk_f32_fp8((int)x, true);
                    acc[4 * q] += w * a[0]; acc[4 * q + 1] += w * a[1]; acc[4 * q + 2] += w * b[0]; acc[4 * q + 3] += w * b[1]; } }
        }
    }
    float rr[16], s = 0.f;
#pragma unroll
    for (int k = 0; k < 16; ++k) { rr[k] = ALPHA * xv[k >> 2][k & 3] + acc[k]; s += rr[k]; }
    const float mean = wave_sum(s) * (1.f / D); float s2 = 0.f;
#pragma unroll
    for (int k = 0; k < 16; ++k) { rr[k] -= mean; s2 += rr[k] * rr[k]; }
    const float rstd = __builtin_amdgcn_rsqf(wave_sum(s2) * (1.f / D) + LN_EPS);
#pragma unroll
    for (int q = 0; q < 4; ++q) { const f32x4 g = *(const f32x4*)(gam + 16 * lane + 4 * q), bb = *(const f32x4*)(bet + 16 * lane + 4 * q);
        f32x4 y; y[0] = rr[4 * q] * rstd * g[0] + bb[0]; y[1] = rr[4 * q + 1] * rstd * g[1] + bb[1]; y[2] = rr[4 * q + 2] * rstd * g[2] + bb[2]; y[3] = rr[4 * q + 3] * rstd * g[3] + bb[3];
        *(f32x4*)(xrow + 4 * q) = y; }
}
__device__ __forceinline__ void row_to_fp8(const float* src, unsigned char* dst, float* inv, int row, int lane) {
    const float* p = src + (size_t)row * D + 16 * lane;
    f32x4 v[4]; float am = 0.f;
#pragma unroll
    for (int q = 0; q < 4; ++q) { v[q] = *(const f32x4*)(p + 4 * q); am = fmaxf(am, fmaxf(fmaxf(fabsf(v[q][0]), fabsf(v[q][1])), fmaxf(fabsf(v[q][2]), fabsf(v[q][3])))); }
    am = wave_max(am);
    float s = 1.f, is = 1.f;
    if (am > 1e-30f) { const int eb = (__float_as_int(224.f / am) >> 23) & 0xff; if (eb > 0 && eb < 254) { s = __int_as_float(eb << 23); is = __int_as_float((254 - eb) << 23); } }
    v4u o;
#pragma unroll
    for (int q = 0; q < 4; ++q) { int w = 0; w = __builtin_amdgcn_cvt_pk_fp8_f32(v[q][0] * s, v[q][1] * s, w, false); w = __builtin_amdgcn_cvt_pk_fp8_f32(v[q][2] * s, v[q][3] * s, w, true); o[q] = (unsigned)w; }
    *(v4u*)(dst + (size_t)row * D + 16 * lane) = o;
    if (lane == 0) inv[row] = is;
}
}
constexpr int NPH = 8;
__global__ void __launch_bounds__(NWAVES * 64, 2) mk_fwd(Args args) {
    extern __shared__ __attribute__((aligned(16))) unsigned char lds_raw[];
    LAS unsigned char* lds = (LAS unsigned char*)lds_raw;
    volatile LAS unsigned* MISC = (volatile LAS unsigned*)(lds + MISC_OFF);
    const int tid0 = threadIdx.x, lane0 = tid0 & 63, wave = __builtin_amdgcn_readfirstlane(tid0 >> 6);
    const int G = gridDim.x, bx = blockIdx.x, vcu = (G % 8 == 0) ? (bx % 8) * (G / 8) + bx / 8 : bx;
    unsigned char* ws0 = args.ws;
    gu32* ctl = (gu32*)(ws0 + WS_CTL);
    for (int u = tid0; u < (LDS_BYTES - RING_BYTES) / 4; u += NWAVES * 64) ((LAS unsigned*)(lds + RING_BYTES))[u] = 0u;
    __syncthreads();
    XcdBarrier bar; bar.bar = (unsigned*)(ctl + CW_BAR); bar.x = 0; bar.st = nullptr;
    if (MK_N_LAUNCHES == 1) bar = xcd_barrier_post((unsigned*)(ctl + CW_BAR), MISC + 8);
    const int lo = args.ph_lo, hi = args.ph_hi;
#ifndef PH_MASK
#define PH_MASK 0xFF
#endif
#define IN(k) ((((PH_MASK) >> (k)) & 1) && lo <= (k) && (k) < hi)
#define SEAM(k) do { if (IN(k) && IN((k) + 1)) xcd_barrier(bar); } while (0)
    const int NGW = G * NWAVES;
#define SUB_BEGIN() unsigned char* ws = ws0; asm volatile("" : "+s"(ws)); const int lane = (int)__builtin_amdgcn_mbcnt_hi(~0u, __builtin_amdgcn_mbcnt_lo(~0u, 0u)), tid = wave * 64 + lane; (void)tid; (void)lane
#define PHASE_BEGIN() unsigned char* ws = ws0; asm volatile("" : "+s"(ws)); const int lane = (int)__builtin_amdgcn_mbcnt_hi(~0u, __builtin_amdgcn_mbcnt_lo(~0u, 0u)), tid = wave * 64 + lane; const int gw = vcu * NWAVES + wave; (void)gw; (void)lane; (void)tid

    if (IN(0)) { PHASE_BEGIN(); p0_prologue(args, lds, vcu, G, wave, lane); VM_WAIT(); __syncthreads(); SEAM(0); }

#if defined(MICRO)
    {
        f32x16 a0 = {0.f,0.f,0.f,0.f,0.f,0.f,0.f,0.f,0.f,0.f,0.f,0.f,0.f,0.f,0.f,0.f}, a1 = a0; bf16x8 fa = {1,2,3,4,5,6,7,8}, fb = {8,7,6,5,4,3,2,1};
        float e[8]; for (int i = 0; i < 8; ++i) e[i] = 0.001f * (float)(lane0 + i);
        asm volatile("" : "+v"(fa), "+v"(fb));
        for (int it = 0; it < 512; ++it) {
#pragma unroll
            for (int j = 0; j < 8; ++j) {
                if (MICRO == 1 || MICRO == 3 || MICRO == 4) { a0 = __builtin_amdgcn_mfma_f32_32x32x16_bf16(fa, fb, a0, 0, 0, 0); }
                if (MICRO == 2 || MICRO == 3) {
#pragma unroll
                    for (int i = 0; i < 8; ++i) e[i] = __builtin_amdgcn_exp2f(e[i]);
                }
                if (MICRO == 4) {
#pragma unroll
                    for (int i = 0; i < 4; ++i) e[i] = __builtin_amdgcn_exp2f(e[i]);
#pragma unroll
                    for (int i = 4; i < 8; ++i) { e[i] = e[i] * 1.0001f + 0.5f; e[i] = e[i] * 0.9999f - 0.5f; }
                }
                if (MICRO == 1 || MICRO == 3 || MICRO == 4) { a1 = __builtin_amdgcn_mfma_f32_32x32x16_bf16(fb, fa, a1, 0, 0, 0); }
                if (MICRO == 2 || MICRO == 3) {
#pragma unroll
                    for (int i = 0; i < 8; ++i) e[i] = __builtin_amdgcn_exp2f(e[i]);
                }
                if (MICRO == 4) {
#pragma unroll
                    for (int i = 0; i < 4; ++i) e[i] = __builtin_amdgcn_exp2f(e[i]);
#pragma unroll
                    for (int i = 4; i < 8; ++i) { e[i] = e[i] * 1.0001f + 0.5f; e[i] = e[i] * 0.9999f - 0.5f; }
                }
                __builtin_amdgcn_sched_barrier(0);
            }
        }
        asm volatile("" :: "v"(a0), "v"(a1), "v"(e[0]), "v"(e[1]), "v"(e[2]), "v"(e[3]), "v"(e[4]), "v"(e[5]), "v"(e[6]), "v"(e[7]));
    }
#endif

    if (IN(1)) { PHASE_BEGIN();
        pg8::Gemm g{(const pg8::bf16_t*)(ws + WS_A), (const pg8::bf16_t*)(ws + WS_WIN), T, INC, D}; pg8::StaticOrder S; S.init(T, INC, G, bx); S.rep = NREP(1);
        pg8::EpiInProj E{(pg8::bf16_t*)(ws + WS_QD), (pg8::bf16_t*)(ws + WS_KD), (pg8::bf16_t*)(ws + WS_VD), (pg8::bf16_t*)(ws + WS_LQ), (pg8::bf16_t*)(ws + WS_LK), (pg8::bf16_t*)(ws + WS_LV),
                         (pg8::bf16_t*)(ws + WS_GA), (pg8::bf16_t*)(ws + WS_GB)};
        pg8::gemm_phase<pg8::EpiInProj, pg8::StaticOrder, true, true>(lds, g, S, E);
        SEAM(1);
    }

    if (IN(2)) { PHASE_BEGIN();
#ifndef NO_DIFF
        {   SUB_BEGIN();
            const da::Tensors X{(const bf16*)(ws + WS_QD), (const bf16*)(ws + WS_KD), (const bf16*)(ws + WS_VD), (float*)(ws + WS_STASH), (bf16*)(ws + WS_YA),
                                args.in[I_DLAM], args.in[I_SUBG], args.in[I_RELB]};
            int cur_h = -1;
            float lam; { const float* dl = args.in[I_DLAM]; const float p1 = dl[lane] * dl[64 + lane], p2 = dl[128 + lane] * dl[192 + lane];
                lam = __uint_as_float(__builtin_amdgcn_readfirstlane(__float_as_uint(__expf(wave_sum(p1)) - __expf(wave_sum(p2)) + LAM_INIT))); }
            for (int rep_ = 0; rep_ < NREP(20); ++rep_)
            for (int p = vcu; p < 256; p += G) {
                const int bh = p >> 5, s = p & 31, b = bh >> 2, h = bh & 3;
                if (h != cur_h) {
                    __syncthreads();
                    const float* bd = (const float*)(ws + WS_BIASD) + h * BIAS_TAB; asm volatile("" : "+s"(bd));
                    for (int i = tid; i < BIAS_TAB; i += NWAVES * 64) ((LAS float*)(lds + da::LDS_BIAS))[i] = bd[i];
                    __syncthreads(); cur_h = h;
                }
                const float c31 = args.in[I_RELB][31 * 16 + h] * LOG2E;
                for (int k2 = 0; k2 < 2; ++k2) da::unit(X, b, h, k2 ? 63 - s : s, lds, bx, lam, c31);
            }
        }
#endif
#ifndef NO_DIL
        {   SUB_BEGIN();
            const dil::Tensors X{(const bf16*)(ws + WS_LQ), (const bf16*)(ws + WS_LK), (const bf16*)(ws + WS_LV), (bf16*)(ws + WS_YB)};
            int cur_h = -1;
            for (int rep_ = 0; rep_ < NREP(21); ++rep_)
            for (int u = vcu; u < 256; u += G) {
                const int bh = u >> 5, blk = u & 31, b = bh >> 2, h = bh & 3;
                if (h != cur_h) {
                    __syncthreads();
                    const float* blsrc = (const float*)(ws + WS_BIASL);
                    for (int i = tid; i < 3 * dil::BT; i += NWAVES * 64) { const int g = i / dil::BT, jj = i % dil::BT - dil::BT0;
                        ((LAS float*)(lds + dil::LDS_BL))[i] = (jj >= 0 && jj <= 128) ? blsrc[(g * 4 + h) * 132 + jj] : 0.f; }
                    __syncthreads(); cur_h = h;
                }
                float* lse0 = (float*)(ws + WS_LSE0);
                for (int k2 = 0; k2 < 2; ++k2) dil::wave_tile_g0(X, lse0, b, h, blk * 512 + (wave + 8 * k2) * 32, lds + dil::LDS_VST + wave * 4096, (const LAS float*)(lds + dil::LDS_BL), lane);
                VM_WAIT(); __syncthreads();
                for (int k2 = 0; k2 < 2; ++k2) dil::wave_tile(X, lse0, b, h, blk * 512, wave + 8 * k2, lds + dil::LDS_VST + wave * 4096, (const LAS float*)(lds + dil::LDS_BL), lane);
            }
            __syncthreads();
        }
#endif
        SEAM(2);
    }

    if (IN(3)) { PHASE_BEGIN();
        { pg8::Gemm g{(const pg8::bf16_t*)(ws + WS_YA), (const pg8::bf16_t*)(ws + WS_WBD), T, D, 512}; pg8::StaticOrder S; S.init(T, D, G, bx); S.rep = NREP(3);
          pg8::EpiGate1 E{(const pg8::bf16_t*)(ws + WS_GA), (pg8::bf16_t*)(ws + WS_GATED)};
          pg8::gemm_phase<pg8::EpiGate1, pg8::StaticOrder, true, true>(lds, g, S, E); }
        VM_WAIT(); __syncthreads();
        { pg8::Gemm g{(const pg8::bf16_t*)(ws + WS_YB), (const pg8::bf16_t*)(ws + WS_WBL), T, D, 256}; pg8::StaticOrder S; S.init(T, D, G, bx);
          pg8::EpiGate2 E{(const pg8::bf16_t*)(ws + WS_GB), (pg8::bf16_t*)(ws + WS_GATED)};
          pg8::gemm_phase<pg8::EpiGate2, pg8::StaticOrder, true, true>(lds, g, S, E); }
        SEAM(3);
    }

    if (IN(4)) { PHASE_BEGIN();
        pg8::Gemm g{(const pg8::bf16_t*)(ws + WS_GATED), (const pg8::bf16_t*)(ws + WS_WO), T, D, D}; pg8::StaticOrder S; S.init(T, D, G, bx); S.rep = NREP(4);
        pg8::EpiOut E{args.in[I_X], (float*)(ws + WS_R)};
        pg8::gemm_phase<pg8::EpiOut, pg8::StaticOrder, true, true>(lds, g, S, E);
        SEAM(4);
    }

    if (IN(5)) { PHASE_BEGIN();
        p5_ln1(args, vcu, G, wave, lane);
        for (int row = gw; row < 2 * NEXP; row += NGW) {
            if (row < NEXP) peer::row_to_fp8(args.in[I_PU], ws + WS_UU, (float*)(ws + WS_ISU), row, lane);
            else peer::row_to_fp8(args.in[I_PV], ws + WS_UV, (float*)(ws + WS_ISV), row - NEXP, lane);
        }
        SEAM(5);
    }

    if (IN(6)) { PHASE_BEGIN();
        pg8::Gemm g{(const pg8::bf16_t*)(ws + WS_WP), (const pg8::bf16_t*)(ws + WS_A), 2048, T, D}; pg8::StaticOrder S; S.init(2048, T, G, bx); S.rep = NREP(6);
        pg8::EpiScoreT E{(float*)(ws + WS_ST)};
        pg8::gemm_phase<pg8::EpiScoreT, pg8::StaticOrder, true, true>(lds, g, S, E);
        SEAM(6);
    }

    if (IN(7)) { PHASE_BEGIN();
        const float* ST = (const float*)(ws + WS_ST); v2u* sel = (v2u*)(ws + WS_SEL);
        for (int u = vcu; u < T / 128; u += G) {
            for (int p = 0; p < 2; ++p) peer::select(ST, sel, u * 128 + p * 64 + lane, wave);
            VM_WAIT(); __syncthreads();
            for (int i = 0; i < 16; ++i) peer::gather_token(sel, ws + WS_UU, ws + WS_UV, (const float*)(ws + WS_ISU), (const float*)(ws + WS_ISV), args.out, args.in[I_LN2G], args.in[I_LN2B], u * 128 + wave * 16 + i, lane);
            VM_WAIT(); __syncthreads();
        }
    }
#undef IN
#undef SEAM
}

extern "C" void kernel_launch(void* const* d_in, const int* in_sizes, int n_in, void* d_out, int out_size, void* d_ws, size_t ws_size, hipStream_t stream) {
    static int grid = 0;
    if (grid == 0) {
        if (n_in != 16 || in_sizes[0] != T * D || out_size != T * D || ws_size < WS_END) { fprintf(stderr, "kernel_launch: unexpected shapes (n_in %d, in0 %d, out %d, ws %zu); nothing launched\n", n_in, n_in > 0 ? in_sizes[0] : -1, out_size, ws_size); grid = -1; return; }
        int dev = 0, cus = 0, per_cu = 0;
        if (hipGetDevice(&dev) != hipSuccess || hipDeviceGetAttribute(&cus, hipDeviceAttributeMultiprocessorCount, dev) != hipSuccess) { grid = -1; return; }
        if (hipFuncSetAttribute((const void*)mk_fwd, hipFuncAttributeMaxDynamicSharedMemorySize, LDS_BYTES) != hipSuccess) { fprintf(stderr, "kernel_launch: hipFuncSetAttribute failed\n"); grid = -1; return; }
        if (hipOccupancyMaxActiveBlocksPerMultiprocessor(&per_cu, (const void*)mk_fwd, NWAVES * 64, LDS_BYTES) != hipSuccess || per_cu < 1) { fprintf(stderr, "kernel_launch: occupancy query reports %d\n", per_cu); per_cu = 1; }
        (void)hipGetLastError();
        grid = cus;
    }
    if (grid < 0) return;
    if (hipMemsetAsync((char*)d_ws + WS_CTL, 0, CTL_ZERO_BYTES, stream) != hipSuccess) return;
    Args a{};
    for (int i = 0; i < 16; ++i) a.in[i] = (const float*)d_in[i];
    a.out = (float*)d_out; a.ws = (unsigned char*)d_ws;
    for (int li = 0; li < MK_N_LAUNCHES; ++li) {
        a.ph_lo = (MK_N_LAUNCHES == 1) ? 0 : li; a.ph_hi = (MK_N_LAUNCHES == 1) ? NPH : li + 1;
        hipLaunchKernelGGL(mk_fwd, dim3(grid), dim3(NWAVES * 64), LDS_BYTES, stream, a);
    }
}
```

```cpp
#include <hip/hip_runtime.h>
#include <cstdio>
#include <cstdint>

#ifndef MK_N_LAUNCHES
#define MK_N_LAUNCHES 1
#endif

#ifndef REPEAT_PH
#define REPEAT_PH (-1)
#endif
#define NREP(k) ((REPEAT_PH) == (k) ? 2 : 1)

constexpr int BATCH = 2, SEQ = 16384, T = BATCH * SEQ, D = 1024, INC = 5888;
constexpr int OFF_DQ = 0, OFF_DK = 512, OFF_DV = 1024, OFF_LQ = 1536, OFF_LK = 2304, OFF_LV = 3072, OFF_GA = 3840, OFF_GB = 4864;
constexpr int NEXP = 16384;
constexpr float LOG2E = 1.4426950408889634f;
constexpr float QSCALE = 0.125f * LOG2E;
constexpr float ALPHA = 1.189207115002721f;
constexpr float LN_EPS = 1e-5f, SUBLN_EPS = 1e-5f;
constexpr float LAM_INIT = 0.2f;
constexpr int NTILE = SEQ / 64;
constexpr int BIAS_TAB = 2112, BIAS_GUARD = 256, DFAR = 1513;

constexpr size_t MiB = 1u << 20;
constexpr size_t WS_CTL = 0, CTL_ZERO_BYTES = 1 * MiB;
constexpr size_t WS_BIASD = 1 * MiB;
constexpr size_t WS_BIASL = 1 * MiB + 64 * 1024;
constexpr size_t WS_WIN = 8 * MiB, WS_WO = 20 * MiB, WS_WBD = 22 * MiB, WS_WBL = 23 * MiB, WS_WP = 24 * MiB;
constexpr size_t WS_A = 32 * MiB;
constexpr size_t WS_YA = WS_A, WS_YB = WS_A + 32 * MiB;
constexpr size_t WS_QD = 96 * MiB, WS_KD = 128 * MiB, WS_VD = 160 * MiB, WS_LQ = 192 * MiB, WS_LK = 240 * MiB, WS_LV = 288 * MiB, WS_GA = 336 * MiB, WS_GB = 400 * MiB;
constexpr size_t WS_STASH = 464 * MiB;
constexpr size_t WS_SEL = 464 * MiB;
constexpr size_t WS_GATED = 96 * MiB;
constexpr size_t WS_R = 160 * MiB;
constexpr size_t WS_ST = 96 * MiB;
constexpr size_t WS_UU = 352 * MiB, WS_UV = 384 * MiB;
constexpr size_t WS_LSE0 = 3 * MiB;
constexpr size_t WS_ISU = 2 * MiB, WS_ISV = 2 * MiB + 65536;
constexpr size_t WS_END = 512 * MiB;

constexpr int CW_BAR = 4096;
constexpr int NWAVES = 8;
constexpr int RING_BYTES = 131072, MISC_OFF = RING_BYTES + 320, LDS_BYTES = 147456;

#define GAS __attribute__((address_space(1)))
#define LAS __attribute__((address_space(3)))
typedef unsigned short bf16;
typedef unsigned v4u __attribute__((ext_vector_type(4)));
typedef unsigned v2u __attribute__((ext_vector_type(2)));
typedef float f32x4 __attribute__((ext_vector_type(4)));
typedef float f32x16 __attribute__((ext_vector_type(16)));
typedef short bf16x8 __attribute__((ext_vector_type(8)));
typedef short s16x4 __attribute__((ext_vector_type(4)));
typedef __bf16 bf16x2 __attribute__((ext_vector_type(2)));
typedef GAS unsigned gu32;
#define RLX_AGENT __ATOMIC_RELAXED, __HIP_MEMORY_SCOPE_AGENT
#define LDS_WAIT() asm volatile("s_waitcnt lgkmcnt(0)" ::: "memory")
#define VM_WAIT() asm volatile("s_waitcnt vmcnt(0)" ::: "memory")
__device__ __forceinline__ unsigned f2bf(float f) { unsigned u = __builtin_bit_cast(unsigned, f); return (u + 0x7fffu + ((u >> 16) & 1u)) >> 16; }
__device__ __forceinline__ unsigned pk2(float lo, float hi) { return f2bf(lo) | (f2bf(hi) << 16); }
typedef float f32x2_t __attribute__((ext_vector_type(2)));
__device__ __forceinline__ unsigned cvtpk(float lo, float hi) { f32x2_t v = {lo, hi}; bf16x2 b = __builtin_convertvector(v, bf16x2); return __builtin_bit_cast(unsigned, b); }
__device__ __forceinline__ float bf_lo(unsigned w) { return __builtin_bit_cast(float, w << 16); }
__device__ __forceinline__ float bf_hi(unsigned w) { return __builtin_bit_cast(float, w & 0xffff0000u); }
__device__ __forceinline__ float dot2bf(unsigned a, unsigned b, float acc) { return __builtin_amdgcn_fdot2_f32_bf16(__builtin_bit_cast(bf16x2, a), __builtin_bit_cast(bf16x2, b), acc, false); }
__device__ __forceinline__ float wave_sum(float v) {
#pragma unroll
    for (int o = 1; o < 64; o <<= 1) v += __shfl_xor(v, o);
    return v;
}
__device__ __forceinline__ float wave_max(float v) {
#pragma unroll
    for (int o = 1; o < 64; o <<= 1) v = fmaxf(v, __shfl_xor(v, o));
    return v;
}
__device__ __forceinline__ int rel_bucket(int n) {
    if (n < 16) return n < 0 ? 0 : n;
    return 16 + (n >= 22) + (n >= 30) + (n >= 40) + (n >= 54) + (n >= 73) + (n >= 99) + (n >= 134) + (n >= 182) + (n >= 246) + (n >= 332) + (n >= 450) + (n >= 609) + (n >= 825) + (n >= 1117) + (n >= 1513);
}
namespace pg8 {
#define PG8_LAS __attribute__((address_space(3)))
typedef unsigned short bf16_t;
typedef short bf16x8 __attribute__((ext_vector_type(8)));
typedef float f32x4 __attribute__((ext_vector_type(4)));
typedef unsigned u32x4 __attribute__((ext_vector_type(4)));
constexpr int BM = 256, BK = 64, HALF = 128, HTB = HALF * BK * 2  , STAGE_BYTES = 8 * HTB, NXCD = 8, WGM = 8;

__host__ __device__ __forceinline__ int lds_byte(int r, int c) { const int st = (r >> 4) * 2 + (c >> 5), rr = r & 15, cc = c & 31, ob = rr * 64 + cc * 2; return st * 1024 + (ob ^ (((ob >> 9) & 1) << 5)); }
__host__ __device__ __forceinline__ void stage_rc(int b, int& R, int& C) { const int st = b / 1024, sb = b % 1024, swz = sb ^ (((sb >> 9) & 1) << 5); R = (st >> 1) * 16 + swz / 64; C = (st & 1) * 32 + (swz % 64) / 2; }
__host__ __device__ __forceinline__ int perm32(int rho) { const int n = rho >> 4, i = rho & 15; return 8 * (i >> 2) + 4 * n + (i & 3); }

struct Unit { int pm, pn; };
struct Gemm { const bf16_t* A; const bf16_t* Bt; int M, N, K; };

struct StaticOrder {
    int nM, nN, nwg, G, c;
    __host__ __device__ void init(int M, int N, int G_, int c_) { nM = M / BM; nN = N / BM; nwg = nM * nN; G = G_; c = c_; }
    int rep = 1;
    __host__ __device__ bool next(int i0, Unit& u) const {
        const int i = i0 / rep;
        const long L = (long)i * G + c; if (L >= nwg) return false;
        int wgid = (int)L; { const int q = nwg / NXCD, r = nwg % NXCD, xcd = wgid % NXCD, off = wgid / NXCD; wgid = (xcd < r ? xcd * (q + 1) : r * (q + 1) + (xcd - r) * q) + off; }
        const int nig = WGM * nN, gid = wgid / nig, fm = gid * WGM, gsz = (nM - fm) < WGM ? (nM - fm) : WGM;
        u.pm = fm + ((wgid % nig) % gsz); u.pn = (wgid % nig) / gsz; return true;
    }
    __device__ __forceinline__ void a_ready(const Unit&) const {}
    __device__ __forceinline__ void done(const Unit&) const {}
};
__device__ __forceinline__ unsigned cvt_pk_bf16(float lo, float hi) { unsigned r; asm volatile("v_cvt_pk_bf16_f32 %0, %1, %2" : "=v"(r) : "v"(lo), "v"(hi)); return r; }
__device__ __forceinline__ u32x4 pack8(const f32x4 v0, const f32x4 v1) { u32x4 w; w.x = cvt_pk_bf16(v0[0], v0[1]); w.y = cvt_pk_bf16(v0[2], v0[3]); w.z = cvt_pk_bf16(v1[0], v1[1]); w.w = cvt_pk_bf16(v1[2], v1[3]); return w; }
__device__ __forceinline__ float blo(unsigned w) { return __builtin_bit_cast(float, w << 16); }
__device__ __forceinline__ float bhi(unsigned w) { return __builtin_bit_cast(float, w & 0xffff0000u); }
__device__ __forceinline__ float sigm(float v) { return __builtin_amdgcn_rcpf(1.f + __expf(-v)); }
template <class E> __device__ __forceinline__ void epi_loop(const E& e, const f32x4 (&acc)[2][2][4][2], const Unit& u, int wr, int wc, int fr, int fq) {
#pragma unroll
    for (int ai = 0; ai < 2; ++ai)
#pragma unroll
        for (int m = 0; m < 4; ++m) { const int row = u.pm * BM + ai * HALF + wr * 64 + m * 16 + fr;
#pragma unroll
            for (int bj = 0; bj < 2; ++bj) { const int col = u.pn * BM + bj * HALF + wc * 32 + 8 * fq; e.item(u.pn, row, col, acc[ai][bj][m][0], acc[ai][bj][m][1]); } }
}

struct EpiInProj {
    static constexpr bool PERM = true, AFTER_DRAIN = false;
    bf16_t *Qd, *Kd, *Vd, *LQ, *LK, *LV, *GA, *GB;
    __device__ __forceinline__ void operator()(const f32x4 (&acc)[2][2][4][2], const Unit& u, int wr, int wc, int fr, int fq) const { epi_loop(*this, acc, u, wr, wc, fr, fq); }
    __device__ __forceinline__ void item(int pn, int row, int col, f32x4 v0, f32x4 v1) const {
            const int b = row >> 14, s = row & 16383; bf16_t* dst;
            if (pn < 2) {
                const int h = col >> 7, c = (col >> 6) & 1, d = col & 63; v0 = v0 * 0.18033688011112042f; v1 = v1 * 0.18033688011112042f;
                dst = Qd + ((size_t)((b * 4 + h) * 2 + c) * 16384 + s) * 64 + d;
            } else if (pn < 4) {
                const int cc = col - 512, h = cc >> 7, c = (cc >> 6) & 1, d = cc & 63;
                dst = Kd + ((((size_t)((b * 4 + h) * 2 + c) * 256 + (s >> 6)) * 8 + (d >> 3)) * 64 + (s & 63)) * 8;
            } else if (pn < 6) {
                const int cc = col - 1024, h = cc >> 7, d = cc & 127;
                dst = Vd + ((size_t)(b * 4 + h) * 256 + (s >> 6)) * 8192 + ((d >> 5) * 4 + ((s & 63) >> 4)) * 512 + (s & 15) * 32 + (d & 31);
            } else if (pn < 9) {
                v0 = v0 * 0.18033688011112042f; v1 = v1 * 0.18033688011112042f; dst = LQ + (size_t)row * 768 + (col - 1536);
            } else if (pn < 12) { dst = LK + (size_t)row * 768 + (col - 2304);
            } else if (pn < 15) { dst = LV + (size_t)row * 768 + (col - 3072);
            } else {
#pragma unroll
                for (int i = 0; i < 4; ++i) { v0[i] = sigm(v0[i]); v1[i] = sigm(v1[i]); }
                dst = (pn < 19) ? GA + (size_t)row * 1024 + (col - 3840) : GB + (size_t)row * 1024 + (col - 4864);
            }
            *(u32x4*)dst = pack8(v0, v1);
        }
};
struct EpiGate1 {
    static constexpr bool PERM = true, AFTER_DRAIN = false;
    const bf16_t* GA; bf16_t* G;
    __device__ __forceinline__ void operator()(const f32x4 (&acc)[2][2][4][2], const Unit& u, int wr, int wc, int fr, int fq) const { epi_loop(*this, acc, u, wr, wc, fr, fq); }
    __device__ __forceinline__ void item(int pn, int row, int col, f32x4 v0, f32x4 v1) const {
            const size_t o = (size_t)row * 1024 + col; const u32x4 g = *(const u32x4*)(GA + o);
            v0[0] *= blo(g.x); v0[1] *= bhi(g.x); v0[2] *= blo(g.y); v0[3] *= bhi(g.y); v1[0] *= blo(g.z); v1[1] *= bhi(g.z); v1[2] *= blo(g.w); v1[3] *= bhi(g.w);
            *(u32x4*)(G + o) = pack8(v0, v1);
        }
};
struct EpiGate2 {
    static constexpr bool PERM = true, AFTER_DRAIN = false;
    const bf16_t* GB; bf16_t* G;
    __device__ __forceinline__ void operator()(const f32x4 (&acc)[2][2][4][2], const Unit& u, int wr, int wc, int fr, int fq) const { epi_loop(*this, acc, u, wr, wc, fr, fq); }
    __device__ __forceinline__ void item(int pn, int row, int col, f32x4 v0, f32x4 v1) const {
            const size_t o = (size_t)row * 1024 + col; const u32x4 g = *(const u32x4*)(GB + o); const u32x4 p = *(const u32x4*)(G + o);
            v0[0] = v0[0] * blo(g.x) + blo(p.x); v0[1] = v0[1] * bhi(g.x) + bhi(p.x); v0[2] = v0[2] * blo(g.y) + blo(p.y); v0[3] = v0[3] * bhi(g.y) + bhi(p.y);
            v1[0] = v1[0] * blo(g.z) + blo(p.z); v1[1] = v1[1] * bhi(g.z) + bhi(p.z); v1[2] = v1[2] * blo(g.w) + blo(p.w); v1[3] = v1[3] * bhi(g.w) + bhi(p.w);
            *(u32x4*)(G + o) = pack8(v0, v1);
        }
};
struct EpiOut {
    static constexpr bool PERM = true, AFTER_DRAIN = false;
    const float* X; float* R;
    __device__ __forceinline__ void operator()(const f32x4 (&acc)[2][2][4][2], const Unit& u, int wr, int wc, int fr, int fq) const { epi_loop(*this, acc, u, wr, wc, fr, fq); }
    __device__ __forceinline__ void item(int pn, int row, int col, f32x4 v0, f32x4 v1) const {
            const size_t o = (size_t)row * 1024 + col; const f32x4 x0 = *(const f32x4*)(X + o), x1 = *(const f32x4*)(X + o + 4);
            *(f32x4*)(R + o) = x0 * 1.189207115002721f + v0; *(f32x4*)(R + o + 4) = x1 * 1.189207115002721f + v1;
    }
};
struct EpiScoreT {
    static constexpr bool PERM = true, AFTER_DRAIN = false;
    float* ST;
    __device__ __forceinline__ void operator()(const f32x4 (&acc)[2][2][4][2], const Unit& u, int wr, int wc, int fr, int fq) const { epi_loop(*this, acc, u, wr, wc, fr, fq); }
    __device__ __forceinline__ void item(int pn, int row, int col, f32x4 v0, f32x4 v1) const { const size_t o = (size_t)row * 32768 + col; *(f32x4*)(ST + o) = v0; *(f32x4*)(ST + o + 4) = v1; }
};
template <class Epi, class Sched, bool ALIGN_EPI = false, bool SP2 = false>
__device__ __forceinline__ void gemm_phase(PG8_LAS unsigned char* lds, const Gemm g, const Sched& S, const Epi& E) {
    const int tid = threadIdx.x, wid = __builtin_amdgcn_readfirstlane(tid >> 6), lane = tid & 63, wr = wid >> 2, wc = wid & 3, fr = lane & 15, fq = lane >> 4;
    const int K = g.K, nt = K / BK;
    unsigned voffA[2], voffB[2];
#pragma unroll
    for (int i = 0; i < 2; ++i) { int R, C; stage_rc(tid * 16 + i * 8192, R, C); const int Rb = Epi::PERM ? ((R & ~31) + perm32(R & 31)) : R;
        voffA[i] = (unsigned)(R * K + C) * 2u; voffB[i] = (unsigned)(Rb * K + C) * 2u; }
    const size_t kstep = (size_t)(BK * 2);
    const size_t hstep = (size_t)HALF * K * 2;
    const size_t tstep = 2 * hstep;
    const unsigned ldsw = (unsigned)wid * 1024u;
    const int aoff = lds_byte(wr * 64 + fr, fq * 8), boff = lds_byte(wc * 32 + fr, fq * 8);
#define PG8_SA(b, h) (((b) * 2 + (h)) * HTB)
#define PG8_SB(b, h) ((4 + (b) * 2 + (h)) * HTB)
#define PG8_STAGE(bufoff, gbase, voff) do { _Pragma("unroll") for (int _i = 0; _i < 2; ++_i) \
        __builtin_amdgcn_global_load_lds((const unsigned*)((const char*)(gbase) + (voff)[_i]), (PG8_LAS unsigned*)(lds + (bufoff) + ldsw + _i * 8192), 16, 0, 0); } while (0)
#define PG8_LDA(dst, b, h) do { _Pragma("unroll") for (int m = 0; m < 4; ++m) _Pragma("unroll") for (int k = 0; k < 2; ++k) dst[m][k] = *(const PG8_LAS bf16x8*)(lds + PG8_SA(b, h) + aoff + m * 2048 + k * 1024); } while (0)
#define PG8_LDB(dst, b, h) do { _Pragma("unroll") for (int n = 0; n < 2; ++n) _Pragma("unroll") for (int k = 0; k < 2; ++k) dst[n][k] = *(const PG8_LAS bf16x8*)(lds + PG8_SB(b, h) + boff + n * 2048 + k * 1024); } while (0)
#define PG8_MMA(ai, bj, At, Bt) do { __builtin_amdgcn_s_setprio(1); _Pragma("unroll") for (int m = 0; m < 4; ++m) _Pragma("unroll") for (int n = 0; n < 2; ++n) _Pragma("unroll") for (int k = 0; k < 2; ++k) \
        acc[ai][bj][m][n] = __builtin_amdgcn_mfma_f32_16x16x32_bf16(Bt[n][k], At[m][k], acc[ai][bj][m][n], 0, 0, 0); __builtin_amdgcn_s_setprio(0); } while (0)
#define PG8_WAIT_V(n) asm volatile("s_waitcnt vmcnt(" #n ")" ::: "memory")
#define PG8_WAIT_L(n) asm volatile("s_waitcnt lgkmcnt(" #n ")" ::: "memory")
#define PG8_BAR __builtin_amdgcn_s_barrier()
#define PG8_SCHED __builtin_amdgcn_sched_barrier(0)
    Unit cur, nxt; int ui = 0;
    if (!S.next(0, cur)) return;
    f32x4 acc[2][2][4][2];
#pragma unroll
    for (int a = 0; a < 2; ++a)
#pragma unroll
        for (int b = 0; b < 2; ++b)
#pragma unroll
            for (int m = 0; m < 4; ++m)
#pragma unroll
                for (int n = 0; n < 2; ++n) acc[a][b][m][n] = (f32x4){0.f, 0.f, 0.f, 0.f};
    bf16x8 At[4][2], B0[2][2], B1[2][2];
    const char* cA = (const char*)g.A + (size_t)cur.pm * tstep; const char* cB = (const char*)g.Bt + (size_t)cur.pn * tstep;
    S.a_ready(cur);
    if constexpr (SP2) {
        PG8_STAGE(PG8_SB(0, 0), cB, voffB); PG8_STAGE(PG8_SB(0, 1), cB + hstep, voffB); PG8_STAGE(PG8_SA(0, 0), cA, voffA); PG8_STAGE(PG8_SA(0, 1), cA + hstep, voffA);
        if (wr == 1) PG8_BAR;
        PG8_WAIT_V(2); PG8_BAR;
        PG8_STAGE(PG8_SB(1, 0), cB + kstep, voffB); PG8_STAGE(PG8_SA(1, 0), cA + kstep, voffA); PG8_STAGE(PG8_SB(1, 1), cB + hstep + kstep, voffB);
        PG8_WAIT_V(6); PG8_BAR;
    } else {
        PG8_STAGE(PG8_SB(0, 0), cB, voffB); PG8_STAGE(PG8_SA(0, 0), cA, voffA); PG8_STAGE(PG8_SB(0, 1), cB + hstep, voffB); PG8_STAGE(PG8_SA(0, 1), cA + hstep, voffA);
        if (wr == 1) PG8_BAR;
        PG8_WAIT_V(4); PG8_BAR;
        PG8_STAGE(PG8_SB(1, 0), cB + kstep, voffB); PG8_STAGE(PG8_SA(1, 0), cA + kstep, voffA); PG8_STAGE(PG8_SB(1, 1), cB + hstep + kstep, voffB);
        PG8_WAIT_V(6); PG8_BAR;
    }
    for (;;) {
        const bool has_next = S.next(ui + 1, nxt);
        const char* nA = has_next ? (const char*)g.A + (size_t)nxt.pm * tstep : cA; const char* nB = has_next ? (const char*)g.Bt + (size_t)nxt.pn * tstep : cB;
        for (int t = 0; t < nt; t += 2) {
            const bool last = (t == nt - 2);
            const char* a1 = cA + (size_t)(t + 1) * kstep;
            const char* a2 = last ? nA : cA + (size_t)(t + 2) * kstep; const char* b2 = last ? nB : cB + (size_t)(t + 2) * kstep;
            const char* a3 = a2 + kstep; const char* b3 = b2 + kstep;
            if (last && has_next) S.a_ready(nxt);
            if constexpr (SP2) {
            PG8_LDB(B0, 0, 0); PG8_LDB(B1, 0, 1); PG8_SCHED; PG8_LDA(At, 0, 0); PG8_STAGE(PG8_SA(1, 1), a1 + hstep, voffA);
            PG8_WAIT_V(8); PG8_WAIT_L(0); PG8_BAR; PG8_MMA(0, 0, At, B0); PG8_MMA(0, 1, At, B1); PG8_BAR; PG8_SCHED;
            PG8_LDA(At, 0, 1); PG8_STAGE(PG8_SB(0, 0), b2, voffB); PG8_STAGE(PG8_SB(0, 1), b2 + hstep, voffB); PG8_STAGE(PG8_SA(0, 0), a2, voffA);
            PG8_WAIT_V(8); PG8_WAIT_L(0); PG8_BAR; PG8_MMA(1, 0, At, B0); PG8_MMA(1, 1, At, B1); PG8_BAR; PG8_SCHED;
            PG8_LDB(B0, 1, 0); PG8_LDB(B1, 1, 1); PG8_SCHED; PG8_LDA(At, 1, 0); PG8_STAGE(PG8_SA(0, 1), a2 + hstep, voffA);
            PG8_WAIT_V(8); PG8_WAIT_L(0); PG8_BAR; PG8_MMA(0, 0, At, B0); PG8_MMA(0, 1, At, B1); PG8_BAR; PG8_SCHED;
            PG8_LDA(At, 1, 1); PG8_STAGE(PG8_SB(1, 0), b3, voffB); PG8_STAGE(PG8_SB(1, 1), b3 + hstep, voffB); PG8_STAGE(PG8_SA(1, 0), a3, voffA);
            PG8_WAIT_V(8); PG8_WAIT_L(0); PG8_BAR; PG8_MMA(1, 0, At, B0); PG8_MMA(1, 1, At, B1); PG8_BAR; PG8_SCHED;
            } else {
            PG8_LDB(B0, 0, 0); PG8_SCHED; PG8_LDA(At, 0, 0); PG8_STAGE(PG8_SA(1, 1), a1 + hstep, voffA);
            PG8_WAIT_L(8); PG8_BAR; PG8_WAIT_L(0); PG8_MMA(0, 0, At, B0); PG8_BAR; PG8_SCHED;
            PG8_LDB(B1, 0, 1); PG8_STAGE(PG8_SB(0, 0), b2, voffB);
            PG8_BAR; PG8_WAIT_L(0); PG8_MMA(0, 1, At, B1); PG8_BAR;
            PG8_LDA(At, 0, 1); PG8_STAGE(PG8_SA(0, 0), a2, voffA);
            PG8_BAR; PG8_WAIT_L(0); PG8_MMA(1, 0, At, B0); PG8_BAR; PG8_SCHED;
            PG8_STAGE(PG8_SB(0, 1), b2 + hstep, voffB);
            PG8_WAIT_V(6); PG8_BAR; PG8_MMA(1, 1, At, B1); PG8_BAR;
            PG8_LDB(B0, 1, 0); PG8_SCHED; PG8_LDA(At, 1, 0); PG8_STAGE(PG8_SA(0, 1), a2 + hstep, voffA);
            PG8_WAIT_L(8); PG8_BAR; PG8_WAIT_L(0); PG8_MMA(0, 0, At, B0); PG8_BAR; PG8_SCHED;
            PG8_LDB(B1, 1, 1); PG8_STAGE(PG8_SB(1, 0), b3, voffB);
            PG8_BAR; PG8_WAIT_L(0); PG8_MMA(0, 1, At, B1); PG8_BAR;
            PG8_LDA(At, 1, 1); PG8_STAGE(PG8_SA(1, 0), a3, voffA);
            PG8_BAR; PG8_WAIT_L(0); PG8_MMA(1, 0, At, B0); PG8_BAR; PG8_SCHED;
            PG8_STAGE(PG8_SB(1, 1), b3 + hstep, voffB);
            PG8_WAIT_V(6); PG8_BAR; PG8_MMA(1, 1, At, B1); PG8_BAR;
            }
        }
        if constexpr (ALIGN_EPI) { if (wr == 0) PG8_BAR; }
        if constexpr (!Epi::AFTER_DRAIN) { E(acc, cur, wr, wc, fr, fq); S.done(cur); }
        if (!has_next) break;
#pragma unroll
        for (int a = 0; a < 2; ++a)
#pragma unroll
            for (int b = 0; b < 2; ++b)
#pragma unroll
                for (int m = 0; m < 4; ++m)
#pragma unroll
                    for (int n = 0; n < 2; ++n) acc[a][b][m][n] = (f32x4){0.f, 0.f, 0.f, 0.f};
        cur = nxt; cA = nA; cB = nB; ++ui;
        if constexpr (ALIGN_EPI) { if (wr == 1) PG8_BAR; }
    }
    PG8_WAIT_V(0);
    if constexpr (!ALIGN_EPI) { if (wr == 0) PG8_BAR; }
    PG8_BAR;
    if constexpr (Epi::AFTER_DRAIN) { E.fused(acc, cur, wr, wc, fr, fq, lds, wid, lane); S.done(cur); }
#undef PG8_SA
#undef PG8_SB
#undef PG8_STAGE
#undef PG8_LDA
#undef PG8_LDB
#undef PG8_MMA
#undef PG8_WAIT_V
#undef PG8_WAIT_L
#undef PG8_BAR
#undef PG8_SCHED
}
}
#define XB_TMO      128
#define XB_XCNT(j)  (256  + 64 * (j))
#define XB_XSUB(j)  (1280 + 64 * (j))
#define XB_XGEN(j)  (2304 + 64 * (j))
#define XB_TOP      3328
#define XB_TOPGEN   3392
#define XCD_BAR_WORDS 3456
#define XB_SPIN_CAP (1u << 18)

__device__ __forceinline__ unsigned xb_ld(unsigned* p)              { return __hip_atomic_load(p, __ATOMIC_RELAXED, __HIP_MEMORY_SCOPE_AGENT); }
__device__ __forceinline__ unsigned xb_add(unsigned* p, unsigned v) { return __hip_atomic_fetch_add(p, v, __ATOMIC_RELAXED, __HIP_MEMORY_SCOPE_AGENT); }
__device__ __forceinline__ unsigned xb_xcc_id() { return (unsigned)__builtin_amdgcn_s_getreg((3 << 11) | 20) & 0xFu; }
#define XB_SPIN(cond, bar) do { unsigned _sp = 0; while (cond) { __builtin_amdgcn_s_sleep(1); \
    if ((++_sp & 255u) == 0u) { if (xb_ld(&(bar)[XB_TMO])) break; if (_sp > XB_SPIN_CAP) { atomicAdd(&(bar)[XB_TMO], 1u); break; } } } } while (0)

struct XcdBarrier {
    unsigned* bar; unsigned x;
    volatile LAS unsigned* st;
};

__device__ __forceinline__ XcdBarrier xcd_barrier_post(unsigned* bar, volatile LAS unsigned* st) {
    XcdBarrier b; b.bar = bar; b.x = xb_xcc_id(); b.st = st;
    if (threadIdx.x == 0) (void)xb_add(&bar[XB_XCNT(b.x)], 1u);
    return b;
}
__device__ __forceinline__ void xcd_barrier_complete(unsigned* bar, unsigned x, unsigned& nloc, unsigned& nx) {
    const unsigned G = gridDim.x * gridDim.y * gridDim.z;
    unsigned sum, cnt, mine, sp = 0u;
    for (;;) {
        sum = 0u; cnt = 0u; mine = 0u;
#pragma unroll
        for (unsigned j = 0; j < 16; ++j) { const unsigned c = xb_ld(&bar[XB_XCNT(j)]); sum += c; cnt += (c > 0u) ? 1u : 0u; mine = (j == x) ? c : mine; }
        if (sum == G) break;
        __builtin_amdgcn_s_sleep(1);
        if ((++sp & 255u) == 0u) { if (xb_ld(&bar[XB_TMO])) break; if (sp > XB_SPIN_CAP) { atomicAdd(&bar[XB_TMO], 1u); break; } }
    }
    nloc = mine > 0u ? mine : 1u; nx = cnt > 0u ? cnt : 1u;
}

__device__ __forceinline__ void xcd_barrier(const XcdBarrier& b) {
    asm volatile("s_waitcnt vmcnt(0)" ::: "memory");
    __syncthreads();
    if (threadIdx.x == 0) {
        unsigned* bar = b.bar;
        __builtin_amdgcn_s_waitcnt(0);
        unsigned nloc = b.st[0], nx = b.st[1];
        if (nloc == 0u) { xcd_barrier_complete(bar, b.x, nloc, nx); b.st[0] = nloc; b.st[1] = nx; }
        const unsigned old = xb_add(&bar[XB_XSUB(b.x)], 1u);
        const unsigned gen = old / nloc;
        if (old + 1u == (gen + 1u) * nloc) {
            __builtin_amdgcn_fence(__ATOMIC_RELEASE, "agent");
            asm volatile("s_waitcnt vmcnt(0)" ::: "memory");
            const unsigned og = xb_add(&bar[XB_TOP], 1u);
            const unsigned tg = og / nx;
            if (og + 1u == (tg + 1u) * nx) xb_add(&bar[XB_TOPGEN], 1u);
            else XB_SPIN(xb_ld(&bar[XB_TOPGEN]) == tg, bar);
            __builtin_amdgcn_fence(__ATOMIC_ACQUIRE, "agent");
            xb_add(&bar[XB_XGEN(b.x)], 1u);
            asm volatile("s_waitcnt vmcnt(0)" ::: "memory");
        } else {
            XB_SPIN(xb_ld(&bar[XB_XGEN(b.x)]) == gen, bar);
            __builtin_amdgcn_fence(__ATOMIC_ACQUIRE, "agent");
            asm volatile("s_waitcnt vmcnt(0)" ::: "memory");
        }
    }
    __syncthreads();
}
namespace da {
constexpr int SLOT_K = 8192, SLOT_V = 16384, SLOT = SLOT_K + SLOT_V;
constexpr int NSLOT = 4;
constexpr int LDS_BIAS = NSLOT * SLOT;
constexpr int LDS_END = LDS_BIAS + BIAS_TAB * 4;
constexpr float THR = 8.f;
__device__ __forceinline__ int crow(int r, int hi) { return (r & 3) + 8 * (r >> 2) + 4 * hi; }
__device__ __forceinline__ void glds16(const void* gbase  , unsigned voff  , unsigned lds_dst) { unsigned keep;
    asm volatile("s_mov_b32 %0, m0\n\ts_mov_b32 m0, %3\n\ts_nop 0\n\tglobal_load_lds_dwordx4 %1, %2\n\ts_mov_b32 m0, %0" : "=&s"(keep) : "v"(voff), "s"(gbase), "s"(lds_dst) : "memory"); }
typedef short v4i16_t __attribute__((ext_vector_type(4)));
__device__ __forceinline__ s16x4 vtr(const LAS char* p) { return __builtin_bit_cast(s16x4, __builtin_amdgcn_ds_read_tr16_b64_v4i16((LAS v4i16_t*)p)); }
#define DA_WAIT_BAR() asm volatile("s_waitcnt vmcnt(0) lgkmcnt(0)\n\ts_barrier" ::: "memory")

struct Tensors { const bf16* Qd; const bf16* Kd; const bf16* Vd; float* stash; bf16* ya; const float* dlam; const float* subg; const float* relb; };

__device__ __forceinline__ float max3f(float a, float b, float c) { float r; asm("v_max3_f32 %0, %1, %2, %3" : "=v"(r) : "v"(a), "v"(b), "v"(c)); return r; }
#define DA_STAGE_Q(T_) do { const int t_ = (T_); const LAS char* kb_ = kp0 + (t_ & 3) * SLOT; \
        bf16x8 kf_[8]; \
        _Pragma("unroll") for (int d0 = 0; d0 < 2; ++d0) { kf_[2 * d0] = *(const LAS bf16x8*)(kb_ + d0 * 2048); kf_[2 * d0 + 1] = *(const LAS bf16x8*)(kb_ + d0 * 2048 + 512); } \
        if ((q0 - 64 * t_ - 63) < DFAR) { int base_ = qabs - 64 * t_ - 4 * hi + BIAS_GUARD; asm volatile("" : "+v"(base_)); \
            _Pragma("unroll") for (int r = 0; r < 16; ++r) { const int o_ = (r & 3) + 8 * (r >> 2); p0[r] = tb[base_ - o_] - m; p1[r] = tb[base_ - o_ - 32] - m; } \
            _Pragma("unroll") for (int d0 = 0; d0 < 4; ++d0) { if (d0 < 2) { kf_[2 * d0 + 4] = *(const LAS bf16x8*)(kb_ + (d0 + 2) * 2048); kf_[2 * d0 + 5] = *(const LAS bf16x8*)(kb_ + (d0 + 2) * 2048 + 512); } \
                p0 = __builtin_amdgcn_mfma_f32_32x32x16_bf16(kf_[2 * d0], qr[d0], p0, 0, 0, 0); p1 = __builtin_amdgcn_mfma_f32_32x32x16_bf16(kf_[2 * d0 + 1], qr[d0], p1, 0, 0, 0); } \
        } else { f32x16 ci_; const float cm_ = c31 - m; _Pragma("unroll") for (int r = 0; r < 16; ++r) ci_[r] = cm_; \
            _Pragma("unroll") for (int d0 = 0; d0 < 4; ++d0) { if (d0 < 2) { kf_[2 * d0 + 4] = *(const LAS bf16x8*)(kb_ + (d0 + 2) * 2048); kf_[2 * d0 + 5] = *(const LAS bf16x8*)(kb_ + (d0 + 2) * 2048 + 512); } \
                p0 = __builtin_amdgcn_mfma_f32_32x32x16_bf16(kf_[2 * d0], qr[d0], d0 == 0 ? ci_ : p0, 0, 0, 0); p1 = __builtin_amdgcn_mfma_f32_32x32x16_bf16(kf_[2 * d0 + 1], qr[d0], d0 == 0 ? ci_ : p1, 0, 0, 0); } } \
    } while (0)
#ifdef PROBE_B
#define DA_PROBE_B() do { float dsum_ = 0.f; _Pragma("unroll") for (int r = 0; r < 16; ++r) { dsum_ += __builtin_amdgcn_exp2f(p0[r] - 1.f) + __builtin_amdgcn_exp2f(p1[r] - 2.f); } asm volatile("" :: "v"(dsum_)); } while (0)
#else
#define DA_PROBE_B() do {} while (0)
#endif
#define DA_STAGE_S(T_) do { const int t_ = (T_); \
        if (t_ >= NT - 4) { int base_ = qabs - 64 * t_ - 4 * hi + BIAS_GUARD; asm volatile("" : "+v"(base_)); \
            _Pragma("unroll") for (int r = 0; r < 16; ++r) { const int o_ = (r & 3) + 8 * (r >> 2); if (base_ - o_ < BIAS_GUARD) p0[r] = -1e30f; if (base_ - o_ - 32 < BIAS_GUARD) p1[r] = -1e30f; } } \
        float ra_ = max3f(p0[0], p0[1], p1[0]), rb_ = max3f(p0[2], p0[3], p1[1]); ra_ = max3f(ra_, p1[2], p1[3]); \
        _Pragma("unroll") for (int r = 4; r < 16; r += 4) { ra_ = max3f(ra_, p0[r], p0[r + 1]); rb_ = max3f(rb_, p0[r + 2], p0[r + 3]); ra_ = max3f(ra_, p1[r], p1[r + 1]); rb_ = max3f(rb_, p1[r + 2], p1[r + 3]); } \
        float rm_ = fmaxf(ra_, rb_); \
        { auto rr_ = __builtin_amdgcn_permlane32_swap(__float_as_uint(rm_), __float_as_uint(rm_), false, false); rm_ = fmaxf(__uint_as_float(rr_[0]), __uint_as_float(rr_[1])); } \
        if (t_ == 0 || __any(rm_ > THR)) { const float dl_ = (t_ == 0) ? rm_ : fmaxf(rm_, 0.f), f_ = __builtin_amdgcn_exp2f(-dl_); \
            _Pragma("unroll") for (int r = 0; r < 16; ++r) { p0[r] -= dl_; p1[r] -= dl_; } \
            _Pragma("unroll") for (int d0 = 0; d0 < 4; ++d0) _Pragma("unroll") for (int r = 0; r < 16; ++r) o[d0][r] *= f_; \
            l *= f_; m += dl_; } \
        float ls0_ = 0.f, ls1_ = 0.f; \
        _Pragma("unroll") for (int r = 0; r < 16; ++r) { p0[r] = __builtin_amdgcn_exp2f(p0[r]); p1[r] = __builtin_amdgcn_exp2f(p1[r]); ls0_ += p0[r]; ls1_ += p1[r]; } \
        l += ls0_ + ls1_; DA_PROBE_B(); \
        { v4u w; \
          w.x = cvtpk(p0[0], p0[1]); w.y = cvtpk(p0[2], p0[3]); w.z = cvtpk(p0[4], p0[5]); w.w = cvtpk(p0[6], p0[7]); pw[0] = __builtin_bit_cast(bf16x8, w); \
          w.x = cvtpk(p0[8], p0[9]); w.y = cvtpk(p0[10], p0[11]); w.z = cvtpk(p0[12], p0[13]); w.w = cvtpk(p0[14], p0[15]); pw[1] = __builtin_bit_cast(bf16x8, w); \
          w.x = cvtpk(p1[0], p1[1]); w.y = cvtpk(p1[2], p1[3]); w.z = cvtpk(p1[4], p1[5]); w.w = cvtpk(p1[6], p1[7]); pw[2] = __builtin_bit_cast(bf16x8, w); \
          w.x = cvtpk(p1[8], p1[9]); w.y = cvtpk(p1[10], p1[11]); w.z = cvtpk(p1[12], p1[13]); w.w = cvtpk(p1[14], p1[15]); pw[3] = __builtin_bit_cast(bf16x8, w); } \
    } while (0)
#define DA_VF(V_, ks) (bf16x8){V_[2 * (ks)][0], V_[2 * (ks)][1], V_[2 * (ks)][2], V_[2 * (ks)][3], V_[2 * (ks) + 1][0], V_[2 * (ks) + 1][1], V_[2 * (ks) + 1][2], V_[2 * (ks) + 1][3]}
#define DA_STAGE_B(T_) do { const LAS char* vb_ = vp0 + ((T_) & 3) * SLOT; \
        _Pragma("unroll") for (int d0 = 0; d0 < 4; ++d0) { s16x4 vA[8]; \
            _Pragma("unroll") for (int ks = 0; ks < 4; ++ks) { vA[2 * ks] = vtr(vb_ + d0 * 4096 + ks * 1024); vA[2 * ks + 1] = vtr(vb_ + d0 * 4096 + ks * 1024 + 512); } \
            _Pragma("unroll") for (int ks = 0; ks < 4; ++ks) o[d0] = __builtin_amdgcn_mfma_f32_32x32x16_bf16(DA_VF(vA, ks), pw[ks], o[d0], 0, 0, 0); \
            __builtin_amdgcn_sched_barrier(0); } \
    } while (0)
__device__ __forceinline__ void unit(const Tensors& X, int b, int h, int qb, LAS unsigned char* lds, int wgslot, float lam, float c31) {
    const int wid = __builtin_amdgcn_readfirstlane((int)threadIdx.x >> 6);
    const int grp = wid >> 2;
    const int q0 = qb * 256, NT = 4 * (qb + 1);
    const unsigned lds0 = (unsigned)(uintptr_t)lds;
    const LAS float* tb = (const LAS float*)(lds + LDS_BIAS);
    for (int c = 0; c < 2; ++c) {
        int lane = (int)__builtin_amdgcn_mbcnt_hi(~0u, __builtin_amdgcn_mbcnt_lo(~0u, 0u)); asm volatile("" : "+v"(lane));
        const int r32 = lane & 31, hi = lane >> 5;
        const unsigned lane16 = (unsigned)lane * 16u;
        const int qabs = q0 + wid * 32 + r32;
        const LAS char* vp0 = (const LAS char*)lds + SLOT_K + ((lane >> 4) & 1) * 32 + (lane & 3) * 8 + (4 * hi + ((lane & 15) >> 2)) * 64;
        const LAS char* kp0 = (const LAS char*)lds + hi * 1024 + r32 * 16;
        const int bhc = (b * 4 + h) * 2 + c;
        const bf16* Qw = X.Qd + ((size_t)bhc * SEQ + q0 + wid * 32 + r32) * 64 + hi * 8;
        const char* Kt = (const char*)X.Kd + (size_t)bhc * NTILE * SLOT_K + wid * 1024;
        const char* Vt = (const char*)X.Vd + (size_t)(b * 4 + h) * NTILE * SLOT_V + wid * 1024;
#define DA_DMA(t, slot) do { const unsigned sb_ = (unsigned)__builtin_amdgcn_readfirstlane(lds0 + (slot) * SLOT + wid * 1024); \
        glds16(Kt + (size_t)(t) * SLOT_K, lane16, sb_); glds16(Vt + (size_t)(t) * SLOT_V, lane16, sb_ + SLOT_K); glds16(Vt + (size_t)(t) * SLOT_V + 8192, lane16, sb_ + SLOT_K + 8192); } while (0)
        DA_DMA(0, 0); DA_DMA(1, 1); DA_DMA(2, 2);
        bf16x8 qr[4];
#pragma unroll
        for (int d0 = 0; d0 < 4; ++d0) qr[d0] = *(const bf16x8*)(Qw + d0 * 16);
        f32x16 o[4];
#pragma unroll
        for (int d0 = 0; d0 < 4; ++d0)
#pragma unroll
            for (int r = 0; r < 16; ++r) o[d0][r] = 0.f;
        float m = 0.f, l = 0.f;
        bf16x8 pw[4]; f32x16 p0, p1;
        asm volatile("" :: "v"(qr[0]), "v"(qr[1]), "v"(qr[2]), "v"(qr[3]));
        asm volatile("s_waitcnt vmcnt(6) lgkmcnt(0)\n\ts_barrier" ::: "memory");
        DA_STAGE_Q(0);
#define DA_TILE_BARRIER(t) do { \
            if ((t) + 1 < NT) asm volatile("s_waitcnt vmcnt(3) lgkmcnt(0)\n\ts_barrier" ::: "memory"); else asm volatile("s_waitcnt vmcnt(0) lgkmcnt(0)\n\ts_barrier" ::: "memory"); \
            if ((t) + 2 < NT) { const int sn_ = ((t) + 2) & 3; DA_DMA((t) + 2, sn_); } } while (0)
        for (int t = 1; t <= NT; ++t) {
            if (grp == 1) DA_TILE_BARRIER(t);
            DA_STAGE_S(t - 1);
            if (grp == 0) DA_TILE_BARRIER(t);
            __builtin_amdgcn_sched_barrier(0);
            DA_STAGE_B(t - 1);
#ifdef PROBE_A
            { f32x16 dz = {0.f,0.f,0.f,0.f,0.f,0.f,0.f,0.f,0.f,0.f,0.f,0.f,0.f,0.f,0.f,0.f};
              _Pragma("unroll") for (int rep = 0; rep < 4; ++rep) _Pragma("unroll") for (int ks = 0; ks < 4; ++ks) dz = __builtin_amdgcn_mfma_f32_32x32x16_bf16(pw[ks], pw[3 - ks], dz, 0, 0, 0);
              asm volatile("" :: "v"(dz)); }
#endif
            if (t < NT) DA_STAGE_Q(t);
        }
#undef DA_TILE_BARRIER
#undef DA_DMA
        { auto rr = __builtin_amdgcn_permlane32_swap(__float_as_uint(l), __float_as_uint(l), false, false); l = __uint_as_float(rr[0]) + __uint_as_float(rr[1]); }
        const float inv = 1.f / l;
        int lane_e = lane; asm volatile("" : "+v"(lane_e));
        GAS float* stg = (GAS float*)(X.stash + ((size_t)(wgslot * 8 + wid) * 64) * 64 + lane_e);
        if (c == 0) {
#pragma unroll
            for (int d0 = 0; d0 < 4; ++d0)
#pragma unroll
                for (int r = 0; r < 16; ++r) stg[(d0 * 16 + r) * 64] = o[d0][r] * inv;
        } else {
            float ss = 0.f;
#pragma unroll
            for (int d0 = 0; d0 < 4; ++d0)
#pragma unroll
                for (int r = 0; r < 16; ++r) { const float dv = stg[(d0 * 16 + r) * 64] - lam * (o[d0][r] * inv); o[d0][r] = dv; ss += dv * dv; if (r == 15) asm volatile("" ::: "memory"); }
            { auto rr = __builtin_amdgcn_permlane32_swap(__float_as_uint(ss), __float_as_uint(ss), false, false); ss = __uint_as_float(rr[0]) + __uint_as_float(rr[1]); }
            const float rn = __builtin_amdgcn_rsqf(ss * (1.f / 128.f) + SUBLN_EPS) * (1.f - LAM_INIT);
            const int hi_e = lane_e >> 5, qabs_e = q0 + wid * 32 + (lane_e & 31);
            bf16* yrow = X.ya + ((size_t)b * SEQ + qabs_e) * 512 + h * 128 + 4 * hi_e; const float* sg = X.subg + 4 * hi_e;
#pragma unroll
            for (int d0 = 0; d0 < 4; ++d0)
#pragma unroll
                for (int r4 = 0; r4 < 4; ++r4) {
                    const int dd = 32 * d0 + 8 * r4; const f32x4 g = *(const f32x4*)(sg + dd);
                    v2u w; w.x = pk2(o[d0][4 * r4] * rn * g[0], o[d0][4 * r4 + 1] * rn * g[1]); w.y = pk2(o[d0][4 * r4 + 2] * rn * g[2], o[d0][4 * r4 + 3] * rn * g[3]);
                    *(v2u*)(yrow + dd) = w;
                }
        }
    }
    asm volatile("s_waitcnt vmcnt(0) lgkmcnt(0)\n\ts_barrier" ::: "memory");
}
#undef DA_STAGE_Q
#undef DA_STAGE_S
#undef DA_STAGE_B
#undef DA_VF
#undef DA_WAIT_BAR
}
namespace dil {
constexpr int BT = 1152, BT0 = 512;
constexpr int LDS_VST = 0, LDS_BL = 32768, LDS_END = LDS_BL + 3 * BT * 4;
constexpr float THR = 8.f;
struct Tensors { const bf16* LQ; const bf16* LK; const bf16* LV; bf16* yb; };
typedef short v4i16_t __attribute__((ext_vector_type(4)));
__device__ __forceinline__ s16x4 vtr(const LAS unsigned char* p) { return __builtin_bit_cast(s16x4, __builtin_amdgcn_ds_read_tr16_b64_v4i16((LAS v4i16_t*)p)); }

template <int G_, int QS_> __device__ __forceinline__ void group(const Tensors& X, size_t rowb, int h, int P0, int r, LAS unsigned char* vst, const LAS float* blg, int lane, f32x16 (&o)[2], float& m, float& l) {
    constexpr int DL = (G_ == 0) ? 1 : (G_ == 1) ? 4 : 16, MG = QS_ / DL, NKB = (31 * MG + 128) / 32 + 1;
    static_assert(QS_ % DL == 0, "query stride must be a multiple of the dilation");
    const int i = lane & 31, hi = lane >> 5;
    const int colb = G_ * 256 + h * 64;
    bf16x8 qr[4];
    { const bf16* qp = X.LQ + (rowb + P0 + r + QS_ * i) * 768 + colb + hi * 8;
#pragma unroll
      for (int d0 = 0; d0 < 4; ++d0) qr[d0] = *(const bf16x8*)(qp + 16 * d0); }
    const int kpos0 = P0 + r - 128 * DL;
    const LAS unsigned char* vrd = vst + ((lane >> 4) & 1) * 32 + (lane & 3) * 8 + (4 * hi + ((lane & 15) >> 2)) * 64;
#define DIL_LOAD(KF, VR, KB) do { \
        { int kpos_ = kpos0 + (32 * (KB) + i) * DL; kpos_ = kpos_ < 0 ? 0 : (kpos_ > SEQ - 1 ? SEQ - 1 : kpos_); const bf16* kp_ = X.LK + (rowb + kpos_) * 768 + colb + hi * 8; \
          _Pragma("unroll") for (int d0 = 0; d0 < 4; ++d0) KF[d0] = *(const bf16x8*)(kp_ + 16 * d0); } \
        _Pragma("unroll") for (int t = 0; t < 4; ++t) { const int qd = lane + 64 * t, key = qd >> 3, ch = qd & 7; int vpos_ = kpos0 + (32 * (KB) + key) * DL; vpos_ = vpos_ < 0 ? 0 : (vpos_ > SEQ - 1 ? SEQ - 1 : vpos_); \
            VR[t] = *(const v4u*)(X.LV + (rowb + vpos_) * 768 + colb + ch * 8); } } while (0)
    bf16x8 kfn[4]; v4u vregn[4];
    DIL_LOAD(kfn, vregn, 0);
#pragma unroll 1
    for (int kb = 0; kb < NKB; ++kb) {
        bf16x8 kf[4]; v4u vreg[4];
#pragma unroll
        for (int d0 = 0; d0 < 4; ++d0) { kf[d0] = kfn[d0]; vreg[d0] = vregn[d0]; }
        if (kb + 1 < NKB) DIL_LOAD(kfn, vregn, kb + 1);
        const int jb = i * MG + 128 - 32 * kb - 4 * hi;
        f32x16 p;
#pragma unroll
        for (int rr = 0; rr < 16; ++rr) p[rr] = blg[jb - ((rr & 3) + 8 * (rr >> 2)) + BT0];
#pragma unroll
        for (int d0 = 0; d0 < 4; ++d0) p = __builtin_amdgcn_mfma_f32_32x32x16_bf16(kf[d0], qr[d0], p, 0, 0, 0);
        const int cb = 32 * kb + 4 * hi;
#pragma unroll
        for (int rr = 0; rr < 16; ++rr) { const int o_ = (rr & 3) + 8 * (rr >> 2); if ((unsigned)(jb - o_) > 128u || kpos0 + (cb + o_) * DL < 0) p[rr] = -3e38f; }
        float rm = p[0];
#pragma unroll
        for (int rr = 1; rr < 16; ++rr) rm = fmaxf(rm, p[rr]);
        { auto sw = __builtin_amdgcn_permlane32_swap(__float_as_uint(rm), __float_as_uint(rm), false, false); rm = fmaxf(__uint_as_float(sw[0]), __uint_as_float(sw[1])); }
        if (__any(rm > m + THR)) {
            const float mn = fmaxf(m, rm), f = __builtin_amdgcn_exp2f(m - mn);
#pragma unroll
            for (int d0 = 0; d0 < 2; ++d0)
#pragma unroll
                for (int rr = 0; rr < 16; ++rr) o[d0][rr] *= f;
            l *= f; m = mn;
        }
        float ls = 0.f;
#pragma unroll
        for (int rr = 0; rr < 16; ++rr) { p[rr] = __builtin_amdgcn_exp2f(p[rr] - m); ls += p[rr]; }
        l += ls;
        bf16x8 pw[2];
        { v4u w;
          w.x = cvtpk(p[0], p[1]); w.y = cvtpk(p[2], p[3]); w.z = cvtpk(p[4], p[5]); w.w = cvtpk(p[6], p[7]); pw[0] = __builtin_bit_cast(bf16x8, w);
          w.x = cvtpk(p[8], p[9]); w.y = cvtpk(p[10], p[11]); w.z = cvtpk(p[12], p[13]); w.w = cvtpk(p[14], p[15]); pw[1] = __builtin_bit_cast(bf16x8, w); }
#pragma unroll
        for (int t = 0; t < 4; ++t) { const int qd = lane + 64 * t, key = qd >> 3, ch = qd & 7;
            *(LAS v4u*)(vst + ((ch >> 2) * 2 + (key >> 4)) * 1024 + (key & 15) * 64 + (ch & 3) * 16) = vreg[t]; }
        asm volatile("s_waitcnt lgkmcnt(0)" ::: "memory");
#pragma unroll
        for (int d0 = 0; d0 < 2; ++d0)
#pragma unroll
            for (int ks = 0; ks < 2; ++ks) {
                const s16x4 lo = vtr(vrd + (d0 * 2 + ks) * 1024), hh = vtr(vrd + (d0 * 2 + ks) * 1024 + 512);
                const bf16x8 vf = (bf16x8){lo[0], lo[1], lo[2], lo[3], hh[0], hh[1], hh[2], hh[3]};
                o[d0] = __builtin_amdgcn_mfma_f32_32x32x16_bf16(vf, pw[ks], o[d0], 0, 0, 0);
            }
        asm volatile("s_waitcnt lgkmcnt(0)" ::: "memory");
    }
#undef DIL_LOAD
}
__device__ __forceinline__ void wave_tile_g0(const Tensors& X, float* lse0, int b, int h, int P0, LAS unsigned char* vst, const LAS float* bl, int lane) {
    const size_t rowb = (size_t)b * SEQ;
    f32x16 o[2];
#pragma unroll
    for (int d0 = 0; d0 < 2; ++d0)
#pragma unroll
        for (int rr = 0; rr < 16; ++rr) o[d0][rr] = 0.f;
    float m = -1e30f, l = 0.f;
    group<0, 1>(X, rowb, h, P0, 0, vst, bl, lane, o, m, l);
    { auto sw = __builtin_amdgcn_permlane32_swap(__float_as_uint(l), __float_as_uint(l), false, false); l = __uint_as_float(sw[0]) + __uint_as_float(sw[1]); }
    const float inv = 1.f / l; const int i = lane & 31, hi = lane >> 5;
    bf16* yrow = X.yb + (rowb + P0 + i) * 256 + h * 64 + 4 * hi;
#pragma unroll
    for (int d0 = 0; d0 < 2; ++d0)
#pragma unroll
        for (int r4 = 0; r4 < 4; ++r4) { v2u w; w.x = pk2(o[d0][4 * r4] * inv, o[d0][4 * r4 + 1] * inv); w.y = pk2(o[d0][4 * r4 + 2] * inv, o[d0][4 * r4 + 3] * inv); *(v2u*)(yrow + 32 * d0 + 8 * r4) = w; }
    if (hi == 0) lse0[(rowb + P0 + i) * 4 + h] = m + __builtin_amdgcn_logf(l);
}
__device__ __forceinline__ void wave_tile(const Tensors& X, const float* lse0, int b, int h, int P0, int r, LAS unsigned char* vst, const LAS float* bl, int lane) {
    const size_t rowb = (size_t)b * SEQ;
    f32x16 o[2];
#pragma unroll
    for (int d0 = 0; d0 < 2; ++d0)
#pragma unroll
        for (int rr = 0; rr < 16; ++rr) o[d0][rr] = 0.f;
    float m = -1e30f, l = 0.f;
    group<1, 16>(X, rowb, h, P0, r, vst, bl + BT, lane, o, m, l);
    group<2, 16>(X, rowb, h, P0, r, vst, bl + 2 * BT, lane, o, m, l);
    { auto sw = __builtin_amdgcn_permlane32_swap(__float_as_uint(l), __float_as_uint(l), false, false); l = __uint_as_float(sw[0]) + __uint_as_float(sw[1]); }
    const int i = lane & 31, hi = lane >> 5;
    const float w0 = __builtin_amdgcn_exp2f(lse0[(rowb + P0 + r + 16 * i) * 4 + h] - m);
    const float inv = 1.f / (l + w0);
    bf16* yrow = X.yb + (rowb + P0 + r + 16 * i) * 256 + h * 64 + 4 * hi;
#pragma unroll
    for (int d0 = 0; d0 < 2; ++d0)
#pragma unroll
        for (int r4 = 0; r4 < 4; ++r4) { const v2u g0 = *(const v2u*)(yrow + 32 * d0 + 8 * r4);
            v2u w; w.x = pk2((o[d0][4 * r4] + w0 * bf_lo(g0.x)) * inv, (o[d0][4 * r4 + 1] + w0 * bf_hi(g0.x)) * inv); w.y = pk2((o[d0][4 * r4 + 2] + w0 * bf_lo(g0.y)) * inv, (o[d0][4 * r4 + 3] + w0 * bf_hi(g0.y)) * inv);
            *(v2u*)(yrow + 32 * d0 + 8 * r4) = w; }
}
}
__device__ __forceinline__ void p0_transpose_item(const float* W, int K, int N, bf16* WT, LAS float* scr, int item, int lane) {
    const int nblk = N / 32, kb = item / nblk, nb = item % nblk, k0 = 64 * kb, n0 = 32 * nb;
#pragma unroll 8
    for (int i = 0; i < 32; ++i) { const int kk = 2 * i + (lane >> 5); scr[kk * 33 + (lane & 31)] = W[(size_t)(k0 + kk) * N + n0 + (lane & 31)]; }
    LDS_WAIT(); asm volatile("" ::: "memory");
    const int c = lane & 7;
#pragma unroll
    for (int j = 0; j < 4; ++j) { const int n = (lane >> 3) + 8 * j; const LAS float* s = scr + (8 * c) * 33 + n;
        v4u o; o.x = pk2(s[0 * 33], s[1 * 33]); o.y = pk2(s[2 * 33], s[3 * 33]); o.z = pk2(s[4 * 33], s[5 * 33]); o.w = pk2(s[6 * 33], s[7 * 33]);
        *(v4u*)(WT + (size_t)(n0 + n) * K + k0 + 8 * c) = o; }
    LDS_WAIT(); asm volatile("" ::: "memory");
}
__device__ __forceinline__ void cast_bf16(const float* src, bf16* dst, size_t n8, size_t gtid, size_t gthreads) {
    for (size_t i = gtid; i < n8; i += gthreads) { const f32x4 a = *(const f32x4*)(src + i * 8), b = *(const f32x4*)(src + i * 8 + 4);
        v4u o; o.x = pk2(a[0], a[1]); o.y = pk2(a[2], a[3]); o.z = pk2(b[0], b[1]); o.w = pk2(b[2], b[3]); *(v4u*)(dst + i * 8) = o; }
}

struct Args { const float* in[16]; float* out; unsigned char* ws; int ph_lo, ph_hi; };
enum { I_X = 0, I_WIN, I_DLAM, I_SUBG, I_WBD, I_WBL, I_WO, I_LN1G, I_LN1B, I_PWQ, I_PKEYS, I_PU, I_PV, I_LN2G, I_LN2B, I_RELB };

__device__ __forceinline__ void p0_prologue(const Args& A, LAS unsigned char* lds, int vcu, int G, int wave, int lane) {
    unsigned char* ws = A.ws;
    const int gw = vcu * NWAVES + wave, NGW = G * NWAVES;
    const size_t gtid = (size_t)gw * 64 + lane, gthreads = (size_t)NGW * 64;
    LAS float* scr = (LAS float*)(lds + wave * 16384);
    constexpr int I_IN = (D / 64) * (INC / 32), I_BD = (512 / 64) * (D / 32), I_BL = (256 / 64) * (D / 32), I_O = (D / 64) * (D / 32);
    for (int it0 = gw; it0 < (I_IN + I_BD + I_BL + I_O) * NREP(32); it0 += NGW) {
        int r = it0 % (I_IN + I_BD + I_BL + I_O);
        if (r < I_IN) { p0_transpose_item(A.in[I_WIN], D, INC, (bf16*)(ws + WS_WIN), scr, r, lane); continue; } r -= I_IN;
        if (r < I_BD) { p0_transpose_item(A.in[I_WBD], 512, D, (bf16*)(ws + WS_WBD), scr, r, lane); continue; } r -= I_BD;
        if (r < I_BL) { p0_transpose_item(A.in[I_WBL], 256, D, (bf16*)(ws + WS_WBL), scr, r, lane); continue; } r -= I_BL;
        p0_transpose_item(A.in[I_WO], D, D, (bf16*)(ws + WS_WO), scr, r, lane);
    }
    for (int rep_ = 0; rep_ < NREP(31); ++rep_) cast_bf16(A.in[I_X], (bf16*)(ws + WS_A), (size_t)T * D / 8, gtid, gthreads);
    { const float* wq = A.in[I_PWQ]; const float* keys = A.in[I_PKEYS]; bf16* wp = (bf16*)(ws + WS_WP);
      for (int it0 = gw; it0 < 1024 * NREP(30); it0 += NGW) { const int it = it0 & 1023;
          const int hc = it >> 6, jb = (it >> 2) & 15, nq = it & 3, j = jb * 64 + lane;
          const f32x4* wr_ = (const f32x4*)(wq + (size_t)j * 2048 + hc * 128);
          f32x4 w[32];
#pragma unroll
          for (int d = 0; d < 32; ++d) w[d] = wr_[d];
#pragma unroll 1
          for (int n = nq * 32; n < nq * 32 + 32; ++n) {
              const f32x4* kr = (const f32x4*)(keys + (size_t)(hc * 128 + n) * 128);
              float a0 = 0.f, a1 = 0.f, a2 = 0.f, a3 = 0.f;
#pragma unroll
              for (int d = 0; d < 32; ++d) { const f32x4 k = kr[d]; a0 += w[d][0] * k[0]; a1 += w[d][1] * k[1]; a2 += w[d][2] * k[2]; a3 += w[d][3] * k[3]; }
              wp[(size_t)(hc * 128 + n) * 1024 + j] = (bf16)f2bf((a0 + a1) + (a2 + a3));
          }
      } }
    { const float* relb = A.in[I_RELB]; float* bd = (float*)(ws + WS_BIASD); float* bl = (float*)(ws + WS_BIASL);
      for (size_t i = gtid; i < 4 * BIAS_TAB; i += gthreads) { const int h = (int)(i / BIAS_TAB), dist = (int)(i % BIAS_TAB) - BIAS_GUARD; bd[i] = dist < 0 ? 0.f : relb[rel_bucket(dist) * 16 + h] * LOG2E; }
      for (size_t i = gtid; i < 12 * 132; i += gthreads) { const int gh = (int)(i / 132), j = (int)(i % 132), g = gh >> 2; const int dl = (g == 0) ? 1 : (g == 1) ? 4 : 16;
          bl[i] = relb[rel_bucket((j > 128 ? 128 : j) * dl) * 16 + 4 + gh] * LOG2E; } }
}

__device__ __forceinline__ void p5_ln1(const Args& A, int vcu, int G, int wave, int lane) {
    unsigned char* ws = A.ws;
    const int gw = vcu * NWAVES + wave, NGW = G * NWAVES;
    const float* R = (const float*)(ws + WS_R); bf16* x1b = (bf16*)(ws + WS_A);
    const float* gam = A.in[I_LN1G]; const float* bet = A.in[I_LN1B];
    f32x4 gv[4], bv[4];
#pragma unroll
    for (int j = 0; j < 4; ++j) { gv[j] = *(const f32x4*)(gam + 256 * j + 4 * lane); bv[j] = *(const f32x4*)(bet + 256 * j + 4 * lane); }
    for (int mrow = gw; mrow < T; mrow += NGW) {
        const f32x4* xr = (const f32x4*)(R + (size_t)mrow * D) + lane;
        f32x4 v[4]; float s = 0.f;
#pragma unroll
        for (int j = 0; j < 4; ++j) { v[j] = xr[64 * j]; s += (v[j][0] + v[j][1]) + (v[j][2] + v[j][3]); }
        const float mean = wave_sum(s) * (1.f / D); float s2 = 0.f;
#pragma unroll
        for (int j = 0; j < 4; ++j) { v[j] = v[j] - mean; s2 += (v[j][0] * v[j][0] + v[j][1] * v[j][1]) + (v[j][2] * v[j][2] + v[j][3] * v[j][3]); }
        const float rstd = __builtin_amdgcn_rsqf(wave_sum(s2) * (1.f / D) + LN_EPS);
        f32x4* orow = (f32x4*)(A.out + (size_t)mrow * D) + lane; v2u* brow = (v2u*)(x1b + (size_t)mrow * D) + lane;
#pragma unroll
        for (int j = 0; j < 4; ++j) { const f32x4 y = v[j] * rstd * gv[j] + bv[j]; orow[64 * j] = y; v2u w; w.x = pk2(y[0], y[1]); w.y = pk2(y[2], y[3]); brow[64 * j] = w; }
    }
}
namespace peer {
__device__ __forceinline__ int mono(float v) { const int b = __float_as_int(v); return b ^ ((b >> 31) & 0x7fffffff); }
__device__ __forceinline__ float unmono(int k) { return __int_as_float(k ^ ((k >> 31) & 0x7fffffff)); }
__device__ __forceinline__ int med3i(int a, int b, int c) { int r; asm("v_med3_i32 %0, %1, %2, %3" : "=v"(r) : "v"(a), "v"(b), "v"(c)); return r; }
#define PEER_INS16(a, x) do { _Pragma("unroll") for (int k_ = 15; k_ >= 1; --k_) a[k_] = med3i(a[k_ - 1], a[k_], (x)); a[0] = max(a[0], (x)); } while (0)
__device__ __forceinline__ unsigned byte_sel(const unsigned (&p)[4], int i) { const int w = i >> 2; const unsigned x = (w == 0) ? p[0] : (w == 1) ? p[1] : (w == 2) ? p[2] : p[3]; return (x >> ((i & 3) * 8)) & 0xffu; }
__device__ __forceinline__ float gelu_erf(float v) { return 0.5f * v * (1.f + erff(v * 0.7071067811865476f)); }

__device__ __forceinline__ void select(const float* ST, v2u* sel, int tok, int head) {
    int a0[16], a1[16];
#pragma unroll
    for (int k = 0; k < 16; ++k) { a0[k] = (int)0x80000000; a1[k] = (int)0x80000000; }
    const float* s0 = ST + (size_t)(head * 256) * T + tok; const float* s1 = s0 + (size_t)128 * T;
#pragma unroll 8
    for (int n = 0; n < 128; ++n) { const int k = (mono(s0[(size_t)n * T]) & ~127) | (127 - n); PEER_INS16(a0, k); }
#pragma unroll 8
    for (int n = 0; n < 128; ++n) { const int k = (mono(s1[(size_t)n * T]) & ~127) | (127 - n); PEER_INS16(a1, k); }
    float v0[16], v1[16]; unsigned i0p[4] = {0u, 0u, 0u, 0u}, i1p[4] = {0u, 0u, 0u, 0u};
#pragma unroll
    for (int k = 0; k < 16; ++k) { v0[k] = unmono((a0[k] & ~127) | 64); v1[k] = unmono((a1[k] & ~127) | 64);
        i0p[k >> 2] |= (unsigned)(127 - (a0[k] & 127)) << (8 * (k & 3)); i1p[k >> 2] |= (unsigned)(127 - (a1[k] & 127)) << (8 * (k & 3)); }
    int cd[16];
#pragma unroll
    for (int k = 0; k < 16; ++k) cd[k] = (int)0x80000000;
#pragma unroll
    for (int i = 0; i < 16; ++i)
#pragma unroll
        for (int j = 0; j < 16; ++j)
            if ((i + 1) * (j + 1) <= 16) { const int k = (mono(v0[i] + v1[j]) & ~255) | (255 - (i * 16 + j)); PEER_INS16(cd, k); }
    float sv[16], ex[16], sum = 0.f; unsigned eid[16];
#pragma unroll
    for (int k = 0; k < 16; ++k) { const int code = 255 - (cd[k] & 255); eid[k] = byte_sel(i0p, code >> 4) * 128u + byte_sel(i1p, code & 15); sv[k] = unmono((cd[k] & ~255) | 128); }
#pragma unroll
    for (int k = 0; k < 16; ++k) { ex[k] = __expf(sv[k] - sv[0]); sum += ex[k]; }
    const float rs = 1.f / sum;
    v4u* dst = (v4u*)(sel + ((size_t)tok * 8 + head) * 16);
#pragma unroll
    for (int k = 0; k < 8; ++k) { v4u w; w.x = eid[2 * k]; w.y = __float_as_uint(ex[2 * k] * rs); w.z = eid[2 * k + 1]; w.w = __float_as_uint(ex[2 * k + 1] * rs); dst[k] = w; }
}

typedef float f32x2v __attribute__((ext_vector_type(2)));
__device__ __forceinline__ void gather_token(const v2u* sel, const unsigned char* U8, const unsigned char* V8, const float* isu, const float* isv, float* xo, const float* gam, const float* bet, int tok, int lane) {
    float* xrow = xo + (size_t)tok * D + 16 * lane;
    f32x4 xv[4];
#pragma unroll
    for (int q = 0; q < 4; ++q) xv[q] = *(const f32x4*)(xrow + 4 * q);
    float acc[16];
#pragma unroll
    for (int k = 0; k < 16; ++k) acc[k] = 0.f;
    for (int head = 0; head < 8; ++head) {
        const v2u se = sel[((size_t)tok * 8 + head) * 16 + (lane & 15)];
        const unsigned eq = (unsigned)__shfl((int)se.x, lane >> 2);
        const float su = isu[eq], sv = isv[eq];
        float part[16];
        {
            v4u uu[16];
#pragma unroll
            for (int k = 0; k < 16; ++k) { const unsigned e = __builtin_amdgcn_readlane(se.x, k); uu[k] = *(const v4u*)(U8 + (size_t)e * D + 16 * lane); }
#pragma unroll
            for (int k = 0; k < 16; ++k) { float d0 = 0.f, d1 = 0.f;
#pragma unroll
                for (int q = 0; q < 4; ++q) { const unsigned w = uu[k][q]; const f32x2v a = __builtin_amdgcn_cvt_pk_f32_fp8((int)w, false), b = __builtin_amdgcn_cvt_pk_f32_fp8((int)w, true);
                    d0 += xv[q][0] * a[0]; d1 += xv[q][1] * a[1]; d0 += xv[q][2] * b[0]; d1 += xv[q][3] * b[1]; }
                part[k] = d0 + d1; }
        }
#ifdef PROBE_L2
        {
            v4u du[16], dv[16];
#pragma unroll
            for (int k = 0; k < 16; ++k) { const unsigned e = __builtin_amdgcn_readlane(se.x, k) & PROBE_L2; du[k] = *(const v4u*)(U8 + (size_t)e * D + 16 * lane); dv[k] = *(const v4u*)(V8 + (size_t)e * D + 16 * lane); }
#pragma unroll
            for (int k = 0; k < 16; ++k) asm volatile("" :: "v"(du[k]), "v"(dv[k]));
        }
#endif
        float r8[8], r4[4], r2[2], r1;
#pragma unroll
        for (int i = 0; i < 8; ++i) { const bool up = (lane & 32) != 0; const float send = up ? part[i] : part[i + 8], keep = up ? part[i + 8] : part[i]; r8[i] = keep + __shfl_xor(send, 32); }
#pragma unroll
        for (int i = 0; i < 4; ++i) { const bool up = (lane & 16) != 0; const float send = up ? r8[i] : r8[i + 4], keep = up ? r8[i + 4] : r8[i]; r4[i] = keep + __shfl_xor(send, 16); }
#pragma unroll
        for (int i = 0; i < 2; ++i) { const bool up = (lane & 8) != 0; const float send = up ? r4[i] : r4[i + 2], keep = up ? r4[i + 2] : r4[i]; r2[i] = keep + __shfl_xor(send, 8); }
        { const bool up = (lane & 4) != 0; const float send = up ? r2[0] : r2[1], keep = up ? r2[1] : r2[0]; r1 = keep + __shfl_xor(send, 4); }
        r1 += __shfl_xor(r1, 2); r1 += __shfl_xor(r1, 1);
        const float gq = __uint_as_float((unsigned)__shfl((int)se.y, lane >> 2));
        const float wgt = gq * gelu_erf(r1 * su) * sv;
        {
            v4u vv[16];
#pragma unroll
            for (int k = 0; k < 16; ++k) { const unsigned e = __builtin_amdgcn_readlane(se.x, k); vv[k] = *(const v4u*)(V8 + (size_t)e * D + 16 * lane); }
#pragma unroll
            for (int k = 0; k < 16; ++k) { const float w = __uint_as_float(__builtin_amdgcn_readlane(__float_as_uint(wgt), 4 * k));
#pragma unroll
                for (int q = 0; q < 4; ++q) { const unsigned x = vv[k][q]; const f32x2v a = __builtin_amdgcn_cvt_pk_f32_fp8((int)x, false), b = __builtin_amdgcn_cvt_pk_f32_fp8((int)x, true);
                    acc[4 * q] += w * a[0]; acc[4 * q + 1] += w * a[1]; acc[4 * q + 2] += w * b[0]; acc[4 * q + 3] += w * b[1]; } }
        }
    }
    float rr[16], s = 0.f;
#pragma unroll
    for (int k = 0; k < 16; ++k) { rr[k] = ALPHA * xv[k >> 2][k & 3] + acc[k]; s += rr[k]; }
    const float mean = wave_sum(s) * (1.f / D); float s2 = 0.f;
#pragma unroll
    for (int k = 0; k < 16; ++k) { rr[k] -= mean; s2 += rr[k] * rr[k]; }
    const float rstd = __builtin_amdgcn_rsqf(wave_sum(s2) * (1.f / D) + LN_EPS);
#pragma unroll
    for (int q = 0; q < 4; ++q) { const f32x4 g = *(const f32x4*)(gam + 16 * lane + 4 * q), bb = *(const f32x4*)(bet + 16 * lane + 4 * q);
        f32x4 y; y[0] = rr[4 * q] * rstd * g[0] + bb[0]; y[1] = rr[4 * q + 1] * rstd * g[1] + bb[1]; y[2] = rr[4 * q + 2] * rstd * g[2] + bb[2]; y[3] = rr[4 * q + 3] * rstd * g[3] + bb[3];
        *(f32x4*)(xrow + 4 * q) = y; }
}
typedef float f32x2w __attribute__((ext_vector_type(2)));
struct G4 { const unsigned char* U8; const unsigned char* V8; const float* isu; const float* isv; };
__device__ __forceinline__ v2u peer_ec(const v2u lo, const v2u hi, int c) { const unsigned mk = (c < 4) ? 0xffffffffu : 0u; v2u r; r.x = (lo.x & mk) | (hi.x & ~mk); r.y = (lo.y & mk) | (hi.y & ~mk); return r; }
#define PEER_EC(en, c) peer_ec((en)[0], (en)[1], (c))
__device__ __forceinline__ void a_load(v4u (&uu)[16], const v2u ec, int c, const unsigned char* U8, int lane) {
#pragma unroll
    for (int j = 0; j < 16; ++j) { const unsigned e = __builtin_amdgcn_readlane(ec.x, 16 * (c & 3) + j); uu[j] = *(const v4u*)(U8 + (size_t)e * D + 16 * lane); }
}
__device__ __forceinline__ void a_step(const v4u (&uu)[16], v2u (&en)[2], int c, const LAS f32x4* xl, const G4& T, int lane) {
    const v2u ec = PEER_EC(en, c);
    const int ls = 16 * (c & 3) + (lane >> 2);
    const unsigned eq = (unsigned)__shfl((int)ec.x, ls); const float gq = __uint_as_float((unsigned)__shfl((int)ec.y, ls));
    const float su = T.isu[eq], sv = T.isv[eq];
    f32x4 xv[4];
#pragma unroll
    for (int q = 0; q < 4; ++q) xv[q] = xl[q * 64];
    float part[16];
#pragma unroll
    for (int j = 0; j < 16; ++j) { f32x2w d = {0.f, 0.f};
#pragma unroll
        for (int q = 0; q < 4; ++q) { const unsigned w = uu[j][q]; const f32x2w a = __builtin_amdgcn_cvt_pk_f32_fp8((int)w, false), b = __builtin_amdgcn_cvt_pk_f32_fp8((int)w, true);
            d += (f32x2w){xv[q][0], xv[q][1]} * a; d += (f32x2w){xv[q][2], xv[q][3]} * b; }
        part[j] = d[0] + d[1]; }
    float r8[8], r4[4], r2[2], r1;
#pragma unroll
    for (int i = 0; i < 8; ++i) { const bool up = (lane & 32) != 0; const float send = up ? part[i] : part[i + 8], keep = up ? part[i + 8] : part[i]; r8[i] = keep + __shfl_xor(send, 32); }
#pragma unroll
    for (int i = 0; i < 4; ++i) { const bool up = (lane & 16) != 0; const float send = up ? r8[i] : r8[i + 4], keep = up ? r8[i + 4] : r8[i]; r4[i] = keep + __shfl_xor(send, 16); }
#pragma unroll
    for (int i = 0; i < 2; ++i) { const bool up = (lane & 8) != 0; const float send = up ? r4[i] : r4[i + 2], keep = up ? r4[i + 2] : r4[i]; r2[i] = keep + __shfl_xor(send, 8); }
    { const bool up = (lane & 4) != 0; const float send = up ? r2[0] : r2[1], keep = up ? r2[1] : r2[0]; r1 = keep + __shfl_xor(send, 4); }
    r1 += __shfl_xor(r1, 2); r1 += __shfl_xor(r1, 1);
    const float wgt = gq * gelu_erf(r1 * su) * sv;
    const int rel = lane - 16 * (c & 3);
    const float wv = __shfl(wgt, 4 * (rel & 15));
    const bool mine = (rel >= 0) && (rel < 16);
    const bool lo_ = mine && (c < 4), hi_ = mine && (c >= 4);
    en[0].y = lo_ ? __float_as_uint(wv) : en[0].y; en[1].y = hi_ ? __float_as_uint(wv) : en[1].y;
}
__device__ __forceinline__ void b_load(v4u (&vv)[8], const v2u ec, int c, int h8, const unsigned char* V8, int lane) {
#pragma unroll
    for (int j = 0; j < 8; ++j) { const unsigned e = __builtin_amdgcn_readlane(ec.x, 16 * (c & 3) + 8 * h8 + j); vv[j] = *(const v4u*)(V8 + (size_t)e * D + 16 * lane); }
}
__device__ __forceinline__ void b_step(const v4u (&vv)[8], const v2u ec, int c, int h8, f32x2w (&acc)[8]) {
#pragma unroll
    for (int j = 0; j < 8; ++j) { const float w = __uint_as_float(__builtin_amdgcn_readlane(ec.y, 16 * (c & 3) + 8 * h8 + j)); const f32x2w w2 = {w, w};
#pragma unroll
        for (int q = 0; q < 4; ++q) { const unsigned x = vv[j][q]; const f32x2w a = __builtin_amdgcn_cvt_pk_f32_fp8((int)x, false), b = __builtin_amdgcn_cvt_pk_f32_fp8((int)x, true);
            acc[2 * q] += w2 * a; acc[2 * q + 1] += w2 * b; } }
}
__device__ __forceinline__ void tok_finish(const LAS f32x4* xl, const f32x2w (&acc)[8], float* xrow, const float* gam, const float* bet, int lane) {
    float rr[16], s = 0.f;
#pragma unroll
    for (int q = 0; q < 4; ++q) { const f32x4 xv = xl[q * 64];
#pragma unroll
        for (int e = 0; e < 4; ++e) { const int k = 4 * q + e; rr[k] = ALPHA * xv[e] + acc[k >> 1][k & 1]; s += rr[k]; } }
    const float mean = wave_sum(s) * (1.f / D); float s2 = 0.f;
#pragma unroll
    for (int k = 0; k < 16; ++k) { rr[k] -= mean; s2 += rr[k] * rr[k]; }
    const float rstd = __builtin_amdgcn_rsqf(wave_sum(s2) * (1.f / D) + LN_EPS);
#pragma unroll
    for (int q = 0; q < 4; ++q) { const f32x4 g = *(const f32x4*)(gam + 16 * lane + 4 * q), bb = *(const f32x4*)(bet + 16 * lane + 4 * q);
        f32x4 y; y[0] = rr[4 * q] * rstd * g[0] + bb[0]; y[1] = rr[4 * q + 1] * rstd * g[1] + bb[1]; y[2] = rr[4 * q + 2] * rstd * g[2] + bb[2]; y[3] = rr[4 * q + 3] * rstd * g[3] + bb[3];
        *(f32x4*)(xrow + 4 * q) = y; }
}
__device__ __forceinline__ void gather4(const v2u* sel, const G4& T, float* xo, const float* gam, const float* bet, int tok0, int lane, LAS f32x4* xl, LAS v2u* srt) {
    v2u en[4][2];
#pragma unroll
    for (int tt = 0; tt < 4; ++tt) { const float* xrow = xo + (size_t)(tok0 + tt) * D + 16 * lane;
#pragma unroll
        for (int q = 0; q < 4; ++q) xl[tt * 256 + q * 64] = *(const f32x4*)(xrow + 4 * q);
        const v2u e0 = sel[(size_t)(tok0 + tt) * 128 + lane], e1 = sel[(size_t)(tok0 + tt) * 128 + 64 + lane];
        const unsigned b0 = e0.x >> 11, b1 = e1.x >> 11; unsigned d0 = 0u, d1 = 0u, base = 0u;
#pragma unroll
        for (unsigned k = 0; k < 8; ++k) { const unsigned long long m0 = __ballot(b0 == k), m1 = __ballot(b1 == k);
            const unsigned c0 = (unsigned)__builtin_popcountll(m0), c1 = (unsigned)__builtin_popcountll(m1);
            const unsigned p0 = __builtin_amdgcn_mbcnt_hi((unsigned)(m0 >> 32), __builtin_amdgcn_mbcnt_lo((unsigned)m0, 0u)), p1 = __builtin_amdgcn_mbcnt_hi((unsigned)(m1 >> 32), __builtin_amdgcn_mbcnt_lo((unsigned)m1, 0u));
            d0 = (b0 == k) ? base + p0 : d0; d1 = (b1 == k) ? base + c0 + p1 : d1; base += c0 + c1; }
        srt[d0] = e0; srt[d1] = e1;
        asm volatile("s_waitcnt lgkmcnt(0)" ::: "memory");
        en[tt][0] = srt[lane]; en[tt][1] = srt[64 + lane];
        asm volatile("s_waitcnt lgkmcnt(0)" ::: "memory");
    }
#ifndef PEER_NO_A
    {
#pragma unroll 1
        for (int c = 0; c < 8; ++c) {
#pragma unroll
            for (int tt = 0; tt < 4; ++tt) { v4u ua[16]; a_load(ua, PEER_EC(en[tt], c), c, T.U8, lane); a_step(ua, en[tt], c, xl + tt * 256, T, lane); __builtin_amdgcn_sched_barrier(0); }
        }
    }
#endif
    f32x2w acc[4][8];
#pragma unroll
    for (int tt = 0; tt < 4; ++tt)
#pragma unroll
        for (int q = 0; q < 8; ++q) acc[tt][q] = (f32x2w){0.f, 0.f};
#ifndef PEER_NO_B
    {
#pragma unroll 1
        for (int c = 0; c < 8; ++c) {
#pragma unroll
            for (int tt = 0; tt < 4; ++tt) {
#pragma unroll
                for (int h8 = 0; h8 < 2; ++h8) { v4u va[8]; const v2u ec = PEER_EC(en[tt], c); b_load(va, ec, c, h8, T.V8, lane); b_step(va, ec, c, h8, acc[tt]); __builtin_amdgcn_sched_barrier(0); }
            }
        }
    }
#endif
#pragma unroll
    for (int tt = 0; tt < 4; ++tt) tok_finish(xl + tt * 256, acc[tt], xo + (size_t)(tok0 + tt) * D + 16 * lane, gam, bet, lane);
}
#undef PEER_EC
__device__ __forceinline__ void row_to_fp8(const float* src, unsigned char* dst, float* inv, int row, int lane) {
    const float* p = src + (size_t)row * D + 16 * lane;
    f32x4 v[4]; float am = 0.f;
#pragma unroll
    for (int q = 0; q < 4; ++q) { v[q] = *(const f32x4*)(p + 4 * q); am = fmaxf(am, fmaxf(fmaxf(fabsf(v[q][0]), fabsf(v[q][1])), fmaxf(fabsf(v[q][2]), fabsf(v[q][3])))); }
    am = wave_max(am);
    float s = 1.f, is = 1.f;
    if (am > 1e-30f) { const int eb = (__float_as_int(224.f / am) >> 23) & 0xff; if (eb > 0 && eb < 254) { s = __int_as_float(eb << 23); is = __int_as_float((254 - eb) << 23); } }
    v4u o;
#pragma unroll
    for (int q = 0; q < 4; ++q) { int w = 0; w = __builtin_amdgcn_cvt_pk_fp8_f32(v[q][0] * s, v[q][1] * s, w, false); w = __builtin_amdgcn_cvt_pk_fp8_f32(v[q][2] * s, v[q][3] * s, w, true); o[q] = (unsigned)w; }
    *(v4u*)(dst + (size_t)row * D + 16 * lane) = o;
    if (lane == 0) inv[row] = is;
}
}
constexpr int NPH = 8;
__global__ void __launch_bounds__(NWAVES * 64, 2) mk_fwd(Args args) {
    extern __shared__ __attribute__((aligned(16))) unsigned char lds_raw[];
    LAS unsigned char* lds = (LAS unsigned char*)lds_raw;
    volatile LAS unsigned* MISC = (volatile LAS unsigned*)(lds + MISC_OFF);
    const int tid0 = threadIdx.x, lane0 = tid0 & 63, wave = __builtin_amdgcn_readfirstlane(tid0 >> 6);
    const int G = gridDim.x, bx = blockIdx.x, vcu = (G % 8 == 0) ? (bx % 8) * (G / 8) + bx / 8 : bx;
    unsigned char* ws0 = args.ws;
    gu32* ctl = (gu32*)(ws0 + WS_CTL);
    for (int u = tid0; u < (LDS_BYTES - RING_BYTES) / 4; u += NWAVES * 64) ((LAS unsigned*)(lds + RING_BYTES))[u] = 0u;
    __syncthreads();
    XcdBarrier bar; bar.bar = (unsigned*)(ctl + CW_BAR); bar.x = 0; bar.st = nullptr;
    if (MK_N_LAUNCHES == 1) bar = xcd_barrier_post((unsigned*)(ctl + CW_BAR), MISC + 8);
    const int lo = args.ph_lo, hi = args.ph_hi;
#ifndef PH_MASK
#define PH_MASK 0xFF
#endif
#define IN(k) ((((PH_MASK) >> (k)) & 1) && lo <= (k) && (k) < hi)
#define SEAM(k) do { if (IN(k) && IN((k) + 1)) xcd_barrier(bar); } while (0)
    const int NGW = G * NWAVES;
#define SUB_BEGIN() unsigned char* ws = ws0; asm volatile("" : "+s"(ws)); const int lane = (int)__builtin_amdgcn_mbcnt_hi(~0u, __builtin_amdgcn_mbcnt_lo(~0u, 0u)), tid = wave * 64 + lane; (void)tid; (void)lane
#define PHASE_BEGIN() unsigned char* ws = ws0; asm volatile("" : "+s"(ws)); const int lane = (int)__builtin_amdgcn_mbcnt_hi(~0u, __builtin_amdgcn_mbcnt_lo(~0u, 0u)), tid = wave * 64 + lane; const int gw = vcu * NWAVES + wave; (void)gw; (void)lane; (void)tid

    if (IN(0)) { PHASE_BEGIN(); p0_prologue(args, lds, vcu, G, wave, lane); VM_WAIT(); __syncthreads(); SEAM(0); }

#if defined(MICRO)
    {
        f32x16 a0 = {0.f,0.f,0.f,0.f,0.f,0.f,0.f,0.f,0.f,0.f,0.f,0.f,0.f,0.f,0.f,0.f}, a1 = a0; bf16x8 fa = {1,2,3,4,5,6,7,8}, fb = {8,7,6,5,4,3,2,1};
        float e[8]; for (int i = 0; i < 8; ++i) e[i] = 0.001f * (float)(lane0 + i);
        asm volatile("" : "+v"(fa), "+v"(fb));
        for (int it = 0; it < 512; ++it) {
#pragma unroll
            for (int j = 0; j < 8; ++j) {
                if (MICRO == 1 || MICRO == 3 || MICRO == 4) { a0 = __builtin_amdgcn_mfma_f32_32x32x16_bf16(fa, fb, a0, 0, 0, 0); }
                if (MICRO == 2 || MICRO == 3) {
#pragma unroll
                    for (int i = 0; i < 8; ++i) e[i] = __builtin_amdgcn_exp2f(e[i]);
                }
                if (MICRO == 4) {
#pragma unroll
                    for (int i = 0; i < 4; ++i) e[i] = __builtin_amdgcn_exp2f(e[i]);
#pragma unroll
                    for (int i = 4; i < 8; ++i) { e[i] = e[i] * 1.0001f + 0.5f; e[i] = e[i] * 0.9999f - 0.5f; }
                }
                if (MICRO == 1 || MICRO == 3 || MICRO == 4) { a1 = __builtin_amdgcn_mfma_f32_32x32x16_bf16(fb, fa, a1, 0, 0, 0); }
                if (MICRO == 2 || MICRO == 3) {
#pragma unroll
                    for (int i = 0; i < 8; ++i) e[i] = __builtin_amdgcn_exp2f(e[i]);
                }
                if (MICRO == 4) {
#pragma unroll
                    for (int i = 0; i < 4; ++i) e[i] = __builtin_amdgcn_exp2f(e[i]);
#pragma unroll
                    for (int i = 4; i < 8; ++i) { e[i] = e[i] * 1.0001f + 0.5f; e[i] = e[i] * 0.9999f - 0.5f; }
                }
                __builtin_amdgcn_sched_barrier(0);
            }
        }
        asm volatile("" :: "v"(a0), "v"(a1), "v"(e[0]), "v"(e[1]), "v"(e[2]), "v"(e[3]), "v"(e[4]), "v"(e[5]), "v"(e[6]), "v"(e[7]));
    }
#endif

    if (IN(1)) { PHASE_BEGIN();
        pg8::Gemm g{(const pg8::bf16_t*)(ws + WS_A), (const pg8::bf16_t*)(ws + WS_WIN), T, INC, D}; pg8::StaticOrder S; S.init(T, INC, G, bx); S.rep = NREP(1);
        pg8::EpiInProj E{(pg8::bf16_t*)(ws + WS_QD), (pg8::bf16_t*)(ws + WS_KD), (pg8::bf16_t*)(ws + WS_VD), (pg8::bf16_t*)(ws + WS_LQ), (pg8::bf16_t*)(ws + WS_LK), (pg8::bf16_t*)(ws + WS_LV),
                         (pg8::bf16_t*)(ws + WS_GA), (pg8::bf16_t*)(ws + WS_GB)};
        pg8::gemm_phase<pg8::EpiInProj, pg8::StaticOrder, true, true>(lds, g, S, E);
        SEAM(1);
    }

    if (IN(2)) { PHASE_BEGIN();
#ifndef NO_DIFF
        {   SUB_BEGIN();
            const da::Tensors X{(const bf16*)(ws + WS_QD), (const bf16*)(ws + WS_KD), (const bf16*)(ws + WS_VD), (float*)(ws + WS_STASH), (bf16*)(ws + WS_YA),
                                args.in[I_DLAM], args.in[I_SUBG], args.in[I_RELB]};
            int cur_h = -1;
            float lam; { const float* dl = args.in[I_DLAM]; const float p1 = dl[lane] * dl[64 + lane], p2 = dl[128 + lane] * dl[192 + lane];
                lam = __uint_as_float(__builtin_amdgcn_readfirstlane(__float_as_uint(__expf(wave_sum(p1)) - __expf(wave_sum(p2)) + LAM_INIT))); }
            for (int rep_ = 0; rep_ < NREP(20); ++rep_)
            for (int p = vcu; p < 256; p += G) {
                const int bh = p >> 5, s = p & 31, b = bh >> 2, h = bh & 3;
                if (h != cur_h) {
                    __syncthreads();
                    const float* bd = (const float*)(ws + WS_BIASD) + h * BIAS_TAB; asm volatile("" : "+s"(bd));
                    for (int i = tid; i < BIAS_TAB; i += NWAVES * 64) ((LAS float*)(lds + da::LDS_BIAS))[i] = bd[i];
                    __syncthreads(); cur_h = h;
                }
                const float c31 = args.in[I_RELB][31 * 16 + h] * LOG2E;
                for (int k2 = 0; k2 < 2; ++k2) da::unit(X, b, h, k2 ? 63 - s : s, lds, bx, lam, c31);
            }
        }
#endif
#ifndef NO_DIL
        {   SUB_BEGIN();
            const dil::Tensors X{(const bf16*)(ws + WS_LQ), (const bf16*)(ws + WS_LK), (const bf16*)(ws + WS_LV), (bf16*)(ws + WS_YB)};
            int cur_h = -1;
            for (int rep_ = 0; rep_ < NREP(21); ++rep_)
            for (int u = vcu; u < 256; u += G) {
                const int bh = u >> 5, blk = u & 31, b = bh >> 2, h = bh & 3;
                if (h != cur_h) {
                    __syncthreads();
                    const float* blsrc = (const float*)(ws + WS_BIASL);
                    for (int i = tid; i < 3 * dil::BT; i += NWAVES * 64) { const int g = i / dil::BT, jj = i % dil::BT - dil::BT0;
                        ((LAS float*)(lds + dil::LDS_BL))[i] = (jj >= 0 && jj <= 128) ? blsrc[(g * 4 + h) * 132 + jj] : 0.f; }
                    __syncthreads(); cur_h = h;
                }
                float* lse0 = (float*)(ws + WS_LSE0);
                for (int k2 = 0; k2 < 2; ++k2) dil::wave_tile_g0(X, lse0, b, h, blk * 512 + (wave + 8 * k2) * 32, lds + dil::LDS_VST + wave * 4096, (const LAS float*)(lds + dil::LDS_BL), lane);
                VM_WAIT(); __syncthreads();
                for (int k2 = 0; k2 < 2; ++k2) dil::wave_tile(X, lse0, b, h, blk * 512, wave + 8 * k2, lds + dil::LDS_VST + wave * 4096, (const LAS float*)(lds + dil::LDS_BL), lane);
            }
            __syncthreads();
        }
#endif
        SEAM(2);
    }

    if (IN(3)) { PHASE_BEGIN();
        { pg8::Gemm g{(const pg8::bf16_t*)(ws + WS_YA), (const pg8::bf16_t*)(ws + WS_WBD), T, D, 512}; pg8::StaticOrder S; S.init(T, D, G, bx); S.rep = NREP(3);
          pg8::EpiGate1 E{(const pg8::bf16_t*)(ws + WS_GA), (pg8::bf16_t*)(ws + WS_GATED)};
          pg8::gemm_phase<pg8::EpiGate1, pg8::StaticOrder, true, true>(lds, g, S, E); }
        VM_WAIT(); __syncthreads();
        { pg8::Gemm g{(const pg8::bf16_t*)(ws + WS_YB), (const pg8::bf16_t*)(ws + WS_WBL), T, D, 256}; pg8::StaticOrder S; S.init(T, D, G, bx);
          pg8::EpiGate2 E{(const pg8::bf16_t*)(ws + WS_GB), (pg8::bf16_t*)(ws + WS_GATED)};
          pg8::gemm_phase<pg8::EpiGate2, pg8::StaticOrder, true, true>(lds, g, S, E); }
        SEAM(3);
    }

    if (IN(4)) { PHASE_BEGIN();
        pg8::Gemm g{(const pg8::bf16_t*)(ws + WS_GATED), (const pg8::bf16_t*)(ws + WS_WO), T, D, D}; pg8::StaticOrder S; S.init(T, D, G, bx); S.rep = NREP(4);
        pg8::EpiOut E{args.in[I_X], (float*)(ws + WS_R)};
        pg8::gemm_phase<pg8::EpiOut, pg8::StaticOrder, true, true>(lds, g, S, E);
        SEAM(4);
    }

    if (IN(5)) { PHASE_BEGIN();
        p5_ln1(args, vcu, G, wave, lane);
        for (int row = gw; row < 2 * NEXP; row += NGW) {
            if (row < NEXP) peer::row_to_fp8(args.in[I_PU], ws + WS_UU, (float*)(ws + WS_ISU), row, lane);
            else peer::row_to_fp8(args.in[I_PV], ws + WS_UV, (float*)(ws + WS_ISV), row - NEXP, lane);
        }
        SEAM(5);
    }

    if (IN(6)) { PHASE_BEGIN();
        pg8::Gemm g{(const pg8::bf16_t*)(ws + WS_WP), (const pg8::bf16_t*)(ws + WS_A), 2048, T, D}; pg8::StaticOrder S; S.init(2048, T, G, bx); S.rep = NREP(6);
        pg8::EpiScoreT E{(float*)(ws + WS_ST)};
        pg8::gemm_phase<pg8::EpiScoreT, pg8::StaticOrder, true, true>(lds, g, S, E);
        SEAM(6);
    }

    if (IN(7)) { PHASE_BEGIN();
        const float* ST = (const float*)(ws + WS_ST); v2u* sel = (v2u*)(ws + WS_SEL);
        for (int u = vcu; u < T / 128; u += G) {
#ifndef PEER_NO_SELECT
            for (int p = 0; p < 2; ++p) peer::select(ST, sel, u * 128 + p * 64 + lane, wave);
#endif
            VM_WAIT(); __syncthreads();
            { const peer::G4 TB{ws + WS_UU, ws + WS_UV, (const float*)(ws + WS_ISU), (const float*)(ws + WS_ISV)};
              for (int i = 0; i < 4; ++i) peer::gather4(sel, TB, args.out, args.in[I_LN2G], args.in[I_LN2B], u * 128 + i * 32 + wave * 4, lane, (LAS f32x4*)(lds + wave * 16384) + lane, (LAS v2u*)(lds + RING_BYTES + 2048 + wave * 1024)); }
            VM_WAIT(); __syncthreads();
        }
    }
#undef IN
#undef SEAM
}

extern "C" void kernel_launch(void* const* d_in, const int* in_sizes, int n_in, void* d_out, int out_size, void* d_ws, size_t ws_size, hipStream_t stream) {
    static int grid = 0;
    if (grid == 0) {
        if (n_in != 16 || in_sizes[0] != T * D || out_size != T * D || ws_size < WS_END) { fprintf(stderr, "kernel_launch: unexpected shapes (n_in %d, in0 %d, out %d, ws %zu); nothing launched\n", n_in, n_in > 0 ? in_sizes[0] : -1, out_size, ws_size); grid = -1; return; }
        int dev = 0, cus = 0, per_cu = 0;
        if (hipGetDevice(&dev) != hipSuccess || hipDeviceGetAttribute(&cus, hipDeviceAttributeMultiprocessorCount, dev) != hipSuccess) { grid = -1; return; }
        if (hipFuncSetAttribute((const void*)mk_fwd, hipFuncAttributeMaxDynamicSharedMemorySize, LDS_BYTES) != hipSuccess) { fprintf(stderr, "kernel_launch: hipFuncSetAttribute failed\n"); grid = -1; return; }
        if (hipOccupancyMaxActiveBlocksPerMultiprocessor(&per_cu, (const void*)mk_fwd, NWAVES * 64, LDS_BYTES) != hipSuccess || per_cu < 1) { fprintf(stderr, "kernel_launch: occupancy query reports %d\n", per_cu); per_cu = 1; }
        (void)hipGetLastError();
        grid = cus;
    }
    if (grid < 0) return;
    if (hipMemsetAsync((char*)d_ws + WS_CTL, 0, CTL_ZERO_BYTES, stream) != hipSuccess) return;
    Args a{};
    for (int i = 0; i < 16; ++i) a.in[i] = (const float*)d_in[i];
    a.out = (float*)d_out; a.ws = (unsigned char*)d_ws;
    for (int li = 0; li < MK_N_LAUNCHES; ++li) {
        a.ph_lo = (MK_N_LAUNCHES == 1) ? 0 : li; a.ph_hi = (MK_N_LAUNCHES == 1) ? NPH : li + 1;
        hipLaunchKernelGGL(mk_fwd, dim3(grid), dim3(NWAVES * 64), LDS_BYTES, stream, a);
    }
}
```

```cpp
#include <hip/hip_runtime.h>
#include <cstdio>
#include <cstdint>

#ifndef MK_N_LAUNCHES
#define MK_N_LAUNCHES 1
#endif

#ifndef REPEAT_PH
#define REPEAT_PH (-1)
#endif
#define NREP(k) ((REPEAT_PH) == (k) ? 2 : 1)

constexpr int BATCH = 2, SEQ = 16384, T = BATCH * SEQ, D = 1024, INC = 5888;
constexpr int OFF_DQ = 0, OFF_DK = 512, OFF_DV = 1024, OFF_LQ = 1536, OFF_LK = 2304, OFF_LV = 3072, OFF_GA = 3840, OFF_GB = 4864;
constexpr int NEXP = 16384;
constexpr float LOG2E = 1.4426950408889634f;
constexpr float QSCALE = 0.125f * LOG2E;
constexpr float ALPHA = 1.189207115002721f;
constexpr float LN_EPS = 1e-5f, SUBLN_EPS = 1e-5f;
constexpr float LAM_INIT = 0.2f;
constexpr int NTILE = SEQ / 64;
constexpr int BIAS_TAB = 2112, BIAS_GUARD = 256, DFAR = 1513;

constexpr size_t MiB = 1u << 20;
constexpr size_t WS_CTL = 0, CTL_ZERO_BYTES = 1 * MiB;
constexpr size_t WS_BIASD = 1 * MiB;
constexpr size_t WS_BIASL = 1 * MiB + 64 * 1024;
constexpr size_t WS_WIN = 8 * MiB, WS_WO = 20 * MiB, WS_WBD = 22 * MiB, WS_WBL = 23 * MiB, WS_WP = 24 * MiB;
constexpr size_t WS_A = 32 * MiB;
constexpr size_t WS_YA = WS_A, WS_YB = WS_A + 32 * MiB;
constexpr size_t WS_QD = 96 * MiB, WS_KD = 128 * MiB, WS_VD = 160 * MiB, WS_LQ = 192 * MiB, WS_LK = 240 * MiB, WS_LV = 288 * MiB, WS_GA = 336 * MiB, WS_GB = 400 * MiB;
constexpr size_t WS_STASH = 464 * MiB;
constexpr size_t WS_SEL = 352 * MiB;
constexpr size_t WS_GATED = 96 * MiB;
constexpr size_t WS_R = 160 * MiB;
constexpr size_t WS_ST = 96 * MiB;
constexpr size_t WS_UU = 480 * MiB, WS_UV = 496 * MiB;
constexpr size_t WS_LSE0 = 3 * MiB;
constexpr size_t WS_ISU = 2 * MiB, WS_ISV = 2 * MiB + 65536;
constexpr size_t WS_END = 512 * MiB;

constexpr int CW_BAR = 4096;
constexpr int NWAVES = 8;
constexpr int RING_BYTES = 131072, MISC_OFF = RING_BYTES + 320, LDS_BYTES = 147456;

#define GAS __attribute__((address_space(1)))
#define LAS __attribute__((address_space(3)))
typedef unsigned short bf16;
typedef unsigned v4u __attribute__((ext_vector_type(4)));
typedef unsigned v2u __attribute__((ext_vector_type(2)));
typedef float f32x4 __attribute__((ext_vector_type(4)));
typedef float f32x16 __attribute__((ext_vector_type(16)));
typedef short bf16x8 __attribute__((ext_vector_type(8)));
typedef short s16x4 __attribute__((ext_vector_type(4)));
typedef __bf16 bf16x2 __attribute__((ext_vector_type(2)));
typedef GAS unsigned gu32;
#define RLX_AGENT __ATOMIC_RELAXED, __HIP_MEMORY_SCOPE_AGENT
#define LDS_WAIT() asm volatile("s_waitcnt lgkmcnt(0)" ::: "memory")
#define VM_WAIT() asm volatile("s_waitcnt vmcnt(0)" ::: "memory")
__device__ __forceinline__ unsigned f2bf(float f) { unsigned u = __builtin_bit_cast(unsigned, f); return (u + 0x7fffu + ((u >> 16) & 1u)) >> 16; }
__device__ __forceinline__ unsigned pk2(float lo, float hi) { return f2bf(lo) | (f2bf(hi) << 16); }
typedef float f32x2_t __attribute__((ext_vector_type(2)));
__device__ __forceinline__ unsigned cvtpk(float lo, float hi) { f32x2_t v = {lo, hi}; bf16x2 b = __builtin_convertvector(v, bf16x2); return __builtin_bit_cast(unsigned, b); }
__device__ __forceinline__ float bf_lo(unsigned w) { return __builtin_bit_cast(float, w << 16); }
__device__ __forceinline__ float bf_hi(unsigned w) { return __builtin_bit_cast(float, w & 0xffff0000u); }
__device__ __forceinline__ float dot2bf(unsigned a, unsigned b, float acc) { return __builtin_amdgcn_fdot2_f32_bf16(__builtin_bit_cast(bf16x2, a), __builtin_bit_cast(bf16x2, b), acc, false); }
__device__ __forceinline__ float wave_sum(float v) {
#pragma unroll
    for (int o = 1; o < 64; o <<= 1) v += __shfl_xor(v, o);
    return v;
}
__device__ __forceinline__ float wave_max(float v) {
#pragma unroll
    for (int o = 1; o < 64; o <<= 1) v = fmaxf(v, __shfl_xor(v, o));
    return v;
}
__device__ __forceinline__ int rel_bucket(int n) {
    if (n < 16) return n < 0 ? 0 : n;
    return 16 + (n >= 22) + (n >= 30) + (n >= 40) + (n >= 54) + (n >= 73) + (n >= 99) + (n >= 134) + (n >= 182) + (n >= 246) + (n >= 332) + (n >= 450) + (n >= 609) + (n >= 825) + (n >= 1117) + (n >= 1513);
}
namespace pg8 {
#define PG8_LAS __attribute__((address_space(3)))
typedef unsigned short bf16_t;
typedef short bf16x8 __attribute__((ext_vector_type(8)));
typedef float f32x4 __attribute__((ext_vector_type(4)));
typedef unsigned u32x4 __attribute__((ext_vector_type(4)));
constexpr int BM = 256, BK = 64, HALF = 128, HTB = HALF * BK * 2  , STAGE_BYTES = 8 * HTB, NXCD = 8, WGM = 8;

__host__ __device__ __forceinline__ int lds_byte(int r, int c) { const int st = (r >> 4) * 2 + (c >> 5), rr = r & 15, cc = c & 31, ob = rr * 64 + cc * 2; return st * 1024 + (ob ^ (((ob >> 9) & 1) << 5)); }
__host__ __device__ __forceinline__ void stage_rc(int b, int& R, int& C) { const int st = b / 1024, sb = b % 1024, swz = sb ^ (((sb >> 9) & 1) << 5); R = (st >> 1) * 16 + swz / 64; C = (st & 1) * 32 + (swz % 64) / 2; }
__host__ __device__ __forceinline__ int perm32(int rho) { const int n = rho >> 4, i = rho & 15; return 8 * (i >> 2) + 4 * n + (i & 3); }

struct Unit { int pm, pn; };
struct Gemm { const bf16_t* A; const bf16_t* Bt; int M, N, K; };

struct StaticOrder {
    int nM, nN, nwg, G, c;
    __host__ __device__ void init(int M, int N, int G_, int c_) { nM = M / BM; nN = N / BM; nwg = nM * nN; G = G_; c = c_; }
    int rep = 1;
    __host__ __device__ bool next(int i0, Unit& u) const {
        const int i = i0 / rep;
        const long L = (long)i * G + c; if (L >= nwg) return false;
        int wgid = (int)L; { const int q = nwg / NXCD, r = nwg % NXCD, xcd = wgid % NXCD, off = wgid / NXCD; wgid = (xcd < r ? xcd * (q + 1) : r * (q + 1) + (xcd - r) * q) + off; }
        const int nig = WGM * nN, gid = wgid / nig, fm = gid * WGM, gsz = (nM - fm) < WGM ? (nM - fm) : WGM;
        u.pm = fm + ((wgid % nig) % gsz); u.pn = (wgid % nig) / gsz; return true;
    }
    __device__ __forceinline__ void a_ready(const Unit&) const {}
    __device__ __forceinline__ void done(const Unit&) const {}
};
__device__ __forceinline__ unsigned cvt_pk_bf16(float lo, float hi) { unsigned r; asm volatile("v_cvt_pk_bf16_f32 %0, %1, %2" : "=v"(r) : "v"(lo), "v"(hi)); return r; }
__device__ __forceinline__ u32x4 pack8(const f32x4 v0, const f32x4 v1) { u32x4 w; w.x = cvt_pk_bf16(v0[0], v0[1]); w.y = cvt_pk_bf16(v0[2], v0[3]); w.z = cvt_pk_bf16(v1[0], v1[1]); w.w = cvt_pk_bf16(v1[2], v1[3]); return w; }
__device__ __forceinline__ float blo(unsigned w) { return __builtin_bit_cast(float, w << 16); }
__device__ __forceinline__ float bhi(unsigned w) { return __builtin_bit_cast(float, w & 0xffff0000u); }
__device__ __forceinline__ float sigm(float v) { return __builtin_amdgcn_rcpf(1.f + __expf(-v)); }
template <class E> __device__ __forceinline__ void epi_loop(const E& e, const f32x4 (&acc)[2][2][4][2], const Unit& u, int wr, int wc, int fr, int fq) {
#pragma unroll
    for (int ai = 0; ai < 2; ++ai)
#pragma unroll
        for (int m = 0; m < 4; ++m) { const int row = u.pm * BM + ai * HALF + wr * 64 + m * 16 + fr;
#pragma unroll
            for (int bj = 0; bj < 2; ++bj) { const int col = u.pn * BM + bj * HALF + wc * 32 + 8 * fq; e.item(u.pn, row, col, acc[ai][bj][m][0], acc[ai][bj][m][1]); } }
}

struct EpiInProj {
    static constexpr bool PERM = true, AFTER_DRAIN = false;
    bf16_t *Qd, *Kd, *Vd, *LQ, *LK, *LV, *GA, *GB;
    __device__ __forceinline__ void operator()(const f32x4 (&acc)[2][2][4][2], const Unit& u, int wr, int wc, int fr, int fq) const { epi_loop(*this, acc, u, wr, wc, fr, fq); }
    __device__ __forceinline__ void item(int pn, int row, int col, f32x4 v0, f32x4 v1) const {
            const int b = row >> 14, s = row & 16383; bf16_t* dst;
            if (pn < 2) {
                const int h = col >> 7, c = (col >> 6) & 1, d = col & 63; v0 = v0 * 0.18033688011112042f; v1 = v1 * 0.18033688011112042f;
                dst = Qd + ((size_t)((b * 4 + h) * 2 + c) * 16384 + s) * 64 + d;
            } else if (pn < 4) {
                const int cc = col - 512, h = cc >> 7, c = (cc >> 6) & 1, d = cc & 63;
                dst = Kd + ((((size_t)((b * 4 + h) * 2 + c) * 256 + (s >> 6)) * 8 + (d >> 3)) * 64 + (s & 63)) * 8;
            } else if (pn < 6) {
                const int cc = col - 1024, h = cc >> 7, d = cc & 127;
                dst = Vd + ((size_t)(b * 4 + h) * 256 + (s >> 6)) * 8192 + ((d >> 5) * 4 + ((s & 63) >> 4)) * 512 + (s & 15) * 32 + (d & 31);
            } else if (pn < 9) {
                v0 = v0 * 0.18033688011112042f; v1 = v1 * 0.18033688011112042f; dst = LQ + (size_t)row * 768 + (col - 1536);
            } else if (pn < 12) { dst = LK + (size_t)row * 768 + (col - 2304);
            } else if (pn < 15) { dst = LV + (size_t)row * 768 + (col - 3072);
            } else {
#pragma unroll
                for (int i = 0; i < 4; ++i) { v0[i] = sigm(v0[i]); v1[i] = sigm(v1[i]); }
                dst = (pn < 19) ? GA + (size_t)row * 1024 + (col - 3840) : GB + (size_t)row * 1024 + (col - 4864);
            }
            *(u32x4*)dst = pack8(v0, v1);
        }
};
struct EpiGate1 {
    static constexpr bool PERM = true, AFTER_DRAIN = false;
    const bf16_t* GA; bf16_t* G;
    __device__ __forceinline__ void operator()(const f32x4 (&acc)[2][2][4][2], const Unit& u, int wr, int wc, int fr, int fq) const { epi_loop(*this, acc, u, wr, wc, fr, fq); }
    __device__ __forceinline__ void item(int pn, int row, int col, f32x4 v0, f32x4 v1) const {
            const size_t o = (size_t)row * 1024 + col; const u32x4 g = *(const u32x4*)(GA + o);
            v0[0] *= blo(g.x); v0[1] *= bhi(g.x); v0[2] *= blo(g.y); v0[3] *= bhi(g.y); v1[0] *= blo(g.z); v1[1] *= bhi(g.z); v1[2] *= blo(g.w); v1[3] *= bhi(g.w);
            *(u32x4*)(G + o) = pack8(v0, v1);
        }
};
struct EpiGate2 {
    static constexpr bool PERM = true, AFTER_DRAIN = false;
    const bf16_t* GB; bf16_t* G;
    __device__ __forceinline__ void operator()(const f32x4 (&acc)[2][2][4][2], const Unit& u, int wr, int wc, int fr, int fq) const { epi_loop(*this, acc, u, wr, wc, fr, fq); }
    __device__ __forceinline__ void item(int pn, int row, int col, f32x4 v0, f32x4 v1) const {
            const size_t o = (size_t)row * 1024 + col; const u32x4 g = *(const u32x4*)(GB + o); const u32x4 p = *(const u32x4*)(G + o);
            v0[0] = v0[0] * blo(g.x) + blo(p.x); v0[1] = v0[1] * bhi(g.x) + bhi(p.x); v0[2] = v0[2] * blo(g.y) + blo(p.y); v0[3] = v0[3] * bhi(g.y) + bhi(p.y);
            v1[0] = v1[0] * blo(g.z) + blo(p.z); v1[1] = v1[1] * bhi(g.z) + bhi(p.z); v1[2] = v1[2] * blo(g.w) + blo(p.w); v1[3] = v1[3] * bhi(g.w) + bhi(p.w);
            *(u32x4*)(G + o) = pack8(v0, v1);
        }
};
struct EpiOut {
    static constexpr bool PERM = true, AFTER_DRAIN = false;
    const float* X; float* R;
    __device__ __forceinline__ void operator()(const f32x4 (&acc)[2][2][4][2], const Unit& u, int wr, int wc, int fr, int fq) const { epi_loop(*this, acc, u, wr, wc, fr, fq); }
    __device__ __forceinline__ void item(int pn, int row, int col, f32x4 v0, f32x4 v1) const {
            const size_t o = (size_t)row * 1024 + col; const f32x4 x0 = *(const f32x4*)(X + o), x1 = *(const f32x4*)(X + o + 4);
            *(f32x4*)(R + o) = x0 * 1.189207115002721f + v0; *(f32x4*)(R + o + 4) = x1 * 1.189207115002721f + v1;
    }
};
struct EpiScoreT {
    static constexpr bool PERM = true, AFTER_DRAIN = false;
    float* ST;
    __device__ __forceinline__ void operator()(const f32x4 (&acc)[2][2][4][2], const Unit& u, int wr, int wc, int fr, int fq) const { epi_loop(*this, acc, u, wr, wc, fr, fq); }
    __device__ __forceinline__ void item(int pn, int row, int col, f32x4 v0, f32x4 v1) const { const size_t o = (size_t)row * 32768 + col; *(f32x4*)(ST + o) = v0; *(f32x4*)(ST + o + 4) = v1; }
};
template <class Epi, class Sched, bool ALIGN_EPI = false, bool SP2 = false>
__device__ __forceinline__ void gemm_phase(PG8_LAS unsigned char* lds, const Gemm g, const Sched& S, const Epi& E) {
    const int tid = threadIdx.x, wid = __builtin_amdgcn_readfirstlane(tid >> 6), lane = tid & 63, wr = wid >> 2, wc = wid & 3, fr = lane & 15, fq = lane >> 4;
    const int K = g.K, nt = K / BK;
    unsigned voffA[2], voffB[2];
#pragma unroll
    for (int i = 0; i < 2; ++i) { int R, C; stage_rc(tid * 16 + i * 8192, R, C); const int Rb = Epi::PERM ? ((R & ~31) + perm32(R & 31)) : R;
        voffA[i] = (unsigned)(R * K + C) * 2u; voffB[i] = (unsigned)(Rb * K + C) * 2u; }
    const size_t kstep = (size_t)(BK * 2);
    const size_t hstep = (size_t)HALF * K * 2;
    const size_t tstep = 2 * hstep;
    const unsigned ldsw = (unsigned)wid * 1024u;
    const int aoff = lds_byte(wr * 64 + fr, fq * 8), boff = lds_byte(wc * 32 + fr, fq * 8);
#define PG8_SA(b, h) (((b) * 2 + (h)) * HTB)
#define PG8_SB(b, h) ((4 + (b) * 2 + (h)) * HTB)
#define PG8_STAGE(bufoff, gbase, voff) do { _Pragma("unroll") for (int _i = 0; _i < 2; ++_i) \
        __builtin_amdgcn_global_load_lds((const unsigned*)((const char*)(gbase) + (voff)[_i]), (PG8_LAS unsigned*)(lds + (bufoff) + ldsw + _i * 8192), 16, 0, 0); } while (0)
#define PG8_LDA(dst, b, h) do { _Pragma("unroll") for (int m = 0; m < 4; ++m) _Pragma("unroll") for (int k = 0; k < 2; ++k) dst[m][k] = *(const PG8_LAS bf16x8*)(lds + PG8_SA(b, h) + aoff + m * 2048 + k * 1024); } while (0)
#define PG8_LDB(dst, b, h) do { _Pragma("unroll") for (int n = 0; n < 2; ++n) _Pragma("unroll") for (int k = 0; k < 2; ++k) dst[n][k] = *(const PG8_LAS bf16x8*)(lds + PG8_SB(b, h) + boff + n * 2048 + k * 1024); } while (0)
#define PG8_MMA(ai, bj, At, Bt) do { __builtin_amdgcn_s_setprio(1); _Pragma("unroll") for (int m = 0; m < 4; ++m) _Pragma("unroll") for (int n = 0; n < 2; ++n) _Pragma("unroll") for (int k = 0; k < 2; ++k) \
        acc[ai][bj][m][n] = __builtin_amdgcn_mfma_f32_16x16x32_bf16(Bt[n][k], At[m][k], acc[ai][bj][m][n], 0, 0, 0); __builtin_amdgcn_s_setprio(0); } while (0)
#define PG8_WAIT_V(n) asm volatile("s_waitcnt vmcnt(" #n ")" ::: "memory")
#define PG8_WAIT_L(n) asm volatile("s_waitcnt lgkmcnt(" #n ")" ::: "memory")
#define PG8_BAR __builtin_amdgcn_s_barrier()
#define PG8_SCHED __builtin_amdgcn_sched_barrier(0)
    Unit cur, nxt; int ui = 0;
    if (!S.next(0, cur)) return;
    f32x4 acc[2][2][4][2];
#pragma unroll
    for (int a = 0; a < 2; ++a)
#pragma unroll
        for (int b = 0; b < 2; ++b)
#pragma unroll
            for (int m = 0; m < 4; ++m)
#pragma unroll
                for (int n = 0; n < 2; ++n) acc[a][b][m][n] = (f32x4){0.f, 0.f, 0.f, 0.f};
    bf16x8 At[4][2], B0[2][2], B1[2][2];
    const char* cA = (const char*)g.A + (size_t)cur.pm * tstep; const char* cB = (const char*)g.Bt + (size_t)cur.pn * tstep;
    S.a_ready(cur);
    if constexpr (SP2) {
        PG8_STAGE(PG8_SB(0, 0), cB, voffB); PG8_STAGE(PG8_SB(0, 1), cB + hstep, voffB); PG8_STAGE(PG8_SA(0, 0), cA, voffA); PG8_STAGE(PG8_SA(0, 1), cA + hstep, voffA);
        if (wr == 1) PG8_BAR;
        PG8_WAIT_V(2); PG8_BAR;
        PG8_STAGE(PG8_SB(1, 0), cB + kstep, voffB); PG8_STAGE(PG8_SA(1, 0), cA + kstep, voffA); PG8_STAGE(PG8_SB(1, 1), cB + hstep + kstep, voffB);
        PG8_WAIT_V(6); PG8_BAR;
    } else {
        PG8_STAGE(PG8_SB(0, 0), cB, voffB); PG8_STAGE(PG8_SA(0, 0), cA, voffA); PG8_STAGE(PG8_SB(0, 1), cB + hstep, voffB); PG8_STAGE(PG8_SA(0, 1), cA + hstep, voffA);
        if (wr == 1) PG8_BAR;
        PG8_WAIT_V(4); PG8_BAR;
        PG8_STAGE(PG8_SB(1, 0), cB + kstep, voffB); PG8_STAGE(PG8_SA(1, 0), cA + kstep, voffA); PG8_STAGE(PG8_SB(1, 1), cB + hstep + kstep, voffB);
        PG8_WAIT_V(6); PG8_BAR;
    }
    for (;;) {
        const bool has_next = S.next(ui + 1, nxt);
        const char* nA = has_next ? (const char*)g.A + (size_t)nxt.pm * tstep : cA; const char* nB = has_next ? (const char*)g.Bt + (size_t)nxt.pn * tstep : cB;
        for (int t = 0; t < nt; t += 2) {
            const bool last = (t == nt - 2);
            const char* a1 = cA + (size_t)(t + 1) * kstep;
            const char* a2 = last ? nA : cA + (size_t)(t + 2) * kstep; const char* b2 = last ? nB : cB + (size_t)(t + 2) * kstep;
            const char* a3 = a2 + kstep; const char* b3 = b2 + kstep;
            if (last && has_next) S.a_ready(nxt);
            if constexpr (SP2) {
            PG8_LDB(B0, 0, 0); PG8_LDB(B1, 0, 1); PG8_SCHED; PG8_LDA(At, 0, 0); PG8_STAGE(PG8_SA(1, 1), a1 + hstep, voffA);
            PG8_WAIT_V(8); PG8_WAIT_L(0); PG8_BAR; PG8_MMA(0, 0, At, B0); PG8_MMA(0, 1, At, B1); PG8_BAR; PG8_SCHED;
            PG8_LDA(At, 0, 1); PG8_STAGE(PG8_SB(0, 0), b2, voffB); PG8_STAGE(PG8_SB(0, 1), b2 + hstep, voffB); PG8_STAGE(PG8_SA(0, 0), a2, voffA);
            PG8_WAIT_V(8); PG8_WAIT_L(0); PG8_BAR; PG8_MMA(1, 0, At, B0); PG8_MMA(1, 1, At, B1); PG8_BAR; PG8_SCHED;
            PG8_LDB(B0, 1, 0); PG8_LDB(B1, 1, 1); PG8_SCHED; PG8_LDA(At, 1, 0); PG8_STAGE(PG8_SA(0, 1), a2 + hstep, voffA);
            PG8_WAIT_V(8); PG8_WAIT_L(0); PG8_BAR; PG8_MMA(0, 0, At, B0); PG8_MMA(0, 1, At, B1); PG8_BAR; PG8_SCHED;
            PG8_LDA(At, 1, 1); PG8_STAGE(PG8_SB(1, 0), b3, voffB); PG8_STAGE(PG8_SB(1, 1), b3 + hstep, voffB); PG8_STAGE(PG8_SA(1, 0), a3, voffA);
            PG8_WAIT_V(8); PG8_WAIT_L(0); PG8_BAR; PG8_MMA(1, 0, At, B0); PG8_MMA(1, 1, At, B1); PG8_BAR; PG8_SCHED;
            } else {
            PG8_LDB(B0, 0, 0); PG8_SCHED; PG8_LDA(At, 0, 0); PG8_STAGE(PG8_SA(1, 1), a1 + hstep, voffA);
            PG8_WAIT_L(8); PG8_BAR; PG8_WAIT_L(0); PG8_MMA(0, 0, At, B0); PG8_BAR; PG8_SCHED;
            PG8_LDB(B1, 0, 1); PG8_STAGE(PG8_SB(0, 0), b2, voffB);
            PG8_BAR; PG8_WAIT_L(0); PG8_MMA(0, 1, At, B1); PG8_BAR;
            PG8_LDA(At, 0, 1); PG8_STAGE(PG8_SA(0, 0), a2, voffA);
            PG8_BAR; PG8_WAIT_L(0); PG8_MMA(1, 0, At, B0); PG8_BAR; PG8_SCHED;
            PG8_STAGE(PG8_SB(0, 1), b2 + hstep, voffB);
            PG8_WAIT_V(6); PG8_BAR; PG8_MMA(1, 1, At, B1); PG8_BAR;
            PG8_LDB(B0, 1, 0); PG8_SCHED; PG8_LDA(At, 1, 0); PG8_STAGE(PG8_SA(0, 1), a2 + hstep, voffA);
            PG8_WAIT_L(8); PG8_BAR; PG8_WAIT_L(0); PG8_MMA(0, 0, At, B0); PG8_BAR; PG8_SCHED;
            PG8_LDB(B1, 1, 1); PG8_STAGE(PG8_SB(1, 0), b3, voffB);
            PG8_BAR; PG8_WAIT_L(0); PG8_MMA(0, 1, At, B1); PG8_BAR;
            PG8_LDA(At, 1, 1); PG8_STAGE(PG8_SA(1, 0), a3, voffA);
            PG8_BAR; PG8_WAIT_L(0); PG8_MMA(1, 0, At, B0); PG8_BAR; PG8_SCHED;
            PG8_STAGE(PG8_SB(1, 1), b3 + hstep, voffB);
            PG8_WAIT_V(6); PG8_BAR; PG8_MMA(1, 1, At, B1); PG8_BAR;
            }
        }
        if constexpr (ALIGN_EPI) { if (wr == 0) PG8_BAR; }
        if constexpr (!Epi::AFTER_DRAIN) { E(acc, cur, wr, wc, fr, fq); S.done(cur); }
        if (!has_next) break;
#pragma unroll
        for (int a = 0; a < 2; ++a)
#pragma unroll
            for (int b = 0; b < 2; ++b)
#pragma unroll
                for (int m = 0; m < 4; ++m)
#pragma unroll
                    for (int n = 0; n < 2; ++n) acc[a][b][m][n] = (f32x4){0.f, 0.f, 0.f, 0.f};
        cur = nxt; cA = nA; cB = nB; ++ui;
        if constexpr (ALIGN_EPI) { if (wr == 1) PG8_BAR; }
    }
    PG8_WAIT_V(0);
    if constexpr (!ALIGN_EPI) { if (wr == 0) PG8_BAR; }
    PG8_BAR;
    if constexpr (Epi::AFTER_DRAIN) { E.fused(acc, cur, wr, wc, fr, fq, lds, wid, lane); S.done(cur); }
#undef PG8_SA
#undef PG8_SB
#undef PG8_STAGE
#undef PG8_LDA
#undef PG8_LDB
#undef PG8_MMA
#undef PG8_WAIT_V
#undef PG8_WAIT_L
#undef PG8_BAR
#undef PG8_SCHED
}
}
#define XB_TMO      128
#define XB_XCNT(j)  (256  + 64 * (j))
#define XB_XSUB(j)  (1280 + 64 * (j))
#define XB_XGEN(j)  (2304 + 64 * (j))
#define XB_TOP      3328
#define XB_TOPGEN   3392
#define XCD_BAR_WORDS 3456
#define XB_SPIN_CAP (1u << 18)

__device__ __forceinline__ unsigned xb_ld(unsigned* p)              { return __hip_atomic_load(p, __ATOMIC_RELAXED, __HIP_MEMORY_SCOPE_AGENT); }
__device__ __forceinline__ unsigned xb_add(unsigned* p, unsigned v) { return __hip_atomic_fetch_add(p, v, __ATOMIC_RELAXED, __HIP_MEMORY_SCOPE_AGENT); }
__device__ __forceinline__ unsigned xb_xcc_id() { return (unsigned)__builtin_amdgcn_s_getreg((3 << 11) | 20) & 0xFu; }
#define XB_SPIN(cond, bar) do { unsigned _sp = 0; while (cond) { __builtin_amdgcn_s_sleep(1); \
    if ((++_sp & 255u) == 0u) { if (xb_ld(&(bar)[XB_TMO])) break; if (_sp > XB_SPIN_CAP) { atomicAdd(&(bar)[XB_TMO], 1u); break; } } } } while (0)

struct XcdBarrier {
    unsigned* bar; unsigned x;
    volatile LAS unsigned* st;
};

__device__ __forceinline__ XcdBarrier xcd_barrier_post(unsigned* bar, volatile LAS unsigned* st) {
    XcdBarrier b; b.bar = bar; b.x = xb_xcc_id(); b.st = st;
    if (threadIdx.x == 0) (void)xb_add(&bar[XB_XCNT(b.x)], 1u);
    return b;
}
__device__ __forceinline__ void xcd_barrier_complete(unsigned* bar, unsigned x, unsigned& nloc, unsigned& nx) {
    const unsigned G = gridDim.x * gridDim.y * gridDim.z;
    unsigned sum, cnt, mine, sp = 0u;
    for (;;) {
        sum = 0u; cnt = 0u; mine = 0u;
#pragma unroll
        for (unsigned j = 0; j < 16; ++j) { const unsigned c = xb_ld(&bar[XB_XCNT(j)]); sum += c; cnt += (c > 0u) ? 1u : 0u; mine = (j == x) ? c : mine; }
        if (sum == G) break;
        __builtin_amdgcn_s_sleep(1);
        if ((++sp & 255u) == 0u) { if (xb_ld(&bar[XB_TMO])) break; if (sp > XB_SPIN_CAP) { atomicAdd(&bar[XB_TMO], 1u); break; } }
    }
    nloc = mine > 0u ? mine : 1u; nx = cnt > 0u ? cnt : 1u;
}

__device__ __forceinline__ void xcd_barrier(const XcdBarrier& b) {
    asm volatile("s_waitcnt vmcnt(0)" ::: "memory");
    __syncthreads();
    if (threadIdx.x == 0) {
        unsigned* bar = b.bar;
        __builtin_amdgcn_s_waitcnt(0);
        unsigned nloc = b.st[0], nx = b.st[1];
        if (nloc == 0u) { xcd_barrier_complete(bar, b.x, nloc, nx); b.st[0] = nloc; b.st[1] = nx; }
        const unsigned old = xb_add(&bar[XB_XSUB(b.x)], 1u);
        const unsigned gen = old / nloc;
        if (old + 1u == (gen + 1u) * nloc) {
            __builtin_amdgcn_fence(__ATOMIC_RELEASE, "agent");
            asm volatile("s_waitcnt vmcnt(0)" ::: "memory");
            const unsigned og = xb_add(&bar[XB_TOP], 1u);
            const unsigned tg = og / nx;
            if (og + 1u == (tg + 1u) * nx) xb_add(&bar[XB_TOPGEN], 1u);
            else XB_SPIN(xb_ld(&bar[XB_TOPGEN]) == tg, bar);
            __builtin_amdgcn_fence(__ATOMIC_ACQUIRE, "agent");
            xb_add(&bar[XB_XGEN(b.x)], 1u);
            asm volatile("s_waitcnt vmcnt(0)" ::: "memory");
        } else {
            XB_SPIN(xb_ld(&bar[XB_XGEN(b.x)]) == gen, bar);
            __builtin_amdgcn_fence(__ATOMIC_ACQUIRE, "agent");
            asm volatile("s_waitcnt vmcnt(0)" ::: "memory");
        }
    }
    __syncthreads();
}
namespace da {
constexpr int SLOT_K = 8192, SLOT_V = 16384, SLOT = SLOT_K + SLOT_V;
constexpr int NSLOT = 4;
constexpr int LDS_BIAS = NSLOT * SLOT;
constexpr int LDS_END = LDS_BIAS + BIAS_TAB * 4;
constexpr float THR = 8.f;
__device__ __forceinline__ int crow(int r, int hi) { return (r & 3) + 8 * (r >> 2) + 4 * hi; }
__device__ __forceinline__ void glds16(const void* gbase  , unsigned voff  , unsigned lds_dst) { unsigned keep;
    asm volatile("s_mov_b32 %0, m0\n\ts_mov_b32 m0, %3\n\ts_nop 0\n\tglobal_load_lds_dwordx4 %1, %2\n\ts_mov_b32 m0, %0" : "=&s"(keep) : "v"(voff), "s"(gbase), "s"(lds_dst) : "memory"); }
typedef short v4i16_t __attribute__((ext_vector_type(4)));
__device__ __forceinline__ s16x4 vtr(const LAS char* p) { return __builtin_bit_cast(s16x4, __builtin_amdgcn_ds_read_tr16_b64_v4i16((LAS v4i16_t*)p)); }
#define DA_WAIT_BAR() asm volatile("s_waitcnt vmcnt(0) lgkmcnt(0)\n\ts_barrier" ::: "memory")

struct Tensors { const bf16* Qd; const bf16* Kd; const bf16* Vd; float* stash; bf16* ya; const float* dlam; const float* subg; const float* relb; };

__device__ __forceinline__ float max3f(float a, float b, float c) { float r; asm("v_max3_f32 %0, %1, %2, %3" : "=v"(r) : "v"(a), "v"(b), "v"(c)); return r; }
#define DA_STAGE_Q(T_) do { const int t_ = (T_); const LAS char* kb_ = kp0 + (t_ & 3) * SLOT; \
        bf16x8 kf_[8]; \
        _Pragma("unroll") for (int d0 = 0; d0 < 2; ++d0) { kf_[2 * d0] = *(const LAS bf16x8*)(kb_ + d0 * 2048); kf_[2 * d0 + 1] = *(const LAS bf16x8*)(kb_ + d0 * 2048 + 512); } \
        if ((q0 - 64 * t_ - 63) < DFAR) { int base_ = qabs - 64 * t_ - 4 * hi + BIAS_GUARD; asm volatile("" : "+v"(base_)); \
            _Pragma("unroll") for (int r = 0; r < 16; ++r) { const int o_ = (r & 3) + 8 * (r >> 2); p0[r] = tb[base_ - o_] - m; p1[r] = tb[base_ - o_ - 32] - m; } \
            _Pragma("unroll") for (int d0 = 0; d0 < 4; ++d0) { if (d0 < 2) { kf_[2 * d0 + 4] = *(const LAS bf16x8*)(kb_ + (d0 + 2) * 2048); kf_[2 * d0 + 5] = *(const LAS bf16x8*)(kb_ + (d0 + 2) * 2048 + 512); } \
                p0 = __builtin_amdgcn_mfma_f32_32x32x16_bf16(kf_[2 * d0], qr[d0], p0, 0, 0, 0); p1 = __builtin_amdgcn_mfma_f32_32x32x16_bf16(kf_[2 * d0 + 1], qr[d0], p1, 0, 0, 0); } \
        } else { f32x16 ci_; const float cm_ = c31 - m; _Pragma("unroll") for (int r = 0; r < 16; ++r) ci_[r] = cm_; \
            _Pragma("unroll") for (int d0 = 0; d0 < 4; ++d0) { if (d0 < 2) { kf_[2 * d0 + 4] = *(const LAS bf16x8*)(kb_ + (d0 + 2) * 2048); kf_[2 * d0 + 5] = *(const LAS bf16x8*)(kb_ + (d0 + 2) * 2048 + 512); } \
                p0 = __builtin_amdgcn_mfma_f32_32x32x16_bf16(kf_[2 * d0], qr[d0], d0 == 0 ? ci_ : p0, 0, 0, 0); p1 = __builtin_amdgcn_mfma_f32_32x32x16_bf16(kf_[2 * d0 + 1], qr[d0], d0 == 0 ? ci_ : p1, 0, 0, 0); } } \
    } while (0)
#define DA_STAGE_S(T_) do { const int t_ = (T_); \
        if (t_ >= NT - 4) { int base_ = qabs - 64 * t_ - 4 * hi + BIAS_GUARD; asm volatile("" : "+v"(base_)); \
            _Pragma("unroll") for (int r = 0; r < 16; ++r) { const int o_ = (r & 3) + 8 * (r >> 2); if (base_ - o_ < BIAS_GUARD) p0[r] = -1e30f; if (base_ - o_ - 32 < BIAS_GUARD) p1[r] = -1e30f; } } \
        float ra_ = max3f(p0[0], p0[1], p1[0]), rb_ = max3f(p0[2], p0[3], p1[1]); ra_ = max3f(ra_, p1[2], p1[3]); \
        _Pragma("unroll") for (int r = 4; r < 16; r += 4) { ra_ = max3f(ra_, p0[r], p0[r + 1]); rb_ = max3f(rb_, p0[r + 2], p0[r + 3]); ra_ = max3f(ra_, p1[r], p1[r + 1]); rb_ = max3f(rb_, p1[r + 2], p1[r + 3]); } \
        float rm_ = fmaxf(ra_, rb_); \
        { auto rr_ = __builtin_amdgcn_permlane32_swap(__float_as_uint(rm_), __float_as_uint(rm_), false, false); rm_ = fmaxf(__uint_as_float(rr_[0]), __uint_as_float(rr_[1])); } \
        if (t_ == 0 || __any(rm_ > THR)) { const float dl_ = (t_ == 0) ? rm_ : fmaxf(rm_, 0.f), f_ = __builtin_amdgcn_exp2f(-dl_); \
            _Pragma("unroll") for (int r = 0; r < 16; ++r) { p0[r] -= dl_; p1[r] -= dl_; } \
            _Pragma("unroll") for (int d0 = 0; d0 < 4; ++d0) _Pragma("unroll") for (int r = 0; r < 16; ++r) o[d0][r] *= f_; \
            l *= f_; m += dl_; } \
        float ls0_ = 0.f, ls1_ = 0.f; \
        _Pragma("unroll") for (int r = 0; r < 16; ++r) { p0[r] = __builtin_amdgcn_exp2f(p0[r]); p1[r] = __builtin_amdgcn_exp2f(p1[r]); ls0_ += p0[r]; ls1_ += p1[r]; } \
        l += ls0_ + ls1_; \
        { v4u w; \
          w.x = cvtpk(p0[0], p0[1]); w.y = cvtpk(p0[2], p0[3]); w.z = cvtpk(p0[4], p0[5]); w.w = cvtpk(p0[6], p0[7]); pw[0] = __builtin_bit_cast(bf16x8, w); \
          w.x = cvtpk(p0[8], p0[9]); w.y = cvtpk(p0[10], p0[11]); w.z = cvtpk(p0[12], p0[13]); w.w = cvtpk(p0[14], p0[15]); pw[1] = __builtin_bit_cast(bf16x8, w); \
          w.x = cvtpk(p1[0], p1[1]); w.y = cvtpk(p1[2], p1[3]); w.z = cvtpk(p1[4], p1[5]); w.w = cvtpk(p1[6], p1[7]); pw[2] = __builtin_bit_cast(bf16x8, w); \
          w.x = cvtpk(p1[8], p1[9]); w.y = cvtpk(p1[10], p1[11]); w.z = cvtpk(p1[12], p1[13]); w.w = cvtpk(p1[14], p1[15]); pw[3] = __builtin_bit_cast(bf16x8, w); } \
    } while (0)
#define DA_VF(V_, ks) (bf16x8){V_[2 * (ks)][0], V_[2 * (ks)][1], V_[2 * (ks)][2], V_[2 * (ks)][3], V_[2 * (ks) + 1][0], V_[2 * (ks) + 1][1], V_[2 * (ks) + 1][2], V_[2 * (ks) + 1][3]}
#define DA_STAGE_B(T_) do { const LAS char* vb_ = vp0 + ((T_) & 3) * SLOT; \
        _Pragma("unroll") for (int d0 = 0; d0 < 4; ++d0) { s16x4 vA[8]; \
            _Pragma("unroll") for (int ks = 0; ks < 4; ++ks) { vA[2 * ks] = vtr(vb_ + d0 * 4096 + ks * 1024); vA[2 * ks + 1] = vtr(vb_ + d0 * 4096 + ks * 1024 + 512); } \
            _Pragma("unroll") for (int ks = 0; ks < 4; ++ks) o[d0] = __builtin_amdgcn_mfma_f32_32x32x16_bf16(DA_VF(vA, ks), pw[ks], o[d0], 0, 0, 0); \
            __builtin_amdgcn_sched_barrier(0); } \
    } while (0)
__device__ __forceinline__ void unit(const Tensors& X, int b, int h, int qb, LAS unsigned char* lds, int wgslot, float lam, float c31) {
    const int wid = __builtin_amdgcn_readfirstlane((int)threadIdx.x >> 6);
    const int grp = wid >> 2;
    const int q0 = qb * 256, NT = 4 * (qb + 1);
    const unsigned lds0 = (unsigned)(uintptr_t)lds;
    const LAS float* tb = (const LAS float*)(lds + LDS_BIAS);
    for (int c = 0; c < 2; ++c) {
        int lane = (int)__builtin_amdgcn_mbcnt_hi(~0u, __builtin_amdgcn_mbcnt_lo(~0u, 0u)); asm volatile("" : "+v"(lane));
        const int r32 = lane & 31, hi = lane >> 5;
        const unsigned lane16 = (unsigned)lane * 16u;
        const int qabs = q0 + wid * 32 + r32;
        const LAS char* vp0 = (const LAS char*)lds + SLOT_K + ((lane >> 4) & 1) * 32 + (lane & 3) * 8 + (4 * hi + ((lane & 15) >> 2)) * 64;
        const LAS char* kp0 = (const LAS char*)lds + hi * 1024 + r32 * 16;
        const int bhc = (b * 4 + h) * 2 + c;
        const bf16* Qw = X.Qd + ((size_t)bhc * SEQ + q0 + wid * 32 + r32) * 64 + hi * 8;
        const char* Kt = (const char*)X.Kd + (size_t)bhc * NTILE * SLOT_K + wid * 1024;
        const char* Vt = (const char*)X.Vd + (size_t)(b * 4 + h) * NTILE * SLOT_V + wid * 1024;
#define DA_DMA(t, slot) do { const unsigned sb_ = (unsigned)__builtin_amdgcn_readfirstlane(lds0 + (slot) * SLOT + wid * 1024); \
        glds16(Kt + (size_t)(t) * SLOT_K, lane16, sb_); glds16(Vt + (size_t)(t) * SLOT_V, lane16, sb_ + SLOT_K); glds16(Vt + (size_t)(t) * SLOT_V + 8192, lane16, sb_ + SLOT_K + 8192); } while (0)
        DA_DMA(0, 0); DA_DMA(1, 1); DA_DMA(2, 2);
        bf16x8 qr[4];
#pragma unroll
        for (int d0 = 0; d0 < 4; ++d0) qr[d0] = *(const bf16x8*)(Qw + d0 * 16);
        f32x16 o[4];
#pragma unroll
        for (int d0 = 0; d0 < 4; ++d0)
#pragma unroll
            for (int r = 0; r < 16; ++r) o[d0][r] = 0.f;
        float m = 0.f, l = 0.f;
        bf16x8 pw[4]; f32x16 p0, p1;
        asm volatile("" :: "v"(qr[0]), "v"(qr[1]), "v"(qr[2]), "v"(qr[3]));
        asm volatile("s_waitcnt vmcnt(6) lgkmcnt(0)\n\ts_barrier" ::: "memory");
        DA_STAGE_Q(0);
#define DA_TILE_BARRIER(t) do { \
            if ((t) + 1 < NT) asm volatile("s_waitcnt vmcnt(3) lgkmcnt(0)\n\ts_barrier" ::: "memory"); else asm volatile("s_waitcnt vmcnt(0) lgkmcnt(0)\n\ts_barrier" ::: "memory"); \
            if ((t) + 2 < NT) { const int sn_ = ((t) + 2) & 3; DA_DMA((t) + 2, sn_); } } while (0)
        for (int t = 1; t <= NT; ++t) {
            if (grp == 1) DA_TILE_BARRIER(t);
            DA_STAGE_S(t - 1);
            if (grp == 0) DA_TILE_BARRIER(t);
            __builtin_amdgcn_sched_barrier(0);
            DA_STAGE_B(t - 1);
            if (t < NT) DA_STAGE_Q(t);
        }
#undef DA_TILE_BARRIER
#undef DA_DMA
        { auto rr = __builtin_amdgcn_permlane32_swap(__float_as_uint(l), __float_as_uint(l), false, false); l = __uint_as_float(rr[0]) + __uint_as_float(rr[1]); }
        const float inv = 1.f / l;
        int lane_e = lane; asm volatile("" : "+v"(lane_e));
        GAS unsigned* stg = (GAS unsigned*)((unsigned*)X.stash + ((size_t)(wgslot * 8 + wid) * 32) * 64 + lane_e);
        if (c == 0) {
#pragma unroll
            for (int d0 = 0; d0 < 4; ++d0)
#pragma unroll
                for (int r = 0; r < 16; r += 2) stg[(d0 * 8 + (r >> 1)) * 64] = cvtpk(o[d0][r] * inv, o[d0][r + 1] * inv);
        } else {
            float ss = 0.f;
#pragma unroll
            for (int d0 = 0; d0 < 4; ++d0)
#pragma unroll
                for (int r = 0; r < 16; r += 2) { const unsigned w1 = stg[(d0 * 8 + (r >> 1)) * 64]; const float dv0 = bf_lo(w1) - lam * (o[d0][r] * inv), dv1 = bf_hi(w1) - lam * (o[d0][r + 1] * inv);
                    o[d0][r] = dv0; o[d0][r + 1] = dv1; ss += dv0 * dv0 + dv1 * dv1; if (r == 14) asm volatile("" ::: "memory"); }
            { auto rr = __builtin_amdgcn_permlane32_swap(__float_as_uint(ss), __float_as_uint(ss), false, false); ss = __uint_as_float(rr[0]) + __uint_as_float(rr[1]); }
            const float rn = __builtin_amdgcn_rsqf(ss * (1.f / 128.f) + SUBLN_EPS) * (1.f - LAM_INIT);
            const int hi_e = lane_e >> 5, qabs_e = q0 + wid * 32 + (lane_e & 31);
            bf16* yrow = X.ya + ((size_t)b * SEQ + qabs_e) * 512 + h * 128 + 4 * hi_e; const float* sg = X.subg + 4 * hi_e;
#pragma unroll
            for (int d0 = 0; d0 < 4; ++d0)
#pragma unroll
                for (int r4 = 0; r4 < 4; ++r4) {
                    const int dd = 32 * d0 + 8 * r4; const f32x4 g = *(const f32x4*)(sg + dd);
                    v2u w; w.x = pk2(o[d0][4 * r4] * rn * g[0], o[d0][4 * r4 + 1] * rn * g[1]); w.y = pk2(o[d0][4 * r4 + 2] * rn * g[2], o[d0][4 * r4 + 3] * rn * g[3]);
                    *(v2u*)(yrow + dd) = w;
                }
        }
    }
    asm volatile("s_waitcnt vmcnt(0) lgkmcnt(0)\n\ts_barrier" ::: "memory");
}
#undef DA_STAGE_Q
#undef DA_STAGE_S
#undef DA_STAGE_B
#undef DA_VF
#undef DA_WAIT_BAR
}
namespace dil {
constexpr int BT = 1152, BT0 = 512;
constexpr int LDS_VST = 0, LDS_BL = 32768, LDS_END = LDS_BL + 3 * BT * 4;
constexpr float THR = 8.f;
struct Tensors { const bf16* LQ; const bf16* LK; const bf16* LV; bf16* yb; };
typedef short v4i16_t __attribute__((ext_vector_type(4)));
__device__ __forceinline__ s16x4 vtr(const LAS unsigned char* p) { return __builtin_bit_cast(s16x4, __builtin_amdgcn_ds_read_tr16_b64_v4i16((LAS v4i16_t*)p)); }

template <int G_, int QS_> __device__ __forceinline__ void group(const Tensors& X, size_t rowb, int h, int P0, int r, LAS unsigned char* vst, const LAS float* blg, int lane, f32x16 (&o)[2], float& m, float& l) {
    constexpr int DL = (G_ == 0) ? 1 : (G_ == 1) ? 4 : 16, MG = QS_ / DL, NKB = (31 * MG + 128) / 32 + 1;
    static_assert(QS_ % DL == 0, "query stride must be a multiple of the dilation");
    const int i = lane & 31, hi = lane >> 5;
    const int colb = G_ * 256 + h * 64;
    bf16x8 qr[4];
    { const bf16* qp = X.LQ + (rowb + P0 + r + QS_ * i) * 768 + colb + hi * 8;
#pragma unroll
      for (int d0 = 0; d0 < 4; ++d0) qr[d0] = *(const bf16x8*)(qp + 16 * d0); }
    const int kpos0 = P0 + r - 128 * DL;
    const LAS unsigned char* vrd = vst + ((lane >> 4) & 1) * 32 + (lane & 3) * 8 + (4 * hi + ((lane & 15) >> 2)) * 64;
#define DIL_LOAD(KF, VR, KB) do { \
        { int kpos_ = kpos0 + (32 * (KB) + i) * DL; kpos_ = kpos_ < 0 ? 0 : (kpos_ > SEQ - 1 ? SEQ - 1 : kpos_); const bf16* kp_ = X.LK + (rowb + kpos_) * 768 + colb + hi * 8; \
          _Pragma("unroll") for (int d0 = 0; d0 < 4; ++d0) KF[d0] = *(const bf16x8*)(kp_ + 16 * d0); } \
        _Pragma("unroll") for (int t = 0; t < 4; ++t) { const int qd = lane + 64 * t, key = qd >> 3, ch = qd & 7; int vpos_ = kpos0 + (32 * (KB) + key) * DL; vpos_ = vpos_ < 0 ? 0 : (vpos_ > SEQ - 1 ? SEQ - 1 : vpos_); \
            VR[t] = *(const v4u*)(X.LV + (rowb + vpos_) * 768 + colb + ch * 8); } } while (0)
    bf16x8 kfn[4]; v4u vregn[4];
    DIL_LOAD(kfn, vregn, 0);
#pragma unroll 1
    for (int kb = 0; kb < NKB; ++kb) {
        bf16x8 kf[4]; v4u vreg[4];
#pragma unroll
        for (int d0 = 0; d0 < 4; ++d0) { kf[d0] = kfn[d0]; vreg[d0] = vregn[d0]; }
        if (kb + 1 < NKB) DIL_LOAD(kfn, vregn, kb + 1);
        const int jb = i * MG + 128 - 32 * kb - 4 * hi;
        f32x16 p;
#pragma unroll
        for (int rr = 0; rr < 16; ++rr) p[rr] = blg[jb - ((rr & 3) + 8 * (rr >> 2)) + BT0];
#pragma unroll
        for (int d0 = 0; d0 < 4; ++d0) p = __builtin_amdgcn_mfma_f32_32x32x16_bf16(kf[d0], qr[d0], p, 0, 0, 0);
        const int cb = 32 * kb + 4 * hi;
#pragma unroll
        for (int rr = 0; rr < 16; ++rr) { const int o_ = (rr & 3) + 8 * (rr >> 2); if ((unsigned)(jb - o_) > 128u || kpos0 + (cb + o_) * DL < 0) p[rr] = -3e38f; }
        float rm = p[0];
#pragma unroll
        for (int rr = 1; rr < 16; ++rr) rm = fmaxf(rm, p[rr]);
        { auto sw = __builtin_amdgcn_permlane32_swap(__float_as_uint(rm), __float_as_uint(rm), false, false); rm = fmaxf(__uint_as_float(sw[0]), __uint_as_float(sw[1])); }
        if (__any(rm > m + THR)) {
            const float mn = fmaxf(m, rm), f = __builtin_amdgcn_exp2f(m - mn);
#pragma unroll
            for (int d0 = 0; d0 < 2; ++d0)
#pragma unroll
                for (int rr = 0; rr < 16; ++rr) o[d0][rr] *= f;
            l *= f; m = mn;
        }
        float ls = 0.f;
#pragma unroll
        for (int rr = 0; rr < 16; ++rr) { p[rr] = __builtin_amdgcn_exp2f(p[rr] - m); ls += p[rr]; }
        l += ls;
        bf16x8 pw[2];
        { v4u w;
          w.x = cvtpk(p[0], p[1]); w.y = cvtpk(p[2], p[3]); w.z = cvtpk(p[4], p[5]); w.w = cvtpk(p[6], p[7]); pw[0] = __builtin_bit_cast(bf16x8, w);
          w.x = cvtpk(p[8], p[9]); w.y = cvtpk(p[10], p[11]); w.z = cvtpk(p[12], p[13]); w.w = cvtpk(p[14], p[15]); pw[1] = __builtin_bit_cast(bf16x8, w); }
#pragma unroll
        for (int t = 0; t < 4; ++t) { const int qd = lane + 64 * t, key = qd >> 3, ch = qd & 7;
            *(LAS v4u*)(vst + ((ch >> 2) * 2 + (key >> 4)) * 1024 + (key & 15) * 64 + (ch & 3) * 16) = vreg[t]; }
        asm volatile("s_waitcnt lgkmcnt(0)" ::: "memory");
#pragma unroll
        for (int d0 = 0; d0 < 2; ++d0)
#pragma unroll
            for (int ks = 0; ks < 2; ++ks) {
                const s16x4 lo = vtr(vrd + (d0 * 2 + ks) * 1024), hh = vtr(vrd + (d0 * 2 + ks) * 1024 + 512);
                const bf16x8 vf = (bf16x8){lo[0], lo[1], lo[2], lo[3], hh[0], hh[1], hh[2], hh[3]};
                o[d0] = __builtin_amdgcn_mfma_f32_32x32x16_bf16(vf, pw[ks], o[d0], 0, 0, 0);
            }
        asm volatile("s_waitcnt lgkmcnt(0)" ::: "memory");
    }
#undef DIL_LOAD
}
__device__ __forceinline__ void wave_tile_g0(const Tensors& X, float* lse0, int b, int h, int P0, LAS unsigned char* vst, const LAS float* bl, int lane) {
    const size_t rowb = (size_t)b * SEQ;
    f32x16 o[2];
#pragma unroll
    for (int d0 = 0; d0 < 2; ++d0)
#pragma unroll
        for (int rr = 0; rr < 16; ++rr) o[d0][rr] = 0.f;
    float m = -1e30f, l = 0.f;
    group<0, 1>(X, rowb, h, P0, 0, vst, bl, lane, o, m, l);
    { auto sw = __builtin_amdgcn_permlane32_swap(__float_as_uint(l), __float_as_uint(l), false, false); l = __uint_as_float(sw[0]) + __uint_as_float(sw[1]); }
    const float inv = 1.f / l; const int i = lane & 31, hi = lane >> 5;
    bf16* yrow = X.yb + (rowb + P0 + i) * 256 + h * 64 + 4 * hi;
#pragma unroll
    for (int d0 = 0; d0 < 2; ++d0)
#pragma unroll
        for (int r4 = 0; r4 < 4; ++r4) { v2u w; w.x = pk2(o[d0][4 * r4] * inv, o[d0][4 * r4 + 1] * inv); w.y = pk2(o[d0][4 * r4 + 2] * inv, o[d0][4 * r4 + 3] * inv); *(v2u*)(yrow + 32 * d0 + 8 * r4) = w; }
    if (hi == 0) lse0[(rowb + P0 + i) * 4 + h] = m + __builtin_amdgcn_logf(l);
}
__device__ __forceinline__ void wave_tile(const Tensors& X, const float* lse0, int b, int h, int P0, int r, LAS unsigned char* vst, const LAS float* bl, int lane) {
    const size_t rowb = (size_t)b * SEQ;
    f32x16 o[2];
#pragma unroll
    for (int d0 = 0; d0 < 2; ++d0)
#pragma unroll
        for (int rr = 0; rr < 16; ++rr) o[d0][rr] = 0.f;
    float m = -1e30f, l = 0.f;
    group<1, 16>(X, rowb, h, P0, r, vst, bl + BT, lane, o, m, l);
    group<2, 16>(X, rowb, h, P0, r, vst, bl + 2 * BT, lane, o, m, l);
    { auto sw = __builtin_amdgcn_permlane32_swap(__float_as_uint(l), __float_as_uint(l), false, false); l = __uint_as_float(sw[0]) + __uint_as_float(sw[1]); }
    const int i = lane & 31, hi = lane >> 5;
    const float w0 = __builtin_amdgcn_exp2f(lse0[(rowb + P0 + r + 16 * i) * 4 + h] - m);
    const float inv = 1.f / (l + w0);
    bf16* yrow = X.yb + (rowb + P0 + r + 16 * i) * 256 + h * 64 + 4 * hi;
#pragma unroll
    for (int d0 = 0; d0 < 2; ++d0)
#pragma unroll
        for (int r4 = 0; r4 < 4; ++r4) { const v2u g0 = *(const v2u*)(yrow + 32 * d0 + 8 * r4);
            v2u w; w.x = pk2((o[d0][4 * r4] + w0 * bf_lo(g0.x)) * inv, (o[d0][4 * r4 + 1] + w0 * bf_hi(g0.x)) * inv); w.y = pk2((o[d0][4 * r4 + 2] + w0 * bf_lo(g0.y)) * inv, (o[d0][4 * r4 + 3] + w0 * bf_hi(g0.y)) * inv);
            *(v2u*)(yrow + 32 * d0 + 8 * r4) = w; }
}
}
__device__ __forceinline__ void p0_transpose_item(const float* W, int K, int N, bf16* WT, LAS float* scr, int item, int lane) {
    const int nblk = N / 32, kb = item / nblk, nb = item % nblk, k0 = 64 * kb, n0 = 32 * nb;
#pragma unroll 8
    for (int i = 0; i < 32; ++i) { const int kk = 2 * i + (lane >> 5); scr[kk * 33 + (lane & 31)] = W[(size_t)(k0 + kk) * N + n0 + (lane & 31)]; }
    LDS_WAIT(); asm volatile("" ::: "memory");
    const int c = lane & 7;
#pragma unroll
    for (int j = 0; j < 4; ++j) { const int n = (lane >> 3) + 8 * j; const LAS float* s = scr + (8 * c) * 33 + n;
        v4u o; o.x = pk2(s[0 * 33], s[1 * 33]); o.y = pk2(s[2 * 33], s[3 * 33]); o.z = pk2(s[4 * 33], s[5 * 33]); o.w = pk2(s[6 * 33], s[7 * 33]);
        *(v4u*)(WT + (size_t)(n0 + n) * K + k0 + 8 * c) = o; }
    LDS_WAIT(); asm volatile("" ::: "memory");
}
__device__ __forceinline__ void cast_bf16(const float* src, bf16* dst, size_t n8, size_t gtid, size_t gthreads) {
    for (size_t i = gtid; i < n8; i += gthreads) { const f32x4 a = *(const f32x4*)(src + i * 8), b = *(const f32x4*)(src + i * 8 + 4);
        v4u o; o.x = pk2(a[0], a[1]); o.y = pk2(a[2], a[3]); o.z = pk2(b[0], b[1]); o.w = pk2(b[2], b[3]); *(v4u*)(dst + i * 8) = o; }
}

struct Args { const float* in[16]; float* out; unsigned char* ws; int ph_lo, ph_hi; };
enum { I_X = 0, I_WIN, I_DLAM, I_SUBG, I_WBD, I_WBL, I_WO, I_LN1G, I_LN1B, I_PWQ, I_PKEYS, I_PU, I_PV, I_LN2G, I_LN2B, I_RELB };

__device__ __forceinline__ void p0_prologue(const Args& A, LAS unsigned char* lds, int vcu, int G, int wave, int lane) {
    unsigned char* ws = A.ws;
    const int gw = vcu * NWAVES + wave, NGW = G * NWAVES;
    const size_t gtid = (size_t)gw * 64 + lane, gthreads = (size_t)NGW * 64;
    LAS float* scr = (LAS float*)(lds + wave * 16384);
    constexpr int I_IN = (D / 64) * (INC / 32), I_BD = (512 / 64) * (D / 32), I_BL = (256 / 64) * (D / 32), I_O = (D / 64) * (D / 32);
    for (int it0 = gw; it0 < (I_IN + I_BD + I_BL + I_O) * NREP(32); it0 += NGW) {
        int r = it0 % (I_IN + I_BD + I_BL + I_O);
        if (r < I_IN) { p0_transpose_item(A.in[I_WIN], D, INC, (bf16*)(ws + WS_WIN), scr, r, lane); continue; } r -= I_IN;
        if (r < I_BD) { p0_transpose_item(A.in[I_WBD], 512, D, (bf16*)(ws + WS_WBD), scr, r, lane); continue; } r -= I_BD;
        if (r < I_BL) { p0_transpose_item(A.in[I_WBL], 256, D, (bf16*)(ws + WS_WBL), scr, r, lane); continue; } r -= I_BL;
        p0_transpose_item(A.in[I_WO], D, D, (bf16*)(ws + WS_WO), scr, r, lane);
    }
    for (int rep_ = 0; rep_ < NREP(31); ++rep_) cast_bf16(A.in[I_X], (bf16*)(ws + WS_A), (size_t)T * D / 8, gtid, gthreads);
    { const float* wq = A.in[I_PWQ]; const float* keys = A.in[I_PKEYS]; bf16* wp = (bf16*)(ws + WS_WP);
      for (int it0 = gw; it0 < 1024 * NREP(30); it0 += NGW) { const int it = it0 & 1023;
          const int hc = it >> 6, jb = (it >> 2) & 15, nq = it & 3, j = jb * 64 + lane;
          const f32x4* wr_ = (const f32x4*)(wq + (size_t)j * 2048 + hc * 128);
          f32x4 w[32];
#pragma unroll
          for (int d = 0; d < 32; ++d) w[d] = wr_[d];
#pragma unroll 1
          for (int n = nq * 32; n < nq * 32 + 32; ++n) {
              const f32x4* kr = (const f32x4*)(keys + (size_t)(hc * 128 + n) * 128);
              float a0 = 0.f, a1 = 0.f, a2 = 0.f, a3 = 0.f;
#pragma unroll
              for (int d = 0; d < 32; ++d) { const f32x4 k = kr[d]; a0 += w[d][0] * k[0]; a1 += w[d][1] * k[1]; a2 += w[d][2] * k[2]; a3 += w[d][3] * k[3]; }
              wp[(size_t)(hc * 128 + n) * 1024 + j] = (bf16)f2bf((a0 + a1) + (a2 + a3));
          }
      } }
    { const float* relb = A.in[I_RELB]; float* bd = (float*)(ws + WS_BIASD); float* bl = (float*)(ws + WS_BIASL);
      for (size_t i = gtid; i < 4 * BIAS_TAB; i += gthreads) { const int h = (int)(i / BIAS_TAB), dist = (int)(i % BIAS_TAB) - BIAS_GUARD; bd[i] = dist < 0 ? 0.f : relb[rel_bucket(dist) * 16 + h] * LOG2E; }
      for (size_t i = gtid; i < 12 * 132; i += gthreads) { const int gh = (int)(i / 132), j = (int)(i % 132), g = gh >> 2; const int dl = (g == 0) ? 1 : (g == 1) ? 4 : 16;
          bl[i] = relb[rel_bucket((j > 128 ? 128 : j) * dl) * 16 + 4 + gh] * LOG2E; } }
}

__device__ __forceinline__ void p5_ln1(const Args& A, int vcu, int G, int wave, int lane) {
    unsigned char* ws = A.ws;
    const int gw = vcu * NWAVES + wave, NGW = G * NWAVES;
    const float* R = (const float*)(ws + WS_R); bf16* x1b = (bf16*)(ws + WS_A);
    const float* gam = A.in[I_LN1G]; const float* bet = A.in[I_LN1B];
    f32x4 gv[4], bv[4];
#pragma unroll
    for (int j = 0; j < 4; ++j) { gv[j] = *(const f32x4*)(gam + 256 * j + 4 * lane); bv[j] = *(const f32x4*)(bet + 256 * j + 4 * lane); }
    for (int mrow = gw; mrow < T; mrow += NGW) {
        const f32x4* xr = (const f32x4*)(R + (size_t)mrow * D) + lane;
        f32x4 v[4]; float s = 0.f;
#pragma unroll
        for (int j = 0; j < 4; ++j) { v[j] = xr[64 * j]; s += (v[j][0] + v[j][1]) + (v[j][2] + v[j][3]); }
        const float mean = wave_sum(s) * (1.f / D); float s2 = 0.f;
#pragma unroll
        for (int j = 0; j < 4; ++j) { v[j] = v[j] - mean; s2 += (v[j][0] * v[j][0] + v[j][1] * v[j][1]) + (v[j][2] * v[j][2] + v[j][3] * v[j][3]); }
        const float rstd = __builtin_amdgcn_rsqf(wave_sum(s2) * (1.f / D) + LN_EPS);
        f32x4* orow = (f32x4*)(A.out + (size_t)mrow * D) + lane; v2u* brow = (v2u*)(x1b + (size_t)mrow * D) + lane;
#pragma unroll
        for (int j = 0; j < 4; ++j) { const f32x4 y = v[j] * rstd * gv[j] + bv[j]; orow[64 * j] = y; v2u w; w.x = pk2(y[0], y[1]); w.y = pk2(y[2], y[3]); brow[64 * j] = w; }
    }
}
namespace peer {
__device__ __forceinline__ int mono(float v) { const int b = __float_as_int(v); return b ^ ((b >> 31) & 0x7fffffff); }
__device__ __forceinline__ float unmono(int k) { return __int_as_float(k ^ ((k >> 31) & 0x7fffffff)); }
__device__ __forceinline__ int med3i(int a, int b, int c) { int r; asm("v_med3_i32 %0, %1, %2, %3" : "=v"(r) : "v"(a), "v"(b), "v"(c)); return r; }
#define PEER_INS16(a, x) do { _Pragma("unroll") for (int k_ = 15; k_ >= 1; --k_) a[k_] = med3i(a[k_ - 1], a[k_], (x)); a[0] = max(a[0], (x)); } while (0)
__device__ __forceinline__ unsigned byte_sel(const unsigned (&p)[4], int i) { const int w = i >> 2; const unsigned x = (w == 0) ? p[0] : (w == 1) ? p[1] : (w == 2) ? p[2] : p[3]; return (x >> ((i & 3) * 8)) & 0xffu; }
__device__ __forceinline__ float gelu_erf(float v) { return 0.5f * v * (1.f + erff(v * 0.7071067811865476f)); }

__device__ __forceinline__ void select(const float* ST, v2u* sel, int tok, int head) {
    int a0[16], a1[16];
#pragma unroll
    for (int k = 0; k < 16; ++k) { a0[k] = (int)0x80000000; a1[k] = (int)0x80000000; }
    const float* s0 = ST + (size_t)(head * 256) * T + tok; const float* s1 = s0 + (size_t)128 * T;
#pragma unroll 8
    for (int n = 0; n < 128; ++n) { const int k = (mono(s0[(size_t)n * T]) & ~127) | (127 - n); PEER_INS16(a0, k); }
#pragma unroll 8
    for (int n = 0; n < 128; ++n) { const int k = (mono(s1[(size_t)n * T]) & ~127) | (127 - n); PEER_INS16(a1, k); }
    float v0[16], v1[16]; unsigned i0p[4] = {0u, 0u, 0u, 0u}, i1p[4] = {0u, 0u, 0u, 0u};
#pragma unroll
    for (int k = 0; k < 16; ++k) { v0[k] = unmono((a0[k] & ~127) | 64); v1[k] = unmono((a1[k] & ~127) | 64);
        i0p[k >> 2] |= (unsigned)(127 - (a0[k] & 127)) << (8 * (k & 3)); i1p[k >> 2] |= (unsigned)(127 - (a1[k] & 127)) << (8 * (k & 3)); }
    int cd[16];
#pragma unroll
    for (int k = 0; k < 16; ++k) cd[k] = (int)0x80000000;
#pragma unroll
    for (int i = 0; i < 16; ++i)
#pragma unroll
        for (int j = 0; j < 16; ++j)
            if ((i + 1) * (j + 1) <= 16) { const int k = (mono(v0[i] + v1[j]) & ~255) | (255 - (i * 16 + j)); PEER_INS16(cd, k); }
    float sv[16], ex[16], sum = 0.f; unsigned eid[16];
#pragma unroll
    for (int k = 0; k < 16; ++k) { const int code = 255 - (cd[k] & 255); eid[k] = byte_sel(i0p, code >> 4) * 128u + byte_sel(i1p, code & 15); sv[k] = unmono((cd[k] & ~255) | 128); }
#pragma unroll
    for (int k = 0; k < 16; ++k) { ex[k] = __expf(sv[k] - sv[0]); sum += ex[k]; }
    const float rs = 1.f / sum;
    v4u* dst = (v4u*)(sel + ((size_t)tok * 8 + head) * 16);
#pragma unroll
    for (int k = 0; k < 8; ++k) { v4u w; w.x = eid[2 * k]; w.y = __float_as_uint(ex[2 * k] * rs); w.z = eid[2 * k + 1]; w.w = __float_as_uint(ex[2 * k + 1] * rs); dst[k] = w; }
}

typedef float f32x2v __attribute__((ext_vector_type(2)));
__device__ __forceinline__ void gather_token(const v2u* sel, const unsigned char* U8, const unsigned char* V8, const float* isu, const float* isv, float* xo, const float* gam, const float* bet, int tok, int lane) {
    float* xrow = xo + (size_t)tok * D + 16 * lane;
    f32x4 xv[4];
#pragma unroll
    for (int q = 0; q < 4; ++q) xv[q] = *(const f32x4*)(xrow + 4 * q);
    float acc[16];
#pragma unroll
    for (int k = 0; k < 16; ++k) acc[k] = 0.f;
    for (int head = 0; head < 8; ++head) {
        const v2u se = sel[((size_t)tok * 8 + head) * 16 + (lane & 15)];
        const unsigned eq = (unsigned)__shfl((int)se.x, lane >> 2);
        const float su = isu[eq], sv = isv[eq];
        float part[16];
        {
            v4u uu[16];
#pragma unroll
            for (int k = 0; k < 16; ++k) { const unsigned e = __builtin_amdgcn_readlane(se.x, k); uu[k] = *(const v4u*)(U8 + (size_t)e * D + 16 * lane); }
#pragma unroll
            for (int k = 0; k < 16; ++k) { float d0 = 0.f, d1 = 0.f;
#pragma unroll
                for (int q = 0; q < 4; ++q) { const unsigned w = uu[k][q]; const f32x2v a = __builtin_amdgcn_cvt_pk_f32_fp8((int)w, false), b = __builtin_amdgcn_cvt_pk_f32_fp8((int)w, true);
                    d0 += xv[q][0] * a[0]; d1 += xv[q][1] * a[1]; d0 += xv[q][2] * b[0]; d1 += xv[q][3] * b[1]; }
                part[k] = d0 + d1; }
        }
        float r8[8], r4[4], r2[2], r1;
#pragma unroll
        for (int i = 0; i < 8; ++i) { const bool up = (lane & 32) != 0; const float send = up ? part[i] : part[i + 8], keep = up ? part[i + 8] : part[i]; r8[i] = keep + __shfl_xor(send, 32); }
#pragma unroll
        for (int i = 0; i < 4; ++i) { const bool up = (lane & 16) != 0; const float send = up ? r8[i] : r8[i + 4], keep = up ? r8[i + 4] : r8[i]; r4[i] = keep + __shfl_xor(send, 16); }
#pragma unroll
        for (int i = 0; i < 2; ++i) { const bool up = (lane & 8) != 0; const float send = up ? r4[i] : r4[i + 2], keep = up ? r4[i + 2] : r4[i]; r2[i] = keep + __shfl_xor(send, 8); }
        { const bool up = (lane & 4) != 0; const float send = up ? r2[0] : r2[1], keep = up ? r2[1] : r2[0]; r1 = keep + __shfl_xor(send, 4); }
        r1 += __shfl_xor(r1, 2); r1 += __shfl_xor(r1, 1);
        const float gq = __uint_as_float((unsigned)__shfl((int)se.y, lane >> 2));
        const float wgt = gq * gelu_erf(r1 * su) * sv;
        {
            v4u vv[16];
#pragma unroll
            for (int k = 0; k < 16; ++k) { const unsigned e = __builtin_amdgcn_readlane(se.x, k); vv[k] = *(const v4u*)(V8 + (size_t)e * D + 16 * lane); }
#pragma unroll
            for (int k = 0; k < 16; ++k) { const float w = __uint_as_float(__builtin_amdgcn_readlane(__float_as_uint(wgt), 4 * k));
#pragma unroll
                for (int q = 0; q < 4; ++q) { const unsigned x = vv[k][q]; const f32x2v a = __builtin_amdgcn_cvt_pk_f32_fp8((int)x, false), b = __builtin_amdgcn_cvt_pk_f32_fp8((int)x, true);
                    acc[4 * q] += w * a[0]; acc[4 * q + 1] += w * a[1]; acc[4 * q + 2] += w * b[0]; acc[4 * q + 3] += w * b[1]; } }
        }
    }
    float rr[16], s = 0.f;
#pragma unroll
    for (int k = 0; k < 16; ++k) { rr[k] = ALPHA * xv[k >> 2][k & 3] + acc[k]; s += rr[k]; }
    const float mean = wave_sum(s) * (1.f / D); float s2 = 0.f;
#pragma unroll
    for (int k = 0; k < 16; ++k) { rr[k] -= mean; s2 += rr[k] * rr[k]; }
    const float rstd = __builtin_amdgcn_rsqf(wave_sum(s2) * (1.f / D) + LN_EPS);
#pragma unroll
    for (int q = 0; q < 4; ++q) { const f32x4 g = *(const f32x4*)(gam + 16 * lane + 4 * q), bb = *(const f32x4*)(bet + 16 * lane + 4 * q);
        f32x4 y; y[0] = rr[4 * q] * rstd * g[0] + bb[0]; y[1] = rr[4 * q + 1] * rstd * g[1] + bb[1]; y[2] = rr[4 * q + 2] * rstd * g[2] + bb[2]; y[3] = rr[4 * q + 3] * rstd * g[3] + bb[3];
        *(f32x4*)(xrow + 4 * q) = y; }
}
typedef float f32x2w __attribute__((ext_vector_type(2)));
struct G4 { const unsigned char* U8; const unsigned char* V8; const float* isu; const float* isv; };
__device__ __forceinline__ v2u peer_ec(const v2u lo, const v2u hi, int c) { const unsigned mk = (c < 4) ? 0xffffffffu : 0u; v2u r; r.x = (lo.x & mk) | (hi.x & ~mk); r.y = (lo.y & mk) | (hi.y & ~mk); return r; }
#define PEER_EC(en, c) peer_ec((en)[0], (en)[1], (c))
__device__ __forceinline__ void a_load(v4u (&uu)[16], const v2u ec, int c, const unsigned char* U8, int lane) {
#pragma unroll
    for (int j = 0; j < 16; ++j) { const unsigned e = __builtin_amdgcn_readlane(ec.x, 16 * (c & 3) + j); uu[j] = *(const v4u*)(U8 + (size_t)e * D + 16 * lane); }
}
__device__ __forceinline__ void a_step(const v4u (&uu)[16], v2u (&en)[2], int c, const LAS f32x4* xl, const G4& T, int lane) {
    const v2u ec = PEER_EC(en, c);
    const int ls = 16 * (c & 3) + (lane >> 2);
    const unsigned eq = (unsigned)__shfl((int)ec.x, ls); const float gq = __uint_as_float((unsigned)__shfl((int)ec.y, ls));
    const float su = T.isu[eq], sv = T.isv[eq];
    f32x4 xv[4];
#pragma unroll
    for (int q = 0; q < 4; ++q) xv[q] = xl[q * 64];
    float part[16];
#pragma unroll
    for (int j = 0; j < 16; ++j) { f32x2w d = {0.f, 0.f};
#pragma unroll
        for (int q = 0; q < 4; ++q) { const unsigned w = uu[j][q]; const f32x2w a = __builtin_amdgcn_cvt_pk_f32_fp8((int)w, false), b = __builtin_amdgcn_cvt_pk_f32_fp8((int)w, true);
            d += (f32x2w){xv[q][0], xv[q][1]} * a; d += (f32x2w){xv[q][2], xv[q][3]} * b; }
        part[j] = d[0] + d[1]; }
    float r8[8], r4[4], r2[2], r1;
#pragma unroll
    for (int i = 0; i < 8; ++i) { const bool up = (lane & 32) != 0; const float send = up ? part[i] : part[i + 8], keep = up ? part[i + 8] : part[i]; r8[i] = keep + __shfl_xor(send, 32); }
#pragma unroll
    for (int i = 0; i < 4; ++i) { const bool up = (lane & 16) != 0; const float send = up ? r8[i] : r8[i + 4], keep = up ? r8[i + 4] : r8[i]; r4[i] = keep + __shfl_xor(send, 16); }
#pragma unroll
    for (int i = 0; i < 2; ++i) { const bool up = (lane & 8) != 0; const float send = up ? r4[i] : r4[i + 2], keep = up ? r4[i + 2] : r4[i]; r2[i] = keep + __shfl_xor(send, 8); }
    { const bool up = (lane & 4) != 0; const float send = up ? r2[0] : r2[1], keep = up ? r2[1] : r2[0]; r1 = keep + __shfl_xor(send, 4); }
    r1 += __shfl_xor(r1, 2); r1 += __shfl_xor(r1, 1);
    const float wgt = gq * gelu_erf(r1 * su) * sv;
    const int rel = lane - 16 * (c & 3);
    const float wv = __shfl(wgt, 4 * (rel & 15));
    const bool mine = (rel >= 0) && (rel < 16);
    const bool lo_ = mine && (c < 4), hi_ = mine && (c >= 4);
    en[0].y = lo_ ? __float_as_uint(wv) : en[0].y; en[1].y = hi_ ? __float_as_uint(wv) : en[1].y;
}
__device__ __forceinline__ void b_load8(v4u (&vv)[8], const v2u ec, int c, int h8, const unsigned char* V8, int lane) {
#pragma unroll
    for (int j = 0; j < 8; ++j) { const unsigned e = __builtin_amdgcn_readlane(ec.x, 16 * (c & 3) + 8 * h8 + j); vv[j] = *(const v4u*)(V8 + (size_t)e * D + 16 * lane); }
}
__device__ __forceinline__ void b_step8(const v4u (&vv)[8], const v2u ec, int c, int h8, f32x2w (&acc)[8]) {
#pragma unroll
    for (int j = 0; j < 8; ++j) { const float w = __uint_as_float(__builtin_amdgcn_readlane(ec.y, 16 * (c & 3) + 8 * h8 + j)); const f32x2w w2 = {w, w};
#pragma unroll
        for (int q = 0; q < 4; ++q) { const unsigned x = vv[j][q]; const f32x2w a = __builtin_amdgcn_cvt_pk_f32_fp8((int)x, false), b = __builtin_amdgcn_cvt_pk_f32_fp8((int)x, true);
            acc[2 * q] += w2 * a; acc[2 * q + 1] += w2 * b; } }
}
__device__ __forceinline__ void b_load(v4u (&vv)[16], const v2u ec, int c, const unsigned char* V8, int lane) {
#pragma unroll
    for (int j = 0; j < 16; ++j) { const unsigned e = __builtin_amdgcn_readlane(ec.x, 16 * (c & 3) + j); vv[j] = *(const v4u*)(V8 + (size_t)e * D + 16 * lane); }
}
__device__ __forceinline__ void b_step(const v4u (&vv)[16], const v2u ec, int c, f32x2w (&acc)[8]) {
#pragma unroll
    for (int j = 0; j < 16; ++j) { const float w = __uint_as_float(__builtin_amdgcn_readlane(ec.y, 16 * (c & 3) + j)); const f32x2w w2 = {w, w};
#pragma unroll
        for (int q = 0; q < 4; ++q) { const unsigned x = vv[j][q]; const f32x2w a = __builtin_amdgcn_cvt_pk_f32_fp8((int)x, false), b = __builtin_amdgcn_cvt_pk_f32_fp8((int)x, true);
            acc[2 * q] += w2 * a; acc[2 * q + 1] += w2 * b; } }
}
__device__ __forceinline__ void tok_finish(const LAS f32x4* xl, const f32x2w (&acc)[8], float* xrow, const float* gam, const float* bet, int lane) {
    float rr[16], s = 0.f;
#pragma unroll
    for (int q = 0; q < 4; ++q) { const f32x4 xv = xl[q * 64];
#pragma unroll
        for (int e = 0; e < 4; ++e) { const int k = 4 * q + e; rr[k] = ALPHA * xv[e] + acc[k >> 1][k & 1]; s += rr[k]; } }
    const float mean = wave_sum(s) * (1.f / D); float s2 = 0.f;
#pragma unroll
    for (int k = 0; k < 16; ++k) { rr[k] -= mean; s2 += rr[k] * rr[k]; }
    const float rstd = __builtin_amdgcn_rsqf(wave_sum(s2) * (1.f / D) + LN_EPS);
#pragma unroll
    for (int q = 0; q < 4; ++q) { const f32x4 g = *(const f32x4*)(gam + 16 * lane + 4 * q), bb = *(const f32x4*)(bet + 16 * lane + 4 * q);
        f32x4 y; y[0] = rr[4 * q] * rstd * g[0] + bb[0]; y[1] = rr[4 * q + 1] * rstd * g[1] + bb[1]; y[2] = rr[4 * q + 2] * rstd * g[2] + bb[2]; y[3] = rr[4 * q + 3] * rstd * g[3] + bb[3];
        *(f32x4*)(xrow + 4 * q) = y; }
}
__device__ __forceinline__ void gather4(const v2u* sel, const G4& T, float* xo, const float* gam, const float* bet, int tok0, int lane, LAS f32x4* xl, LAS v2u* srt) {
    v2u en[4][2];
#pragma unroll
    for (int tt = 0; tt < 4; ++tt) { const float* xrow = xo + (size_t)(tok0 + tt) * D + 16 * lane;
#pragma unroll
        for (int q = 0; q < 4; ++q) xl[tt * 256 + q * 64] = *(const f32x4*)(xrow + 4 * q);
        const v2u e0 = sel[(size_t)(tok0 + tt) * 128 + lane], e1 = sel[(size_t)(tok0 + tt) * 128 + 64 + lane];
        const unsigned b0 = e0.x >> 9, b1 = e1.x >> 9; unsigned d0 = 0u, d1 = 0u, base = 0u;
#pragma unroll
        for (unsigned k = 0; k < 32; ++k) { const unsigned long long m0 = __ballot(b0 == k), m1 = __ballot(b1 == k);
            const unsigned c0 = (unsigned)__builtin_popcountll(m0), c1 = (unsigned)__builtin_popcountll(m1);
            const unsigned p0 = __builtin_amdgcn_mbcnt_hi((unsigned)(m0 >> 32), __builtin_amdgcn_mbcnt_lo((unsigned)m0, 0u)), p1 = __builtin_amdgcn_mbcnt_hi((unsigned)(m1 >> 32), __builtin_amdgcn_mbcnt_lo((unsigned)m1, 0u));
            d0 = (b0 == k) ? base + p0 : d0; d1 = (b1 == k) ? base + c0 + p1 : d1; base += c0 + c1; }
        srt[d0] = e0; srt[d1] = e1;
        asm volatile("s_waitcnt lgkmcnt(0)" ::: "memory");
        en[tt][0] = srt[lane]; en[tt][1] = srt[64 + lane];
        asm volatile("s_waitcnt lgkmcnt(0)" ::: "memory");
    }
    {
#pragma unroll 1
        for (int c = 0; c < 8; ++c) {
            v4u ua[16], ub[16];
            a_load(ua, PEER_EC(en[0], c), c, T.U8, lane); a_load(ub, PEER_EC(en[1], c), c, T.U8, lane); __builtin_amdgcn_sched_barrier(0);
            a_step(ua, en[0], c, xl + 0 * 256, T, lane); __builtin_amdgcn_sched_barrier(0);
            a_load(ua, PEER_EC(en[2], c), c, T.U8, lane); __builtin_amdgcn_sched_barrier(0);
            a_step(ub, en[1], c, xl + 1 * 256, T, lane); __builtin_amdgcn_sched_barrier(0);
            a_load(ub, PEER_EC(en[3], c), c, T.U8, lane); __builtin_amdgcn_sched_barrier(0);
            a_step(ua, en[2], c, xl + 2 * 256, T, lane); __builtin_amdgcn_sched_barrier(0);
            a_step(ub, en[3], c, xl + 3 * 256, T, lane); __builtin_amdgcn_sched_barrier(0);
        }
    }
    f32x2w acc[4][8];
#pragma unroll
    for (int tt = 0; tt < 4; ++tt)
#pragma unroll
        for (int q = 0; q < 8; ++q) acc[tt][q] = (f32x2w){0.f, 0.f};
    {
#define PEER_SB() __builtin_amdgcn_sched_barrier(0)
#pragma unroll 1
        for (int c = 0; c < 8; ++c) {
            const v2u e0 = PEER_EC(en[0], c), e1 = PEER_EC(en[1], c), e2 = PEER_EC(en[2], c), e3 = PEER_EC(en[3], c);
            v4u va[8], vb[8], vc[8];
            b_load8(va, e0, c, 0, T.V8, lane); b_load8(vb, e0, c, 1, T.V8, lane); PEER_SB();
            b_load8(vc, e1, c, 0, T.V8, lane); PEER_SB(); b_step8(va, e0, c, 0, acc[0]); PEER_SB();
            b_load8(va, e1, c, 1, T.V8, lane); PEER_SB(); b_step8(vb, e0, c, 1, acc[0]); PEER_SB();
            b_load8(vb, e2, c, 0, T.V8, lane); PEER_SB(); b_step8(vc, e1, c, 0, acc[1]); PEER_SB();
            b_load8(vc, e2, c, 1, T.V8, lane); PEER_SB(); b_step8(va, e1, c, 1, acc[1]); PEER_SB();
            b_load8(va, e3, c, 0, T.V8, lane); PEER_SB(); b_step8(vb, e2, c, 0, acc[2]); PEER_SB();
            b_load8(vb, e3, c, 1, T.V8, lane); PEER_SB(); b_step8(vc, e2, c, 1, acc[2]); PEER_SB();
            b_step8(va, e3, c, 0, acc[3]); PEER_SB(); b_step8(vb, e3, c, 1, acc[3]); PEER_SB();
        }
#undef PEER_SB
    }
#pragma unroll
    for (int tt = 0; tt < 4; ++tt) tok_finish(xl + tt * 256, acc[tt], xo + (size_t)(tok0 + tt) * D + 16 * lane, gam, bet, lane);
}
#undef PEER_EC
__device__ __forceinline__ void row_to_fp8(const float* src, unsigned char* dst, float* inv, int row, int lane) {
    const float* p = src + (size_t)row * D + 16 * lane;
    f32x4 v[4]; float am = 0.f;
#pragma unroll
    for (int q = 0; q < 4; ++q) { v[q] = *(const f32x4*)(p + 4 * q); am = fmaxf(am, fmaxf(fmaxf(fabsf(v[q][0]), fabsf(v[q][1])), fmaxf(fabsf(v[q][2]), fabsf(v[q][3])))); }
    am = wave_max(am);
    float s = 1.f, is = 1.f;
    if (am > 1e-30f) { const int eb = (__float_as_int(224.f / am) >> 23) & 0xff; if (eb > 0 && eb < 254) { s = __int_as_float(eb << 23); is = __int_as_float((254 - eb) << 23); } }
    v4u o;
#pragma unroll
    for (int q = 0; q < 4; ++q) { int w = 0; w = __builtin_amdgcn_cvt_pk_fp8_f32(v[q][0] * s, v[q][1] * s, w, false); w = __builtin_amdgcn_cvt_pk_fp8_f32(v[q][2] * s, v[q][3] * s, w, true); o[q] = (unsigned)w; }
    *(v4u*)(dst + (size_t)row * D + 16 * lane) = o;
    if (lane == 0) inv[row] = is;
}
}
constexpr int NPH = 8;
__global__ void __launch_bounds__(NWAVES * 64, 2) mk_fwd(Args args) {
    extern __shared__ __attribute__((aligned(16))) unsigned char lds_raw[];
    LAS unsigned char* lds = (LAS unsigned char*)lds_raw;
    volatile LAS unsigned* MISC = (volatile LAS unsigned*)(lds + MISC_OFF);
    const int tid0 = threadIdx.x, lane0 = tid0 & 63, wave = __builtin_amdgcn_readfirstlane(tid0 >> 6);
    const int G = gridDim.x, bx = blockIdx.x, vcu = (G % 8 == 0) ? (bx % 8) * (G / 8) + bx / 8 : bx;
    unsigned char* ws0 = args.ws;
    gu32* ctl = (gu32*)(ws0 + WS_CTL);
    for (int u = tid0; u < (LDS_BYTES - RING_BYTES) / 4; u += NWAVES * 64) ((LAS unsigned*)(lds + RING_BYTES))[u] = 0u;
    __syncthreads();
    XcdBarrier bar; bar.bar = (unsigned*)(ctl + CW_BAR); bar.x = 0; bar.st = nullptr;
    if (MK_N_LAUNCHES == 1) bar = xcd_barrier_post((unsigned*)(ctl + CW_BAR), MISC + 8);
    const int lo = args.ph_lo, hi = args.ph_hi;
#ifndef PH_MASK
#define PH_MASK 0xFF
#endif
#define IN(k) ((((PH_MASK) >> (k)) & 1) && lo <= (k) && (k) < hi)
#define SEAM(k) do { if (IN(k) && IN((k) + 1)) xcd_barrier(bar); } while (0)
    const int NGW = G * NWAVES;
#define SUB_BEGIN() unsigned char* ws = ws0; asm volatile("" : "+s"(ws)); const int lane = (int)__builtin_amdgcn_mbcnt_hi(~0u, __builtin_amdgcn_mbcnt_lo(~0u, 0u)), tid = wave * 64 + lane; (void)tid; (void)lane
#define PHASE_BEGIN() unsigned char* ws = ws0; asm volatile("" : "+s"(ws)); const int lane = (int)__builtin_amdgcn_mbcnt_hi(~0u, __builtin_amdgcn_mbcnt_lo(~0u, 0u)), tid = wave * 64 + lane; const int gw = vcu * NWAVES + wave; (void)gw; (void)lane; (void)tid

    if (IN(0)) { PHASE_BEGIN(); p0_prologue(args, lds, vcu, G, wave, lane); VM_WAIT(); __syncthreads(); SEAM(0); }

    if (IN(1)) { PHASE_BEGIN();
        pg8::Gemm g{(const pg8::bf16_t*)(ws + WS_A), (const pg8::bf16_t*)(ws + WS_WIN), T, INC, D}; pg8::StaticOrder S; S.init(T, INC, G, bx); S.rep = NREP(1);
        pg8::EpiInProj E{(pg8::bf16_t*)(ws + WS_QD), (pg8::bf16_t*)(ws + WS_KD), (pg8::bf16_t*)(ws + WS_VD), (pg8::bf16_t*)(ws + WS_LQ), (pg8::bf16_t*)(ws + WS_LK), (pg8::bf16_t*)(ws + WS_LV),
                         (pg8::bf16_t*)(ws + WS_GA), (pg8::bf16_t*)(ws + WS_GB)};
        pg8::gemm_phase<pg8::EpiInProj, pg8::StaticOrder, true, true>(lds, g, S, E);
        {
            const int nwg = (T / 256) * (INC / 256), rem = nwg % G, nshort = rem ? G - rem : G, first = rem ? rem : 0;
            if (bx >= first) { const int cw = (bx - first) * NWAVES + wave, ncw = nshort * NWAVES;
                for (int row = cw; row < 2 * NEXP; row += ncw) {
                    if (row < NEXP) peer::row_to_fp8(args.in[I_PU], ws + WS_UU, (float*)(ws + WS_ISU), row, lane);
                    else peer::row_to_fp8(args.in[I_PV], ws + WS_UV, (float*)(ws + WS_ISV), row - NEXP, lane);
                } }
        }
        SEAM(1);
    }

    if (IN(2)) { PHASE_BEGIN();
#ifndef NO_DIFF
        {   SUB_BEGIN();
            const da::Tensors X{(const bf16*)(ws + WS_QD), (const bf16*)(ws + WS_KD), (const bf16*)(ws + WS_VD), (float*)(ws + WS_STASH), (bf16*)(ws + WS_YA),
                                args.in[I_DLAM], args.in[I_SUBG], args.in[I_RELB]};
            int cur_h = -1;
            float lam; { const float* dl = args.in[I_DLAM]; const float p1 = dl[lane] * dl[64 + lane], p2 = dl[128 + lane] * dl[192 + lane];
                lam = __uint_as_float(__builtin_amdgcn_readfirstlane(__float_as_uint(__expf(wave_sum(p1)) - __expf(wave_sum(p2)) + LAM_INIT))); }
            for (int rep_ = 0; rep_ < NREP(20); ++rep_)
            for (int p = vcu; p < 256; p += G) {
                const int bh = p >> 5, s = p & 31, b = bh >> 2, h = bh & 3;
                if (h != cur_h) {
                    __syncthreads();
                    const float* bd = (const float*)(ws + WS_BIASD) + h * BIAS_TAB; asm volatile("" : "+s"(bd));
                    for (int i = tid; i < BIAS_TAB; i += NWAVES * 64) ((LAS float*)(lds + da::LDS_BIAS))[i] = bd[i];
                    __syncthreads(); cur_h = h;
                }
                const float c31 = args.in[I_RELB][31 * 16 + h] * LOG2E;
                for (int k2 = 0; k2 < 2; ++k2) da::unit(X, b, h, k2 ? 63 - s : s, lds, bx, lam, c31);
            }
        }
#endif
#ifndef NO_DIL
        {   SUB_BEGIN();
            const dil::Tensors X{(const bf16*)(ws + WS_LQ), (const bf16*)(ws + WS_LK), (const bf16*)(ws + WS_LV), (bf16*)(ws + WS_YB)};
            int cur_h = -1;
            for (int rep_ = 0; rep_ < NREP(21); ++rep_)
            for (int u = vcu; u < 256; u += G) {
                const int bh = u >> 5, blk = u & 31, b = bh >> 2, h = bh & 3;
                if (h != cur_h) {
                    __syncthreads();
                    const float* blsrc = (const float*)(ws + WS_BIASL);
                    for (int i = tid; i < 3 * dil::BT; i += NWAVES * 64) { const int g = i / dil::BT, jj = i % dil::BT - dil::BT0;
                        ((LAS float*)(lds + dil::LDS_BL))[i] = (jj >= 0 && jj <= 128) ? blsrc[(g * 4 + h) * 132 + jj] : 0.f; }
                    __syncthreads(); cur_h = h;
                }
                float* lse0 = (float*)(ws + WS_LSE0);
                for (int k2 = 0; k2 < 2; ++k2) dil::wave_tile_g0(X, lse0, b, h, blk * 512 + (wave + 8 * k2) * 32, lds + dil::LDS_VST + wave * 4096, (const LAS float*)(lds + dil::LDS_BL), lane);
                VM_WAIT(); __syncthreads();
                for (int k2 = 0; k2 < 2; ++k2) dil::wave_tile(X, lse0, b, h, blk * 512, wave + 8 * k2, lds + dil::LDS_VST + wave * 4096, (const LAS float*)(lds + dil::LDS_BL), lane);
            }
            __syncthreads();
        }
#endif
        SEAM(2);
    }

    if (IN(3)) { PHASE_BEGIN();
        { pg8::Gemm g{(const pg8::bf16_t*)(ws + WS_YA), (const pg8::bf16_t*)(ws + WS_WBD), T, D, 512}; pg8::StaticOrder S; S.init(T, D, G, bx); S.rep = NREP(3);
          pg8::EpiGate1 E{(const pg8::bf16_t*)(ws + WS_GA), (pg8::bf16_t*)(ws + WS_GATED)};
          pg8::gemm_phase<pg8::EpiGate1, pg8::StaticOrder, true, true>(lds, g, S, E); }
        VM_WAIT(); __syncthreads();
        { pg8::Gemm g{(const pg8::bf16_t*)(ws + WS_YB), (const pg8::bf16_t*)(ws + WS_WBL), T, D, 256}; pg8::StaticOrder S; S.init(T, D, G, bx);
          pg8::EpiGate2 E{(const pg8::bf16_t*)(ws + WS_GB), (pg8::bf16_t*)(ws + WS_GATED)};
          pg8::gemm_phase<pg8::EpiGate2, pg8::StaticOrder, true, true>(lds, g, S, E); }
        SEAM(3);
    }

    if (IN(4)) { PHASE_BEGIN();
        pg8::Gemm g{(const pg8::bf16_t*)(ws + WS_GATED), (const pg8::bf16_t*)(ws + WS_WO), T, D, D}; pg8::StaticOrder S; S.init(T, D, G, bx); S.rep = NREP(4);
        pg8::EpiOut E{args.in[I_X], (float*)(ws + WS_R)};
        pg8::gemm_phase<pg8::EpiOut, pg8::StaticOrder, true, true>(lds, g, S, E);
        SEAM(4);
    }

    if (IN(5)) { PHASE_BEGIN();
        p5_ln1(args, vcu, G, wave, lane);
        SEAM(5);
    }

    if (IN(6)) { PHASE_BEGIN();
        pg8::Gemm g{(const pg8::bf16_t*)(ws + WS_WP), (const pg8::bf16_t*)(ws + WS_A), 2048, T, D}; pg8::StaticOrder S; S.init(2048, T, G, bx); S.rep = NREP(6);
        pg8::EpiScoreT E{(float*)(ws + WS_ST)};
        pg8::gemm_phase<pg8::EpiScoreT, pg8::StaticOrder, true, true>(lds, g, S, E);
        SEAM(6);
    }

    if (IN(7)) { PHASE_BEGIN();
        const float* ST = (const float*)(ws + WS_ST); v2u* sel = (v2u*)(ws + WS_SEL);
        for (int u = vcu; u < T / 128; u += G) {
            for (int p = 0; p < 2; ++p) peer::select(ST, sel, u * 128 + p * 64 + lane, wave);
            VM_WAIT(); __syncthreads();
            { const peer::G4 TB{ws + WS_UU, ws + WS_UV, (const float*)(ws + WS_ISU), (const float*)(ws + WS_ISV)};
              for (int i = 0; i < 4; ++i) peer::gather4(sel, TB, args.out, args.in[I_LN2G], args.in[I_LN2B], u * 128 + i * 32 + wave * 4, lane, (LAS f32x4*)(lds + wave * 16384) + lane, (LAS v2u*)(lds + RING_BYTES + 2048 + wave * 1024)); }
            VM_WAIT(); __syncthreads();
        }
    }
#undef IN
#undef SEAM
}

extern "C" void kernel_launch(void* const* d_in, const int* in_sizes, int n_in, void* d_out, int out_size, void* d_ws, size_t ws_size, hipStream_t stream) {
    static int grid = 0;
    if (grid == 0) {
        if (n_in != 16 || in_sizes[0] != T * D || out_size != T * D || ws_size < WS_END) { fprintf(stderr, "kernel_launch: unexpected shapes (n_in %d, in0 %d, out %d, ws %zu); nothing launched\n", n_in, n_in > 0 ? in_sizes[0] : -1, out_size, ws_size); grid = -1; return; }
        int dev = 0, cus = 0, per_cu = 0;
        if (hipGetDevice(&dev) != hipSuccess || hipDeviceGetAttribute(&cus, hipDeviceAttributeMultiprocessorCount, dev) != hipSuccess) { grid = -1; return; }
        if (hipFuncSetAttribute((const void*)mk_fwd, hipFuncAttributeMaxDynamicSharedMemorySize, LDS_BYTES) != hipSuccess) { fprintf(stderr, "kernel_launch: hipFuncSetAttribute failed\n"); grid = -1; return; }
        if (hipOccupancyMaxActiveBlocksPerMultiprocessor(&per_cu, (const void*)mk_fwd, NWAVES * 64, LDS_BYTES) != hipSuccess || per_cu < 1) { fprintf(stderr, "kernel_launch: occupancy query reports %d\n", per_cu); per_cu = 1; }
        (void)hipGetLastError();
        grid = cus;
    }
    if (grid < 0) return;
    if (hipMemsetAsync((char*)d_ws + WS_CTL, 0, CTL_ZERO_BYTES, stream) != hipSuccess) return;
    Args a{};
    for (int i = 0; i < 16; ++i) a.in[i] = (const float*)d_in[i];
    a.out = (float*)d_out; a.ws = (unsigned char*)d_ws;
    for (int li = 0; li < MK_N_LAUNCHES; ++li) {
        a.ph_lo = (MK_N_LAUNCHES == 1) ? 0 : li; a.ph_hi = (MK_N_LAUNCHES == 1) ? NPH : li + 1;
        hipLaunchKernelGGL(mk_fwd, dim3(grid), dim3(NWAVES * 64), LDS_BYTES, stream, a);
    }
}
```

```cpp
#include <hip/hip_runtime.h>
#include <cstdio>
#include <cstdint>

#ifndef MK_N_LAUNCHES
#define MK_N_LAUNCHES 1
#endif

#ifndef REPEAT_PH
#define REPEAT_PH (-1)
#endif
#define NREP(k) ((REPEAT_PH) == (k) ? 2 : 1)

constexpr int BATCH = 2, SEQ = 16384, T = BATCH * SEQ, D = 1024, INC = 5888;
constexpr int OFF_DQ = 0, OFF_DK = 512, OFF_DV = 1024, OFF_LQ = 1536, OFF_LK = 2304, OFF_LV = 3072, OFF_GA = 3840, OFF_GB = 4864;
constexpr int NEXP = 16384;
constexpr float LOG2E = 1.4426950408889634f;
constexpr float QSCALE = 0.125f * LOG2E;
constexpr float ALPHA = 1.189207115002721f;
constexpr float LN_EPS = 1e-5f, SUBLN_EPS = 1e-5f;
constexpr float LAM_INIT = 0.2f;
constexpr int NTILE = SEQ / 64;
constexpr int BIAS_TAB = 2112, BIAS_GUARD = 256, DFAR = 1513;

constexpr size_t MiB = 1u << 20;
constexpr size_t WS_CTL = 0, CTL_ZERO_BYTES = 1 * MiB;
constexpr size_t WS_BIASD = 1 * MiB;
constexpr size_t WS_BIASL = 1 * MiB + 64 * 1024;
constexpr size_t WS_WIN = 8 * MiB, WS_WO = 20 * MiB, WS_WBD = 22 * MiB, WS_WBL = 23 * MiB, WS_WP = 24 * MiB;
constexpr size_t WS_A = 32 * MiB;
constexpr size_t WS_YA = WS_A, WS_YB = WS_A + 32 * MiB;
constexpr size_t WS_QD = 96 * MiB, WS_KD = 128 * MiB, WS_VD = 160 * MiB, WS_LQ = 192 * MiB, WS_LK = 240 * MiB, WS_LV = 288 * MiB, WS_GA = 336 * MiB, WS_GB = 400 * MiB;
constexpr size_t WS_STASH = 464 * MiB;
constexpr size_t WS_SEL = 32 * MiB;
constexpr size_t WS_GATED = 96 * MiB;
constexpr size_t WS_R = 352 * MiB;
constexpr size_t WS_ST = 96 * MiB;
constexpr size_t WS_UU = 480 * MiB, WS_UV = 496 * MiB;
constexpr size_t WS_LSE0 = 3 * MiB;
constexpr size_t WS_ISU = 2 * MiB, WS_ISV = 2 * MiB + 65536;
constexpr size_t WS_END = 512 * MiB;

constexpr int CW_BAR = 4096;
constexpr int NWAVES = 8;
constexpr int RING_BYTES = 131072, MISC_OFF = RING_BYTES + 320, LDS_BYTES = 147456;

#define GAS __attribute__((address_space(1)))
#define LAS __attribute__((address_space(3)))
typedef unsigned short bf16;
typedef unsigned v4u __attribute__((ext_vector_type(4)));
typedef unsigned v2u __attribute__((ext_vector_type(2)));
typedef float f32x4 __attribute__((ext_vector_type(4)));
typedef float f32x16 __attribute__((ext_vector_type(16)));
typedef short bf16x8 __attribute__((ext_vector_type(8)));
typedef short s16x4 __attribute__((ext_vector_type(4)));
typedef __bf16 bf16x2 __attribute__((ext_vector_type(2)));
typedef GAS unsigned gu32;
#define RLX_AGENT __ATOMIC_RELAXED, __HIP_MEMORY_SCOPE_AGENT
#define LDS_WAIT() asm volatile("s_waitcnt lgkmcnt(0)" ::: "memory")
#define VM_WAIT() asm volatile("s_waitcnt vmcnt(0)" ::: "memory")
__device__ __forceinline__ unsigned f2bf(float f) { unsigned u = __builtin_bit_cast(unsigned, f); return (u + 0x7fffu + ((u >> 16) & 1u)) >> 16; }
__device__ __forceinline__ unsigned pk2(float lo, float hi) { return f2bf(lo) | (f2bf(hi) << 16); }
typedef float f32x2_t __attribute__((ext_vector_type(2)));
__device__ __forceinline__ unsigned cvtpk(float lo, float hi) { f32x2_t v = {lo, hi}; bf16x2 b = __builtin_convertvector(v, bf16x2); return __builtin_bit_cast(unsigned, b); }
__device__ __forceinline__ float bf_lo(unsigned w) { return __builtin_bit_cast(float, w << 16); }
__device__ __forceinline__ float bf_hi(unsigned w) { return __builtin_bit_cast(float, w & 0xffff0000u); }
__device__ __forceinline__ float dot2bf(unsigned a, unsigned b, float acc) { return __builtin_amdgcn_fdot2_f32_bf16(__builtin_bit_cast(bf16x2, a), __builtin_bit_cast(bf16x2, b), acc, false); }
__device__ __forceinline__ float wave_sum(float v) {
#pragma unroll
    for (int o = 1; o < 64; o <<= 1) v += __shfl_xor(v, o);
    return v;
}
__device__ __forceinline__ float wave_max(float v) {
#pragma unroll
    for (int o = 1; o < 64; o <<= 1) v = fmaxf(v, __shfl_xor(v, o));
    return v;
}
__device__ __forceinline__ int rel_bucket(int n) {
    if (n < 16) return n < 0 ? 0 : n;
    return 16 + (n >= 22) + (n >= 30) + (n >= 40) + (n >= 54) + (n >= 73) + (n >= 99) + (n >= 134) + (n >= 182) + (n >= 246) + (n >= 332) + (n >= 450) + (n >= 609) + (n >= 825) + (n >= 1117) + (n >= 1513);
}
namespace pg8 {
#define PG8_LAS __attribute__((address_space(3)))
typedef unsigned short bf16_t;
typedef short bf16x8 __attribute__((ext_vector_type(8)));
typedef float f32x4 __attribute__((ext_vector_type(4)));
typedef unsigned u32x4 __attribute__((ext_vector_type(4)));
constexpr int BM = 256, BK = 64, HALF = 128, HTB = HALF * BK * 2  , STAGE_BYTES = 8 * HTB, NXCD = 8, WGM = 8;

__host__ __device__ __forceinline__ int lds_byte(int r, int c) { const int st = (r >> 4) * 2 + (c >> 5), rr = r & 15, cc = c & 31, ob = rr * 64 + cc * 2; return st * 1024 + (ob ^ (((ob >> 9) & 1) << 5)); }
__host__ __device__ __forceinline__ void stage_rc(int b, int& R, int& C) { const int st = b / 1024, sb = b % 1024, swz = sb ^ (((sb >> 9) & 1) << 5); R = (st >> 1) * 16 + swz / 64; C = (st & 1) * 32 + (swz % 64) / 2; }
__host__ __device__ __forceinline__ int perm32(int rho) { const int n = rho >> 4, i = rho & 15; return 8 * (i >> 2) + 4 * n + (i & 3); }

struct Unit { int pm, pn; };
struct Gemm { const bf16_t* A; const bf16_t* Bt; int M, N, K; };

struct StaticOrder {
    int nM, nN, nwg, G, c;
    __host__ __device__ void init(int M, int N, int G_, int c_) { nM = M / BM; nN = N / BM; nwg = nM * nN; G = G_; c = c_; }
    int rep = 1;
    __host__ __device__ bool next(int i0, Unit& u) const {
        const int i = i0 / rep;
        const long L = (long)i * G + c; if (L >= nwg) return false;
        int wgid = (int)L; { const int q = nwg / NXCD, r = nwg % NXCD, xcd = wgid % NXCD, off = wgid / NXCD; wgid = (xcd < r ? xcd * (q + 1) : r * (q + 1) + (xcd - r) * q) + off; }
        const int nig = WGM * nN, gid = wgid / nig, fm = gid * WGM, gsz = (nM - fm) < WGM ? (nM - fm) : WGM;
        u.pm = fm + ((wgid % nig) % gsz); u.pn = (wgid % nig) / gsz; return true;
    }
    __device__ __forceinline__ void a_ready(const Unit&) const {}
    __device__ __forceinline__ void done(const Unit&) const {}
};
__device__ __forceinline__ unsigned cvt_pk_bf16(float lo, float hi) { unsigned r; asm volatile("v_cvt_pk_bf16_f32 %0, %1, %2" : "=v"(r) : "v"(lo), "v"(hi)); return r; }
__device__ __forceinline__ u32x4 pack8(const f32x4 v0, const f32x4 v1) { u32x4 w; w.x = cvt_pk_bf16(v0[0], v0[1]); w.y = cvt_pk_bf16(v0[2], v0[3]); w.z = cvt_pk_bf16(v1[0], v1[1]); w.w = cvt_pk_bf16(v1[2], v1[3]); return w; }
__device__ __forceinline__ float blo(unsigned w) { return __builtin_bit_cast(float, w << 16); }
__device__ __forceinline__ float bhi(unsigned w) { return __builtin_bit_cast(float, w & 0xffff0000u); }
__device__ __forceinline__ float sigm(float v) { return __builtin_amdgcn_rcpf(1.f + __expf(-v)); }
template <class E> __device__ __forceinline__ void epi_loop(const E& e, const f32x4 (&acc)[2][2][4][2], const Unit& u, int wr, int wc, int fr, int fq) {
#pragma unroll
    for (int ai = 0; ai < 2; ++ai)
#pragma unroll
        for (int m = 0; m < 4; ++m) { const int row = u.pm * BM + ai * HALF + wr * 64 + m * 16 + fr;
#pragma unroll
            for (int bj = 0; bj < 2; ++bj) { const int col = u.pn * BM + bj * HALF + wc * 32 + 8 * fq; e.item(u.pn, row, col, acc[ai][bj][m][0], acc[ai][bj][m][1]); } }
}

struct EpiInProj {
    static constexpr bool PERM = true, AFTER_DRAIN = false;
    bf16_t *Qd, *Kd, *Vd, *LQ, *LK, *LV, *GA, *GB;
    __device__ __forceinline__ void operator()(const f32x4 (&acc)[2][2][4][2], const Unit& u, int wr, int wc, int fr, int fq) const { epi_loop(*this, acc, u, wr, wc, fr, fq); }
    __device__ __forceinline__ void item(int pn, int row, int col, f32x4 v0, f32x4 v1) const {
            const int b = row >> 14, s = row & 16383; bf16_t* dst;
            if (pn < 2) {
                const int h = col >> 7, c = (col >> 6) & 1, d = col & 63; v0 = v0 * 0.18033688011112042f; v1 = v1 * 0.18033688011112042f;
                dst = Qd + ((size_t)((b * 4 + h) * 2 + c) * 16384 + s) * 64 + d;
            } else if (pn < 4) {
                const int cc = col - 512, h = cc >> 7, c = (cc >> 6) & 1, d = cc & 63;
                dst = Kd + ((((size_t)((b * 4 + h) * 2 + c) * 256 + (s >> 6)) * 8 + (d >> 3)) * 64 + (s & 63)) * 8;
            } else if (pn < 6) {
                const int cc = col - 1024, h = cc >> 7, d = cc & 127;
                dst = Vd + ((size_t)(b * 4 + h) * 256 + (s >> 6)) * 8192 + ((d >> 5) * 4 + ((s & 63) >> 4)) * 512 + (s & 15) * 32 + (d & 31);
            } else if (pn < 9) {
                v0 = v0 * 0.18033688011112042f; v1 = v1 * 0.18033688011112042f; dst = LQ + (size_t)row * 768 + (col - 1536);
            } else if (pn < 12) { dst = LK + (size_t)row * 768 + (col - 2304);
            } else if (pn < 15) { dst = LV + (size_t)row * 768 + (col - 3072);
            } else {
#pragma unroll
                for (int i = 0; i < 4; ++i) { v0[i] = sigm(v0[i]); v1[i] = sigm(v1[i]); }
                dst = (pn < 19) ? GA + (size_t)row * 1024 + (col - 3840) : GB + (size_t)row * 1024 + (col - 4864);
            }
            *(u32x4*)dst = pack8(v0, v1);
        }
};
struct EpiGate1 {
    static constexpr bool PERM = true, AFTER_DRAIN = false;
    const bf16_t* GA; bf16_t* G;
    __device__ __forceinline__ void operator()(const f32x4 (&acc)[2][2][4][2], const Unit& u, int wr, int wc, int fr, int fq) const { epi_loop(*this, acc, u, wr, wc, fr, fq); }
    __device__ __forceinline__ void item(int pn, int row, int col, f32x4 v0, f32x4 v1) const {
            const size_t o = (size_t)row * 1024 + col; const u32x4 g = *(const u32x4*)(GA + o);
            v0[0] *= blo(g.x); v0[1] *= bhi(g.x); v0[2] *= blo(g.y); v0[3] *= bhi(g.y); v1[0] *= blo(g.z); v1[1] *= bhi(g.z); v1[2] *= blo(g.w); v1[3] *= bhi(g.w);
            *(u32x4*)(G + o) = pack8(v0, v1);
        }
};
struct EpiGate2 {
    static constexpr bool PERM = true, AFTER_DRAIN = false;
    const bf16_t* GB; bf16_t* G;
    __device__ __forceinline__ void operator()(const f32x4 (&acc)[2][2][4][2], const Unit& u, int wr, int wc, int fr, int fq) const { epi_loop(*this, acc, u, wr, wc, fr, fq); }
    __device__ __forceinline__ void item(int pn, int row, int col, f32x4 v0, f32x4 v1) const {
            const size_t o = (size_t)row * 1024 + col; const u32x4 g = *(const u32x4*)(GB + o); const u32x4 p = *(const u32x4*)(G + o);
            v0[0] = v0[0] * blo(g.x) + blo(p.x); v0[1] = v0[1] * bhi(g.x) + bhi(p.x); v0[2] = v0[2] * blo(g.y) + blo(p.y); v0[3] = v0[3] * bhi(g.y) + bhi(p.y);
            v1[0] = v1[0] * blo(g.z) + blo(p.z); v1[1] = v1[1] * bhi(g.z) + bhi(p.z); v1[2] = v1[2] * blo(g.w) + blo(p.w); v1[3] = v1[3] * bhi(g.w) + bhi(p.w);
            *(u32x4*)(G + o) = pack8(v0, v1);
        }
};
struct EpiOut {
    static constexpr bool PERM = true, AFTER_DRAIN = false;
    const float* X; float* R;
    __device__ __forceinline__ void operator()(const f32x4 (&acc)[2][2][4][2], const Unit& u, int wr, int wc, int fr, int fq) const { epi_loop(*this, acc, u, wr, wc, fr, fq); }
    __device__ __forceinline__ void item(int pn, int row, int col, f32x4 v0, f32x4 v1) const {
            const size_t o = (size_t)row * 1024 + col; const f32x4 x0 = *(const f32x4*)(X + o), x1 = *(const f32x4*)(X + o + 4);
            *(f32x4*)(R + o) = x0 * 1.189207115002721f + v0; *(f32x4*)(R + o + 4) = x1 * 1.189207115002721f + v1;
    }
};
struct EpiScoreT {
    static constexpr bool PERM = true, AFTER_DRAIN = false;
    float* ST;
    __device__ __forceinline__ void operator()(const f32x4 (&acc)[2][2][4][2], const Unit& u, int wr, int wc, int fr, int fq) const { epi_loop(*this, acc, u, wr, wc, fr, fq); }
    __device__ __forceinline__ void item(int pn, int row, int col, f32x4 v0, f32x4 v1) const { const size_t o = (size_t)row * 32768 + col; *(f32x4*)(ST + o) = v0; *(f32x4*)(ST + o + 4) = v1; }
};
template <class Epi, class Sched, bool ALIGN_EPI = false, bool SP2 = false>
__device__ __forceinline__ void gemm_phase(PG8_LAS unsigned char* lds, const Gemm g, const Sched& S, const Epi& E) {
    const int tid = threadIdx.x, wid = __builtin_amdgcn_readfirstlane(tid >> 6), lane = tid & 63, wr = wid >> 2, wc = wid & 3, fr = lane & 15, fq = lane >> 4;
    const int K = g.K, nt = K / BK;
    unsigned voffA[2], voffB[2];
#pragma unroll
    for (int i = 0; i < 2; ++i) { int R, C; stage_rc(tid * 16 + i * 8192, R, C); const int Rb = Epi::PERM ? ((R & ~31) + perm32(R & 31)) : R;
        voffA[i] = (unsigned)(R * K + C) * 2u; voffB[i] = (unsigned)(Rb * K + C) * 2u; }
    const size_t kstep = (size_t)(BK * 2);
    const size_t hstep = (size_t)HALF * K * 2;
    const size_t tstep = 2 * hstep;
    const unsigned ldsw = (unsigned)wid * 1024u;
    const int aoff = lds_byte(wr * 64 + fr, fq * 8), boff = lds_byte(wc * 32 + fr, fq * 8);
#define PG8_SA(b, h) (((b) * 2 + (h)) * HTB)
#define PG8_SB(b, h) ((4 + (b) * 2 + (h)) * HTB)
#define PG8_STAGE(bufoff, gbase, voff) do { _Pragma("unroll") for (int _i = 0; _i < 2; ++_i) \
        __builtin_amdgcn_global_load_lds((const unsigned*)((const char*)(gbase) + (voff)[_i]), (PG8_LAS unsigned*)(lds + (bufoff) + ldsw + _i * 8192), 16, 0, 0); } while (0)
#define PG8_LDA(dst, b, h) do { _Pragma("unroll") for (int m = 0; m < 4; ++m) _Pragma("unroll") for (int k = 0; k < 2; ++k) dst[m][k] = *(const PG8_LAS bf16x8*)(lds + PG8_SA(b, h) + aoff + m * 2048 + k * 1024); } while (0)
#define PG8_LDB(dst, b, h) do { _Pragma("unroll") for (int n = 0; n < 2; ++n) _Pragma("unroll") for (int k = 0; k < 2; ++k) dst[n][k] = *(const PG8_LAS bf16x8*)(lds + PG8_SB(b, h) + boff + n * 2048 + k * 1024); } while (0)
#define PG8_MMA(ai, bj, At, Bt) do { __builtin_amdgcn_s_setprio(1); _Pragma("unroll") for (int m = 0; m < 4; ++m) _Pragma("unroll") for (int n = 0; n < 2; ++n) _Pragma("unroll") for (int k = 0; k < 2; ++k) \
        acc[ai][bj][m][n] = __builtin_amdgcn_mfma_f32_16x16x32_bf16(Bt[n][k], At[m][k], acc[ai][bj][m][n], 0, 0, 0); __builtin_amdgcn_s_setprio(0); } while (0)
#define PG8_WAIT_V(n) asm volatile("s_waitcnt vmcnt(" #n ")" ::: "memory")
#define PG8_WAIT_L(n) asm volatile("s_waitcnt lgkmcnt(" #n ")" ::: "memory")
#define PG8_BAR __builtin_amdgcn_s_barrier()
#define PG8_SCHED __builtin_amdgcn_sched_barrier(0)
    Unit cur, nxt; int ui = 0;
    if (!S.next(0, cur)) return;
    f32x4 acc[2][2][4][2];
#pragma unroll
    for (int a = 0; a < 2; ++a)
#pragma unroll
        for (int b = 0; b < 2; ++b)
#pragma unroll
            for (int m = 0; m < 4; ++m)
#pragma unroll
                for (int n = 0; n < 2; ++n) acc[a][b][m][n] = (f32x4){0.f, 0.f, 0.f, 0.f};
    bf16x8 At[4][2], B0[2][2], B1[2][2];
    const char* cA = (const char*)g.A + (size_t)cur.pm * tstep; const char* cB = (const char*)g.Bt + (size_t)cur.pn * tstep;
    S.a_ready(cur);
    if constexpr (SP2) {
        PG8_STAGE(PG8_SB(0, 0), cB, voffB); PG8_STAGE(PG8_SB(0, 1), cB + hstep, voffB); PG8_STAGE(PG8_SA(0, 0), cA, voffA); PG8_STAGE(PG8_SA(0, 1), cA + hstep, voffA);
        if (wr == 1) PG8_BAR;
        PG8_WAIT_V(2); PG8_BAR;
        PG8_STAGE(PG8_SB(1, 0), cB + kstep, voffB); PG8_STAGE(PG8_SA(1, 0), cA + kstep, voffA); PG8_STAGE(PG8_SB(1, 1), cB + hstep + kstep, voffB);
        PG8_WAIT_V(6); PG8_BAR;
    } else {
        PG8_STAGE(PG8_SB(0, 0), cB, voffB); PG8_STAGE(PG8_SA(0, 0), cA, voffA); PG8_STAGE(PG8_SB(0, 1), cB + hstep, voffB); PG8_STAGE(PG8_SA(0, 1), cA + hstep, voffA);
        if (wr == 1) PG8_BAR;
        PG8_WAIT_V(4); PG8_BAR;
        PG8_STAGE(PG8_SB(1, 0), cB + kstep, voffB); PG8_STAGE(PG8_SA(1, 0), cA + kstep, voffA); PG8_STAGE(PG8_SB(1, 1), cB + hstep + kstep, voffB);
        PG8_WAIT_V(6); PG8_BAR;
    }
    for (;;) {
        const bool has_next = S.next(ui + 1, nxt);
        const char* nA = has_next ? (const char*)g.A + (size_t)nxt.pm * tstep : cA; const char* nB = has_next ? (const char*)g.Bt + (size_t)nxt.pn * tstep : cB;
        for (int t = 0; t < nt; t += 2) {
            const bool last = (t == nt - 2);
            const char* a1 = cA + (size_t)(t + 1) * kstep;
            const char* a2 = last ? nA : cA + (size_t)(t + 2) * kstep; const char* b2 = last ? nB : cB + (size_t)(t + 2) * kstep;
            const char* a3 = a2 + kstep; const char* b3 = b2 + kstep;
            if (last && has_next) S.a_ready(nxt);
            if constexpr (SP2) {
            PG8_LDB(B0, 0, 0); PG8_LDB(B1, 0, 1); PG8_SCHED; PG8_LDA(At, 0, 0); PG8_STAGE(PG8_SA(1, 1), a1 + hstep, voffA);
            PG8_WAIT_V(8); PG8_WAIT_L(0); PG8_BAR; PG8_MMA(0, 0, At, B0); PG8_MMA(0, 1, At, B1); PG8_BAR; PG8_SCHED;
            PG8_LDA(At, 0, 1); PG8_STAGE(PG8_SB(0, 0), b2, voffB); PG8_STAGE(PG8_SB(0, 1), b2 + hstep, voffB); PG8_STAGE(PG8_SA(0, 0), a2, voffA);
            PG8_WAIT_V(8); PG8_WAIT_L(0); PG8_BAR; PG8_MMA(1, 0, At, B0); PG8_MMA(1, 1, At, B1); PG8_BAR; PG8_SCHED;
            PG8_LDB(B0, 1, 0); PG8_LDB(B1, 1, 1); PG8_SCHED; PG8_LDA(At, 1, 0); PG8_STAGE(PG8_SA(0, 1), a2 + hstep, voffA);
            PG8_WAIT_V(8); PG8_WAIT_L(0); PG8_BAR; PG8_MMA(0, 0, At, B0); PG8_MMA(0, 1, At, B1); PG8_BAR; PG8_SCHED;
            PG8_LDA(At, 1, 1); PG8_STAGE(PG8_SB(1, 0), b3, voffB); PG8_STAGE(PG8_SB(1, 1), b3 + hstep, voffB); PG8_STAGE(PG8_SA(1, 0), a3, voffA);
            PG8_WAIT_V(8); PG8_WAIT_L(0); PG8_BAR; PG8_MMA(1, 0, At, B0); PG8_MMA(1, 1, At, B1); PG8_BAR; PG8_SCHED;
            } else {
            PG8_LDB(B0, 0, 0); PG8_SCHED; PG8_LDA(At, 0, 0); PG8_STAGE(PG8_SA(1, 1), a1 + hstep, voffA);
            PG8_WAIT_L(8); PG8_BAR; PG8_WAIT_L(0); PG8_MMA(0, 0, At, B0); PG8_BAR; PG8_SCHED;
            PG8_LDB(B1, 0, 1); PG8_STAGE(PG8_SB(0, 0), b2, voffB);
            PG8_BAR; PG8_WAIT_L(0); PG8_MMA(0, 1, At, B1); PG8_BAR;
            PG8_LDA(At, 0, 1); PG8_STAGE(PG8_SA(0, 0), a2, voffA);
            PG8_BAR; PG8_WAIT_L(0); PG8_MMA(1, 0, At, B0); PG8_BAR; PG8_SCHED;
            PG8_STAGE(PG8_SB(0, 1), b2 + hstep, voffB);
            PG8_WAIT_V(6); PG8_BAR; PG8_MMA(1, 1, At, B1); PG8_BAR;
            PG8_LDB(B0, 1, 0); PG8_SCHED; PG8_LDA(At, 1, 0); PG8_STAGE(PG8_SA(0, 1), a2 + hstep, voffA);
            PG8_WAIT_L(8); PG8_BAR; PG8_WAIT_L(0); PG8_MMA(0, 0, At, B0); PG8_BAR; PG8_SCHED;
            PG8_LDB(B1, 1, 1); PG8_STAGE(PG8_SB(1, 0), b3, voffB);
            PG8_BAR; PG8_WAIT_L(0); PG8_MMA(0, 1, At, B1); PG8_BAR;
            PG8_LDA(At, 1, 1); PG8_STAGE(PG8_SA(1, 0), a3, voffA);
            PG8_BAR; PG8_WAIT_L(0); PG8_MMA(1, 0, At, B0); PG8_BAR; PG8_SCHED;
            PG8_STAGE(PG8_SB(1, 1), b3 + hstep, voffB);
            PG8_WAIT_V(6); PG8_BAR; PG8_MMA(1, 1, At, B1); PG8_BAR;
            }
        }
        if constexpr (ALIGN_EPI) { if (wr == 0) PG8_BAR; }
        if constexpr (!Epi::AFTER_DRAIN) { E(acc, cur, wr, wc, fr, fq); S.done(cur); }
        if (!has_next) break;
#pragma unroll
        for (int a = 0; a < 2; ++a)
#pragma unroll
            for (int b = 0; b < 2; ++b)
#pragma unroll
                for (int m = 0; m < 4; ++m)
#pragma unroll
                    for (int n = 0; n < 2; ++n) acc[a][b][m][n] = (f32x4){0.f, 0.f, 0.f, 0.f};
        cur = nxt; cA = nA; cB = nB; ++ui;
        if constexpr (ALIGN_EPI) { if (wr == 1) PG8_BAR; }
    }
    PG8_WAIT_V(0);
    if constexpr (!ALIGN_EPI) { if (wr == 0) PG8_BAR; }
    PG8_BAR;
    if constexpr (Epi::AFTER_DRAIN) { E.fused(acc, cur, wr, wc, fr, fq, lds, wid, lane); S.done(cur); }
#undef PG8_SA
#undef PG8_SB
#undef PG8_STAGE
#undef PG8_LDA
#undef PG8_LDB
#undef PG8_MMA
#undef PG8_WAIT_V
#undef PG8_WAIT_L
#undef PG8_BAR
#undef PG8_SCHED
}
}
#define XB_TMO      128
#define XB_XCNT(j)  (256  + 64 * (j))
#define XB_XSUB(j)  (1280 + 64 * (j))
#define XB_XGEN(j)  (2304 + 64 * (j))
#define XB_TOP      3328
#define XB_TOPGEN   3392
#define XCD_BAR_WORDS 3456
#define XB_SPIN_CAP (1u << 18)

__device__ __forceinline__ unsigned xb_ld(unsigned* p)              { return __hip_atomic_load(p, __ATOMIC_RELAXED, __HIP_MEMORY_SCOPE_AGENT); }
__device__ __forceinline__ unsigned xb_add(unsigned* p, unsigned v) { return __hip_atomic_fetch_add(p, v, __ATOMIC_RELAXED, __HIP_MEMORY_SCOPE_AGENT); }
__device__ __forceinline__ unsigned xb_xcc_id() { return (unsigned)__builtin_amdgcn_s_getreg((3 << 11) | 20) & 0xFu; }
#define XB_SPIN(cond, bar) do { unsigned _sp = 0; while (cond) { __builtin_amdgcn_s_sleep(1); \
    if ((++_sp & 255u) == 0u) { if (xb_ld(&(bar)[XB_TMO])) break; if (_sp > XB_SPIN_CAP) { atomicAdd(&(bar)[XB_TMO], 1u); break; } } } } while (0)

struct XcdBarrier {
    unsigned* bar; unsigned x;
    volatile LAS unsigned* st;
};

__device__ __forceinline__ XcdBarrier xcd_barrier_post(unsigned* bar, volatile LAS unsigned* st) {
    XcdBarrier b; b.bar = bar; b.x = xb_xcc_id(); b.st = st;
    if (threadIdx.x == 0) (void)xb_add(&bar[XB_XCNT(b.x)], 1u);
    return b;
}
__device__ __forceinline__ void xcd_barrier_complete(unsigned* bar, unsigned x, unsigned& nloc, unsigned& nx) {
    const unsigned G = gridDim.x * gridDim.y * gridDim.z;
    unsigned sum, cnt, mine, sp = 0u;
    for (;;) {
        sum = 0u; cnt = 0u; mine = 0u;
#pragma unroll
        for (unsigned j = 0; j < 16; ++j) { const unsigned c = xb_ld(&bar[XB_XCNT(j)]); sum += c; cnt += (c > 0u) ? 1u : 0u; mine = (j == x) ? c : mine; }
        if (sum == G) break;
        __builtin_amdgcn_s_sleep(1);
        if ((++sp & 255u) == 0u) { if (xb_ld(&bar[XB_TMO])) break; if (sp > XB_SPIN_CAP) { atomicAdd(&bar[XB_TMO], 1u); break; } }
    }
    nloc = mine > 0u ? mine : 1u; nx = cnt > 0u ? cnt : 1u;
}

__device__ __forceinline__ void xcd_barrier(const XcdBarrier& b) {
    asm volatile("s_waitcnt vmcnt(0)" ::: "memory");
    __syncthreads();
    if (threadIdx.x == 0) {
        unsigned* bar = b.bar;
        __builtin_amdgcn_s_waitcnt(0);
        unsigned nloc = b.st[0], nx = b.st[1];
        if (nloc == 0u) { xcd_barrier_complete(bar, b.x, nloc, nx); b.st[0] = nloc; b.st[1] = nx; }
        const unsigned old = xb_add(&bar[XB_XSUB(b.x)], 1u);
        const unsigned gen = old / nloc;
        if (old + 1u == (gen + 1u) * nloc) {
            __builtin_amdgcn_fence(__ATOMIC_RELEASE, "agent");
            asm volatile("s_waitcnt vmcnt(0)" ::: "memory");
            const unsigned og = xb_add(&bar[XB_TOP], 1u);
            const unsigned tg = og / nx;
            if (og + 1u == (tg + 1u) * nx) xb_add(&bar[XB_TOPGEN], 1u);
            else XB_SPIN(xb_ld(&bar[XB_TOPGEN]) == tg, bar);
            __builtin_amdgcn_fence(__ATOMIC_ACQUIRE, "agent");
            xb_add(&bar[XB_XGEN(b.x)], 1u);
            asm volatile("s_waitcnt vmcnt(0)" ::: "memory");
        } else {
            XB_SPIN(xb_ld(&bar[XB_XGEN(b.x)]) == gen, bar);
            __builtin_amdgcn_fence(__ATOMIC_ACQUIRE, "agent");
            asm volatile("s_waitcnt vmcnt(0)" ::: "memory");
        }
    }
    __syncthreads();
}
namespace da {
constexpr int SLOT_K = 8192, SLOT_V = 16384, SLOT = SLOT_K + SLOT_V;
constexpr int NSLOT = 4;
constexpr int LDS_BIAS = NSLOT * SLOT;
constexpr int LDS_END = LDS_BIAS + BIAS_TAB * 4;
constexpr float THR = 8.f;
__device__ __forceinline__ int crow(int r, int hi) { return (r & 3) + 8 * (r >> 2) + 4 * hi; }
__device__ __forceinline__ void glds16(const void* gbase  , unsigned voff  , unsigned lds_dst) { unsigned keep;
    asm volatile("s_mov_b32 %0, m0\n\ts_mov_b32 m0, %3\n\ts_nop 0\n\tglobal_load_lds_dwordx4 %1, %2\n\ts_mov_b32 m0, %0" : "=&s"(keep) : "v"(voff), "s"(gbase), "s"(lds_dst) : "memory"); }
typedef short v4i16_t __attribute__((ext_vector_type(4)));
__device__ __forceinline__ s16x4 vtr(const LAS char* p) { return __builtin_bit_cast(s16x4, __builtin_amdgcn_ds_read_tr16_b64_v4i16((LAS v4i16_t*)p)); }
#define DA_WAIT_BAR() asm volatile("s_waitcnt vmcnt(0) lgkmcnt(0)\n\ts_barrier" ::: "memory")

struct Tensors { const bf16* Qd; const bf16* Kd; const bf16* Vd; float* stash; bf16* ya; const float* dlam; const float* subg; const float* relb; };

__device__ __forceinline__ float max3f(float a, float b, float c) { float r; asm("v_max3_f32 %0, %1, %2, %3" : "=v"(r) : "v"(a), "v"(b), "v"(c)); return r; }
#define DA_STAGE_Q(T_) do { const int t_ = (T_); const LAS char* kb_ = kp0 + (t_ & 3) * SLOT; \
        bf16x8 kf_[8]; \
        _Pragma("unroll") for (int d0 = 0; d0 < 2; ++d0) { kf_[2 * d0] = *(const LAS bf16x8*)(kb_ + d0 * 2048); kf_[2 * d0 + 1] = *(const LAS bf16x8*)(kb_ + d0 * 2048 + 512); } \
        if ((q0 - 64 * t_ - 63) < DFAR) { int base_ = qabs - 64 * t_ - 4 * hi + BIAS_GUARD; asm volatile("" : "+v"(base_)); \
            _Pragma("unroll") for (int r = 0; r < 16; ++r) { const int o_ = (r & 3) + 8 * (r >> 2); p0[r] = tb[base_ - o_] - m; p1[r] = tb[base_ - o_ - 32] - m; } \
            _Pragma("unroll") for (int d0 = 0; d0 < 4; ++d0) { if (d0 < 2) { kf_[2 * d0 + 4] = *(const LAS bf16x8*)(kb_ + (d0 + 2) * 2048); kf_[2 * d0 + 5] = *(const LAS bf16x8*)(kb_ + (d0 + 2) * 2048 + 512); } \
                p0 = __builtin_amdgcn_mfma_f32_32x32x16_bf16(kf_[2 * d0], qr[d0], p0, 0, 0, 0); p1 = __builtin_amdgcn_mfma_f32_32x32x16_bf16(kf_[2 * d0 + 1], qr[d0], p1, 0, 0, 0); } \
        } else { f32x16 ci_; const float cm_ = c31 - m; _Pragma("unroll") for (int r = 0; r < 16; ++r) ci_[r] = cm_; \
            _Pragma("unroll") for (int d0 = 0; d0 < 4; ++d0) { if (d0 < 2) { kf_[2 * d0 + 4] = *(const LAS bf16x8*)(kb_ + (d0 + 2) * 2048); kf_[2 * d0 + 5] = *(const LAS bf16x8*)(kb_ + (d0 + 2) * 2048 + 512); } \
                p0 = __builtin_amdgcn_mfma_f32_32x32x16_bf16(kf_[2 * d0], qr[d0], d0 == 0 ? ci_ : p0, 0, 0, 0); p1 = __builtin_amdgcn_mfma_f32_32x32x16_bf16(kf_[2 * d0 + 1], qr[d0], d0 == 0 ? ci_ : p1, 0, 0, 0); } } \
    } while (0)
#define DA_STAGE_S(T_) do { const int t_ = (T_); \
        if (t_ >= NT - 4) { int base_ = qabs - 64 * t_ - 4 * hi + BIAS_GUARD; asm volatile("" : "+v"(base_)); \
            _Pragma("unroll") for (int r = 0; r < 16; ++r) { const int o_ = (r & 3) + 8 * (r >> 2); if (base_ - o_ < BIAS_GUARD) p0[r] = -1e30f; if (base_ - o_ - 32 < BIAS_GUARD) p1[r] = -1e30f; } } \
        float ra_ = max3f(p0[0], p0[1], p1[0]), rb_ = max3f(p0[2], p0[3], p1[1]); ra_ = max3f(ra_, p1[2], p1[3]); \
        _Pragma("unroll") for (int r = 4; r < 16; r += 4) { ra_ = max3f(ra_, p0[r], p0[r + 1]); rb_ = max3f(rb_, p0[r + 2], p0[r + 3]); ra_ = max3f(ra_, p1[r], p1[r + 1]); rb_ = max3f(rb_, p1[r + 2], p1[r + 3]); } \
        float rm_ = fmaxf(ra_, rb_); \
        { auto rr_ = __builtin_amdgcn_permlane32_swap(__float_as_uint(rm_), __float_as_uint(rm_), false, false); rm_ = fmaxf(__uint_as_float(rr_[0]), __uint_as_float(rr_[1])); } \
        if (t_ == 0 || __any(rm_ > THR)) { const float dl_ = (t_ == 0) ? rm_ : fmaxf(rm_, 0.f), f_ = __builtin_amdgcn_exp2f(-dl_); \
            _Pragma("unroll") for (int r = 0; r < 16; ++r) { p0[r] -= dl_; p1[r] -= dl_; } \
            _Pragma("unroll") for (int d0 = 0; d0 < 4; ++d0) _Pragma("unroll") for (int r = 0; r < 16; ++r) o[d0][r] *= f_; \
            l *= f_; m += dl_; } \
        float ls0_ = 0.f, ls1_ = 0.f; \
        _Pragma("unroll") for (int r = 0; r < 16; ++r) { p0[r] = __builtin_amdgcn_exp2f(p0[r]); p1[r] = __builtin_amdgcn_exp2f(p1[r]); ls0_ += p0[r]; ls1_ += p1[r]; } \
        l += ls0_ + ls1_; \
        { v4u w; \
          w.x = cvtpk(p0[0], p0[1]); w.y = cvtpk(p0[2], p0[3]); w.z = cvtpk(p0[4], p0[5]); w.w = cvtpk(p0[6], p0[7]); pw[0] = __builtin_bit_cast(bf16x8, w); \
          w.x = cvtpk(p0[8], p0[9]); w.y = cvtpk(p0[10], p0[11]); w.z = cvtpk(p0[12], p0[13]); w.w = cvtpk(p0[14], p0[15]); pw[1] = __builtin_bit_cast(bf16x8, w); \
          w.x = cvtpk(p1[0], p1[1]); w.y = cvtpk(p1[2], p1[3]); w.z = cvtpk(p1[4], p1[5]); w.w = cvtpk(p1[6], p1[7]); pw[2] = __builtin_bit_cast(bf16x8, w); \
          w.x = cvtpk(p1[8], p1[9]); w.y = cvtpk(p1[10], p1[11]); w.z = cvtpk(p1[12], p1[13]); w.w = cvtpk(p1[14], p1[15]); pw[3] = __builtin_bit_cast(bf16x8, w); } \
    } while (0)
#define DA_VF(V_, ks) (bf16x8){V_[2 * (ks)][0], V_[2 * (ks)][1], V_[2 * (ks)][2], V_[2 * (ks)][3], V_[2 * (ks) + 1][0], V_[2 * (ks) + 1][1], V_[2 * (ks) + 1][2], V_[2 * (ks) + 1][3]}
#define DA_STAGE_B(T_) do { const LAS char* vb_ = vp0 + ((T_) & 3) * SLOT; \
        _Pragma("unroll") for (int d0 = 0; d0 < 4; ++d0) { s16x4 vA[8]; \
            _Pragma("unroll") for (int ks = 0; ks < 4; ++ks) { vA[2 * ks] = vtr(vb_ + d0 * 4096 + ks * 1024); vA[2 * ks + 1] = vtr(vb_ + d0 * 4096 + ks * 1024 + 512); } \
            _Pragma("unroll") for (int ks = 0; ks < 4; ++ks) o[d0] = __builtin_amdgcn_mfma_f32_32x32x16_bf16(DA_VF(vA, ks), pw[ks], o[d0], 0, 0, 0); \
            __builtin_amdgcn_sched_barrier(0); } \
    } while (0)
__device__ __forceinline__ void unit(const Tensors& X, int b, int h, int qb, LAS unsigned char* lds, int wgslot, float lam, float c31) {
    const int wid = __builtin_amdgcn_readfirstlane((int)threadIdx.x >> 6);
    const int grp = wid >> 2;
    const int q0 = qb * 256, NT = 4 * (qb + 1);
    const unsigned lds0 = (unsigned)(uintptr_t)lds;
    const LAS float* tb = (const LAS float*)(lds + LDS_BIAS);
    for (int c = 0; c < 2; ++c) {
        int lane = (int)__builtin_amdgcn_mbcnt_hi(~0u, __builtin_amdgcn_mbcnt_lo(~0u, 0u)); asm volatile("" : "+v"(lane));
        const int r32 = lane & 31, hi = lane >> 5;
        const unsigned lane16 = (unsigned)lane * 16u;
        const int qabs = q0 + wid * 32 + r32;
        const LAS char* vp0 = (const LAS char*)lds + SLOT_K + ((lane >> 4) & 1) * 32 + (lane & 3) * 8 + (4 * hi + ((lane & 15) >> 2)) * 64;
        const LAS char* kp0 = (const LAS char*)lds + hi * 1024 + r32 * 16;
        const int bhc = (b * 4 + h) * 2 + c;
        const bf16* Qw = X.Qd + ((size_t)bhc * SEQ + q0 + wid * 32 + r32) * 64 + hi * 8;
        const char* Kt = (const char*)X.Kd + (size_t)bhc * NTILE * SLOT_K + wid * 1024;
        const char* Vt = (const char*)X.Vd + (size_t)(b * 4 + h) * NTILE * SLOT_V + wid * 1024;
#define DA_DMA(t, slot) do { const unsigned sb_ = (unsigned)__builtin_amdgcn_readfirstlane(lds0 + (slot) * SLOT + wid * 1024); \
        glds16(Kt + (size_t)(t) * SLOT_K, lane16, sb_); glds16(Vt + (size_t)(t) * SLOT_V, lane16, sb_ + SLOT_K); glds16(Vt + (size_t)(t) * SLOT_V + 8192, lane16, sb_ + SLOT_K + 8192); } while (0)
        DA_DMA(0, 0); DA_DMA(1, 1); DA_DMA(2, 2);
        bf16x8 qr[4];
#pragma unroll
        for (int d0 = 0; d0 < 4; ++d0) qr[d0] = *(const bf16x8*)(Qw + d0 * 16);
        f32x16 o[4];
#pragma unroll
        for (int d0 = 0; d0 < 4; ++d0)
#pragma unroll
            for (int r = 0; r < 16; ++r) o[d0][r] = 0.f;
        float m = 0.f, l = 0.f;
        bf16x8 pw[4]; f32x16 p0, p1;
        asm volatile("" :: "v"(qr[0]), "v"(qr[1]), "v"(qr[2]), "v"(qr[3]));
        asm volatile("s_waitcnt vmcnt(6) lgkmcnt(0)\n\ts_barrier" ::: "memory");
        DA_STAGE_Q(0);
#define DA_TILE_BARRIER(t) do { \
            if ((t) + 1 < NT) asm volatile("s_waitcnt vmcnt(3) lgkmcnt(0)\n\ts_barrier" ::: "memory"); else asm volatile("s_waitcnt vmcnt(0) lgkmcnt(0)\n\ts_barrier" ::: "memory"); \
            if ((t) + 2 < NT) { const int sn_ = ((t) + 2) & 3; DA_DMA((t) + 2, sn_); } } while (0)
        for (int t = 1; t <= NT; ++t) {
            if (grp == 1) DA_TILE_BARRIER(t);
            DA_STAGE_S(t - 1);
            if (grp == 0) DA_TILE_BARRIER(t);
            __builtin_amdgcn_sched_barrier(0);
            DA_STAGE_B(t - 1);
            if (t < NT) DA_STAGE_Q(t);
        }
#undef DA_TILE_BARRIER
#undef DA_DMA
        { auto rr = __builtin_amdgcn_permlane32_swap(__float_as_uint(l), __float_as_uint(l), false, false); l = __uint_as_float(rr[0]) + __uint_as_float(rr[1]); }
        const float inv = 1.f / l;
        int lane_e = lane; asm volatile("" : "+v"(lane_e));
        GAS unsigned* stg = (GAS unsigned*)((unsigned*)X.stash + ((size_t)(wgslot * 8 + wid) * 32) * 64 + lane_e);
        if (c == 0) {
#pragma unroll
            for (int d0 = 0; d0 < 4; ++d0)
#pragma unroll
                for (int r = 0; r < 16; r += 2) stg[(d0 * 8 + (r >> 1)) * 64] = cvtpk(o[d0][r] * inv, o[d0][r + 1] * inv);
        } else {
            float ss = 0.f;
#pragma unroll
            for (int d0 = 0; d0 < 4; ++d0)
#pragma unroll
                for (int r = 0; r < 16; r += 2) { const unsigned w1 = stg[(d0 * 8 + (r >> 1)) * 64]; const float dv0 = bf_lo(w1) - lam * (o[d0][r] * inv), dv1 = bf_hi(w1) - lam * (o[d0][r + 1] * inv);
                    o[d0][r] = dv0; o[d0][r + 1] = dv1; ss += dv0 * dv0 + dv1 * dv1; if (r == 14) asm volatile("" ::: "memory"); }
            { auto rr = __builtin_amdgcn_permlane32_swap(__float_as_uint(ss), __float_as_uint(ss), false, false); ss = __uint_as_float(rr[0]) + __uint_as_float(rr[1]); }
            const float rn = __builtin_amdgcn_rsqf(ss * (1.f / 128.f) + SUBLN_EPS) * (1.f - LAM_INIT);
            const int hi_e = lane_e >> 5, qabs_e = q0 + wid * 32 + (lane_e & 31);
            bf16* yrow = X.ya + ((size_t)b * SEQ + qabs_e) * 512 + h * 128 + 4 * hi_e; const float* sg = X.subg + 4 * hi_e;
#pragma unroll
            for (int d0 = 0; d0 < 4; ++d0)
#pragma unroll
                for (int r4 = 0; r4 < 4; ++r4) {
                    const int dd = 32 * d0 + 8 * r4; const f32x4 g = *(const f32x4*)(sg + dd);
                    v2u w; w.x = pk2(o[d0][4 * r4] * rn * g[0], o[d0][4 * r4 + 1] * rn * g[1]); w.y = pk2(o[d0][4 * r4 + 2] * rn * g[2], o[d0][4 * r4 + 3] * rn * g[3]);
                    *(v2u*)(yrow + dd) = w;
                }
        }
    }
    asm volatile("s_waitcnt vmcnt(0) lgkmcnt(0)\n\ts_barrier" ::: "memory");
}
#undef DA_STAGE_Q
#undef DA_STAGE_S
#undef DA_STAGE_B
#undef DA_VF
#undef DA_WAIT_BAR
}
namespace dil {
constexpr int BT = 1152, BT0 = 512;
constexpr int LDS_VST = 0, LDS_BL = 32768, LDS_END = LDS_BL + 3 * BT * 4;
constexpr float THR = 8.f;
struct Tensors { const bf16* LQ; const bf16* LK; const bf16* LV; bf16* yb; };
typedef short v4i16_t __attribute__((ext_vector_type(4)));
__device__ __forceinline__ s16x4 vtr(const LAS unsigned char* p) { return __builtin_bit_cast(s16x4, __builtin_amdgcn_ds_read_tr16_b64_v4i16((LAS v4i16_t*)p)); }

template <int G_, int QS_> __device__ __forceinline__ void group(const Tensors& X, size_t rowb, int h, int P0, int r, LAS unsigned char* vst, const LAS float* blg, int lane, f32x16 (&o)[2], float& m, float& l) {
    constexpr int DL = (G_ == 0) ? 1 : (G_ == 1) ? 4 : 16, MG = QS_ / DL, NKB = (31 * MG + 128) / 32 + 1;
    static_assert(QS_ % DL == 0, "query stride must be a multiple of the dilation");
    const int i = lane & 31, hi = lane >> 5;
    const int colb = G_ * 256 + h * 64;
    bf16x8 qr[4];
    { const bf16* qp = X.LQ + (rowb + P0 + r + QS_ * i) * 768 + colb + hi * 8;
#pragma unroll
      for (int d0 = 0; d0 < 4; ++d0) qr[d0] = *(const bf16x8*)(qp + 16 * d0); }
    const int kpos0 = P0 + r - 128 * DL;
    const LAS unsigned char* vrd = vst + ((lane >> 4) & 1) * 32 + (lane & 3) * 8 + (4 * hi + ((lane & 15) >> 2)) * 64;
#define DIL_LOAD(KF, VR, KB) do { \
        { int kpos_ = kpos0 + (32 * (KB) + i) * DL; kpos_ = kpos_ < 0 ? 0 : (kpos_ > SEQ - 1 ? SEQ - 1 : kpos_); const bf16* kp_ = X.LK + (rowb + kpos_) * 768 + colb + hi * 8; \
          _Pragma("unroll") for (int d0 = 0; d0 < 4; ++d0) KF[d0] = *(const bf16x8*)(kp_ + 16 * d0); } \
        _Pragma("unroll") for (int t = 0; t < 4; ++t) { const int qd = lane + 64 * t, key = qd >> 3, ch = qd & 7; int vpos_ = kpos0 + (32 * (KB) + key) * DL; vpos_ = vpos_ < 0 ? 0 : (vpos_ > SEQ - 1 ? SEQ - 1 : vpos_); \
            VR[t] = *(const v4u*)(X.LV + (rowb + vpos_) * 768 + colb + ch * 8); } } while (0)
    bf16x8 kfn[4]; v4u vregn[4];
    DIL_LOAD(kfn, vregn, 0);
#pragma unroll 1
    for (int kb = 0; kb < NKB; ++kb) {
        bf16x8 kf[4]; v4u vreg[4];
#pragma unroll
        for (int d0 = 0; d0 < 4; ++d0) { kf[d0] = kfn[d0]; vreg[d0] = vregn[d0]; }
        if (kb + 1 < NKB) DIL_LOAD(kfn, vregn, kb + 1);
        const int jb = i * MG + 128 - 32 * kb - 4 * hi;
        f32x16 p;
#pragma unroll
        for (int rr = 0; rr < 16; ++rr) p[rr] = blg[jb - ((rr & 3) + 8 * (rr >> 2)) + BT0];
#pragma unroll
        for (int d0 = 0; d0 < 4; ++d0) p = __builtin_amdgcn_mfma_f32_32x32x16_bf16(kf[d0], qr[d0], p, 0, 0, 0);
        const int cb = 32 * kb + 4 * hi;
#pragma unroll
        for (int rr = 0; rr < 16; ++rr) { const int o_ = (rr & 3) + 8 * (rr >> 2); if ((unsigned)(jb - o_) > 128u || kpos0 + (cb + o_) * DL < 0) p[rr] = -3e38f; }
        float rm = p[0];
#pragma unroll
        for (int rr = 1; rr < 16; ++rr) rm = fmaxf(rm, p[rr]);
        { auto sw = __builtin_amdgcn_permlane32_swap(__float_as_uint(rm), __float_as_uint(rm), false, false); rm = fmaxf(__uint_as_float(sw[0]), __uint_as_float(sw[1])); }
        if (__any(rm > m + THR)) {
            const float mn = fmaxf(m, rm), f = __builtin_amdgcn_exp2f(m - mn);
#pragma unroll
            for (int d0 = 0; d0 < 2; ++d0)
#pragma unroll
                for (int rr = 0; rr < 16; ++rr) o[d0][rr] *= f;
            l *= f; m = mn;
        }
        float ls = 0.f;
#pragma unroll
        for (int rr = 0; rr < 16; ++rr) { p[rr] = __builtin_amdgcn_exp2f(p[rr] - m); ls += p[rr]; }
        l += ls;
        bf16x8 pw[2];
        { v4u w;
          w.x = cvtpk(p[0], p[1]); w.y = cvtpk(p[2], p[3]); w.z = cvtpk(p[4], p[5]); w.w = cvtpk(p[6], p[7]); pw[0] = __builtin_bit_cast(bf16x8, w);
          w.x = cvtpk(p[8], p[9]); w.y = cvtpk(p[10], p[11]); w.z = cvtpk(p[12], p[13]); w.w = cvtpk(p[14], p[15]); pw[1] = __builtin_bit_cast(bf16x8, w); }
#pragma unroll
        for (int t = 0; t < 4; ++t) { const int qd = lane + 64 * t, key = qd >> 3, ch = qd & 7;
            *(LAS v4u*)(vst + ((ch >> 2) * 2 + (key >> 4)) * 1024 + (key & 15) * 64 + (ch & 3) * 16) = vreg[t]; }
        asm volatile("s_waitcnt lgkmcnt(0)" ::: "memory");
#pragma unroll
        for (int d0 = 0; d0 < 2; ++d0)
#pragma unroll
            for (int ks = 0; ks < 2; ++ks) {
                const s16x4 lo = vtr(vrd + (d0 * 2 + ks) * 1024), hh = vtr(vrd + (d0 * 2 + ks) * 1024 + 512);
                const bf16x8 vf = (bf16x8){lo[0], lo[1], lo[2], lo[3], hh[0], hh[1], hh[2], hh[3]};
                o[d0] = __builtin_amdgcn_mfma_f32_32x32x16_bf16(vf, pw[ks], o[d0], 0, 0, 0);
            }
        asm volatile("s_waitcnt lgkmcnt(0)" ::: "memory");
    }
#undef DIL_LOAD
}
__device__ __forceinline__ void wave_tile_g0(const Tensors& X, float* lse0, int b, int h, int P0, LAS unsigned char* vst, const LAS float* bl, int lane) {
    const size_t rowb = (size_t)b * SEQ;
    f32x16 o[2];
#pragma unroll
    for (int d0 = 0; d0 < 2; ++d0)
#pragma unroll
        for (int rr = 0; rr < 16; ++rr) o[d0][rr] = 0.f;
    float m = -1e30f, l = 0.f;
    group<0, 1>(X, rowb, h, P0, 0, vst, bl, lane, o, m, l);
    { auto sw = __builtin_amdgcn_permlane32_swap(__float_as_uint(l), __float_as_uint(l), false, false); l = __uint_as_float(sw[0]) + __uint_as_float(sw[1]); }
    const float inv = 1.f / l; const int i = lane & 31, hi = lane >> 5;
    bf16* yrow = X.yb + (rowb + P0 + i) * 256 + h * 64 + 4 * hi;
#pragma unroll
    for (int d0 = 0; d0 < 2; ++d0)
#pragma unroll
        for (int r4 = 0; r4 < 4; ++r4) { v2u w; w.x = pk2(o[d0][4 * r4] * inv, o[d0][4 * r4 + 1] * inv); w.y = pk2(o[d0][4 * r4 + 2] * inv, o[d0][4 * r4 + 3] * inv); *(v2u*)(yrow + 32 * d0 + 8 * r4) = w; }
    if (hi == 0) lse0[(rowb + P0 + i) * 4 + h] = m + __builtin_amdgcn_logf(l);
}
__device__ __forceinline__ void wave_tile(const Tensors& X, const float* lse0, int b, int h, int P0, int r, LAS unsigned char* vst, const LAS float* bl, int lane) {
    const size_t rowb = (size_t)b * SEQ;
    f32x16 o[2];
#pragma unroll
    for (int d0 = 0; d0 < 2; ++d0)
#pragma unroll
        for (int rr = 0; rr < 16; ++rr) o[d0][rr] = 0.f;
    float m = -1e30f, l = 0.f;
    group<1, 16>(X, rowb, h, P0, r, vst, bl + BT, lane, o, m, l);
    group<2, 16>(X, rowb, h, P0, r, vst, bl + 2 * BT, lane, o, m, l);
    { auto sw = __builtin_amdgcn_permlane32_swap(__float_as_uint(l), __float_as_uint(l), false, false); l = __uint_as_float(sw[0]) + __uint_as_float(sw[1]); }
    const int i = lane & 31, hi = lane >> 5;
    const float w0 = __builtin_amdgcn_exp2f(lse0[(rowb + P0 + r + 16 * i) * 4 + h] - m);
    const float inv = 1.f / (l + w0);
    bf16* yrow = X.yb + (rowb + P0 + r + 16 * i) * 256 + h * 64 + 4 * hi;
#pragma unroll
    for (int d0 = 0; d0 < 2; ++d0)
#pragma unroll
        for (int r4 = 0; r4 < 4; ++r4) { const v2u g0 = *(const v2u*)(yrow + 32 * d0 + 8 * r4);
            v2u w; w.x = pk2((o[d0][4 * r4] + w0 * bf_lo(g0.x)) * inv, (o[d0][4 * r4 + 1] + w0 * bf_hi(g0.x)) * inv); w.y = pk2((o[d0][4 * r4 + 2] + w0 * bf_lo(g0.y)) * inv, (o[d0][4 * r4 + 3] + w0 * bf_hi(g0.y)) * inv);
            *(v2u*)(yrow + 32 * d0 + 8 * r4) = w; }
}
}
__device__ __forceinline__ void p0_transpose_item(const float* W, int K, int N, bf16* WT, LAS float* scr, int item, int lane) {
    const int nblk = N / 32, kb = item / nblk, nb = item % nblk, k0 = 64 * kb, n0 = 32 * nb;
#pragma unroll 8
    for (int i = 0; i < 32; ++i) { const int kk = 2 * i + (lane >> 5); scr[kk * 33 + (lane & 31)] = W[(size_t)(k0 + kk) * N + n0 + (lane & 31)]; }
    LDS_WAIT(); asm volatile("" ::: "memory");
    const int c = lane & 7;
#pragma unroll
    for (int j = 0; j < 4; ++j) { const int n = (lane >> 3) + 8 * j; const LAS float* s = scr + (8 * c) * 33 + n;
        v4u o; o.x = pk2(s[0 * 33], s[1 * 33]); o.y = pk2(s[2 * 33], s[3 * 33]); o.z = pk2(s[4 * 33], s[5 * 33]); o.w = pk2(s[6 * 33], s[7 * 33]);
        *(v4u*)(WT + (size_t)(n0 + n) * K + k0 + 8 * c) = o; }
    LDS_WAIT(); asm volatile("" ::: "memory");
}
__device__ __forceinline__ void cast_bf16(const float* src, bf16* dst, size_t n8, size_t gtid, size_t gthreads) {
    for (size_t i = gtid; i < n8; i += gthreads) { const f32x4 a = *(const f32x4*)(src + i * 8), b = *(const f32x4*)(src + i * 8 + 4);
        v4u o; o.x = pk2(a[0], a[1]); o.y = pk2(a[2], a[3]); o.z = pk2(b[0], b[1]); o.w = pk2(b[2], b[3]); *(v4u*)(dst + i * 8) = o; }
}

struct Args { const float* in[16]; float* out; unsigned char* ws; int ph_lo, ph_hi; };
enum { I_X = 0, I_WIN, I_DLAM, I_SUBG, I_WBD, I_WBL, I_WO, I_LN1G, I_LN1B, I_PWQ, I_PKEYS, I_PU, I_PV, I_LN2G, I_LN2B, I_RELB };

__device__ __forceinline__ void p0_prologue(const Args& A, LAS unsigned char* lds, int vcu, int G, int wave, int lane) {
    unsigned char* ws = A.ws;
    const int gw = vcu * NWAVES + wave, NGW = G * NWAVES;
    const size_t gtid = (size_t)gw * 64 + lane, gthreads = (size_t)NGW * 64;
    LAS float* scr = (LAS float*)(lds + wave * 16384);
    constexpr int I_IN = (D / 64) * (INC / 32), I_BD = (512 / 64) * (D / 32), I_BL = (256 / 64) * (D / 32), I_O = (D / 64) * (D / 32);
    for (int it0 = gw; it0 < (I_IN + I_BD + I_BL + I_O) * NREP(32); it0 += NGW) {
        int r = it0 % (I_IN + I_BD + I_BL + I_O);
        if (r < I_IN) { p0_transpose_item(A.in[I_WIN], D, INC, (bf16*)(ws + WS_WIN), scr, r, lane); continue; } r -= I_IN;
        if (r < I_BD) { p0_transpose_item(A.in[I_WBD], 512, D, (bf16*)(ws + WS_WBD), scr, r, lane); continue; } r -= I_BD;
        if (r < I_BL) { p0_transpose_item(A.in[I_WBL], 256, D, (bf16*)(ws + WS_WBL), scr, r, lane); continue; } r -= I_BL;
        p0_transpose_item(A.in[I_WO], D, D, (bf16*)(ws + WS_WO), scr, r, lane);
    }
    for (int rep_ = 0; rep_ < NREP(31); ++rep_) cast_bf16(A.in[I_X], (bf16*)(ws + WS_A), (size_t)T * D / 8, gtid, gthreads);
    { const float* wq = A.in[I_PWQ]; const float* keys = A.in[I_PKEYS]; bf16* wp = (bf16*)(ws + WS_WP);
      for (int it0 = gw; it0 < 1024 * NREP(30); it0 += NGW) { const int it = it0 & 1023;
          const int hc = it >> 6, jb = (it >> 2) & 15, nq = it & 3, j = jb * 64 + lane;
          const f32x4* wr_ = (const f32x4*)(wq + (size_t)j * 2048 + hc * 128);
          f32x4 w[32];
#pragma unroll
          for (int d = 0; d < 32; ++d) w[d] = wr_[d];
#pragma unroll 1
          for (int n = nq * 32; n < nq * 32 + 32; ++n) {
              const f32x4* kr = (const f32x4*)(keys + (size_t)(hc * 128 + n) * 128);
              float a0 = 0.f, a1 = 0.f, a2 = 0.f, a3 = 0.f;
#pragma unroll
              for (int d = 0; d < 32; ++d) { const f32x4 k = kr[d]; a0 += w[d][0] * k[0]; a1 += w[d][1] * k[1]; a2 += w[d][2] * k[2]; a3 += w[d][3] * k[3]; }
              wp[(size_t)(hc * 128 + n) * 1024 + j] = (bf16)f2bf((a0 + a1) + (a2 + a3));
          }
      } }
    { const float* relb = A.in[I_RELB]; float* bd = (float*)(ws + WS_BIASD); float* bl = (float*)(ws + WS_BIASL);
      for (size_t i = gtid; i < 4 * BIAS_TAB; i += gthreads) { const int h = (int)(i / BIAS_TAB), dist = (int)(i % BIAS_TAB) - BIAS_GUARD; bd[i] = dist < 0 ? 0.f : relb[rel_bucket(dist) * 16 + h] * LOG2E; }
      for (size_t i = gtid; i < 12 * 132; i += gthreads) { const int gh = (int)(i / 132), j = (int)(i % 132), g = gh >> 2; const int dl = (g == 0) ? 1 : (g == 1) ? 4 : 16;
          bl[i] = relb[rel_bucket((j > 128 ? 128 : j) * dl) * 16 + 4 + gh] * LOG2E; } }
}

__device__ __forceinline__ void p5_ln1(const Args& A, int vcu, int G, int wave, int lane) {
    unsigned char* ws = A.ws;
    const int gw = vcu * NWAVES + wave, NGW = G * NWAVES;
    const float* R = (const float*)(ws + WS_R); bf16* x1b = (bf16*)(ws + WS_A);
    const float* gam = A.in[I_LN1G]; const float* bet = A.in[I_LN1B];
    f32x4 gv[4], bv[4];
#pragma unroll
    for (int j = 0; j < 4; ++j) { gv[j] = *(const f32x4*)(gam + 256 * j + 4 * lane); bv[j] = *(const f32x4*)(bet + 256 * j + 4 * lane); }
    for (int mrow = gw; mrow < T; mrow += NGW) {
        const f32x4* xr = (const f32x4*)(R + (size_t)mrow * D) + lane;
        f32x4 v[4]; float s = 0.f;
#pragma unroll
        for (int j = 0; j < 4; ++j) { v[j] = xr[64 * j]; s += (v[j][0] + v[j][1]) + (v[j][2] + v[j][3]); }
        const float mean = wave_sum(s) * (1.f / D); float s2 = 0.f;
#pragma unroll
        for (int j = 0; j < 4; ++j) { v[j] = v[j] - mean; s2 += (v[j][0] * v[j][0] + v[j][1] * v[j][1]) + (v[j][2] * v[j][2] + v[j][3] * v[j][3]); }
        const float rstd = __builtin_amdgcn_rsqf(wave_sum(s2) * (1.f / D) + LN_EPS);
        v2u* brow = (v2u*)(x1b + (size_t)mrow * D) + lane;
#pragma unroll
        for (int j = 0; j < 4; ++j) { const f32x4 y = v[j] * rstd * gv[j] + bv[j]; v2u w; w.x = pk2(y[0], y[1]); w.y = pk2(y[2], y[3]); brow[64 * j] = w; }
    }
}
namespace peer {
__device__ __forceinline__ int mono(float v) { const int b = __float_as_int(v); return b ^ ((b >> 31) & 0x7fffffff); }
__device__ __forceinline__ float unmono(int k) { return __int_as_float(k ^ ((k >> 31) & 0x7fffffff)); }
__device__ __forceinline__ int med3i(int a, int b, int c) { int r; asm("v_med3_i32 %0, %1, %2, %3" : "=v"(r) : "v"(a), "v"(b), "v"(c)); return r; }
#define PEER_INS16(a, x) do { _Pragma("unroll") for (int k_ = 15; k_ >= 1; --k_) a[k_] = med3i(a[k_ - 1], a[k_], (x)); a[0] = max(a[0], (x)); } while (0)
__device__ __forceinline__ unsigned byte_sel(const unsigned (&p)[4], int i) { const int w = i >> 2; const unsigned x = (w == 0) ? p[0] : (w == 1) ? p[1] : (w == 2) ? p[2] : p[3]; return (x >> ((i & 3) * 8)) & 0xffu; }
__device__ __forceinline__ float gelu_erf(float v) { return 0.5f * v * (1.f + erff(v * 0.7071067811865476f)); }

__device__ __forceinline__ void select(const float* ST, v2u* sel, int tok, int head) {
    int a0[16], a1[16];
#pragma unroll
    for (int k = 0; k < 16; ++k) { a0[k] = (int)0x80000000; a1[k] = (int)0x80000000; }
    const float* s0 = ST + (size_t)(head * 256) * T + tok; const float* s1 = s0 + (size_t)128 * T;
#pragma unroll 8
    for (int n = 0; n < 128; ++n) { const int k = (mono(s0[(size_t)n * T]) & ~127) | (127 - n); PEER_INS16(a0, k); }
#pragma unroll 8
    for (int n = 0; n < 128; ++n) { const int k = (mono(s1[(size_t)n * T]) & ~127) | (127 - n); PEER_INS16(a1, k); }
    float v0[16], v1[16]; unsigned i0p[4] = {0u, 0u, 0u, 0u}, i1p[4] = {0u, 0u, 0u, 0u};
#pragma unroll
    for (int k = 0; k < 16; ++k) { v0[k] = unmono((a0[k] & ~127) | 64); v1[k] = unmono((a1[k] & ~127) | 64);
        i0p[k >> 2] |= (unsigned)(127 - (a0[k] & 127)) << (8 * (k & 3)); i1p[k >> 2] |= (unsigned)(127 - (a1[k] & 127)) << (8 * (k & 3)); }
    int cd[16];
#pragma unroll
    for (int k = 0; k < 16; ++k) cd[k] = (int)0x80000000;
#pragma unroll
    for (int i = 0; i < 16; ++i)
#pragma unroll
        for (int j = 0; j < 16; ++j)
            if ((i + 1) * (j + 1) <= 16) { const int k = (mono(v0[i] + v1[j]) & ~255) | (255 - (i * 16 + j)); PEER_INS16(cd, k); }
    float sv[16], ex[16], sum = 0.f; unsigned eid[16];
#pragma unroll
    for (int k = 0; k < 16; ++k) { const int code = 255 - (cd[k] & 255); eid[k] = byte_sel(i0p, code >> 4) * 128u + byte_sel(i1p, code & 15); sv[k] = unmono((cd[k] & ~255) | 128); }
#pragma unroll
    for (int k = 0; k < 16; ++k) { ex[k] = __expf(sv[k] - sv[0]); sum += ex[k]; }
    const float rs = 1.f / sum;
    v4u* dst = (v4u*)(sel + ((size_t)tok * 8 + head) * 16);
#pragma unroll
    for (int k = 0; k < 8; ++k) { v4u w; w.x = eid[2 * k]; w.y = __float_as_uint(ex[2 * k] * rs); w.z = eid[2 * k + 1]; w.w = __float_as_uint(ex[2 * k + 1] * rs); dst[k] = w; }
}

typedef float f32x2w __attribute__((ext_vector_type(2)));
struct G4 { const unsigned char* U8; const unsigned char* V8; const float* isu; const float* isv; };
__device__ __forceinline__ v2u peer_ec(const v2u lo, const v2u hi, int c) { const unsigned mk = (c < 4) ? 0xffffffffu : 0u; v2u r; r.x = (lo.x & mk) | (hi.x & ~mk); r.y = (lo.y & mk) | (hi.y & ~mk); return r; }
#define PEER_EC(en, c) peer_ec((en)[0], (en)[1], (c))
__device__ __forceinline__ void a_load(v4u (&uu)[16], const v2u ec, int c, const unsigned char* U8, int lane) {
#pragma unroll
    for (int j = 0; j < 16; ++j) { const unsigned e = __builtin_amdgcn_readlane(ec.x, 16 * (c & 3) + j); uu[j] = *(const v4u*)(U8 + (size_t)e * D + 16 * lane); }
}
__device__ __forceinline__ void a_step(const v4u (&uu)[16], v2u (&en)[2], int c, const LAS f32x4* xl, const G4& T, int lane) {
    const v2u ec = PEER_EC(en, c);
    const int ls = 16 * (c & 3) + (lane >> 2);
    const unsigned eq = (unsigned)__shfl((int)ec.x, ls); const float gq = __uint_as_float((unsigned)__shfl((int)ec.y, ls));
    const float su = T.isu[eq], sv = T.isv[eq];
    f32x4 xv[4];
#pragma unroll
    for (int q = 0; q < 4; ++q) xv[q] = xl[q * 64];
    float part[16];
#pragma unroll
    for (int j = 0; j < 16; ++j) { f32x2w d = {0.f, 0.f};
#pragma unroll
        for (int q = 0; q < 4; ++q) { const unsigned w = uu[j][q]; const f32x2w a = __builtin_amdgcn_cvt_pk_f32_fp8((int)w, false), b = __builtin_amdgcn_cvt_pk_f32_fp8((int)w, true);
            d += (f32x2w){xv[q][0], xv[q][1]} * a; d += (f32x2w){xv[q][2], xv[q][3]} * b; }
        part[j] = d[0] + d[1]; }
    float r8[8], r4[4], r2[2], r1;
#pragma unroll
    for (int i = 0; i < 8; ++i) { auto sw = __builtin_amdgcn_permlane32_swap(__float_as_uint(part[i]), __float_as_uint(part[i + 8]), false, false); r8[i] = __uint_as_float(sw[0]) + __uint_as_float(sw[1]); }
#pragma unroll
    for (int i = 0; i < 4; ++i) { auto sw = __builtin_amdgcn_permlane16_swap(__float_as_uint(r8[i]), __float_as_uint(r8[i + 4]), false, false); r4[i] = __uint_as_float(sw[0]) + __uint_as_float(sw[1]); }
#pragma unroll
    for (int i = 0; i < 2; ++i) { const bool up = (lane & 8) != 0; const float send = up ? r4[i] : r4[i + 2], keep = up ? r4[i + 2] : r4[i]; r2[i] = keep + __shfl_xor(send, 8); }
    { const bool up = (lane & 4) != 0; const float send = up ? r2[0] : r2[1], keep = up ? r2[1] : r2[0]; r1 = keep + __shfl_xor(send, 4); }
    r1 += __shfl_xor(r1, 2); r1 += __shfl_xor(r1, 1);
    const float wgt = gq * gelu_erf(r1 * su) * sv;
    const int rel = lane - 16 * (c & 3);
    const float wv = __shfl(wgt, 4 * (rel & 15));
    const bool mine = (rel >= 0) && (rel < 16);
    const bool lo_ = mine && (c < 4), hi_ = mine && (c >= 4);
    en[0].y = lo_ ? __float_as_uint(wv) : en[0].y; en[1].y = hi_ ? __float_as_uint(wv) : en[1].y;
}
__device__ __forceinline__ void b_load8(v4u (&vv)[8], const v2u ec, int c, int h8, const unsigned char* V8, int lane) {
#pragma unroll
    for (int j = 0; j < 8; ++j) { const unsigned e = __builtin_amdgcn_readlane(ec.x, 16 * (c & 3) + 8 * h8 + j); vv[j] = *(const v4u*)(V8 + (size_t)e * D + 16 * lane); }
}
__device__ __forceinline__ void b_step8(const v4u (&vv)[8], const v2u ec, int c, int h8, f32x2w (&acc)[8]) {
#pragma unroll
    for (int j = 0; j < 8; ++j) { const float w = __uint_as_float(__builtin_amdgcn_readlane(ec.y, 16 * (c & 3) + 8 * h8 + j)); const f32x2w w2 = {w, w};
#pragma unroll
        for (int q = 0; q < 4; ++q) { const unsigned x = vv[j][q]; const f32x2w a = __builtin_amdgcn_cvt_pk_f32_fp8((int)x, false), b = __builtin_amdgcn_cvt_pk_f32_fp8((int)x, true);
            acc[2 * q] += w2 * a; acc[2 * q + 1] += w2 * b; } }
}
__device__ __forceinline__ void b_load(v4u (&vv)[16], const v2u ec, int c, const unsigned char* V8, int lane) {
#pragma unroll
    for (int j = 0; j < 16; ++j) { const unsigned e = __builtin_amdgcn_readlane(ec.x, 16 * (c & 3) + j); vv[j] = *(const v4u*)(V8 + (size_t)e * D + 16 * lane); }
}
__device__ __forceinline__ void b_step(const v4u (&vv)[16], const v2u ec, int c, f32x2w (&acc)[8]) {
#pragma unroll
    for (int j = 0; j < 16; ++j) { const float w = __uint_as_float(__builtin_amdgcn_readlane(ec.y, 16 * (c & 3) + j)); const f32x2w w2 = {w, w};
#pragma unroll
        for (int q = 0; q < 4; ++q) { const unsigned x = vv[j][q]; const f32x2w a = __builtin_amdgcn_cvt_pk_f32_fp8((int)x, false), b = __builtin_amdgcn_cvt_pk_f32_fp8((int)x, true);
            acc[2 * q] += w2 * a; acc[2 * q + 1] += w2 * b; } }
}
__device__ __forceinline__ void tok_finish(const LAS f32x4* xl, const f32x2w (&acc)[8], float* xrow, const float* gam, const float* bet, int lane) {
    float rr[16], s = 0.f;
#pragma unroll
    for (int q = 0; q < 4; ++q) { const f32x4 xv = xl[q * 64];
#pragma unroll
        for (int e = 0; e < 4; ++e) { const int k = 4 * q + e; rr[k] = ALPHA * xv[e] + acc[k >> 1][k & 1]; s += rr[k]; } }
    const float mean = wave_sum(s) * (1.f / D); float s2 = 0.f;
#pragma unroll
    for (int k = 0; k < 16; ++k) { rr[k] -= mean; s2 += rr[k] * rr[k]; }
    const float rstd = __builtin_amdgcn_rsqf(wave_sum(s2) * (1.f / D) + LN_EPS);
#pragma unroll
    for (int q = 0; q < 4; ++q) { const f32x4 g = *(const f32x4*)(gam + 16 * lane + 4 * q), bb = *(const f32x4*)(bet + 16 * lane + 4 * q);
        f32x4 y; y[0] = rr[4 * q] * rstd * g[0] + bb[0]; y[1] = rr[4 * q + 1] * rstd * g[1] + bb[1]; y[2] = rr[4 * q + 2] * rstd * g[2] + bb[2]; y[3] = rr[4 * q + 3] * rstd * g[3] + bb[3];
        *(f32x4*)(xrow + 4 * q) = y; }
}
__device__ __forceinline__ void gather4(const v2u* sel, const G4& T, const float* rin, const float* g1, const float* b1, float* xo, const float* gam, const float* bet, int tok0, int lane, LAS f32x4* xl, LAS v2u* srt) {
    v2u en[4][2];
#pragma unroll
    for (int tt = 0; tt < 4; ++tt) { const float* rrow = rin + (size_t)(tok0 + tt) * D + 16 * lane;
        {
            f32x4 rv[4]; float s = 0.f;
#pragma unroll
            for (int q = 0; q < 4; ++q) { rv[q] = *(const f32x4*)(rrow + 4 * q); s += (rv[q][0] + rv[q][1]) + (rv[q][2] + rv[q][3]); }
            const float mean = wave_sum(s) * (1.f / D); float s2 = 0.f;
#pragma unroll
            for (int q = 0; q < 4; ++q) { rv[q] = rv[q] - mean; s2 += (rv[q][0] * rv[q][0] + rv[q][1] * rv[q][1]) + (rv[q][2] * rv[q][2] + rv[q][3] * rv[q][3]); }
            const float rstd = __builtin_amdgcn_rsqf(wave_sum(s2) * (1.f / D) + LN_EPS);
#pragma unroll
            for (int q = 0; q < 4; ++q) { const f32x4 gg = *(const f32x4*)(g1 + 16 * lane + 4 * q), bb = *(const f32x4*)(b1 + 16 * lane + 4 * q); xl[tt * 256 + q * 64] = rv[q] * rstd * gg + bb; }
        }
        const v2u e0 = sel[(size_t)(tok0 + tt) * 128 + lane], e1 = sel[(size_t)(tok0 + tt) * 128 + 64 + lane];
        const unsigned b0 = e0.x >> 9, b1 = e1.x >> 9; unsigned d0 = 0u, d1 = 0u, base = 0u;
#pragma unroll
        for (unsigned k = 0; k < 32; ++k) { const unsigned long long m0 = __ballot(b0 == k), m1 = __ballot(b1 == k);
            const unsigned c0 = (unsigned)__builtin_popcountll(m0), c1 = (unsigned)__builtin_popcountll(m1);
            const unsigned p0 = __builtin_amdgcn_mbcnt_hi((unsigned)(m0 >> 32), __builtin_amdgcn_mbcnt_lo((unsigned)m0, 0u)), p1 = __builtin_amdgcn_mbcnt_hi((unsigned)(m1 >> 32), __builtin_amdgcn_mbcnt_lo((unsigned)m1, 0u));
            d0 = (b0 == k) ? base + p0 : d0; d1 = (b1 == k) ? base + c0 + p1 : d1; base += c0 + c1; }
        srt[d0] = e0; srt[d1] = e1;
        asm volatile("s_waitcnt lgkmcnt(0)" ::: "memory");
        en[tt][0] = srt[lane]; en[tt][1] = srt[64 + lane];
        asm volatile("s_waitcnt lgkmcnt(0)" ::: "memory");
    }
    {
#pragma unroll 1
        for (int c = 0; c < 8; ++c) {
            v4u ua[16], ub[16];
            a_load(ua, PEER_EC(en[0], c), c, T.U8, lane); a_load(ub, PEER_EC(en[1], c), c, T.U8, lane); __builtin_amdgcn_sched_barrier(0);
            a_step(ua, en[0], c, xl + 0 * 256, T, lane); __builtin_amdgcn_sched_barrier(0);
            a_load(ua, PEER_EC(en[2], c), c, T.U8, lane); __builtin_amdgcn_sched_barrier(0);
            a_step(ub, en[1], c, xl + 1 * 256, T, lane); __builtin_amdgcn_sched_barrier(0);
            a_load(ub, PEER_EC(en[3], c), c, T.U8, lane); __builtin_amdgcn_sched_barrier(0);
            a_step(ua, en[2], c, xl + 2 * 256, T, lane); __builtin_amdgcn_sched_barrier(0);
            a_step(ub, en[3], c, xl + 3 * 256, T, lane); __builtin_amdgcn_sched_barrier(0);
        }
    }
    f32x2w acc[4][8];
#pragma unroll
    for (int tt = 0; tt < 4; ++tt)
#pragma unroll
        for (int q = 0; q < 8; ++q) acc[tt][q] = (f32x2w){0.f, 0.f};
    {
#define PEER_SB() __builtin_amdgcn_sched_barrier(0)
#pragma unroll 1
        for (int c = 0; c < 8; ++c) {
            const v2u e0 = PEER_EC(en[0], c), e1 = PEER_EC(en[1], c), e2 = PEER_EC(en[2], c), e3 = PEER_EC(en[3], c);
            v4u va[8], vb[8], vc[8];
            b_load8(va, e0, c, 0, T.V8, lane); b_load8(vb, e0, c, 1, T.V8, lane); PEER_SB();
            b_load8(vc, e1, c, 0, T.V8, lane); PEER_SB(); b_step8(va, e0, c, 0, acc[0]); PEER_SB();
            b_load8(va, e1, c, 1, T.V8, lane); PEER_SB(); b_step8(vb, e0, c, 1, acc[0]); PEER_SB();
            b_load8(vb, e2, c, 0, T.V8, lane); PEER_SB(); b_step8(vc, e1, c, 0, acc[1]); PEER_SB();
            b_load8(vc, e2, c, 1, T.V8, lane); PEER_SB(); b_step8(va, e1, c, 1, acc[1]); PEER_SB();
            b_load8(va, e3, c, 0, T.V8, lane); PEER_SB(); b_step8(vb, e2, c, 0, acc[2]); PEER_SB();
            b_load8(vb, e3, c, 1, T.V8, lane); PEER_SB(); b_step8(vc, e2, c, 1, acc[2]); PEER_SB();
            b_step8(va, e3, c, 0, acc[3]); PEER_SB(); b_step8(vb, e3, c, 1, acc[3]); PEER_SB();
        }
#undef PEER_SB
    }
#pragma unroll
    for (int tt = 0; tt < 4; ++tt) tok_finish(xl + tt * 256, acc[tt], xo + (size_t)(tok0 + tt) * D + 16 * lane, gam, bet, lane);
}
#undef PEER_EC
__device__ __forceinline__ void row_to_fp8(const float* src, unsigned char* dst, float* inv, int row, int lane) {
    const float* p = src + (size_t)row * D + 16 * lane;
    f32x4 v[4]; float am = 0.f;
#pragma unroll
    for (int q = 0; q < 4; ++q) { v[q] = *(const f32x4*)(p + 4 * q); am = fmaxf(am, fmaxf(fmaxf(fabsf(v[q][0]), fabsf(v[q][1])), fmaxf(fabsf(v[q][2]), fabsf(v[q][3])))); }
    am = wave_max(am);
    float s = 1.f, is = 1.f;
    if (am > 1e-30f) { const int eb = (__float_as_int(224.f / am) >> 23) & 0xff; if (eb > 0 && eb < 254) { s = __int_as_float(eb << 23); is = __int_as_float((254 - eb) << 23); } }
    v4u o;
#pragma unroll
    for (int q = 0; q < 4; ++q) { int w = 0; w = __builtin_amdgcn_cvt_pk_fp8_f32(v[q][0] * s, v[q][1] * s, w, false); w = __builtin_amdgcn_cvt_pk_fp8_f32(v[q][2] * s, v[q][3] * s, w, true); o[q] = (unsigned)w; }
    *(v4u*)(dst + (size_t)row * D + 16 * lane) = o;
    if (lane == 0) inv[row] = is;
}
}
constexpr int NPH = 8;
__global__ void __launch_bounds__(NWAVES * 64, 2) mk_fwd(Args args) {
    extern __shared__ __attribute__((aligned(16))) unsigned char lds_raw[];
    LAS unsigned char* lds = (LAS unsigned char*)lds_raw;
    volatile LAS unsigned* MISC = (volatile LAS unsigned*)(lds + MISC_OFF);
    const int tid0 = threadIdx.x, lane0 = tid0 & 63, wave = __builtin_amdgcn_readfirstlane(tid0 >> 6);
    const int G = gridDim.x, bx = blockIdx.x, vcu = (G % 8 == 0) ? (bx % 8) * (G / 8) + bx / 8 : bx;
    unsigned char* ws0 = args.ws;
    gu32* ctl = (gu32*)(ws0 + WS_CTL);
    for (int u = tid0; u < (LDS_BYTES - RING_BYTES) / 4; u += NWAVES * 64) ((LAS unsigned*)(lds + RING_BYTES))[u] = 0u;
    __syncthreads();
    XcdBarrier bar; bar.bar = (unsigned*)(ctl + CW_BAR); bar.x = 0; bar.st = nullptr;
    if (MK_N_LAUNCHES == 1) bar = xcd_barrier_post((unsigned*)(ctl + CW_BAR), MISC + 8);
    const int lo = args.ph_lo, hi = args.ph_hi;
#ifndef PH_MASK
#define PH_MASK 0xFF
#endif
#define IN(k) ((((PH_MASK) >> (k)) & 1) && lo <= (k) && (k) < hi)
#define SEAM(k) do { if (IN(k) && IN((k) + 1)) xcd_barrier(bar); } while (0)
    const int NGW = G * NWAVES;
#define SUB_BEGIN() unsigned char* ws = ws0; asm volatile("" : "+s"(ws)); const int lane = (int)__builtin_amdgcn_mbcnt_hi(~0u, __builtin_amdgcn_mbcnt_lo(~0u, 0u)), tid = wave * 64 + lane; (void)tid; (void)lane
#define PHASE_BEGIN() unsigned char* ws = ws0; asm volatile("" : "+s"(ws)); const int lane = (int)__builtin_amdgcn_mbcnt_hi(~0u, __builtin_amdgcn_mbcnt_lo(~0u, 0u)), tid = wave * 64 + lane; const int gw = vcu * NWAVES + wave; (void)gw; (void)lane; (void)tid

    if (IN(0)) { PHASE_BEGIN(); p0_prologue(args, lds, vcu, G, wave, lane); VM_WAIT(); __syncthreads(); SEAM(0); }

    if (IN(1)) { PHASE_BEGIN();
        pg8::Gemm g{(const pg8::bf16_t*)(ws + WS_A), (const pg8::bf16_t*)(ws + WS_WIN), T, INC, D}; pg8::StaticOrder S; S.init(T, INC, G, bx); S.rep = NREP(1);
        pg8::EpiInProj E{(pg8::bf16_t*)(ws + WS_QD), (pg8::bf16_t*)(ws + WS_KD), (pg8::bf16_t*)(ws + WS_VD), (pg8::bf16_t*)(ws + WS_LQ), (pg8::bf16_t*)(ws + WS_LK), (pg8::bf16_t*)(ws + WS_LV),
                         (pg8::bf16_t*)(ws + WS_GA), (pg8::bf16_t*)(ws + WS_GB)};
        pg8::gemm_phase<pg8::EpiInProj, pg8::StaticOrder, true, true>(lds, g, S, E);
        {
            const int nwg = (T / 256) * (INC / 256), rem = nwg % G, nshort = rem ? G - rem : G, first = rem ? rem : 0;
            if (bx >= first) { const int cw = (bx - first) * NWAVES + wave, ncw = nshort * NWAVES;
                for (int row = cw; row < 2 * NEXP; row += ncw) {
                    if (row < NEXP) peer::row_to_fp8(args.in[I_PU], ws + WS_UU, (float*)(ws + WS_ISU), row, lane);
                    else peer::row_to_fp8(args.in[I_PV], ws + WS_UV, (float*)(ws + WS_ISV), row - NEXP, lane);
                } }
        }
        SEAM(1);
    }

    if (IN(2)) { PHASE_BEGIN();
#ifndef NO_DIFF
        {   SUB_BEGIN();
            const da::Tensors X{(const bf16*)(ws + WS_QD), (const bf16*)(ws + WS_KD), (const bf16*)(ws + WS_VD), (float*)(ws + WS_STASH), (bf16*)(ws + WS_YA),
                                args.in[I_DLAM], args.in[I_SUBG], args.in[I_RELB]};
            int cur_h = -1;
            float lam; { const float* dl = args.in[I_DLAM]; const float p1 = dl[lane] * dl[64 + lane], p2 = dl[128 + lane] * dl[192 + lane];
                lam = __uint_as_float(__builtin_amdgcn_readfirstlane(__float_as_uint(__expf(wave_sum(p1)) - __expf(wave_sum(p2)) + LAM_INIT))); }
            for (int rep_ = 0; rep_ < NREP(20); ++rep_)
            for (int p = vcu; p < 256; p += G) {
                const int bh = p >> 5, s = p & 31, b = bh >> 2, h = bh & 3;
                if (h != cur_h) {
                    __syncthreads();
                    const float* bd = (const float*)(ws + WS_BIASD) + h * BIAS_TAB; asm volatile("" : "+s"(bd));
                    for (int i = tid; i < BIAS_TAB; i += NWAVES * 64) ((LAS float*)(lds + da::LDS_BIAS))[i] = bd[i];
                    __syncthreads(); cur_h = h;
                }
                const float c31 = args.in[I_RELB][31 * 16 + h] * LOG2E;
                for (int k2 = 0; k2 < 2; ++k2) da::unit(X, b, h, k2 ? 63 - s : s, lds, bx, lam, c31);
            }
        }
#endif
#ifndef NO_DIL
        {   SUB_BEGIN();
            const dil::Tensors X{(const bf16*)(ws + WS_LQ), (const bf16*)(ws + WS_LK), (const bf16*)(ws + WS_LV), (bf16*)(ws + WS_YB)};
            int cur_h = -1;
            for (int rep_ = 0; rep_ < NREP(21); ++rep_)
            for (int u = vcu; u < 256; u += G) {
                const int bh = u >> 5, blk = u & 31, b = bh >> 2, h = bh & 3;
                if (h != cur_h) {
                    __syncthreads();
                    const float* blsrc = (const float*)(ws + WS_BIASL);
                    for (int i = tid; i < 3 * dil::BT; i += NWAVES * 64) { const int g = i / dil::BT, jj = i % dil::BT - dil::BT0;
                        ((LAS float*)(lds + dil::LDS_BL))[i] = (jj >= 0 && jj <= 128) ? blsrc[(g * 4 + h) * 132 + jj] : 0.f; }
                    __syncthreads(); cur_h = h;
                }
                float* lse0 = (float*)(ws + WS_LSE0);
                for (int k2 = 0; k2 < 2; ++k2) dil::wave_tile_g0(X, lse0, b, h, blk * 512 + (wave + 8 * k2) * 32, lds + dil::LDS_VST + wave * 4096, (const LAS float*)(lds + dil::LDS_BL), lane);
                VM_WAIT(); __syncthreads();
                for (int k2 = 0; k2 < 2; ++k2) dil::wave_tile(X, lse0, b, h, blk * 512, wave + 8 * k2, lds + dil::LDS_VST + wave * 4096, (const LAS float*)(lds + dil::LDS_BL), lane);
            }
            __syncthreads();
        }
#endif
        SEAM(2);
    }

    if (IN(3)) { PHASE_BEGIN();
        { pg8::Gemm g{(const pg8::bf16_t*)(ws + WS_YA), (const pg8::bf16_t*)(ws + WS_WBD), T, D, 512}; pg8::StaticOrder S; S.init(T, D, G, bx); S.rep = NREP(3);
          pg8::EpiGate1 E{(const pg8::bf16_t*)(ws + WS_GA), (pg8::bf16_t*)(ws + WS_GATED)};
          pg8::gemm_phase<pg8::EpiGate1, pg8::StaticOrder, true, true>(lds, g, S, E); }
        VM_WAIT(); __syncthreads();
        { pg8::Gemm g{(const pg8::bf16_t*)(ws + WS_YB), (const pg8::bf16_t*)(ws + WS_WBL), T, D, 256}; pg8::StaticOrder S; S.init(T, D, G, bx);
          pg8::EpiGate2 E{(const pg8::bf16_t*)(ws + WS_GB), (pg8::bf16_t*)(ws + WS_GATED)};
          pg8::gemm_phase<pg8::EpiGate2, pg8::StaticOrder, true, true>(lds, g, S, E); }
        SEAM(3);
    }

    if (IN(4)) { PHASE_BEGIN();
        pg8::Gemm g{(const pg8::bf16_t*)(ws + WS_GATED), (const pg8::bf16_t*)(ws + WS_WO), T, D, D}; pg8::StaticOrder S; S.init(T, D, G, bx); S.rep = NREP(4);
        pg8::EpiOut E{args.in[I_X], (float*)(ws + WS_R)};
        pg8::gemm_phase<pg8::EpiOut, pg8::StaticOrder, true, true>(lds, g, S, E);
        SEAM(4);
    }

    if (IN(5)) { PHASE_BEGIN();
        p5_ln1(args, vcu, G, wave, lane);
        SEAM(5);
    }

    if (IN(6)) { PHASE_BEGIN();
        pg8::Gemm g{(const pg8::bf16_t*)(ws + WS_WP), (const pg8::bf16_t*)(ws + WS_A), 2048, T, D}; pg8::StaticOrder S; S.init(2048, T, G, bx); S.rep = NREP(6);
        pg8::EpiScoreT E{(float*)(ws + WS_ST)};
        pg8::gemm_phase<pg8::EpiScoreT, pg8::StaticOrder, true, true>(lds, g, S, E);
        SEAM(6);
    }

    if (IN(7)) { PHASE_BEGIN();
        const float* ST = (const float*)(ws + WS_ST); v2u* sel = (v2u*)(ws + WS_SEL);
        for (int u = vcu; u < T / 128; u += G) {
            for (int p = 0; p < 2; ++p) peer::select(ST, sel, u * 128 + p * 64 + lane, wave);
            VM_WAIT(); __syncthreads();
            { const peer::G4 TB{ws + WS_UU, ws + WS_UV, (const float*)(ws + WS_ISU), (const float*)(ws + WS_ISV)};
              for (int i = 0; i < 4; ++i) peer::gather4(sel, TB, (const float*)(ws + WS_R), args.in[I_LN1G], args.in[I_LN1B], args.out, args.in[I_LN2G], args.in[I_LN2B], u * 128 + i * 32 + wave * 4, lane, (LAS f32x4*)(lds + wave * 16384) + lane, (LAS v2u*)(lds + RING_BYTES + 2048 + wave * 1024)); }
            VM_WAIT(); __syncthreads();
        }
    }
#undef IN
#undef SEAM
}

extern "C" void kernel_launch(void* const* d_in, const int* in_sizes, int n_in, void* d_out, int out_size, void* d_ws, size_t ws_size, hipStream_t stream) {
    static int grid = 0;
    if (grid == 0) {
        if (n_in != 16 || in_sizes[0] != T * D || out_size != T * D || ws_size < WS_END) { fprintf(stderr, "kernel_launch: unexpected shapes (n_in %d, in0 %d, out %d, ws %zu); nothing launched\n", n_in, n_in > 0 ? in_sizes[0] : -1, out_size, ws_size); grid = -1; return; }
        int dev = 0, cus = 0, per_cu = 0;
        if (hipGetDevice(&dev) != hipSuccess || hipDeviceGetAttribute(&cus, hipDeviceAttributeMultiprocessorCount, dev) != hipSuccess) { grid = -1; return; }
        if (hipFuncSetAttribute((const void*)mk_fwd, hipFuncAttributeMaxDynamicSharedMemorySize, LDS_BYTES) != hipSuccess) { fprintf(stderr, "kernel_launch: hipFuncSetAttribute failed\n"); grid = -1; return; }
        if (hipOccupancyMaxActiveBlocksPerMultiprocessor(&per_cu, (const void*)mk_fwd, NWAVES * 64, LDS_BYTES) != hipSuccess || per_cu < 1) { fprintf(stderr, "kernel_launch: occupancy query reports %d\n", per_cu); per_cu = 1; }
        (void)hipGetLastError();
        grid = cus;
    }
    if (grid < 0) return;
    if (hipMemsetAsync((char*)d_ws + WS_CTL, 0, CTL_ZERO_BYTES, stream) != hipSuccess) return;
    Args a{};
    for (int i = 0; i < 16; ++i) a.in[i] = (const float*)d_in[i];
    a.out = (float*)d_out; a.ws = (unsigned char*)d_ws;
    for (int li = 0; li < MK_N_LAUNCHES; ++li) {
        a.ph_lo = (MK_N_LAUNCHES == 1) ? 0 : li; a.ph_hi = (MK_N_LAUNCHES == 1) ? NPH : li + 1;
        hipLaunchKernelGGL(mk_fwd, dim3(grid), dim3(NWAVES * 64), LDS_BYTES, stream, a);
    }
}
```

```cpp
#include <hip/hip_runtime.h>
#include <cstdio>
#include <cstdint>

#ifndef MK_N_LAUNCHES
#define MK_N_LAUNCHES 1
#endif

#ifndef REPEAT_PH
#define REPEAT_PH (-1)
#endif
#define NREP(k) ((REPEAT_PH) == (k) ? 2 : 1)

constexpr int BATCH = 2, SEQ = 16384, T = BATCH * SEQ, D = 1024, INC = 5888;
constexpr int OFF_DQ = 0, OFF_DK = 512, OFF_DV = 1024, OFF_LQ = 1536, OFF_LK = 2304, OFF_LV = 3072, OFF_GA = 3840, OFF_GB = 4864;
constexpr int NEXP = 16384;
constexpr float LOG2E = 1.4426950408889634f;
constexpr float QSCALE = 0.125f * LOG2E;
constexpr float ALPHA = 1.189207115002721f;
constexpr float LN_EPS = 1e-5f, SUBLN_EPS = 1e-5f;
constexpr float LAM_INIT = 0.2f;
constexpr int NTILE = SEQ / 64;
constexpr int BIAS_TAB = 2112, BIAS_GUARD = 256, DFAR = 1513;

constexpr size_t MiB = 1u << 20;
constexpr size_t WS_CTL = 0, CTL_ZERO_BYTES = 1 * MiB;
constexpr size_t WS_BIASD = 1 * MiB;
constexpr size_t WS_BIASL = 1 * MiB + 64 * 1024;
constexpr size_t WS_WIN = 8 * MiB, WS_WO = 20 * MiB, WS_WBD = 22 * MiB, WS_WBL = 23 * MiB, WS_WP = 24 * MiB;
constexpr size_t WS_A = 32 * MiB;
constexpr size_t WS_YA = WS_A, WS_YB = WS_A + 32 * MiB;
constexpr size_t WS_QD = 96 * MiB, WS_KD = 128 * MiB, WS_VD = 160 * MiB, WS_LQ = 192 * MiB, WS_LK = 240 * MiB, WS_LV = 288 * MiB, WS_GA = 336 * MiB, WS_GB = 400 * MiB;
constexpr size_t WS_STASH = 464 * MiB;
constexpr size_t WS_SEL = 32 * MiB;
constexpr size_t WS_GATED = 96 * MiB;
constexpr size_t WS_R = 352 * MiB;
constexpr size_t WS_ST = 96 * MiB;
constexpr size_t WS_UU = 480 * MiB, WS_UV = 496 * MiB;
constexpr size_t WS_LSE0 = 3 * MiB;
constexpr size_t WS_ISU = 2 * MiB, WS_ISV = 2 * MiB + 65536;
constexpr size_t WS_END = 512 * MiB;

constexpr int CW_BAR = 4096;
constexpr int NWAVES = 8;
constexpr int RING_BYTES = 131072, MISC_OFF = RING_BYTES + 320, LDS_BYTES = 147456;

#define GAS __attribute__((address_space(1)))
#define LAS __attribute__((address_space(3)))
typedef unsigned short bf16;
typedef unsigned v4u __attribute__((ext_vector_type(4)));
typedef unsigned v2u __attribute__((ext_vector_type(2)));
typedef float f32x4 __attribute__((ext_vector_type(4)));
typedef float f32x16 __attribute__((ext_vector_type(16)));
typedef short bf16x8 __attribute__((ext_vector_type(8)));
typedef short s16x4 __attribute__((ext_vector_type(4)));
typedef __bf16 bf16x2 __attribute__((ext_vector_type(2)));
typedef GAS unsigned gu32;
#define RLX_AGENT __ATOMIC_RELAXED, __HIP_MEMORY_SCOPE_AGENT
#define LDS_WAIT() asm volatile("s_waitcnt lgkmcnt(0)" ::: "memory")
#define VM_WAIT() asm volatile("s_waitcnt vmcnt(0)" ::: "memory")
__device__ __forceinline__ unsigned f2bf(float f) { unsigned u = __builtin_bit_cast(unsigned, f); return (u + 0x7fffu + ((u >> 16) & 1u)) >> 16; }
__device__ __forceinline__ unsigned pk2(float lo, float hi) { return f2bf(lo) | (f2bf(hi) << 16); }
typedef float f32x2_t __attribute__((ext_vector_type(2)));
__device__ __forceinline__ unsigned cvtpk(float lo, float hi) { f32x2_t v = {lo, hi}; bf16x2 b = __builtin_convertvector(v, bf16x2); return __builtin_bit_cast(unsigned, b); }
__device__ __forceinline__ float bf_lo(unsigned w) { return __builtin_bit_cast(float, w << 16); }
__device__ __forceinline__ float bf_hi(unsigned w) { return __builtin_bit_cast(float, w & 0xffff0000u); }
__device__ __forceinline__ float dot2bf(unsigned a, unsigned b, float acc) { return __builtin_amdgcn_fdot2_f32_bf16(__builtin_bit_cast(bf16x2, a), __builtin_bit_cast(bf16x2, b), acc, false); }
__device__ __forceinline__ float wave_sum(float v) {
#pragma unroll
    for (int o = 1; o < 64; o <<= 1) v += __shfl_xor(v, o);
    return v;
}
__device__ __forceinline__ float wave_max(float v) {
#pragma unroll
    for (int o = 1; o < 64; o <<= 1) v = fmaxf(v, __shfl_xor(v, o));
    return v;
}
__device__ __forceinline__ int rel_bucket(int n) {
    if (n < 16) return n < 0 ? 0 : n;
    return 16 + (n >= 22) + (n >= 30) + (n >= 40) + (n >= 54) + (n >= 73) + (n >= 99) + (n >= 134) + (n >= 182) + (n >= 246) + (n >= 332) + (n >= 450) + (n >= 609) + (n >= 825) + (n >= 1117) + (n >= 1513);
}
namespace pg8 {
#define PG8_LAS __attribute__((address_space(3)))
typedef unsigned short bf16_t;
typedef short bf16x8 __attribute__((ext_vector_type(8)));
typedef float f32x4 __attribute__((ext_vector_type(4)));
typedef unsigned u32x4 __attribute__((ext_vector_type(4)));
constexpr int BM = 256, BK = 64, HALF = 128, HTB = HALF * BK * 2  , STAGE_BYTES = 8 * HTB, NXCD = 8, WGM = 8;

__host__ __device__ __forceinline__ int lds_byte(int r, int c) { const int st = (r >> 4) * 2 + (c >> 5), rr = r & 15, cc = c & 31, ob = rr * 64 + cc * 2; return st * 1024 + (ob ^ (((ob >> 9) & 1) << 5)); }
__host__ __device__ __forceinline__ void stage_rc(int b, int& R, int& C) { const int st = b / 1024, sb = b % 1024, swz = sb ^ (((sb >> 9) & 1) << 5); R = (st >> 1) * 16 + swz / 64; C = (st & 1) * 32 + (swz % 64) / 2; }
__host__ __device__ __forceinline__ int perm32(int rho) { const int n = rho >> 4, i = rho & 15; return 8 * (i >> 2) + 4 * n + (i & 3); }

struct Unit { int pm, pn; };
struct Gemm { const bf16_t* A; const bf16_t* Bt; int M, N, K; };

struct StaticOrder {
    int nM, nN, nwg, G, c;
    __host__ __device__ void init(int M, int N, int G_, int c_) { nM = M / BM; nN = N / BM; nwg = nM * nN; G = G_; c = c_; }
    int rep = 1;
    __host__ __device__ bool next(int i0, Unit& u) const {
        const int i = i0 / rep;
        const long L = (long)i * G + c; if (L >= nwg) return false;
        int wgid = (int)L; { const int q = nwg / NXCD, r = nwg % NXCD, xcd = wgid % NXCD, off = wgid / NXCD; wgid = (xcd < r ? xcd * (q + 1) : r * (q + 1) + (xcd - r) * q) + off; }
        const int nig = WGM * nN, gid = wgid / nig, fm = gid * WGM, gsz = (nM - fm) < WGM ? (nM - fm) : WGM;
        u.pm = fm + ((wgid % nig) % gsz); u.pn = (wgid % nig) / gsz; return true;
    }
    __device__ __forceinline__ void a_ready(const Unit&) const {}
    __device__ __forceinline__ void done(const Unit&) const {}
};
__device__ __forceinline__ unsigned cvt_pk_bf16(float lo, float hi) { unsigned r; asm volatile("v_cvt_pk_bf16_f32 %0, %1, %2" : "=v"(r) : "v"(lo), "v"(hi)); return r; }
__device__ __forceinline__ u32x4 pack8(const f32x4 v0, const f32x4 v1) { u32x4 w; w.x = cvt_pk_bf16(v0[0], v0[1]); w.y = cvt_pk_bf16(v0[2], v0[3]); w.z = cvt_pk_bf16(v1[0], v1[1]); w.w = cvt_pk_bf16(v1[2], v1[3]); return w; }
__device__ __forceinline__ float blo(unsigned w) { return __builtin_bit_cast(float, w << 16); }
__device__ __forceinline__ float bhi(unsigned w) { return __builtin_bit_cast(float, w & 0xffff0000u); }
__device__ __forceinline__ float sigm(float v) { return __builtin_amdgcn_rcpf(1.f + __expf(-v)); }
template <class E> __device__ __forceinline__ void epi_loop(const E& e, const f32x4 (&acc)[2][2][4][2], const Unit& u, int wr, int wc, int fr, int fq) {
#pragma unroll
    for (int ai = 0; ai < 2; ++ai)
#pragma unroll
        for (int m = 0; m < 4; ++m) { const int row = u.pm * BM + ai * HALF + wr * 64 + m * 16 + fr;
#pragma unroll
            for (int bj = 0; bj < 2; ++bj) { const int col = u.pn * BM + bj * HALF + wc * 32 + 8 * fq; e.item(u.pn, row, col, acc[ai][bj][m][0], acc[ai][bj][m][1]); } }
}

struct EpiInProj {
    static constexpr bool PERM = true, AFTER_DRAIN = false;
    bf16_t *Qd, *Kd, *Vd, *LQ, *LK, *LV, *GA, *GB;
    __device__ __forceinline__ void operator()(const f32x4 (&acc)[2][2][4][2], const Unit& u, int wr, int wc, int fr, int fq) const { epi_loop(*this, acc, u, wr, wc, fr, fq); }
    __device__ __forceinline__ void item(int pn, int row, int col, f32x4 v0, f32x4 v1) const {
            const int b = row >> 14, s = row & 16383; bf16_t* dst;
            if (pn < 2) {
                const int h = col >> 7, c = (col >> 6) & 1, d = col & 63; v0 = v0 * 0.18033688011112042f; v1 = v1 * 0.18033688011112042f;
                dst = Qd + ((size_t)((b * 4 + h) * 2 + c) * 16384 + s) * 64 + d;
            } else if (pn < 4) {
                const int cc = col - 512, h = cc >> 7, c = (cc >> 6) & 1, d = cc & 63;
                dst = Kd + ((((size_t)((b * 4 + h) * 2 + c) * 256 + (s >> 6)) * 8 + (d >> 3)) * 64 + (s & 63)) * 8;
            } else if (pn < 6) {
                const int cc = col - 1024, h = cc >> 7, d = cc & 127;
                dst = Vd + ((size_t)(b * 4 + h) * 256 + (s >> 6)) * 8192 + ((d >> 5) * 4 + ((s & 63) >> 4)) * 512 + (s & 15) * 32 + (d & 31);
            } else if (pn < 9) {
                v0 = v0 * 0.18033688011112042f; v1 = v1 * 0.18033688011112042f; dst = LQ + (size_t)row * 768 + (col - 1536);
            } else if (pn < 12) { dst = LK + (size_t)row * 768 + (col - 2304);
            } else if (pn < 15) { dst = LV + (size_t)row * 768 + (col - 3072);
            } else {
#pragma unroll
                for (int i = 0; i < 4; ++i) { v0[i] = sigm(v0[i]); v1[i] = sigm(v1[i]); }
                dst = (pn < 19) ? GA + (size_t)row * 1024 + (col - 3840) : GB + (size_t)row * 1024 + (col - 4864);
            }
            *(u32x4*)dst = pack8(v0, v1);
        }
};
struct EpiGate1 {
    static constexpr bool PERM = true, AFTER_DRAIN = false;
    const bf16_t* GA; bf16_t* G;
    __device__ __forceinline__ void operator()(const f32x4 (&acc)[2][2][4][2], const Unit& u, int wr, int wc, int fr, int fq) const { epi_loop(*this, acc, u, wr, wc, fr, fq); }
    __device__ __forceinline__ void item(int pn, int row, int col, f32x4 v0, f32x4 v1) const {
            const size_t o = (size_t)row * 1024 + col; const u32x4 g = *(const u32x4*)(GA + o);
            v0[0] *= blo(g.x); v0[1] *= bhi(g.x); v0[2] *= blo(g.y); v0[3] *= bhi(g.y); v1[0] *= blo(g.z); v1[1] *= bhi(g.z); v1[2] *= blo(g.w); v1[3] *= bhi(g.w);
            *(u32x4*)(G + o) = pack8(v0, v1);
        }
};
struct EpiGate2 {
    static constexpr bool PERM = true, AFTER_DRAIN = false;
    const bf16_t* GB; bf16_t* G;
    __device__ __forceinline__ void operator()(const f32x4 (&acc)[2][2][4][2], const Unit& u, int wr, int wc, int fr, int fq) const { epi_loop(*this, acc, u, wr, wc, fr, fq); }
    __device__ __forceinline__ void item(int pn, int row, int col, f32x4 v0, f32x4 v1) const {
            const size_t o = (size_t)row * 1024 + col; const u32x4 g = *(const u32x4*)(GB + o); const u32x4 p = *(const u32x4*)(G + o);
            v0[0] = v0[0] * blo(g.x) + blo(p.x); v0[1] = v0[1] * bhi(g.x) + bhi(p.x); v0[2] = v0[2] * blo(g.y) + blo(p.y); v0[3] = v0[3] * bhi(g.y) + bhi(p.y);
            v1[0] = v1[0] * blo(g.z) + blo(p.z); v1[1] = v1[1] * bhi(g.z) + bhi(p.z); v1[2] = v1[2] * blo(g.w) + blo(p.w); v1[3] = v1[3] * bhi(g.w) + bhi(p.w);
            *(u32x4*)(G + o) = pack8(v0, v1);
        }
};
struct EpiOut {
    static constexpr bool PERM = true, AFTER_DRAIN = false;
    const float* X; float* R;
    __device__ __forceinline__ void operator()(const f32x4 (&acc)[2][2][4][2], const Unit& u, int wr, int wc, int fr, int fq) const { epi_loop(*this, acc, u, wr, wc, fr, fq); }
    __device__ __forceinline__ void item(int pn, int row, int col, f32x4 v0, f32x4 v1) const {
            const size_t o = (size_t)row * 1024 + col; const f32x4 x0 = *(const f32x4*)(X + o), x1 = *(const f32x4*)(X + o + 4);
            *(f32x4*)(R + o) = x0 * 1.189207115002721f + v0; *(f32x4*)(R + o + 4) = x1 * 1.189207115002721f + v1;
    }
};
struct EpiScoreT {
    static constexpr bool PERM = true, AFTER_DRAIN = false;
    float* ST;
    __device__ __forceinline__ void operator()(const f32x4 (&acc)[2][2][4][2], const Unit& u, int wr, int wc, int fr, int fq) const { epi_loop(*this, acc, u, wr, wc, fr, fq); }
    __device__ __forceinline__ void item(int pn, int row, int col, f32x4 v0, f32x4 v1) const { const size_t o = (size_t)row * 32768 + col; *(f32x4*)(ST + o) = v0; *(f32x4*)(ST + o + 4) = v1; }
};
template <class Epi, class Sched, bool ALIGN_EPI = false, bool SP2 = false>
__device__ __forceinline__ void gemm_phase(PG8_LAS unsigned char* lds, const Gemm g, const Sched& S, const Epi& E) {
    const int tid = threadIdx.x, wid = __builtin_amdgcn_readfirstlane(tid >> 6), lane = tid & 63, wr = wid >> 2, wc = wid & 3, fr = lane & 15, fq = lane >> 4;
    const int K = g.K, nt = K / BK;
    unsigned voffA[2], voffB[2];
#pragma unroll
    for (int i = 0; i < 2; ++i) { int R, C; stage_rc(tid * 16 + i * 8192, R, C); const int Rb = Epi::PERM ? ((R & ~31) + perm32(R & 31)) : R;
        voffA[i] = (unsigned)(R * K + C) * 2u; voffB[i] = (unsigned)(Rb * K + C) * 2u; }
    const size_t kstep = (size_t)(BK * 2);
    const size_t hstep = (size_t)HALF * K * 2;
    const size_t tstep = 2 * hstep;
    const unsigned ldsw = (unsigned)wid * 1024u;
    const int aoff = lds_byte(wr * 64 + fr, fq * 8), boff = lds_byte(wc * 32 + fr, fq * 8);
#define PG8_SA(b, h) (((b) * 2 + (h)) * HTB)
#define PG8_SB(b, h) ((4 + (b) * 2 + (h)) * HTB)
#define PG8_STAGE(bufoff, gbase, voff) do { _Pragma("unroll") for (int _i = 0; _i < 2; ++_i) \
        __builtin_amdgcn_global_load_lds((const unsigned*)((const char*)(gbase) + (voff)[_i]), (PG8_LAS unsigned*)(lds + (bufoff) + ldsw + _i * 8192), 16, 0, 0); } while (0)
#define PG8_LDA(dst, b, h) do { _Pragma("unroll") for (int m = 0; m < 4; ++m) _Pragma("unroll") for (int k = 0; k < 2; ++k) dst[m][k] = *(const PG8_LAS bf16x8*)(lds + PG8_SA(b, h) + aoff + m * 2048 + k * 1024); } while (0)
#define PG8_LDB(dst, b, h) do { _Pragma("unroll") for (int n = 0; n < 2; ++n) _Pragma("unroll") for (int k = 0; k < 2; ++k) dst[n][k] = *(const PG8_LAS bf16x8*)(lds + PG8_SB(b, h) + boff + n * 2048 + k * 1024); } while (0)
#define PG8_MMA(ai, bj, At, Bt) do { __builtin_amdgcn_s_setprio(1); _Pragma("unroll") for (int m = 0; m < 4; ++m) _Pragma("unroll") for (int n = 0; n < 2; ++n) _Pragma("unroll") for (int k = 0; k < 2; ++k) \
        acc[ai][bj][m][n] = __builtin_amdgcn_mfma_f32_16x16x32_bf16(Bt[n][k], At[m][k], acc[ai][bj][m][n], 0, 0, 0); __builtin_amdgcn_s_setprio(0); } while (0)
#define PG8_WAIT_V(n) asm volatile("s_waitcnt vmcnt(" #n ")" ::: "memory")
#define PG8_WAIT_L(n) asm volatile("s_waitcnt lgkmcnt(" #n ")" ::: "memory")
#define PG8_BAR __builtin_amdgcn_s_barrier()
#define PG8_SCHED __builtin_amdgcn_sched_barrier(0)
    Unit cur, nxt; int ui = 0;
    if (!S.next(0, cur)) return;
    f32x4 acc[2][2][4][2];
#pragma unroll
    for (int a = 0; a < 2; ++a)
#pragma unroll
        for (int b = 0; b < 2; ++b)
#pragma unroll
            for (int m = 0; m < 4; ++m)
#pragma unroll
                for (int n = 0; n < 2; ++n) acc[a][b][m][n] = (f32x4){0.f, 0.f, 0.f, 0.f};
    bf16x8 At[4][2], B0[2][2], B1[2][2];
    const char* cA = (const char*)g.A + (size_t)cur.pm * tstep; const char* cB = (const char*)g.Bt + (size_t)cur.pn * tstep;
    S.a_ready(cur);
    if constexpr (SP2) {
        PG8_STAGE(PG8_SB(0, 0), cB, voffB); PG8_STAGE(PG8_SB(0, 1), cB + hstep, voffB); PG8_STAGE(PG8_SA(0, 0), cA, voffA); PG8_STAGE(PG8_SA(0, 1), cA + hstep, voffA);
        if (wr == 1) PG8_BAR;
        PG8_WAIT_V(2); PG8_BAR;
        PG8_STAGE(PG8_SB(1, 0), cB + kstep, voffB); PG8_STAGE(PG8_SA(1, 0), cA + kstep, voffA); PG8_STAGE(PG8_SB(1, 1), cB + hstep + kstep, voffB);
        PG8_WAIT_V(6); PG8_BAR;
    } else {
        PG8_STAGE(PG8_SB(0, 0), cB, voffB); PG8_STAGE(PG8_SA(0, 0), cA, voffA); PG8_STAGE(PG8_SB(0, 1), cB + hstep, voffB); PG8_STAGE(PG8_SA(0, 1), cA + hstep, voffA);
        if (wr == 1) PG8_BAR;
        PG8_WAIT_V(4); PG8_BAR;
        PG8_STAGE(PG8_SB(1, 0), cB + kstep, voffB); PG8_STAGE(PG8_SA(1, 0), cA + kstep, voffA); PG8_STAGE(PG8_SB(1, 1), cB + hstep + kstep, voffB);
        PG8_WAIT_V(6); PG8_BAR;
    }
    for (;;) {
        const bool has_next = S.next(ui + 1, nxt);
        const char* nA = has_next ? (const char*)g.A + (size_t)nxt.pm * tstep : cA; const char* nB = has_next ? (const char*)g.Bt + (size_t)nxt.pn * tstep : cB;
        for (int t = 0; t < nt; t += 2) {
            const bool last = (t == nt - 2);
            const char* a1 = cA + (size_t)(t + 1) * kstep;
            const char* a2 = last ? nA : cA + (size_t)(t + 2) * kstep; const char* b2 = last ? nB : cB + (size_t)(t + 2) * kstep;
            const char* a3 = a2 + kstep; const char* b3 = b2 + kstep;
            if (last && has_next) S.a_ready(nxt);
            if constexpr (SP2) {
            PG8_LDB(B0, 0, 0); PG8_LDB(B1, 0, 1); PG8_SCHED; PG8_LDA(At, 0, 0); PG8_STAGE(PG8_SA(1, 1), a1 + hstep, voffA);
            PG8_WAIT_V(8); PG8_WAIT_L(0); PG8_BAR; PG8_MMA(0, 0, At, B0); PG8_MMA(0, 1, At, B1); PG8_BAR; PG8_SCHED;
            PG8_LDA(At, 0, 1); PG8_STAGE(PG8_SB(0, 0), b2, voffB); PG8_STAGE(PG8_SB(0, 1), b2 + hstep, voffB); PG8_STAGE(PG8_SA(0, 0), a2, voffA);
            PG8_WAIT_V(8); PG8_WAIT_L(0); PG8_BAR; PG8_MMA(1, 0, At, B0); PG8_MMA(1, 1, At, B1); PG8_BAR; PG8_SCHED;
            PG8_LDB(B0, 1, 0); PG8_LDB(B1, 1, 1); PG8_SCHED; PG8_LDA(At, 1, 0); PG8_STAGE(PG8_SA(0, 1), a2 + hstep, voffA);
            PG8_WAIT_V(8); PG8_WAIT_L(0); PG8_BAR; PG8_MMA(0, 0, At, B0); PG8_MMA(0, 1, At, B1); PG8_BAR; PG8_SCHED;
            PG8_LDA(At, 1, 1); PG8_STAGE(PG8_SB(1, 0), b3, voffB); PG8_STAGE(PG8_SB(1, 1), b3 + hstep, voffB); PG8_STAGE(PG8_SA(1, 0), a3, voffA);
            PG8_WAIT_V(8); PG8_WAIT_L(0); PG8_BAR; PG8_MMA(1, 0, At, B0); PG8_MMA(1, 1, At, B1); PG8_BAR; PG8_SCHED;
            } else {
            PG8_LDB(B0, 0, 0); PG8_SCHED; PG8_LDA(At, 0, 0); PG8_STAGE(PG8_SA(1, 1), a1 + hstep, voffA);
            PG8_WAIT_L(8); PG8_BAR; PG8_WAIT_L(0); PG8_MMA(0, 0, At, B0); PG8_BAR; PG8_SCHED;
            PG8_LDB(B1, 0, 1); PG8_STAGE(PG8_SB(0, 0), b2, voffB);
            PG8_BAR; PG8_WAIT_L(0); PG8_MMA(0, 1, At, B1); PG8_BAR;
            PG8_LDA(At, 0, 1); PG8_STAGE(PG8_SA(0, 0), a2, voffA);
            PG8_BAR; PG8_WAIT_L(0); PG8_MMA(1, 0, At, B0); PG8_BAR; PG8_SCHED;
            PG8_STAGE(PG8_SB(0, 1), b2 + hstep, voffB);
            PG8_WAIT_V(6); PG8_BAR; PG8_MMA(1, 1, At, B1); PG8_BAR;
            PG8_LDB(B0, 1, 0); PG8_SCHED; PG8_LDA(At, 1, 0); PG8_STAGE(PG8_SA(0, 1), a2 + hstep, voffA);
            PG8_WAIT_L(8); PG8_BAR; PG8_WAIT_L(0); PG8_MMA(0, 0, At, B0); PG8_BAR; PG8_SCHED;
            PG8_LDB(B1, 1, 1); PG8_STAGE(PG8_SB(1, 0), b3, voffB);
            PG8_BAR; PG8_WAIT_L(0); PG8_MMA(0, 1, At, B1); PG8_BAR;
            PG8_LDA(At, 1, 1); PG8_STAGE(PG8_SA(1, 0), a3, voffA);
            PG8_BAR; PG8_WAIT_L(0); PG8_MMA(1, 0, At, B0); PG8_BAR; PG8_SCHED;
            PG8_STAGE(PG8_SB(1, 1), b3 + hstep, voffB);
            PG8_WAIT_V(6); PG8_BAR; PG8_MMA(1, 1, At, B1); PG8_BAR;
            }
        }
        if constexpr (ALIGN_EPI) { if (wr == 0) PG8_BAR; }
        if constexpr (!Epi::AFTER_DRAIN) { E(acc, cur, wr, wc, fr, fq); S.done(cur); }
        if (!has_next) break;
#pragma unroll
        for (int a = 0; a < 2; ++a)
#pragma unroll
            for (int b = 0; b < 2; ++b)
#pragma unroll
                for (int m = 0; m < 4; ++m)
#pragma unroll
                    for (int n = 0; n < 2; ++n) acc[a][b][m][n] = (f32x4){0.f, 0.f, 0.f, 0.f};
        cur = nxt; cA = nA; cB = nB; ++ui;
        if constexpr (ALIGN_EPI) { if (wr == 1) PG8_BAR; }
    }
    PG8_WAIT_V(0);
    if constexpr (!ALIGN_EPI) { if (wr == 0) PG8_BAR; }
    PG8_BAR;
    if constexpr (Epi::AFTER_DRAIN) { E.fused(acc, cur, wr, wc, fr, fq, lds, wid, lane); S.done(cur); }
#undef PG8_SA
#undef PG8_SB
#undef PG8_STAGE
#undef PG8_LDA
#undef PG8_LDB
#undef PG8_MMA
#undef PG8_WAIT_V
#undef PG8_WAIT_L
#undef PG8_BAR
#undef PG8_SCHED
}
}
#define XB_TMO      128
#define XB_XCNT(j)  (256  + 64 * (j))
#define XB_XSUB(j)  (1280 + 64 * (j))
#define XB_XGEN(j)  (2304 + 64 * (j))
#define XB_TOP      3328
#define XB_TOPGEN   3392
#define XCD_BAR_WORDS 3456
#define XB_SPIN_CAP (1u << 18)

__device__ __forceinline__ unsigned xb_ld(unsigned* p)              { return __hip_atomic_load(p, __ATOMIC_RELAXED, __HIP_MEMORY_SCOPE_AGENT); }
__device__ __forceinline__ unsigned xb_add(unsigned* p, unsigned v) { return __hip_atomic_fetch_add(p, v, __ATOMIC_RELAXED, __HIP_MEMORY_SCOPE_AGENT); }
__device__ __forceinline__ unsigned xb_xcc_id() { return (unsigned)__builtin_amdgcn_s_getreg((3 << 11) | 20) & 0xFu; }
#define XB_SPIN(cond, bar) do { unsigned _sp = 0; while (cond) { __builtin_amdgcn_s_sleep(1); \
    if ((++_sp & 255u) == 0u) { if (xb_ld(&(bar)[XB_TMO])) break; if (_sp > XB_SPIN_CAP) { atomicAdd(&(bar)[XB_TMO], 1u); break; } } } } while (0)

struct XcdBarrier {
    unsigned* bar; unsigned x;
    volatile LAS unsigned* st;
};

__device__ __forceinline__ XcdBarrier xcd_barrier_post(unsigned* bar, volatile LAS unsigned* st) {
    XcdBarrier b; b.bar = bar; b.x = xb_xcc_id(); b.st = st;
    if (threadIdx.x == 0) (void)xb_add(&bar[XB_XCNT(b.x)], 1u);
    return b;
}
__device__ __forceinline__ void xcd_barrier_complete(unsigned* bar, unsigned x, unsigned& nloc, unsigned& nx) {
    const unsigned G = gridDim.x * gridDim.y * gridDim.z;
    unsigned sum, cnt, mine, sp = 0u;
    for (;;) {
        sum = 0u; cnt = 0u; mine = 0u;
#pragma unroll
        for (unsigned j = 0; j < 16; ++j) { const unsigned c = xb_ld(&bar[XB_XCNT(j)]); sum += c; cnt += (c > 0u) ? 1u : 0u; mine = (j == x) ? c : mine; }
        if (sum == G) break;
        __builtin_amdgcn_s_sleep(1);
        if ((++sp & 255u) == 0u) { if (xb_ld(&bar[XB_TMO])) break; if (sp > XB_SPIN_CAP) { atomicAdd(&bar[XB_TMO], 1u); break; } }
    }
    nloc = mine > 0u ? mine : 1u; nx = cnt > 0u ? cnt : 1u;
}

__device__ __forceinline__ void xcd_barrier(const XcdBarrier& b) {
    asm volatile("s_waitcnt vmcnt(0)" ::: "memory");
    __syncthreads();
    if (threadIdx.x == 0) {
        unsigned* bar = b.bar;
        __builtin_amdgcn_s_waitcnt(0);
        unsigned nloc = b.st[0], nx = b.st[1];
        if (nloc == 0u) { xcd_barrier_complete(bar, b.x, nloc, nx); b.st[0] = nloc; b.st[1] = nx; }
        const unsigned old = xb_add(&bar[XB_XSUB(b.x)], 1u);
        const unsigned gen = old / nloc;
        if (old + 1u == (gen + 1u) * nloc) {
            __builtin_amdgcn_fence(__ATOMIC_RELEASE, "agent");
            asm volatile("s_waitcnt vmcnt(0)" ::: "memory");
            const unsigned og = xb_add(&bar[XB_TOP], 1u);
            const unsigned tg = og / nx;
            if (og + 1u == (tg + 1u) * nx) xb_add(&bar[XB_TOPGEN], 1u);
            else XB_SPIN(xb_ld(&bar[XB_TOPGEN]) == tg, bar);
            __builtin_amdgcn_fence(__ATOMIC_ACQUIRE, "agent");
            xb_add(&bar[XB_XGEN(b.x)], 1u);
            asm volatile("s_waitcnt vmcnt(0)" ::: "memory");
        } else {
            XB_SPIN(xb_ld(&bar[XB_XGEN(b.x)]) == gen, bar);
            __builtin_amdgcn_fence(__ATOMIC_ACQUIRE, "agent");
            asm volatile("s_waitcnt vmcnt(0)" ::: "memory");
        }
    }
    __syncthreads();
}
namespace da {
constexpr int SLOT_K = 8192, SLOT_V = 16384, SLOT = SLOT_K + SLOT_V;
constexpr int NSLOT = 4;
constexpr int LDS_BIAS = NSLOT * SLOT;
constexpr int LDS_END = LDS_BIAS + BIAS_TAB * 4;
constexpr float THR = 8.f;
__device__ __forceinline__ int crow(int r, int hi) { return (r & 3) + 8 * (r >> 2) + 4 * hi; }
__device__ __forceinline__ void glds16(const void* gbase  , unsigned voff  , unsigned lds_dst) { unsigned keep;
    asm volatile("s_mov_b32 %0, m0\n\ts_mov_b32 m0, %3\n\ts_nop 0\n\tglobal_load_lds_dwordx4 %1, %2\n\ts_mov_b32 m0, %0" : "=&s"(keep) : "v"(voff), "s"(gbase), "s"(lds_dst) : "memory"); }
typedef short v4i16_t __attribute__((ext_vector_type(4)));
__device__ __forceinline__ s16x4 vtr(const LAS char* p) { return __builtin_bit_cast(s16x4, __builtin_amdgcn_ds_read_tr16_b64_v4i16((LAS v4i16_t*)p)); }
#define DA_WAIT_BAR() asm volatile("s_waitcnt vmcnt(0) lgkmcnt(0)\n\ts_barrier" ::: "memory")

struct Tensors { const bf16* Qd; const bf16* Kd; const bf16* Vd; float* stash; bf16* ya; const float* dlam; const float* subg; const float* relb; };

__device__ __forceinline__ float max3f(float a, float b, float c) { float r; asm("v_max3_f32 %0, %1, %2, %3" : "=v"(r) : "v"(a), "v"(b), "v"(c)); return r; }
#define DA_STAGE_Q(T_) do { const int t_ = (T_); const LAS char* kb_ = kp0 + (t_ & 3) * SLOT; \
        bf16x8 kf_[8]; \
        _Pragma("unroll") for (int d0 = 0; d0 < 2; ++d0) { kf_[2 * d0] = *(const LAS bf16x8*)(kb_ + d0 * 2048); kf_[2 * d0 + 1] = *(const LAS bf16x8*)(kb_ + d0 * 2048 + 512); } \
        if ((q0 - 64 * t_ - 63) < DFAR) { int base_ = qabs - 64 * t_ - 4 * hi + BIAS_GUARD; asm volatile("" : "+v"(base_)); \
            _Pragma("unroll") for (int r = 0; r < 16; ++r) { const int o_ = (r & 3) + 8 * (r >> 2); p0[r] = tb[base_ - o_] - m; p1[r] = tb[base_ - o_ - 32] - m; } \
            _Pragma("unroll") for (int d0 = 0; d0 < 4; ++d0) { if (d0 < 2) { kf_[2 * d0 + 4] = *(const LAS bf16x8*)(kb_ + (d0 + 2) * 2048); kf_[2 * d0 + 5] = *(const LAS bf16x8*)(kb_ + (d0 + 2) * 2048 + 512); } \
                p0 = __builtin_amdgcn_mfma_f32_32x32x16_bf16(kf_[2 * d0], qr[d0], p0, 0, 0, 0); p1 = __builtin_amdgcn_mfma_f32_32x32x16_bf16(kf_[2 * d0 + 1], qr[d0], p1, 0, 0, 0); } \
        } else { f32x16 ci_; const float cm_ = c31 - m; _Pragma("unroll") for (int r = 0; r < 16; ++r) ci_[r] = cm_; \
            _Pragma("unroll") for (int d0 = 0; d0 < 4; ++d0) { if (d0 < 2) { kf_[2 * d0 + 4] = *(const LAS bf16x8*)(kb_ + (d0 + 2) * 2048); kf_[2 * d0 + 5] = *(const LAS bf16x8*)(kb_ + (d0 + 2) * 2048 + 512); } \
                p0 = __builtin_amdgcn_mfma_f32_32x32x16_bf16(kf_[2 * d0], qr[d0], d0 == 0 ? ci_ : p0, 0, 0, 0); p1 = __builtin_amdgcn_mfma_f32_32x32x16_bf16(kf_[2 * d0 + 1], qr[d0], d0 == 0 ? ci_ : p1, 0, 0, 0); } } \
    } while (0)
#define DA_STAGE_S(T_) do { const int t_ = (T_); \
        if (t_ >= NT - 4) { int base_ = qabs - 64 * t_ - 4 * hi + BIAS_GUARD; asm volatile("" : "+v"(base_)); \
            _Pragma("unroll") for (int r = 0; r < 16; ++r) { const int o_ = (r & 3) + 8 * (r >> 2); if (base_ - o_ < BIAS_GUARD) p0[r] = -1e30f; if (base_ - o_ - 32 < BIAS_GUARD) p1[r] = -1e30f; } } \
        float ra_ = max3f(p0[0], p0[1], p1[0]), rb_ = max3f(p0[2], p0[3], p1[1]); ra_ = max3f(ra_, p1[2], p1[3]); \
        _Pragma("unroll") for (int r = 4; r < 16; r += 4) { ra_ = max3f(ra_, p0[r], p0[r + 1]); rb_ = max3f(rb_, p0[r + 2], p0[r + 3]); ra_ = max3f(ra_, p1[r], p1[r + 1]); rb_ = max3f(rb_, p1[r + 2], p1[r + 3]); } \
        float rm_ = fmaxf(ra_, rb_); \
        { auto rr_ = __builtin_amdgcn_permlane32_swap(__float_as_uint(rm_), __float_as_uint(rm_), false, false); rm_ = fmaxf(__uint_as_float(rr_[0]), __uint_as_float(rr_[1])); } \
        if (t_ == 0 || __any(rm_ > THR)) { const float dl_ = (t_ == 0) ? rm_ : fmaxf(rm_, 0.f), f_ = __builtin_amdgcn_exp2f(-dl_); \
            _Pragma("unroll") for (int r = 0; r < 16; ++r) { p0[r] -= dl_; p1[r] -= dl_; } \
            _Pragma("unroll") for (int d0 = 0; d0 < 4; ++d0) _Pragma("unroll") for (int r = 0; r < 16; ++r) o[d0][r] *= f_; \
            l *= f_; m += dl_; } \
        float ls0_ = 0.f, ls1_ = 0.f; \
        _Pragma("unroll") for (int r = 0; r < 16; ++r) { p0[r] = __builtin_amdgcn_exp2f(p0[r]); p1[r] = __builtin_amdgcn_exp2f(p1[r]); ls0_ += p0[r]; ls1_ += p1[r]; } \
        l += ls0_ + ls1_; \
        { v4u w; \
          w.x = cvtpk(p0[0], p0[1]); w.y = cvtpk(p0[2], p0[3]); w.z = cvtpk(p0[4], p0[5]); w.w = cvtpk(p0[6], p0[7]); pw[0] = __builtin_bit_cast(bf16x8, w); \
          w.x = cvtpk(p0[8], p0[9]); w.y = cvtpk(p0[10], p0[11]); w.z = cvtpk(p0[12], p0[13]); w.w = cvtpk(p0[14], p0[15]); pw[1] = __builtin_bit_cast(bf16x8, w); \
          w.x = cvtpk(p1[0], p1[1]); w.y = cvtpk(p1[2], p1[3]); w.z = cvtpk(p1[4], p1[5]); w.w = cvtpk(p1[6], p1[7]); pw[2] = __builtin_bit_cast(bf16x8, w); \
          w.x = cvtpk(p1[8], p1[9]); w.y = cvtpk(p1[10], p1[11]); w.z = cvtpk(p1[12], p1[13]); w.w = cvtpk(p1[14], p1[15]); pw[3] = __builtin_bit_cast(bf16x8, w); } \
    } while (0)
#define DA_VF(V_, ks) (bf16x8){V_[2 * (ks)][0], V_[2 * (ks)][1], V_[2 * (ks)][2], V_[2 * (ks)][3], V_[2 * (ks) + 1][0], V_[2 * (ks) + 1][1], V_[2 * (ks) + 1][2], V_[2 * (ks) + 1][3]}
#define DA_STAGE_B(T_) do { const LAS char* vb_ = vp0 + ((T_) & 3) * SLOT; \
        _Pragma("unroll") for (int d0 = 0; d0 < 4; ++d0) { s16x4 vA[8]; \
            _Pragma("unroll") for (int ks = 0; ks < 4; ++ks) { vA[2 * ks] = vtr(vb_ + d0 * 4096 + ks * 1024); vA[2 * ks + 1] = vtr(vb_ + d0 * 4096 + ks * 1024 + 512); } \
            _Pragma("unroll") for (int ks = 0; ks < 4; ++ks) o[d0] = __builtin_amdgcn_mfma_f32_32x32x16_bf16(DA_VF(vA, ks), pw[ks], o[d0], 0, 0, 0); \
            __builtin_amdgcn_sched_barrier(0); } \
    } while (0)
__device__ __forceinline__ void unit(const Tensors& X, int b, int h, int qb, LAS unsigned char* lds, int wgslot, float lam, float c31) {
    const int wid = __builtin_amdgcn_readfirstlane((int)threadIdx.x >> 6);
    const int grp = wid >> 2;
    const int q0 = qb * 256, NT = 4 * (qb + 1);
    const unsigned lds0 = (unsigned)(uintptr_t)lds;
    const LAS float* tb = (const LAS float*)(lds + LDS_BIAS);
    for (int c = 0; c < 2; ++c) {
        int lane = (int)__builtin_amdgcn_mbcnt_hi(~0u, __builtin_amdgcn_mbcnt_lo(~0u, 0u)); asm volatile("" : "+v"(lane));
        const int r32 = lane & 31, hi = lane >> 5;
        const unsigned lane16 = (unsigned)lane * 16u;
        const int qabs = q0 + wid * 32 + r32;
        const LAS char* vp0 = (const LAS char*)lds + SLOT_K + ((lane >> 4) & 1) * 32 + (lane & 3) * 8 + (4 * hi + ((lane & 15) >> 2)) * 64;
        const LAS char* kp0 = (const LAS char*)lds + hi * 1024 + r32 * 16;
        const int bhc = (b * 4 + h) * 2 + c;
        const bf16* Qw = X.Qd + ((size_t)bhc * SEQ + q0 + wid * 32 + r32) * 64 + hi * 8;
        const char* Kt = (const char*)X.Kd + (size_t)bhc * NTILE * SLOT_K + wid * 1024;
        const char* Vt = (const char*)X.Vd + (size_t)(b * 4 + h) * NTILE * SLOT_V + wid * 1024;
#define DA_DMA(t, slot) do { const unsigned sb_ = (unsigned)__builtin_amdgcn_readfirstlane(lds0 + (slot) * SLOT + wid * 1024); \
        glds16(Kt + (size_t)(t) * SLOT_K, lane16, sb_); glds16(Vt + (size_t)(t) * SLOT_V, lane16, sb_ + SLOT_K); glds16(Vt + (size_t)(t) * SLOT_V + 8192, lane16, sb_ + SLOT_K + 8192); } while (0)
        DA_DMA(0, 0); DA_DMA(1, 1); DA_DMA(2, 2);
        bf16x8 qr[4];
#pragma unroll
        for (int d0 = 0; d0 < 4; ++d0) qr[d0] = *(const bf16x8*)(Qw + d0 * 16);
        f32x16 o[4];
#pragma unroll
        for (int d0 = 0; d0 < 4; ++d0)
#pragma unroll
            for (int r = 0; r < 16; ++r) o[d0][r] = 0.f;
        float m = 0.f, l = 0.f;
        bf16x8 pw[4]; f32x16 p0, p1;
        asm volatile("" :: "v"(qr[0]), "v"(qr[1]), "v"(qr[2]), "v"(qr[3]));
        asm volatile("s_waitcnt vmcnt(6) lgkmcnt(0)\n\ts_barrier" ::: "memory");
        DA_STAGE_Q(0);
#define DA_TILE_BARRIER(t) do { \
            if ((t) + 1 < NT) asm volatile("s_waitcnt vmcnt(3) lgkmcnt(0)\n\ts_barrier" ::: "memory"); else asm volatile("s_waitcnt vmcnt(0) lgkmcnt(0)\n\ts_barrier" ::: "memory"); \
            if ((t) + 2 < NT) { const int sn_ = ((t) + 2) & 3; DA_DMA((t) + 2, sn_); } } while (0)
        for (int t = 1; t <= NT; ++t) {
            if (grp == 1) DA_TILE_BARRIER(t);
            DA_STAGE_S(t - 1);
            if (grp == 0) DA_TILE_BARRIER(t);
            __builtin_amdgcn_sched_barrier(0);
            DA_STAGE_B(t - 1);
            if (t < NT) DA_STAGE_Q(t);
        }
#undef DA_TILE_BARRIER
#undef DA_DMA
        { auto rr = __builtin_amdgcn_permlane32_swap(__float_as_uint(l), __float_as_uint(l), false, false); l = __uint_as_float(rr[0]) + __uint_as_float(rr[1]); }
        const float inv = 1.f / l;
        int lane_e = lane; asm volatile("" : "+v"(lane_e));
        GAS unsigned* stg = (GAS unsigned*)((unsigned*)X.stash + ((size_t)(wgslot * 8 + wid) * 32) * 64 + lane_e);
        if (c == 0) {
#pragma unroll
            for (int d0 = 0; d0 < 4; ++d0)
#pragma unroll
                for (int r = 0; r < 16; r += 2) stg[(d0 * 8 + (r >> 1)) * 64] = cvtpk(o[d0][r] * inv, o[d0][r + 1] * inv);
        } else {
            float ss = 0.f;
#pragma unroll
            for (int d0 = 0; d0 < 4; ++d0)
#pragma unroll
                for (int r = 0; r < 16; r += 2) { const unsigned w1 = stg[(d0 * 8 + (r >> 1)) * 64]; const float dv0 = bf_lo(w1) - lam * (o[d0][r] * inv), dv1 = bf_hi(w1) - lam * (o[d0][r + 1] * inv);
                    o[d0][r] = dv0; o[d0][r + 1] = dv1; ss += dv0 * dv0 + dv1 * dv1; if (r == 14) asm volatile("" ::: "memory"); }
            { auto rr = __builtin_amdgcn_permlane32_swap(__float_as_uint(ss), __float_as_uint(ss), false, false); ss = __uint_as_float(rr[0]) + __uint_as_float(rr[1]); }
            const float rn = __builtin_amdgcn_rsqf(ss * (1.f / 128.f) + SUBLN_EPS) * (1.f - LAM_INIT);
            const int hi_e = lane_e >> 5, qabs_e = q0 + wid * 32 + (lane_e & 31);
            bf16* yrow = X.ya + ((size_t)b * SEQ + qabs_e) * 512 + h * 128 + 4 * hi_e; const float* sg = X.subg + 4 * hi_e;
#pragma unroll
            for (int d0 = 0; d0 < 4; ++d0)
#pragma unroll
                for (int r4 = 0; r4 < 4; ++r4) {
                    const int dd = 32 * d0 + 8 * r4; const f32x4 g = *(const f32x4*)(sg + dd);
                    v2u w; w.x = pk2(o[d0][4 * r4] * rn * g[0], o[d0][4 * r4 + 1] * rn * g[1]); w.y = pk2(o[d0][4 * r4 + 2] * rn * g[2], o[d0][4 * r4 + 3] * rn * g[3]);
                    *(v2u*)(yrow + dd) = w;
                }
        }
    }
    asm volatile("s_waitcnt vmcnt(0) lgkmcnt(0)\n\ts_barrier" ::: "memory");
}
#undef DA_STAGE_Q
#undef DA_STAGE_S
#undef DA_STAGE_B
#undef DA_VF
#undef DA_WAIT_BAR
}
namespace dil {
constexpr int BT = 1152, BT0 = 512;
constexpr int LDS_VST = 0, LDS_BL = 32768, LDS_END = LDS_BL + 3 * BT * 4;
constexpr float THR = 8.f;
struct Tensors { const bf16* LQ; const bf16* LK; const bf16* LV; bf16* yb; };
typedef short v4i16_t __attribute__((ext_vector_type(4)));
__device__ __forceinline__ s16x4 vtr(const LAS unsigned char* p) { return __builtin_bit_cast(s16x4, __builtin_amdgcn_ds_read_tr16_b64_v4i16((LAS v4i16_t*)p)); }

template <int G_, int QS_> __device__ __forceinline__ void group(const Tensors& X, size_t rowb, int h, int P0, int r, LAS unsigned char* vst, const LAS float* blg, int lane, f32x16 (&o)[2], float& m, float& l) {
    constexpr int DL = (G_ == 0) ? 1 : (G_ == 1) ? 4 : 16, MG = QS_ / DL, NKB = (31 * MG + 128) / 32 + 1;
    static_assert(QS_ % DL == 0, "query stride must be a multiple of the dilation");
    const int i = lane & 31, hi = lane >> 5;
    const int colb = G_ * 256 + h * 64;
    bf16x8 qr[4];
    { const bf16* qp = X.LQ + (rowb + P0 + r + QS_ * i) * 768 + colb + hi * 8;
#pragma unroll
      for (int d0 = 0; d0 < 4; ++d0) qr[d0] = *(const bf16x8*)(qp + 16 * d0); }
    const int kpos0 = P0 + r - 128 * DL;
    const LAS unsigned char* vrd = vst + ((lane >> 4) & 1) * 32 + (lane & 3) * 8 + (4 * hi + ((lane & 15) >> 2)) * 64;
#define DIL_LOAD(KF, VR, KB) do { \
        { int kpos_ = kpos0 + (32 * (KB) + i) * DL; kpos_ = kpos_ < 0 ? 0 : (kpos_ > SEQ - 1 ? SEQ - 1 : kpos_); const bf16* kp_ = X.LK + (rowb + kpos_) * 768 + colb + hi * 8; \
          _Pragma("unroll") for (int d0 = 0; d0 < 4; ++d0) KF[d0] = *(const bf16x8*)(kp_ + 16 * d0); } \
        _Pragma("unroll") for (int t = 0; t < 4; ++t) { const int qd = lane + 64 * t, key = qd >> 3, ch = qd & 7; int vpos_ = kpos0 + (32 * (KB) + key) * DL; vpos_ = vpos_ < 0 ? 0 : (vpos_ > SEQ - 1 ? SEQ - 1 : vpos_); \
            VR[t] = *(const v4u*)(X.LV + (rowb + vpos_) * 768 + colb + ch * 8); } } while (0)
    bf16x8 kfn[4]; v4u vregn[4];
    DIL_LOAD(kfn, vregn, 0);
#pragma unroll 1
    for (int kb = 0; kb < NKB; ++kb) {
        bf16x8 kf[4]; v4u vreg[4];
#pragma unroll
        for (int d0 = 0; d0 < 4; ++d0) { kf[d0] = kfn[d0]; vreg[d0] = vregn[d0]; }
        if (kb + 1 < NKB) DIL_LOAD(kfn, vregn, kb + 1);
        const int jb = i * MG + 128 - 32 * kb - 4 * hi;
        f32x16 p;
#pragma unroll
        for (int rr = 0; rr < 16; ++rr) p[rr] = blg[jb - ((rr & 3) + 8 * (rr >> 2)) + BT0];
#pragma unroll
        for (int d0 = 0; d0 < 4; ++d0) p = __builtin_amdgcn_mfma_f32_32x32x16_bf16(kf[d0], qr[d0], p, 0, 0, 0);
        const int cb = 32 * kb + 4 * hi;
#pragma unroll
        for (int rr = 0; rr < 16; ++rr) { const int o_ = (rr & 3) + 8 * (rr >> 2); if ((unsigned)(jb - o_) > 128u || kpos0 + (cb + o_) * DL < 0) p[rr] = -3e38f; }
        float rm = p[0];
#pragma unroll
        for (int rr = 1; rr < 16; ++rr) rm = fmaxf(rm, p[rr]);
        { auto sw = __builtin_amdgcn_permlane32_swap(__float_as_uint(rm), __float_as_uint(rm), false, false); rm = fmaxf(__uint_as_float(sw[0]), __uint_as_float(sw[1])); }
        if (__any(rm > m + THR)) {
            const float mn = fmaxf(m, rm), f = __builtin_amdgcn_exp2f(m - mn);
#pragma unroll
            for (int d0 = 0; d0 < 2; ++d0)
#pragma unroll
                for (int rr = 0; rr < 16; ++rr) o[d0][rr] *= f;
            l *= f; m = mn;
        }
        float ls = 0.f;
#pragma unroll
        for (int rr = 0; rr < 16; ++rr) { p[rr] = __builtin_amdgcn_exp2f(p[rr] - m); ls += p[rr]; }
        l += ls;
        bf16x8 pw[2];
        { v4u w;
          w.x = cvtpk(p[0], p[1]); w.y = cvtpk(p[2], p[3]); w.z = cvtpk(p[4], p[5]); w.w = cvtpk(p[6], p[7]); pw[0] = __builtin_bit_cast(bf16x8, w);
          w.x = cvtpk(p[8], p[9]); w.y = cvtpk(p[10], p[11]); w.z = cvtpk(p[12], p[13]); w.w = cvtpk(p[14], p[15]); pw[1] = __builtin_bit_cast(bf16x8, w); }
#pragma unroll
        for (int t = 0; t < 4; ++t) { const int qd = lane + 64 * t, key = qd >> 3, ch = qd & 7;
            *(LAS v4u*)(vst + ((ch >> 2) * 2 + (key >> 4)) * 1024 + (key & 15) * 64 + (ch & 3) * 16) = vreg[t]; }
        asm volatile("s_waitcnt lgkmcnt(0)" ::: "memory");
#pragma unroll
        for (int d0 = 0; d0 < 2; ++d0)
#pragma unroll
            for (int ks = 0; ks < 2; ++ks) {
                const s16x4 lo = vtr(vrd + (d0 * 2 + ks) * 1024), hh = vtr(vrd + (d0 * 2 + ks) * 1024 + 512);
                const bf16x8 vf = (bf16x8){lo[0], lo[1], lo[2], lo[3], hh[0], hh[1], hh[2], hh[3]};
                o[d0] = __builtin_amdgcn_mfma_f32_32x32x16_bf16(vf, pw[ks], o[d0], 0, 0, 0);
            }
        asm volatile("s_waitcnt lgkmcnt(0)" ::: "memory");
    }
#undef DIL_LOAD
}
__device__ __forceinline__ void wave_tile_g0(const Tensors& X, float* lse0, int b, int h, int P0, LAS unsigned char* vst, const LAS float* bl, int lane) {
    const size_t rowb = (size_t)b * SEQ;
    f32x16 o[2];
#pragma unroll
    for (int d0 = 0; d0 < 2; ++d0)
#pragma unroll
        for (int rr = 0; rr < 16; ++rr) o[d0][rr] = 0.f;
    float m = -1e30f, l = 0.f;
    group<0, 1>(X, rowb, h, P0, 0, vst, bl, lane, o, m, l);
    { auto sw = __builtin_amdgcn_permlane32_swap(__float_as_uint(l), __float_as_uint(l), false, false); l = __uint_as_float(sw[0]) + __uint_as_float(sw[1]); }
    const float inv = 1.f / l; const int i = lane & 31, hi = lane >> 5;
    bf16* yrow = X.yb + (rowb + P0 + i) * 256 + h * 64 + 4 * hi;
#pragma unroll
    for (int d0 = 0; d0 < 2; ++d0)
#pragma unroll
        for (int r4 = 0; r4 < 4; ++r4) { v2u w; w.x = pk2(o[d0][4 * r4] * inv, o[d0][4 * r4 + 1] * inv); w.y = pk2(o[d0][4 * r4 + 2] * inv, o[d0][4 * r4 + 3] * inv); *(v2u*)(yrow + 32 * d0 + 8 * r4) = w; }
    if (hi == 0) lse0[(rowb + P0 + i) * 4 + h] = m + __builtin_amdgcn_logf(l);
}
__device__ __forceinline__ void wave_tile(const Tensors& X, const float* lse0, int b, int h, int P0, int r, LAS unsigned char* vst, const LAS float* bl, int lane) {
    const size_t rowb = (size_t)b * SEQ;
    f32x16 o[2];
#pragma unroll
    for (int d0 = 0; d0 < 2; ++d0)
#pragma unroll
        for (int rr = 0; rr < 16; ++rr) o[d0][rr] = 0.f;
    float m = -1e30f, l = 0.f;
    group<1, 16>(X, rowb, h, P0, r, vst, bl + BT, lane, o, m, l);
    group<2, 16>(X, rowb, h, P0, r, vst, bl + 2 * BT, lane, o, m, l);
    { auto sw = __builtin_amdgcn_permlane32_swap(__float_as_uint(l), __float_as_uint(l), false, false); l = __uint_as_float(sw[0]) + __uint_as_float(sw[1]); }
    const int i = lane & 31, hi = lane >> 5;
    const float w0 = __builtin_amdgcn_exp2f(lse0[(rowb + P0 + r + 16 * i) * 4 + h] - m);
    const float inv = 1.f / (l + w0);
    bf16* yrow = X.yb + (rowb + P0 + r + 16 * i) * 256 + h * 64 + 4 * hi;
#pragma unroll
    for (int d0 = 0; d0 < 2; ++d0)
#pragma unroll
        for (int r4 = 0; r4 < 4; ++r4) { const v2u g0 = *(const v2u*)(yrow + 32 * d0 + 8 * r4);
            v2u w; w.x = pk2((o[d0][4 * r4] + w0 * bf_lo(g0.x)) * inv, (o[d0][4 * r4 + 1] + w0 * bf_hi(g0.x)) * inv); w.y = pk2((o[d0][4 * r4 + 2] + w0 * bf_lo(g0.y)) * inv, (o[d0][4 * r4 + 3] + w0 * bf_hi(g0.y)) * inv);
            *(v2u*)(yrow + 32 * d0 + 8 * r4) = w; }
}
}
__device__ __forceinline__ void p0_transpose_item(const float* W, int K, int N, bf16* WT, LAS float* scr, int item, int lane) {
    const int nblk = N / 32, kb = item / nblk, nb = item % nblk, k0 = 64 * kb, n0 = 32 * nb;
#pragma unroll 8
    for (int i = 0; i < 32; ++i) { const int kk = 2 * i + (lane >> 5); scr[kk * 33 + (lane & 31)] = W[(size_t)(k0 + kk) * N + n0 + (lane & 31)]; }
    LDS_WAIT(); asm volatile("" ::: "memory");
    const int c = lane & 7;
#pragma unroll
    for (int j = 0; j < 4; ++j) { const int n = (lane >> 3) + 8 * j; const LAS float* s = scr + (8 * c) * 33 + n;
        v4u o; o.x = pk2(s[0 * 33], s[1 * 33]); o.y = pk2(s[2 * 33], s[3 * 33]); o.z = pk2(s[4 * 33], s[5 * 33]); o.w = pk2(s[6 * 33], s[7 * 33]);
        *(v4u*)(WT + (size_t)(n0 + n) * K + k0 + 8 * c) = o; }
    LDS_WAIT(); asm volatile("" ::: "memory");
}
__device__ __forceinline__ void cast_bf16(const float* src, bf16* dst, size_t n8, size_t gtid, size_t gthreads) {
    for (size_t i = gtid; i < n8; i += gthreads) { const f32x4 a = *(const f32x4*)(src + i * 8), b = *(const f32x4*)(src + i * 8 + 4);
        v4u o; o.x = pk2(a[0], a[1]); o.y = pk2(a[2], a[3]); o.z = pk2(b[0], b[1]); o.w = pk2(b[2], b[3]); *(v4u*)(dst + i * 8) = o; }
}

struct Args { const float* in[16]; float* out; unsigned char* ws; int ph_lo, ph_hi; };
enum { I_X = 0, I_WIN, I_DLAM, I_SUBG, I_WBD, I_WBL, I_WO, I_LN1G, I_LN1B, I_PWQ, I_PKEYS, I_PU, I_PV, I_LN2G, I_LN2B, I_RELB };

__device__ __forceinline__ void p0_prologue(const Args& A, LAS unsigned char* lds, int vcu, int G, int wave, int lane) {
    unsigned char* ws = A.ws;
    const int gw = vcu * NWAVES + wave, NGW = G * NWAVES;
    const size_t gtid = (size_t)gw * 64 + lane, gthreads = (size_t)NGW * 64;
    LAS float* scr = (LAS float*)(lds + wave * 16384);
    constexpr int I_IN = (D / 64) * (INC / 32), I_BD = (512 / 64) * (D / 32), I_BL = (256 / 64) * (D / 32), I_O = (D / 64) * (D / 32);
    for (int it0 = gw; it0 < (I_IN + I_BD + I_BL + I_O) * NREP(32); it0 += NGW) {
        int r = it0 % (I_IN + I_BD + I_BL + I_O);
        if (r < I_IN) { p0_transpose_item(A.in[I_WIN], D, INC, (bf16*)(ws + WS_WIN), scr, r, lane); continue; } r -= I_IN;
        if (r < I_BD) { p0_transpose_item(A.in[I_WBD], 512, D, (bf16*)(ws + WS_WBD), scr, r, lane); continue; } r -= I_BD;
        if (r < I_BL) { p0_transpose_item(A.in[I_WBL], 256, D, (bf16*)(ws + WS_WBL), scr, r, lane); continue; } r -= I_BL;
        p0_transpose_item(A.in[I_WO], D, D, (bf16*)(ws + WS_WO), scr, r, lane);
    }
    for (int rep_ = 0; rep_ < NREP(31); ++rep_) cast_bf16(A.in[I_X], (bf16*)(ws + WS_A), (size_t)T * D / 8, gtid, gthreads);
    { const float* wq = A.in[I_PWQ]; const float* keys = A.in[I_PKEYS]; bf16* wp = (bf16*)(ws + WS_WP);
      for (int it0 = gw; it0 < 1024 * NREP(30); it0 += NGW) { const int it = it0 & 1023;
          const int hc = it >> 6, jb = (it >> 2) & 15, nq = it & 3, j = jb * 64 + lane;
          const f32x4* wr_ = (const f32x4*)(wq + (size_t)j * 2048 + hc * 128);
          f32x4 w[32];
#pragma unroll
          for (int d = 0; d < 32; ++d) w[d] = wr_[d];
#pragma unroll 1
          for (int n = nq * 32; n < nq * 32 + 32; ++n) {
              const f32x4* kr = (const f32x4*)(keys + (size_t)(hc * 128 + n) * 128);
              float a0 = 0.f, a1 = 0.f, a2 = 0.f, a3 = 0.f;
#pragma unroll
              for (int d = 0; d < 32; ++d) { const f32x4 k = kr[d]; a0 += w[d][0] * k[0]; a1 += w[d][1] * k[1]; a2 += w[d][2] * k[2]; a3 += w[d][3] * k[3]; }
              wp[(size_t)(hc * 128 + n) * 1024 + j] = (bf16)f2bf((a0 + a1) + (a2 + a3));
          }
      } }
    { const float* relb = A.in[I_RELB]; float* bd = (float*)(ws + WS_BIASD); float* bl = (float*)(ws + WS_BIASL);
      for (size_t i = gtid; i < 4 * BIAS_TAB; i += gthreads) { const int h = (int)(i / BIAS_TAB), dist = (int)(i % BIAS_TAB) - BIAS_GUARD; bd[i] = dist < 0 ? 0.f : relb[rel_bucket(dist) * 16 + h] * LOG2E; }
      for (size_t i = gtid; i < 12 * 132; i += gthreads) { const int gh = (int)(i / 132), j = (int)(i % 132), g = gh >> 2; const int dl = (g == 0) ? 1 : (g == 1) ? 4 : 16;
          bl[i] = relb[rel_bucket((j > 128 ? 128 : j) * dl) * 16 + 4 + gh] * LOG2E; } }
}

__device__ __forceinline__ void p5_ln1(const Args& A, int vcu, int G, int wave, int lane) {
    unsigned char* ws = A.ws;
    const int gw = vcu * NWAVES + wave, NGW = G * NWAVES;
    const float* R = (const float*)(ws + WS_R); bf16* x1b = (bf16*)(ws + WS_A);
    const float* gam = A.in[I_LN1G]; const float* bet = A.in[I_LN1B];
    f32x4 gv[4], bv[4];
#pragma unroll
    for (int j = 0; j < 4; ++j) { gv[j] = *(const f32x4*)(gam + 256 * j + 4 * lane); bv[j] = *(const f32x4*)(bet + 256 * j + 4 * lane); }
    f32x4 nx[4];
    if (gw < T) {
#pragma unroll
        for (int j = 0; j < 4; ++j) nx[j] = ((const f32x4*)(R + (size_t)gw * D) + lane)[64 * j]; }
#pragma unroll 1
    for (int mrow = gw; mrow < T; mrow += NGW) {
        f32x4 v[4]; float s = 0.f;
#pragma unroll
        for (int j = 0; j < 4; ++j) { v[j] = nx[j]; s += (v[j][0] + v[j][1]) + (v[j][2] + v[j][3]); }
        if (mrow + NGW < T) {
#pragma unroll
            for (int j = 0; j < 4; ++j) nx[j] = ((const f32x4*)(R + (size_t)(mrow + NGW) * D) + lane)[64 * j]; }
        const float mean = wave_sum(s) * (1.f / D); float s2 = 0.f;
#pragma unroll
        for (int j = 0; j < 4; ++j) { v[j] = v[j] - mean; s2 += (v[j][0] * v[j][0] + v[j][1] * v[j][1]) + (v[j][2] * v[j][2] + v[j][3] * v[j][3]); }
        const float rstd = __builtin_amdgcn_rsqf(wave_sum(s2) * (1.f / D) + LN_EPS);
        v2u* brow = (v2u*)(x1b + (size_t)mrow * D) + lane;
#pragma unroll
        for (int j = 0; j < 4; ++j) { const f32x4 y = v[j] * rstd * gv[j] + bv[j]; v2u w; w.x = pk2(y[0], y[1]); w.y = pk2(y[2], y[3]); brow[64 * j] = w; }
    }
}
namespace peer {
__device__ __forceinline__ int mono(float v) { const int b = __float_as_int(v); return b ^ ((b >> 31) & 0x7fffffff); }
__device__ __forceinline__ float unmono(int k) { return __int_as_float(k ^ ((k >> 31) & 0x7fffffff)); }
__device__ __forceinline__ int med3i(int a, int b, int c) { int r; asm("v_med3_i32 %0, %1, %2, %3" : "=v"(r) : "v"(a), "v"(b), "v"(c)); return r; }
#define PEER_INS16(a, x) do { _Pragma("unroll") for (int k_ = 15; k_ >= 1; --k_) a[k_] = med3i(a[k_ - 1], a[k_], (x)); a[0] = max(a[0], (x)); } while (0)
__device__ __forceinline__ unsigned byte_sel(const unsigned (&p)[4], int i) { const int w = i >> 2; const unsigned x = (w == 0) ? p[0] : (w == 1) ? p[1] : (w == 2) ? p[2] : p[3]; return (x >> ((i & 3) * 8)) & 0xffu; }
__device__ __forceinline__ float gelu_erf(float v) { return 0.5f * v * (1.f + erff(v * 0.7071067811865476f)); }

__device__ __forceinline__ void select(const float* ST, v2u* sel, int tok, int head) {
    int a0[16], a1[16];
#pragma unroll
    for (int k = 0; k < 16; ++k) { a0[k] = (int)0x80000000; a1[k] = (int)0x80000000; }
    const float* s0 = ST + (size_t)(head * 256) * T + tok; const float* s1 = s0 + (size_t)128 * T;
    float c0[8], c1[8];
#pragma unroll
    for (int i = 0; i < 8; ++i) { c0[i] = s0[(size_t)i * T]; c1[i] = s1[(size_t)i * T]; }
#pragma unroll 1
    for (int n = 0; n < 128; n += 8) {
        float x0[8], x1[8];
#pragma unroll
        for (int i = 0; i < 8; ++i) { x0[i] = c0[i]; x1[i] = c1[i]; }
        if (n + 8 < 128) {
#pragma unroll
            for (int i = 0; i < 8; ++i) { c0[i] = s0[(size_t)(n + 8 + i) * T]; c1[i] = s1[(size_t)(n + 8 + i) * T]; }
        }
#pragma unroll
        for (int i = 0; i < 8; ++i) { const int k0 = (mono(x0[i]) & ~127) | (127 - (n + i)), k1 = (mono(x1[i]) & ~127) | (127 - (n + i)); PEER_INS16(a0, k0); PEER_INS16(a1, k1); }
    }
    float v0[16], v1[16]; unsigned i0p[4] = {0u, 0u, 0u, 0u}, i1p[4] = {0u, 0u, 0u, 0u};
#pragma unroll
    for (int k = 0; k < 16; ++k) { v0[k] = unmono((a0[k] & ~127) | 64); v1[k] = unmono((a1[k] & ~127) | 64);
        i0p[k >> 2] |= (unsigned)(127 - (a0[k] & 127)) << (8 * (k & 3)); i1p[k >> 2] |= (unsigned)(127 - (a1[k] & 127)) << (8 * (k & 3)); }
    int cd[16];
#pragma unroll
    for (int k = 0; k < 16; ++k) cd[k] = (int)0x80000000;
#pragma unroll
    for (int i = 0; i < 16; ++i)
#pragma unroll
        for (int j = 0; j < 16; ++j)
            if ((i + 1) * (j + 1) <= 16) { const int k = (mono(v0[i] + v1[j]) & ~255) | (255 - (i * 16 + j)); PEER_INS16(cd, k); }
    float sv[16], ex[16], sum = 0.f; unsigned eid[16];
#pragma unroll
    for (int k = 0; k < 16; ++k) { const int code = 255 - (cd[k] & 255); eid[k] = byte_sel(i0p, code >> 4) * 128u + byte_sel(i1p, code & 15); sv[k] = unmono((cd[k] & ~255) | 128); }
#pragma unroll
    for (int k = 0; k < 16; ++k) { ex[k] = __expf(sv[k] - sv[0]); sum += ex[k]; }
    const float rs = 1.f / sum;
    v4u* dst = (v4u*)(sel + ((size_t)tok * 8 + head) * 16);
#pragma unroll
    for (int k = 0; k < 8; ++k) { v4u w; w.x = eid[2 * k]; w.y = __float_as_uint(ex[2 * k] * rs); w.z = eid[2 * k + 1]; w.w = __float_as_uint(ex[2 * k + 1] * rs); dst[k] = w; }
}

typedef float f32x2w __attribute__((ext_vector_type(2)));
struct G4 { const unsigned char* U8; const unsigned char* V8; const float* isu; const float* isv; };
__device__ __forceinline__ v2u peer_ec(const v2u lo, const v2u hi, int c) { const unsigned mk = (c < 4) ? 0xffffffffu : 0u; v2u r; r.x = (lo.x & mk) | (hi.x & ~mk); r.y = (lo.y & mk) | (hi.y & ~mk); return r; }
#define PEER_EC(en, c) peer_ec((en)[0], (en)[1], (c))
__device__ __forceinline__ void a_load(v4u (&uu)[16], const v2u ec, int c, const unsigned char* U8, int lane) {
#pragma unroll
    for (int j = 0; j < 16; ++j) { const unsigned e = __builtin_amdgcn_readlane(ec.x, 16 * (c & 3) + j); uu[j] = *(const v4u*)(U8 + (size_t)e * D + 16 * lane); }
}
__device__ __forceinline__ void a_step(const v4u (&uu)[16], v2u (&en)[2], int c, const LAS f32x4* xl, const G4& T, int lane) {
    const v2u ec = PEER_EC(en, c);
    const int ls = 16 * (c & 3) + (lane >> 2);
    const unsigned eq = (unsigned)__shfl((int)ec.x, ls); const float gq = __uint_as_float((unsigned)__shfl((int)ec.y, ls));
    const float su = T.isu[eq], sv = T.isv[eq];
    f32x4 xv[4];
#pragma unroll
    for (int q = 0; q < 4; ++q) xv[q] = xl[q * 64];
    float part[16];
#pragma unroll
    for (int j = 0; j < 16; ++j) { f32x2w d = {0.f, 0.f};
#pragma unroll
        for (int q = 0; q < 4; ++q) { const unsigned w = uu[j][q]; const f32x2w a = __builtin_amdgcn_cvt_pk_f32_fp8((int)w, false), b = __builtin_amdgcn_cvt_pk_f32_fp8((int)w, true);
            d += (f32x2w){xv[q][0], xv[q][1]} * a; d += (f32x2w){xv[q][2], xv[q][3]} * b; }
        part[j] = d[0] + d[1]; }
    float r8[8], r4[4], r2[2], r1;
#pragma unroll
    for (int i = 0; i < 8; ++i) { auto sw = __builtin_amdgcn_permlane32_swap(__float_as_uint(part[i]), __float_as_uint(part[i + 8]), false, false); r8[i] = __uint_as_float(sw[0]) + __uint_as_float(sw[1]); }
#pragma unroll
    for (int i = 0; i < 4; ++i) { auto sw = __builtin_amdgcn_permlane16_swap(__float_as_uint(r8[i]), __float_as_uint(r8[i + 4]), false, false); r4[i] = __uint_as_float(sw[0]) + __uint_as_float(sw[1]); }
#pragma unroll
    for (int i = 0; i < 2; ++i) { const bool up = (lane & 8) != 0; const float send = up ? r4[i] : r4[i + 2], keep = up ? r4[i + 2] : r4[i]; r2[i] = keep + __shfl_xor(send, 8); }
    { const bool up = (lane & 4) != 0; const float send = up ? r2[0] : r2[1], keep = up ? r2[1] : r2[0]; r1 = keep + __shfl_xor(send, 4); }
    r1 += __shfl_xor(r1, 2); r1 += __shfl_xor(r1, 1);
    const float wgt = gq * gelu_erf(r1 * su) * sv;
    const int rel = lane - 16 * (c & 3);
    const float wv = __shfl(wgt, 4 * (rel & 15));
    const bool mine = (rel >= 0) && (rel < 16);
    const bool lo_ = mine && (c < 4), hi_ = mine && (c >= 4);
    en[0].y = lo_ ? __float_as_uint(wv) : en[0].y; en[1].y = hi_ ? __float_as_uint(wv) : en[1].y;
}
__device__ __forceinline__ void b_load8(v4u (&vv)[8], const v2u ec, int c, int h8, const unsigned char* V8, int lane) {
#pragma unroll
    for (int j = 0; j < 8; ++j) { const unsigned e = __builtin_amdgcn_readlane(ec.x, 16 * (c & 3) + 8 * h8 + j); vv[j] = *(const v4u*)(V8 + (size_t)e * D + 16 * lane); }
}
__device__ __forceinline__ void b_step8(const v4u (&vv)[8], const v2u ec, int c, int h8, f32x2w (&acc)[8]) {
#pragma unroll
    for (int j = 0; j < 8; ++j) { const float w = __uint_as_float(__builtin_amdgcn_readlane(ec.y, 16 * (c & 3) + 8 * h8 + j)); const f32x2w w2 = {w, w};
#pragma unroll
        for (int q = 0; q < 4; ++q) { const unsigned x = vv[j][q]; const f32x2w a = __builtin_amdgcn_cvt_pk_f32_fp8((int)x, false), b = __builtin_amdgcn_cvt_pk_f32_fp8((int)x, true);
            acc[2 * q] += w2 * a; acc[2 * q + 1] += w2 * b; } }
}
__device__ __forceinline__ void b_load(v4u (&vv)[16], const v2u ec, int c, const unsigned char* V8, int lane) {
#pragma unroll
    for (int j = 0; j < 16; ++j) { const unsigned e = __builtin_amdgcn_readlane(ec.x, 16 * (c & 3) + j); vv[j] = *(const v4u*)(V8 + (size_t)e * D + 16 * lane); }
}
__device__ __forceinline__ void b_step(const v4u (&vv)[16], const v2u ec, int c, f32x2w (&acc)[8]) {
#pragma unroll
    for (int j = 0; j < 16; ++j) { const float w = __uint_as_float(__builtin_amdgcn_readlane(ec.y, 16 * (c & 3) + j)); const f32x2w w2 = {w, w};
#pragma unroll
        for (int q = 0; q < 4; ++q) { const unsigned x = vv[j][q]; const f32x2w a = __builtin_amdgcn_cvt_pk_f32_fp8((int)x, false), b = __builtin_amdgcn_cvt_pk_f32_fp8((int)x, true);
            acc[2 * q] += w2 * a; acc[2 * q + 1] += w2 * b; } }
}
__device__ __forceinline__ void tok_finish(const LAS f32x4* xl, const f32x2w (&acc)[8], float* xrow, const float* gam, const float* bet, int lane) {
    float rr[16], s = 0.f;
#pragma unroll
    for (int q = 0; q < 4; ++q) { const f32x4 xv = xl[q * 64];
#pragma unroll
        for (int e = 0; e < 4; ++e) { const int k = 4 * q + e; rr[k] = ALPHA * xv[e] + acc[k >> 1][k & 1]; s += rr[k]; } }
    const float mean = wave_sum(s) * (1.f / D); float s2 = 0.f;
#pragma unroll
    for (int k = 0; k < 16; ++k) { rr[k] -= mean; s2 += rr[k] * rr[k]; }
    const float rstd = __builtin_amdgcn_rsqf(wave_sum(s2) * (1.f / D) + LN_EPS);
#pragma unroll
    for (int q = 0; q < 4; ++q) { const f32x4 g = *(const f32x4*)(gam + 16 * lane + 4 * q), bb = *(const f32x4*)(bet + 16 * lane + 4 * q);
        f32x4 y; y[0] = rr[4 * q] * rstd * g[0] + bb[0]; y[1] = rr[4 * q + 1] * rstd * g[1] + bb[1]; y[2] = rr[4 * q + 2] * rstd * g[2] + bb[2]; y[3] = rr[4 * q + 3] * rstd * g[3] + bb[3];
        *(f32x4*)(xrow + 4 * q) = y; }
}
__device__ __forceinline__ void gather4(const v2u* sel, const G4& T, const float* rin, const float* g1, const float* b1, float* xo, const float* gam, const float* bet, int tok0, int lane, LAS f32x4* xl, LAS v2u* srt) {
    v2u en[4][2];
#pragma unroll
    for (int tt = 0; tt < 4; ++tt) { const float* rrow = rin + (size_t)(tok0 + tt) * D + 16 * lane;
        {
            f32x4 rv[4]; float s = 0.f;
#pragma unroll
            for (int q = 0; q < 4; ++q) { rv[q] = *(const f32x4*)(rrow + 4 * q); s += (rv[q][0] + rv[q][1]) + (rv[q][2] + rv[q][3]); }
            const float mean = wave_sum(s) * (1.f / D); float s2 = 0.f;
#pragma unroll
            for (int q = 0; q < 4; ++q) { rv[q] = rv[q] - mean; s2 += (rv[q][0] * rv[q][0] + rv[q][1] * rv[q][1]) + (rv[q][2] * rv[q][2] + rv[q][3] * rv[q][3]); }
            const float rstd = __builtin_amdgcn_rsqf(wave_sum(s2) * (1.f / D) + LN_EPS);
#pragma unroll
            for (int q = 0; q < 4; ++q) { const f32x4 gg = *(const f32x4*)(g1 + 16 * lane + 4 * q), bb = *(const f32x4*)(b1 + 16 * lane + 4 * q); xl[tt * 256 + q * 64] = rv[q] * rstd * gg + bb; }
        }
        const v2u e0 = sel[(size_t)(tok0 + tt) * 128 + lane], e1 = sel[(size_t)(tok0 + tt) * 128 + 64 + lane];
        const unsigned b0 = e0.x >> 9, b1 = e1.x >> 9; unsigned d0 = 0u, d1 = 0u, base = 0u;
#pragma unroll
        for (unsigned k = 0; k < 32; ++k) { const unsigned long long m0 = __ballot(b0 == k), m1 = __ballot(b1 == k);
            const unsigned c0 = (unsigned)__builtin_popcountll(m0), c1 = (unsigned)__builtin_popcountll(m1);
            const unsigned p0 = __builtin_amdgcn_mbcnt_hi((unsigned)(m0 >> 32), __builtin_amdgcn_mbcnt_lo((unsigned)m0, 0u)), p1 = __builtin_amdgcn_mbcnt_hi((unsigned)(m1 >> 32), __builtin_amdgcn_mbcnt_lo((unsigned)m1, 0u));
            d0 = (b0 == k) ? base + p0 : d0; d1 = (b1 == k) ? base + c0 + p1 : d1; base += c0 + c1; }
        srt[d0] = e0; srt[d1] = e1;
        asm volatile("s_waitcnt lgkmcnt(0)" ::: "memory");
        en[tt][0] = srt[lane]; en[tt][1] = srt[64 + lane];
        asm volatile("s_waitcnt lgkmcnt(0)" ::: "memory");
    }
    {
#pragma unroll 1
        for (int c = 0; c < 8; ++c) {
            v4u ua[16], ub[16];
            a_load(ua, PEER_EC(en[0], c), c, T.U8, lane); a_load(ub, PEER_EC(en[1], c), c, T.U8, lane); __builtin_amdgcn_sched_barrier(0);
            a_step(ua, en[0], c, xl + 0 * 256, T, lane); __builtin_amdgcn_sched_barrier(0);
            a_load(ua, PEER_EC(en[2], c), c, T.U8, lane); __builtin_amdgcn_sched_barrier(0);
            a_step(ub, en[1], c, xl + 1 * 256, T, lane); __builtin_amdgcn_sched_barrier(0);
            a_load(ub, PEER_EC(en[3], c), c, T.U8, lane); __builtin_amdgcn_sched_barrier(0);
            a_step(ua, en[2], c, xl + 2 * 256, T, lane); __builtin_amdgcn_sched_barrier(0);
            a_step(ub, en[3], c, xl + 3 * 256, T, lane); __builtin_amdgcn_sched_barrier(0);
        }
    }
    f32x2w acc[4][8];
#pragma unroll
    for (int tt = 0; tt < 4; ++tt)
#pragma unroll
        for (int q = 0; q < 8; ++q) acc[tt][q] = (f32x2w){0.f, 0.f};
    {
#define PEER_SB() __builtin_amdgcn_sched_barrier(0)
#pragma unroll 1
        for (int c = 0; c < 8; ++c) {
            const v2u e0 = PEER_EC(en[0], c), e1 = PEER_EC(en[1], c), e2 = PEER_EC(en[2], c), e3 = PEER_EC(en[3], c);
            v4u va[8], vb[8], vc[8];
            b_load8(va, e0, c, 0, T.V8, lane); b_load8(vb, e0, c, 1, T.V8, lane); PEER_SB();
            b_load8(vc, e1, c, 0, T.V8, lane); PEER_SB(); b_step8(va, e0, c, 0, acc[0]); PEER_SB();
            b_load8(va, e1, c, 1, T.V8, lane); PEER_SB(); b_step8(vb, e0, c, 1, acc[0]); PEER_SB();
            b_load8(vb, e2, c, 0, T.V8, lane); PEER_SB(); b_step8(vc, e1, c, 0, acc[1]); PEER_SB();
            b_load8(vc, e2, c, 1, T.V8, lane); PEER_SB(); b_step8(va, e1, c, 1, acc[1]); PEER_SB();
            b_load8(va, e3, c, 0, T.V8, lane); PEER_SB(); b_step8(vb, e2, c, 0, acc[2]); PEER_SB();
            b_load8(vb, e3, c, 1, T.V8, lane); PEER_SB(); b_step8(vc, e2, c, 1, acc[2]); PEER_SB();
            b_step8(va, e3, c, 0, acc[3]); PEER_SB(); b_step8(vb, e3, c, 1, acc[3]); PEER_SB();
        }
#undef PEER_SB
    }
#pragma unroll
    for (int tt = 0; tt < 4; ++tt) tok_finish(xl + tt * 256, acc[tt], xo + (size_t)(tok0 + tt) * D + 16 * lane, gam, bet, lane);
}
#undef PEER_EC
__device__ __forceinline__ void rows_to_fp8(const float* usrc, const float* vsrc, unsigned char* udst, unsigned char* vdst, float* uinv, float* vinv, int row0, int stride, int lane) {
    f32x4 nx[4];
    if (row0 < 2 * NEXP) { const float* p = (row0 < NEXP ? usrc + (size_t)row0 * D : vsrc + (size_t)(row0 - NEXP) * D) + 16 * lane;
#pragma unroll
        for (int q = 0; q < 4; ++q) nx[q] = *(const f32x4*)(p + 4 * q); }
#pragma unroll 1
    for (int row = row0; row < 2 * NEXP; row += stride) {
        f32x4 v[4]; float am = 0.f;
#pragma unroll
        for (int q = 0; q < 4; ++q) { v[q] = nx[q]; am = fmaxf(am, fmaxf(fmaxf(fabsf(v[q][0]), fabsf(v[q][1])), fmaxf(fabsf(v[q][2]), fabsf(v[q][3])))); }
        const int rn = row + stride;
        if (rn < 2 * NEXP) { const float* p = (rn < NEXP ? usrc + (size_t)rn * D : vsrc + (size_t)(rn - NEXP) * D) + 16 * lane;
#pragma unroll
            for (int q = 0; q < 4; ++q) nx[q] = *(const f32x4*)(p + 4 * q); }
        am = wave_max(am);
        float s = 1.f, is = 1.f;
        if (am > 1e-30f) { const int eb = (__float_as_int(224.f / am) >> 23) & 0xff; if (eb > 0 && eb < 254) { s = __int_as_float(eb << 23); is = __int_as_float((254 - eb) << 23); } }
        v4u o;
#pragma unroll
        for (int q = 0; q < 4; ++q) { int w = 0; w = __builtin_amdgcn_cvt_pk_fp8_f32(v[q][0] * s, v[q][1] * s, w, false); w = __builtin_amdgcn_cvt_pk_fp8_f32(v[q][2] * s, v[q][3] * s, w, true); o[q] = (unsigned)w; }
        unsigned char* dst = (row < NEXP ? udst + (size_t)row * D : vdst + (size_t)(row - NEXP) * D) + 16 * lane;
        *(v4u*)dst = o;
        if (lane == 0) { if (row < NEXP) uinv[row] = is; else vinv[row - NEXP] = is; }
    }
}
}
constexpr int NPH = 8;
__global__ void __launch_bounds__(NWAVES * 64, 2) mk_fwd(Args args) {
    extern __shared__ __attribute__((aligned(16))) unsigned char lds_raw[];
    LAS unsigned char* lds = (LAS unsigned char*)lds_raw;
    volatile LAS unsigned* MISC = (volatile LAS unsigned*)(lds + MISC_OFF);
    const int tid0 = threadIdx.x, lane0 = tid0 & 63, wave = __builtin_amdgcn_readfirstlane(tid0 >> 6);
    const int G = gridDim.x, bx = blockIdx.x, vcu = (G % 8 == 0) ? (bx % 8) * (G / 8) + bx / 8 : bx;
    unsigned char* ws0 = args.ws;
    gu32* ctl = (gu32*)(ws0 + WS_CTL);
    for (int u = tid0; u < (LDS_BYTES - RING_BYTES) / 4; u += NWAVES * 64) ((LAS unsigned*)(lds + RING_BYTES))[u] = 0u;
    __syncthreads();
    XcdBarrier bar; bar.bar = (unsigned*)(ctl + CW_BAR); bar.x = 0; bar.st = nullptr;
    if (MK_N_LAUNCHES == 1) bar = xcd_barrier_post((unsigned*)(ctl + CW_BAR), MISC + 8);
    const int lo = args.ph_lo, hi = args.ph_hi;
#ifndef PH_MASK
#define PH_MASK 0xFF
#endif
#define IN(k) ((((PH_MASK) >> (k)) & 1) && lo <= (k) && (k) < hi)
#define SEAM(k) do { if (IN(k) && IN((k) + 1)) xcd_barrier(bar); } while (0)
    const int NGW = G * NWAVES;
#define SUB_BEGIN() unsigned char* ws = ws0; asm volatile("" : "+s"(ws)); const int lane = (int)__builtin_amdgcn_mbcnt_hi(~0u, __builtin_amdgcn_mbcnt_lo(~0u, 0u)), tid = wave * 64 + lane; (void)tid; (void)lane
#define PHASE_BEGIN() unsigned char* ws = ws0; asm volatile("" : "+s"(ws)); const int lane = (int)__builtin_amdgcn_mbcnt_hi(~0u, __builtin_amdgcn_mbcnt_lo(~0u, 0u)), tid = wave * 64 + lane; const int gw = vcu * NWAVES + wave; (void)gw; (void)lane; (void)tid

    if (IN(0)) { PHASE_BEGIN(); p0_prologue(args, lds, vcu, G, wave, lane); VM_WAIT(); __syncthreads(); SEAM(0); }

    if (IN(1)) { PHASE_BEGIN();
        pg8::Gemm g{(const pg8::bf16_t*)(ws + WS_A), (const pg8::bf16_t*)(ws + WS_WIN), T, INC, D}; pg8::StaticOrder S; S.init(T, INC, G, bx); S.rep = NREP(1);
        pg8::EpiInProj E{(pg8::bf16_t*)(ws + WS_QD), (pg8::bf16_t*)(ws + WS_KD), (pg8::bf16_t*)(ws + WS_VD), (pg8::bf16_t*)(ws + WS_LQ), (pg8::bf16_t*)(ws + WS_LK), (pg8::bf16_t*)(ws + WS_LV),
                         (pg8::bf16_t*)(ws + WS_GA), (pg8::bf16_t*)(ws + WS_GB)};
        pg8::gemm_phase<pg8::EpiInProj, pg8::StaticOrder, true, true>(lds, g, S, E);
        {
            const int nwg = (T / 256) * (INC / 256), rem = nwg % G, nshort = rem ? G - rem : G, first = rem ? rem : 0;
            if (bx >= first) peer::rows_to_fp8(args.in[I_PU], args.in[I_PV], ws + WS_UU, ws + WS_UV, (float*)(ws + WS_ISU), (float*)(ws + WS_ISV), (bx - first) * NWAVES + wave, nshort * NWAVES, lane);
        }
        SEAM(1);
    }

    if (IN(2)) { PHASE_BEGIN();
#ifndef NO_DIFF
        {   SUB_BEGIN();
            const da::Tensors X{(const bf16*)(ws + WS_QD), (const bf16*)(ws + WS_KD), (const bf16*)(ws + WS_VD), (float*)(ws + WS_STASH), (bf16*)(ws + WS_YA),
                                args.in[I_DLAM], args.in[I_SUBG], args.in[I_RELB]};
            int cur_h = -1;
            float lam; { const float* dl = args.in[I_DLAM]; const float p1 = dl[lane] * dl[64 + lane], p2 = dl[128 + lane] * dl[192 + lane];
                lam = __uint_as_float(__builtin_amdgcn_readfirstlane(__float_as_uint(__expf(wave_sum(p1)) - __expf(wave_sum(p2)) + LAM_INIT))); }
            for (int rep_ = 0; rep_ < NREP(20); ++rep_)
            for (int p = vcu; p < 256; p += G) {
                const int bh = p >> 5, s = p & 31, b = bh >> 2, h = bh & 3;
                if (h != cur_h) {
                    __syncthreads();
                    const float* bd = (const float*)(ws + WS_BIASD) + h * BIAS_TAB; asm volatile("" : "+s"(bd));
                    for (int i = tid; i < BIAS_TAB; i += NWAVES * 64) ((LAS float*)(lds + da::LDS_BIAS))[i] = bd[i];
                    __syncthreads(); cur_h = h;
                }
                const float c31 = args.in[I_RELB][31 * 16 + h] * LOG2E;
                for (int k2 = 0; k2 < 2; ++k2) da::unit(X, b, h, k2 ? 63 - s : s, lds, bx, lam, c31);
            }
        }
#endif
#ifndef NO_DIL
        {   SUB_BEGIN();
            const dil::Tensors X{(const bf16*)(ws + WS_LQ), (const bf16*)(ws + WS_LK), (const bf16*)(ws + WS_LV), (bf16*)(ws + WS_YB)};
            int cur_h = -1;
            for (int rep_ = 0; rep_ < NREP(21); ++rep_)
            for (int u = vcu; u < 256; u += G) {
                const int bh = u >> 5, blk = u & 31, b = bh >> 2, h = bh & 3;
                if (h != cur_h) {
                    __syncthreads();
                    const float* blsrc = (const float*)(ws + WS_BIASL);
                    for (int i = tid; i < 3 * dil::BT; i += NWAVES * 64) { const int g = i / dil::BT, jj = i % dil::BT - dil::BT0;
                        ((LAS float*)(lds + dil::LDS_BL))[i] = (jj >= 0 && jj <= 128) ? blsrc[(g * 4 + h) * 132 + jj] : 0.f; }
                    __syncthreads(); cur_h = h;
                }
                float* lse0 = (float*)(ws + WS_LSE0);
                for (int k2 = 0; k2 < 2; ++k2) dil::wave_tile_g0(X, lse0, b, h, blk * 512 + (wave + 8 * k2) * 32, lds + dil::LDS_VST + wave * 4096, (const LAS float*)(lds + dil::LDS_BL), lane);
                VM_WAIT(); __syncthreads();
                for (int k2 = 0; k2 < 2; ++k2) dil::wave_tile(X, lse0, b, h, blk * 512, wave + 8 * k2, lds + dil::LDS_VST + wave * 4096, (const LAS float*)(lds + dil::LDS_BL), lane);
            }
            __syncthreads();
        }
#endif
        SEAM(2);
    }

    if (IN(3)) { PHASE_BEGIN();
        { pg8::Gemm g{(const pg8::bf16_t*)(ws + WS_YA), (const pg8::bf16_t*)(ws + WS_WBD), T, D, 512}; pg8::StaticOrder S; S.init(T, D, G, bx); S.rep = NREP(3);
          pg8::EpiGate1 E{(const pg8::bf16_t*)(ws + WS_GA), (pg8::bf16_t*)(ws + WS_GATED)};
          pg8::gemm_phase<pg8::EpiGate1, pg8::StaticOrder, true, true>(lds, g, S, E); }
        VM_WAIT(); __syncthreads();
        { pg8::Gemm g{(const pg8::bf16_t*)(ws + WS_YB), (const pg8::bf16_t*)(ws + WS_WBL), T, D, 256}; pg8::StaticOrder S; S.init(T, D, G, bx);
          pg8::EpiGate2 E{(const pg8::bf16_t*)(ws + WS_GB), (pg8::bf16_t*)(ws + WS_GATED)};
          pg8::gemm_phase<pg8::EpiGate2, pg8::StaticOrder, true, true>(lds, g, S, E); }
        SEAM(3);
    }

    if (IN(4)) { PHASE_BEGIN();
        pg8::Gemm g{(const pg8::bf16_t*)(ws + WS_GATED), (const pg8::bf16_t*)(ws + WS_WO), T, D, D}; pg8::StaticOrder S; S.init(T, D, G, bx); S.rep = NREP(4);
        pg8::EpiOut E{args.in[I_X], (float*)(ws + WS_R)};
        pg8::gemm_phase<pg8::EpiOut, pg8::StaticOrder, true, true>(lds, g, S, E);
        SEAM(4);
    }

    if (IN(5)) { PHASE_BEGIN();
        p5_ln1(args, vcu, G, wave, lane);
        SEAM(5);
    }

    if (IN(6)) { PHASE_BEGIN();
        pg8::Gemm g{(const pg8::bf16_t*)(ws + WS_WP), (const pg8::bf16_t*)(ws + WS_A), 2048, T, D}; pg8::StaticOrder S; S.init(2048, T, G, bx); S.rep = NREP(6);
        pg8::EpiScoreT E{(float*)(ws + WS_ST)};
        pg8::gemm_phase<pg8::EpiScoreT, pg8::StaticOrder, true, true>(lds, g, S, E);
        SEAM(6);
    }

    if (IN(7)) { PHASE_BEGIN();
        const float* ST = (const float*)(ws + WS_ST); v2u* sel = (v2u*)(ws + WS_SEL);
        for (int u = vcu; u < T / 128; u += G) {
            for (int p = 0; p < 2; ++p) peer::select(ST, sel, u * 128 + p * 64 + lane, wave);
            VM_WAIT(); __syncthreads();
            { const peer::G4 TB{ws + WS_UU, ws + WS_UV, (const float*)(ws + WS_ISU), (const float*)(ws + WS_ISV)};
              for (int i = 0; i < 4; ++i) peer::gather4(sel, TB, (const float*)(ws + WS_R), args.in[I_LN1G], args.in[I_LN1B], args.out, args.in[I_LN2G], args.in[I_LN2B], u * 128 + i * 32 + wave * 4, lane, (LAS f32x4*)(lds + wave * 16384) + lane, (LAS v2u*)(lds + RING_BYTES + 2048 + wave * 1024)); }
            VM_WAIT(); __syncthreads();
        }
    }
#undef IN
#undef SEAM
}

extern "C" void kernel_launch(void* const* d_in, const int* in_sizes, int n_in, void* d_out, int out_size, void* d_ws, size_t ws_size, hipStream_t stream) {
    static int grid = 0;
    if (grid == 0) {
        if (n_in != 16 || in_sizes[0] != T * D || out_size != T * D || ws_size < WS_END) { fprintf(stderr, "kernel_launch: unexpected shapes (n_in %d, in0 %d, out %d, ws %zu); nothing launched\n", n_in, n_in > 0 ? in_sizes[0] : -1, out_size, ws_size); grid = -1; return; }
        int dev = 0, cus = 0, per_cu = 0;
        if (hipGetDevice(&dev) != hipSuccess || hipDeviceGetAttribute(&cus, hipDeviceAttributeMultiprocessorCount, dev) != hipSuccess) { grid = -1; return; }
        if (hipFuncSetAttribute((const void*)mk_fwd, hipFuncAttributeMaxDynamicSharedMemorySize, LDS_BYTES) != hipSuccess) { fprintf(stderr, "kernel_launch: hipFuncSetAttribute failed\n"); grid = -1; return; }
        if (hipOccupancyMaxActiveBlocksPerMultiprocessor(&per_cu, (const void*)mk_fwd, NWAVES * 64, LDS_BYTES) != hipSuccess || per_cu < 1) { fprintf(stderr, "kernel_launch: occupancy query reports %d\n", per_cu); per_cu = 1; }
        (void)hipGetLastError();
        grid = cus;
    }
    if (grid < 0) return;
    if (hipMemsetAsync((char*)d_ws + WS_CTL, 0, CTL_ZERO_BYTES, stream) != hipSuccess) return;
    Args a{};
    for (int i = 0; i < 16; ++i) a.in[i] = (const float*)d_in[i];
    a.out = (float*)d_out; a.ws = (unsigned char*)d_ws;
    for (int li = 0; li < MK_N_LAUNCHES; ++li) {
        a.ph_lo = (MK_N_LAUNCHES == 1) ? 0 : li; a.ph_hi = (MK_N_LAUNCHES == 1) ? NPH : li + 1;
        hipLaunchKernelGGL(mk_fwd, dim3(grid), dim3(NWAVES * 64), LDS_BYTES, stream, a);
    }
}
```

```cpp
#include <hip/hip_runtime.h>
#include <cstdio>
#include <cstdint>

#ifndef MK_N_LAUNCHES
#define MK_N_LAUNCHES 1
#endif

#ifndef REPEAT_PH
#define REPEAT_PH (-1)
#endif
#define NREP(k) ((REPEAT_PH) == (k) ? 2 : 1)

constexpr int BATCH = 2, SEQ = 16384, T = BATCH * SEQ, D = 1024, INC = 5888;
constexpr int OFF_DQ = 0, OFF_DK = 512, OFF_DV = 1024, OFF_LQ = 1536, OFF_LK = 2304, OFF_LV = 3072, OFF_GA = 3840, OFF_GB = 4864;
constexpr int NEXP = 16384;
constexpr float LOG2E = 1.4426950408889634f;
constexpr float QSCALE = 0.125f * LOG2E;
constexpr float ALPHA = 1.189207115002721f;
constexpr float LN_EPS = 1e-5f, SUBLN_EPS = 1e-5f;
constexpr float LAM_INIT = 0.2f;
constexpr int NTILE = SEQ / 64;
constexpr int BIAS_TAB = 2240, BIAS_GUARD = 256, DFAR = 1513;

constexpr size_t MiB = 1u << 20;
constexpr size_t WS_CTL = 0, CTL_ZERO_BYTES = 1 * MiB;
constexpr size_t WS_BIASD = 1 * MiB;
constexpr size_t WS_BIASL = 1 * MiB + 64 * 1024;
constexpr size_t WS_WIN = 8 * MiB, WS_WO = 20 * MiB, WS_WBD = 22 * MiB, WS_WBL = 23 * MiB, WS_WP = 24 * MiB;
constexpr size_t WS_A = 32 * MiB;
constexpr size_t WS_YA = WS_A, WS_YB = WS_A + 32 * MiB;
constexpr size_t WS_QD = 96 * MiB, WS_KD = 128 * MiB, WS_VD = 160 * MiB, WS_LQ = 192 * MiB, WS_LK = 240 * MiB, WS_LV = 288 * MiB, WS_GA = 336 * MiB, WS_GB = 400 * MiB;
constexpr size_t WS_STASH = 464 * MiB;
constexpr size_t WS_SEL = 32 * MiB;
constexpr size_t WS_GATED = 96 * MiB;
constexpr size_t WS_R = 352 * MiB;
constexpr size_t WS_ST = 96 * MiB;
constexpr size_t WS_UU = 480 * MiB, WS_UV = 496 * MiB;
constexpr size_t WS_LSE0 = 3 * MiB;
constexpr size_t WS_ISU = 2 * MiB, WS_ISV = 2 * MiB + 65536;
constexpr size_t WS_END = 512 * MiB;

constexpr int CW_BAR = 4096;
constexpr int NWAVES = 8;
constexpr int RING_BYTES = 131072, MISC_OFF = RING_BYTES + 320, LDS_BYTES = 147456;

#define GAS __attribute__((address_space(1)))
#define LAS __attribute__((address_space(3)))
typedef unsigned short bf16;
typedef unsigned v4u __attribute__((ext_vector_type(4)));
typedef unsigned v2u __attribute__((ext_vector_type(2)));
typedef float f32x4 __attribute__((ext_vector_type(4)));
typedef float f32x16 __attribute__((ext_vector_type(16)));
typedef short bf16x8 __attribute__((ext_vector_type(8)));
typedef short s16x4 __attribute__((ext_vector_type(4)));
typedef __bf16 bf16x2 __attribute__((ext_vector_type(2)));
typedef GAS unsigned gu32;
#define RLX_AGENT __ATOMIC_RELAXED, __HIP_MEMORY_SCOPE_AGENT
#define LDS_WAIT() asm volatile("s_waitcnt lgkmcnt(0)" ::: "memory")
#define VM_WAIT() asm volatile("s_waitcnt vmcnt(0)" ::: "memory")
__device__ __forceinline__ unsigned f2bf(float f) { unsigned u = __builtin_bit_cast(unsigned, f); return (u + 0x7fffu + ((u >> 16) & 1u)) >> 16; }
__device__ __forceinline__ unsigned pk2(float lo, float hi) { return f2bf(lo) | (f2bf(hi) << 16); }
typedef float f32x2_t __attribute__((ext_vector_type(2)));
__device__ __forceinline__ unsigned cvtpk(float lo, float hi) { f32x2_t v = {lo, hi}; bf16x2 b = __builtin_convertvector(v, bf16x2); return __builtin_bit_cast(unsigned, b); }
__device__ __forceinline__ float bf_lo(unsigned w) { return __builtin_bit_cast(float, w << 16); }
__device__ __forceinline__ float bf_hi(unsigned w) { return __builtin_bit_cast(float, w & 0xffff0000u); }
__device__ __forceinline__ float dot2bf(unsigned a, unsigned b, float acc) { return __builtin_amdgcn_fdot2_f32_bf16(__builtin_bit_cast(bf16x2, a), __builtin_bit_cast(bf16x2, b), acc, false); }
__device__ __forceinline__ float wave_sum(float v) {
#pragma unroll
    for (int o = 1; o < 64; o <<= 1) v += __shfl_xor(v, o);
    return v;
}
__device__ __forceinline__ float wave_max(float v) {
#pragma unroll
    for (int o = 1; o < 64; o <<= 1) v = fmaxf(v, __shfl_xor(v, o));
    return v;
}
__device__ __forceinline__ int rel_bucket(int n) {
    if (n < 16) return n < 0 ? 0 : n;
    return 16 + (n >= 22) + (n >= 30) + (n >= 40) + (n >= 54) + (n >= 73) + (n >= 99) + (n >= 134) + (n >= 182) + (n >= 246) + (n >= 332) + (n >= 450) + (n >= 609) + (n >= 825) + (n >= 1117) + (n >= 1513);
}
namespace pg8 {
#define PG8_LAS __attribute__((address_space(3)))
typedef unsigned short bf16_t;
typedef short bf16x8 __attribute__((ext_vector_type(8)));
typedef float f32x4 __attribute__((ext_vector_type(4)));
typedef unsigned u32x4 __attribute__((ext_vector_type(4)));
constexpr int BM = 256, BK = 64, HALF = 128, HTB = HALF * BK * 2  , STAGE_BYTES = 8 * HTB, NXCD = 8, WGM = 8;

__host__ __device__ __forceinline__ int lds_byte(int r, int c) { const int st = (r >> 4) * 2 + (c >> 5), rr = r & 15, cc = c & 31, ob = rr * 64 + cc * 2; return st * 1024 + (ob ^ (((ob >> 9) & 1) << 5)); }
__host__ __device__ __forceinline__ void stage_rc(int b, int& R, int& C) { const int st = b / 1024, sb = b % 1024, swz = sb ^ (((sb >> 9) & 1) << 5); R = (st >> 1) * 16 + swz / 64; C = (st & 1) * 32 + (swz % 64) / 2; }
__host__ __device__ __forceinline__ int perm32(int rho) { const int n = rho >> 4, i = rho & 15; return 8 * (i >> 2) + 4 * n + (i & 3); }

struct Unit { int pm, pn; };
struct Gemm { const bf16_t* A; const bf16_t* Bt; int M, N, K; };

struct StaticOrder {
    int nM, nN, nwg, G, c;
    __host__ __device__ void init(int M, int N, int G_, int c_) { nM = M / BM; nN = N / BM; nwg = nM * nN; G = G_; c = c_; }
    int rep = 1;
    __host__ __device__ bool next(int i0, Unit& u) const {
        const int i = i0 / rep;
        const long L = (long)i * G + c; if (L >= nwg) return false;
        int wgid = (int)L; { const int q = nwg / NXCD, r = nwg % NXCD, xcd = wgid % NXCD, off = wgid / NXCD; wgid = (xcd < r ? xcd * (q + 1) : r * (q + 1) + (xcd - r) * q) + off; }
        const int nig = WGM * nN, gid = wgid / nig, fm = gid * WGM, gsz = (nM - fm) < WGM ? (nM - fm) : WGM;
        u.pm = fm + ((wgid % nig) % gsz); u.pn = (wgid % nig) / gsz; return true;
    }
    __device__ __forceinline__ void a_ready(const Unit&) const {}
    __device__ __forceinline__ void done(const Unit&) const {}
};
__device__ __forceinline__ unsigned cvt_pk_bf16(float lo, float hi) { unsigned r; asm volatile("v_cvt_pk_bf16_f32 %0, %1, %2" : "=v"(r) : "v"(lo), "v"(hi)); return r; }
__device__ __forceinline__ u32x4 pack8(const f32x4 v0, const f32x4 v1) { u32x4 w; w.x = cvt_pk_bf16(v0[0], v0[1]); w.y = cvt_pk_bf16(v0[2], v0[3]); w.z = cvt_pk_bf16(v1[0], v1[1]); w.w = cvt_pk_bf16(v1[2], v1[3]); return w; }
__device__ __forceinline__ float blo(unsigned w) { return __builtin_bit_cast(float, w << 16); }
__device__ __forceinline__ float bhi(unsigned w) { return __builtin_bit_cast(float, w & 0xffff0000u); }
__device__ __forceinline__ float sigm(float v) { return __builtin_amdgcn_rcpf(1.f + __expf(-v)); }
template <class E> __device__ __forceinline__ void epi_loop(const E& e, const f32x4 (&acc)[2][2][4][2], const Unit& u, int wr, int wc, int fr, int fq) {
#pragma unroll
    for (int ai = 0; ai < 2; ++ai)
#pragma unroll
        for (int m = 0; m < 4; ++m) { const int row = u.pm * BM + ai * HALF + wr * 64 + m * 16 + fr;
#pragma unroll
            for (int bj = 0; bj < 2; ++bj) { const int col = u.pn * BM + bj * HALF + wc * 32 + 8 * fq; e.item(u.pn, row, col, acc[ai][bj][m][0], acc[ai][bj][m][1]); } }
}

struct EpiInProj {
    static constexpr bool PERM = true, AFTER_DRAIN = false;
    bf16_t *Qd, *Kd, *Vd, *LQ, *LK, *LV, *GA, *GB;
    __device__ __forceinline__ void operator()(const f32x4 (&acc)[2][2][4][2], const Unit& u, int wr, int wc, int fr, int fq) const { epi_loop(*this, acc, u, wr, wc, fr, fq); }
    __device__ __forceinline__ void item(int pn, int row, int col, f32x4 v0, f32x4 v1) const {
            const int b = row >> 14, s = row & 16383; bf16_t* dst;
            if (pn < 2) {
                const int h = col >> 7, c = (col >> 6) & 1, d = col & 63; v0 = v0 * 0.18033688011112042f; v1 = v1 * 0.18033688011112042f;
                dst = Qd + ((size_t)((b * 4 + h) * 2 + c) * 16384 + s) * 64 + d;
            } else if (pn < 4) {
                const int cc = col - 512, h = cc >> 7, c = (cc >> 6) & 1, d = cc & 63;
                dst = Kd + ((((size_t)((b * 4 + h) * 2 + c) * 256 + (s >> 6)) * 8 + (d >> 3)) * 64 + (s & 63)) * 8;
            } else if (pn < 6) {
                const int cc = col - 1024, h = cc >> 7, d = cc & 127;
                dst = Vd + ((size_t)(b * 4 + h) * 256 + (s >> 6)) * 8192 + ((d >> 5) * 4 + ((s & 63) >> 4)) * 512 + (s & 15) * 32 + (d & 31);
            } else if (pn < 9) {
                v0 = v0 * 0.18033688011112042f; v1 = v1 * 0.18033688011112042f; dst = LQ + (size_t)row * 768 + (col - 1536);
            } else if (pn < 12) { dst = LK + (size_t)row * 768 + (col - 2304);
            } else if (pn < 15) { dst = LV + (size_t)row * 768 + (col - 3072);
            } else {
#pragma unroll
                for (int i = 0; i < 4; ++i) { v0[i] = sigm(v0[i]); v1[i] = sigm(v1[i]); }
                dst = (pn < 19) ? GA + (size_t)row * 1024 + (col - 3840) : GB + (size_t)row * 1024 + (col - 4864);
            }
            *(u32x4*)dst = pack8(v0, v1);
        }
};
struct EpiGate1 {
    static constexpr bool PERM = true, AFTER_DRAIN = false;
    const bf16_t* GA; bf16_t* G;
    __device__ __forceinline__ void operator()(const f32x4 (&acc)[2][2][4][2], const Unit& u, int wr, int wc, int fr, int fq) const { epi_loop(*this, acc, u, wr, wc, fr, fq); }
    __device__ __forceinline__ void item(int pn, int row, int col, f32x4 v0, f32x4 v1) const {
            const size_t o = (size_t)row * 1024 + col; const u32x4 g = *(const u32x4*)(GA + o);
            v0[0] *= blo(g.x); v0[1] *= bhi(g.x); v0[2] *= blo(g.y); v0[3] *= bhi(g.y); v1[0] *= blo(g.z); v1[1] *= bhi(g.z); v1[2] *= blo(g.w); v1[3] *= bhi(g.w);
            *(u32x4*)(G + o) = pack8(v0, v1);
        }
};
struct EpiGate2 {
    static constexpr bool PERM = true, AFTER_DRAIN = false;
    const bf16_t* GB; bf16_t* G;
    __device__ __forceinline__ void operator()(const f32x4 (&acc)[2][2][4][2], const Unit& u, int wr, int wc, int fr, int fq) const { epi_loop(*this, acc, u, wr, wc, fr, fq); }
    __device__ __forceinline__ void item(int pn, int row, int col, f32x4 v0, f32x4 v1) const {
            const size_t o = (size_t)row * 1024 + col; const u32x4 g = *(const u32x4*)(GB + o); const u32x4 p = *(const u32x4*)(G + o);
            v0[0] = v0[0] * blo(g.x) + blo(p.x); v0[1] = v0[1] * bhi(g.x) + bhi(p.x); v0[2] = v0[2] * blo(g.y) + blo(p.y); v0[3] = v0[3] * bhi(g.y) + bhi(p.y);
            v1[0] = v1[0] * blo(g.z) + blo(p.z); v1[1] = v1[1] * bhi(g.z) + bhi(p.z); v1[2] = v1[2] * blo(g.w) + blo(p.w); v1[3] = v1[3] * bhi(g.w) + bhi(p.w);
            *(u32x4*)(G + o) = pack8(v0, v1);
        }
};
struct EpiOut {
    static constexpr bool PERM = true, AFTER_DRAIN = false;
    const float* X; float* R;
    __device__ __forceinline__ void operator()(const f32x4 (&acc)[2][2][4][2], const Unit& u, int wr, int wc, int fr, int fq) const { epi_loop(*this, acc, u, wr, wc, fr, fq); }
    __device__ __forceinline__ void item(int pn, int row, int col, f32x4 v0, f32x4 v1) const {
            const size_t o = (size_t)row * 1024 + col; const f32x4 x0 = *(const f32x4*)(X + o), x1 = *(const f32x4*)(X + o + 4);
            *(f32x4*)(R + o) = x0 * 1.189207115002721f + v0; *(f32x4*)(R + o + 4) = x1 * 1.189207115002721f + v1;
    }
};
struct EpiScoreT {
    static constexpr bool PERM = true, AFTER_DRAIN = false;
    float* ST;
    __device__ __forceinline__ void operator()(const f32x4 (&acc)[2][2][4][2], const Unit& u, int wr, int wc, int fr, int fq) const { epi_loop(*this, acc, u, wr, wc, fr, fq); }
    __device__ __forceinline__ void item(int pn, int row, int col, f32x4 v0, f32x4 v1) const { const size_t o = (size_t)row * 32768 + col; *(f32x4*)(ST + o) = v0; *(f32x4*)(ST + o + 4) = v1; }
};
template <class Epi, class Sched, bool ALIGN_EPI = false, bool SP2 = false>
__device__ __forceinline__ void gemm_phase(PG8_LAS unsigned char* lds, const Gemm g, const Sched& S, const Epi& E, const int wid  ) {
    const int lane = (int)__builtin_amdgcn_mbcnt_hi(~0u, __builtin_amdgcn_mbcnt_lo(~0u, 0u)), tid = wid * 64 + lane, wr = wid >> 2, wc = wid & 3, fr = lane & 15, fq = lane >> 4;
    const int K = g.K, nt = K / BK;
    unsigned voffA[2], voffB[2];
#pragma unroll
    for (int i = 0; i < 2; ++i) { int R, C; stage_rc(tid * 16 + i * 8192, R, C); const int Rb = Epi::PERM ? ((R & ~31) + perm32(R & 31)) : R;
        voffA[i] = (unsigned)(R * K + C) * 2u; voffB[i] = (unsigned)(Rb * K + C) * 2u; }
    const size_t kstep = (size_t)(BK * 2);
    const size_t hstep = (size_t)HALF * K * 2;
    const size_t tstep = 2 * hstep;
    const unsigned ldsw = (unsigned)wid * 1024u;
    const int aoff = lds_byte(wr * 64 + fr, fq * 8), boff = lds_byte(wc * 32 + fr, fq * 8);
#define PG8_SA(b, h) (((b) * 2 + (h)) * HTB)
#define PG8_SB(b, h) ((4 + (b) * 2 + (h)) * HTB)
#define PG8_STAGE(bufoff, gbase, voff) do { _Pragma("unroll") for (int _i = 0; _i < 2; ++_i) \
        __builtin_amdgcn_global_load_lds((const unsigned*)((const char*)(gbase) + (voff)[_i]), (PG8_LAS unsigned*)(lds + (bufoff) + ldsw + _i * 8192), 16, 0, 0); } while (0)
#define PG8_LDA(dst, b, h) do { _Pragma("unroll") for (int m = 0; m < 4; ++m) _Pragma("unroll") for (int k = 0; k < 2; ++k) dst[m][k] = *(const PG8_LAS bf16x8*)(lds + PG8_SA(b, h) + aoff + m * 2048 + k * 1024); } while (0)
#define PG8_LDB(dst, b, h) do { _Pragma("unroll") for (int n = 0; n < 2; ++n) _Pragma("unroll") for (int k = 0; k < 2; ++k) dst[n][k] = *(const PG8_LAS bf16x8*)(lds + PG8_SB(b, h) + boff + n * 2048 + k * 1024); } while (0)
#define PG8_MMA(ai, bj, At, Bt) do { __builtin_amdgcn_s_setprio(1); _Pragma("unroll") for (int m = 0; m < 4; ++m) _Pragma("unroll") for (int n = 0; n < 2; ++n) _Pragma("unroll") for (int k = 0; k < 2; ++k) \
        acc[ai][bj][m][n] = __builtin_amdgcn_mfma_f32_16x16x32_bf16(Bt[n][k], At[m][k], acc[ai][bj][m][n], 0, 0, 0); __builtin_amdgcn_s_setprio(0); } while (0)
#define PG8_WAIT_V(n) asm volatile("s_waitcnt vmcnt(" #n ")" ::: "memory")
#define PG8_WAIT_L(n) asm volatile("s_waitcnt lgkmcnt(" #n ")" ::: "memory")
#define PG8_BAR __builtin_amdgcn_s_barrier()
#define PG8_SCHED __builtin_amdgcn_sched_barrier(0)
    Unit cur, nxt; int ui = 0;
    if (!S.next(0, cur)) return;
    f32x4 acc[2][2][4][2];
#pragma unroll
    for (int a = 0; a < 2; ++a)
#pragma unroll
        for (int b = 0; b < 2; ++b)
#pragma unroll
            for (int m = 0; m < 4; ++m)
#pragma unroll
                for (int n = 0; n < 2; ++n) acc[a][b][m][n] = (f32x4){0.f, 0.f, 0.f, 0.f};
    bf16x8 At[4][2], B0[2][2], B1[2][2];
    const char* cA = (const char*)g.A + (size_t)cur.pm * tstep; const char* cB = (const char*)g.Bt + (size_t)cur.pn * tstep;
    S.a_ready(cur);
    if constexpr (SP2) {
        PG8_STAGE(PG8_SB(0, 0), cB, voffB); PG8_STAGE(PG8_SB(0, 1), cB + hstep, voffB); PG8_STAGE(PG8_SA(0, 0), cA, voffA); PG8_STAGE(PG8_SA(0, 1), cA + hstep, voffA);
        if (wr == 1) PG8_BAR;
        PG8_WAIT_V(2); PG8_BAR;
        PG8_STAGE(PG8_SB(1, 0), cB + kstep, voffB); PG8_STAGE(PG8_SA(1, 0), cA + kstep, voffA); PG8_STAGE(PG8_SB(1, 1), cB + hstep + kstep, voffB);
        PG8_WAIT_V(6); PG8_BAR;
    } else {
        PG8_STAGE(PG8_SB(0, 0), cB, voffB); PG8_STAGE(PG8_SA(0, 0), cA, voffA); PG8_STAGE(PG8_SB(0, 1), cB + hstep, voffB); PG8_STAGE(PG8_SA(0, 1), cA + hstep, voffA);
        if (wr == 1) PG8_BAR;
        PG8_WAIT_V(4); PG8_BAR;
        PG8_STAGE(PG8_SB(1, 0), cB + kstep, voffB); PG8_STAGE(PG8_SA(1, 0), cA + kstep, voffA); PG8_STAGE(PG8_SB(1, 1), cB + hstep + kstep, voffB);
        PG8_WAIT_V(6); PG8_BAR;
    }
    for (;;) {
        const bool has_next = S.next(ui + 1, nxt);
        const char* nA = has_next ? (const char*)g.A + (size_t)nxt.pm * tstep : cA; const char* nB = has_next ? (const char*)g.Bt + (size_t)nxt.pn * tstep : cB;
        for (int t = 0; t < nt; t += 2) {
            const bool last = (t == nt - 2);
            const char* a1 = cA + (size_t)(t + 1) * kstep;
            const char* a2 = last ? nA : cA + (size_t)(t + 2) * kstep; const char* b2 = last ? nB : cB + (size_t)(t + 2) * kstep;
            const char* a3 = a2 + kstep; const char* b3 = b2 + kstep;
            if (last && has_next) S.a_ready(nxt);
            if constexpr (SP2) {
            PG8_LDB(B0, 0, 0); PG8_LDB(B1, 0, 1); PG8_SCHED; PG8_LDA(At, 0, 0); PG8_STAGE(PG8_SA(1, 1), a1 + hstep, voffA);
            PG8_WAIT_V(8); PG8_WAIT_L(0); PG8_BAR; PG8_MMA(0, 0, At, B0); PG8_MMA(0, 1, At, B1); PG8_BAR; PG8_SCHED;
            PG8_LDA(At, 0, 1); PG8_STAGE(PG8_SB(0, 0), b2, voffB); PG8_STAGE(PG8_SB(0, 1), b2 + hstep, voffB); PG8_STAGE(PG8_SA(0, 0), a2, voffA);
            PG8_WAIT_V(8); PG8_WAIT_L(0); PG8_BAR; PG8_MMA(1, 0, At, B0); PG8_MMA(1, 1, At, B1); PG8_BAR; PG8_SCHED;
            PG8_LDB(B0, 1, 0); PG8_LDB(B1, 1, 1); PG8_SCHED; PG8_LDA(At, 1, 0); PG8_STAGE(PG8_SA(0, 1), a2 + hstep, voffA);
            PG8_WAIT_V(8); PG8_WAIT_L(0); PG8_BAR; PG8_MMA(0, 0, At, B0); PG8_MMA(0, 1, At, B1); PG8_BAR; PG8_SCHED;
            PG8_LDA(At, 1, 1); PG8_STAGE(PG8_SB(1, 0), b3, voffB); PG8_STAGE(PG8_SB(1, 1), b3 + hstep, voffB); PG8_STAGE(PG8_SA(1, 0), a3, voffA);
            PG8_WAIT_V(8); PG8_WAIT_L(0); PG8_BAR; PG8_MMA(1, 0, At, B0); PG8_MMA(1, 1, At, B1); PG8_BAR; PG8_SCHED;
            } else {
            PG8_LDB(B0, 0, 0); PG8_SCHED; PG8_LDA(At, 0, 0); PG8_STAGE(PG8_SA(1, 1), a1 + hstep, voffA);
            PG8_WAIT_L(8); PG8_BAR; PG8_WAIT_L(0); PG8_MMA(0, 0, At, B0); PG8_BAR; PG8_SCHED;
            PG8_LDB(B1, 0, 1); PG8_STAGE(PG8_SB(0, 0), b2, voffB);
            PG8_BAR; PG8_WAIT_L(0); PG8_MMA(0, 1, At, B1); PG8_BAR;
            PG8_LDA(At, 0, 1); PG8_STAGE(PG8_SA(0, 0), a2, voffA);
            PG8_BAR; PG8_WAIT_L(0); PG8_MMA(1, 0, At, B0); PG8_BAR; PG8_SCHED;
            PG8_STAGE(PG8_SB(0, 1), b2 + hstep, voffB);
            PG8_WAIT_V(6); PG8_BAR; PG8_MMA(1, 1, At, B1); PG8_BAR;
            PG8_LDB(B0, 1, 0); PG8_SCHED; PG8_LDA(At, 1, 0); PG8_STAGE(PG8_SA(0, 1), a2 + hstep, voffA);
            PG8_WAIT_L(8); PG8_BAR; PG8_WAIT_L(0); PG8_MMA(0, 0, At, B0); PG8_BAR; PG8_SCHED;
            PG8_LDB(B1, 1, 1); PG8_STAGE(PG8_SB(1, 0), b3, voffB);
            PG8_BAR; PG8_WAIT_L(0); PG8_MMA(0, 1, At, B1); PG8_BAR;
            PG8_LDA(At, 1, 1); PG8_STAGE(PG8_SA(1, 0), a3, voffA);
            PG8_BAR; PG8_WAIT_L(0); PG8_MMA(1, 0, At, B0); PG8_BAR; PG8_SCHED;
            PG8_STAGE(PG8_SB(1, 1), b3 + hstep, voffB);
            PG8_WAIT_V(6); PG8_BAR; PG8_MMA(1, 1, At, B1); PG8_BAR;
            }
        }
        if constexpr (ALIGN_EPI) { if (wr == 0) PG8_BAR; }
        if constexpr (!Epi::AFTER_DRAIN) { E(acc, cur, wr, wc, fr, fq); S.done(cur); }
        if (!has_next) break;
#pragma unroll
        for (int a = 0; a < 2; ++a)
#pragma unroll
            for (int b = 0; b < 2; ++b)
#pragma unroll
                for (int m = 0; m < 4; ++m)
#pragma unroll
                    for (int n = 0; n < 2; ++n) acc[a][b][m][n] = (f32x4){0.f, 0.f, 0.f, 0.f};
        cur = nxt; cA = nA; cB = nB; ++ui;
        if constexpr (ALIGN_EPI) { if (wr == 1) PG8_BAR; }
    }
    PG8_WAIT_V(0);
    if constexpr (!ALIGN_EPI) { if (wr == 0) PG8_BAR; }
    PG8_BAR;
    if constexpr (Epi::AFTER_DRAIN) { E.fused(acc, cur, wr, wc, fr, fq, lds, wid, lane); S.done(cur); }
#undef PG8_SA
#undef PG8_SB
#undef PG8_STAGE
#undef PG8_LDA
#undef PG8_LDB
#undef PG8_MMA
#undef PG8_WAIT_V
#undef PG8_WAIT_L
#undef PG8_BAR
#undef PG8_SCHED
}
}
#define XB_TMO      128
#define XB_XCNT(j)  (256  + 64 * (j))
#define XB_XSUB(j)  (1280 + 64 * (j))
#define XB_XGEN(j)  (2304 + 64 * (j))
#define XB_TOP      3328
#define XB_TOPGEN   3392
#define XCD_BAR_WORDS 3456
#define XB_SPIN_CAP (1u << 18)

__device__ __forceinline__ unsigned xb_ld(unsigned* p)              { return __hip_atomic_load(p, __ATOMIC_RELAXED, __HIP_MEMORY_SCOPE_AGENT); }
__device__ __forceinline__ unsigned xb_add(unsigned* p, unsigned v) { return __hip_atomic_fetch_add(p, v, __ATOMIC_RELAXED, __HIP_MEMORY_SCOPE_AGENT); }
__device__ __forceinline__ unsigned xb_xcc_id() { return (unsigned)__builtin_amdgcn_s_getreg((3 << 11) | 20) & 0xFu; }
#define XB_SPIN(cond, bar) do { unsigned _sp = 0; while (cond) { __builtin_amdgcn_s_sleep(1); \
    if ((++_sp & 255u) == 0u) { if (xb_ld(&(bar)[XB_TMO])) break; if (_sp > XB_SPIN_CAP) { atomicAdd(&(bar)[XB_TMO], 1u); break; } } } } while (0)

struct XcdBarrier {
    unsigned* bar; unsigned x;
    volatile LAS unsigned* st;
    int w;
};

__device__ __forceinline__ bool xb_leader(int w) { unsigned l; asm volatile("v_mbcnt_lo_u32_b32 %0, -1, 0\n\tv_mbcnt_hi_u32_b32 %0, -1, %0" : "=v"(l)); return w == 0 && l == 0u; }
__device__ __forceinline__ XcdBarrier xcd_barrier_post(unsigned* bar, volatile LAS unsigned* st, int wave) {
    XcdBarrier b; b.bar = bar; b.x = xb_xcc_id(); b.st = st; b.w = wave;
    if (xb_leader(wave)) (void)xb_add(&bar[XB_XCNT(b.x)], 1u);
    return b;
}
__device__ __forceinline__ void xcd_barrier_complete(unsigned* bar, unsigned x, unsigned& nloc, unsigned& nx) {
    const unsigned G = gridDim.x * gridDim.y * gridDim.z;
    unsigned sum, cnt, mine, sp = 0u;
    for (;;) {
        sum = 0u; cnt = 0u; mine = 0u;
#pragma unroll
        for (unsigned j = 0; j < 16; ++j) { const unsigned c = xb_ld(&bar[XB_XCNT(j)]); sum += c; cnt += (c > 0u) ? 1u : 0u; mine = (j == x) ? c : mine; }
        if (sum == G) break;
        __builtin_amdgcn_s_sleep(1);
        if ((++sp & 255u) == 0u) { if (xb_ld(&bar[XB_TMO])) break; if (sp > XB_SPIN_CAP) { atomicAdd(&bar[XB_TMO], 1u); break; } }
    }
    nloc = mine > 0u ? mine : 1u; nx = cnt > 0u ? cnt : 1u;
}

__device__ __forceinline__ void xcd_barrier(const XcdBarrier& b) {
    asm volatile("s_waitcnt vmcnt(0)" ::: "memory");
    __syncthreads();
    if (xb_leader(b.w)) {
        unsigned* bar = b.bar;
        __builtin_amdgcn_s_waitcnt(0);
        unsigned nloc = b.st[0], nx = b.st[1];
        if (nloc == 0u) { xcd_barrier_complete(bar, b.x, nloc, nx); b.st[0] = nloc; b.st[1] = nx; }
        const unsigned old = xb_add(&bar[XB_XSUB(b.x)], 1u);
        const unsigned gen = old / nloc;
        if (old + 1u == (gen + 1u) * nloc) {
            __builtin_amdgcn_fence(__ATOMIC_RELEASE, "agent");
            asm volatile("s_waitcnt vmcnt(0)" ::: "memory");
            const unsigned og = xb_add(&bar[XB_TOP], 1u);
            const unsigned tg = og / nx;
            if (og + 1u == (tg + 1u) * nx) xb_add(&bar[XB_TOPGEN], 1u);
            else XB_SPIN(xb_ld(&bar[XB_TOPGEN]) == tg, bar);
            __builtin_amdgcn_fence(__ATOMIC_ACQUIRE, "agent");
            xb_add(&bar[XB_XGEN(b.x)], 1u);
            asm volatile("s_waitcnt vmcnt(0)" ::: "memory");
        } else {
            XB_SPIN(xb_ld(&bar[XB_XGEN(b.x)]) == gen, bar);
            __builtin_amdgcn_fence(__ATOMIC_ACQUIRE, "agent");
            asm volatile("s_waitcnt vmcnt(0)" ::: "memory");
        }
    }
    __syncthreads();
}
namespace da {
constexpr int SLOT_K = 8192, SLOT_V = 16384;
constexpr int LDS_K = 0, LDS_V = 3 * SLOT_K;
constexpr int LDS_BIAS = LDS_V + 3 * SLOT_V;
constexpr int LDS_END = LDS_BIAS + BIAS_TAB * 4;
static_assert(LDS_END <= RING_BYTES, "attention LDS map");
constexpr float THR = 8.f;
__device__ __forceinline__ int crow(int r, int hi) { return (r & 3) + 8 * (r >> 2) + 4 * hi; }
__device__ __forceinline__ void glds16(const void* gbase  , unsigned voff  , unsigned lds_dst) { unsigned keep;
    asm volatile("s_mov_b32 %0, m0\n\ts_mov_b32 m0, %3\n\ts_nop 0\n\tglobal_load_lds_dwordx4 %1, %2\n\ts_mov_b32 m0, %0" : "=&s"(keep) : "v"(voff), "s"(gbase), "s"(lds_dst) : "memory"); }
typedef short v4i16_t __attribute__((ext_vector_type(4)));
__device__ __forceinline__ s16x4 vtr(const LAS char* p) { return __builtin_bit_cast(s16x4, __builtin_amdgcn_ds_read_tr16_b64_v4i16((LAS v4i16_t*)p)); }

struct Tensors { const bf16* Qd; const bf16* Kd; const bf16* Vd; float* stash; bf16* ya; const float* dlam; const float* subg; const float* relb; };

#define DA_SBAR() __builtin_amdgcn_sched_barrier(0)
#define DA_PIN(x) asm volatile("" : "+v"(x))
#define DA_MFMA(a, b, c) __builtin_amdgcn_mfma_f32_32x32x16_bf16(a, b, c, 0, 0, 0)
#define DA_MX3(a, b, c) __builtin_fmaxf(__builtin_fmaxf((a), (b)), (c))
__device__ __forceinline__ float rowmax(const f32x16& p0, const f32x16& p1) {
    float a = DA_MX3(p0[0], p0[1], p1[0]), b = DA_MX3(p0[2], p0[3], p1[1]); a = DA_MX3(a, p1[2], p1[3]);
#pragma unroll
    for (int r = 4; r < 16; r += 4) { a = DA_MX3(a, p0[r], p0[r + 1]); b = DA_MX3(b, p0[r + 2], p0[r + 3]); a = DA_MX3(a, p1[r], p1[r + 1]); b = DA_MX3(b, p1[r + 2], p1[r + 3]); }
    float mx = __builtin_fmaxf(a, b); auto rr = __builtin_amdgcn_permlane32_swap(__float_as_uint(mx), __float_as_uint(mx), false, false);
    return __builtin_fmaxf(__uint_as_float(rr[0]), __uint_as_float(rr[1])); }

#define DA_TABINIT(N0, N1, T_) do { int base_ = qabs - 64 * (T_) - 4 * hi + BIAS_GUARD; asm volatile("" : "+v"(base_)); \
        _Pragma("unroll") for (int r = 0; r < 16; ++r) { const int o_ = (r & 3) + 8 * (r >> 2); N0[r] = tb[base_ - o_] - m; N1[r] = tb[base_ - o_ - 32] - m; } } while (0)
#define DA_MASK(C0, C1, T_) do { int base_ = qabs - 64 * (T_) - 4 * hi + BIAS_GUARD; asm volatile("" : "+v"(base_)); \
        _Pragma("unroll") for (int r = 0; r < 16; ++r) { const int o_ = (r & 3) + 8 * (r >> 2); if (base_ - o_ < BIAS_GUARD) C0[r] = -1e30f; if (base_ - o_ - 32 < BIAS_GUARD) C1[r] = -1e30f; } } while (0)
#define DA_FAR(T_) ((q0 - 64 * (T_) - 63) >= DFAR)
#define DA_PKW(P, i) cvtpk(P[i], P[(i) + 1])
#define DA_PAF(k) __builtin_bit_cast(bf16x8, pw[k])
#define DA_VOFF(g) ((2 * ((g) >> 3) + ((g) & 1)) * 4096 + (((g) >> 1) & 3) * 1024)
#define DA_VRD(g) do { vl[(g) % 5] = vtr(vp_ + DA_VOFF(g)); vh[(g) % 5] = vtr(vp_ + DA_VOFF(g) + 512); } while (0)
#define DA_VFR(g) (bf16x8){vl[(g) % 5][0], vl[(g) % 5][1], vl[(g) % 5][2], vl[(g) % 5][3], vh[(g) % 5][0], vh[(g) % 5][1], vh[(g) % 5][2], vh[(g) % 5][3]}
#define DA_KRD(G, j) do { if (G) kf[j] = *(const LAS bf16x8*)(kp_ + ((j) >> 1) * 2048 + ((j) & 1) * 512); } while (0)
#define DA_GAPA(MF, a0, a1, a2, a3, W0, W1, PW) do { MF; sacc += a0; sacc += a1; sacc += a2; sacc += a3; W0; W1; DA_PIN(PW); DA_PIN(sacc); DA_SBAR(); } while (0)
#define DA_GAPB(g, X, i) do { o[2 * ((g) >> 3) + ((g) & 1)] = DA_MFMA(DA_VFR(g), DA_PAF(((g) >> 1) & 3), o[2 * ((g) >> 3) + ((g) & 1)]); \
        X[i] = __builtin_amdgcn_exp2f(X[i]); X[(i) + 1] = __builtin_amdgcn_exp2f(X[(i) + 1]); DA_PIN(X); DA_SBAR(); } while (0)
#define DA_STEP(C0, C1, P0, P1, T_, MASK, GK, GV, GL, FARV, NEARN) do { DA_SBAR(); const int t_ = (T_); \
    const LAS char* vp_ = vp0 + sl_prev * SLOT_V; const LAS char* kp_ = kp0 + sl_next * SLOT_K; \
    float sacc = P0[0] + P0[1]; \
                       DA_GAPA(C0 = DA_MFMA(kf[0], qr[0], FARV ? cinit : C0), P0[2], P0[3], P0[4], P0[5],     pw[0][0] = DA_PKW(P0, 0),  pw[0][1] = DA_PKW(P0, 2),  pw[0]); \
                       DA_GAPA(C1 = DA_MFMA(kf[1], qr[0], FARV ? cinit : C1), P0[6], P0[7], P0[8], P0[9],     pw[0][2] = DA_PKW(P0, 4),  pw[0][3] = DA_PKW(P0, 6),  pw[0]); \
                       DA_GAPA(C0 = DA_MFMA(kf[2], qr[1], C0),               P0[10], P0[11], P0[12], P0[13], pw[1][0] = DA_PKW(P0, 8),  pw[1][1] = DA_PKW(P0, 10), pw[1]); \
                       DA_GAPA(C1 = DA_MFMA(kf[3], qr[1], C1),               P0[14], P0[15], P1[0], P1[1],   pw[1][2] = DA_PKW(P0, 12), pw[1][3] = DA_PKW(P0, 14), pw[1]); \
    DA_VRD(0); DA_SBAR(); DA_GAPA(C0 = DA_MFMA(kf[4], qr[2], C0),               P1[2], P1[3], P1[4], P1[5],     pw[2][0] = DA_PKW(P1, 0),  pw[2][1] = DA_PKW(P1, 2),  pw[2]); \
    DA_VRD(1); DA_SBAR(); DA_GAPA(C1 = DA_MFMA(kf[5], qr[2], C1),               P1[6], P1[7], P1[8], P1[9],     pw[2][2] = DA_PKW(P1, 4),  pw[2][3] = DA_PKW(P1, 6),  pw[2]); \
    DA_VRD(2); DA_SBAR(); DA_GAPA(C0 = DA_MFMA(kf[6], qr[3], C0),               P1[10], P1[11], P1[12], P1[13], pw[3][0] = DA_PKW(P1, 8),  pw[3][1] = DA_PKW(P1, 10), pw[3]); \
    DA_VRD(3); DA_SBAR(); DA_GAPA(C1 = DA_MFMA(kf[7], qr[3], C1),               P1[14], P1[15], 0.f, 0.f,       pw[3][2] = DA_PKW(P1, 12), pw[3][3] = DA_PKW(P1, 14), pw[3]); \
    l += sacc; \
    if (GK) DA_DMA_K(t_ + 3, sl_cur); if (GV) DA_DMA_V(t_ + 1, sl_next);                         \
    if (MASK) { if (t_ >= NT - 4) DA_MASK(C0, C1, t_); } \
    { const float rm_ = rowmax(C0, C1); resc = false; \
      if (__builtin_expect(__any(rm_ > THR), 0)) { const float dl_ = __builtin_fmaxf(rm_, 0.f); m += dl_; fsc = __builtin_amdgcn_exp2f(-dl_); l *= fsc; resc = true; \
          _Pragma("unroll") for (int r = 0; r < 16; ++r) { C0[r] -= dl_; C1[r] -= dl_; } \
          if (FARV) { _Pragma("unroll") for (int r = 0; r < 16; ++r) cinit[r] -= dl_; } } }                \
    DA_SBAR(); \
    DA_VRD(4);                  DA_SBAR(); DA_GAPB(0, C0, 0); \
    DA_VRD(5);                  DA_SBAR(); DA_GAPB(1, C0, 2); \
    DA_VRD(6);                  DA_SBAR(); DA_GAPB(2, C0, 4); \
    DA_VRD(7);                  DA_SBAR(); DA_GAPB(3, C0, 6); \
    DA_VRD(8);                  DA_SBAR(); DA_GAPB(4, C0, 8); \
    DA_VRD(9);                  DA_SBAR(); DA_GAPB(5, C0, 10); \
    DA_VRD(10); DA_KRD(GL, 0);  DA_SBAR(); DA_GAPB(6, C0, 12); \
    DA_VRD(11); DA_KRD(GL, 1);  DA_SBAR(); DA_GAPB(7, C0, 14); \
    DA_VRD(12); DA_KRD(GL, 2);  DA_SBAR(); DA_GAPB(8, C1, 0); \
    DA_VRD(13); DA_KRD(GL, 3);  DA_SBAR(); DA_GAPB(9, C1, 2); \
    DA_VRD(14); DA_KRD(GL, 4);  DA_SBAR(); DA_GAPB(10, C1, 4); \
    DA_VRD(15); DA_KRD(GL, 5);  DA_SBAR(); DA_GAPB(11, C1, 6); \
                DA_KRD(GL, 6);  DA_SBAR(); DA_GAPB(12, C1, 8); \
                DA_KRD(GL, 7);  DA_SBAR(); DA_GAPB(13, C1, 10); \
                                           DA_GAPB(14, C1, 12); \
                                           DA_GAPB(15, C1, 14); \
    if (NEARN) DA_TABINIT(P0, P1, t_ + 1); \
    } while (0)
#define DA_RESC() do { if (resc) { _Pragma("unroll") for (int d0 = 0; d0 < 4; ++d0) _Pragma("unroll") for (int r = 0; r < 16; ++r) o[d0][r] *= fsc; } } while (0)
#define DA_WAITB(N) asm volatile("s_waitcnt vmcnt(" #N ") lgkmcnt(0)\n\ts_barrier" ::: "memory")
#define DA_ROT() do { sl_prev = sl_cur; sl_cur = sl_next; sl_next = (sl_next == 2) ? 0 : sl_next + 1; } while (0)
#define DA_ENDW(tt) do { if ((tt) + 3 < NT) { DA_WAITB(3); } else if ((tt) + 2 < NT) { DA_WAITB(2); } else { DA_WAITB(0); } } while (0)

__device__ __forceinline__ void unit(const Tensors& X, int b, int h, int qb, LAS unsigned char* lds, int wgslot, float lam, float c31, const int wid  ) {
    const int q0 = qb * 256, NT = 4 * (qb + 1);
    const unsigned lds0 = (unsigned)(uintptr_t)lds;
    const LAS float* tb = (const LAS float*)(lds + LDS_BIAS);
    for (int c = 0; c < 2; ++c) {
        int lane = (int)__builtin_amdgcn_mbcnt_hi(~0u, __builtin_amdgcn_mbcnt_lo(~0u, 0u)); asm volatile("" : "+v"(lane));
        const int r32 = lane & 31, hi = lane >> 5;
        const unsigned lane16 = (unsigned)lane * 16u;
        const int qabs = q0 + wid * 32 + r32;
        const LAS char* vp0 = (const LAS char*)lds + LDS_V + ((lane >> 4) & 1) * 32 + (lane & 3) * 8 + (4 * hi + ((lane & 15) >> 2)) * 64;
        const LAS char* kp0 = (const LAS char*)lds + LDS_K + hi * 1024 + r32 * 16;
        const int bhc = (b * 4 + h) * 2 + c;
        const bf16* Qw = X.Qd + ((size_t)bhc * SEQ + q0 + wid * 32 + r32) * 64 + hi * 8;
        const char* Kt = (const char*)X.Kd + (size_t)bhc * NTILE * SLOT_K + wid * 1024;
        const char* Vt = (const char*)X.Vd + (size_t)(b * 4 + h) * NTILE * SLOT_V + wid * 1024;
#define DA_DMA_K(t, slot) glds16(Kt + (size_t)(t) * SLOT_K, lane16, (unsigned)__builtin_amdgcn_readfirstlane(lds0 + LDS_K + (slot) * SLOT_K + wid * 1024))
#define DA_DMA_V(t, slot) do { const unsigned sb_ = (unsigned)__builtin_amdgcn_readfirstlane(lds0 + LDS_V + (slot) * SLOT_V + wid * 1024); \
        glds16(Vt + (size_t)(t) * SLOT_V, lane16, sb_); glds16(Vt + (size_t)(t) * SLOT_V + 8192, lane16, sb_ + 8192); } while (0)
        DA_DMA_K(0, 0); DA_DMA_V(0, 0); DA_DMA_K(1, 1); DA_DMA_K(2, 2);
        bf16x8 qr[4];
#pragma unroll
        for (int d0 = 0; d0 < 4; ++d0) qr[d0] = *(const bf16x8*)(Qw + d0 * 16);
        f32x16 o[4];
#pragma unroll
        for (int d0 = 0; d0 < 4; ++d0)
#pragma unroll
            for (int r = 0; r < 16; ++r) o[d0][r] = 0.f;
        float m = 0.f, l = 0.f, fsc = 1.f; bool resc = false;
        f32x16 pA0, pA1, pB0, pB1, cinit; bf16x8 kf[8]; s16x4 vl[5], vh[5]; v4u pw[4];
        int sl_prev = 0, sl_cur = 1, sl_next = 2;
        asm volatile("" :: "v"(qr[0]), "v"(qr[1]), "v"(qr[2]), "v"(qr[3]));
        DA_WAITB(4);
        {   const LAS char* kp_ = kp0;
#pragma unroll
            for (int j = 0; j < 8; ++j) DA_KRD(true, j);
            if (DA_FAR(0)) {
#pragma unroll
                for (int r = 0; r < 16; ++r) { pA0[r] = c31; pA1[r] = c31; }
            } else DA_TABINIT(pA0, pA1, 0);
#pragma unroll
            for (int d0 = 0; d0 < 4; ++d0) { pA0 = DA_MFMA(kf[2 * d0], qr[d0], pA0); pA1 = DA_MFMA(kf[2 * d0 + 1], qr[d0], pA1); }
            if (NT == 4) DA_MASK(pA0, pA1, 0);
            m = rowmax(pA0, pA1);
#pragma unroll
            for (int r = 0; r < 16; ++r) { pA0[r] = __builtin_amdgcn_exp2f(pA0[r] - m); pA1[r] = __builtin_amdgcn_exp2f(pA1[r] - m); }
        }
        DA_WAITB(0);
        DA_DMA_K(3, 0); DA_DMA_V(1, 1);
        {   const LAS char* kp_ = kp0 + SLOT_K;
#pragma unroll
            for (int j = 0; j < 8; ++j) DA_KRD(true, j);
        }
        DA_WAITB(3);
        {   const float cm = c31 - m;
#pragma unroll
            for (int r = 0; r < 16; ++r) cinit[r] = cm; }
        int t = 1;
        for (; t + 5 < NT && DA_FAR(t + 1); t += 2) {
            DA_STEP(pB0, pB1, pA0, pA1, t, false, true, true, true, true, false);     DA_WAITB(3); DA_RESC(); DA_ROT();
            DA_STEP(pA0, pA1, pB0, pB1, t + 1, false, true, true, true, true, false); DA_WAITB(3); DA_RESC(); DA_ROT();
        }
        DA_TABINIT(pB0, pB1, t);
        for (; t + 5 < NT; t += 2) {
            DA_STEP(pB0, pB1, pA0, pA1, t, false, true, true, true, false, true);     DA_WAITB(3); DA_RESC(); DA_ROT();
            DA_STEP(pA0, pA1, pB0, pB1, t + 1, false, true, true, true, false, true); DA_WAITB(3); DA_RESC(); DA_ROT();
        }
        for (; t + 1 < NT; t += 2) {
            DA_STEP(pB0, pB1, pA0, pA1, t, true, (t + 3 < NT), (t + 1 < NT), (t + 1 < NT), false, true);         DA_ENDW(t);     DA_RESC(); DA_ROT();
            DA_STEP(pA0, pA1, pB0, pB1, t + 1, true, (t + 4 < NT), (t + 2 < NT), (t + 2 < NT), false, true);     DA_ENDW(t + 1); DA_RESC(); DA_ROT();
        }
        DA_STEP(pB0, pB1, pA0, pA1, NT - 1, true, false, false, false, false, false); DA_RESC();
        {   float sacc = pB0[0] + pB0[1];
#pragma unroll
            for (int r = 2; r < 16; ++r) sacc += pB0[r];
#pragma unroll
            for (int r = 0; r < 16; ++r) sacc += pB1[r];
            l += sacc;
            pw[0] = (v4u){DA_PKW(pB0, 0), DA_PKW(pB0, 2), DA_PKW(pB0, 4), DA_PKW(pB0, 6)}; pw[1] = (v4u){DA_PKW(pB0, 8), DA_PKW(pB0, 10), DA_PKW(pB0, 12), DA_PKW(pB0, 14)};
            pw[2] = (v4u){DA_PKW(pB1, 0), DA_PKW(pB1, 2), DA_PKW(pB1, 4), DA_PKW(pB1, 6)}; pw[3] = (v4u){DA_PKW(pB1, 8), DA_PKW(pB1, 10), DA_PKW(pB1, 12), DA_PKW(pB1, 14)};
            const LAS char* vb_ = vp0 + sl_cur * SLOT_V;
#pragma unroll
            for (int d0 = 0; d0 < 4; ++d0) {
#pragma unroll
                for (int ks = 0; ks < 4; ++ks) { const s16x4 lo_ = vtr(vb_ + d0 * 4096 + ks * 1024), hh_ = vtr(vb_ + d0 * 4096 + ks * 1024 + 512);
                    const bf16x8 vf_ = (bf16x8){lo_[0], lo_[1], lo_[2], lo_[3], hh_[0], hh_[1], hh_[2], hh_[3]};
                    o[d0] = DA_MFMA(vf_, DA_PAF(ks), o[d0]); }
                DA_SBAR(); }
        }
#undef DA_DMA_K
#undef DA_DMA_V
        { auto rr = __builtin_amdgcn_permlane32_swap(__float_as_uint(l), __float_as_uint(l), false, false); l = __uint_as_float(rr[0]) + __uint_as_float(rr[1]); }
        const float inv = 1.f / l;
        int lane_e = lane; asm volatile("" : "+v"(lane_e));
        GAS unsigned* stg = (GAS unsigned*)((unsigned*)X.stash + ((size_t)(wgslot * 8 + wid) * 32) * 64 + lane_e);
        if (c == 0) {
#pragma unroll
            for (int d0 = 0; d0 < 4; ++d0)
#pragma unroll
                for (int r = 0; r < 16; r += 2) stg[(d0 * 8 + (r >> 1)) * 64] = cvtpk(o[d0][r] * inv, o[d0][r + 1] * inv);
        } else {
            float ss = 0.f;
#pragma unroll
            for (int d0 = 0; d0 < 4; ++d0)
#pragma unroll
                for (int r = 0; r < 16; r += 2) { const unsigned w1 = stg[(d0 * 8 + (r >> 1)) * 64]; const float dv0 = bf_lo(w1) - lam * (o[d0][r] * inv), dv1 = bf_hi(w1) - lam * (o[d0][r + 1] * inv);
                    o[d0][r] = dv0; o[d0][r + 1] = dv1; ss += dv0 * dv0 + dv1 * dv1; if (r == 14) asm volatile("" ::: "memory"); }
            { auto rr = __builtin_amdgcn_permlane32_swap(__float_as_uint(ss), __float_as_uint(ss), false, false); ss = __uint_as_float(rr[0]) + __uint_as_float(rr[1]); }
            const float rn = __builtin_amdgcn_rsqf(ss * (1.f / 128.f) + SUBLN_EPS) * (1.f - LAM_INIT);
            const int hi_e = lane_e >> 5, qabs_e = q0 + wid * 32 + (lane_e & 31);
            bf16* yrow = X.ya + ((size_t)b * SEQ + qabs_e) * 512 + h * 128 + 4 * hi_e; const float* sg = X.subg + 4 * hi_e;
#pragma unroll
            for (int d0 = 0; d0 < 4; ++d0)
#pragma unroll
                for (int r4 = 0; r4 < 4; ++r4) {
                    const int dd = 32 * d0 + 8 * r4; const f32x4 g = *(const f32x4*)(sg + dd);
                    v2u w; w.x = pk2(o[d0][4 * r4] * rn * g[0], o[d0][4 * r4 + 1] * rn * g[1]); w.y = pk2(o[d0][4 * r4 + 2] * rn * g[2], o[d0][4 * r4 + 3] * rn * g[3]);
                    *(v2u*)(yrow + dd) = w;
                }
        }
        asm volatile("s_waitcnt vmcnt(0) lgkmcnt(0)\n\ts_barrier" ::: "memory");
    }
}
#undef DA_STEP
#undef DA_GAPA
#undef DA_GAPB
#undef DA_KRD
#undef DA_VRD
#undef DA_VFR
#undef DA_VOFF
#undef DA_PAF
#undef DA_PKW
#undef DA_FAR
#undef DA_MASK
#undef DA_TABINIT
#undef DA_RESC
#undef DA_WAITB
#undef DA_ROT
#undef DA_ENDW
#undef DA_MX3
#undef DA_MFMA
#undef DA_PIN
#undef DA_SBAR
}
namespace dil {
constexpr int BT = 1152, BT0 = 512;
constexpr int LDS_VST = 0, LDS_BL = 32768, LDS_END = LDS_BL + 3 * BT * 4;
constexpr float THR = 8.f;
struct Tensors { const bf16* LQ; const bf16* LK; const bf16* LV; bf16* yb; };
typedef short v4i16_t __attribute__((ext_vector_type(4)));
__device__ __forceinline__ s16x4 vtr(const LAS unsigned char* p) { return __builtin_bit_cast(s16x4, __builtin_amdgcn_ds_read_tr16_b64_v4i16((LAS v4i16_t*)p)); }

template <int G_, int QS_> __device__ __forceinline__ void group(const Tensors& X, size_t rowb, int h, int P0, int r, LAS unsigned char* vst, const LAS float* blg, int lane, f32x16 (&o)[2], float& m, float& l) {
    constexpr int DL = (G_ == 0) ? 1 : (G_ == 1) ? 4 : 16, MG = QS_ / DL, NKB = (31 * MG + 128) / 32 + 1;
    static_assert(QS_ % DL == 0, "query stride must be a multiple of the dilation");
    const int i = lane & 31, hi = lane >> 5;
    const int colb = G_ * 256 + h * 64;
    bf16x8 qr[4];
    { const bf16* qp = X.LQ + (rowb + P0 + r + QS_ * i) * 768 + colb + hi * 8;
#pragma unroll
      for (int d0 = 0; d0 < 4; ++d0) qr[d0] = *(const bf16x8*)(qp + 16 * d0); }
    const int kpos0 = P0 + r - 128 * DL;
    const LAS unsigned char* vrd = vst + ((lane >> 4) & 1) * 32 + (lane & 3) * 8 + (4 * hi + ((lane & 15) >> 2)) * 64;
#define DIL_LOAD(KF, VR, KB) do { \
        { int kpos_ = kpos0 + (32 * (KB) + i) * DL; kpos_ = kpos_ < 0 ? 0 : (kpos_ > SEQ - 1 ? SEQ - 1 : kpos_); const bf16* kp_ = X.LK + (rowb + kpos_) * 768 + colb + hi * 8; \
          _Pragma("unroll") for (int d0 = 0; d0 < 4; ++d0) KF[d0] = *(const bf16x8*)(kp_ + 16 * d0); } \
        _Pragma("unroll") for (int t = 0; t < 4; ++t) { const int qd = lane + 64 * t, key = qd >> 3, ch = qd & 7; int vpos_ = kpos0 + (32 * (KB) + key) * DL; vpos_ = vpos_ < 0 ? 0 : (vpos_ > SEQ - 1 ? SEQ - 1 : vpos_); \
            VR[t] = *(const v4u*)(X.LV + (rowb + vpos_) * 768 + colb + ch * 8); } } while (0)
    bf16x8 kfn[4]; v4u vregn[4];
    DIL_LOAD(kfn, vregn, 0);
#pragma unroll 1
    for (int kb = 0; kb < NKB; ++kb) {
        bf16x8 kf[4]; v4u vreg[4];
#pragma unroll
        for (int d0 = 0; d0 < 4; ++d0) { kf[d0] = kfn[d0]; vreg[d0] = vregn[d0]; }
        if (kb + 1 < NKB) DIL_LOAD(kfn, vregn, kb + 1);
        const int jb = i * MG + 128 - 32 * kb - 4 * hi;
        f32x16 p;
#pragma unroll
        for (int rr = 0; rr < 16; ++rr) p[rr] = blg[jb - ((rr & 3) + 8 * (rr >> 2)) + BT0];
#pragma unroll
        for (int d0 = 0; d0 < 4; ++d0) p = __builtin_amdgcn_mfma_f32_32x32x16_bf16(kf[d0], qr[d0], p, 0, 0, 0);
        const int cb = 32 * kb + 4 * hi;
#pragma unroll
        for (int rr = 0; rr < 16; ++rr) { const int o_ = (rr & 3) + 8 * (rr >> 2); if ((unsigned)(jb - o_) > 128u || kpos0 + (cb + o_) * DL < 0) p[rr] = -3e38f; }
        float rm = p[0];
#pragma unroll
        for (int rr = 1; rr < 16; ++rr) rm = fmaxf(rm, p[rr]);
        { auto sw = __builtin_amdgcn_permlane32_swap(__float_as_uint(rm), __float_as_uint(rm), false, false); rm = fmaxf(__uint_as_float(sw[0]), __uint_as_float(sw[1])); }
        if (__any(rm > m + THR)) {
            const float mn = fmaxf(m, rm), f = __builtin_amdgcn_exp2f(m - mn);
#pragma unroll
            for (int d0 = 0; d0 < 2; ++d0)
#pragma unroll
                for (int rr = 0; rr < 16; ++rr) o[d0][rr] *= f;
            l *= f; m = mn;
        }
        float ls = 0.f;
#pragma unroll
        for (int rr = 0; rr < 16; ++rr) { p[rr] = __builtin_amdgcn_exp2f(p[rr] - m); ls += p[rr]; }
        l += ls;
        bf16x8 pw[2];
        { v4u w;
          w.x = cvtpk(p[0], p[1]); w.y = cvtpk(p[2], p[3]); w.z = cvtpk(p[4], p[5]); w.w = cvtpk(p[6], p[7]); pw[0] = __builtin_bit_cast(bf16x8, w);
          w.x = cvtpk(p[8], p[9]); w.y = cvtpk(p[10], p[11]); w.z = cvtpk(p[12], p[13]); w.w = cvtpk(p[14], p[15]); pw[1] = __builtin_bit_cast(bf16x8, w); }
#pragma unroll
        for (int t = 0; t < 4; ++t) { const int qd = lane + 64 * t, key = qd >> 3, ch = qd & 7;
            *(LAS v4u*)(vst + ((ch >> 2) * 2 + (key >> 4)) * 1024 + (key & 15) * 64 + (ch & 3) * 16) = vreg[t]; }
        asm volatile("s_waitcnt lgkmcnt(0)" ::: "memory");
#pragma unroll
        for (int d0 = 0; d0 < 2; ++d0)
#pragma unroll
            for (int ks = 0; ks < 2; ++ks) {
                const s16x4 lo = vtr(vrd + (d0 * 2 + ks) * 1024), hh = vtr(vrd + (d0 * 2 + ks) * 1024 + 512);
                const bf16x8 vf = (bf16x8){lo[0], lo[1], lo[2], lo[3], hh[0], hh[1], hh[2], hh[3]};
                o[d0] = __builtin_amdgcn_mfma_f32_32x32x16_bf16(vf, pw[ks], o[d0], 0, 0, 0);
            }
        asm volatile("s_waitcnt lgkmcnt(0)" ::: "memory");
    }
#undef DIL_LOAD
}
__device__ __forceinline__ void wave_tile_g0(const Tensors& X, float* lse0, int b, int h, int P0, LAS unsigned char* vst, const LAS float* bl, int lane) {
    const size_t rowb = (size_t)b * SEQ;
    f32x16 o[2];
#pragma unroll
    for (int d0 = 0; d0 < 2; ++d0)
#pragma unroll
        for (int rr = 0; rr < 16; ++rr) o[d0][rr] = 0.f;
    float m = -1e30f, l = 0.f;
    group<0, 1>(X, rowb, h, P0, 0, vst, bl, lane, o, m, l);
    { auto sw = __builtin_amdgcn_permlane32_swap(__float_as_uint(l), __float_as_uint(l), false, false); l = __uint_as_float(sw[0]) + __uint_as_float(sw[1]); }
    const float inv = 1.f / l; const int i = lane & 31, hi = lane >> 5;
    bf16* yrow = X.yb + (rowb + P0 + i) * 256 + h * 64 + 4 * hi;
#pragma unroll
    for (int d0 = 0; d0 < 2; ++d0)
#pragma unroll
        for (int r4 = 0; r4 < 4; ++r4) { v2u w; w.x = pk2(o[d0][4 * r4] * inv, o[d0][4 * r4 + 1] * inv); w.y = pk2(o[d0][4 * r4 + 2] * inv, o[d0][4 * r4 + 3] * inv); *(v2u*)(yrow + 32 * d0 + 8 * r4) = w; }
    if (hi == 0) lse0[(rowb + P0 + i) * 4 + h] = m + __builtin_amdgcn_logf(l);
}
__device__ __forceinline__ void wave_tile(const Tensors& X, const float* lse0, int b, int h, int P0, int r, LAS unsigned char* vst, const LAS float* bl, int lane) {
    const size_t rowb = (size_t)b * SEQ;
    f32x16 o[2];
#pragma unroll
    for (int d0 = 0; d0 < 2; ++d0)
#pragma unroll
        for (int rr = 0; rr < 16; ++rr) o[d0][rr] = 0.f;
    float m = -1e30f, l = 0.f;
    group<1, 16>(X, rowb, h, P0, r, vst, bl + BT, lane, o, m, l);
    group<2, 16>(X, rowb, h, P0, r, vst, bl + 2 * BT, lane, o, m, l);
    { auto sw = __builtin_amdgcn_permlane32_swap(__float_as_uint(l), __float_as_uint(l), false, false); l = __uint_as_float(sw[0]) + __uint_as_float(sw[1]); }
    const int i = lane & 31, hi = lane >> 5;
    const float w0 = __builtin_amdgcn_exp2f(lse0[(rowb + P0 + r + 16 * i) * 4 + h] - m);
    const float inv = 1.f / (l + w0);
    bf16* yrow = X.yb + (rowb + P0 + r + 16 * i) * 256 + h * 64 + 4 * hi;
#pragma unroll
    for (int d0 = 0; d0 < 2; ++d0)
#pragma unroll
        for (int r4 = 0; r4 < 4; ++r4) { const v2u g0 = *(const v2u*)(yrow + 32 * d0 + 8 * r4);
            v2u w; w.x = pk2((o[d0][4 * r4] + w0 * bf_lo(g0.x)) * inv, (o[d0][4 * r4 + 1] + w0 * bf_hi(g0.x)) * inv); w.y = pk2((o[d0][4 * r4 + 2] + w0 * bf_lo(g0.y)) * inv, (o[d0][4 * r4 + 3] + w0 * bf_hi(g0.y)) * inv);
            *(v2u*)(yrow + 32 * d0 + 8 * r4) = w; }
}
}
__device__ __forceinline__ void p0_transpose_item(const float* W, int K, int N, bf16* WT, LAS float* scr, int item, int lane) {
    const int nblk = N / 32, kb = item / nblk, nb = item % nblk, k0 = 64 * kb, n0 = 32 * nb;
#pragma unroll 8
    for (int i = 0; i < 32; ++i) { const int kk = 2 * i + (lane >> 5); scr[kk * 33 + (lane & 31)] = W[(size_t)(k0 + kk) * N + n0 + (lane & 31)]; }
    LDS_WAIT(); asm volatile("" ::: "memory");
    const int c = lane & 7;
#pragma unroll
    for (int j = 0; j < 4; ++j) { const int n = (lane >> 3) + 8 * j; const LAS float* s = scr + (8 * c) * 33 + n;
        v4u o; o.x = pk2(s[0 * 33], s[1 * 33]); o.y = pk2(s[2 * 33], s[3 * 33]); o.z = pk2(s[4 * 33], s[5 * 33]); o.w = pk2(s[6 * 33], s[7 * 33]);
        *(v4u*)(WT + (size_t)(n0 + n) * K + k0 + 8 * c) = o; }
    LDS_WAIT(); asm volatile("" ::: "memory");
}
__device__ __forceinline__ void cast_bf16(const float* src, bf16* dst, size_t n8, size_t gtid, size_t gthreads) {
    for (size_t i = gtid; i < n8; i += gthreads) { const f32x4 a = *(const f32x4*)(src + i * 8), b = *(const f32x4*)(src + i * 8 + 4);
        v4u o; o.x = pk2(a[0], a[1]); o.y = pk2(a[2], a[3]); o.z = pk2(b[0], b[1]); o.w = pk2(b[2], b[3]); *(v4u*)(dst + i * 8) = o; }
}

struct Args { const float* in[16]; float* out; unsigned char* ws; int ph_lo, ph_hi; };
enum { I_X = 0, I_WIN, I_DLAM, I_SUBG, I_WBD, I_WBL, I_WO, I_LN1G, I_LN1B, I_PWQ, I_PKEYS, I_PU, I_PV, I_LN2G, I_LN2B, I_RELB };

__device__ __forceinline__ void p0_prologue(const Args& A, LAS unsigned char* lds, int vcu, int G, int wave, int lane) {
    unsigned char* ws = A.ws;
    const int gw = vcu * NWAVES + wave, NGW = G * NWAVES;
    const size_t gtid = (size_t)gw * 64 + lane, gthreads = (size_t)NGW * 64;
    LAS float* scr = (LAS float*)(lds + wave * 16384);
    constexpr int I_IN = (D / 64) * (INC / 32), I_BD = (512 / 64) * (D / 32), I_BL = (256 / 64) * (D / 32), I_O = (D / 64) * (D / 32);
    for (int it0 = gw; it0 < (I_IN + I_BD + I_BL + I_O) * NREP(32); it0 += NGW) {
        int r = it0 % (I_IN + I_BD + I_BL + I_O);
        if (r < I_IN) { p0_transpose_item(A.in[I_WIN], D, INC, (bf16*)(ws + WS_WIN), scr, r, lane); continue; } r -= I_IN;
        if (r < I_BD) { p0_transpose_item(A.in[I_WBD], 512, D, (bf16*)(ws + WS_WBD), scr, r, lane); continue; } r -= I_BD;
        if (r < I_BL) { p0_transpose_item(A.in[I_WBL], 256, D, (bf16*)(ws + WS_WBL), scr, r, lane); continue; } r -= I_BL;
        p0_transpose_item(A.in[I_WO], D, D, (bf16*)(ws + WS_WO), scr, r, lane);
    }
    for (int rep_ = 0; rep_ < NREP(31); ++rep_) cast_bf16(A.in[I_X], (bf16*)(ws + WS_A), (size_t)T * D / 8, gtid, gthreads);
    { const float* wq = A.in[I_PWQ]; const float* keys = A.in[I_PKEYS]; bf16* wp = (bf16*)(ws + WS_WP);
      for (int it0 = gw; it0 < 1024 * NREP(30); it0 += NGW) { const int it = it0 & 1023;
          const int hc = it >> 6, jb = (it >> 2) & 15, nq = it & 3, j = jb * 64 + lane;
          const f32x4* wr_ = (const f32x4*)(wq + (size_t)j * 2048 + hc * 128);
          f32x4 w[32];
#pragma unroll
          for (int d = 0; d < 32; ++d) w[d] = wr_[d];
#pragma unroll 1
          for (int n = nq * 32; n < nq * 32 + 32; ++n) {
              const f32x4* kr = (const f32x4*)(keys + (size_t)(hc * 128 + n) * 128);
              float a0 = 0.f, a1 = 0.f, a2 = 0.f, a3 = 0.f;
#pragma unroll
              for (int d = 0; d < 32; ++d) { const f32x4 k = kr[d]; a0 += w[d][0] * k[0]; a1 += w[d][1] * k[1]; a2 += w[d][2] * k[2]; a3 += w[d][3] * k[3]; }
              wp[(size_t)(hc * 128 + n) * 1024 + j] = (bf16)f2bf((a0 + a1) + (a2 + a3));
          }
      } }
    { const float* relb = A.in[I_RELB]; float* bd = (float*)(ws + WS_BIASD); float* bl = (float*)(ws + WS_BIASL);
      for (size_t i = gtid; i < 4 * BIAS_TAB; i += gthreads) { const int h = (int)(i / BIAS_TAB), dist = (int)(i % BIAS_TAB) - BIAS_GUARD; bd[i] = dist < 0 ? 0.f : relb[rel_bucket(dist) * 16 + h] * LOG2E; }
      for (size_t i = gtid; i < 12 * 132; i += gthreads) { const int gh = (int)(i / 132), j = (int)(i % 132), g = gh >> 2; const int dl = (g == 0) ? 1 : (g == 1) ? 4 : 16;
          bl[i] = relb[rel_bucket((j > 128 ? 128 : j) * dl) * 16 + 4 + gh] * LOG2E; } }
}

__device__ __forceinline__ void p5_ln1(const Args& A, int vcu, int G, int wave, int lane) {
    unsigned char* ws = A.ws;
    const int gw = vcu * NWAVES + wave, NGW = G * NWAVES;
    const float* R = (const float*)(ws + WS_R); bf16* x1b = (bf16*)(ws + WS_A);
    const float* gam = A.in[I_LN1G]; const float* bet = A.in[I_LN1B];
    f32x4 gv[4], bv[4];
#pragma unroll
    for (int j = 0; j < 4; ++j) { gv[j] = *(const f32x4*)(gam + 256 * j + 4 * lane); bv[j] = *(const f32x4*)(bet + 256 * j + 4 * lane); }
    f32x4 nx[4];
    if (gw < T) {
#pragma unroll
        for (int j = 0; j < 4; ++j) nx[j] = ((const f32x4*)(R + (size_t)gw * D) + lane)[64 * j]; }
#pragma unroll 1
    for (int mrow = gw; mrow < T; mrow += NGW) {
        f32x4 v[4]; float s = 0.f;
#pragma unroll
        for (int j = 0; j < 4; ++j) { v[j] = nx[j]; s += (v[j][0] + v[j][1]) + (v[j][2] + v[j][3]); }
        if (mrow + NGW < T) {
#pragma unroll
            for (int j = 0; j < 4; ++j) nx[j] = ((const f32x4*)(R + (size_t)(mrow + NGW) * D) + lane)[64 * j]; }
        const float mean = wave_sum(s) * (1.f / D); float s2 = 0.f;
#pragma unroll
        for (int j = 0; j < 4; ++j) { v[j] = v[j] - mean; s2 += (v[j][0] * v[j][0] + v[j][1] * v[j][1]) + (v[j][2] * v[j][2] + v[j][3] * v[j][3]); }
        const float rstd = __builtin_amdgcn_rsqf(wave_sum(s2) * (1.f / D) + LN_EPS);
        v2u* brow = (v2u*)(x1b + (size_t)mrow * D) + lane;
#pragma unroll
        for (int j = 0; j < 4; ++j) { const f32x4 y = v[j] * rstd * gv[j] + bv[j]; v2u w; w.x = pk2(y[0], y[1]); w.y = pk2(y[2], y[3]); brow[64 * j] = w; }
    }
}
namespace peer {
__device__ __forceinline__ int mono(float v) { const int b = __float_as_int(v); return b ^ ((b >> 31) & 0x7fffffff); }
__device__ __forceinline__ float unmono(int k) { return __int_as_float(k ^ ((k >> 31) & 0x7fffffff)); }
__device__ __forceinline__ int med3i(int a, int b, int c) { int r; asm("v_med3_i32 %0, %1, %2, %3" : "=v"(r) : "v"(a), "v"(b), "v"(c)); return r; }
#define PEER_INS16(a, x) do { _Pragma("unroll") for (int k_ = 15; k_ >= 1; --k_) a[k_] = med3i(a[k_ - 1], a[k_], (x)); a[0] = max(a[0], (x)); } while (0)
__device__ __forceinline__ unsigned byte_sel(const unsigned (&p)[4], int i) { const int w = i >> 2; const unsigned x = (w == 0) ? p[0] : (w == 1) ? p[1] : (w == 2) ? p[2] : p[3]; return (x >> ((i & 3) * 8)) & 0xffu; }
__device__ __forceinline__ float gelu_erf(float v) { return 0.5f * v * (1.f + erff(v * 0.7071067811865476f)); }

__device__ __forceinline__ void select(const float* ST, v2u* sel, int tok, int head) {
    int a0[16], a1[16];
#pragma unroll
    for (int k = 0; k < 16; ++k) { a0[k] = (int)0x80000000; a1[k] = (int)0x80000000; }
    const float* s0 = ST + (size_t)(head * 256) * T + tok; const float* s1 = s0 + (size_t)128 * T;
    float c0[8], c1[8];
#pragma unroll
    for (int i = 0; i < 8; ++i) { c0[i] = s0[(size_t)i * T]; c1[i] = s1[(size_t)i * T]; }
#pragma unroll 1
    for (int n = 0; n < 128; n += 8) {
        float x0[8], x1[8];
#pragma unroll
        for (int i = 0; i < 8; ++i) { x0[i] = c0[i]; x1[i] = c1[i]; }
        if (n + 8 < 128) {
#pragma unroll
            for (int i = 0; i < 8; ++i) { c0[i] = s0[(size_t)(n + 8 + i) * T]; c1[i] = s1[(size_t)(n + 8 + i) * T]; }
        }
#pragma unroll
        for (int i = 0; i < 8; ++i) { const int k0 = (mono(x0[i]) & ~127) | (127 - (n + i)), k1 = (mono(x1[i]) & ~127) | (127 - (n + i)); PEER_INS16(a0, k0); PEER_INS16(a1, k1); }
    }
    float v0[16], v1[16]; unsigned i0p[4] = {0u, 0u, 0u, 0u}, i1p[4] = {0u, 0u, 0u, 0u};
#pragma unroll
    for (int k = 0; k < 16; ++k) { v0[k] = unmono((a0[k] & ~127) | 64); v1[k] = unmono((a1[k] & ~127) | 64);
        i0p[k >> 2] |= (unsigned)(127 - (a0[k] & 127)) << (8 * (k & 3)); i1p[k >> 2] |= (unsigned)(127 - (a1[k] & 127)) << (8 * (k & 3)); }
    int cd[16];
#pragma unroll
    for (int k = 0; k < 16; ++k) cd[k] = (int)0x80000000;
#pragma unroll
    for (int i = 0; i < 16; ++i)
#pragma unroll
        for (int j = 0; j < 16; ++j)
            if ((i + 1) * (j + 1) <= 16) { const int k = (mono(v0[i] + v1[j]) & ~255) | (255 - (i * 16 + j)); PEER_INS16(cd, k); }
    float sv[16], ex[16], sum = 0.f; unsigned eid[16];
#pragma unroll
    for (int k = 0; k < 16; ++k) { const int code = 255 - (cd[k] & 255); eid[k] = byte_sel(i0p, code >> 4) * 128u + byte_sel(i1p, code & 15); sv[k] = unmono((cd[k] & ~255) | 128); }
#pragma unroll
    for (int k = 0; k < 16; ++k) { ex[k] = __expf(sv[k] - sv[0]); sum += ex[k]; }
    const float rs = 1.f / sum;
    v4u* dst = (v4u*)(sel + ((size_t)tok * 8 + head) * 16);
#pragma unroll
    for (int k = 0; k < 8; ++k) { v4u w; w.x = eid[2 * k]; w.y = __float_as_uint(ex[2 * k] * rs); w.z = eid[2 * k + 1]; w.w = __float_as_uint(ex[2 * k + 1] * rs); dst[k] = w; }
}

typedef float f32x2w __attribute__((ext_vector_type(2)));
struct G4 { const unsigned char* U8; const unsigned char* V8; const float* isu; const float* isv; };
__device__ __forceinline__ v2u peer_ec(const v2u lo, const v2u hi, int c) { const unsigned mk = (c < 4) ? 0xffffffffu : 0u; v2u r; r.x = (lo.x & mk) | (hi.x & ~mk); r.y = (lo.y & mk) | (hi.y & ~mk); return r; }
#define PEER_EC(en, c) peer_ec((en)[0], (en)[1], (c))
__device__ __forceinline__ void a_load(v4u (&uu)[16], const v2u ec, int c, const unsigned char* U8, int lane) {
#pragma unroll
    for (int j = 0; j < 16; ++j) { const unsigned e = __builtin_amdgcn_readlane(ec.x, 16 * (c & 3) + j); uu[j] = *(const v4u*)(U8 + (size_t)e * D + 16 * lane); }
}
__device__ __forceinline__ void a_step(const v4u (&uu)[16], v2u (&en)[2], int c, const LAS f32x4* xl, const G4& T, int lane) {
    const v2u ec = PEER_EC(en, c);
    const int ls = 16 * (c & 3) + (lane >> 2);
    const unsigned eq = (unsigned)__shfl((int)ec.x, ls); const float gq = __uint_as_float((unsigned)__shfl((int)ec.y, ls));
    const float su = T.isu[eq], sv = T.isv[eq];
    f32x4 xv[4];
#pragma unroll
    for (int q = 0; q < 4; ++q) xv[q] = xl[q * 64];
    float part[16];
#pragma unroll
    for (int j = 0; j < 16; ++j) { f32x2w d = {0.f, 0.f};
#pragma unroll
        for (int q = 0; q < 4; ++q) { const unsigned w = uu[j][q]; const f32x2w a = __builtin_amdgcn_cvt_pk_f32_fp8((int)w, false), b = __builtin_amdgcn_cvt_pk_f32_fp8((int)w, true);
            d += (f32x2w){xv[q][0], xv[q][1]} * a; d += (f32x2w){xv[q][2], xv[q][3]} * b; }
        part[j] = d[0] + d[1]; }
    float r8[8], r4[4], r2[2], r1;
#pragma unroll
    for (int i = 0; i < 8; ++i) { auto sw = __builtin_amdgcn_permlane32_swap(__float_as_uint(part[i]), __float_as_uint(part[i + 8]), false, false); r8[i] = __uint_as_float(sw[0]) + __uint_as_float(sw[1]); }
#pragma unroll
    for (int i = 0; i < 4; ++i) { auto sw = __builtin_amdgcn_permlane16_swap(__float_as_uint(r8[i]), __float_as_uint(r8[i + 4]), false, false); r4[i] = __uint_as_float(sw[0]) + __uint_as_float(sw[1]); }
#pragma unroll
    for (int i = 0; i < 2; ++i) { const bool up = (lane & 8) != 0; const float send = up ? r4[i] : r4[i + 2], keep = up ? r4[i + 2] : r4[i]; r2[i] = keep + __shfl_xor(send, 8); }
    { const bool up = (lane & 4) != 0; const float send = up ? r2[0] : r2[1], keep = up ? r2[1] : r2[0]; r1 = keep + __shfl_xor(send, 4); }
    r1 += __shfl_xor(r1, 2); r1 += __shfl_xor(r1, 1);
    const float wgt = gq * gelu_erf(r1 * su) * sv;
    const int rel = lane - 16 * (c & 3);
    const float wv = __shfl(wgt, 4 * (rel & 15));
    const bool mine = (rel >= 0) && (rel < 16);
    const bool lo_ = mine && (c < 4), hi_ = mine && (c >= 4);
    en[0].y = lo_ ? __float_as_uint(wv) : en[0].y; en[1].y = hi_ ? __float_as_uint(wv) : en[1].y;
}
__device__ __forceinline__ void b_load8(v4u (&vv)[8], const v2u ec, int c, int h8, const unsigned char* V8, int lane) {
#pragma unroll
    for (int j = 0; j < 8; ++j) { const unsigned e = __builtin_amdgcn_readlane(ec.x, 16 * (c & 3) + 8 * h8 + j); vv[j] = *(const v4u*)(V8 + (size_t)e * D + 16 * lane); }
}
__device__ __forceinline__ void b_step8(const v4u (&vv)[8], const v2u ec, int c, int h8, f32x2w (&acc)[8]) {
#pragma unroll
    for (int j = 0; j < 8; ++j) { const float w = __uint_as_float(__builtin_amdgcn_readlane(ec.y, 16 * (c & 3) + 8 * h8 + j)); const f32x2w w2 = {w, w};
#pragma unroll
        for (int q = 0; q < 4; ++q) { const unsigned x = vv[j][q]; const f32x2w a = __builtin_amdgcn_cvt_pk_f32_fp8((int)x, false), b = __builtin_amdgcn_cvt_pk_f32_fp8((int)x, true);
            acc[2 * q] += w2 * a; acc[2 * q + 1] += w2 * b; } }
}
__device__ __forceinline__ void b_load(v4u (&vv)[16], const v2u ec, int c, const unsigned char* V8, int lane) {
#pragma unroll
    for (int j = 0; j < 16; ++j) { const unsigned e = __builtin_amdgcn_readlane(ec.x, 16 * (c & 3) + j); vv[j] = *(const v4u*)(V8 + (size_t)e * D + 16 * lane); }
}
__device__ __forceinline__ void b_step(const v4u (&vv)[16], const v2u ec, int c, f32x2w (&acc)[8]) {
#pragma unroll
    for (int j = 0; j < 16; ++j) { const float w = __uint_as_float(__builtin_amdgcn_readlane(ec.y, 16 * (c & 3) + j)); const f32x2w w2 = {w, w};
#pragma unroll
        for (int q = 0; q < 4; ++q) { const unsigned x = vv[j][q]; const f32x2w a = __builtin_amdgcn_cvt_pk_f32_fp8((int)x, false), b = __builtin_amdgcn_cvt_pk_f32_fp8((int)x, true);
            acc[2 * q] += w2 * a; acc[2 * q + 1] += w2 * b; } }
}
__device__ __forceinline__ void tok_finish(const LAS f32x4* xl, const f32x2w (&acc)[8], float* xrow, const float* gam, const float* bet, int lane) {
    float rr[16], s = 0.f;
#pragma unroll
    for (int q = 0; q < 4; ++q) { const f32x4 xv = xl[q * 64];
#pragma unroll
        for (int e = 0; e < 4; ++e) { const int k = 4 * q + e; rr[k] = ALPHA * xv[e] + acc[k >> 1][k & 1]; s += rr[k]; } }
    const float mean = wave_sum(s) * (1.f / D); float s2 = 0.f;
#pragma unroll
    for (int k = 0; k < 16; ++k) { rr[k] -= mean; s2 += rr[k] * rr[k]; }
    const float rstd = __builtin_amdgcn_rsqf(wave_sum(s2) * (1.f / D) + LN_EPS);
#pragma unroll
    for (int q = 0; q < 4; ++q) { const f32x4 g = *(const f32x4*)(gam + 16 * lane + 4 * q), bb = *(const f32x4*)(bet + 16 * lane + 4 * q);
        f32x4 y; y[0] = rr[4 * q] * rstd * g[0] + bb[0]; y[1] = rr[4 * q + 1] * rstd * g[1] + bb[1]; y[2] = rr[4 * q + 2] * rstd * g[2] + bb[2]; y[3] = rr[4 * q + 3] * rstd * g[3] + bb[3];
        *(f32x4*)(xrow + 4 * q) = y; }
}
__device__ __forceinline__ void gather4(const v2u* sel, const G4& T, const float* rin, const float* g1, const float* b1, float* xo, const float* gam, const float* bet, int tok0, int lane, LAS f32x4* xl, LAS v2u* srt) {
    v2u en[4][2];
#pragma unroll
    for (int tt = 0; tt < 4; ++tt) { const float* rrow = rin + (size_t)(tok0 + tt) * D + 16 * lane;
        {
            f32x4 rv[4]; float s = 0.f;
#pragma unroll
            for (int q = 0; q < 4; ++q) { rv[q] = *(const f32x4*)(rrow + 4 * q); s += (rv[q][0] + rv[q][1]) + (rv[q][2] + rv[q][3]); }
            const float mean = wave_sum(s) * (1.f / D); float s2 = 0.f;
#pragma unroll
            for (int q = 0; q < 4; ++q) { rv[q] = rv[q] - mean; s2 += (rv[q][0] * rv[q][0] + rv[q][1] * rv[q][1]) + (rv[q][2] * rv[q][2] + rv[q][3] * rv[q][3]); }
            const float rstd = __builtin_amdgcn_rsqf(wave_sum(s2) * (1.f / D) + LN_EPS);
#pragma unroll
            for (int q = 0; q < 4; ++q) { const f32x4 gg = *(const f32x4*)(g1 + 16 * lane + 4 * q), bb = *(const f32x4*)(b1 + 16 * lane + 4 * q); xl[tt * 256 + q * 64] = rv[q] * rstd * gg + bb; }
        }
        const v2u e0 = sel[(size_t)(tok0 + tt) * 128 + lane], e1 = sel[(size_t)(tok0 + tt) * 128 + 64 + lane];
        const unsigned b0 = e0.x >> 9, b1 = e1.x >> 9; unsigned d0 = 0u, d1 = 0u, base = 0u;
#pragma unroll
        for (unsigned k = 0; k < 32; ++k) { const unsigned long long m0 = __ballot(b0 == k), m1 = __ballot(b1 == k);
            const unsigned c0 = (unsigned)__builtin_popcountll(m0), c1 = (unsigned)__builtin_popcountll(m1);
            const unsigned p0 = __builtin_amdgcn_mbcnt_hi((unsigned)(m0 >> 32), __builtin_amdgcn_mbcnt_lo((unsigned)m0, 0u)), p1 = __builtin_amdgcn_mbcnt_hi((unsigned)(m1 >> 32), __builtin_amdgcn_mbcnt_lo((unsigned)m1, 0u));
            d0 = (b0 == k) ? base + p0 : d0; d1 = (b1 == k) ? base + c0 + p1 : d1; base += c0 + c1; }
        srt[d0] = e0; srt[d1] = e1;
        asm volatile("s_waitcnt lgkmcnt(0)" ::: "memory");
        en[tt][0] = srt[lane]; en[tt][1] = srt[64 + lane];
        asm volatile("s_waitcnt lgkmcnt(0)" ::: "memory");
    }
    {
#pragma unroll 1
        for (int c = 0; c < 8; ++c) {
            v4u ua[16], ub[16];
            a_load(ua, PEER_EC(en[0], c), c, T.U8, lane); a_load(ub, PEER_EC(en[1], c), c, T.U8, lane); __builtin_amdgcn_sched_barrier(0);
            a_step(ua, en[0], c, xl + 0 * 256, T, lane); __builtin_amdgcn_sched_barrier(0);
            a_load(ua, PEER_EC(en[2], c), c, T.U8, lane); __builtin_amdgcn_sched_barrier(0);
            a_step(ub, en[1], c, xl + 1 * 256, T, lane); __builtin_amdgcn_sched_barrier(0);
            a_load(ub, PEER_EC(en[3], c), c, T.U8, lane); __builtin_amdgcn_sched_barrier(0);
            a_step(ua, en[2], c, xl + 2 * 256, T, lane); __builtin_amdgcn_sched_barrier(0);
            a_step(ub, en[3], c, xl + 3 * 256, T, lane); __builtin_amdgcn_sched_barrier(0);
        }
    }
    f32x2w acc[4][8];
#pragma unroll
    for (int tt = 0; tt < 4; ++tt)
#pragma unroll
        for (int q = 0; q < 8; ++q) acc[tt][q] = (f32x2w){0.f, 0.f};
    {
#define PEER_SB() __builtin_amdgcn_sched_barrier(0)
#pragma unroll 1
        for (int c = 0; c < 8; ++c) {
            const v2u e0 = PEER_EC(en[0], c), e1 = PEER_EC(en[1], c), e2 = PEER_EC(en[2], c), e3 = PEER_EC(en[3], c);
            v4u va[8], vb[8], vc[8];
            b_load8(va, e0, c, 0, T.V8, lane); b_load8(vb, e0, c, 1, T.V8, lane); PEER_SB();
            b_load8(vc, e1, c, 0, T.V8, lane); PEER_SB(); b_step8(va, e0, c, 0, acc[0]); PEER_SB();
            b_load8(va, e1, c, 1, T.V8, lane); PEER_SB(); b_step8(vb, e0, c, 1, acc[0]); PEER_SB();
            b_load8(vb, e2, c, 0, T.V8, lane); PEER_SB(); b_step8(vc, e1, c, 0, acc[1]); PEER_SB();
            b_load8(vc, e2, c, 1, T.V8, lane); PEER_SB(); b_step8(va, e1, c, 1, acc[1]); PEER_SB();
            b_load8(va, e3, c, 0, T.V8, lane); PEER_SB(); b_step8(vb, e2, c, 0, acc[2]); PEER_SB();
            b_load8(vb, e3, c, 1, T.V8, lane); PEER_SB(); b_step8(vc, e2, c, 1, acc[2]); PEER_SB();
            b_step8(va, e3, c, 0, acc[3]); PEER_SB(); b_step8(vb, e3, c, 1, acc[3]); PEER_SB();
        }
#undef PEER_SB
    }
#pragma unroll
    for (int tt = 0; tt < 4; ++tt) tok_finish(xl + tt * 256, acc[tt], xo + (size_t)(tok0 + tt) * D + 16 * lane, gam, bet, lane);
}
#undef PEER_EC
__device__ __forceinline__ void rows_to_fp8(const float* usrc, const float* vsrc, unsigned char* udst, unsigned char* vdst, float* uinv, float* vinv, int row0, int stride, int lane) {
    f32x4 nx[4];
    if (row0 < 2 * NEXP) { const float* p = (row0 < NEXP ? usrc + (size_t)row0 * D : vsrc + (size_t)(row0 - NEXP) * D) + 16 * lane;
#pragma unroll
        for (int q = 0; q < 4; ++q) nx[q] = *(const f32x4*)(p + 4 * q); }
#pragma unroll 1
    for (int row = row0; row < 2 * NEXP; row += stride) {
        f32x4 v[4]; float am = 0.f;
#pragma unroll
        for (int q = 0; q < 4; ++q) { v[q] = nx[q]; am = fmaxf(am, fmaxf(fmaxf(fabsf(v[q][0]), fabsf(v[q][1])), fmaxf(fabsf(v[q][2]), fabsf(v[q][3])))); }
        const int rn = row + stride;
        if (rn < 2 * NEXP) { const float* p = (rn < NEXP ? usrc + (size_t)rn * D : vsrc + (size_t)(rn - NEXP) * D) + 16 * lane;
#pragma unroll
            for (int q = 0; q < 4; ++q) nx[q] = *(const f32x4*)(p + 4 * q); }
        am = wave_max(am);
        float s = 1.f, is = 1.f;
        if (am > 1e-30f) { const int eb = (__float_as_int(224.f / am) >> 23) & 0xff; if (eb > 0 && eb < 254) { s = __int_as_float(eb << 23); is = __int_as_float((254 - eb) << 23); } }
        v4u o;
#pragma unroll
        for (int q = 0; q < 4; ++q) { int w = 0; w = __builtin_amdgcn_cvt_pk_fp8_f32(v[q][0] * s, v[q][1] * s, w, false); w = __builtin_amdgcn_cvt_pk_fp8_f32(v[q][2] * s, v[q][3] * s, w, true); o[q] = (unsigned)w; }
        unsigned char* dst = (row < NEXP ? udst + (size_t)row * D : vdst + (size_t)(row - NEXP) * D) + 16 * lane;
        *(v4u*)dst = o;
        if (lane == 0) { if (row < NEXP) uinv[row] = is; else vinv[row - NEXP] = is; }
    }
}
}
constexpr int NPH = 8;
__global__ void __launch_bounds__(NWAVES * 64, 2) mk_fwd(Args args) {
    extern __shared__ __attribute__((aligned(16))) unsigned char lds_raw[];
    LAS unsigned char* lds = (LAS unsigned char*)lds_raw;
    volatile LAS unsigned* MISC = (volatile LAS unsigned*)(lds + MISC_OFF);
    const int tid0 = threadIdx.x, lane0 = tid0 & 63, wave = __builtin_amdgcn_readfirstlane(tid0 >> 6);
    const int G = gridDim.x, bx = blockIdx.x, vcu = (G % 8 == 0) ? (bx % 8) * (G / 8) + bx / 8 : bx;
    unsigned char* ws0 = args.ws;
    gu32* ctl = (gu32*)(ws0 + WS_CTL);
    for (int u = tid0; u < (LDS_BYTES - RING_BYTES) / 4; u += NWAVES * 64) ((LAS unsigned*)(lds + RING_BYTES))[u] = 0u;
    __syncthreads();
    XcdBarrier bar; bar.bar = (unsigned*)(ctl + CW_BAR); bar.x = 0; bar.st = nullptr;
    if (MK_N_LAUNCHES == 1) bar = xcd_barrier_post((unsigned*)(ctl + CW_BAR), MISC + 8, wave);
    const int lo = args.ph_lo, hi = args.ph_hi;
#ifndef PH_MASK
#define PH_MASK 0xFF
#endif
#define IN(k) ((((PH_MASK) >> (k)) & 1) && lo <= (k) && (k) < hi)
#define SEAM(k) do { if (IN(k) && IN((k) + 1)) xcd_barrier(bar); } while (0)
    const int NGW = G * NWAVES;
#define SUB_BEGIN() unsigned char* ws = ws0; asm volatile("" : "+s"(ws)); const int lane = (int)__builtin_amdgcn_mbcnt_hi(~0u, __builtin_amdgcn_mbcnt_lo(~0u, 0u)), tid = wave * 64 + lane; (void)tid; (void)lane
#define PHASE_BEGIN() unsigned char* ws = ws0; asm volatile("" : "+s"(ws)); const int lane = (int)__builtin_amdgcn_mbcnt_hi(~0u, __builtin_amdgcn_mbcnt_lo(~0u, 0u)), tid = wave * 64 + lane; const int gw = vcu * NWAVES + wave; (void)gw; (void)lane; (void)tid

    if (IN(0)) { PHASE_BEGIN(); p0_prologue(args, lds, vcu, G, wave, lane); VM_WAIT(); __syncthreads(); SEAM(0); }

    if (IN(1)) { PHASE_BEGIN();
        pg8::Gemm g{(const pg8::bf16_t*)(ws + WS_A), (const pg8::bf16_t*)(ws + WS_WIN), T, INC, D}; pg8::StaticOrder S; S.init(T, INC, G, bx); S.rep = NREP(1);
        pg8::EpiInProj E{(pg8::bf16_t*)(ws + WS_QD), (pg8::bf16_t*)(ws + WS_KD), (pg8::bf16_t*)(ws + WS_VD), (pg8::bf16_t*)(ws + WS_LQ), (pg8::bf16_t*)(ws + WS_LK), (pg8::bf16_t*)(ws + WS_LV),
                         (pg8::bf16_t*)(ws + WS_GA), (pg8::bf16_t*)(ws + WS_GB)};
        pg8::gemm_phase<pg8::EpiInProj, pg8::StaticOrder, true, true>(lds, g, S, E, wave);
        {
            const int nwg = (T / 256) * (INC / 256), rem = nwg % G, nshort = rem ? G - rem : G, first = rem ? rem : 0;
            if (bx >= first) peer::rows_to_fp8(args.in[I_PU], args.in[I_PV], ws + WS_UU, ws + WS_UV, (float*)(ws + WS_ISU), (float*)(ws + WS_ISV), (bx - first) * NWAVES + wave, nshort * NWAVES, lane);
        }
        SEAM(1);
    }

    if (IN(2)) { PHASE_BEGIN();
#ifndef NO_DIFF
        {   SUB_BEGIN();
            const da::Tensors X{(const bf16*)(ws + WS_QD), (const bf16*)(ws + WS_KD), (const bf16*)(ws + WS_VD), (float*)(ws + WS_STASH), (bf16*)(ws + WS_YA),
                                args.in[I_DLAM], args.in[I_SUBG], args.in[I_RELB]};
            int cur_h = -1;
            float lam; { const float* dl = args.in[I_DLAM]; const float p1 = dl[lane] * dl[64 + lane], p2 = dl[128 + lane] * dl[192 + lane];
                lam = __uint_as_float(__builtin_amdgcn_readfirstlane(__float_as_uint(__expf(wave_sum(p1)) - __expf(wave_sum(p2)) + LAM_INIT))); }
            for (int rep_ = 0; rep_ < NREP(20); ++rep_)
            for (int p = vcu; p < 256; p += G) {
                const int bh = p >> 5, s = p & 31, b = bh >> 2, h = bh & 3;
                if (h != cur_h) {
                    __syncthreads();
                    const float* bd = (const float*)(ws + WS_BIASD) + h * BIAS_TAB; asm volatile("" : "+s"(bd));
                    int ln2 = (int)__builtin_amdgcn_mbcnt_hi(~0u, __builtin_amdgcn_mbcnt_lo(~0u, 0u)); asm volatile("" : "+v"(ln2));
                    for (int i = wave * 64 + ln2; i < BIAS_TAB; i += NWAVES * 64) ((LAS float*)(lds + da::LDS_BIAS))[i] = bd[i];
                    __syncthreads(); cur_h = h;
                }
                const float c31 = args.in[I_RELB][31 * 16 + h] * LOG2E;
                for (int k2 = 0; k2 < 2; ++k2) da::unit(X, b, h, k2 ? 63 - s : s, lds, bx, lam, c31, wave);
            }
        }
#endif
#ifndef NO_DIL
        {   SUB_BEGIN();
            const dil::Tensors X{(const bf16*)(ws + WS_LQ), (const bf16*)(ws + WS_LK), (const bf16*)(ws + WS_LV), (bf16*)(ws + WS_YB)};
            int cur_h = -1;
            for (int rep_ = 0; rep_ < NREP(21); ++rep_)
            for (int u = vcu; u < 256; u += G) {
                const int bh = u >> 5, blk = u & 31, b = bh >> 2, h = bh & 3;
                if (h != cur_h) {
                    __syncthreads();
                    const float* blsrc = (const float*)(ws + WS_BIASL);
                    for (int i = tid; i < 3 * dil::BT; i += NWAVES * 64) { const int g = i / dil::BT, jj = i % dil::BT - dil::BT0;
                        ((LAS float*)(lds + dil::LDS_BL))[i] = (jj >= 0 && jj <= 128) ? blsrc[(g * 4 + h) * 132 + jj] : 0.f; }
                    __syncthreads(); cur_h = h;
                }
                float* lse0 = (float*)(ws + WS_LSE0);
                for (int k2 = 0; k2 < 2; ++k2) dil::wave_tile_g0(X, lse0, b, h, blk * 512 + (wave + 8 * k2) * 32, lds + dil::LDS_VST + wave * 4096, (const LAS float*)(lds + dil::LDS_BL), lane);
                VM_WAIT(); __syncthreads();
                for (int k2 = 0; k2 < 2; ++k2) dil::wave_tile(X, lse0, b, h, blk * 512, wave + 8 * k2, lds + dil::LDS_VST + wave * 4096, (const LAS float*)(lds + dil::LDS_BL), lane);
            }
            __syncthreads();
        }
#endif
        SEAM(2);
    }

    if (IN(3)) { PHASE_BEGIN();
        { pg8::Gemm g{(const pg8::bf16_t*)(ws + WS_YA), (const pg8::bf16_t*)(ws + WS_WBD), T, D, 512}; pg8::StaticOrder S; S.init(T, D, G, bx); S.rep = NREP(3);
          pg8::EpiGate1 E{(const pg8::bf16_t*)(ws + WS_GA), (pg8::bf16_t*)(ws + WS_GATED)};
          pg8::gemm_phase<pg8::EpiGate1, pg8::StaticOrder, true, true>(lds, g, S, E, wave); }
        VM_WAIT(); __syncthreads();
        { pg8::Gemm g{(const pg8::bf16_t*)(ws + WS_YB), (const pg8::bf16_t*)(ws + WS_WBL), T, D, 256}; pg8::StaticOrder S; S.init(T, D, G, bx);
          pg8::EpiGate2 E{(const pg8::bf16_t*)(ws + WS_GB), (pg8::bf16_t*)(ws + WS_GATED)};
          pg8::gemm_phase<pg8::EpiGate2, pg8::StaticOrder, true, true>(lds, g, S, E, wave); }
        SEAM(3);
    }

    if (IN(4)) { PHASE_BEGIN();
        pg8::Gemm g{(const pg8::bf16_t*)(ws + WS_GATED), (const pg8::bf16_t*)(ws + WS_WO), T, D, D}; pg8::StaticOrder S; S.init(T, D, G, bx); S.rep = NREP(4);
        pg8::EpiOut E{args.in[I_X], (float*)(ws + WS_R)};
        pg8::gemm_phase<pg8::EpiOut, pg8::StaticOrder, true, true>(lds, g, S, E, wave);
        SEAM(4);
    }

    if (IN(5)) { PHASE_BEGIN();
        p5_ln1(args, vcu, G, wave, lane);
        SEAM(5);
    }

    if (IN(6)) { PHASE_BEGIN();
        pg8::Gemm g{(const pg8::bf16_t*)(ws + WS_WP), (const pg8::bf16_t*)(ws + WS_A), 2048, T, D}; pg8::StaticOrder S; S.init(2048, T, G, bx); S.rep = NREP(6);
        pg8::EpiScoreT E{(float*)(ws + WS_ST)};
        pg8::gemm_phase<pg8::EpiScoreT, pg8::StaticOrder, true, true>(lds, g, S, E, wave);
        SEAM(6);
    }

    if (IN(7)) { PHASE_BEGIN();
        const float* ST = (const float*)(ws + WS_ST); v2u* sel = (v2u*)(ws + WS_SEL);
        for (int u = vcu; u < T / 128; u += G) {
            for (int p = 0; p < 2; ++p) peer::select(ST, sel, u * 128 + p * 64 + lane, wave);
            VM_WAIT(); __syncthreads();
            { const peer::G4 TB{ws + WS_UU, ws + WS_UV, (const float*)(ws + WS_ISU), (const float*)(ws + WS_ISV)};
              for (int i = 0; i < 4; ++i) peer::gather4(sel, TB, (const float*)(ws + WS_R), args.in[I_LN1G], args.in[I_LN1B], args.out, args.in[I_LN2G], args.in[I_LN2B], u * 128 + i * 32 + wave * 4, lane, (LAS f32x4*)(lds + wave * 16384) + lane, (LAS v2u*)(lds + RING_BYTES + 2048 + wave * 1024)); }
            VM_WAIT(); __syncthreads();
        }
    }
#undef IN
#undef SEAM
}

extern "C" void kernel_launch(void* const* d_in, const int* in_sizes, int n_in, void* d_out, int out_size, void* d_ws, size_t ws_size, hipStream_t stream) {
    static int grid = 0;
    if (grid == 0) {
        if (n_in != 16 || in_sizes[0] != T * D || out_size != T * D || ws_size < WS_END) { fprintf(stderr, "kernel_launch: unexpected shapes (n_in %d, in0 %d, out %d, ws %zu); nothing launched\n", n_in, n_in > 0 ? in_sizes[0] : -1, out_size, ws_size); grid = -1; return; }
        int dev = 0, cus = 0, per_cu = 0;
        if (hipGetDevice(&dev) != hipSuccess || hipDeviceGetAttribute(&cus, hipDeviceAttributeMultiprocessorCount, dev) != hipSuccess) { grid = -1; return; }
        if (hipFuncSetAttribute((const void*)mk_fwd, hipFuncAttributeMaxDynamicSharedMemorySize, LDS_BYTES) != hipSuccess) { fprintf(stderr, "kernel_launch: hipFuncSetAttribute failed\n"); grid = -1; return; }
        if (hipOccupancyMaxActiveBlocksPerMultiprocessor(&per_cu, (const void*)mk_fwd, NWAVES * 64, LDS_BYTES) != hipSuccess || per_cu < 1) { fprintf(stderr, "kernel_launch: occupancy query reports %d\n", per_cu); per_cu = 1; }
        (void)hipGetLastError();
        grid = cus;
    }
    if (grid < 0) return;
    if (hipMemsetAsync((char*)d_ws + WS_CTL, 0, CTL_ZERO_BYTES, stream) != hipSuccess) return;
    Args a{};
    for (int i = 0; i < 16; ++i) a.in[i] = (const float*)d_in[i];
    a.out = (float*)d_out; a.ws = (unsigned char*)d_ws;
    for (int li = 0; li < MK_N_LAUNCHES; ++li) {
        a.ph_lo = (MK_N_LAUNCHES == 1) ? 0 : li; a.ph_hi = (MK_N_LAUNCHES == 1) ? NPH : li + 1;
        hipLaunchKernelGGL(mk_fwd, dim3(grid), dim3(NWAVES * 64), LDS_BYTES, stream, a);
    }
}
```

```cpp
#include <hip/hip_runtime.h>
#include <cstdio>
#include <cstdint>

#ifndef MK_N_LAUNCHES
#define MK_N_LAUNCHES 1
#endif

#ifndef REPEAT_PH
#define REPEAT_PH (-1)
#endif
#define NREP(k) ((REPEAT_PH) == (k) ? 2 : 1)

constexpr int BATCH = 2, SEQ = 16384, T = BATCH * SEQ, D = 1024, INC = 5888;
constexpr int OFF_DQ = 0, OFF_DK = 512, OFF_DV = 1024, OFF_LQ = 1536, OFF_LK = 2304, OFF_LV = 3072, OFF_GA = 3840, OFF_GB = 4864;
constexpr int NEXP = 16384;
constexpr float LOG2E = 1.4426950408889634f;
constexpr float QSCALE = 0.125f * LOG2E;
constexpr float ALPHA = 1.189207115002721f;
constexpr float LN_EPS = 1e-5f, SUBLN_EPS = 1e-5f;
constexpr float LAM_INIT = 0.2f;
constexpr int NTILE = SEQ / 64;
constexpr int BIAS_TAB = 2240, BIAS_GUARD = 256, DFAR = 1513;

constexpr size_t MiB = 1u << 20;
constexpr size_t WS_CTL = 0, CTL_ZERO_BYTES = 1 * MiB;
constexpr size_t WS_BIASD = 1 * MiB;
constexpr size_t WS_BIASL = 1 * MiB + 64 * 1024;
constexpr size_t WS_WIN = 8 * MiB, WS_WO = 20 * MiB, WS_WBD = 22 * MiB, WS_WBL = 23 * MiB, WS_WP = 24 * MiB;
constexpr size_t WS_A = 32 * MiB;
constexpr size_t WS_YA = WS_A, WS_YB = WS_A + 32 * MiB;
constexpr size_t WS_QD = 96 * MiB, WS_KD = 128 * MiB, WS_VD = 160 * MiB, WS_LQ = 192 * MiB, WS_LK = 240 * MiB, WS_LV = 288 * MiB, WS_GA = 336 * MiB, WS_GB = 400 * MiB;
constexpr size_t WS_STASH = 464 * MiB;
constexpr size_t WS_SEL = 32 * MiB;
constexpr size_t WS_GATED = 96 * MiB;
constexpr size_t WS_R = 352 * MiB;
constexpr size_t WS_ST = 96 * MiB;
constexpr size_t WS_UU = 480 * MiB, WS_UV = 496 * MiB;
constexpr size_t WS_LSE0 = 3 * MiB;
constexpr size_t WS_ISU = 2 * MiB, WS_ISV = 2 * MiB + 65536;
constexpr size_t WS_END = 512 * MiB;

constexpr int CW_BAR = 4096;
constexpr int NWAVES = 8;
constexpr int RING_BYTES = 131072, MISC_OFF = RING_BYTES + 320, LDS_BYTES = 147456;

#define GAS __attribute__((address_space(1)))
#define LAS __attribute__((address_space(3)))
typedef unsigned short bf16;
typedef unsigned v4u __attribute__((ext_vector_type(4)));
typedef unsigned v2u __attribute__((ext_vector_type(2)));
typedef float f32x4 __attribute__((ext_vector_type(4)));
typedef float f32x16 __attribute__((ext_vector_type(16)));
typedef short bf16x8 __attribute__((ext_vector_type(8)));
typedef short s16x4 __attribute__((ext_vector_type(4)));
typedef __bf16 bf16x2 __attribute__((ext_vector_type(2)));
typedef GAS unsigned gu32;
#define RLX_AGENT __ATOMIC_RELAXED, __HIP_MEMORY_SCOPE_AGENT
#define LDS_WAIT() asm volatile("s_waitcnt lgkmcnt(0)" ::: "memory")
#define VM_WAIT() asm volatile("s_waitcnt vmcnt(0)" ::: "memory")
__device__ __forceinline__ unsigned f2bf(float f) { unsigned u = __builtin_bit_cast(unsigned, f); return (u + 0x7fffu + ((u >> 16) & 1u)) >> 16; }
__device__ __forceinline__ unsigned pk2(float lo, float hi) { return f2bf(lo) | (f2bf(hi) << 16); }
typedef float f32x2_t __attribute__((ext_vector_type(2)));
__device__ __forceinline__ unsigned cvtpk(float lo, float hi) { f32x2_t v = {lo, hi}; bf16x2 b = __builtin_convertvector(v, bf16x2); return __builtin_bit_cast(unsigned, b); }
__device__ __forceinline__ float bf_lo(unsigned w) { return __builtin_bit_cast(float, w << 16); }
__device__ __forceinline__ float bf_hi(unsigned w) { return __builtin_bit_cast(float, w & 0xffff0000u); }
__device__ __forceinline__ float dot2bf(unsigned a, unsigned b, float acc) { return __builtin_amdgcn_fdot2_f32_bf16(__builtin_bit_cast(bf16x2, a), __builtin_bit_cast(bf16x2, b), acc, false); }
__device__ __forceinline__ float wave_sum(float v) {
#pragma unroll
    for (int o = 1; o < 64; o <<= 1) v += __shfl_xor(v, o);
    return v;
}
__device__ __forceinline__ float wave_max(float v) {
#pragma unroll
    for (int o = 1; o < 64; o <<= 1) v = fmaxf(v, __shfl_xor(v, o));
    return v;
}
__device__ __forceinline__ int rel_bucket(int n) {
    if (n < 16) return n < 0 ? 0 : n;
    return 16 + (n >= 22) + (n >= 30) + (n >= 40) + (n >= 54) + (n >= 73) + (n >= 99) + (n >= 134) + (n >= 182) + (n >= 246) + (n >= 332) + (n >= 450) + (n >= 609) + (n >= 825) + (n >= 1117) + (n >= 1513);
}
namespace pg8 {
#define PG8_LAS __attribute__((address_space(3)))
typedef unsigned short bf16_t;
typedef short bf16x8 __attribute__((ext_vector_type(8)));
typedef float f32x4 __attribute__((ext_vector_type(4)));
typedef unsigned u32x4 __attribute__((ext_vector_type(4)));
constexpr int BM = 256, BK = 64, HALF = 128, HTB = HALF * BK * 2  , STAGE_BYTES = 8 * HTB, NXCD = 8, WGM = 8;

__host__ __device__ __forceinline__ int lds_byte(int r, int c) { const int st = (r >> 4) * 2 + (c >> 5), rr = r & 15, cc = c & 31, ob = rr * 64 + cc * 2; return st * 1024 + (ob ^ (((ob >> 9) & 1) << 5)); }
__host__ __device__ __forceinline__ void stage_rc(int b, int& R, int& C) { const int st = b / 1024, sb = b % 1024, swz = sb ^ (((sb >> 9) & 1) << 5); R = (st >> 1) * 16 + swz / 64; C = (st & 1) * 32 + (swz % 64) / 2; }
__host__ __device__ __forceinline__ int perm32(int rho) { const int n = rho >> 4, i = rho & 15; return 8 * (i >> 2) + 4 * n + (i & 3); }

struct Unit { int pm, pn; };
struct Gemm { const bf16_t* A; const bf16_t* Bt; int M, N, K; };

struct StaticOrder {
    int nM, nN, nwg, G, c;
    __host__ __device__ void init(int M, int N, int G_, int c_) { nM = M / BM; nN = N / BM; nwg = nM * nN; G = G_; c = c_; }
    int rep = 1;
    __host__ __device__ bool next(int i0, Unit& u) const {
        const int i = i0 / rep;
        const long L = (long)i * G + c; if (L >= nwg) return false;
        int wgid = (int)L; { const int q = nwg / NXCD, r = nwg % NXCD, xcd = wgid % NXCD, off = wgid / NXCD; wgid = (xcd < r ? xcd * (q + 1) : r * (q + 1) + (xcd - r) * q) + off; }
        const int nig = WGM * nN, gid = wgid / nig, fm = gid * WGM, gsz = (nM - fm) < WGM ? (nM - fm) : WGM;
        u.pm = fm + ((wgid % nig) % gsz); u.pn = (wgid % nig) / gsz; return true;
    }
    __device__ __forceinline__ void a_ready(const Unit&) const {}
    __device__ __forceinline__ void done(const Unit&) const {}
};
__device__ __forceinline__ unsigned cvt_pk_bf16(float lo, float hi) { unsigned r; asm volatile("v_cvt_pk_bf16_f32 %0, %1, %2" : "=v"(r) : "v"(lo), "v"(hi)); return r; }
__device__ __forceinline__ u32x4 pack8(const f32x4 v0, const f32x4 v1) { u32x4 w; w.x = cvt_pk_bf16(v0[0], v0[1]); w.y = cvt_pk_bf16(v0[2], v0[3]); w.z = cvt_pk_bf16(v1[0], v1[1]); w.w = cvt_pk_bf16(v1[2], v1[3]); return w; }
__device__ __forceinline__ float blo(unsigned w) { return __builtin_bit_cast(float, w << 16); }
__device__ __forceinline__ float bhi(unsigned w) { return __builtin_bit_cast(float, w & 0xffff0000u); }
__device__ __forceinline__ float sigm(float v) { return __builtin_amdgcn_rcpf(1.f + __expf(-v)); }
template <class E> __device__ __forceinline__ void epi_loop(const E& e, const f32x4 (&acc)[2][2][4][2], const Unit& u, int wr, int wc, int fr, int fq) {
#pragma unroll
    for (int ai = 0; ai < 2; ++ai)
#pragma unroll
        for (int m = 0; m < 4; ++m) { const int row = u.pm * BM + ai * HALF + wr * 64 + m * 16 + fr;
#pragma unroll
            for (int bj = 0; bj < 2; ++bj) { const int col = u.pn * BM + bj * HALF + wc * 32 + 8 * fq; e.item(u.pn, row, col, acc[ai][bj][m][0], acc[ai][bj][m][1]); } }
}

struct EpiInProj {
    static constexpr bool PERM = true, AFTER_DRAIN = false;
    bf16_t *Qd, *Kd, *Vd, *LQ, *LK, *LV, *GA, *GB;
    __device__ __forceinline__ void operator()(const f32x4 (&acc)[2][2][4][2], const Unit& u, int wr, int wc, int fr, int fq) const { epi_loop(*this, acc, u, wr, wc, fr, fq); }
    __device__ __forceinline__ void item(int pn, int row, int col, f32x4 v0, f32x4 v1) const {
            const int b = row >> 14, s = row & 16383; bf16_t* dst;
            if (pn < 2) {
                const int h = col >> 7, c = (col >> 6) & 1, d = col & 63; v0 = v0 * 0.18033688011112042f; v1 = v1 * 0.18033688011112042f;
                dst = Qd + ((size_t)((b * 4 + h) * 2 + c) * 16384 + s) * 64 + d;
            } else if (pn < 4) {
                const int cc = col - 512, h = cc >> 7, c = (cc >> 6) & 1, d = cc & 63;
                dst = Kd + ((((size_t)((b * 4 + h) * 2 + c) * 256 + (s >> 6)) * 8 + (d >> 3)) * 64 + (s & 63)) * 8;
            } else if (pn < 6) {
                const int cc = col - 1024, h = cc >> 7, d = cc & 127;
                dst = Vd + ((size_t)(b * 4 + h) * 256 + (s >> 6)) * 8192 + ((d >> 5) * 4 + ((s & 63) >> 4)) * 512 + (s & 15) * 32 + (d & 31);
            } else if (pn < 9) {
                v0 = v0 * 0.18033688011112042f; v1 = v1 * 0.18033688011112042f; dst = LQ + (size_t)row * 768 + (col - 1536);
            } else if (pn < 12) { dst = LK + (size_t)row * 768 + (col - 2304);
            } else if (pn < 15) { dst = LV + (size_t)row * 768 + (col - 3072);
            } else {
#pragma unroll
                for (int i = 0; i < 4; ++i) { v0[i] = sigm(v0[i]); v1[i] = sigm(v1[i]); }
                dst = (pn < 19) ? GA + (size_t)row * 1024 + (col - 3840) : GB + (size_t)row * 1024 + (col - 4864);
            }
            *(u32x4*)dst = pack8(v0, v1);
        }
};
struct EpiGate1 {
    static constexpr bool PERM = true, AFTER_DRAIN = false;
    const bf16_t* GA; bf16_t* G;
    __device__ __forceinline__ void operator()(const f32x4 (&acc)[2][2][4][2], const Unit& u, int wr, int wc, int fr, int fq) const { epi_loop(*this, acc, u, wr, wc, fr, fq); }
    __device__ __forceinline__ void item(int pn, int row, int col, f32x4 v0, f32x4 v1) const {
            const size_t o = (size_t)row * 1024 + col; const u32x4 g = *(const u32x4*)(GA + o);
            v0[0] *= blo(g.x); v0[1] *= bhi(g.x); v0[2] *= blo(g.y); v0[3] *= bhi(g.y); v1[0] *= blo(g.z); v1[1] *= bhi(g.z); v1[2] *= blo(g.w); v1[3] *= bhi(g.w);
            *(u32x4*)(G + o) = pack8(v0, v1);
        }
};
struct EpiGate2 {
    static constexpr bool PERM = true, AFTER_DRAIN = false;
    const bf16_t* GB; bf16_t* G;
    __device__ __forceinline__ void operator()(const f32x4 (&acc)[2][2][4][2], const Unit& u, int wr, int wc, int fr, int fq) const { epi_loop(*this, acc, u, wr, wc, fr, fq); }
    __device__ __forceinline__ void item(int pn, int row, int col, f32x4 v0, f32x4 v1) const {
            const size_t o = (size_t)row * 1024 + col; const u32x4 g = *(const u32x4*)(GB + o); const u32x4 p = *(const u32x4*)(G + o);
            v0[0] = v0[0] * blo(g.x) + blo(p.x); v0[1] = v0[1] * bhi(g.x) + bhi(p.x); v0[2] = v0[2] * blo(g.y) + blo(p.y); v0[3] = v0[3] * bhi(g.y) + bhi(p.y);
            v1[0] = v1[0] * blo(g.z) + blo(p.z); v1[1] = v1[1] * bhi(g.z) + bhi(p.z); v1[2] = v1[2] * blo(g.w) + blo(p.w); v1[3] = v1[3] * bhi(g.w) + bhi(p.w);
            *(u32x4*)(G + o) = pack8(v0, v1);
        }
};
struct EpiOut {
    static constexpr bool PERM = true, AFTER_DRAIN = false;
    const float* X; float* R;
    __device__ __forceinline__ void operator()(const f32x4 (&acc)[2][2][4][2], const Unit& u, int wr, int wc, int fr, int fq) const { epi_loop(*this, acc, u, wr, wc, fr, fq); }
    __device__ __forceinline__ void item(int pn, int row, int col, f32x4 v0, f32x4 v1) const {
            const size_t o = (size_t)row * 1024 + col; const f32x4 x0 = *(const f32x4*)(X + o), x1 = *(const f32x4*)(X + o + 4);
            *(f32x4*)(R + o) = x0 * 1.189207115002721f + v0; *(f32x4*)(R + o + 4) = x1 * 1.189207115002721f + v1;
    }
};
struct EpiScoreT {
    static constexpr bool PERM = true, AFTER_DRAIN = false;
    float* ST;
    __device__ __forceinline__ void operator()(const f32x4 (&acc)[2][2][4][2], const Unit& u, int wr, int wc, int fr, int fq) const { epi_loop(*this, acc, u, wr, wc, fr, fq); }
    __device__ __forceinline__ void item(int pn, int row, int col, f32x4 v0, f32x4 v1) const { const size_t o = (size_t)row * 32768 + col; *(f32x4*)(ST + o) = v0; *(f32x4*)(ST + o + 4) = v1; }
};
template <class Epi, class Sched, bool ALIGN_EPI = false, bool SP2 = false>
__device__ __forceinline__ void gemm_phase(PG8_LAS unsigned char* lds, const Gemm g, const Sched& S, const Epi& E, const int wid  ) {
    const int lane = (int)__builtin_amdgcn_mbcnt_hi(~0u, __builtin_amdgcn_mbcnt_lo(~0u, 0u)), tid = wid * 64 + lane, wr = wid >> 2, wc = wid & 3, fr = lane & 15, fq = lane >> 4;
    const int K = g.K, nt = K / BK;
    unsigned voffA[2], voffB[2];
#pragma unroll
    for (int i = 0; i < 2; ++i) { int R, C; stage_rc(tid * 16 + i * 8192, R, C); const int Rb = Epi::PERM ? ((R & ~31) + perm32(R & 31)) : R;
        voffA[i] = (unsigned)(R * K + C) * 2u; voffB[i] = (unsigned)(Rb * K + C) * 2u; }
    const size_t kstep = (size_t)(BK * 2);
    const size_t hstep = (size_t)HALF * K * 2;
    const size_t tstep = 2 * hstep;
    const unsigned ldsw = (unsigned)wid * 1024u;
    const int aoff = lds_byte(wr * 64 + fr, fq * 8), boff = lds_byte(wc * 32 + fr, fq * 8);
#define PG8_SA(b, h) (((b) * 2 + (h)) * HTB)
#define PG8_SB(b, h) ((4 + (b) * 2 + (h)) * HTB)
#define PG8_STAGE(bufoff, gbase, voff) do { _Pragma("unroll") for (int _i = 0; _i < 2; ++_i) \
        __builtin_amdgcn_global_load_lds((const unsigned*)((const char*)(gbase) + (voff)[_i]), (PG8_LAS unsigned*)(lds + (bufoff) + ldsw + _i * 8192), 16, 0, 0); } while (0)
#define PG8_LDA(dst, b, h) do { _Pragma("unroll") for (int m = 0; m < 4; ++m) _Pragma("unroll") for (int k = 0; k < 2; ++k) dst[m][k] = *(const PG8_LAS bf16x8*)(lds + PG8_SA(b, h) + aoff + m * 2048 + k * 1024); } while (0)
#define PG8_LDB(dst, b, h) do { _Pragma("unroll") for (int n = 0; n < 2; ++n) _Pragma("unroll") for (int k = 0; k < 2; ++k) dst[n][k] = *(const PG8_LAS bf16x8*)(lds + PG8_SB(b, h) + boff + n * 2048 + k * 1024); } while (0)
#define PG8_MMA(ai, bj, At, Bt) do { __builtin_amdgcn_s_setprio(1); _Pragma("unroll") for (int m = 0; m < 4; ++m) _Pragma("unroll") for (int n = 0; n < 2; ++n) _Pragma("unroll") for (int k = 0; k < 2; ++k) \
        acc[ai][bj][m][n] = __builtin_amdgcn_mfma_f32_16x16x32_bf16(Bt[n][k], At[m][k], acc[ai][bj][m][n], 0, 0, 0); __builtin_amdgcn_s_setprio(0); } while (0)
#define PG8_WAIT_V(n) asm volatile("s_waitcnt vmcnt(" #n ")" ::: "memory")
#define PG8_WAIT_L(n) asm volatile("s_waitcnt lgkmcnt(" #n ")" ::: "memory")
#define PG8_BAR __builtin_amdgcn_s_barrier()
#define PG8_SCHED __builtin_amdgcn_sched_barrier(0)
    Unit cur, nxt; int ui = 0;
    if (!S.next(0, cur)) return;
    f32x4 acc[2][2][4][2];
#pragma unroll
    for (int a = 0; a < 2; ++a)
#pragma unroll
        for (int b = 0; b < 2; ++b)
#pragma unroll
            for (int m = 0; m < 4; ++m)
#pragma unroll
                for (int n = 0; n < 2; ++n) acc[a][b][m][n] = (f32x4){0.f, 0.f, 0.f, 0.f};
    bf16x8 At[4][2], B0[2][2], B1[2][2];
    const char* cA = (const char*)g.A + (size_t)cur.pm * tstep; const char* cB = (const char*)g.Bt + (size_t)cur.pn * tstep;
    S.a_ready(cur);
    if constexpr (SP2) {
        PG8_STAGE(PG8_SB(0, 0), cB, voffB); PG8_STAGE(PG8_SB(0, 1), cB + hstep, voffB); PG8_STAGE(PG8_SA(0, 0), cA, voffA); PG8_STAGE(PG8_SA(0, 1), cA + hstep, voffA);
        if (wr == 1) PG8_BAR;
        PG8_WAIT_V(2); PG8_BAR;
        PG8_STAGE(PG8_SB(1, 0), cB + kstep, voffB); PG8_STAGE(PG8_SA(1, 0), cA + kstep, voffA); PG8_STAGE(PG8_SB(1, 1), cB + hstep + kstep, voffB);
        PG8_WAIT_V(6); PG8_BAR;
    } else {
        PG8_STAGE(PG8_SB(0, 0), cB, voffB); PG8_STAGE(PG8_SA(0, 0), cA, voffA); PG8_STAGE(PG8_SB(0, 1), cB + hstep, voffB); PG8_STAGE(PG8_SA(0, 1), cA + hstep, voffA);
        if (wr == 1) PG8_BAR;
        PG8_WAIT_V(4); PG8_BAR;
        PG8_STAGE(PG8_SB(1, 0), cB + kstep, voffB); PG8_STAGE(PG8_SA(1, 0), cA + kstep, voffA); PG8_STAGE(PG8_SB(1, 1), cB + hstep + kstep, voffB);
        PG8_WAIT_V(6); PG8_BAR;
    }
    for (;;) {
        const bool has_next = S.next(ui + 1, nxt);
        const char* nA = has_next ? (const char*)g.A + (size_t)nxt.pm * tstep : cA; const char* nB = has_next ? (const char*)g.Bt + (size_t)nxt.pn * tstep : cB;
        for (int t = 0; t < nt; t += 2) {
            const bool last = (t == nt - 2);
            const char* a1 = cA + (size_t)(t + 1) * kstep;
            const char* a2 = last ? nA : cA + (size_t)(t + 2) * kstep; const char* b2 = last ? nB : cB + (size_t)(t + 2) * kstep;
            const char* a3 = a2 + kstep; const char* b3 = b2 + kstep;
            if (last && has_next) S.a_ready(nxt);
            if constexpr (SP2) {
            PG8_LDB(B0, 0, 0); PG8_LDB(B1, 0, 1); PG8_SCHED; PG8_LDA(At, 0, 0); PG8_STAGE(PG8_SA(1, 1), a1 + hstep, voffA);
            PG8_WAIT_V(8); PG8_WAIT_L(0); PG8_BAR; PG8_MMA(0, 0, At, B0); PG8_MMA(0, 1, At, B1); PG8_BAR; PG8_SCHED;
            PG8_LDA(At, 0, 1); PG8_STAGE(PG8_SB(0, 0), b2, voffB); PG8_STAGE(PG8_SB(0, 1), b2 + hstep, voffB); PG8_STAGE(PG8_SA(0, 0), a2, voffA);
            PG8_WAIT_V(8); PG8_WAIT_L(0); PG8_BAR; PG8_MMA(1, 0, At, B0); PG8_MMA(1, 1, At, B1); PG8_BAR; PG8_SCHED;
            PG8_LDB(B0, 1, 0); PG8_LDB(B1, 1, 1); PG8_SCHED; PG8_LDA(At, 1, 0); PG8_STAGE(PG8_SA(0, 1), a2 + hstep, voffA);
            PG8_WAIT_V(8); PG8_WAIT_L(0); PG8_BAR; PG8_MMA(0, 0, At, B0); PG8_MMA(0, 1, At, B1); PG8_BAR; PG8_SCHED;
            PG8_LDA(At, 1, 1); PG8_STAGE(PG8_SB(1, 0), b3, voffB); PG8_STAGE(PG8_SB(1, 1), b3 + hstep, voffB); PG8_STAGE(PG8_SA(1, 0), a3, voffA);
            PG8_WAIT_V(8); PG8_WAIT_L(0); PG8_BAR; PG8_MMA(1, 0, At, B0); PG8_MMA(1, 1, At, B1); PG8_BAR; PG8_SCHED;
            } else {
            PG8_LDB(B0, 0, 0); PG8_SCHED; PG8_LDA(At, 0, 0); PG8_STAGE(PG8_SA(1, 1), a1 + hstep, voffA);
            PG8_WAIT_L(8); PG8_BAR; PG8_WAIT_L(0); PG8_MMA(0, 0, At, B0); PG8_BAR; PG8_SCHED;
            PG8_LDB(B1, 0, 1); PG8_STAGE(PG8_SB(0, 0), b2, voffB);
            PG8_BAR; PG8_WAIT_L(0); PG8_MMA(0, 1, At, B1); PG8_BAR;
            PG8_LDA(At, 0, 1); PG8_STAGE(PG8_SA(0, 0), a2, voffA);
            PG8_BAR; PG8_WAIT_L(0); PG8_MMA(1, 0, At, B0); PG8_BAR; PG8_SCHED;
            PG8_STAGE(PG8_SB(0, 1), b2 + hstep, voffB);
            PG8_WAIT_V(6); PG8_BAR; PG8_MMA(1, 1, At, B1); PG8_BAR;
            PG8_LDB(B0, 1, 0); PG8_SCHED; PG8_LDA(At, 1, 0); PG8_STAGE(PG8_SA(0, 1), a2 + hstep, voffA);
            PG8_WAIT_L(8); PG8_BAR; PG8_WAIT_L(0); PG8_MMA(0, 0, At, B0); PG8_BAR; PG8_SCHED;
            PG8_LDB(B1, 1, 1); PG8_STAGE(PG8_SB(1, 0), b3, voffB);
            PG8_BAR; PG8_WAIT_L(0); PG8_MMA(0, 1, At, B1); PG8_BAR;
            PG8_LDA(At, 1, 1); PG8_STAGE(PG8_SA(1, 0), a3, voffA);
            PG8_BAR; PG8_WAIT_L(0); PG8_MMA(1, 0, At, B0); PG8_BAR; PG8_SCHED;
            PG8_STAGE(PG8_SB(1, 1), b3 + hstep, voffB);
            PG8_WAIT_V(6); PG8_BAR; PG8_MMA(1, 1, At, B1); PG8_BAR;
            }
        }
        if constexpr (ALIGN_EPI) { if (wr == 0) PG8_BAR; }
        if constexpr (!Epi::AFTER_DRAIN) { E(acc, cur, wr, wc, fr, fq); S.done(cur); }
        if (!has_next) break;
#pragma unroll
        for (int a = 0; a < 2; ++a)
#pragma unroll
            for (int b = 0; b < 2; ++b)
#pragma unroll
                for (int m = 0; m < 4; ++m)
#pragma unroll
                    for (int n = 0; n < 2; ++n) acc[a][b][m][n] = (f32x4){0.f, 0.f, 0.f, 0.f};
        cur = nxt; cA = nA; cB = nB; ++ui;
        if constexpr (ALIGN_EPI) { if (wr == 1) PG8_BAR; }
    }
    PG8_WAIT_V(0);
    if constexpr (!ALIGN_EPI) { if (wr == 0) PG8_BAR; }
    PG8_BAR;
    if constexpr (Epi::AFTER_DRAIN) { E.fused(acc, cur, wr, wc, fr, fq, lds, wid, lane); S.done(cur); }
#undef PG8_SA
#undef PG8_SB
#undef PG8_STAGE
#undef PG8_LDA
#undef PG8_LDB
#undef PG8_MMA
#undef PG8_WAIT_V
#undef PG8_WAIT_L
#undef PG8_BAR
#undef PG8_SCHED
}
}
#define XB_TMO      128
#define XB_XCNT(j)  (256  + 64 * (j))
#define XB_XSUB(j)  (1280 + 64 * (j))
#define XB_XGEN(j)  (2304 + 64 * (j))
#define XB_TOP      3328
#define XB_TOPGEN   3392
#define XCD_BAR_WORDS 3456
#define XB_SPIN_CAP (1u << 18)

__device__ __forceinline__ unsigned xb_ld(unsigned* p)              { return __hip_atomic_load(p, __ATOMIC_RELAXED, __HIP_MEMORY_SCOPE_AGENT); }
__device__ __forceinline__ unsigned xb_add(unsigned* p, unsigned v) { return __hip_atomic_fetch_add(p, v, __ATOMIC_RELAXED, __HIP_MEMORY_SCOPE_AGENT); }
__device__ __forceinline__ unsigned xb_xcc_id() { return (unsigned)__builtin_amdgcn_s_getreg((3 << 11) | 20) & 0xFu; }
#define XB_SPIN(cond, bar) do { unsigned _sp = 0; while (cond) { __builtin_amdgcn_s_sleep(1); \
    if ((++_sp & 255u) == 0u) { if (xb_ld(&(bar)[XB_TMO])) break; if (_sp > XB_SPIN_CAP) { atomicAdd(&(bar)[XB_TMO], 1u); break; } } } } while (0)

struct XcdBarrier {
    unsigned* bar; unsigned x;
    volatile LAS unsigned* st;
    int w;
};

__device__ __forceinline__ bool xb_leader(int w) { unsigned l; asm volatile("v_mbcnt_lo_u32_b32 %0, -1, 0\n\tv_mbcnt_hi_u32_b32 %0, -1, %0" : "=v"(l)); return w == 0 && l == 0u; }
__device__ __forceinline__ XcdBarrier xcd_barrier_post(unsigned* bar, volatile LAS unsigned* st, int wave) {
    XcdBarrier b; b.bar = bar; b.x = xb_xcc_id(); b.st = st; b.w = wave;
    if (xb_leader(wave)) (void)xb_add(&bar[XB_XCNT(b.x)], 1u);
    return b;
}
__device__ __forceinline__ void xcd_barrier_complete(unsigned* bar, unsigned x, unsigned& nloc, unsigned& nx) {
    const unsigned G = gridDim.x * gridDim.y * gridDim.z;
    unsigned sum, cnt, mine, sp = 0u;
    for (;;) {
        sum = 0u; cnt = 0u; mine = 0u;
#pragma unroll
        for (unsigned j = 0; j < 16; ++j) { const unsigned c = xb_ld(&bar[XB_XCNT(j)]); sum += c; cnt += (c > 0u) ? 1u : 0u; mine = (j == x) ? c : mine; }
        if (sum == G) break;
        __builtin_amdgcn_s_sleep(1);
        if ((++sp & 255u) == 0u) { if (xb_ld(&bar[XB_TMO])) break; if (sp > XB_SPIN_CAP) { atomicAdd(&bar[XB_TMO], 1u); break; } }
    }
    nloc = mine > 0u ? mine : 1u; nx = cnt > 0u ? cnt : 1u;
}

__device__ __forceinline__ void xcd_barrier(const XcdBarrier& b) {
    asm volatile("s_waitcnt vmcnt(0)" ::: "memory");
    __syncthreads();
    if (xb_leader(b.w)) {
        unsigned* bar = b.bar;
        __builtin_amdgcn_s_waitcnt(0);
        unsigned nloc = b.st[0], nx = b.st[1];
        if (nloc == 0u) { xcd_barrier_complete(bar, b.x, nloc, nx); b.st[0] = nloc; b.st[1] = nx; }
        const unsigned old = xb_add(&bar[XB_XSUB(b.x)], 1u);
        const unsigned gen = old / nloc;
        if (old + 1u == (gen + 1u) * nloc) {
            __builtin_amdgcn_fence(__ATOMIC_RELEASE, "agent");
            asm volatile("s_waitcnt vmcnt(0)" ::: "memory");
            const unsigned og = xb_add(&bar[XB_TOP], 1u);
            const unsigned tg = og / nx;
            if (og + 1u == (tg + 1u) * nx) xb_add(&bar[XB_TOPGEN], 1u);
            else XB_SPIN(xb_ld(&bar[XB_TOPGEN]) == tg, bar);
            __builtin_amdgcn_fence(__ATOMIC_ACQUIRE, "agent");
            xb_add(&bar[XB_XGEN(b.x)], 1u);
            asm volatile("s_waitcnt vmcnt(0)" ::: "memory");
        } else {
            XB_SPIN(xb_ld(&bar[XB_XGEN(b.x)]) == gen, bar);
            __builtin_amdgcn_fence(__ATOMIC_ACQUIRE, "agent");
            asm volatile("s_waitcnt vmcnt(0)" ::: "memory");
        }
    }
    __syncthreads();
}
namespace da {
constexpr int SLOT_K = 8192, SLOT_V = 16384;
constexpr int LDS_K = 0, LDS_V = 3 * SLOT_K;
constexpr int LDS_BIAS = LDS_V + 3 * SLOT_V;
constexpr int TAB_NR = BIAS_TAB - 4, TAB_CL = 2304;
constexpr int LDS_TREV = LDS_BIAS + BIAS_TAB * 4;
constexpr int LDS_FLAG = LDS_TREV + 4 * TAB_CL * 4;
constexpr int LDS_END = LDS_FLAG + 16;
static_assert(LDS_END <= RING_BYTES && (LDS_TREV % 16) == 0 && (TAB_NR % 4) == 0, "attention LDS map");
constexpr float THR = 8.f;
__device__ __forceinline__ int crow(int r, int hi) { return (r & 3) + 8 * (r >> 2) + 4 * hi; }
__device__ __forceinline__ void glds16(const void* gbase  , unsigned voff  , unsigned lds_dst) { unsigned keep;
    asm volatile("s_mov_b32 %0, m0\n\ts_mov_b32 m0, %3\n\ts_nop 0\n\tglobal_load_lds_dwordx4 %1, %2\n\ts_mov_b32 m0, %0" : "=&s"(keep) : "v"(voff), "s"(gbase), "s"(lds_dst) : "memory"); }
typedef short v4i16_t __attribute__((ext_vector_type(4)));
__device__ __forceinline__ s16x4 vtr(const LAS char* p) { return __builtin_bit_cast(s16x4, __builtin_amdgcn_ds_read_tr16_b64_v4i16((LAS v4i16_t*)p)); }

struct Tensors { const bf16* Qd; const bf16* Kd; const bf16* Vd; float* stash; bf16* ya; const float* dlam; const float* subg; const float* relb; };

#define DA_SBAR() __builtin_amdgcn_sched_barrier(0)
#define DA_PIN(x) asm volatile("" : "+v"(x))
#define DA_MFMA(a, b, c) __builtin_amdgcn_mfma_f32_32x32x16_bf16(a, b, c, 0, 0, 0)
#define DA_MX3(a, b, c) __builtin_fmaxf(__builtin_fmaxf((a), (b)), (c))
__device__ __forceinline__ float rowmax(const f32x16& p0, const f32x16& p1) {
    float a = DA_MX3(p0[0], p0[1], p1[0]), b = DA_MX3(p0[2], p0[3], p1[1]); a = DA_MX3(a, p1[2], p1[3]);
#pragma unroll
    for (int r = 4; r < 16; r += 4) { a = DA_MX3(a, p0[r], p0[r + 1]); b = DA_MX3(b, p0[r + 2], p0[r + 3]); a = DA_MX3(a, p1[r], p1[r + 1]); b = DA_MX3(b, p1[r + 2], p1[r + 3]); }
    float mx = __builtin_fmaxf(a, b); auto rr = __builtin_amdgcn_permlane32_swap(__float_as_uint(mx), __float_as_uint(mx), false, false);
    return __builtin_fmaxf(__uint_as_float(rr[0]), __uint_as_float(rr[1])); }

#define DA_TABINIT(N0, N1, T_) do { int base_ = qabs - 64 * (T_) - 4 * hi + BIAS_GUARD; asm volatile("" : "+v"(base_)); \
        _Pragma("unroll") for (int r = 0; r < 16; ++r) { const int o_ = (r & 3) + 8 * (r >> 2); N0[r] = tb[base_ - o_] - m; N1[r] = tb[base_ - o_ - 32] - m; } } while (0)
#define DA_TREV4(N, j, off) do { const f32x4 t4_ = *(const LAS f32x4*)(ta_ + (off)); N[4 * (j)] = t4_[0]; N[4 * (j) + 1] = t4_[1]; N[4 * (j) + 2] = t4_[2]; N[4 * (j) + 3] = t4_[3]; } while (0)
#define DA_TREVINIT(N0, N1, T_) do { const LAS char* ta_ = trev0 + 256 * (T_); DA_TREV4(N0, 0, 0); DA_TREV4(N0, 1, 32); DA_TREV4(N0, 2, 64); DA_TREV4(N0, 3, 96); \
        DA_TREV4(N1, 0, 128); DA_TREV4(N1, 1, 160); DA_TREV4(N1, 2, 192); DA_TREV4(N1, 3, 224); } while (0)
#define DA_NEARINIT(N0, N1, T_) do { if (OPT) DA_TREVINIT(N0, N1, T_); else DA_TABINIT(N0, N1, T_); } while (0)
#define DA_MASK(C0, C1, T_) do { int base_ = qabs - 64 * (T_) - 4 * hi + BIAS_GUARD; asm volatile("" : "+v"(base_)); \
        _Pragma("unroll") for (int r = 0; r < 16; ++r) { const int o_ = (r & 3) + 8 * (r >> 2); if (base_ - o_ < BIAS_GUARD) C0[r] = -1e30f; if (base_ - o_ - 32 < BIAS_GUARD) C1[r] = -1e30f; } } while (0)
#define DA_FAR(T_) ((q0 - 64 * (T_) - 63) >= DFAR)
#define DA_PKW(P, i) cvtpk(P[i], P[(i) + 1])
#define DA_PAF(k) __builtin_bit_cast(bf16x8, pw[k])
#define DA_VOFF(g) ((2 * ((g) >> 3) + ((g) & 1)) * 4096 + (((g) >> 1) & 3) * 1024)
#define DA_VRD(g) do { vl[(g) % 5] = vtr(vp_ + DA_VOFF(g)); vh[(g) % 5] = vtr(vp_ + DA_VOFF(g) + 512); } while (0)
#define DA_VFR(g) (bf16x8){vl[(g) % 5][0], vl[(g) % 5][1], vl[(g) % 5][2], vl[(g) % 5][3], vh[(g) % 5][0], vh[(g) % 5][1], vh[(g) % 5][2], vh[(g) % 5][3]}
#define DA_KRD(G, j) do { if (G) kf[j] = *(const LAS bf16x8*)(kp_ + ((j) >> 1) * 2048 + ((j) & 1) * 512); } while (0)
#define DA_GAPA(MF, a0, a1, a2, a3, W0, W1, PW, G, j) do { MF; DA_KRD(G, j); sacc += a0; sacc += a1; sacc += a2; sacc += a3; W0; W1; DA_PIN(PW); DA_PIN(sacc); DA_SBAR(); } while (0)
#define DA_GAPB(g, X, i) do { o[2 * ((g) >> 3) + ((g) & 1)] = DA_MFMA(DA_VFR(g), DA_PAF(((g) >> 1) & 3), o[2 * ((g) >> 3) + ((g) & 1)]); \
        X[i] = __builtin_amdgcn_exp2f(X[i]); X[(i) + 1] = __builtin_amdgcn_exp2f(X[(i) + 1]); DA_PIN(X); DA_SBAR(); } while (0)
#define DA_STEP(OPT, C0, C1, P0, P1, T_, MASK, GK, GV, GL, FARV, NEARN) do { DA_SBAR(); const int t_ = (T_); \
    const LAS char* vp_ = vp0 + sl_prev * SLOT_V; const LAS char* kp_ = kp0 + sl_next * SLOT_K; const LAS char* ta_ = trev0 + 256 * (t_ + 1); (void)ta_; \
    if (!OPT && FARV) { const float cm_ = c31 - m; _Pragma("unroll") for (int r = 0; r < 16; ++r) { C0[r] = cm_; C1[r] = cm_; } }     \
    float sacc = P0[0] + P0[1]; \
                       DA_GAPA(C0 = DA_MFMA(kf[0], qr[0], (OPT && FARV) ? cinit : C0), P0[2], P0[3], P0[4], P0[5],     pw[0][0] = DA_PKW(P0, 0),  pw[0][1] = DA_PKW(P0, 2),  pw[0], GL, 0); \
                       DA_GAPA(C1 = DA_MFMA(kf[1], qr[0], (OPT && FARV) ? cinit : C1), P0[6], P0[7], P0[8], P0[9],     pw[0][2] = DA_PKW(P0, 4),  pw[0][3] = DA_PKW(P0, 6),  pw[0], GL, 1); \
                       DA_GAPA(C0 = DA_MFMA(kf[2], qr[1], C0),               P0[10], P0[11], P0[12], P0[13], pw[1][0] = DA_PKW(P0, 8),  pw[1][1] = DA_PKW(P0, 10), pw[1], GL, 2); \
                       DA_GAPA(C1 = DA_MFMA(kf[3], qr[1], C1),               P0[14], P0[15], P1[0], P1[1],   pw[1][2] = DA_PKW(P0, 12), pw[1][3] = DA_PKW(P0, 14), pw[1], GL, 3); \
                       DA_GAPA(C0 = DA_MFMA(kf[4], qr[2], C0),               P1[2], P1[3], P1[4], P1[5],     pw[2][0] = DA_PKW(P1, 0),  pw[2][1] = DA_PKW(P1, 2),  pw[2], GL, 4); \
                       DA_GAPA(C1 = DA_MFMA(kf[5], qr[2], C1),               P1[6], P1[7], P1[8], P1[9],     pw[2][2] = DA_PKW(P1, 4),  pw[2][3] = DA_PKW(P1, 6),  pw[2], GL, 5); \
                       DA_GAPA(C0 = DA_MFMA(kf[6], qr[3], C0),               P1[10], P1[11], P1[12], P1[13], pw[3][0] = DA_PKW(P1, 8),  pw[3][1] = DA_PKW(P1, 10), pw[3], GL, 6); \
                       DA_GAPA(C1 = DA_MFMA(kf[7], qr[3], C1),               P1[14], P1[15], 0.f, 0.f,       pw[3][2] = DA_PKW(P1, 12), pw[3][3] = DA_PKW(P1, 14), pw[3], GL, 7); \
    DA_VRD(0); DA_VRD(1); DA_VRD(2); DA_VRD(3); DA_SBAR();                                       \
    l += sacc; \
    if (GK) DA_DMA_K(t_ + 3, sl_cur); if (GV) DA_DMA_V(t_ + 1, sl_next);                         \
    if (MASK) { if (t_ >= NT - 4) DA_MASK(C0, C1, t_); } \
    if (!OPT) { const float rm_ = rowmax(C0, C1); resc = false; \
      if (__builtin_expect(__any(rm_ > THR), 0)) { const float dl_ = __builtin_fmaxf(rm_, 0.f); m += dl_; fsc = __builtin_amdgcn_exp2f(-dl_); l *= fsc; resc = true; \
          _Pragma("unroll") for (int r = 0; r < 16; ++r) { C0[r] -= dl_; C1[r] -= dl_; } \
          } } \
    DA_SBAR(); \
    DA_VRD(4);                  DA_SBAR(); DA_GAPB(0, C0, 0); \
    DA_VRD(5);                  DA_SBAR(); DA_GAPB(1, C0, 2); \
    DA_VRD(6);                  DA_SBAR(); DA_GAPB(2, C0, 4); \
    DA_VRD(7);                  DA_SBAR(); DA_GAPB(3, C0, 6); \
    DA_VRD(8);                  DA_SBAR(); DA_GAPB(4, C0, 8); \
    DA_VRD(9);                  DA_SBAR(); DA_GAPB(5, C0, 10); \
    DA_VRD(10);                 DA_SBAR(); DA_GAPB(6, C0, 12); \
    DA_VRD(11);                 DA_SBAR(); DA_GAPB(7, C0, 14); \
    DA_VRD(12);                 DA_SBAR(); DA_GAPB(8, C1, 0); \
    DA_VRD(13);                 DA_SBAR(); DA_GAPB(9, C1, 2); \
    DA_VRD(14);                 DA_SBAR(); DA_GAPB(10, C1, 4); \
    DA_VRD(15);                 DA_SBAR(); DA_GAPB(11, C1, 6); \
    if (OPT && NEARN) { DA_TREV4(P0, 0, 0);  DA_TREV4(P0, 1, 32); }  DA_SBAR(); DA_GAPB(12, C1, 8); \
    if (OPT && NEARN) { DA_TREV4(P0, 2, 64); DA_TREV4(P0, 3, 96); }  DA_SBAR(); DA_GAPB(13, C1, 10); \
    if (OPT && NEARN) { DA_TREV4(P1, 0, 128); DA_TREV4(P1, 1, 160); } DA_SBAR(); DA_GAPB(14, C1, 12); \
    if (OPT && NEARN) { DA_TREV4(P1, 2, 192); DA_TREV4(P1, 3, 224); } DA_SBAR(); DA_GAPB(15, C1, 14); \
    if (!OPT && NEARN) DA_TABINIT(P0, P1, t_ + 1); \
    } while (0)
#define DA_RESC() do { if (resc) { _Pragma("unroll") for (int d0 = 0; d0 < 4; ++d0) _Pragma("unroll") for (int r = 0; r < 16; ++r) o[d0][r] *= fsc; } } while (0)
#define DA_WAITB(N) asm volatile("s_waitcnt vmcnt(" #N ") lgkmcnt(0)\n\ts_barrier" ::: "memory")
#define DA_ROT() do { sl_prev = sl_cur; sl_cur = sl_next; sl_next = (sl_next == 2) ? 0 : sl_next + 1; } while (0)
#define DA_ENDW(tt) do { if ((tt) + 3 < NT) { DA_WAITB(3); } else if ((tt) + 2 < NT) { DA_WAITB(2); } else { DA_WAITB(0); } } while (0)

template <bool OPT>
__device__ __forceinline__ void pass(const Tensors& X, int b, int h, int c, const int q0, const int NT, LAS unsigned char* lds, float c31, const int wid, f32x16 (&o)[4], float& l_out) {
    const unsigned lds0 = (unsigned)(uintptr_t)lds;
    const LAS float* tb = (const LAS float*)(lds + LDS_BIAS); (void)tb;
    {
        int lane = (int)__builtin_amdgcn_mbcnt_hi(~0u, __builtin_amdgcn_mbcnt_lo(~0u, 0u)); asm volatile("" : "+v"(lane));
        const int r32 = lane & 31, hi = lane >> 5;
        const unsigned lane16 = (unsigned)lane * 16u;
        const int qabs = q0 + wid * 32 + r32;
        const LAS char* vp0 = (const LAS char*)lds + LDS_V + ((lane >> 4) & 1) * 32 + (lane & 3) * 8 + (4 * hi + ((lane & 15) >> 2)) * 64;
        const LAS char* kp0 = (const LAS char*)lds + LDS_K + hi * 1024 + r32 * 16;
        const LAS char* trev0 = (const LAS char*)lds + LDS_TREV + (r32 & 3) * (TAB_CL * 4) + 4 * (TAB_NR - (qabs - (r32 & 3) - 4 * hi + BIAS_GUARD));
        const int bhc = (b * 4 + h) * 2 + c;
        const bf16* Qw = X.Qd + ((size_t)bhc * SEQ + q0 + wid * 32 + r32) * 64 + hi * 8;
        const char* Kt = (const char*)X.Kd + (size_t)bhc * NTILE * SLOT_K + wid * 1024;
        const char* Vt = (const char*)X.Vd + (size_t)(b * 4 + h) * NTILE * SLOT_V + wid * 1024;
#define DA_DMA_K(t, slot) glds16(Kt + (size_t)(t) * SLOT_K, lane16, (unsigned)__builtin_amdgcn_readfirstlane(lds0 + LDS_K + (slot) * SLOT_K + wid * 1024))
#define DA_DMA_V(t, slot) do { const unsigned sb_ = (unsigned)__builtin_amdgcn_readfirstlane(lds0 + LDS_V + (slot) * SLOT_V + wid * 1024); \
        glds16(Vt + (size_t)(t) * SLOT_V, lane16, sb_); glds16(Vt + (size_t)(t) * SLOT_V + 8192, lane16, sb_ + 8192); } while (0)
        DA_DMA_K(0, 0); DA_DMA_V(0, 0); DA_DMA_K(1, 1); DA_DMA_K(2, 2);
        bf16x8 qr[4];
#pragma unroll
        for (int d0 = 0; d0 < 4; ++d0) qr[d0] = *(const bf16x8*)(Qw + d0 * 16);
#pragma unroll
        for (int d0 = 0; d0 < 4; ++d0)
#pragma unroll
            for (int r = 0; r < 16; ++r) o[d0][r] = 0.f;
        float m = 0.f, l = 0.f, fsc = 1.f; bool resc = false; (void)fsc; (void)resc;
        f32x16 pA0, pA1, pB0, pB1, cinit; bf16x8 kf[8]; s16x4 vl[5], vh[5]; v4u pw[4];
        int sl_prev = 0, sl_cur = 1, sl_next = 2;
        asm volatile("" :: "v"(qr[0]), "v"(qr[1]), "v"(qr[2]), "v"(qr[3]));
        DA_WAITB(4);
        {   const LAS char* kp_ = kp0;
#pragma unroll
            for (int j = 0; j < 8; ++j) DA_KRD(true, j);
            if (DA_FAR(0)) {
#pragma unroll
                for (int r = 0; r < 16; ++r) { pA0[r] = c31; pA1[r] = c31; }
            } else DA_NEARINIT(pA0, pA1, 0);
#pragma unroll
            for (int d0 = 0; d0 < 4; ++d0) { pA0 = DA_MFMA(kf[2 * d0], qr[d0], pA0); pA1 = DA_MFMA(kf[2 * d0 + 1], qr[d0], pA1); }
            if (NT == 4) DA_MASK(pA0, pA1, 0);
            if (!OPT) m = rowmax(pA0, pA1);
#pragma unroll
            for (int r = 0; r < 16; ++r) { pA0[r] = __builtin_amdgcn_exp2f(pA0[r] - m); pA1[r] = __builtin_amdgcn_exp2f(pA1[r] - m); }
        }
        DA_WAITB(0);
        DA_DMA_K(3, 0); DA_DMA_V(1, 1);
        {   const LAS char* kp_ = kp0 + SLOT_K;
#pragma unroll
            for (int j = 0; j < 8; ++j) DA_KRD(true, j);
        }
        DA_WAITB(3);
        {   const float cm = c31 - m;
#pragma unroll
            for (int r = 0; r < 16; ++r) cinit[r] = cm; }
        int t = 1;
        for (; t + 5 < NT && DA_FAR(t + 1); t += 2) {
            DA_STEP(OPT, pB0, pB1, pA0, pA1, t, false, true, true, true, true, false);     DA_WAITB(3); DA_RESC(); DA_ROT();
            DA_STEP(OPT, pA0, pA1, pB0, pB1, t + 1, false, true, true, true, true, false); DA_WAITB(3); DA_RESC(); DA_ROT();
        }
        DA_NEARINIT(pB0, pB1, t);
        for (; t + 5 < NT; t += 2) {
            DA_STEP(OPT, pB0, pB1, pA0, pA1, t, false, true, true, true, false, true);     DA_WAITB(3); DA_RESC(); DA_ROT();
            DA_STEP(OPT, pA0, pA1, pB0, pB1, t + 1, false, true, true, true, false, true); DA_WAITB(3); DA_RESC(); DA_ROT();
        }
        for (; t + 1 < NT; t += 2) {
            DA_STEP(OPT, pB0, pB1, pA0, pA1, t, true, (t + 3 < NT), (t + 1 < NT), (t + 1 < NT), false, true);         DA_ENDW(t);     DA_RESC(); DA_ROT();
            DA_STEP(OPT, pA0, pA1, pB0, pB1, t + 1, true, (t + 4 < NT), (t + 2 < NT), (t + 2 < NT), false, true);     DA_ENDW(t + 1); DA_RESC(); DA_ROT();
        }
        DA_STEP(OPT, pB0, pB1, pA0, pA1, NT - 1, true, false, false, false, false, false); DA_RESC();
        {   float sacc = pB0[0] + pB0[1];
#pragma unroll
            for (int r = 2; r < 16; ++r) sacc += pB0[r];
#pragma unroll
            for (int r = 0; r < 16; ++r) sacc += pB1[r];
            l += sacc;
            pw[0] = (v4u){DA_PKW(pB0, 0), DA_PKW(pB0, 2), DA_PKW(pB0, 4), DA_PKW(pB0, 6)}; pw[1] = (v4u){DA_PKW(pB0, 8), DA_PKW(pB0, 10), DA_PKW(pB0, 12), DA_PKW(pB0, 14)};
            pw[2] = (v4u){DA_PKW(pB1, 0), DA_PKW(pB1, 2), DA_PKW(pB1, 4), DA_PKW(pB1, 6)}; pw[3] = (v4u){DA_PKW(pB1, 8), DA_PKW(pB1, 10), DA_PKW(pB1, 12), DA_PKW(pB1, 14)};
            const LAS char* vb_ = vp0 + sl_cur * SLOT_V;
#pragma unroll
            for (int d0 = 0; d0 < 4; ++d0) {
#pragma unroll
                for (int ks = 0; ks < 4; ++ks) { const s16x4 lo_ = vtr(vb_ + d0 * 4096 + ks * 1024), hh_ = vtr(vb_ + d0 * 4096 + ks * 1024 + 512);
                    const bf16x8 vf_ = (bf16x8){lo_[0], lo_[1], lo_[2], lo_[3], hh_[0], hh_[1], hh_[2], hh_[3]};
                    o[d0] = DA_MFMA(vf_, DA_PAF(ks), o[d0]); }
                DA_SBAR(); }
        }
#undef DA_DMA_K
#undef DA_DMA_V
        l_out = l;
    }
}

__device__ __forceinline__ void unit(const Tensors& X, int b, int h, int qb, LAS unsigned char* lds, int wgslot, float lam, float c31, const int wid  ) {
    const int q0 = qb * 256, NT = 4 * (qb + 1);
    for (int c = 0; c < 2; ++c) {
        int lane = (int)__builtin_amdgcn_mbcnt_hi(~0u, __builtin_amdgcn_mbcnt_lo(~0u, 0u)); asm volatile("" : "+v"(lane));
        LAS unsigned* flag = (LAS unsigned*)(lds + LDS_FLAG);
        if (wid == 0 && lane == 0) *flag = 0u;
        f32x16 o[4]; float l;
        pass<true>(X, b, h, c, q0, NT, lds, c31, wid, o, l);
        { auto rr = __builtin_amdgcn_permlane32_swap(__float_as_uint(l), __float_as_uint(l), false, false); l = __uint_as_float(rr[0]) + __uint_as_float(rr[1]); }
        if (!__all(l > 1e-30f && l < 1e30f)) *flag = 1u;
        asm volatile("s_waitcnt vmcnt(0) lgkmcnt(0)\n\ts_barrier" ::: "memory");
        if (__builtin_expect(*(volatile LAS unsigned*)flag != 0u, 0)) {
            pass<false>(X, b, h, c, q0, NT, lds, c31, wid, o, l);
            { auto rr = __builtin_amdgcn_permlane32_swap(__float_as_uint(l), __float_as_uint(l), false, false); l = __uint_as_float(rr[0]) + __uint_as_float(rr[1]); }
        }
        const float inv = 1.f / l;
        int lane_e = lane; asm volatile("" : "+v"(lane_e));
        GAS unsigned* stg = (GAS unsigned*)((unsigned*)X.stash + ((size_t)(wgslot * 8 + wid) * 32) * 64 + lane_e);
        if (c == 0) {
#pragma unroll
            for (int d0 = 0; d0 < 4; ++d0)
#pragma unroll
                for (int r = 0; r < 16; r += 2) stg[(d0 * 8 + (r >> 1)) * 64] = cvtpk(o[d0][r] * inv, o[d0][r + 1] * inv);
        } else {
            float ss = 0.f;
#pragma unroll
            for (int d0 = 0; d0 < 4; ++d0)
#pragma unroll
                for (int r = 0; r < 16; r += 2) { const unsigned w1 = stg[(d0 * 8 + (r >> 1)) * 64]; const float dv0 = bf_lo(w1) - lam * (o[d0][r] * inv), dv1 = bf_hi(w1) - lam * (o[d0][r + 1] * inv);
                    o[d0][r] = dv0; o[d0][r + 1] = dv1; ss += dv0 * dv0 + dv1 * dv1; if (r == 14) asm volatile("" ::: "memory"); }
            { auto rr = __builtin_amdgcn_permlane32_swap(__float_as_uint(ss), __float_as_uint(ss), false, false); ss = __uint_as_float(rr[0]) + __uint_as_float(rr[1]); }
            const float rn = __builtin_amdgcn_rsqf(ss * (1.f / 128.f) + SUBLN_EPS) * (1.f - LAM_INIT);
            const int hi_e = lane_e >> 5, qabs_e = q0 + wid * 32 + (lane_e & 31);
            bf16* yrow = X.ya + ((size_t)b * SEQ + qabs_e) * 512 + h * 128 + 4 * hi_e; const float* sg = X.subg + 4 * hi_e;
#pragma unroll
            for (int d0 = 0; d0 < 4; ++d0)
#pragma unroll
                for (int r4 = 0; r4 < 4; ++r4) {
                    const int dd = 32 * d0 + 8 * r4; const f32x4 g = *(const f32x4*)(sg + dd);
                    v2u w; w.x = pk2(o[d0][4 * r4] * rn * g[0], o[d0][4 * r4 + 1] * rn * g[1]); w.y = pk2(o[d0][4 * r4 + 2] * rn * g[2], o[d0][4 * r4 + 3] * rn * g[3]);
                    *(v2u*)(yrow + dd) = w;
                }
        }
        asm volatile("s_waitcnt vmcnt(0) lgkmcnt(0)\n\ts_barrier" ::: "memory");
    }
}
#undef DA_STEP
#undef DA_GAPA
#undef DA_GAPB
#undef DA_KRD
#undef DA_VRD
#undef DA_VFR
#undef DA_VOFF
#undef DA_PAF
#undef DA_PKW
#undef DA_FAR
#undef DA_MASK
#undef DA_TREV4
#undef DA_TREVINIT
#undef DA_NEARINIT
#undef DA_TABINIT
#undef DA_RESC
#undef DA_WAITB
#undef DA_ROT
#undef DA_ENDW
#undef DA_MX3
#undef DA_MFMA
#undef DA_PIN
#undef DA_SBAR
}
namespace dil {
constexpr int BT = 1152, BT0 = 512;
constexpr int LDS_VST = 0, LDS_BL = 32768, LDS_END = LDS_BL + 3 * BT * 4;
constexpr float THR = 8.f;
struct Tensors { const bf16* LQ; const bf16* LK; const bf16* LV; bf16* yb; };
typedef short v4i16_t __attribute__((ext_vector_type(4)));
__device__ __forceinline__ s16x4 vtr(const LAS unsigned char* p) { return __builtin_bit_cast(s16x4, __builtin_amdgcn_ds_read_tr16_b64_v4i16((LAS v4i16_t*)p)); }

template <int G_, int QS_> __device__ __forceinline__ void group(const Tensors& X, size_t rowb, int h, int P0, int r, LAS unsigned char* vst, const LAS float* blg, int lane, f32x16 (&o)[2], float& m, float& l) {
    constexpr int DL = (G_ == 0) ? 1 : (G_ == 1) ? 4 : 16, MG = QS_ / DL, NKB = (31 * MG + 128) / 32 + 1;
    static_assert(QS_ % DL == 0, "query stride must be a multiple of the dilation");
    const int i = lane & 31, hi = lane >> 5;
    const int colb = G_ * 256 + h * 64;
    bf16x8 qr[4];
    { const bf16* qp = X.LQ + (rowb + P0 + r + QS_ * i) * 768 + colb + hi * 8;
#pragma unroll
      for (int d0 = 0; d0 < 4; ++d0) qr[d0] = *(const bf16x8*)(qp + 16 * d0); }
    const int kpos0 = P0 + r - 128 * DL;
    const LAS unsigned char* vrd = vst + ((lane >> 4) & 1) * 32 + (lane & 3) * 8 + (4 * hi + ((lane & 15) >> 2)) * 64;
#define DIL_LOAD(KF, VR, KB) do { \
        { int kpos_ = kpos0 + (32 * (KB) + i) * DL; kpos_ = kpos_ < 0 ? 0 : (kpos_ > SEQ - 1 ? SEQ - 1 : kpos_); const bf16* kp_ = X.LK + (rowb + kpos_) * 768 + colb + hi * 8; \
          _Pragma("unroll") for (int d0 = 0; d0 < 4; ++d0) KF[d0] = *(const bf16x8*)(kp_ + 16 * d0); } \
        _Pragma("unroll") for (int t = 0; t < 4; ++t) { const int qd = lane + 64 * t, key = qd >> 3, ch = qd & 7; int vpos_ = kpos0 + (32 * (KB) + key) * DL; vpos_ = vpos_ < 0 ? 0 : (vpos_ > SEQ - 1 ? SEQ - 1 : vpos_); \
            VR[t] = *(const v4u*)(X.LV + (rowb + vpos_) * 768 + colb + ch * 8); } } while (0)
    bf16x8 kfn[4]; v4u vregn[4];
    DIL_LOAD(kfn, vregn, 0);
#pragma unroll 1
    for (int kb = 0; kb < NKB; ++kb) {
        bf16x8 kf[4]; v4u vreg[4];
#pragma unroll
        for (int d0 = 0; d0 < 4; ++d0) { kf[d0] = kfn[d0]; vreg[d0] = vregn[d0]; }
        if (kb + 1 < NKB) DIL_LOAD(kfn, vregn, kb + 1);
        const int jb = i * MG + 128 - 32 * kb - 4 * hi;
        f32x16 p;
#pragma unroll
        for (int rr = 0; rr < 16; ++rr) p[rr] = blg[jb - ((rr & 3) + 8 * (rr >> 2)) + BT0];
#pragma unroll
        for (int d0 = 0; d0 < 4; ++d0) p = __builtin_amdgcn_mfma_f32_32x32x16_bf16(kf[d0], qr[d0], p, 0, 0, 0);
        const int cb = 32 * kb + 4 * hi;
#pragma unroll
        for (int rr = 0; rr < 16; ++rr) { const int o_ = (rr & 3) + 8 * (rr >> 2); if ((unsigned)(jb - o_) > 128u || kpos0 + (cb + o_) * DL < 0) p[rr] = -3e38f; }
        float rm = p[0];
#pragma unroll
        for (int rr = 1; rr < 16; ++rr) rm = fmaxf(rm, p[rr]);
        { auto sw = __builtin_amdgcn_permlane32_swap(__float_as_uint(rm), __float_as_uint(rm), false, false); rm = fmaxf(__uint_as_float(sw[0]), __uint_as_float(sw[1])); }
        if (__any(rm > m + THR)) {
            const float mn = fmaxf(m, rm), f = __builtin_amdgcn_exp2f(m - mn);
#pragma unroll
            for (int d0 = 0; d0 < 2; ++d0)
#pragma unroll
                for (int rr = 0; rr < 16; ++rr) o[d0][rr] *= f;
            l *= f; m = mn;
        }
        float ls = 0.f;
#pragma unroll
        for (int rr = 0; rr < 16; ++rr) { p[rr] = __builtin_amdgcn_exp2f(p[rr] - m); ls += p[rr]; }
        l += ls;
        bf16x8 pw[2];
        { v4u w;
          w.x = cvtpk(p[0], p[1]); w.y = cvtpk(p[2], p[3]); w.z = cvtpk(p[4], p[5]); w.w = cvtpk(p[6], p[7]); pw[0] = __builtin_bit_cast(bf16x8, w);
          w.x = cvtpk(p[8], p[9]); w.y = cvtpk(p[10], p[11]); w.z = cvtpk(p[12], p[13]); w.w = cvtpk(p[14], p[15]); pw[1] = __builtin_bit_cast(bf16x8, w); }
#pragma unroll
        for (int t = 0; t < 4; ++t) { const int qd = lane + 64 * t, key = qd >> 3, ch = qd & 7;
            *(LAS v4u*)(vst + ((ch >> 2) * 2 + (key >> 4)) * 1024 + (key & 15) * 64 + (ch & 3) * 16) = vreg[t]; }
        asm volatile("s_waitcnt lgkmcnt(0)" ::: "memory");
#pragma unroll
        for (int d0 = 0; d0 < 2; ++d0)
#pragma unroll
            for (int ks = 0; ks < 2; ++ks) {
                const s16x4 lo = vtr(vrd + (d0 * 2 + ks) * 1024), hh = vtr(vrd + (d0 * 2 + ks) * 1024 + 512);
                const bf16x8 vf = (bf16x8){lo[0], lo[1], lo[2], lo[3], hh[0], hh[1], hh[2], hh[3]};
                o[d0] = __builtin_amdgcn_mfma_f32_32x32x16_bf16(vf, pw[ks], o[d0], 0, 0, 0);
            }
        asm volatile("s_waitcnt lgkmcnt(0)" ::: "memory");
    }
#undef DIL_LOAD
}
__device__ __forceinline__ void wave_tile_g0(const Tensors& X, float* lse0, int b, int h, int P0, LAS unsigned char* vst, const LAS float* bl, int lane) {
    const size_t rowb = (size_t)b * SEQ;
    f32x16 o[2];
#pragma unroll
    for (int d0 = 0; d0 < 2; ++d0)
#pragma unroll
        for (int rr = 0; rr < 16; ++rr) o[d0][rr] = 0.f;
    float m = -1e30f, l = 0.f;
    group<0, 1>(X, rowb, h, P0, 0, vst, bl, lane, o, m, l);
    { auto sw = __builtin_amdgcn_permlane32_swap(__float_as_uint(l), __float_as_uint(l), false, false); l = __uint_as_float(sw[0]) + __uint_as_float(sw[1]); }
    const float inv = 1.f / l; const int i = lane & 31, hi = lane >> 5;
    bf16* yrow = X.yb + (rowb + P0 + i) * 256 + h * 64 + 4 * hi;
#pragma unroll
    for (int d0 = 0; d0 < 2; ++d0)
#pragma unroll
        for (int r4 = 0; r4 < 4; ++r4) { v2u w; w.x = pk2(o[d0][4 * r4] * inv, o[d0][4 * r4 + 1] * inv); w.y = pk2(o[d0][4 * r4 + 2] * inv, o[d0][4 * r4 + 3] * inv); *(v2u*)(yrow + 32 * d0 + 8 * r4) = w; }
    if (hi == 0) lse0[(rowb + P0 + i) * 4 + h] = m + __builtin_amdgcn_logf(l);
}
__device__ __forceinline__ void wave_tile(const Tensors& X, const float* lse0, int b, int h, int P0, int r, LAS unsigned char* vst, const LAS float* bl, int lane) {
    const size_t rowb = (size_t)b * SEQ;
    f32x16 o[2];
#pragma unroll
    for (int d0 = 0; d0 < 2; ++d0)
#pragma unroll
        for (int rr = 0; rr < 16; ++rr) o[d0][rr] = 0.f;
    float m = -1e30f, l = 0.f;
    group<1, 16>(X, rowb, h, P0, r, vst, bl + BT, lane, o, m, l);
    group<2, 16>(X, rowb, h, P0, r, vst, bl + 2 * BT, lane, o, m, l);
    { auto sw = __builtin_amdgcn_permlane32_swap(__float_as_uint(l), __float_as_uint(l), false, false); l = __uint_as_float(sw[0]) + __uint_as_float(sw[1]); }
    const int i = lane & 31, hi = lane >> 5;
    const float w0 = __builtin_amdgcn_exp2f(lse0[(rowb + P0 + r + 16 * i) * 4 + h] - m);
    const float inv = 1.f / (l + w0);
    bf16* yrow = X.yb + (rowb + P0 + r + 16 * i) * 256 + h * 64 + 4 * hi;
#pragma unroll
    for (int d0 = 0; d0 < 2; ++d0)
#pragma unroll
        for (int r4 = 0; r4 < 4; ++r4) { const v2u g0 = *(const v2u*)(yrow + 32 * d0 + 8 * r4);
            v2u w; w.x = pk2((o[d0][4 * r4] + w0 * bf_lo(g0.x)) * inv, (o[d0][4 * r4 + 1] + w0 * bf_hi(g0.x)) * inv); w.y = pk2((o[d0][4 * r4 + 2] + w0 * bf_lo(g0.y)) * inv, (o[d0][4 * r4 + 3] + w0 * bf_hi(g0.y)) * inv);
            *(v2u*)(yrow + 32 * d0 + 8 * r4) = w; }
}
}
__device__ __forceinline__ void p0_transpose_item(const float* W, int K, int N, bf16* WT, LAS float* scr, int item, int lane) {
    const int nblk = N / 32, kb = item / nblk, nb = item % nblk, k0 = 64 * kb, n0 = 32 * nb;
#pragma unroll 8
    for (int i = 0; i < 32; ++i) { const int kk = 2 * i + (lane >> 5); scr[kk * 33 + (lane & 31)] = W[(size_t)(k0 + kk) * N + n0 + (lane & 31)]; }
    LDS_WAIT(); asm volatile("" ::: "memory");
    const int c = lane & 7;
#pragma unroll
    for (int j = 0; j < 4; ++j) { const int n = (lane >> 3) + 8 * j; const LAS float* s = scr + (8 * c) * 33 + n;
        v4u o; o.x = pk2(s[0 * 33], s[1 * 33]); o.y = pk2(s[2 * 33], s[3 * 33]); o.z = pk2(s[4 * 33], s[5 * 33]); o.w = pk2(s[6 * 33], s[7 * 33]);
        *(v4u*)(WT + (size_t)(n0 + n) * K + k0 + 8 * c) = o; }
    LDS_WAIT(); asm volatile("" ::: "memory");
}
__device__ __forceinline__ void cast_bf16(const float* src, bf16* dst, size_t n8, size_t gtid, size_t gthreads) {
    for (size_t i = gtid; i < n8; i += gthreads) { const f32x4 a = *(const f32x4*)(src + i * 8), b = *(const f32x4*)(src + i * 8 + 4);
        v4u o; o.x = pk2(a[0], a[1]); o.y = pk2(a[2], a[3]); o.z = pk2(b[0], b[1]); o.w = pk2(b[2], b[3]); *(v4u*)(dst + i * 8) = o; }
}

struct Args { const float* in[16]; float* out; unsigned char* ws; int ph_lo, ph_hi; };
enum { I_X = 0, I_WIN, I_DLAM, I_SUBG, I_WBD, I_WBL, I_WO, I_LN1G, I_LN1B, I_PWQ, I_PKEYS, I_PU, I_PV, I_LN2G, I_LN2B, I_RELB };

__device__ __forceinline__ void p0_prologue(const Args& A, LAS unsigned char* lds, int vcu, int G, int wave, int lane) {
    unsigned char* ws = A.ws;
    const int gw = vcu * NWAVES + wave, NGW = G * NWAVES;
    const size_t gtid = (size_t)gw * 64 + lane, gthreads = (size_t)NGW * 64;
    LAS float* scr = (LAS float*)(lds + wave * 16384);
    constexpr int I_IN = (D / 64) * (INC / 32), I_BD = (512 / 64) * (D / 32), I_BL = (256 / 64) * (D / 32), I_O = (D / 64) * (D / 32);
    for (int it0 = gw; it0 < (I_IN + I_BD + I_BL + I_O) * NREP(32); it0 += NGW) {
        int r = it0 % (I_IN + I_BD + I_BL + I_O);
        if (r < I_IN) { p0_transpose_item(A.in[I_WIN], D, INC, (bf16*)(ws + WS_WIN), scr, r, lane); continue; } r -= I_IN;
        if (r < I_BD) { p0_transpose_item(A.in[I_WBD], 512, D, (bf16*)(ws + WS_WBD), scr, r, lane); continue; } r -= I_BD;
        if (r < I_BL) { p0_transpose_item(A.in[I_WBL], 256, D, (bf16*)(ws + WS_WBL), scr, r, lane); continue; } r -= I_BL;
        p0_transpose_item(A.in[I_WO], D, D, (bf16*)(ws + WS_WO), scr, r, lane);
    }
    for (int rep_ = 0; rep_ < NREP(31); ++rep_) cast_bf16(A.in[I_X], (bf16*)(ws + WS_A), (size_t)T * D / 8, gtid, gthreads);
    { const float* wq = A.in[I_PWQ]; const float* keys = A.in[I_PKEYS]; bf16* wp = (bf16*)(ws + WS_WP);
      for (int it0 = gw; it0 < 1024 * NREP(30); it0 += NGW) { const int it = it0 & 1023;
          const int hc = it >> 6, jb = (it >> 2) & 15, nq = it & 3, j = jb * 64 + lane;
          const f32x4* wr_ = (const f32x4*)(wq + (size_t)j * 2048 + hc * 128);
          f32x4 w[32];
#pragma unroll
          for (int d = 0; d < 32; ++d) w[d] = wr_[d];
#pragma unroll 1
          for (int n = nq * 32; n < nq * 32 + 32; ++n) {
              const f32x4* kr = (const f32x4*)(keys + (size_t)(hc * 128 + n) * 128);
              float a0 = 0.f, a1 = 0.f, a2 = 0.f, a3 = 0.f;
#pragma unroll
              for (int d = 0; d < 32; ++d) { const f32x4 k = kr[d]; a0 += w[d][0] * k[0]; a1 += w[d][1] * k[1]; a2 += w[d][2] * k[2]; a3 += w[d][3] * k[3]; }
              wp[(size_t)(hc * 128 + n) * 1024 + j] = (bf16)f2bf((a0 + a1) + (a2 + a3));
          }
      } }
    { const float* relb = A.in[I_RELB]; float* bd = (float*)(ws + WS_BIASD); float* bl = (float*)(ws + WS_BIASL);
      for (size_t i = gtid; i < 4 * BIAS_TAB; i += gthreads) { const int h = (int)(i / BIAS_TAB), dist = (int)(i % BIAS_TAB) - BIAS_GUARD; bd[i] = dist < 0 ? 0.f : relb[rel_bucket(dist) * 16 + h] * LOG2E; }
      for (size_t i = gtid; i < 12 * 132; i += gthreads) { const int gh = (int)(i / 132), j = (int)(i % 132), g = gh >> 2; const int dl = (g == 0) ? 1 : (g == 1) ? 4 : 16;
          bl[i] = relb[rel_bucket((j > 128 ? 128 : j) * dl) * 16 + 4 + gh] * LOG2E; } }
}

__device__ __forceinline__ void p5_ln1(const Args& A, int vcu, int G, int wave, int lane) {
    unsigned char* ws = A.ws;
    const int gw = vcu * NWAVES + wave, NGW = G * NWAVES;
    const float* R = (const float*)(ws + WS_R); bf16* x1b = (bf16*)(ws + WS_A);
    const float* gam = A.in[I_LN1G]; const float* bet = A.in[I_LN1B];
    f32x4 gv[4], bv[4];
#pragma unroll
    for (int j = 0; j < 4; ++j) { gv[j] = *(const f32x4*)(gam + 256 * j + 4 * lane); bv[j] = *(const f32x4*)(bet + 256 * j + 4 * lane); }
    f32x4 nx[4];
    if (gw < T) {
#pragma unroll
        for (int j = 0; j < 4; ++j) nx[j] = ((const f32x4*)(R + (size_t)gw * D) + lane)[64 * j]; }
#pragma unroll 1
    for (int mrow = gw; mrow < T; mrow += NGW) {
        f32x4 v[4]; float s = 0.f;
#pragma unroll
        for (int j = 0; j < 4; ++j) { v[j] = nx[j]; s += (v[j][0] + v[j][1]) + (v[j][2] + v[j][3]); }
        if (mrow + NGW < T) {
#pragma unroll
            for (int j = 0; j < 4; ++j) nx[j] = ((const f32x4*)(R + (size_t)(mrow + NGW) * D) + lane)[64 * j]; }
        const float mean = wave_sum(s) * (1.f / D); float s2 = 0.f;
#pragma unroll
        for (int j = 0; j < 4; ++j) { v[j] = v[j] - mean; s2 += (v[j][0] * v[j][0] + v[j][1] * v[j][1]) + (v[j][2] * v[j][2] + v[j][3] * v[j][3]); }
        const float rstd = __builtin_amdgcn_rsqf(wave_sum(s2) * (1.f / D) + LN_EPS);
        v2u* brow = (v2u*)(x1b + (size_t)mrow * D) + lane;
#pragma unroll
        for (int j = 0; j < 4; ++j) { const f32x4 y = v[j] * rstd * gv[j] + bv[j]; v2u w; w.x = pk2(y[0], y[1]); w.y = pk2(y[2], y[3]); brow[64 * j] = w; }
    }
}
namespace peer {
__device__ __forceinline__ int mono(float v) { const int b = __float_as_int(v); return b ^ ((b >> 31) & 0x7fffffff); }
__device__ __forceinline__ float unmono(int k) { return __int_as_float(k ^ ((k >> 31) & 0x7fffffff)); }
__device__ __forceinline__ int med3i(int a, int b, int c) { int r; asm("v_med3_i32 %0, %1, %2, %3" : "=v"(r) : "v"(a), "v"(b), "v"(c)); return r; }
#define PEER_INS16(a, x) do { _Pragma("unroll") for (int k_ = 15; k_ >= 1; --k_) a[k_] = med3i(a[k_ - 1], a[k_], (x)); a[0] = max(a[0], (x)); } while (0)
__device__ __forceinline__ unsigned byte_sel(const unsigned (&p)[4], int i) { const int w = i >> 2; const unsigned x = (w == 0) ? p[0] : (w == 1) ? p[1] : (w == 2) ? p[2] : p[3]; return (x >> ((i & 3) * 8)) & 0xffu; }
__device__ __forceinline__ float gelu_erf(float v) { return 0.5f * v * (1.f + erff(v * 0.7071067811865476f)); }

__device__ __forceinline__ void select(const float* ST, v2u* sel, int tok, int head) {
    int a0[16], a1[16];
#pragma unroll
    for (int k = 0; k < 16; ++k) { a0[k] = (int)0x80000000; a1[k] = (int)0x80000000; }
    const float* s0 = ST + (size_t)(head * 256) * T + tok; const float* s1 = s0 + (size_t)128 * T;
    float c0[8], c1[8];
#pragma unroll
    for (int i = 0; i < 8; ++i) { c0[i] = s0[(size_t)i * T]; c1[i] = s1[(size_t)i * T]; }
#pragma unroll 1
    for (int n = 0; n < 128; n += 8) {
        float x0[8], x1[8];
#pragma unroll
        for (int i = 0; i < 8; ++i) { x0[i] = c0[i]; x1[i] = c1[i]; }
        if (n + 8 < 128) {
#pragma unroll
            for (int i = 0; i < 8; ++i) { c0[i] = s0[(size_t)(n + 8 + i) * T]; c1[i] = s1[(size_t)(n + 8 + i) * T]; }
        }
#pragma unroll
        for (int i = 0; i < 8; ++i) { const int k0 = (mono(x0[i]) & ~127) | (127 - (n + i)), k1 = (mono(x1[i]) & ~127) | (127 - (n + i)); PEER_INS16(a0, k0); PEER_INS16(a1, k1); }
    }
    float v0[16], v1[16]; unsigned i0p[4] = {0u, 0u, 0u, 0u}, i1p[4] = {0u, 0u, 0u, 0u};
#pragma unroll
    for (int k = 0; k < 16; ++k) { v0[k] = unmono((a0[k] & ~127) | 64); v1[k] = unmono((a1[k] & ~127) | 64);
        i0p[k >> 2] |= (unsigned)(127 - (a0[k] & 127)) << (8 * (k & 3)); i1p[k >> 2] |= (unsigned)(127 - (a1[k] & 127)) << (8 * (k & 3)); }
    int cd[16];
#pragma unroll
    for (int k = 0; k < 16; ++k) cd[k] = (int)0x80000000;
#pragma unroll
    for (int i = 0; i < 16; ++i)
#pragma unroll
        for (int j = 0; j < 16; ++j)
            if ((i + 1) * (j + 1) <= 16) { const int k = (mono(v0[i] + v1[j]) & ~255) | (255 - (i * 16 + j)); PEER_INS16(cd, k); }
    float sv[16], ex[16], sum = 0.f; unsigned eid[16];
#pragma unroll
    for (int k = 0; k < 16; ++k) { const int code = 255 - (cd[k] & 255); eid[k] = byte_sel(i0p, code >> 4) * 128u + byte_sel(i1p, code & 15); sv[k] = unmono((cd[k] & ~255) | 128); }
#pragma unroll
    for (int k = 0; k < 16; ++k) { ex[k] = __expf(sv[k] - sv[0]); sum += ex[k]; }
    const float rs = 1.f / sum;
    v4u* dst = (v4u*)(sel + ((size_t)tok * 8 + head) * 16);
#pragma unroll
    for (int k = 0; k < 8; ++k) { v4u w; w.x = eid[2 * k]; w.y = __float_as_uint(ex[2 * k] * rs); w.z = eid[2 * k + 1]; w.w = __float_as_uint(ex[2 * k + 1] * rs); dst[k] = w; }
}

typedef float f32x2w __attribute__((ext_vector_type(2)));
struct G4 { const unsigned char* U8; const unsigned char* V8; const float* isu; const float* isv; };
__device__ __forceinline__ v2u peer_ec(const v2u lo, const v2u hi, int c) { const unsigned mk = (c < 4) ? 0xffffffffu : 0u; v2u r; r.x = (lo.x & mk) | (hi.x & ~mk); r.y = (lo.y & mk) | (hi.y & ~mk); return r; }
#define PEER_EC(en, c) peer_ec((en)[0], (en)[1], (c))
__device__ __forceinline__ void a_load(v4u (&uu)[16], const v2u ec, int c, const unsigned char* U8, int lane) {
#pragma unroll
    for (int j = 0; j < 16; ++j) { const unsigned e = __builtin_amdgcn_readlane(ec.x, 16 * (c & 3) + j); uu[j] = *(const v4u*)(U8 + (size_t)e * D + 16 * lane); }
}
__device__ __forceinline__ void a_step(const v4u (&uu)[16], v2u (&en)[2], int c, const LAS f32x4* xl, const G4& T, int lane) {
    const v2u ec = PEER_EC(en, c);
    const int ls = 16 * (c & 3) + (lane >> 2);
    const unsigned eq = (unsigned)__shfl((int)ec.x, ls); const float gq = __uint_as_float((unsigned)__shfl((int)ec.y, ls));
    const float su = T.isu[eq], sv = T.isv[eq];
    f32x4 xv[4];
#pragma unroll
    for (int q = 0; q < 4; ++q) xv[q] = xl[q * 64];
    float part[16];
#pragma unroll
    for (int j = 0; j < 16; ++j) { f32x2w d = {0.f, 0.f};
#pragma unroll
        for (int q = 0; q < 4; ++q) { const unsigned w = uu[j][q]; const f32x2w a = __builtin_amdgcn_cvt_pk_f32_fp8((int)w, false), b = __builtin_amdgcn_cvt_pk_f32_fp8((int)w, true);
            d += (f32x2w){xv[q][0], xv[q][1]} * a; d += (f32x2w){xv[q][2], xv[q][3]} * b; }
        part[j] = d[0] + d[1]; }
    float r8[8], r4[4], r2[2], r1;
#pragma unroll
    for (int i = 0; i < 8; ++i) { auto sw = __builtin_amdgcn_permlane32_swap(__float_as_uint(part[i]), __float_as_uint(part[i + 8]), false, false); r8[i] = __uint_as_float(sw[0]) + __uint_as_float(sw[1]); }
#pragma unroll
    for (int i = 0; i < 4; ++i) { auto sw = __builtin_amdgcn_permlane16_swap(__float_as_uint(r8[i]), __float_as_uint(r8[i + 4]), false, false); r4[i] = __uint_as_float(sw[0]) + __uint_as_float(sw[1]); }
#pragma unroll
    for (int i = 0; i < 2; ++i) { const bool up = (lane & 8) != 0; const float send = up ? r4[i] : r4[i + 2], keep = up ? r4[i + 2] : r4[i]; r2[i] = keep + __shfl_xor(send, 8); }
    { const bool up = (lane & 4) != 0; const float send = up ? r2[0] : r2[1], keep = up ? r2[1] : r2[0]; r1 = keep + __shfl_xor(send, 4); }
    r1 += __shfl_xor(r1, 2); r1 += __shfl_xor(r1, 1);
    const float wgt = gq * gelu_erf(r1 * su) * sv;
    const int rel = lane - 16 * (c & 3);
    const float wv = __shfl(wgt, 4 * (rel & 15));
    const bool mine = (rel >= 0) && (rel < 16);
    const bool lo_ = mine && (c < 4), hi_ = mine && (c >= 4);
    en[0].y = lo_ ? __float_as_uint(wv) : en[0].y; en[1].y = hi_ ? __float_as_uint(wv) : en[1].y;
}
__device__ __forceinline__ void b_load8(v4u (&vv)[8], const v2u ec, int c, int h8, const unsigned char* V8, int lane) {
#pragma unroll
    for (int j = 0; j < 8; ++j) { const unsigned e = __builtin_amdgcn_readlane(ec.x, 16 * (c & 3) + 8 * h8 + j); vv[j] = *(const v4u*)(V8 + (size_t)e * D + 16 * lane); }
}
__device__ __forceinline__ void b_step8(const v4u (&vv)[8], const v2u ec, int c, int h8, f32x2w (&acc)[8]) {
#pragma unroll
    for (int j = 0; j < 8; ++j) { const float w = __uint_as_float(__builtin_amdgcn_readlane(ec.y, 16 * (c & 3) + 8 * h8 + j)); const f32x2w w2 = {w, w};
#pragma unroll
        for (int q = 0; q < 4; ++q) { const unsigned x = vv[j][q]; const f32x2w a = __builtin_amdgcn_cvt_pk_f32_fp8((int)x, false), b = __builtin_amdgcn_cvt_pk_f32_fp8((int)x, true);
            acc[2 * q] += w2 * a; acc[2 * q + 1] += w2 * b; } }
}
__device__ __forceinline__ void b_load(v4u (&vv)[16], const v2u ec, int c, const unsigned char* V8, int lane) {
#pragma unroll
    for (int j = 0; j < 16; ++j) { const unsigned e = __builtin_amdgcn_readlane(ec.x, 16 * (c & 3) + j); vv[j] = *(const v4u*)(V8 + (size_t)e * D + 16 * lane); }
}
__device__ __forceinline__ void b_step(const v4u (&vv)[16], const v2u ec, int c, f32x2w (&acc)[8]) {
#pragma unroll
    for (int j = 0; j < 16; ++j) { const float w = __uint_as_float(__builtin_amdgcn_readlane(ec.y, 16 * (c & 3) + j)); const f32x2w w2 = {w, w};
#pragma unroll
        for (int q = 0; q < 4; ++q) { const unsigned x = vv[j][q]; const f32x2w a = __builtin_amdgcn_cvt_pk_f32_fp8((int)x, false), b = __builtin_amdgcn_cvt_pk_f32_fp8((int)x, true);
            acc[2 * q] += w2 * a; acc[2 * q + 1] += w2 * b; } }
}
__device__ __forceinline__ void tok_finish(const LAS f32x4* xl, const f32x2w (&acc)[8], float* xrow, const float* gam, const float* bet, int lane) {
    float rr[16], s = 0.f;
#pragma unroll
    for (int q = 0; q < 4; ++q) { const f32x4 xv = xl[q * 64];
#pragma unroll
        for (int e = 0; e < 4; ++e) { const int k = 4 * q + e; rr[k] = ALPHA * xv[e] + acc[k >> 1][k & 1]; s += rr[k]; } }
    const float mean = wave_sum(s) * (1.f / D); float s2 = 0.f;
#pragma unroll
    for (int k = 0; k < 16; ++k) { rr[k] -= mean; s2 += rr[k] * rr[k]; }
    const float rstd = __builtin_amdgcn_rsqf(wave_sum(s2) * (1.f / D) + LN_EPS);
#pragma unroll
    for (int q = 0; q < 4; ++q) { const f32x4 g = *(const f32x4*)(gam + 16 * lane + 4 * q), bb = *(const f32x4*)(bet + 16 * lane + 4 * q);
        f32x4 y; y[0] = rr[4 * q] * rstd * g[0] + bb[0]; y[1] = rr[4 * q + 1] * rstd * g[1] + bb[1]; y[2] = rr[4 * q + 2] * rstd * g[2] + bb[2]; y[3] = rr[4 * q + 3] * rstd * g[3] + bb[3];
        *(f32x4*)(xrow + 4 * q) = y; }
}
__device__ __forceinline__ void gather4(const v2u* sel, const G4& T, const float* rin, const float* g1, const float* b1, float* xo, const float* gam, const float* bet, int tok0, int lane, LAS f32x4* xl, LAS v2u* srt) {
    v2u en[4][2];
#pragma unroll
    for (int tt = 0; tt < 4; ++tt) { const float* rrow = rin + (size_t)(tok0 + tt) * D + 16 * lane;
        {
            f32x4 rv[4]; float s = 0.f;
#pragma unroll
            for (int q = 0; q < 4; ++q) { rv[q] = *(const f32x4*)(rrow + 4 * q); s += (rv[q][0] + rv[q][1]) + (rv[q][2] + rv[q][3]); }
            const float mean = wave_sum(s) * (1.f / D); float s2 = 0.f;
#pragma unroll
            for (int q = 0; q < 4; ++q) { rv[q] = rv[q] - mean; s2 += (rv[q][0] * rv[q][0] + rv[q][1] * rv[q][1]) + (rv[q][2] * rv[q][2] + rv[q][3] * rv[q][3]); }
            const float rstd = __builtin_amdgcn_rsqf(wave_sum(s2) * (1.f / D) + LN_EPS);
#pragma unroll
            for (int q = 0; q < 4; ++q) { const f32x4 gg = *(const f32x4*)(g1 + 16 * lane + 4 * q), bb = *(const f32x4*)(b1 + 16 * lane + 4 * q); xl[tt * 256 + q * 64] = rv[q] * rstd * gg + bb; }
        }
        const v2u e0 = sel[(size_t)(tok0 + tt) * 128 + lane], e1 = sel[(size_t)(tok0 + tt) * 128 + 64 + lane];
        const unsigned b0 = e0.x >> 9, b1 = e1.x >> 9; unsigned d0 = 0u, d1 = 0u, base = 0u;
#pragma unroll
        for (unsigned k = 0; k < 32; ++k) { const unsigned long long m0 = __ballot(b0 == k), m1 = __ballot(b1 == k);
            const unsigned c0 = (unsigned)__builtin_popcountll(m0), c1 = (unsigned)__builtin_popcountll(m1);
            const unsigned p0 = __builtin_amdgcn_mbcnt_hi((unsigned)(m0 >> 32), __builtin_amdgcn_mbcnt_lo((unsigned)m0, 0u)), p1 = __builtin_amdgcn_mbcnt_hi((unsigned)(m1 >> 32), __builtin_amdgcn_mbcnt_lo((unsigned)m1, 0u));
            d0 = (b0 == k) ? base + p0 : d0; d1 = (b1 == k) ? base + c0 + p1 : d1; base += c0 + c1; }
        srt[d0] = e0; srt[d1] = e1;
        asm volatile("s_waitcnt lgkmcnt(0)" ::: "memory");
        en[tt][0] = srt[lane]; en[tt][1] = srt[64 + lane];
        asm volatile("s_waitcnt lgkmcnt(0)" ::: "memory");
    }
    {
#pragma unroll 1
        for (int c = 0; c < 8; ++c) {
            v4u ua[16], ub[16];
            a_load(ua, PEER_EC(en[0], c), c, T.U8, lane); a_load(ub, PEER_EC(en[1], c), c, T.U8, lane); __builtin_amdgcn_sched_barrier(0);
            a_step(ua, en[0], c, xl + 0 * 256, T, lane); __builtin_amdgcn_sched_barrier(0);
            a_load(ua, PEER_EC(en[2], c), c, T.U8, lane); __builtin_amdgcn_sched_barrier(0);
            a_step(ub, en[1], c, xl + 1 * 256, T, lane); __builtin_amdgcn_sched_barrier(0);
            a_load(ub, PEER_EC(en[3], c), c, T.U8, lane); __builtin_amdgcn_sched_barrier(0);
            a_step(ua, en[2], c, xl + 2 * 256, T, lane); __builtin_amdgcn_sched_barrier(0);
            a_step(ub, en[3], c, xl + 3 * 256, T, lane); __builtin_amdgcn_sched_barrier(0);
        }
    }
    f32x2w acc[4][8];
#pragma unroll
    for (int tt = 0; tt < 4; ++tt)
#pragma unroll
        for (int q = 0; q < 8; ++q) acc[tt][q] = (f32x2w){0.f, 0.f};
    {
#define PEER_SB() __builtin_amdgcn_sched_barrier(0)
#pragma unroll 1
        for (int c = 0; c < 8; ++c) {
            const v2u e0 = PEER_EC(en[0], c), e1 = PEER_EC(en[1], c), e2 = PEER_EC(en[2], c), e3 = PEER_EC(en[3], c);
            v4u va[8], vb[8], vc[8];
            b_load8(va, e0, c, 0, T.V8, lane); b_load8(vb, e0, c, 1, T.V8, lane); PEER_SB();
            b_load8(vc, e1, c, 0, T.V8, lane); PEER_SB(); b_step8(va, e0, c, 0, acc[0]); PEER_SB();
            b_load8(va, e1, c, 1, T.V8, lane); PEER_SB(); b_step8(vb, e0, c, 1, acc[0]); PEER_SB();
            b_load8(vb, e2, c, 0, T.V8, lane); PEER_SB(); b_step8(vc, e1, c, 0, acc[1]); PEER_SB();
            b_load8(vc, e2, c, 1, T.V8, lane); PEER_SB(); b_step8(va, e1, c, 1, acc[1]); PEER_SB();
            b_load8(va, e3, c, 0, T.V8, lane); PEER_SB(); b_step8(vb, e2, c, 0, acc[2]); PEER_SB();
            b_load8(vb, e3, c, 1, T.V8, lane); PEER_SB(); b_step8(vc, e2, c, 1, acc[2]); PEER_SB();
            b_step8(va, e3, c, 0, acc[3]); PEER_SB(); b_step8(vb, e3, c, 1, acc[3]); PEER_SB();
        }
#undef PEER_SB
    }
#pragma unroll
    for (int tt = 0; tt < 4; ++tt) tok_finish(xl + tt * 256, acc[tt], xo + (size_t)(tok0 + tt) * D + 16 * lane, gam, bet, lane);
}
#undef PEER_EC
__device__ __forceinline__ void rows_to_fp8(const float* usrc, const float* vsrc, unsigned char* udst, unsigned char* vdst, float* uinv, float* vinv, int row0, int stride, int lane) {
    f32x4 nx[4];
    if (row0 < 2 * NEXP) { const float* p = (row0 < NEXP ? usrc + (size_t)row0 * D : vsrc + (size_t)(row0 - NEXP) * D) + 16 * lane;
#pragma unroll
        for (int q = 0; q < 4; ++q) nx[q] = *(const f32x4*)(p + 4 * q); }
#pragma unroll 1
    for (int row = row0; row < 2 * NEXP; row += stride) {
        f32x4 v[4]; float am = 0.f;
#pragma unroll
        for (int q = 0; q < 4; ++q) { v[q] = nx[q]; am = fmaxf(am, fmaxf(fmaxf(fabsf(v[q][0]), fabsf(v[q][1])), fmaxf(fabsf(v[q][2]), fabsf(v[q][3])))); }
        const int rn = row + stride;
        if (rn < 2 * NEXP) { const float* p = (rn < NEXP ? usrc + (size_t)rn * D : vsrc + (size_t)(rn - NEXP) * D) + 16 * lane;
#pragma unroll
            for (int q = 0; q < 4; ++q) nx[q] = *(const f32x4*)(p + 4 * q); }
        am = wave_max(am);
        float s = 1.f, is = 1.f;
        if (am > 1e-30f) { const int eb = (__float_as_int(224.f / am) >> 23) & 0xff; if (eb > 0 && eb < 254) { s = __int_as_float(eb << 23); is = __int_as_float((254 - eb) << 23); } }
        v4u o;
#pragma unroll
        for (int q = 0; q < 4; ++q) { int w = 0; w = __builtin_amdgcn_cvt_pk_fp8_f32(v[q][0] * s, v[q][1] * s, w, false); w = __builtin_amdgcn_cvt_pk_fp8_f32(v[q][2] * s, v[q][3] * s, w, true); o[q] = (unsigned)w; }
        unsigned char* dst = (row < NEXP ? udst + (size_t)row * D : vdst + (size_t)(row - NEXP) * D) + 16 * lane;
        *(v4u*)dst = o;
        if (lane == 0) { if (row < NEXP) uinv[row] = is; else vinv[row - NEXP] = is; }
    }
}
}
constexpr int NPH = 8;
__global__ void __launch_bounds__(NWAVES * 64, 2) mk_fwd(Args args) {
    extern __shared__ __attribute__((aligned(16))) unsigned char lds_raw[];
    LAS unsigned char* lds = (LAS unsigned char*)lds_raw;
    volatile LAS unsigned* MISC = (volatile LAS unsigned*)(lds + MISC_OFF);
    const int tid0 = threadIdx.x, lane0 = tid0 & 63, wave = __builtin_amdgcn_readfirstlane(tid0 >> 6);
    const int G = gridDim.x, bx = blockIdx.x, vcu = (G % 8 == 0) ? (bx % 8) * (G / 8) + bx / 8 : bx;
    unsigned char* ws0 = args.ws;
    gu32* ctl = (gu32*)(ws0 + WS_CTL);
    for (int u = tid0; u < (LDS_BYTES - RING_BYTES) / 4; u += NWAVES * 64) ((LAS unsigned*)(lds + RING_BYTES))[u] = 0u;
    __syncthreads();
    XcdBarrier bar; bar.bar = (unsigned*)(ctl + CW_BAR); bar.x = 0; bar.st = nullptr;
    if (MK_N_LAUNCHES == 1) bar = xcd_barrier_post((unsigned*)(ctl + CW_BAR), MISC + 8, wave);
    const int lo = args.ph_lo, hi = args.ph_hi;
#ifndef PH_MASK
#define PH_MASK 0xFF
#endif
#define IN(k) ((((PH_MASK) >> (k)) & 1) && lo <= (k) && (k) < hi)
#define SEAM(k) do { if (IN(k) && IN((k) + 1)) xcd_barrier(bar); } while (0)
    const int NGW = G * NWAVES;
#define SUB_BEGIN() unsigned char* ws = ws0; asm volatile("" : "+s"(ws)); const int lane = (int)__builtin_amdgcn_mbcnt_hi(~0u, __builtin_amdgcn_mbcnt_lo(~0u, 0u)), tid = wave * 64 + lane; (void)tid; (void)lane
#define PHASE_BEGIN() unsigned char* ws = ws0; asm volatile("" : "+s"(ws)); const int lane = (int)__builtin_amdgcn_mbcnt_hi(~0u, __builtin_amdgcn_mbcnt_lo(~0u, 0u)), tid = wave * 64 + lane; const int gw = vcu * NWAVES + wave; (void)gw; (void)lane; (void)tid

    if (IN(0)) { PHASE_BEGIN(); p0_prologue(args, lds, vcu, G, wave, lane); VM_WAIT(); __syncthreads(); SEAM(0); }

    if (IN(1)) { PHASE_BEGIN();
        pg8::Gemm g{(const pg8::bf16_t*)(ws + WS_A), (const pg8::bf16_t*)(ws + WS_WIN), T, INC, D}; pg8::StaticOrder S; S.init(T, INC, G, bx); S.rep = NREP(1);
        pg8::EpiInProj E{(pg8::bf16_t*)(ws + WS_QD), (pg8::bf16_t*)(ws + WS_KD), (pg8::bf16_t*)(ws + WS_VD), (pg8::bf16_t*)(ws + WS_LQ), (pg8::bf16_t*)(ws + WS_LK), (pg8::bf16_t*)(ws + WS_LV),
                         (pg8::bf16_t*)(ws + WS_GA), (pg8::bf16_t*)(ws + WS_GB)};
        pg8::gemm_phase<pg8::EpiInProj, pg8::StaticOrder, true, true>(lds, g, S, E, wave);
        {
            const int nwg = (T / 256) * (INC / 256), rem = nwg % G, nshort = rem ? G - rem : G, first = rem ? rem : 0;
            if (bx >= first) peer::rows_to_fp8(args.in[I_PU], args.in[I_PV], ws + WS_UU, ws + WS_UV, (float*)(ws + WS_ISU), (float*)(ws + WS_ISV), (bx - first) * NWAVES + wave, nshort * NWAVES, lane);
        }
        SEAM(1);
    }

    if (IN(2)) { PHASE_BEGIN();
#ifndef NO_DIFF
        {   SUB_BEGIN();
            const da::Tensors X{(const bf16*)(ws + WS_QD), (const bf16*)(ws + WS_KD), (const bf16*)(ws + WS_VD), (float*)(ws + WS_STASH), (bf16*)(ws + WS_YA),
                                args.in[I_DLAM], args.in[I_SUBG], args.in[I_RELB]};
            int cur_h = -1;
            float lam; { const float* dl = args.in[I_DLAM]; const float p1 = dl[lane] * dl[64 + lane], p2 = dl[128 + lane] * dl[192 + lane];
                lam = __uint_as_float(__builtin_amdgcn_readfirstlane(__float_as_uint(__expf(wave_sum(p1)) - __expf(wave_sum(p2)) + LAM_INIT))); }
            for (int rep_ = 0; rep_ < NREP(20); ++rep_)
            for (int p = vcu; p < 256; p += G) {
                const int bh = p >> 5, s = p & 31, b = bh >> 2, h = bh & 3;
                if (h != cur_h) {
                    __syncthreads();
                    const float* bd = (const float*)(ws + WS_BIASD) + h * BIAS_TAB; asm volatile("" : "+s"(bd));
                    int ln2 = (int)__builtin_amdgcn_mbcnt_hi(~0u, __builtin_amdgcn_mbcnt_lo(~0u, 0u)); asm volatile("" : "+v"(ln2));
                    for (int i = wave * 64 + ln2; i < BIAS_TAB; i += NWAVES * 64) ((LAS float*)(lds + da::LDS_BIAS))[i] = bd[i];
                    for (int i = wave * 64 + ln2; i < 4 * da::TAB_CL; i += NWAVES * 64) {
                        const int a = i / da::TAB_CL, k = i % da::TAB_CL, idx = da::TAB_NR - k + a;
                        ((LAS float*)(lds + da::LDS_TREV))[i] = (idx >= 0 && idx < BIAS_TAB) ? bd[idx] : 0.f; }
                    __syncthreads(); cur_h = h;
                }
                const float c31 = args.in[I_RELB][31 * 16 + h] * LOG2E;
                for (int k2 = 0; k2 < 2; ++k2) da::unit(X, b, h, k2 ? 63 - s : s, lds, bx, lam, c31, wave);
            }
        }
#endif
#ifndef NO_DIL
        {   SUB_BEGIN();
            const dil::Tensors X{(const bf16*)(ws + WS_LQ), (const bf16*)(ws + WS_LK), (const bf16*)(ws + WS_LV), (bf16*)(ws + WS_YB)};
            int cur_h = -1;
            for (int rep_ = 0; rep_ < NREP(21); ++rep_)
            for (int u = vcu; u < 256; u += G) {
                const int bh = u >> 5, blk = u & 31, b = bh >> 2, h = bh & 3;
                if (h != cur_h) {
                    __syncthreads();
                    const float* blsrc = (const float*)(ws + WS_BIASL);
                    for (int i = tid; i < 3 * dil::BT; i += NWAVES * 64) { const int g = i / dil::BT, jj = i % dil::BT - dil::BT0;
                        ((LAS float*)(lds + dil::LDS_BL))[i] = (jj >= 0 && jj <= 128) ? blsrc[(g * 4 + h) * 132 + jj] : 0.f; }
                    __syncthreads(); cur_h = h;
                }
                float* lse0 = (float*)(ws + WS_LSE0);
                for (int k2 = 0; k2 < 2; ++k2) dil::wave_tile_g0(X, lse0, b, h, blk * 512 + (wave + 8 * k2) * 32, lds + dil::LDS_VST + wave * 4096, (const LAS float*)(lds + dil::LDS_BL), lane);
                VM_WAIT(); __syncthreads();
                for (int k2 = 0; k2 < 2; ++k2) dil::wave_tile(X, lse0, b, h, blk * 512, wave + 8 * k2, lds + dil::LDS_VST + wave * 4096, (const LAS float*)(lds + dil::LDS_BL), lane);
            }
            __syncthreads();
        }
#endif
        SEAM(2);
    }

    if (IN(3)) { PHASE_BEGIN();
        { pg8::Gemm g{(const pg8::bf16_t*)(ws + WS_YA), (const pg8::bf16_t*)(ws + WS_WBD), T, D, 512}; pg8::StaticOrder S; S.init(T, D, G, bx); S.rep = NREP(3);
          pg8::EpiGate1 E{(const pg8::bf16_t*)(ws + WS_GA), (pg8::bf16_t*)(ws + WS_GATED)};
          pg8::gemm_phase<pg8::EpiGate1, pg8::StaticOrder, true, true>(lds, g, S, E, wave); }
        VM_WAIT(); __syncthreads();
        { pg8::Gemm g{(const pg8::bf16_t*)(ws + WS_YB), (const pg8::bf16_t*)(ws + WS_WBL), T, D, 256}; pg8::StaticOrder S; S.init(T, D, G, bx);
          pg8::EpiGate2 E{(const pg8::bf16_t*)(ws + WS_GB), (pg8::bf16_t*)(ws + WS_GATED)};
          pg8::gemm_phase<pg8::EpiGate2, pg8::StaticOrder, true, true>(lds, g, S, E, wave); }
        SEAM(3);
    }

    if (IN(4)) { PHASE_BEGIN();
        pg8::Gemm g{(const pg8::bf16_t*)(ws + WS_GATED), (const pg8::bf16_t*)(ws + WS_WO), T, D, D}; pg8::StaticOrder S; S.init(T, D, G, bx); S.rep = NREP(4);
        pg8::EpiOut E{args.in[I_X], (float*)(ws + WS_R)};
        pg8::gemm_phase<pg8::EpiOut, pg8::StaticOrder, true, true>(lds, g, S, E, wave);
        SEAM(4);
    }

    if (IN(5)) { PHASE_BEGIN();
        p5_ln1(args, vcu, G, wave, lane);
        SEAM(5);
    }

    if (IN(6)) { PHASE_BEGIN();
        pg8::Gemm g{(const pg8::bf16_t*)(ws + WS_WP), (const pg8::bf16_t*)(ws + WS_A), 2048, T, D}; pg8::StaticOrder S; S.init(2048, T, G, bx); S.rep = NREP(6);
        pg8::EpiScoreT E{(float*)(ws + WS_ST)};
        pg8::gemm_phase<pg8::EpiScoreT, pg8::StaticOrder, true, true>(lds, g, S, E, wave);
        SEAM(6);
    }

    if (IN(7)) { PHASE_BEGIN();
        const float* ST = (const float*)(ws + WS_ST); v2u* sel = (v2u*)(ws + WS_SEL);
        for (int u = vcu; u < T / 128; u += G) {
            for (int p = 0; p < 2; ++p) peer::select(ST, sel, u * 128 + p * 64 + lane, wave);
            VM_WAIT(); __syncthreads();
            { const peer::G4 TB{ws + WS_UU, ws + WS_UV, (const float*)(ws + WS_ISU), (const float*)(ws + WS_ISV)};
              for (int i = 0; i < 4; ++i) peer::gather4(sel, TB, (const float*)(ws + WS_R), args.in[I_LN1G], args.in[I_LN1B], args.out, args.in[I_LN2G], args.in[I_LN2B], u * 128 + i * 32 + wave * 4, lane, (LAS f32x4*)(lds + wave * 16384) + lane, (LAS v2u*)(lds + RING_BYTES + 2048 + wave * 1024)); }
            VM_WAIT(); __syncthreads();
        }
    }
#undef IN
#undef SEAM
}

extern "C" void kernel_launch(void* const* d_in, const int* in_sizes, int n_in, void* d_out, int out_size, void* d_ws, size_t ws_size, hipStream_t stream) {
    static int grid = 0;
    if (grid == 0) {
        if (n_in != 16 || in_sizes[0] != T * D || out_size != T * D || ws_size < WS_END) { fprintf(stderr, "kernel_launch: unexpected shapes (n_in %d, in0 %d, out %d, ws %zu); nothing launched\n", n_in, n_in > 0 ? in_sizes[0] : -1, out_size, ws_size); grid = -1; return; }
        int dev = 0, cus = 0, per_cu = 0;
        if (hipGetDevice(&dev) != hipSuccess || hipDeviceGetAttribute(&cus, hipDeviceAttributeMultiprocessorCount, dev) != hipSuccess) { grid = -1; return; }
        if (hipFuncSetAttribute((const void*)mk_fwd, hipFuncAttributeMaxDynamicSharedMemorySize, LDS_BYTES) != hipSuccess) { fprintf(stderr, "kernel_launch: hipFuncSetAttribute failed\n"); grid = -1; return; }
        if (hipOccupancyMaxActiveBlocksPerMultiprocessor(&per_cu, (const void*)mk_fwd, NWAVES * 64, LDS_BYTES) != hipSuccess || per_cu < 1) { fprintf(stderr, "kernel_launch: occupancy query reports %d\n", per_cu); per_cu = 1; }
        (void)hipGetLastError();
        grid = cus;
    }
    if (grid < 0) return;
    if (hipMemsetAsync((char*)d_ws + WS_CTL, 0, CTL_ZERO_BYTES, stream) != hipSuccess) return;
    Args a{};
    for (int i = 0; i < 16; ++i) a.in[i] = (const float*)d_in[i];
    a.out = (float*)d_out; a.ws = (unsigned char*)d_ws;
    for (int li = 0; li < MK_N_LAUNCHES; ++li) {
        a.ph_lo = (MK_N_LAUNCHES == 1) ? 0 : li; a.ph_hi = (MK_N_LAUNCHES == 1) ? NPH : li + 1;
        hipLaunchKernelGGL(mk_fwd, dim3(grid), dim3(NWAVES * 64), LDS_BYTES, stream, a);
    }
}
```

```cpp
#include <hip/hip_runtime.h>
#include <cstdio>
#include <cstdint>

#ifndef MK_N_LAUNCHES
#define MK_N_LAUNCHES 1
#endif

#ifndef REPEAT_PH
#define REPEAT_PH (-1)
#endif
#define NREP(k) ((REPEAT_PH) == (k) ? 2 : 1)

constexpr int BATCH = 2, SEQ = 16384, T = BATCH * SEQ, D = 1024, INC = 5888;
constexpr int OFF_DQ = 0, OFF_DK = 512, OFF_DV = 1024, OFF_LQ = 1536, OFF_LK = 2304, OFF_LV = 3072, OFF_GA = 3840, OFF_GB = 4864;
constexpr int NEXP = 16384;
constexpr float LOG2E = 1.4426950408889634f;
constexpr float QSCALE = 0.125f * LOG2E;
constexpr float ALPHA = 1.189207115002721f;
constexpr float LN_EPS = 1e-5f, SUBLN_EPS = 1e-5f;
constexpr float LAM_INIT = 0.2f;
constexpr int NTILE = SEQ / 64;
constexpr int BIAS_TAB = 2240, BIAS_GUARD = 256, DFAR = 1513;

constexpr size_t MiB = 1u << 20;
constexpr size_t WS_CTL = 0, CTL_ZERO_BYTES = 1 * MiB;
constexpr size_t WS_BIASD = 1 * MiB;
constexpr size_t WS_BIASL = 1 * MiB + 64 * 1024;
constexpr size_t WS_WIN = 8 * MiB, WS_WO = 20 * MiB, WS_WBD = 22 * MiB, WS_WBL = 23 * MiB, WS_WP = 24 * MiB;
constexpr size_t WS_A = 32 * MiB;
constexpr size_t WS_YA = WS_A, WS_YB = WS_A + 32 * MiB;
constexpr size_t WS_QD = 96 * MiB, WS_KD = 128 * MiB, WS_VD = 160 * MiB, WS_LQ = 192 * MiB, WS_LK = 240 * MiB, WS_LV = 288 * MiB, WS_GA = 336 * MiB, WS_GB = 400 * MiB;
constexpr size_t WS_STASH = 464 * MiB;
constexpr size_t WS_SEL = 32 * MiB;
constexpr size_t WS_GATED = 96 * MiB;
constexpr size_t WS_R = 352 * MiB;
constexpr size_t WS_ST = 96 * MiB;
constexpr size_t WS_UU = 480 * MiB, WS_UV = 496 * MiB;
constexpr size_t WS_LSE0 = 3 * MiB;
constexpr size_t WS_ISU = 2 * MiB, WS_ISV = 2 * MiB + 65536;
constexpr size_t WS_END = 512 * MiB;

constexpr int CW_BAR = 4096;
constexpr int NWAVES = 8;
constexpr int RING_BYTES = 131072, MISC_OFF = RING_BYTES + 320, LDS_BYTES = 147456;

#define GAS __attribute__((address_space(1)))
#define LAS __attribute__((address_space(3)))
typedef unsigned short bf16;
typedef unsigned v4u __attribute__((ext_vector_type(4)));
typedef unsigned v2u __attribute__((ext_vector_type(2)));
typedef float f32x4 __attribute__((ext_vector_type(4)));
typedef float f32x16 __attribute__((ext_vector_type(16)));
typedef short bf16x8 __attribute__((ext_vector_type(8)));
typedef short s16x4 __attribute__((ext_vector_type(4)));
typedef __bf16 bf16x2 __attribute__((ext_vector_type(2)));
typedef GAS unsigned gu32;
#define RLX_AGENT __ATOMIC_RELAXED, __HIP_MEMORY_SCOPE_AGENT
#define LDS_WAIT() asm volatile("s_waitcnt lgkmcnt(0)" ::: "memory")
#define VM_WAIT() asm volatile("s_waitcnt vmcnt(0)" ::: "memory")
__device__ __forceinline__ unsigned f2bf(float f) { unsigned u = __builtin_bit_cast(unsigned, f); return (u + 0x7fffu + ((u >> 16) & 1u)) >> 16; }
__device__ __forceinline__ unsigned pk2(float lo, float hi) { return f2bf(lo) | (f2bf(hi) << 16); }
typedef float f32x2_t __attribute__((ext_vector_type(2)));
__device__ __forceinline__ unsigned cvtpk(float lo, float hi) { f32x2_t v = {lo, hi}; bf16x2 b = __builtin_convertvector(v, bf16x2); return __builtin_bit_cast(unsigned, b); }
__device__ __forceinline__ float bf_lo(unsigned w) { return __builtin_bit_cast(float, w << 16); }
__device__ __forceinline__ float bf_hi(unsigned w) { return __builtin_bit_cast(float, w & 0xffff0000u); }
__device__ __forceinline__ float dot2bf(unsigned a, unsigned b, float acc) { return __builtin_amdgcn_fdot2_f32_bf16(__builtin_bit_cast(bf16x2, a), __builtin_bit_cast(bf16x2, b), acc, false); }
__device__ __forceinline__ float wave_sum(float v) {
#pragma unroll
    for (int o = 1; o < 64; o <<= 1) v += __shfl_xor(v, o);
    return v;
}
__device__ __forceinline__ float wave_max(float v) {
#pragma unroll
    for (int o = 1; o < 64; o <<= 1) v = fmaxf(v, __shfl_xor(v, o));
    return v;
}
__device__ __forceinline__ int rel_bucket(int n) {
    if (n < 16) return n < 0 ? 0 : n;
    return 16 + (n >= 22) + (n >= 30) + (n >= 40) + (n >= 54) + (n >= 73) + (n >= 99) + (n >= 134) + (n >= 182) + (n >= 246) + (n >= 332) + (n >= 450) + (n >= 609) + (n >= 825) + (n >= 1117) + (n >= 1513);
}
namespace pg8 {
#define PG8_LAS __attribute__((address_space(3)))
typedef unsigned short bf16_t;
typedef short bf16x8 __attribute__((ext_vector_type(8)));
typedef float f32x4 __attribute__((ext_vector_type(4)));
typedef unsigned u32x4 __attribute__((ext_vector_type(4)));
constexpr int BM = 256, BK = 64, HALF = 128, HTB = HALF * BK * 2  , STAGE_BYTES = 8 * HTB, NXCD = 8, WGM = 8;

__host__ __device__ __forceinline__ int lds_byte(int r, int c) { const int st = (r >> 4) * 2 + (c >> 5), rr = r & 15, cc = c & 31, ob = rr * 64 + cc * 2; return st * 1024 + (ob ^ (((ob >> 9) & 1) << 5)); }
__host__ __device__ __forceinline__ void stage_rc(int b, int& R, int& C) { const int st = b / 1024, sb = b % 1024, swz = sb ^ (((sb >> 9) & 1) << 5); R = (st >> 1) * 16 + swz / 64; C = (st & 1) * 32 + (swz % 64) / 2; }
__host__ __device__ __forceinline__ int perm32(int rho) { const int n = rho >> 4, i = rho & 15; return 8 * (i >> 2) + 4 * n + (i & 3); }

struct Unit { int pm, pn; };
struct Gemm { const bf16_t* A; const bf16_t* Bt; int M, N, K; };

struct StaticOrder {
    int nM, nN, nwg, G, c;
    __host__ __device__ void init(int M, int N, int G_, int c_) { nM = M / BM; nN = N / BM; nwg = nM * nN; G = G_; c = c_; }
    int rep = 1;
    __host__ __device__ bool next(int i0, Unit& u) const {
        const int i = i0 / rep;
        const long L = (long)i * G + c; if (L >= nwg) return false;
        int wgid = (int)L; { const int q = nwg / NXCD, r = nwg % NXCD, xcd = wgid % NXCD, off = wgid / NXCD; wgid = (xcd < r ? xcd * (q + 1) : r * (q + 1) + (xcd - r) * q) + off; }
        const int nig = WGM * nN, gid = wgid / nig, fm = gid * WGM, gsz = (nM - fm) < WGM ? (nM - fm) : WGM;
        u.pm = fm + ((wgid % nig) % gsz); u.pn = (wgid % nig) / gsz; return true;
    }
    __device__ __forceinline__ void a_ready(const Unit&) const {}
    __device__ __forceinline__ void done(const Unit&) const {}
};
__device__ __forceinline__ unsigned cvt_pk_bf16(float lo, float hi) { unsigned r; asm volatile("v_cvt_pk_bf16_f32 %0, %1, %2" : "=v"(r) : "v"(lo), "v"(hi)); return r; }
__device__ __forceinline__ u32x4 pack8(const f32x4 v0, const f32x4 v1) { u32x4 w; w.x = cvt_pk_bf16(v0[0], v0[1]); w.y = cvt_pk_bf16(v0[2], v0[3]); w.z = cvt_pk_bf16(v1[0], v1[1]); w.w = cvt_pk_bf16(v1[2], v1[3]); return w; }
__device__ __forceinline__ float blo(unsigned w) { return __builtin_bit_cast(float, w << 16); }
__device__ __forceinline__ float bhi(unsigned w) { return __builtin_bit_cast(float, w & 0xffff0000u); }
__device__ __forceinline__ float sigm(float v) { return __builtin_amdgcn_rcpf(1.f + __expf(-v)); }
template <class E> __device__ __forceinline__ void epi_loop(const E& e, const f32x4 (&acc)[2][2][4][2], const Unit& u, int wr, int wc, int fr, int fq) {
#pragma unroll
    for (int ai = 0; ai < 2; ++ai)
#pragma unroll
        for (int m = 0; m < 4; ++m) { const int row = u.pm * BM + ai * HALF + wr * 64 + m * 16 + fr;
#pragma unroll
            for (int bj = 0; bj < 2; ++bj) { const int col = u.pn * BM + bj * HALF + wc * 32 + 8 * fq; e.item(u.pn, row, col, acc[ai][bj][m][0], acc[ai][bj][m][1]); } }
}

struct EpiInProj {
    static constexpr bool PERM = true, AFTER_DRAIN = false;
    bf16_t *Qd, *Kd, *Vd, *LQ, *LK, *LV, *GA, *GB;
    __device__ __forceinline__ void operator()(const f32x4 (&acc)[2][2][4][2], const Unit& u, int wr, int wc, int fr, int fq) const { epi_loop(*this, acc, u, wr, wc, fr, fq); }
    __device__ __forceinline__ void item(int pn, int row, int col, f32x4 v0, f32x4 v1) const {
            const int b = row >> 14, s = row & 16383; bf16_t* dst;
            if (pn < 2) {
                const int h = col >> 7, c = (col >> 6) & 1, d = col & 63; v0 = v0 * 0.18033688011112042f; v1 = v1 * 0.18033688011112042f;
                dst = Qd + ((size_t)((b * 4 + h) * 2 + c) * 16384 + s) * 64 + d;
            } else if (pn < 4) {
                const int cc = col - 512, h = cc >> 7, c = (cc >> 6) & 1, d = cc & 63;
                dst = Kd + ((((size_t)((b * 4 + h) * 2 + c) * 256 + (s >> 6)) * 8 + (d >> 3)) * 64 + (s & 63)) * 8;
            } else if (pn < 6) {
                const int cc = col - 1024, h = cc >> 7, d = cc & 127;
                dst = Vd + ((size_t)(b * 4 + h) * 256 + (s >> 6)) * 8192 + ((d >> 5) * 4 + ((s & 63) >> 4)) * 512 + (s & 15) * 32 + (d & 31);
            } else if (pn < 9) {
                v0 = v0 * 0.18033688011112042f; v1 = v1 * 0.18033688011112042f; dst = LQ + (size_t)row * 768 + (col - 1536);
            } else if (pn < 12) { dst = LK + (size_t)row * 768 + (col - 2304);
            } else if (pn < 15) { dst = LV + (size_t)row * 768 + (col - 3072);
            } else {
#pragma unroll
                for (int i = 0; i < 4; ++i) { v0[i] = sigm(v0[i]); v1[i] = sigm(v1[i]); }
                dst = (pn < 19) ? GA + (size_t)row * 1024 + (col - 3840) : GB + (size_t)row * 1024 + (col - 4864);
            }
            *(u32x4*)dst = pack8(v0, v1);
        }
};
struct EpiGate1 {
    static constexpr bool PERM = true, AFTER_DRAIN = false;
    const bf16_t* GA; bf16_t* G;
    __device__ __forceinline__ void operator()(const f32x4 (&acc)[2][2][4][2], const Unit& u, int wr, int wc, int fr, int fq) const { epi_loop(*this, acc, u, wr, wc, fr, fq); }
    __device__ __forceinline__ void item(int pn, int row, int col, f32x4 v0, f32x4 v1) const {
            const size_t o = (size_t)row * 1024 + col; const u32x4 g = *(const u32x4*)(GA + o);
            v0[0] *= blo(g.x); v0[1] *= bhi(g.x); v0[2] *= blo(g.y); v0[3] *= bhi(g.y); v1[0] *= blo(g.z); v1[1] *= bhi(g.z); v1[2] *= blo(g.w); v1[3] *= bhi(g.w);
            *(u32x4*)(G + o) = pack8(v0, v1);
        }
};
struct EpiGate2 {
    static constexpr bool PERM = true, AFTER_DRAIN = false;
    const bf16_t* GB; bf16_t* G;
    __device__ __forceinline__ void operator()(const f32x4 (&acc)[2][2][4][2], const Unit& u, int wr, int wc, int fr, int fq) const { epi_loop(*this, acc, u, wr, wc, fr, fq); }
    __device__ __forceinline__ void item(int pn, int row, int col, f32x4 v0, f32x4 v1) const {
            const size_t o = (size_t)row * 1024 + col; const u32x4 g = *(const u32x4*)(GB + o); const u32x4 p = *(const u32x4*)(G + o);
            v0[0] = v0[0] * blo(g.x) + blo(p.x); v0[1] = v0[1] * bhi(g.x) + bhi(p.x); v0[2] = v0[2] * blo(g.y) + blo(p.y); v0[3] = v0[3] * bhi(g.y) + bhi(p.y);
            v1[0] = v1[0] * blo(g.z) + blo(p.z); v1[1] = v1[1] * bhi(g.z) + bhi(p.z); v1[2] = v1[2] * blo(g.w) + blo(p.w); v1[3] = v1[3] * bhi(g.w) + bhi(p.w);
            *(u32x4*)(G + o) = pack8(v0, v1);
        }
};
struct EpiOut {
    static constexpr bool PERM = true, AFTER_DRAIN = false;
    const float* X; float* R;
    __device__ __forceinline__ void operator()(const f32x4 (&acc)[2][2][4][2], const Unit& u, int wr, int wc, int fr, int fq) const { epi_loop(*this, acc, u, wr, wc, fr, fq); }
    __device__ __forceinline__ void item(int pn, int row, int col, f32x4 v0, f32x4 v1) const {
            const size_t o = (size_t)row * 1024 + col; const f32x4 x0 = *(const f32x4*)(X + o), x1 = *(const f32x4*)(X + o + 4);
            *(f32x4*)(R + o) = x0 * 1.189207115002721f + v0; *(f32x4*)(R + o + 4) = x1 * 1.189207115002721f + v1;
    }
};
struct EpiScoreT {
    static constexpr bool PERM = true, AFTER_DRAIN = false;
    float* ST;
    __device__ __forceinline__ void operator()(const f32x4 (&acc)[2][2][4][2], const Unit& u, int wr, int wc, int fr, int fq) const { epi_loop(*this, acc, u, wr, wc, fr, fq); }
    __device__ __forceinline__ void item(int pn, int row, int col, f32x4 v0, f32x4 v1) const { const size_t o = (size_t)row * 32768 + col; *(f32x4*)(ST + o) = v0; *(f32x4*)(ST + o + 4) = v1; }
};
template <class Epi, class Sched, bool ALIGN_EPI = false, bool SP2 = false>
__device__ __forceinline__ void gemm_phase(PG8_LAS unsigned char* lds, const Gemm g, const Sched& S, const Epi& E, const int wid  ) {
    const int lane = (int)__builtin_amdgcn_mbcnt_hi(~0u, __builtin_amdgcn_mbcnt_lo(~0u, 0u)), tid = wid * 64 + lane, wr = wid >> 2, wc = wid & 3, fr = lane & 15, fq = lane >> 4;
    const int K = g.K, nt = K / BK;
    unsigned voffA[2], voffB[2];
#pragma unroll
    for (int i = 0; i < 2; ++i) { int R, C; stage_rc(tid * 16 + i * 8192, R, C); const int Rb = Epi::PERM ? ((R & ~31) + perm32(R & 31)) : R;
        voffA[i] = (unsigned)(R * K + C) * 2u; voffB[i] = (unsigned)(Rb * K + C) * 2u; }
    const size_t kstep = (size_t)(BK * 2);
    const size_t hstep = (size_t)HALF * K * 2;
    const size_t tstep = 2 * hstep;
    const unsigned ldsw = (unsigned)wid * 1024u;
    const int aoff = lds_byte(wr * 64 + fr, fq * 8), boff = lds_byte(wc * 32 + fr, fq * 8);
#define PG8_SA(b, h) (((b) * 2 + (h)) * HTB)
#define PG8_SB(b, h) ((4 + (b) * 2 + (h)) * HTB)
#define PG8_STAGE(bufoff, gbase, voff) do { _Pragma("unroll") for (int _i = 0; _i < 2; ++_i) \
        __builtin_amdgcn_global_load_lds((const unsigned*)((const char*)(gbase) + (voff)[_i]), (PG8_LAS unsigned*)(lds + (bufoff) + ldsw + _i * 8192), 16, 0, 0); } while (0)
#define PG8_LDA(dst, b, h) do { _Pragma("unroll") for (int m = 0; m < 4; ++m) _Pragma("unroll") for (int k = 0; k < 2; ++k) dst[m][k] = *(const PG8_LAS bf16x8*)(lds + PG8_SA(b, h) + aoff + m * 2048 + k * 1024); } while (0)
#define PG8_LDB(dst, b, h) do { _Pragma("unroll") for (int n = 0; n < 2; ++n) _Pragma("unroll") for (int k = 0; k < 2; ++k) dst[n][k] = *(const PG8_LAS bf16x8*)(lds + PG8_SB(b, h) + boff + n * 2048 + k * 1024); } while (0)
#define PG8_MMA(ai, bj, At, Bt) do { __builtin_amdgcn_s_setprio(1); _Pragma("unroll") for (int m = 0; m < 4; ++m) _Pragma("unroll") for (int n = 0; n < 2; ++n) _Pragma("unroll") for (int k = 0; k < 2; ++k) \
        acc[ai][bj][m][n] = __builtin_amdgcn_mfma_f32_16x16x32_bf16(Bt[n][k], At[m][k], acc[ai][bj][m][n], 0, 0, 0); __builtin_amdgcn_s_setprio(0); } while (0)
#define PG8_WAIT_V(n) asm volatile("s_waitcnt vmcnt(" #n ")" ::: "memory")
#define PG8_WAIT_L(n) asm volatile("s_waitcnt lgkmcnt(" #n ")" ::: "memory")
#define PG8_BAR __builtin_amdgcn_s_barrier()
#define PG8_SCHED __builtin_amdgcn_sched_barrier(0)
    Unit cur, nxt; int ui = 0;
    if (!S.next(0, cur)) return;
    f32x4 acc[2][2][4][2];
#pragma unroll
    for (int a = 0; a < 2; ++a)
#pragma unroll
        for (int b = 0; b < 2; ++b)
#pragma unroll
            for (int m = 0; m < 4; ++m)
#pragma unroll
                for (int n = 0; n < 2; ++n) acc[a][b][m][n] = (f32x4){0.f, 0.f, 0.f, 0.f};
    bf16x8 At[4][2], B0[2][2], B1[2][2];
    const char* cA = (const char*)g.A + (size_t)cur.pm * tstep; const char* cB = (const char*)g.Bt + (size_t)cur.pn * tstep;
    S.a_ready(cur);
    if constexpr (SP2) {
        PG8_STAGE(PG8_SB(0, 0), cB, voffB); PG8_STAGE(PG8_SB(0, 1), cB + hstep, voffB); PG8_STAGE(PG8_SA(0, 0), cA, voffA); PG8_STAGE(PG8_SA(0, 1), cA + hstep, voffA);
        if (wr == 1) PG8_BAR;
        PG8_WAIT_V(2); PG8_BAR;
        PG8_STAGE(PG8_SB(1, 0), cB + kstep, voffB); PG8_STAGE(PG8_SA(1, 0), cA + kstep, voffA); PG8_STAGE(PG8_SB(1, 1), cB + hstep + kstep, voffB);
        PG8_WAIT_V(6); PG8_BAR;
    } else {
        PG8_STAGE(PG8_SB(0, 0), cB, voffB); PG8_STAGE(PG8_SA(0, 0), cA, voffA); PG8_STAGE(PG8_SB(0, 1), cB + hstep, voffB); PG8_STAGE(PG8_SA(0, 1), cA + hstep, voffA);
        if (wr == 1) PG8_BAR;
        PG8_WAIT_V(4); PG8_BAR;
        PG8_STAGE(PG8_SB(1, 0), cB + kstep, voffB); PG8_STAGE(PG8_SA(1, 0), cA + kstep, voffA); PG8_STAGE(PG8_SB(1, 1), cB + hstep + kstep, voffB);
        PG8_WAIT_V(6); PG8_BAR;
    }
    for (;;) {
        const bool has_next = S.next(ui + 1, nxt);
        const char* nA = has_next ? (const char*)g.A + (size_t)nxt.pm * tstep : cA; const char* nB = has_next ? (const char*)g.Bt + (size_t)nxt.pn * tstep : cB;
        for (int t = 0; t < nt; t += 2) {
            const bool last = (t == nt - 2);
            const char* a1 = cA + (size_t)(t + 1) * kstep;
            const char* a2 = last ? nA : cA + (size_t)(t + 2) * kstep; const char* b2 = last ? nB : cB + (size_t)(t + 2) * kstep;
            const char* a3 = a2 + kstep; const char* b3 = b2 + kstep;
            if (last && has_next) S.a_ready(nxt);
            if constexpr (SP2) {
            PG8_LDB(B0, 0, 0); PG8_LDB(B1, 0, 1); PG8_SCHED; PG8_LDA(At, 0, 0); PG8_STAGE(PG8_SA(1, 1), a1 + hstep, voffA);
            PG8_WAIT_V(8); PG8_WAIT_L(0); PG8_BAR; PG8_MMA(0, 0, At, B0); PG8_MMA(0, 1, At, B1); PG8_BAR; PG8_SCHED;
            PG8_LDA(At, 0, 1); PG8_STAGE(PG8_SB(0, 0), b2, voffB); PG8_STAGE(PG8_SB(0, 1), b2 + hstep, voffB); PG8_STAGE(PG8_SA(0, 0), a2, voffA);
            PG8_WAIT_V(8); PG8_WAIT_L(0); PG8_BAR; PG8_MMA(1, 0, At, B0); PG8_MMA(1, 1, At, B1); PG8_BAR; PG8_SCHED;
            PG8_LDB(B0, 1, 0); PG8_LDB(B1, 1, 1); PG8_SCHED; PG8_LDA(At, 1, 0); PG8_STAGE(PG8_SA(0, 1), a2 + hstep, voffA);
            PG8_WAIT_V(8); PG8_WAIT_L(0); PG8_BAR; PG8_MMA(0, 0, At, B0); PG8_MMA(0, 1, At, B1); PG8_BAR; PG8_SCHED;
            PG8_LDA(At, 1, 1); PG8_STAGE(PG8_SB(1, 0), b3, voffB); PG8_STAGE(PG8_SB(1, 1), b3 + hstep, voffB); PG8_STAGE(PG8_SA(1, 0), a3, voffA);
            PG8_WAIT_V(8); PG8_WAIT_L(0); PG8_BAR; PG8_MMA(1, 0, At, B0); PG8_MMA(1, 1, At, B1); PG8_BAR; PG8_SCHED;
            } else {
            PG8_LDB(B0, 0, 0); PG8_SCHED; PG8_LDA(At, 0, 0); PG8_STAGE(PG8_SA(1, 1), a1 + hstep, voffA);
            PG8_WAIT_L(8); PG8_BAR; PG8_WAIT_L(0); PG8_MMA(0, 0, At, B0); PG8_BAR; PG8_SCHED;
            PG8_LDB(B1, 0, 1); PG8_STAGE(PG8_SB(0, 0), b2, voffB);
            PG8_BAR; PG8_WAIT_L(0); PG8_MMA(0, 1, At, B1); PG8_BAR;
            PG8_LDA(At, 0, 1); PG8_STAGE(PG8_SA(0, 0), a2, voffA);
            PG8_BAR; PG8_WAIT_L(0); PG8_MMA(1, 0, At, B0); PG8_BAR; PG8_SCHED;
            PG8_STAGE(PG8_SB(0, 1), b2 + hstep, voffB);
            PG8_WAIT_V(6); PG8_BAR; PG8_MMA(1, 1, At, B1); PG8_BAR;
            PG8_LDB(B0, 1, 0); PG8_SCHED; PG8_LDA(At, 1, 0); PG8_STAGE(PG8_SA(0, 1), a2 + hstep, voffA);
            PG8_WAIT_L(8); PG8_BAR; PG8_WAIT_L(0); PG8_MMA(0, 0, At, B0); PG8_BAR; PG8_SCHED;
            PG8_LDB(B1, 1, 1); PG8_STAGE(PG8_SB(1, 0), b3, voffB);
            PG8_BAR; PG8_WAIT_L(0); PG8_MMA(0, 1, At, B1); PG8_BAR;
            PG8_LDA(At, 1, 1); PG8_STAGE(PG8_SA(1, 0), a3, voffA);
            PG8_BAR; PG8_WAIT_L(0); PG8_MMA(1, 0, At, B0); PG8_BAR; PG8_SCHED;
            PG8_STAGE(PG8_SB(1, 1), b3 + hstep, voffB);
            PG8_WAIT_V(6); PG8_BAR; PG8_MMA(1, 1, At, B1); PG8_BAR;
            }
        }
        if constexpr (ALIGN_EPI) { if (wr == 0) PG8_BAR; }
        if constexpr (!Epi::AFTER_DRAIN) { E(acc, cur, wr, wc, fr, fq); S.done(cur); }
        if (!has_next) break;
#pragma unroll
        for (int a = 0; a < 2; ++a)
#pragma unroll
            for (int b = 0; b < 2; ++b)
#pragma unroll
                for (int m = 0; m < 4; ++m)
#pragma unroll
                    for (int n = 0; n < 2; ++n) acc[a][b][m][n] = (f32x4){0.f, 0.f, 0.f, 0.f};
        cur = nxt; cA = nA; cB = nB; ++ui;
        if constexpr (ALIGN_EPI) { if (wr == 1) PG8_BAR; }
    }
    PG8_WAIT_V(0);
    if constexpr (!ALIGN_EPI) { if (wr == 0) PG8_BAR; }
    PG8_BAR;
    if constexpr (Epi::AFTER_DRAIN) { E.fused(acc, cur, wr, wc, fr, fq, lds, wid, lane); S.done(cur); }
#undef PG8_SA
#undef PG8_SB
#undef PG8_STAGE
#undef PG8_LDA
#undef PG8_LDB
#undef PG8_MMA
#undef PG8_WAIT_V
#undef PG8_WAIT_L
#undef PG8_BAR
#undef PG8_SCHED
}
}
#define XB_TMO      128
#define XB_XCNT(j)  (256  + 64 * (j))
#define XB_XSUB(j)  (1280 + 64 * (j))
#define XB_XGEN(j)  (2304 + 64 * (j))
#define XB_TOP      3328
#define XB_TOPGEN   3392
#define XCD_BAR_WORDS 3456
#define XB_SPIN_CAP (1u << 18)

__device__ __forceinline__ unsigned xb_ld(unsigned* p)              { return __hip_atomic_load(p, __ATOMIC_RELAXED, __HIP_MEMORY_SCOPE_AGENT); }
__device__ __forceinline__ unsigned xb_add(unsigned* p, unsigned v) { return __hip_atomic_fetch_add(p, v, __ATOMIC_RELAXED, __HIP_MEMORY_SCOPE_AGENT); }
__device__ __forceinline__ unsigned xb_xcc_id() { return (unsigned)__builtin_amdgcn_s_getreg((3 << 11) | 20) & 0xFu; }
#define XB_SPIN(cond, bar) do { unsigned _sp = 0; while (cond) { __builtin_amdgcn_s_sleep(1); \
    if ((++_sp & 255u) == 0u) { if (xb_ld(&(bar)[XB_TMO])) break; if (_sp > XB_SPIN_CAP) { atomicAdd(&(bar)[XB_TMO], 1u); break; } } } } while (0)

struct XcdBarrier {
    unsigned* bar; unsigned x;
    volatile LAS unsigned* st;
    int w;
};

__device__ __forceinline__ bool xb_leader(int w) { unsigned l; asm volatile("v_mbcnt_lo_u32_b32 %0, -1, 0\n\tv_mbcnt_hi_u32_b32 %0, -1, %0" : "=v"(l)); return w == 0 && l == 0u; }
__device__ __forceinline__ XcdBarrier xcd_barrier_post(unsigned* bar, volatile LAS unsigned* st, int wave) {
    XcdBarrier b; b.bar = bar; b.x = xb_xcc_id(); b.st = st; b.w = wave;
    if (xb_leader(wave)) (void)xb_add(&bar[XB_XCNT(b.x)], 1u);
    return b;
}
__device__ __forceinline__ void xcd_barrier_complete(unsigned* bar, unsigned x, unsigned& nloc, unsigned& nx) {
    const unsigned G = gridDim.x * gridDim.y * gridDim.z;
    unsigned sum, cnt, mine, sp = 0u;
    for (;;) {
        sum = 0u; cnt = 0u; mine = 0u;
#pragma unroll
        for (unsigned j = 0; j < 16; ++j) { const unsigned c = xb_ld(&bar[XB_XCNT(j)]); sum += c; cnt += (c > 0u) ? 1u : 0u; mine = (j == x) ? c : mine; }
        if (sum == G) break;
        __builtin_amdgcn_s_sleep(1);
        if ((++sp & 255u) == 0u) { if (xb_ld(&bar[XB_TMO])) break; if (sp > XB_SPIN_CAP) { atomicAdd(&bar[XB_TMO], 1u); break; } }
    }
    nloc = mine > 0u ? mine : 1u; nx = cnt > 0u ? cnt : 1u;
}

__device__ __forceinline__ void xcd_barrier(const XcdBarrier& b) {
    asm volatile("s_waitcnt vmcnt(0)" ::: "memory");
    __syncthreads();
    if (xb_leader(b.w)) {
        unsigned* bar = b.bar;
        __builtin_amdgcn_s_waitcnt(0);
        unsigned nloc = b.st[0], nx = b.st[1];
        if (nloc == 0u) { xcd_barrier_complete(bar, b.x, nloc, nx); b.st[0] = nloc; b.st[1] = nx; }
        const unsigned old = xb_add(&bar[XB_XSUB(b.x)], 1u);
        const unsigned gen = old / nloc;
        if (old + 1u == (gen + 1u) * nloc) {
            __builtin_amdgcn_fence(__ATOMIC_RELEASE, "agent");
            asm volatile("s_waitcnt vmcnt(0)" ::: "memory");
            const unsigned og = xb_add(&bar[XB_TOP], 1u);
            const unsigned tg = og / nx;
            if (og + 1u == (tg + 1u) * nx) xb_add(&bar[XB_TOPGEN], 1u);
            else XB_SPIN(xb_ld(&bar[XB_TOPGEN]) == tg, bar);
            __builtin_amdgcn_fence(__ATOMIC_ACQUIRE, "agent");
            xb_add(&bar[XB_XGEN(b.x)], 1u);
            asm volatile("s_waitcnt vmcnt(0)" ::: "memory");
        } else {
            XB_SPIN(xb_ld(&bar[XB_XGEN(b.x)]) == gen, bar);
            __builtin_amdgcn_fence(__ATOMIC_ACQUIRE, "agent");
            asm volatile("s_waitcnt vmcnt(0)" ::: "memory");
        }
    }
    __syncthreads();
}
namespace da {
constexpr int SLOT_K = 8192, SLOT_V = 16384;
constexpr int LDS_K = 0, LDS_V = 3 * SLOT_K;
constexpr int LDS_BIAS = LDS_V + 3 * SLOT_V;
constexpr int TAB_NR = BIAS_TAB - 4, TAB_CL = 2304;
constexpr int LDS_TREV = LDS_BIAS + BIAS_TAB * 4;
constexpr int LDS_FLAG = LDS_TREV + 4 * TAB_CL * 4;
constexpr int LDS_END = LDS_FLAG + 16;
static_assert(LDS_END <= RING_BYTES && (LDS_TREV % 16) == 0 && (TAB_NR % 4) == 0, "attention LDS map");
constexpr float THR = 8.f;
__device__ __forceinline__ int crow(int r, int hi) { return (r & 3) + 8 * (r >> 2) + 4 * hi; }
__device__ __forceinline__ void glds16(const void* gbase  , unsigned voff  , unsigned lds_dst) { unsigned keep;
    asm volatile("s_mov_b32 %0, m0\n\ts_mov_b32 m0, %3\n\ts_nop 0\n\tglobal_load_lds_dwordx4 %1, %2\n\ts_mov_b32 m0, %0" : "=&s"(keep) : "v"(voff), "s"(gbase), "s"(lds_dst) : "memory"); }
typedef short v4i16_t __attribute__((ext_vector_type(4)));
__device__ __forceinline__ s16x4 vtr(const LAS char* p) { return __builtin_bit_cast(s16x4, __builtin_amdgcn_ds_read_tr16_b64_v4i16((LAS v4i16_t*)p)); }

struct Tensors { const bf16* Qd; const bf16* Kd; const bf16* Vd; float* stash; bf16* ya; const float* dlam; const float* subg; const float* relb; };

#define DA_SBAR() __builtin_amdgcn_sched_barrier(0)
#define DA_PIN(x) asm volatile("" : "+v"(x))
#define DA_MFMA(a, b, c) __builtin_amdgcn_mfma_f32_32x32x16_bf16(a, b, c, 0, 0, 0)
#define DA_MX3(a, b, c) __builtin_fmaxf(__builtin_fmaxf((a), (b)), (c))
__device__ __forceinline__ float rowmax(const f32x16& p0, const f32x16& p1) {
    float a = DA_MX3(p0[0], p0[1], p1[0]), b = DA_MX3(p0[2], p0[3], p1[1]); a = DA_MX3(a, p1[2], p1[3]);
#pragma unroll
    for (int r = 4; r < 16; r += 4) { a = DA_MX3(a, p0[r], p0[r + 1]); b = DA_MX3(b, p0[r + 2], p0[r + 3]); a = DA_MX3(a, p1[r], p1[r + 1]); b = DA_MX3(b, p1[r + 2], p1[r + 3]); }
    float mx = __builtin_fmaxf(a, b); auto rr = __builtin_amdgcn_permlane32_swap(__float_as_uint(mx), __float_as_uint(mx), false, false);
    return __builtin_fmaxf(__uint_as_float(rr[0]), __uint_as_float(rr[1])); }

#define DA_TABINIT(N0, N1, T_) do { int base_ = qabs - 64 * (T_) - 4 * hi + BIAS_GUARD; asm volatile("" : "+v"(base_)); \
        _Pragma("unroll") for (int r = 0; r < 16; ++r) { const int o_ = (r & 3) + 8 * (r >> 2); N0[r] = tb[base_ - o_] - m; N1[r] = tb[base_ - o_ - 32] - m; } } while (0)
#define DA_TREV4(N, j, off) do { const f32x4 t4_ = *(const LAS f32x4*)(ta_ + (off)); N[4 * (j)] = t4_[0]; N[4 * (j) + 1] = t4_[1]; N[4 * (j) + 2] = t4_[2]; N[4 * (j) + 3] = t4_[3]; } while (0)
#define DA_TREVINIT(N0, N1, T_) do { const LAS char* ta_ = trev0 + 256 * (T_); DA_TREV4(N0, 0, 0); DA_TREV4(N0, 1, 32); DA_TREV4(N0, 2, 64); DA_TREV4(N0, 3, 96); \
        DA_TREV4(N1, 0, 128); DA_TREV4(N1, 1, 160); DA_TREV4(N1, 2, 192); DA_TREV4(N1, 3, 224); } while (0)
#define DA_NEARINIT(N0, N1, T_) do { if (OPT) DA_TREVINIT(N0, N1, T_); else DA_TABINIT(N0, N1, T_); } while (0)
#define DA_MASK(C0, C1, T_) do { int base_ = qabs - 64 * (T_) - 4 * hi + BIAS_GUARD; asm volatile("" : "+v"(base_)); \
        _Pragma("unroll") for (int r = 0; r < 16; ++r) { const int o_ = (r & 3) + 8 * (r >> 2); if (base_ - o_ < BIAS_GUARD) C0[r] = -1e30f; if (base_ - o_ - 32 < BIAS_GUARD) C1[r] = -1e30f; } } while (0)
#define DA_FAR(T_) ((q0 - 64 * (T_) - 63) >= DFAR)
#define DA_PKW(P, i) cvtpk(P[i], P[(i) + 1])
#define DA_PAF(k) __builtin_bit_cast(bf16x8, pw[k])
#define DA_VOFF(g) ((2 * ((g) >> 3) + ((g) & 1)) * 4096 + (((g) >> 1) & 3) * 1024)
#define DA_VRD(g) do { vl[(g) % 5] = vtr(vp_ + DA_VOFF(g)); vh[(g) % 5] = vtr(vp_ + DA_VOFF(g) + 512); } while (0)
#define DA_VFR(g) (bf16x8){vl[(g) % 5][0], vl[(g) % 5][1], vl[(g) % 5][2], vl[(g) % 5][3], vh[(g) % 5][0], vh[(g) % 5][1], vh[(g) % 5][2], vh[(g) % 5][3]}
#define DA_KRD(G, j) do { if (G) kf[j] = *(const LAS bf16x8*)(kp_ + ((j) >> 1) * 2048 + ((j) & 1) * 512); } while (0)
#define DA_GAPA(MF, a0, a1, a2, a3, W0, W1, PW, G, j) do { MF; DA_KRD(G, j); sacc += a0; sacc += a1; sacc += a2; sacc += a3; W0; W1; DA_PIN(PW); DA_PIN(sacc); DA_SBAR(); } while (0)
#define DA_GAPB(g, X, i) do { o[2 * ((g) >> 3) + ((g) & 1)] = DA_MFMA(DA_VFR(g), DA_PAF(((g) >> 1) & 3), o[2 * ((g) >> 3) + ((g) & 1)]); \
        X[i] = __builtin_amdgcn_exp2f(X[i]); X[(i) + 1] = __builtin_amdgcn_exp2f(X[(i) + 1]); DA_PIN(X); DA_SBAR(); } while (0)
#define DA_STEP(OPT, C0, C1, P0, P1, T_, MASK, GK, GV, GL, FARV, NEARN) do { DA_SBAR(); const int t_ = (T_); \
    const LAS char* vp_ = vp0 + sl_prev * SLOT_V; const LAS char* kp_ = kp0 + sl_next * SLOT_K; const LAS char* ta_ = trev0 + 256 * (t_ + 1); (void)ta_; \
    if (!OPT && FARV) { const float cm_ = c31 - m; _Pragma("unroll") for (int r = 0; r < 16; ++r) { C0[r] = cm_; C1[r] = cm_; } }     \
    float sacc = P0[0] + P0[1]; \
                       DA_GAPA(C0 = DA_MFMA(kf[0], qr[0], (OPT && FARV) ? cinit : C0), P0[2], P0[3], P0[4], P0[5],     pw[0][0] = DA_PKW(P0, 0),  pw[0][1] = DA_PKW(P0, 2),  pw[0], GL, 0); \
                       DA_GAPA(C1 = DA_MFMA(kf[1], qr[0], (OPT && FARV) ? cinit : C1), P0[6], P0[7], P0[8], P0[9],     pw[0][2] = DA_PKW(P0, 4),  pw[0][3] = DA_PKW(P0, 6),  pw[0], GL, 1); \
                       DA_GAPA(C0 = DA_MFMA(kf[2], qr[1], C0),               P0[10], P0[11], P0[12], P0[13], pw[1][0] = DA_PKW(P0, 8),  pw[1][1] = DA_PKW(P0, 10), pw[1], GL, 2); \
                       DA_GAPA(C1 = DA_MFMA(kf[3], qr[1], C1),               P0[14], P0[15], P1[0], P1[1],   pw[1][2] = DA_PKW(P0, 12), pw[1][3] = DA_PKW(P0, 14), pw[1], GL, 3); \
    DA_VRD(0); DA_SBAR(); DA_GAPA(C0 = DA_MFMA(kf[4], qr[2], C0),               P1[2], P1[3], P1[4], P1[5],     pw[2][0] = DA_PKW(P1, 0),  pw[2][1] = DA_PKW(P1, 2),  pw[2], GL, 4); \
    DA_VRD(1); DA_SBAR(); DA_GAPA(C1 = DA_MFMA(kf[5], qr[2], C1),               P1[6], P1[7], P1[8], P1[9],     pw[2][2] = DA_PKW(P1, 4),  pw[2][3] = DA_PKW(P1, 6),  pw[2], GL, 5); \
    DA_VRD(2); DA_SBAR(); DA_GAPA(C0 = DA_MFMA(kf[6], qr[3], C0),               P1[10], P1[11], P1[12], P1[13], pw[3][0] = DA_PKW(P1, 8),  pw[3][1] = DA_PKW(P1, 10), pw[3], GL, 6); \
    DA_VRD(3); DA_SBAR(); DA_GAPA(C1 = DA_MFMA(kf[7], qr[3], C1),               P1[14], P1[15], 0.f, 0.f,       pw[3][2] = DA_PKW(P1, 12), pw[3][3] = DA_PKW(P1, 14), pw[3], GL, 7); \
    l += sacc; \
    if (MASK) { if (t_ >= NT - 4) DA_MASK(C0, C1, t_); } \
    if (!OPT) { const float rm_ = rowmax(C0, C1); resc = false; \
      if (__builtin_expect(__any(rm_ > THR), 0)) { const float dl_ = __builtin_fmaxf(rm_, 0.f); m += dl_; fsc = __builtin_amdgcn_exp2f(-dl_); l *= fsc; resc = true; \
          _Pragma("unroll") for (int r = 0; r < 16; ++r) { C0[r] -= dl_; C1[r] -= dl_; } \
          } } \
    DA_SBAR(); \
    DA_VRD(4);                  DA_SBAR(); DA_GAPB(0, C0, 0); \
    DA_VRD(5);                  DA_SBAR(); DA_GAPB(1, C0, 2); \
    DA_VRD(6);                  DA_SBAR(); DA_GAPB(2, C0, 4); \
    DA_VRD(7);                  DA_SBAR(); DA_GAPB(3, C0, 6); \
    DA_VRD(8);                  DA_SBAR(); DA_GAPB(4, C0, 8); \
    DA_VRD(9);                  DA_SBAR(); DA_GAPB(5, C0, 10); \
    DA_VRD(10);                 DA_SBAR(); DA_GAPB(6, C0, 12); \
    DA_VRD(11);                 DA_SBAR(); DA_GAPB(7, C0, 14); \
    DA_VRD(12);                 DA_SBAR(); DA_GAPB(8, C1, 0); \
    DA_VRD(13);                 DA_SBAR(); DA_GAPB(9, C1, 2); \
    DA_VRD(14);                 DA_SBAR(); DA_GAPB(10, C1, 4); \
    DA_VRD(15);                 DA_SBAR(); DA_GAPB(11, C1, 6); \
    if (OPT && NEARN) { DA_TREV4(P0, 0, 0);  DA_TREV4(P0, 1, 32); }  DA_SBAR(); DA_GAPB(12, C1, 8); \
    if (GK) DA_DMA_K(t_ + 3, sl_cur);                                                           \
    if (OPT && NEARN) { DA_TREV4(P0, 2, 64); DA_TREV4(P0, 3, 96); }  DA_SBAR(); DA_GAPB(13, C1, 10); \
    if (GV) DA_DMA_V(t_ + 1, sl_next);                                                          \
    if (OPT && NEARN) { DA_TREV4(P1, 0, 128); DA_TREV4(P1, 1, 160); } DA_SBAR(); DA_GAPB(14, C1, 12); \
    if (OPT && NEARN) { DA_TREV4(P1, 2, 192); DA_TREV4(P1, 3, 224); } DA_SBAR(); DA_GAPB(15, C1, 14); \
    if (!OPT && NEARN) DA_TABINIT(P0, P1, t_ + 1); \
    } while (0)
#define DA_RESC() do { if (resc) { _Pragma("unroll") for (int d0 = 0; d0 < 4; ++d0) _Pragma("unroll") for (int r = 0; r < 16; ++r) o[d0][r] *= fsc; } } while (0)
#define DA_WAITB(N) asm volatile("s_waitcnt vmcnt(" #N ") lgkmcnt(0)\n\ts_barrier" ::: "memory")
#define DA_ROT() do { sl_prev = sl_cur; sl_cur = sl_next; sl_next = (sl_next == 2) ? 0 : sl_next + 1; } while (0)
#define DA_ENDW(tt) do { if ((tt) + 3 < NT) { DA_WAITB(3); } else if ((tt) + 2 < NT) { DA_WAITB(2); } else { DA_WAITB(0); } } while (0)

template <bool OPT>
__device__ __forceinline__ void pass(const Tensors& X, int b, int h, int c, const int q0, const int NT, LAS unsigned char* lds, float c31, const int wid, f32x16 (&o)[4], float& l_out) {
    const unsigned lds0 = (unsigned)(uintptr_t)lds;
    const LAS float* tb = (const LAS float*)(lds + LDS_BIAS); (void)tb;
    {
        int lane = (int)__builtin_amdgcn_mbcnt_hi(~0u, __builtin_amdgcn_mbcnt_lo(~0u, 0u)); asm volatile("" : "+v"(lane));
        const int r32 = lane & 31, hi = lane >> 5;
        const unsigned lane16 = (unsigned)lane * 16u;
        const int qabs = q0 + wid * 32 + r32;
        const LAS char* vp0 = (const LAS char*)lds + LDS_V + ((lane >> 4) & 1) * 32 + (lane & 3) * 8 + (4 * hi + ((lane & 15) >> 2)) * 64;
        const LAS char* kp0 = (const LAS char*)lds + LDS_K + hi * 1024 + r32 * 16;
        const LAS char* trev0 = (const LAS char*)lds + LDS_TREV + (r32 & 3) * (TAB_CL * 4) + 4 * (TAB_NR - (qabs - (r32 & 3) - 4 * hi + BIAS_GUARD));
        const int bhc = (b * 4 + h) * 2 + c;
        const bf16* Qw = X.Qd + ((size_t)bhc * SEQ + q0 + wid * 32 + r32) * 64 + hi * 8;
        const char* Kt = (const char*)X.Kd + (size_t)bhc * NTILE * SLOT_K + wid * 1024;
        const char* Vt = (const char*)X.Vd + (size_t)(b * 4 + h) * NTILE * SLOT_V + wid * 1024;
#define DA_DMA_K(t, slot) glds16(Kt + (size_t)(t) * SLOT_K, lane16, (unsigned)__builtin_amdgcn_readfirstlane(lds0 + LDS_K + (slot) * SLOT_K + wid * 1024))
#define DA_DMA_V(t, slot) do { const unsigned sb_ = (unsigned)__builtin_amdgcn_readfirstlane(lds0 + LDS_V + (slot) * SLOT_V + wid * 1024); \
        glds16(Vt + (size_t)(t) * SLOT_V, lane16, sb_); glds16(Vt + (size_t)(t) * SLOT_V + 8192, lane16, sb_ + 8192); } while (0)
        DA_DMA_K(0, 0); DA_DMA_V(0, 0); DA_DMA_K(1, 1); DA_DMA_K(2, 2);
        bf16x8 qr[4];
#pragma unroll
        for (int d0 = 0; d0 < 4; ++d0) qr[d0] = *(const bf16x8*)(Qw + d0 * 16);
#pragma unroll
        for (int d0 = 0; d0 < 4; ++d0)
#pragma unroll
            for (int r = 0; r < 16; ++r) o[d0][r] = 0.f;
        float m = 0.f, l = 0.f, fsc = 1.f; bool resc = false; (void)fsc; (void)resc;
        f32x16 pA0, pA1, pB0, pB1, cinit; bf16x8 kf[8]; s16x4 vl[5], vh[5]; v4u pw[4];
        int sl_prev = 0, sl_cur = 1, sl_next = 2;
        asm volatile("" :: "v"(qr[0]), "v"(qr[1]), "v"(qr[2]), "v"(qr[3]));
        DA_WAITB(4);
        {   const LAS char* kp_ = kp0;
#pragma unroll
            for (int j = 0; j < 8; ++j) DA_KRD(true, j);
            if (DA_FAR(0)) {
#pragma unroll
                for (int r = 0; r < 16; ++r) { pA0[r] = c31; pA1[r] = c31; }
            } else DA_NEARINIT(pA0, pA1, 0);
#pragma unroll
            for (int d0 = 0; d0 < 4; ++d0) { pA0 = DA_MFMA(kf[2 * d0], qr[d0], pA0); pA1 = DA_MFMA(kf[2 * d0 + 1], qr[d0], pA1); }
            if (NT == 4) DA_MASK(pA0, pA1, 0);
            if (!OPT) m = rowmax(pA0, pA1);
#pragma unroll
            for (int r = 0; r < 16; ++r) { pA0[r] = __builtin_amdgcn_exp2f(pA0[r] - m); pA1[r] = __builtin_amdgcn_exp2f(pA1[r] - m); }
        }
        DA_WAITB(0);
        DA_DMA_K(3, 0); DA_DMA_V(1, 1);
        {   const LAS char* kp_ = kp0 + SLOT_K;
#pragma unroll
            for (int j = 0; j < 8; ++j) DA_KRD(true, j);
        }
        DA_WAITB(3);
        {   const float cm = c31 - m;
#pragma unroll
            for (int r = 0; r < 16; ++r) cinit[r] = cm; }
        int t = 1;
        for (; t + 5 < NT && DA_FAR(t + 1); t += 2) {
            DA_STEP(OPT, pB0, pB1, pA0, pA1, t, false, true, true, true, true, false);     DA_WAITB(3); DA_RESC(); DA_ROT();
            DA_STEP(OPT, pA0, pA1, pB0, pB1, t + 1, false, true, true, true, true, false); DA_WAITB(3); DA_RESC(); DA_ROT();
        }
        DA_NEARINIT(pB0, pB1, t);
        for (; t + 5 < NT; t += 2) {
            DA_STEP(OPT, pB0, pB1, pA0, pA1, t, false, true, true, true, false, true);     DA_WAITB(3); DA_RESC(); DA_ROT();
            DA_STEP(OPT, pA0, pA1, pB0, pB1, t + 1, false, true, true, true, false, true); DA_WAITB(3); DA_RESC(); DA_ROT();
        }
        for (; t + 1 < NT; t += 2) {
            DA_STEP(OPT, pB0, pB1, pA0, pA1, t, true, (t + 3 < NT), (t + 1 < NT), (t + 1 < NT), false, true);         DA_ENDW(t);     DA_RESC(); DA_ROT();
            DA_STEP(OPT, pA0, pA1, pB0, pB1, t + 1, true, (t + 4 < NT), (t + 2 < NT), (t + 2 < NT), false, true);     DA_ENDW(t + 1); DA_RESC(); DA_ROT();
        }
        DA_STEP(OPT, pB0, pB1, pA0, pA1, NT - 1, true, false, false, false, false, false); DA_RESC();
        {   float sacc = pB0[0] + pB0[1];
#pragma unroll
            for (int r = 2; r < 16; ++r) sacc += pB0[r];
#pragma unroll
            for (int r = 0; r < 16; ++r) sacc += pB1[r];
            l += sacc;
            pw[0] = (v4u){DA_PKW(pB0, 0), DA_PKW(pB0, 2), DA_PKW(pB0, 4), DA_PKW(pB0, 6)}; pw[1] = (v4u){DA_PKW(pB0, 8), DA_PKW(pB0, 10), DA_PKW(pB0, 12), DA_PKW(pB0, 14)};
            pw[2] = (v4u){DA_PKW(pB1, 0), DA_PKW(pB1, 2), DA_PKW(pB1, 4), DA_PKW(pB1, 6)}; pw[3] = (v4u){DA_PKW(pB1, 8), DA_PKW(pB1, 10), DA_PKW(pB1, 12), DA_PKW(pB1, 14)};
            const LAS char* vb_ = vp0 + sl_cur * SLOT_V;
#pragma unroll
            for (int d0 = 0; d0 < 4; ++d0) {
#pragma unroll
                for (int ks = 0; ks < 4; ++ks) { const s16x4 lo_ = vtr(vb_ + d0 * 4096 + ks * 1024), hh_ = vtr(vb_ + d0 * 4096 + ks * 1024 + 512);
                    const bf16x8 vf_ = (bf16x8){lo_[0], lo_[1], lo_[2], lo_[3], hh_[0], hh_[1], hh_[2], hh_[3]};
                    o[d0] = DA_MFMA(vf_, DA_PAF(ks), o[d0]); }
                DA_SBAR(); }
        }
#undef DA_DMA_K
#undef DA_DMA_V
        l_out = l;
    }
}

__device__ __forceinline__ void unit(const Tensors& X, int b, int h, int qb, LAS unsigned char* lds, int wgslot, float lam, float c31, const int wid  ) {
    const int q0 = qb * 256, NT = 4 * (qb + 1);
    for (int c = 0; c < 2; ++c) {
        int lane = (int)__builtin_amdgcn_mbcnt_hi(~0u, __builtin_amdgcn_mbcnt_lo(~0u, 0u)); asm volatile("" : "+v"(lane));
        LAS unsigned* flag = (LAS unsigned*)(lds + LDS_FLAG);
        if (wid == 0 && lane == 0) *flag = 0u;
        f32x16 o[4]; float l;
        pass<true>(X, b, h, c, q0, NT, lds, c31, wid, o, l);
        { auto rr = __builtin_amdgcn_permlane32_swap(__float_as_uint(l), __float_as_uint(l), false, false); l = __uint_as_float(rr[0]) + __uint_as_float(rr[1]); }
        if (!__all(l > 1e-30f && l < 1e30f)) *flag = 1u;
        asm volatile("s_waitcnt vmcnt(0) lgkmcnt(0)\n\ts_barrier" ::: "memory");
        if (__builtin_expect(*(volatile LAS unsigned*)flag != 0u, 0)) {
            pass<false>(X, b, h, c, q0, NT, lds, c31, wid, o, l);
            { auto rr = __builtin_amdgcn_permlane32_swap(__float_as_uint(l), __float_as_uint(l), false, false); l = __uint_as_float(rr[0]) + __uint_as_float(rr[1]); }
        }
        const float inv = 1.f / l;
        int lane_e = lane; asm volatile("" : "+v"(lane_e));
        GAS unsigned* stg = (GAS unsigned*)((unsigned*)X.stash + ((size_t)(wgslot * 8 + wid) * 32) * 64 + lane_e);
        if (c == 0) {
#pragma unroll
            for (int d0 = 0; d0 < 4; ++d0)
#pragma unroll
                for (int r = 0; r < 16; r += 2) stg[(d0 * 8 + (r >> 1)) * 64] = cvtpk(o[d0][r] * inv, o[d0][r + 1] * inv);
        } else {
            float ss = 0.f;
#pragma unroll
            for (int d0 = 0; d0 < 4; ++d0)
#pragma unroll
                for (int r = 0; r < 16; r += 2) { const unsigned w1 = stg[(d0 * 8 + (r >> 1)) * 64]; const float dv0 = bf_lo(w1) - lam * (o[d0][r] * inv), dv1 = bf_hi(w1) - lam * (o[d0][r + 1] * inv);
                    o[d0][r] = dv0; o[d0][r + 1] = dv1; ss += dv0 * dv0 + dv1 * dv1; if (r == 14) asm volatile("" ::: "memory"); }
            { auto rr = __builtin_amdgcn_permlane32_swap(__float_as_uint(ss), __float_as_uint(ss), false, false); ss = __uint_as_float(rr[0]) + __uint_as_float(rr[1]); }
            const float rn = __builtin_amdgcn_rsqf(ss * (1.f / 128.f) + SUBLN_EPS) * (1.f - LAM_INIT);
            const int hi_e = lane_e >> 5, qabs_e = q0 + wid * 32 + (lane_e & 31);
            bf16* yrow = X.ya + ((size_t)b * SEQ + qabs_e) * 512 + h * 128 + 4 * hi_e; const float* sg = X.subg + 4 * hi_e;
#pragma unroll
            for (int d0 = 0; d0 < 4; ++d0)
#pragma unroll
                for (int r4 = 0; r4 < 4; ++r4) {
                    const int dd = 32 * d0 + 8 * r4; const f32x4 g = *(const f32x4*)(sg + dd);
                    v2u w; w.x = pk2(o[d0][4 * r4] * rn * g[0], o[d0][4 * r4 + 1] * rn * g[1]); w.y = pk2(o[d0][4 * r4 + 2] * rn * g[2], o[d0][4 * r4 + 3] * rn * g[3]);
                    *(v2u*)(yrow + dd) = w;
                }
        }
        asm volatile("s_waitcnt vmcnt(0) lgkmcnt(0)\n\ts_barrier" ::: "memory");
    }
}
#undef DA_STEP
#undef DA_GAPA
#undef DA_GAPB
#undef DA_KRD
#undef DA_VRD
#undef DA_VFR
#undef DA_VOFF
#undef DA_PAF
#undef DA_PKW
#undef DA_FAR
#undef DA_MASK
#undef DA_TREV4
#undef DA_TREVINIT
#undef DA_NEARINIT
#undef DA_TABINIT
#undef DA_RESC
#undef DA_WAITB
#undef DA_ROT
#undef DA_ENDW
#undef DA_MX3
#undef DA_MFMA
#undef DA_PIN
#undef DA_SBAR
}
namespace dil {
constexpr int BT = 1152, BT0 = 512;
constexpr int LDS_VST = 0, LDS_BL = 32768, LDS_END = LDS_BL + 3 * BT * 4;
constexpr float THR = 8.f;
struct Tensors { const bf16* LQ; const bf16* LK; const bf16* LV; bf16* yb; };
typedef short v4i16_t __attribute__((ext_vector_type(4)));
__device__ __forceinline__ s16x4 vtr(const LAS unsigned char* p) { return __builtin_bit_cast(s16x4, __builtin_amdgcn_ds_read_tr16_b64_v4i16((LAS v4i16_t*)p)); }

template <int G_, int QS_> __device__ __forceinline__ void group(const Tensors& X, size_t rowb, int h, int P0, int r, LAS unsigned char* vst, const LAS float* blg, int lane, f32x16 (&o)[2], float& m, float& l) {
    constexpr int DL = (G_ == 0) ? 1 : (G_ == 1) ? 4 : 16, MG = QS_ / DL, NKB = (31 * MG + 128) / 32 + 1;
    static_assert(QS_ % DL == 0, "query stride must be a multiple of the dilation");
    const int i = lane & 31, hi = lane >> 5;
    const int colb = G_ * 256 + h * 64;
    bf16x8 qr[4];
    { const bf16* qp = X.LQ + (rowb + P0 + r + QS_ * i) * 768 + colb + hi * 8;
#pragma unroll
      for (int d0 = 0; d0 < 4; ++d0) qr[d0] = *(const bf16x8*)(qp + 16 * d0); }
    const int kpos0 = P0 + r - 128 * DL;
    const LAS unsigned char* vrd = vst + ((lane >> 4) & 1) * 32 + (lane & 3) * 8 + (4 * hi + ((lane & 15) >> 2)) * 64;
#define DIL_LOAD(KF, VR, KB) do { \
        { int kpos_ = kpos0 + (32 * (KB) + i) * DL; kpos_ = kpos_ < 0 ? 0 : (kpos_ > SEQ - 1 ? SEQ - 1 : kpos_); const bf16* kp_ = X.LK + (rowb + kpos_) * 768 + colb + hi * 8; \
          _Pragma("unroll") for (int d0 = 0; d0 < 4; ++d0) KF[d0] = *(const bf16x8*)(kp_ + 16 * d0); } \
        _Pragma("unroll") for (int t = 0; t < 4; ++t) { const int qd = lane + 64 * t, key = qd >> 3, ch = qd & 7; int vpos_ = kpos0 + (32 * (KB) + key) * DL; vpos_ = vpos_ < 0 ? 0 : (vpos_ > SEQ - 1 ? SEQ - 1 : vpos_); \
            VR[t] = *(const v4u*)(X.LV + (rowb + vpos_) * 768 + colb + ch * 8); } } while (0)
    bf16x8 kfn[4]; v4u vregn[4];
    DIL_LOAD(kfn, vregn, 0);
#pragma unroll 1
    for (int kb = 0; kb < NKB; ++kb) {
        bf16x8 kf[4]; v4u vreg[4];
#pragma unroll
        for (int d0 = 0; d0 < 4; ++d0) { kf[d0] = kfn[d0]; vreg[d0] = vregn[d0]; }
        if (kb + 1 < NKB) DIL_LOAD(kfn, vregn, kb + 1);
        const int jb = i * MG + 128 - 32 * kb - 4 * hi;
        f32x16 p;
#pragma unroll
        for (int rr = 0; rr < 16; ++rr) p[rr] = blg[jb - ((rr & 3) + 8 * (rr >> 2)) + BT0];
#pragma unroll
        for (int d0 = 0; d0 < 4; ++d0) p = __builtin_amdgcn_mfma_f32_32x32x16_bf16(kf[d0], qr[d0], p, 0, 0, 0);
        const int cb = 32 * kb + 4 * hi;
#pragma unroll
        for (int rr = 0; rr < 16; ++rr) { const int o_ = (rr & 3) + 8 * (rr >> 2); if ((unsigned)(jb - o_) > 128u || kpos0 + (cb + o_) * DL < 0) p[rr] = -3e38f; }
        float rm = p[0];
#pragma unroll
        for (int rr = 1; rr < 16; ++rr) rm = fmaxf(rm, p[rr]);
        { auto sw = __builtin_amdgcn_permlane32_swap(__float_as_uint(rm), __float_as_uint(rm), false, false); rm = fmaxf(__uint_as_float(sw[0]), __uint_as_float(sw[1])); }
        if (__any(rm > m + THR)) {
            const float mn = fmaxf(m, rm), f = __builtin_amdgcn_exp2f(m - mn);
#pragma unroll
            for (int d0 = 0; d0 < 2; ++d0)
#pragma unroll
                for (int rr = 0; rr < 16; ++rr) o[d0][rr] *= f;
            l *= f; m = mn;
        }
        float ls = 0.f;
#pragma unroll
        for (int rr = 0; rr < 16; ++rr) { p[rr] = __builtin_amdgcn_exp2f(p[rr] - m); ls += p[rr]; }
        l += ls;
        bf16x8 pw[2];
        { v4u w;
          w.x = cvtpk(p[0], p[1]); w.y = cvtpk(p[2], p[3]); w.z = cvtpk(p[4], p[5]); w.w = cvtpk(p[6], p[7]); pw[0] = __builtin_bit_cast(bf16x8, w);
          w.x = cvtpk(p[8], p[9]); w.y = cvtpk(p[10], p[11]); w.z = cvtpk(p[12], p[13]); w.w = cvtpk(p[14], p[15]); pw[1] = __builtin_bit_cast(bf16x8, w); }
#pragma unroll
        for (int t = 0; t < 4; ++t) { const int qd = lane + 64 * t, key = qd >> 3, ch = qd & 7;
            *(LAS v4u*)(vst + ((ch >> 2) * 2 + (key >> 4)) * 1024 + (key & 15) * 64 + (ch & 3) * 16) = vreg[t]; }
        asm volatile("s_waitcnt lgkmcnt(0)" ::: "memory");
#pragma unroll
        for (int d0 = 0; d0 < 2; ++d0)
#pragma unroll
            for (int ks = 0; ks < 2; ++ks) {
                const s16x4 lo = vtr(vrd + (d0 * 2 + ks) * 1024), hh = vtr(vrd + (d0 * 2 + ks) * 1024 + 512);
                const bf16x8 vf = (bf16x8){lo[0], lo[1], lo[2], lo[3], hh[0], hh[1], hh[2], hh[3]};
                o[d0] = __builtin_amdgcn_mfma_f32_32x32x16_bf16(vf, pw[ks], o[d0], 0, 0, 0);
            }
        asm volatile("s_waitcnt lgkmcnt(0)" ::: "memory");
    }
#undef DIL_LOAD
}
__device__ __forceinline__ void wave_tile_g0(const Tensors& X, float* lse0, int b, int h, int P0, LAS unsigned char* vst, const LAS float* bl, int lane) {
    const size_t rowb = (size_t)b * SEQ;
    f32x16 o[2];
#pragma unroll
    for (int d0 = 0; d0 < 2; ++d0)
#pragma unroll
        for (int rr = 0; rr < 16; ++rr) o[d0][rr] = 0.f;
    float m = -1e30f, l = 0.f;
    group<0, 1>(X, rowb, h, P0, 0, vst, bl, lane, o, m, l);
    { auto sw = __builtin_amdgcn_permlane32_swap(__float_as_uint(l), __float_as_uint(l), false, false); l = __uint_as_float(sw[0]) + __uint_as_float(sw[1]); }
    const float inv = 1.f / l; const int i = lane & 31, hi = lane >> 5;
    bf16* yrow = X.yb + (rowb + P0 + i) * 256 + h * 64 + 4 * hi;
#pragma unroll
    for (int d0 = 0; d0 < 2; ++d0)
#pragma unroll
        for (int r4 = 0; r4 < 4; ++r4) { v2u w; w.x = pk2(o[d0][4 * r4] * inv, o[d0][4 * r4 + 1] * inv); w.y = pk2(o[d0][4 * r4 + 2] * inv, o[d0][4 * r4 + 3] * inv); *(v2u*)(yrow + 32 * d0 + 8 * r4) = w; }
    if (hi == 0) lse0[(rowb + P0 + i) * 4 + h] = m + __builtin_amdgcn_logf(l);
}
__device__ __forceinline__ void wave_tile(const Tensors& X, const float* lse0, int b, int h, int P0, int r, LAS unsigned char* vst, const LAS float* bl, int lane) {
    const size_t rowb = (size_t)b * SEQ;
    f32x16 o[2];
#pragma unroll
    for (int d0 = 0; d0 < 2; ++d0)
#pragma unroll
        for (int rr = 0; rr < 16; ++rr) o[d0][rr] = 0.f;
    float m = -1e30f, l = 0.f;
    group<1, 16>(X, rowb, h, P0, r, vst, bl + BT, lane, o, m, l);
    group<2, 16>(X, rowb, h, P0, r, vst, bl + 2 * BT, lane, o, m, l);
    { auto sw = __builtin_amdgcn_permlane32_swap(__float_as_uint(l), __float_as_uint(l), false, false); l = __uint_as_float(sw[0]) + __uint_as_float(sw[1]); }
    const int i = lane & 31, hi = lane >> 5;
    const float w0 = __builtin_amdgcn_exp2f(lse0[(rowb + P0 + r + 16 * i) * 4 + h] - m);
    const float inv = 1.f / (l + w0);
    bf16* yrow = X.yb + (rowb + P0 + r + 16 * i) * 256 + h * 64 + 4 * hi;
#pragma unroll
    for (int d0 = 0; d0 < 2; ++d0)
#pragma unroll
        for (int r4 = 0; r4 < 4; ++r4) { const v2u g0 = *(const v2u*)(yrow + 32 * d0 + 8 * r4);
            v2u w; w.x = pk2((o[d0][4 * r4] + w0 * bf_lo(g0.x)) * inv, (o[d0][4 * r4 + 1] + w0 * bf_hi(g0.x)) * inv); w.y = pk2((o[d0][4 * r4 + 2] + w0 * bf_lo(g0.y)) * inv, (o[d0][4 * r4 + 3] + w0 * bf_hi(g0.y)) * inv);
            *(v2u*)(yrow + 32 * d0 + 8 * r4) = w; }
}
}
__device__ __forceinline__ void p0_transpose_item(const float* W, int K, int N, bf16* WT, LAS float* scr, int item, int lane) {
    const int nblk = N / 32, kb = item / nblk, nb = item % nblk, k0 = 64 * kb, n0 = 32 * nb;
#pragma unroll 8
    for (int i = 0; i < 32; ++i) { const int kk = 2 * i + (lane >> 5); scr[kk * 33 + (lane & 31)] = W[(size_t)(k0 + kk) * N + n0 + (lane & 31)]; }
    LDS_WAIT(); asm volatile("" ::: "memory");
    const int c = lane & 7;
#pragma unroll
    for (int j = 0; j < 4; ++j) { const int n = (lane >> 3) + 8 * j; const LAS float* s = scr + (8 * c) * 33 + n;
        v4u o; o.x = pk2(s[0 * 33], s[1 * 33]); o.y = pk2(s[2 * 33], s[3 * 33]); o.z = pk2(s[4 * 33], s[5 * 33]); o.w = pk2(s[6 * 33], s[7 * 33]);
        *(v4u*)(WT + (size_t)(n0 + n) * K + k0 + 8 * c) = o; }
    LDS_WAIT(); asm volatile("" ::: "memory");
}
__device__ __forceinline__ void cast_bf16(const float* src, bf16* dst, size_t n8, size_t gtid, size_t gthreads) {
    for (size_t i = gtid; i < n8; i += gthreads) { const f32x4 a = *(const f32x4*)(src + i * 8), b = *(const f32x4*)(src + i * 8 + 4);
        v4u o; o.x = pk2(a[0], a[1]); o.y = pk2(a[2], a[3]); o.z = pk2(b[0], b[1]); o.w = pk2(b[2], b[3]); *(v4u*)(dst + i * 8) = o; }
}

struct Args { const float* in[16]; float* out; unsigned char* ws; int ph_lo, ph_hi; };
enum { I_X = 0, I_WIN, I_DLAM, I_SUBG, I_WBD, I_WBL, I_WO, I_LN1G, I_LN1B, I_PWQ, I_PKEYS, I_PU, I_PV, I_LN2G, I_LN2B, I_RELB };

__device__ __forceinline__ void p0_prologue(const Args& A, LAS unsigned char* lds, int vcu, int G, int wave, int lane) {
    unsigned char* ws = A.ws;
    const int gw = vcu * NWAVES + wave, NGW = G * NWAVES;
    const size_t gtid = (size_t)gw * 64 + lane, gthreads = (size_t)NGW * 64;
    LAS float* scr = (LAS float*)(lds + wave * 16384);
    constexpr int I_IN = (D / 64) * (INC / 32), I_BD = (512 / 64) * (D / 32), I_BL = (256 / 64) * (D / 32), I_O = (D / 64) * (D / 32);
    for (int it0 = gw; it0 < (I_IN + I_BD + I_BL + I_O) * NREP(32); it0 += NGW) {
        int r = it0 % (I_IN + I_BD + I_BL + I_O);
        if (r < I_IN) { p0_transpose_item(A.in[I_WIN], D, INC, (bf16*)(ws + WS_WIN), scr, r, lane); continue; } r -= I_IN;
        if (r < I_BD) { p0_transpose_item(A.in[I_WBD], 512, D, (bf16*)(ws + WS_WBD), scr, r, lane); continue; } r -= I_BD;
        if (r < I_BL) { p0_transpose_item(A.in[I_WBL], 256, D, (bf16*)(ws + WS_WBL), scr, r, lane); continue; } r -= I_BL;
        p0_transpose_item(A.in[I_WO], D, D, (bf16*)(ws + WS_WO), scr, r, lane);
    }
    for (int rep_ = 0; rep_ < NREP(31); ++rep_) cast_bf16(A.in[I_X], (bf16*)(ws + WS_A), (size_t)T * D / 8, gtid, gthreads);
    { const float* wq = A.in[I_PWQ]; const float* keys = A.in[I_PKEYS]; bf16* wp = (bf16*)(ws + WS_WP);
      for (int it0 = gw; it0 < 1024 * NREP(30); it0 += NGW) { const int it = it0 & 1023;
          const int hc = it >> 6, jb = (it >> 2) & 15, nq = it & 3, j = jb * 64 + lane;
          const f32x4* wr_ = (const f32x4*)(wq + (size_t)j * 2048 + hc * 128);
          f32x4 w[32];
#pragma unroll
          for (int d = 0; d < 32; ++d) w[d] = wr_[d];
#pragma unroll 1
          for (int n = nq * 32; n < nq * 32 + 32; ++n) {
              const f32x4* kr = (const f32x4*)(keys + (size_t)(hc * 128 + n) * 128);
              float a0 = 0.f, a1 = 0.f, a2 = 0.f, a3 = 0.f;
#pragma unroll
              for (int d = 0; d < 32; ++d) { const f32x4 k = kr[d]; a0 += w[d][0] * k[0]; a1 += w[d][1] * k[1]; a2 += w[d][2] * k[2]; a3 += w[d][3] * k[3]; }
              wp[(size_t)(hc * 128 + n) * 1024 + j] = (bf16)f2bf((a0 + a1) + (a2 + a3));
          }
      } }
    { const float* relb = A.in[I_RELB]; float* bd = (float*)(ws + WS_BIASD); float* bl = (float*)(ws + WS_BIASL);
      for (size_t i = gtid; i < 4 * BIAS_TAB; i += gthreads) { const int h = (int)(i / BIAS_TAB), dist = (int)(i % BIAS_TAB) - BIAS_GUARD; bd[i] = dist < 0 ? 0.f : relb[rel_bucket(dist) * 16 + h] * LOG2E; }
      for (size_t i = gtid; i < 12 * 132; i += gthreads) { const int gh = (int)(i / 132), j = (int)(i % 132), g = gh >> 2; const int dl = (g == 0) ? 1 : (g == 1) ? 4 : 16;
          bl[i] = relb[rel_bucket((j > 128 ? 128 : j) * dl) * 16 + 4 + gh] * LOG2E; } }
}

__device__ __forceinline__ void p5_ln1(const Args& A, int vcu, int G, int wave, int lane) {
    unsigned char* ws = A.ws;
    const int gw = vcu * NWAVES + wave, NGW = G * NWAVES;
    const float* R = (const float*)(ws + WS_R); bf16* x1b = (bf16*)(ws + WS_A);
    const float* gam = A.in[I_LN1G]; const float* bet = A.in[I_LN1B];
    f32x4 gv[4], bv[4];
#pragma unroll
    for (int j = 0; j < 4; ++j) { gv[j] = *(const f32x4*)(gam + 256 * j + 4 * lane); bv[j] = *(const f32x4*)(bet + 256 * j + 4 * lane); }
    f32x4 nx[4];
    if (gw < T) {
#pragma unroll
        for (int j = 0; j < 4; ++j) nx[j] = ((const f32x4*)(R + (size_t)gw * D) + lane)[64 * j]; }
#pragma unroll 1
    for (int mrow = gw; mrow < T; mrow += NGW) {
        f32x4 v[4]; float s = 0.f;
#pragma unroll
        for (int j = 0; j < 4; ++j) { v[j] = nx[j]; s += (v[j][0] + v[j][1]) + (v[j][2] + v[j][3]); }
        if (mrow + NGW < T) {
#pragma unroll
            for (int j = 0; j < 4; ++j) nx[j] = ((const f32x4*)(R + (size_t)(mrow + NGW) * D) + lane)[64 * j]; }
        const float mean = wave_sum(s) * (1.f / D); float s2 = 0.f;
#pragma unroll
        for (int j = 0; j < 4; ++j) { v[j] = v[j] - mean; s2 += (v[j][0] * v[j][0] + v[j][1] * v[j][1]) + (v[j][2] * v[j][2] + v[j][3] * v[j][3]); }
        const float rstd = __builtin_amdgcn_rsqf(wave_sum(s2) * (1.f / D) + LN_EPS);
        v2u* brow = (v2u*)(x1b + (size_t)mrow * D) + lane;
#pragma unroll
        for (int j = 0; j < 4; ++j) { const f32x4 y = v[j] * rstd * gv[j] + bv[j]; v2u w; w.x = pk2(y[0], y[1]); w.y = pk2(y[2], y[3]); brow[64 * j] = w; }
    }
}
namespace peer {
__device__ __forceinline__ int mono(float v) { const int b = __float_as_int(v); return b ^ ((b >> 31) & 0x7fffffff); }
__device__ __forceinline__ float unmono(int k) { return __int_as_float(k ^ ((k >> 31) & 0x7fffffff)); }
__device__ __forceinline__ int med3i(int a, int b, int c) { int r; asm("v_med3_i32 %0, %1, %2, %3" : "=v"(r) : "v"(a), "v"(b), "v"(c)); return r; }
#define PEER_INS16(a, x) do { _Pragma("unroll") for (int k_ = 15; k_ >= 1; --k_) a[k_] = med3i(a[k_ - 1], a[k_], (x)); a[0] = max(a[0], (x)); } while (0)
__device__ __forceinline__ unsigned byte_sel(const unsigned (&p)[4], int i) { const int w = i >> 2; const unsigned x = (w == 0) ? p[0] : (w == 1) ? p[1] : (w == 2) ? p[2] : p[3]; return (x >> ((i & 3) * 8)) & 0xffu; }
__device__ __forceinline__ float gelu_erf(float v) { return 0.5f * v * (1.f + erff(v * 0.7071067811865476f)); }

__device__ __forceinline__ void select(const float* ST, v2u* sel, int tok, int head) {
    int a0[16], a1[16];
#pragma unroll
    for (int k = 0; k < 16; ++k) { a0[k] = (int)0x80000000; a1[k] = (int)0x80000000; }
    const GAS float* s0 = (const GAS float*)ST + (size_t)(head * 256) * T + tok; const GAS float* s1 = s0 + (size_t)128 * T;
    float c0[8], c1[8];
#pragma unroll
    for (int i = 0; i < 8; ++i) { c0[i] = s0[(size_t)i * T]; c1[i] = s1[(size_t)i * T]; }
#pragma unroll 1
    for (int n = 0; n < 128; n += 8) {
        float x0[8], x1[8];
#pragma unroll
        for (int i = 0; i < 8; ++i) { x0[i] = c0[i]; x1[i] = c1[i]; }
        if (n + 8 < 128) {
#pragma unroll
            for (int i = 0; i < 8; ++i) { c0[i] = s0[(size_t)(n + 8 + i) * T]; c1[i] = s1[(size_t)(n + 8 + i) * T]; }
        }
#pragma unroll
        for (int i = 0; i < 8; ++i) { const int k0 = (mono(x0[i]) & ~127) | (127 - (n + i)), k1 = (mono(x1[i]) & ~127) | (127 - (n + i)); PEER_INS16(a0, k0); PEER_INS16(a1, k1); }
    }
    float v0[16], v1[16]; unsigned i0p[4] = {0u, 0u, 0u, 0u}, i1p[4] = {0u, 0u, 0u, 0u};
#pragma unroll
    for (int k = 0; k < 16; ++k) { v0[k] = unmono((a0[k] & ~127) | 64); v1[k] = unmono((a1[k] & ~127) | 64);
        i0p[k >> 2] |= (unsigned)(127 - (a0[k] & 127)) << (8 * (k & 3)); i1p[k >> 2] |= (unsigned)(127 - (a1[k] & 127)) << (8 * (k & 3)); }
    int cd[16];
#pragma unroll
    for (int k = 0; k < 16; ++k) cd[k] = (int)0x80000000;
#pragma unroll
    for (int i = 0; i < 16; ++i)
#pragma unroll
        for (int j = 0; j < 16; ++j)
            if ((i + 1) * (j + 1) <= 16) { const int k = (mono(v0[i] + v1[j]) & ~255) | (255 - (i * 16 + j)); PEER_INS16(cd, k); }
    float sv[16], ex[16], sum = 0.f; unsigned eid[16];
#pragma unroll
    for (int k = 0; k < 16; ++k) { const int code = 255 - (cd[k] & 255); eid[k] = byte_sel(i0p, code >> 4) * 128u + byte_sel(i1p, code & 15); sv[k] = unmono((cd[k] & ~255) | 128); }
#pragma unroll
    for (int k = 0; k < 16; ++k) { ex[k] = __expf(sv[k] - sv[0]); sum += ex[k]; }
    const float rs = 1.f / sum;
    GAS v4u* dst = (GAS v4u*)(sel + ((size_t)tok * 8 + head) * 16);
#pragma unroll
    for (int k = 0; k < 8; ++k) { v4u w; w.x = eid[2 * k]; w.y = __float_as_uint(ex[2 * k] * rs); w.z = eid[2 * k + 1]; w.w = __float_as_uint(ex[2 * k + 1] * rs); dst[k] = w; }
}

typedef float f32x2w __attribute__((ext_vector_type(2)));
struct G4 { const unsigned char* U8; const unsigned char* V8; const float* isu; const float* isv; };
__device__ __forceinline__ v2u peer_ec(const v2u lo, const v2u hi, int c) { const unsigned mk = (c < 4) ? 0xffffffffu : 0u; v2u r; r.x = (lo.x & mk) | (hi.x & ~mk); r.y = (lo.y & mk) | (hi.y & ~mk); return r; }
#define PEER_EC(en, c) peer_ec((en)[0], (en)[1], (c))
__device__ __forceinline__ void a_load(v4u (&uu)[16], const v2u ec, int c, const unsigned char* U8, int lane) {
#pragma unroll
    for (int j = 0; j < 16; ++j) { const unsigned e = __builtin_amdgcn_readlane(ec.x, 16 * (c & 3) + j); uu[j] = *(const GAS v4u*)(U8 + (size_t)e * D + 16 * lane); }
}
__device__ __forceinline__ void a_step(const v4u (&uu)[16], v2u (&en)[2], int c, const LAS f32x4* xl, const G4& T, int lane) {
    const v2u ec = PEER_EC(en, c);
    const int ls = 16 * (c & 3) + (lane >> 2);
    const unsigned eq = (unsigned)__shfl((int)ec.x, ls); const float gq = __uint_as_float((unsigned)__shfl((int)ec.y, ls));
    const float su = ((const GAS float*)T.isu)[eq], sv = ((const GAS float*)T.isv)[eq];
    f32x4 xv[4];
#pragma unroll
    for (int q = 0; q < 4; ++q) xv[q] = xl[q * 64];
    float part[16];
#pragma unroll
    for (int j = 0; j < 16; ++j) { f32x2w d = {0.f, 0.f};
#pragma unroll
        for (int q = 0; q < 4; ++q) { const unsigned w = uu[j][q]; const f32x2w a = __builtin_amdgcn_cvt_pk_f32_fp8((int)w, false), b = __builtin_amdgcn_cvt_pk_f32_fp8((int)w, true);
            d += (f32x2w){xv[q][0], xv[q][1]} * a; d += (f32x2w){xv[q][2], xv[q][3]} * b; }
        part[j] = d[0] + d[1]; }
    float r8[8], r4[4], r2[2], r1;
#pragma unroll
    for (int i = 0; i < 8; ++i) { auto sw = __builtin_amdgcn_permlane32_swap(__float_as_uint(part[i]), __float_as_uint(part[i + 8]), false, false); r8[i] = __uint_as_float(sw[0]) + __uint_as_float(sw[1]); }
#pragma unroll
    for (int i = 0; i < 4; ++i) { auto sw = __builtin_amdgcn_permlane16_swap(__float_as_uint(r8[i]), __float_as_uint(r8[i + 4]), false, false); r4[i] = __uint_as_float(sw[0]) + __uint_as_float(sw[1]); }
#pragma unroll
    for (int i = 0; i < 2; ++i) { const bool up = (lane & 8) != 0; const float send = up ? r4[i] : r4[i + 2], keep = up ? r4[i + 2] : r4[i]; r2[i] = keep + __shfl_xor(send, 8); }
    { const bool up = (lane & 4) != 0; const float send = up ? r2[0] : r2[1], keep = up ? r2[1] : r2[0]; r1 = keep + __shfl_xor(send, 4); }
    r1 += __shfl_xor(r1, 2); r1 += __shfl_xor(r1, 1);
    const float wgt = gq * gelu_erf(r1 * su) * sv;
    const int rel = lane - 16 * (c & 3);
    const float wv = __shfl(wgt, 4 * (rel & 15));
    const bool mine = (rel >= 0) && (rel < 16);
    const bool lo_ = mine && (c < 4), hi_ = mine && (c >= 4);
    en[0].y = lo_ ? __float_as_uint(wv) : en[0].y; en[1].y = hi_ ? __float_as_uint(wv) : en[1].y;
}
__device__ __forceinline__ void b_load8(v4u (&vv)[8], const v2u ec, int c, int h8, const unsigned char* V8, int lane) {
#pragma unroll
    for (int j = 0; j < 8; ++j) { const unsigned e = __builtin_amdgcn_readlane(ec.x, 16 * (c & 3) + 8 * h8 + j); vv[j] = *(const GAS v4u*)(V8 + (size_t)e * D + 16 * lane); }
}
__device__ __forceinline__ void b_step8(const v4u (&vv)[8], const v2u ec, int c, int h8, f32x2w (&acc)[8]) {
#pragma unroll
    for (int j = 0; j < 8; ++j) { const float w = __uint_as_float(__builtin_amdgcn_readlane(ec.y, 16 * (c & 3) + 8 * h8 + j)); const f32x2w w2 = {w, w};
#pragma unroll
        for (int q = 0; q < 4; ++q) { const unsigned x = vv[j][q]; const f32x2w a = __builtin_amdgcn_cvt_pk_f32_fp8((int)x, false), b = __builtin_amdgcn_cvt_pk_f32_fp8((int)x, true);
            acc[2 * q] += w2 * a; acc[2 * q + 1] += w2 * b; } }
}
__device__ __forceinline__ void b_load(v4u (&vv)[16], const v2u ec, int c, const unsigned char* V8, int lane) {
#pragma unroll
    for (int j = 0; j < 16; ++j) { const unsigned e = __builtin_amdgcn_readlane(ec.x, 16 * (c & 3) + j); vv[j] = *(const GAS v4u*)(V8 + (size_t)e * D + 16 * lane); }
}
__device__ __forceinline__ void b_step(const v4u (&vv)[16], const v2u ec, int c, f32x2w (&acc)[8]) {
#pragma unroll
    for (int j = 0; j < 16; ++j) { const float w = __uint_as_float(__builtin_amdgcn_readlane(ec.y, 16 * (c & 3) + j)); const f32x2w w2 = {w, w};
#pragma unroll
        for (int q = 0; q < 4; ++q) { const unsigned x = vv[j][q]; const f32x2w a = __builtin_amdgcn_cvt_pk_f32_fp8((int)x, false), b = __builtin_amdgcn_cvt_pk_f32_fp8((int)x, true);
            acc[2 * q] += w2 * a; acc[2 * q + 1] += w2 * b; } }
}
#define PEER_ROWLD(buf, j, ec, c, TAB) do { const unsigned e_ = __builtin_amdgcn_readlane((ec).x, 16 * ((c) & 3) + (j)); buf[j] = *(const GAS v4u*)((TAB) + (size_t)e_ * D + 16 * lane); } while (0)
template <bool NXT>
__device__ __forceinline__ void a_step_p(v4u (&uu)[16], v2u (&en)[2], int c, const LAS f32x4* xl, const G4& T, int lane, const v2u ecn, int cn) {
    const v2u ec = PEER_EC(en, c);
    const int ls = 16 * (c & 3) + (lane >> 2);
    const unsigned eq = (unsigned)__shfl((int)ec.x, ls); const float gq = __uint_as_float((unsigned)__shfl((int)ec.y, ls));
    const float su = ((const GAS float*)T.isu)[eq], sv = ((const GAS float*)T.isv)[eq];
    f32x4 xv[4];
#pragma unroll
    for (int q = 0; q < 4; ++q) xv[q] = xl[q * 64];
    float part[16];
#pragma unroll
    for (int j = 0; j < 16; ++j) { f32x2w d = {0.f, 0.f}, dd = {0.f, 0.f};
#pragma unroll
        for (int q = 0; q < 4; ++q) { const unsigned w = uu[j][q]; const f32x2w a = __builtin_amdgcn_cvt_pk_f32_fp8((int)w, false), b = __builtin_amdgcn_cvt_pk_f32_fp8((int)w, true);
            d += (f32x2w){xv[q][0], xv[q][1]} * a; dd += (f32x2w){xv[q][2], xv[q][3]} * b; }
        d += dd; part[j] = d[0] + d[1]; asm volatile("" : "+v"(part[j]));
        if (NXT) PEER_ROWLD(uu, j, ecn, cn, T.U8);
        __builtin_amdgcn_sched_barrier(0); }
    float r8[8], r4[4], r2[2], r1;
#pragma unroll
    for (int i = 0; i < 8; ++i) { auto sw = __builtin_amdgcn_permlane32_swap(__float_as_uint(part[i]), __float_as_uint(part[i + 8]), false, false); r8[i] = __uint_as_float(sw[0]) + __uint_as_float(sw[1]); }
#pragma unroll
    for (int i = 0; i < 4; ++i) { auto sw = __builtin_amdgcn_permlane16_swap(__float_as_uint(r8[i]), __float_as_uint(r8[i + 4]), false, false); r4[i] = __uint_as_float(sw[0]) + __uint_as_float(sw[1]); }
#pragma unroll
    for (int i = 0; i < 2; ++i) { const bool up = (lane & 8) != 0; const float send = up ? r4[i] : r4[i + 2], keep = up ? r4[i + 2] : r4[i]; r2[i] = keep + __shfl_xor(send, 8); }
    { const bool up = (lane & 4) != 0; const float send = up ? r2[0] : r2[1], keep = up ? r2[1] : r2[0]; r1 = keep + __shfl_xor(send, 4); }
    r1 += __shfl_xor(r1, 2); r1 += __shfl_xor(r1, 1);
    const float wgt = gq * gelu_erf(r1 * su) * sv;
    const int rel = lane - 16 * (c & 3);
    const float wv = __shfl(wgt, 4 * (rel & 15));
    const bool mine = (rel >= 0) && (rel < 16);
    const bool lo_ = mine && (c < 4), hi_ = mine && (c >= 4);
    en[0].y = lo_ ? __float_as_uint(wv) : en[0].y; en[1].y = hi_ ? __float_as_uint(wv) : en[1].y;
}
template <bool NXT>
__device__ __forceinline__ void b_step_p(v4u (&vv)[16], const v2u ec, int c, f32x2w (&acc)[8], const unsigned char* V8, int lane, const v2u ecn, int cn) {
#pragma unroll
    for (int j = 0; j < 16; ++j) { const float w = __uint_as_float(__builtin_amdgcn_readlane(ec.y, 16 * (c & 3) + j)); const f32x2w w2 = {w, w};
#pragma unroll
        for (int q = 0; q < 4; ++q) { const unsigned x = vv[j][q]; const f32x2w a = __builtin_amdgcn_cvt_pk_f32_fp8((int)x, false), b = __builtin_amdgcn_cvt_pk_f32_fp8((int)x, true);
            acc[2 * q] += w2 * a; acc[2 * q + 1] += w2 * b; }
        if (NXT) PEER_ROWLD(vv, j, ecn, cn, V8);
        __builtin_amdgcn_sched_barrier(0); }
}
__device__ __forceinline__ void tok_finish(const LAS f32x4* xl, const f32x2w (&acc)[8], float* xrow, const float* gam, const float* bet, int lane) {
    float rr[16], s = 0.f;
#pragma unroll
    for (int q = 0; q < 4; ++q) { const f32x4 xv = xl[q * 64];
#pragma unroll
        for (int e = 0; e < 4; ++e) { const int k = 4 * q + e; rr[k] = ALPHA * xv[e] + acc[k >> 1][k & 1]; s += rr[k]; } }
    const float mean = wave_sum(s) * (1.f / D); float s2 = 0.f;
#pragma unroll
    for (int k = 0; k < 16; ++k) { rr[k] -= mean; s2 += rr[k] * rr[k]; }
    const float rstd = __builtin_amdgcn_rsqf(wave_sum(s2) * (1.f / D) + LN_EPS);
#pragma unroll
    for (int q = 0; q < 4; ++q) { const f32x4 g = *(const GAS f32x4*)(gam + 16 * lane + 4 * q), bb = *(const GAS f32x4*)(bet + 16 * lane + 4 * q);
        f32x4 y; y[0] = rr[4 * q] * rstd * g[0] + bb[0]; y[1] = rr[4 * q + 1] * rstd * g[1] + bb[1]; y[2] = rr[4 * q + 2] * rstd * g[2] + bb[2]; y[3] = rr[4 * q + 3] * rstd * g[3] + bb[3];
        *(GAS f32x4*)(xrow + 4 * q) = y; }
}
__device__ __forceinline__ void gather4(const v2u* sel, const G4& T, const float* rin, const float* g1, const float* b1, float* xo, const float* gam, const float* bet, int tok0, int lane, LAS f32x4* xl, LAS v2u* srt) {
    v2u en[4][2];
#pragma unroll
    for (int tt = 0; tt < 4; ++tt) { const float* rrow = rin + (size_t)(tok0 + tt) * D + 16 * lane;
        {
            f32x4 rv[4]; float s = 0.f;
#pragma unroll
            for (int q = 0; q < 4; ++q) { rv[q] = *(const GAS f32x4*)(rrow + 4 * q); s += (rv[q][0] + rv[q][1]) + (rv[q][2] + rv[q][3]); }
            const float mean = wave_sum(s) * (1.f / D); float s2 = 0.f;
#pragma unroll
            for (int q = 0; q < 4; ++q) { rv[q] = rv[q] - mean; s2 += (rv[q][0] * rv[q][0] + rv[q][1] * rv[q][1]) + (rv[q][2] * rv[q][2] + rv[q][3] * rv[q][3]); }
            const float rstd = __builtin_amdgcn_rsqf(wave_sum(s2) * (1.f / D) + LN_EPS);
#pragma unroll
            for (int q = 0; q < 4; ++q) { const f32x4 gg = *(const GAS f32x4*)(g1 + 16 * lane + 4 * q), bb = *(const GAS f32x4*)(b1 + 16 * lane + 4 * q); xl[tt * 256 + q * 64] = rv[q] * rstd * gg + bb; }
        }
        const v2u e0 = ((const GAS v2u*)sel)[(size_t)(tok0 + tt) * 128 + lane], e1 = ((const GAS v2u*)sel)[(size_t)(tok0 + tt) * 128 + 64 + lane];
        const unsigned b0 = e0.x >> 9, b1 = e1.x >> 9; unsigned d0 = 0u, d1 = 0u, base = 0u;
#pragma unroll
        for (unsigned k = 0; k < 32; ++k) { const unsigned long long m0 = __ballot(b0 == k), m1 = __ballot(b1 == k);
            const unsigned c0 = (unsigned)__builtin_popcountll(m0), c1 = (unsigned)__builtin_popcountll(m1);
            const unsigned p0 = __builtin_amdgcn_mbcnt_hi((unsigned)(m0 >> 32), __builtin_amdgcn_mbcnt_lo((unsigned)m0, 0u)), p1 = __builtin_amdgcn_mbcnt_hi((unsigned)(m1 >> 32), __builtin_amdgcn_mbcnt_lo((unsigned)m1, 0u));
            d0 = (b0 == k) ? base + p0 : d0; d1 = (b1 == k) ? base + c0 + p1 : d1; base += c0 + c1; }
        srt[d0] = e0; srt[d1] = e1;
        asm volatile("s_waitcnt lgkmcnt(0)" ::: "memory");
        en[tt][0] = srt[lane]; en[tt][1] = srt[64 + lane];
        asm volatile("s_waitcnt lgkmcnt(0)" ::: "memory");
    }
    {
        v4u uu[16];
        { const v2u e0 = PEER_EC(en[0], 0);
#pragma unroll
          for (int j = 0; j < 16; ++j) PEER_ROWLD(uu, j, e0, 0, T.U8); }
#pragma unroll 1
        for (int c = 0; c < 7; ++c) {
            a_step_p<true>(uu, en[0], c, xl + 0 * 256, T, lane, PEER_EC(en[1], c), c);
            a_step_p<true>(uu, en[1], c, xl + 1 * 256, T, lane, PEER_EC(en[2], c), c);
            a_step_p<true>(uu, en[2], c, xl + 2 * 256, T, lane, PEER_EC(en[3], c), c);
            a_step_p<true>(uu, en[3], c, xl + 3 * 256, T, lane, PEER_EC(en[0], c + 1), c + 1);
        }
        a_step_p<true>(uu, en[0], 7, xl + 0 * 256, T, lane, PEER_EC(en[1], 7), 7);
        a_step_p<true>(uu, en[1], 7, xl + 1 * 256, T, lane, PEER_EC(en[2], 7), 7);
        a_step_p<true>(uu, en[2], 7, xl + 2 * 256, T, lane, PEER_EC(en[3], 7), 7);
        a_step_p<false>(uu, en[3], 7, xl + 3 * 256, T, lane, PEER_EC(en[3], 7), 7);
    }
    f32x2w acc[4][8];
#pragma unroll
    for (int tt = 0; tt < 4; ++tt)
#pragma unroll
        for (int q = 0; q < 8; ++q) acc[tt][q] = (f32x2w){0.f, 0.f};
    {
        v4u vv[16];
        { const v2u e0 = PEER_EC(en[0], 0);
#pragma unroll
          for (int j = 0; j < 16; ++j) PEER_ROWLD(vv, j, e0, 0, T.V8); }
#pragma unroll 1
        for (int c = 0; c < 7; ++c) {
            b_step_p<true>(vv, PEER_EC(en[0], c), c, acc[0], T.V8, lane, PEER_EC(en[1], c), c);
            b_step_p<true>(vv, PEER_EC(en[1], c), c, acc[1], T.V8, lane, PEER_EC(en[2], c), c);
            b_step_p<true>(vv, PEER_EC(en[2], c), c, acc[2], T.V8, lane, PEER_EC(en[3], c), c);
            b_step_p<true>(vv, PEER_EC(en[3], c), c, acc[3], T.V8, lane, PEER_EC(en[0], c + 1), c + 1);
        }
        b_step_p<true>(vv, PEER_EC(en[0], 7), 7, acc[0], T.V8, lane, PEER_EC(en[1], 7), 7);
        b_step_p<true>(vv, PEER_EC(en[1], 7), 7, acc[1], T.V8, lane, PEER_EC(en[2], 7), 7);
        b_step_p<true>(vv, PEER_EC(en[2], 7), 7, acc[2], T.V8, lane, PEER_EC(en[3], 7), 7);
        b_step_p<false>(vv, PEER_EC(en[3], 7), 7, acc[3], T.V8, lane, PEER_EC(en[3], 7), 7);
    }
#pragma unroll
    for (int tt = 0; tt < 4; ++tt) tok_finish(xl + tt * 256, acc[tt], xo + (size_t)(tok0 + tt) * D + 16 * lane, gam, bet, lane);
}
#undef PEER_EC
#undef PEER_ROWLD
__device__ __forceinline__ void rows_to_fp8(const float* usrc, const float* vsrc, unsigned char* udst, unsigned char* vdst, float* uinv, float* vinv, int row0, int stride, int lane) {
    f32x4 nx[4];
    if (row0 < 2 * NEXP) { const float* p = (row0 < NEXP ? usrc + (size_t)row0 * D : vsrc + (size_t)(row0 - NEXP) * D) + 16 * lane;
#pragma unroll
        for (int q = 0; q < 4; ++q) nx[q] = *(const f32x4*)(p + 4 * q); }
#pragma unroll 1
    for (int row = row0; row < 2 * NEXP; row += stride) {
        f32x4 v[4]; float am = 0.f;
#pragma unroll
        for (int q = 0; q < 4; ++q) { v[q] = nx[q]; am = fmaxf(am, fmaxf(fmaxf(fabsf(v[q][0]), fabsf(v[q][1])), fmaxf(fabsf(v[q][2]), fabsf(v[q][3])))); }
        const int rn = row + stride;
        if (rn < 2 * NEXP) { const float* p = (rn < NEXP ? usrc + (size_t)rn * D : vsrc + (size_t)(rn - NEXP) * D) + 16 * lane;
#pragma unroll
            for (int q = 0; q < 4; ++q) nx[q] = *(const f32x4*)(p + 4 * q); }
        am = wave_max(am);
        float s = 1.f, is = 1.f;
        if (am > 1e-30f) { const int eb = (__float_as_int(224.f / am) >> 23) & 0xff; if (eb > 0 && eb < 254) { s = __int_as_float(eb << 23); is = __int_as_float((254 - eb) << 23); } }
        v4u o;
#pragma unroll
        for (int q = 0; q < 4; ++q) { int w = 0; w = __builtin_amdgcn_cvt_pk_fp8_f32(v[q][0] * s, v[q][1] * s, w, false); w = __builtin_amdgcn_cvt_pk_fp8_f32(v[q][2] * s, v[q][3] * s, w, true); o[q] = (unsigned)w; }
        unsigned char* dst = (row < NEXP ? udst + (size_t)row * D : vdst + (size_t)(row - NEXP) * D) + 16 * lane;
        *(v4u*)dst = o;
        if (lane == 0) { if (row < NEXP) uinv[row] = is; else vinv[row - NEXP] = is; }
    }
}
}
constexpr int NPH = 8;
__global__ void __launch_bounds__(NWAVES * 64, 2) mk_fwd(Args args) {
    extern __shared__ __attribute__((aligned(16))) unsigned char lds_raw[];
    LAS unsigned char* lds = (LAS unsigned char*)lds_raw;
    volatile LAS unsigned* MISC = (volatile LAS unsigned*)(lds + MISC_OFF);
    const int tid0 = threadIdx.x, lane0 = tid0 & 63, wave = __builtin_amdgcn_readfirstlane(tid0 >> 6);
    const int G = gridDim.x, bx = blockIdx.x, vcu = (G % 8 == 0) ? (bx % 8) * (G / 8) + bx / 8 : bx;
    unsigned char* ws0 = args.ws;
    gu32* ctl = (gu32*)(ws0 + WS_CTL);
    for (int u = tid0; u < (LDS_BYTES - RING_BYTES) / 4; u += NWAVES * 64) ((LAS unsigned*)(lds + RING_BYTES))[u] = 0u;
    __syncthreads();
    XcdBarrier bar; bar.bar = (unsigned*)(ctl + CW_BAR); bar.x = 0; bar.st = nullptr;
    if (MK_N_LAUNCHES == 1) bar = xcd_barrier_post((unsigned*)(ctl + CW_BAR), MISC + 8, wave);
    const int lo = args.ph_lo, hi = args.ph_hi;
#ifndef PH_MASK
#define PH_MASK 0xFF
#endif
#define IN(k) ((((PH_MASK) >> (k)) & 1) && lo <= (k) && (k) < hi)
#define SEAM(k) do { if (IN(k) && IN((k) + 1)) xcd_barrier(bar); } while (0)
    const int NGW = G * NWAVES;
#define SUB_BEGIN() unsigned char* ws = ws0; asm volatile("" : "+s"(ws)); const int lane = (int)__builtin_amdgcn_mbcnt_hi(~0u, __builtin_amdgcn_mbcnt_lo(~0u, 0u)), tid = wave * 64 + lane; (void)tid; (void)lane
#define PHASE_BEGIN() unsigned char* ws = ws0; asm volatile("" : "+s"(ws)); const int lane = (int)__builtin_amdgcn_mbcnt_hi(~0u, __builtin_amdgcn_mbcnt_lo(~0u, 0u)), tid = wave * 64 + lane; const int gw = vcu * NWAVES + wave; (void)gw; (void)lane; (void)tid

    if (IN(0)) { PHASE_BEGIN(); p0_prologue(args, lds, vcu, G, wave, lane); VM_WAIT(); __syncthreads(); SEAM(0); }

    if (IN(1)) { PHASE_BEGIN();
        pg8::Gemm g{(const pg8::bf16_t*)(ws + WS_A), (const pg8::bf16_t*)(ws + WS_WIN), T, INC, D}; pg8::StaticOrder S; S.init(T, INC, G, bx); S.rep = NREP(1);
        pg8::EpiInProj E{(pg8::bf16_t*)(ws + WS_QD), (pg8::bf16_t*)(ws + WS_KD), (pg8::bf16_t*)(ws + WS_VD), (pg8::bf16_t*)(ws + WS_LQ), (pg8::bf16_t*)(ws + WS_LK), (pg8::bf16_t*)(ws + WS_LV),
                         (pg8::bf16_t*)(ws + WS_GA), (pg8::bf16_t*)(ws + WS_GB)};
        pg8::gemm_phase<pg8::EpiInProj, pg8::StaticOrder, true, true>(lds, g, S, E, wave);
        {
            const int nwg = (T / 256) * (INC / 256), rem = nwg % G, nshort = rem ? G - rem : G, first = rem ? rem : 0;
            if (bx >= first) peer::rows_to_fp8(args.in[I_PU], args.in[I_PV], ws + WS_UU, ws + WS_UV, (float*)(ws + WS_ISU), (float*)(ws + WS_ISV), (bx - first) * NWAVES + wave, nshort * NWAVES, lane);
        }
        SEAM(1);
    }

    if (IN(2)) { PHASE_BEGIN();
#ifndef NO_DIFF
        {   SUB_BEGIN();
            const da::Tensors X{(const bf16*)(ws + WS_QD), (const bf16*)(ws + WS_KD), (const bf16*)(ws + WS_VD), (float*)(ws + WS_STASH), (bf16*)(ws + WS_YA),
                                args.in[I_DLAM], args.in[I_SUBG], args.in[I_RELB]};
            int cur_h = -1;
            float lam; { const float* dl = args.in[I_DLAM]; const float p1 = dl[lane] * dl[64 + lane], p2 = dl[128 + lane] * dl[192 + lane];
                lam = __uint_as_float(__builtin_amdgcn_readfirstlane(__float_as_uint(__expf(wave_sum(p1)) - __expf(wave_sum(p2)) + LAM_INIT))); }
            for (int rep_ = 0; rep_ < NREP(20); ++rep_)
            for (int p = vcu; p < 256; p += G) {
                const int bh = p >> 5, s = p & 31, b = bh >> 2, h = bh & 3;
                if (h != cur_h) {
                    __syncthreads();
                    const float* bd = (const float*)(ws + WS_BIASD) + h * BIAS_TAB; asm volatile("" : "+s"(bd));
                    int ln2 = (int)__builtin_amdgcn_mbcnt_hi(~0u, __builtin_amdgcn_mbcnt_lo(~0u, 0u)); asm volatile("" : "+v"(ln2));
                    for (int i = wave * 64 + ln2; i < BIAS_TAB; i += NWAVES * 64) ((LAS float*)(lds + da::LDS_BIAS))[i] = bd[i];
                    for (int i = wave * 64 + ln2; i < 4 * da::TAB_CL; i += NWAVES * 64) {
                        const int a = i / da::TAB_CL, k = i % da::TAB_CL, idx = da::TAB_NR - k + a;
                        ((LAS float*)(lds + da::LDS_TREV))[i] = (idx >= 0 && idx < BIAS_TAB) ? bd[idx] : 0.f; }
                    __syncthreads(); cur_h = h;
                }
                const float c31 = args.in[I_RELB][31 * 16 + h] * LOG2E;
                for (int k2 = 0; k2 < 2; ++k2) da::unit(X, b, h, k2 ? 63 - s : s, lds, bx, lam, c31, wave);
            }
        }
#endif
#ifndef NO_DIL
        {   SUB_BEGIN();
            const dil::Tensors X{(const bf16*)(ws + WS_LQ), (const bf16*)(ws + WS_LK), (const bf16*)(ws + WS_LV), (bf16*)(ws + WS_YB)};
            int cur_h = -1;
            for (int rep_ = 0; rep_ < NREP(21); ++rep_)
            for (int u = vcu; u < 256; u += G) {
                const int bh = u >> 5, blk = u & 31, b = bh >> 2, h = bh & 3;
                if (h != cur_h) {
                    __syncthreads();
                    const float* blsrc = (const float*)(ws + WS_BIASL);
                    for (int i = tid; i < 3 * dil::BT; i += NWAVES * 64) { const int g = i / dil::BT, jj = i % dil::BT - dil::BT0;
                        ((LAS float*)(lds + dil::LDS_BL))[i] = (jj >= 0 && jj <= 128) ? blsrc[(g * 4 + h) * 132 + jj] : 0.f; }
                    __syncthreads(); cur_h = h;
                }
                float* lse0 = (float*)(ws + WS_LSE0);
                for (int k2 = 0; k2 < 2; ++k2) dil::wave_tile_g0(X, lse0, b, h, blk * 512 + (wave + 8 * k2) * 32, lds + dil::LDS_VST + wave * 4096, (const LAS float*)(lds + dil::LDS_BL), lane);
                VM_WAIT(); __syncthreads();
                for (int k2 = 0; k2 < 2; ++k2) dil::wave_tile(X, lse0, b, h, blk * 512, wave + 8 * k2, lds + dil::LDS_VST + wave * 4096, (const LAS float*)(lds + dil::LDS_BL), lane);
            }
            __syncthreads();
        }
#endif
        SEAM(2);
    }

    if (IN(3)) { PHASE_BEGIN();
        { pg8::Gemm g{(const pg8::bf16_t*)(ws + WS_YA), (const pg8::bf16_t*)(ws + WS_WBD), T, D, 512}; pg8::StaticOrder S; S.init(T, D, G, bx); S.rep = NREP(3);
          pg8::EpiGate1 E{(const pg8::bf16_t*)(ws + WS_GA), (pg8::bf16_t*)(ws + WS_GATED)};
          pg8::gemm_phase<pg8::EpiGate1, pg8::StaticOrder, true, true>(lds, g, S, E, wave); }
        VM_WAIT(); __syncthreads();
        { pg8::Gemm g{(const pg8::bf16_t*)(ws + WS_YB), (const pg8::bf16_t*)(ws + WS_WBL), T, D, 256}; pg8::StaticOrder S; S.init(T, D, G, bx);
          pg8::EpiGate2 E{(const pg8::bf16_t*)(ws + WS_GB), (pg8::bf16_t*)(ws + WS_GATED)};
          pg8::gemm_phase<pg8::EpiGate2, pg8::StaticOrder, true, true>(lds, g, S, E, wave); }
        SEAM(3);
    }

    if (IN(4)) { PHASE_BEGIN();
        pg8::Gemm g{(const pg8::bf16_t*)(ws + WS_GATED), (const pg8::bf16_t*)(ws + WS_WO), T, D, D}; pg8::StaticOrder S; S.init(T, D, G, bx); S.rep = NREP(4);
        pg8::EpiOut E{args.in[I_X], (float*)(ws + WS_R)};
        pg8::gemm_phase<pg8::EpiOut, pg8::StaticOrder, true, true>(lds, g, S, E, wave);
        SEAM(4);
    }

    if (IN(5)) { PHASE_BEGIN();
        p5_ln1(args, vcu, G, wave, lane);
        SEAM(5);
    }

    if (IN(6)) { PHASE_BEGIN();
        pg8::Gemm g{(const pg8::bf16_t*)(ws + WS_WP), (const pg8::bf16_t*)(ws + WS_A), 2048, T, D}; pg8::StaticOrder S; S.init(2048, T, G, bx); S.rep = NREP(6);
        pg8::EpiScoreT E{(float*)(ws + WS_ST)};
        pg8::gemm_phase<pg8::EpiScoreT, pg8::StaticOrder, true, true>(lds, g, S, E, wave);
        SEAM(6);
    }

    if (IN(7)) { PHASE_BEGIN();
        const float* ST = (const float*)(ws + WS_ST); v2u* sel = (v2u*)(ws + WS_SEL);
        for (int u = vcu; u < T / 128; u += G) {
            for (int p = 0; p < 2; ++p) peer::select(ST, sel, u * 128 + p * 64 + lane, wave);
            VM_WAIT(); __syncthreads();
            { const peer::G4 TB{ws + WS_UU, ws + WS_UV, (const float*)(ws + WS_ISU), (const float*)(ws + WS_ISV)};
              for (int i = 0; i < 4; ++i) peer::gather4(sel, TB, (const float*)(ws + WS_R), args.in[I_LN1G], args.in[I_LN1B], args.out, args.in[I_LN2G], args.in[I_LN2B], u * 128 + i * 32 + wave * 4, lane, (LAS f32x4*)(lds + wave * 16384) + lane, (LAS v2u*)(lds + RING_BYTES + 2048 + wave * 1024)); }
            VM_WAIT(); __syncthreads();
        }
    }
#undef IN
#undef SEAM
}

extern "C" void kernel_launch(void* const* d_in, const int* in_sizes, int n_in, void* d_out, int out_size, void* d_ws, size_t ws_size, hipStream_t stream) {
    static int grid = 0;
    if (grid == 0) {
        if (n_in != 16 || in_sizes[0] != T * D || out_size != T * D || ws_size < WS_END) { fprintf(stderr, "kernel_launch: unexpected shapes (n_in %d, in0 %d, out %d, ws %zu); nothing launched\n", n_in, n_in > 0 ? in_sizes[0] : -1, out_size, ws_size); grid = -1; return; }
        int dev = 0, cus = 0, per_cu = 0;
        if (hipGetDevice(&dev) != hipSuccess || hipDeviceGetAttribute(&cus, hipDeviceAttributeMultiprocessorCount, dev) != hipSuccess) { grid = -1; return; }
        if (hipFuncSetAttribute((const void*)mk_fwd, hipFuncAttributeMaxDynamicSharedMemorySize, LDS_BYTES) != hipSuccess) { fprintf(stderr, "kernel_launch: hipFuncSetAttribute failed\n"); grid = -1; return; }
        if (hipOccupancyMaxActiveBlocksPerMultiprocessor(&per_cu, (const void*)mk_fwd, NWAVES * 64, LDS_BYTES) != hipSuccess || per_cu < 1) { fprintf(stderr, "kernel_launch: occupancy query reports %d\n", per_cu); per_cu = 1; }
        (void)hipGetLastError();
        grid = cus;
    }
    if (grid < 0) return;
    if (hipMemsetAsync((char*)d_ws + WS_CTL, 0, CTL_ZERO_BYTES, stream) != hipSuccess) return;
    Args a{};
    for (int i = 0; i < 16; ++i) a.in[i] = (const float*)d_in[i];
    a.out = (float*)d_out; a.ws = (unsigned char*)d_ws;
    for (int li = 0; li < MK_N_LAUNCHES; ++li) {
        a.ph_lo = (MK_N_LAUNCHES == 1) ? 0 : li; a.ph_hi = (MK_N_LAUNCHES == 1) ? NPH : li + 1;
        hipLaunchKernelGGL(mk_fwd, dim3(grid), dim3(NWAVES * 64), LDS_BYTES, stream, a);
    }
}
```

```cpp
#include <hip/hip_runtime.h>
#include <cstdio>
#include <cstdint>

#ifndef MK_N_LAUNCHES
#define MK_N_LAUNCHES 1
#endif

#ifndef REPEAT_PH
#define REPEAT_PH (-1)
#endif
#define NREP(k) ((REPEAT_PH) == (k) ? 2 : 1)

constexpr int BATCH = 2, SEQ = 16384, T = BATCH * SEQ, D = 1024, INC = 5888;
constexpr int OFF_DQ = 0, OFF_DK = 512, OFF_DV = 1024, OFF_LQ = 1536, OFF_LK = 2304, OFF_LV = 3072, OFF_GA = 3840, OFF_GB = 4864;
constexpr int NEXP = 16384;
constexpr float LOG2E = 1.4426950408889634f;
constexpr float QSCALE = 0.125f * LOG2E;
constexpr float ALPHA = 1.189207115002721f;
constexpr float LN_EPS = 1e-5f, SUBLN_EPS = 1e-5f;
constexpr float LAM_INIT = 0.2f;
constexpr int NTILE = SEQ / 64;
constexpr int BIAS_TAB = 2240, BIAS_GUARD = 256, DFAR = 1513;

constexpr size_t MiB = 1u << 20;
constexpr size_t WS_CTL = 0, CTL_ZERO_BYTES = 1 * MiB;
constexpr size_t WS_BIASD = 1 * MiB;
constexpr size_t WS_BIASL = 1 * MiB + 64 * 1024;
constexpr size_t WS_WIN = 8 * MiB, WS_WO = 20 * MiB, WS_WBD = 22 * MiB, WS_WBL = 23 * MiB, WS_WP = 24 * MiB;
constexpr size_t WS_A = 32 * MiB;
constexpr size_t WS_YA = WS_A, WS_YB = WS_A + 32 * MiB;
constexpr size_t WS_QD = 96 * MiB, WS_KD = 128 * MiB, WS_VD = 160 * MiB, WS_LQ = 192 * MiB, WS_LK = 240 * MiB, WS_LV = 288 * MiB, WS_GA = 336 * MiB, WS_GB = 400 * MiB;
constexpr size_t WS_STASH = 464 * MiB;
constexpr size_t WS_SEL = 32 * MiB;
constexpr size_t WS_GATED = 96 * MiB;
constexpr size_t WS_R = 352 * MiB;
constexpr size_t WS_ST = 96 * MiB;
constexpr size_t WS_UU = 480 * MiB, WS_UV = 496 * MiB;
constexpr size_t WS_LSE0 = 3 * MiB;
constexpr size_t WS_ISU = 2 * MiB, WS_ISV = 2 * MiB + 65536;
constexpr size_t WS_END = 512 * MiB;

constexpr int CW_BAR = 4096;
constexpr int NWAVES = 8;
constexpr int RING_BYTES = 131072, MISC_OFF = RING_BYTES + 320, LDS_BYTES = 147456;

#define GAS __attribute__((address_space(1)))
#define LAS __attribute__((address_space(3)))
typedef unsigned short bf16;
typedef unsigned v4u __attribute__((ext_vector_type(4)));
typedef unsigned v2u __attribute__((ext_vector_type(2)));
typedef float f32x4 __attribute__((ext_vector_type(4)));
typedef float f32x16 __attribute__((ext_vector_type(16)));
typedef short bf16x8 __attribute__((ext_vector_type(8)));
typedef short s16x4 __attribute__((ext_vector_type(4)));
typedef __bf16 bf16x2 __attribute__((ext_vector_type(2)));
typedef GAS unsigned gu32;
#define RLX_AGENT __ATOMIC_RELAXED, __HIP_MEMORY_SCOPE_AGENT
#define LDS_WAIT() asm volatile("s_waitcnt lgkmcnt(0)" ::: "memory")
#define VM_WAIT() asm volatile("s_waitcnt vmcnt(0)" ::: "memory")
__device__ __forceinline__ unsigned f2bf(float f) { unsigned u = __builtin_bit_cast(unsigned, f); return (u + 0x7fffu + ((u >> 16) & 1u)) >> 16; }
__device__ __forceinline__ unsigned pk2(float lo, float hi) { return f2bf(lo) | (f2bf(hi) << 16); }
typedef float f32x2_t __attribute__((ext_vector_type(2)));
__device__ __forceinline__ unsigned cvtpk(float lo, float hi) { f32x2_t v = {lo, hi}; bf16x2 b = __builtin_convertvector(v, bf16x2); return __builtin_bit_cast(unsigned, b); }
__device__ __forceinline__ float bf_lo(unsigned w) { return __builtin_bit_cast(float, w << 16); }
__device__ __forceinline__ float bf_hi(unsigned w) { return __builtin_bit_cast(float, w & 0xffff0000u); }
__device__ __forceinline__ float dot2bf(unsigned a, unsigned b, float acc) { return __builtin_amdgcn_fdot2_f32_bf16(__builtin_bit_cast(bf16x2, a), __builtin_bit_cast(bf16x2, b), acc, false); }
template <int CTRL> __device__ __forceinline__ float dpp_rot(float v) { return __builtin_bit_cast(float, __builtin_amdgcn_update_dpp(0, __builtin_bit_cast(int, v), CTRL, 0xf, 0xf, false)); }
__device__ __forceinline__ float wave_sum(float v) {
    v += dpp_rot<0x128>(v); v += dpp_rot<0x124>(v); v += dpp_rot<0x122>(v); v += dpp_rot<0x121>(v);
    { auto s = __builtin_amdgcn_permlane16_swap(__float_as_uint(v), __float_as_uint(v), false, false); v = __uint_as_float(s[0]) + __uint_as_float(s[1]); }
    { auto s = __builtin_amdgcn_permlane32_swap(__float_as_uint(v), __float_as_uint(v), false, false); v = __uint_as_float(s[0]) + __uint_as_float(s[1]); }
    return v;
}
__device__ __forceinline__ float wave_max(float v) {
    v = fmaxf(v, dpp_rot<0x128>(v)); v = fmaxf(v, dpp_rot<0x124>(v)); v = fmaxf(v, dpp_rot<0x122>(v)); v = fmaxf(v, dpp_rot<0x121>(v));
    { auto s = __builtin_amdgcn_permlane16_swap(__float_as_uint(v), __float_as_uint(v), false, false); v = fmaxf(__uint_as_float(s[0]), __uint_as_float(s[1])); }
    { auto s = __builtin_amdgcn_permlane32_swap(__float_as_uint(v), __float_as_uint(v), false, false); v = fmaxf(__uint_as_float(s[0]), __uint_as_float(s[1])); }
    return v;
}
__device__ __forceinline__ int rel_bucket(int n) {
    if (n < 16) return n < 0 ? 0 : n;
    return 16 + (n >= 22) + (n >= 30) + (n >= 40) + (n >= 54) + (n >= 73) + (n >= 99) + (n >= 134) + (n >= 182) + (n >= 246) + (n >= 332) + (n >= 450) + (n >= 609) + (n >= 825) + (n >= 1117) + (n >= 1513);
}
namespace pg8 {
#define PG8_LAS __attribute__((address_space(3)))
typedef unsigned short bf16_t;
typedef short bf16x8 __attribute__((ext_vector_type(8)));
typedef float f32x4 __attribute__((ext_vector_type(4)));
typedef unsigned u32x4 __attribute__((ext_vector_type(4)));
constexpr int BM = 256, BK = 64, HALF = 128, HTB = HALF * BK * 2  , STAGE_BYTES = 8 * HTB, NXCD = 8, WGM = 8;

__host__ __device__ __forceinline__ int lds_byte(int r, int c) { const int st = (r >> 4) * 2 + (c >> 5), rr = r & 15, cc = c & 31, ob = rr * 64 + cc * 2; return st * 1024 + (ob ^ (((ob >> 9) & 1) << 5)); }
__host__ __device__ __forceinline__ void stage_rc(int b, int& R, int& C) { const int st = b / 1024, sb = b % 1024, swz = sb ^ (((sb >> 9) & 1) << 5); R = (st >> 1) * 16 + swz / 64; C = (st & 1) * 32 + (swz % 64) / 2; }
__host__ __device__ __forceinline__ int perm32(int rho) { const int n = rho >> 4, i = rho & 15; return 8 * (i >> 2) + 4 * n + (i & 3); }

struct Unit { int pm, pn; };
struct Gemm { const bf16_t* A; const bf16_t* Bt; int M, N, K; };

struct StaticOrder {
    int nM, nN, nwg, G, c;
    __host__ __device__ void init(int M, int N, int G_, int c_) { nM = M / BM; nN = N / BM; nwg = nM * nN; G = G_; c = c_; }
    int rep = 1;
    __host__ __device__ bool next(int i0, Unit& u) const {
        const int i = i0 / rep;
        const long L = (long)i * G + c; if (L >= nwg) return false;
        int wgid = (int)L; { const int q = nwg / NXCD, r = nwg % NXCD, xcd = wgid % NXCD, off = wgid / NXCD; wgid = (xcd < r ? xcd * (q + 1) : r * (q + 1) + (xcd - r) * q) + off; }
        const int nig = WGM * nN, gid = wgid / nig, fm = gid * WGM, gsz = (nM - fm) < WGM ? (nM - fm) : WGM;
        u.pm = fm + ((wgid % nig) % gsz); u.pn = (wgid % nig) / gsz; return true;
    }
    __device__ __forceinline__ void a_ready(const Unit&) const {}
    __device__ __forceinline__ void done(const Unit&) const {}
};
__device__ __forceinline__ unsigned cvt_pk_bf16(float lo, float hi) { unsigned r; asm volatile("v_cvt_pk_bf16_f32 %0, %1, %2" : "=v"(r) : "v"(lo), "v"(hi)); return r; }
__device__ __forceinline__ u32x4 pack8(const f32x4 v0, const f32x4 v1) { u32x4 w; w.x = cvt_pk_bf16(v0[0], v0[1]); w.y = cvt_pk_bf16(v0[2], v0[3]); w.z = cvt_pk_bf16(v1[0], v1[1]); w.w = cvt_pk_bf16(v1[2], v1[3]); return w; }
__device__ __forceinline__ float blo(unsigned w) { return __builtin_bit_cast(float, w << 16); }
__device__ __forceinline__ float bhi(unsigned w) { return __builtin_bit_cast(float, w & 0xffff0000u); }
__device__ __forceinline__ float sigm(float v) { return __builtin_amdgcn_rcpf(1.f + __expf(-v)); }
template <class E> __device__ __forceinline__ void epi_loop(const E& e, const f32x4 (&acc)[2][2][4][2], const Unit& u, int wr, int wc, int fr, int fq) {
#pragma unroll
    for (int ai = 0; ai < 2; ++ai)
#pragma unroll
        for (int m = 0; m < 4; ++m) { const int row = u.pm * BM + ai * HALF + wr * 64 + m * 16 + fr;
#pragma unroll
            for (int bj = 0; bj < 2; ++bj) { const int col = u.pn * BM + bj * HALF + wc * 32 + 8 * fq; e.item(u.pn, row, col, acc[ai][bj][m][0], acc[ai][bj][m][1]); } }
}

struct EpiInProj {
    static constexpr bool PERM = true, AFTER_DRAIN = false;
    bf16_t *Qd, *Kd, *Vd, *LQ, *LK, *LV, *GA, *GB;
    __device__ __forceinline__ void operator()(const f32x4 (&acc)[2][2][4][2], const Unit& u, int wr, int wc, int fr, int fq) const { epi_loop(*this, acc, u, wr, wc, fr, fq); }
    __device__ __forceinline__ void item(int pn, int row, int col, f32x4 v0, f32x4 v1) const {
            const int b = row >> 14, s = row & 16383; bf16_t* dst;
            if (pn < 2) {
                const int h = col >> 7, c = (col >> 6) & 1, d = col & 63; v0 = v0 * 0.18033688011112042f; v1 = v1 * 0.18033688011112042f;
                dst = Qd + ((size_t)((b * 4 + h) * 2 + c) * 16384 + s) * 64 + d;
            } else if (pn < 4) {
                const int cc = col - 512, h = cc >> 7, c = (cc >> 6) & 1, d = cc & 63;
                dst = Kd + ((((size_t)((b * 4 + h) * 2 + c) * 256 + (s >> 6)) * 8 + (d >> 3)) * 64 + (s & 63)) * 8;
            } else if (pn < 6) {
                const int cc = col - 1024, h = cc >> 7, d = cc & 127;
                dst = Vd + ((size_t)(b * 4 + h) * 256 + (s >> 6)) * 8192 + ((d >> 5) * 4 + ((s & 63) >> 4)) * 512 + (s & 15) * 32 + (d & 31);
            } else if (pn < 9) {
                v0 = v0 * 0.18033688011112042f; v1 = v1 * 0.18033688011112042f; dst = LQ + (size_t)row * 768 + (col - 1536);
            } else if (pn < 12) { dst = LK + (size_t)row * 768 + (col - 2304);
            } else if (pn < 15) { dst = LV + (size_t)row * 768 + (col - 3072);
            } else {
#pragma unroll
                for (int i = 0; i < 4; ++i) { v0[i] = sigm(v0[i]); v1[i] = sigm(v1[i]); }
                dst = (pn < 19) ? GA + (size_t)row * 1024 + (col - 3840) : GB + (size_t)row * 1024 + (col - 4864);
            }
            *(u32x4*)dst = pack8(v0, v1);
        }
};
struct EpiGate1 {
    static constexpr bool PERM = true, AFTER_DRAIN = false;
    const bf16_t* GA; bf16_t* G;
    __device__ __forceinline__ void operator()(const f32x4 (&acc)[2][2][4][2], const Unit& u, int wr, int wc, int fr, int fq) const { epi_loop(*this, acc, u, wr, wc, fr, fq); }
    __device__ __forceinline__ void item(int pn, int row, int col, f32x4 v0, f32x4 v1) const {
            const size_t o = (size_t)row * 1024 + col; const u32x4 g = *(const u32x4*)(GA + o);
            v0[0] *= blo(g.x); v0[1] *= bhi(g.x); v0[2] *= blo(g.y); v0[3] *= bhi(g.y); v1[0] *= blo(g.z); v1[1] *= bhi(g.z); v1[2] *= blo(g.w); v1[3] *= bhi(g.w);
            *(u32x4*)(G + o) = pack8(v0, v1);
        }
};
struct EpiGate2 {
    static constexpr bool PERM = true, AFTER_DRAIN = false;
    const bf16_t* GB; bf16_t* G;
    __device__ __forceinline__ void operator()(const f32x4 (&acc)[2][2][4][2], const Unit& u, int wr, int wc, int fr, int fq) const { epi_loop(*this, acc, u, wr, wc, fr, fq); }
    __device__ __forceinline__ void item(int pn, int row, int col, f32x4 v0, f32x4 v1) const {
            const size_t o = (size_t)row * 1024 + col; const u32x4 g = *(const u32x4*)(GB + o); const u32x4 p = *(const u32x4*)(G + o);
            v0[0] = v0[0] * blo(g.x) + blo(p.x); v0[1] = v0[1] * bhi(g.x) + bhi(p.x); v0[2] = v0[2] * blo(g.y) + blo(p.y); v0[3] = v0[3] * bhi(g.y) + bhi(p.y);
            v1[0] = v1[0] * blo(g.z) + blo(p.z); v1[1] = v1[1] * bhi(g.z) + bhi(p.z); v1[2] = v1[2] * blo(g.w) + blo(p.w); v1[3] = v1[3] * bhi(g.w) + bhi(p.w);
            *(u32x4*)(G + o) = pack8(v0, v1);
        }
};
struct EpiOut {
    static constexpr bool PERM = true, AFTER_DRAIN = false;
    const float* X; float* R;
    __device__ __forceinline__ void operator()(const f32x4 (&acc)[2][2][4][2], const Unit& u, int wr, int wc, int fr, int fq) const { epi_loop(*this, acc, u, wr, wc, fr, fq); }
    __device__ __forceinline__ void item(int pn, int row, int col, f32x4 v0, f32x4 v1) const {
            const size_t o = (size_t)row * 1024 + col; const f32x4 x0 = *(const f32x4*)(X + o), x1 = *(const f32x4*)(X + o + 4);
            *(f32x4*)(R + o) = x0 * 1.189207115002721f + v0; *(f32x4*)(R + o + 4) = x1 * 1.189207115002721f + v1;
    }
};
struct EpiScoreT {
    static constexpr bool PERM = true, AFTER_DRAIN = false;
    float* ST;
    __device__ __forceinline__ void operator()(const f32x4 (&acc)[2][2][4][2], const Unit& u, int wr, int wc, int fr, int fq) const { epi_loop(*this, acc, u, wr, wc, fr, fq); }
    __device__ __forceinline__ void item(int pn, int row, int col, f32x4 v0, f32x4 v1) const { const size_t o = (size_t)row * 32768 + col; *(f32x4*)(ST + o) = v0; *(f32x4*)(ST + o + 4) = v1; }
};
template <class Epi, class Sched, bool ALIGN_EPI = false, bool SP2 = false>
__device__ __forceinline__ void gemm_phase(PG8_LAS unsigned char* lds, const Gemm g, const Sched& S, const Epi& E, const int wid  ) {
    const int lane = (int)__builtin_amdgcn_mbcnt_hi(~0u, __builtin_amdgcn_mbcnt_lo(~0u, 0u)), tid = wid * 64 + lane, wr = wid >> 2, wc = wid & 3, fr = lane & 15, fq = lane >> 4;
    const int K = g.K, nt = K / BK;
    unsigned voffA[2], voffB[2];
#pragma unroll
    for (int i = 0; i < 2; ++i) { int R, C; stage_rc(tid * 16 + i * 8192, R, C); const int Rb = Epi::PERM ? ((R & ~31) + perm32(R & 31)) : R;
        voffA[i] = (unsigned)(R * K + C) * 2u; voffB[i] = (unsigned)(Rb * K + C) * 2u; }
    const size_t kstep = (size_t)(BK * 2);
    const size_t hstep = (size_t)HALF * K * 2;
    const size_t tstep = 2 * hstep;
    const unsigned ldsw = (unsigned)wid * 1024u;
    const int aoff = lds_byte(wr * 64 + fr, fq * 8), boff = lds_byte(wc * 32 + fr, fq * 8);
#define PG8_SA(b, h) (((b) * 2 + (h)) * HTB)
#define PG8_SB(b, h) ((4 + (b) * 2 + (h)) * HTB)
#define PG8_STAGE(bufoff, gbase, voff) do { _Pragma("unroll") for (int _i = 0; _i < 2; ++_i) \
        __builtin_amdgcn_global_load_lds((const unsigned*)((const char*)(gbase) + (voff)[_i]), (PG8_LAS unsigned*)(lds + (bufoff) + ldsw + _i * 8192), 16, 0, 0); } while (0)
#define PG8_LDA(dst, b, h) do { _Pragma("unroll") for (int m = 0; m < 4; ++m) _Pragma("unroll") for (int k = 0; k < 2; ++k) dst[m][k] = *(const PG8_LAS bf16x8*)(lds + PG8_SA(b, h) + aoff + m * 2048 + k * 1024); } while (0)
#define PG8_LDB(dst, b, h) do { _Pragma("unroll") for (int n = 0; n < 2; ++n) _Pragma("unroll") for (int k = 0; k < 2; ++k) dst[n][k] = *(const PG8_LAS bf16x8*)(lds + PG8_SB(b, h) + boff + n * 2048 + k * 1024); } while (0)
#define PG8_MMA(ai, bj, At, Bt) do { __builtin_amdgcn_s_setprio(1); _Pragma("unroll") for (int m = 0; m < 4; ++m) _Pragma("unroll") for (int n = 0; n < 2; ++n) _Pragma("unroll") for (int k = 0; k < 2; ++k) \
        acc[ai][bj][m][n] = __builtin_amdgcn_mfma_f32_16x16x32_bf16(Bt[n][k], At[m][k], acc[ai][bj][m][n], 0, 0, 0); __builtin_amdgcn_s_setprio(0); } while (0)
#define PG8_WAIT_V(n) asm volatile("s_waitcnt vmcnt(" #n ")" ::: "memory")
#define PG8_WAIT_L(n) asm volatile("s_waitcnt lgkmcnt(" #n ")" ::: "memory")
#define PG8_BAR __builtin_amdgcn_s_barrier()
#define PG8_SCHED __builtin_amdgcn_sched_barrier(0)
    Unit cur, nxt; int ui = 0;
    if (!S.next(0, cur)) return;
    f32x4 acc[2][2][4][2];
#pragma unroll
    for (int a = 0; a < 2; ++a)
#pragma unroll
        for (int b = 0; b < 2; ++b)
#pragma unroll
            for (int m = 0; m < 4; ++m)
#pragma unroll
                for (int n = 0; n < 2; ++n) acc[a][b][m][n] = (f32x4){0.f, 0.f, 0.f, 0.f};
    bf16x8 At[4][2], B0[2][2], B1[2][2];
    const char* cA = (const char*)g.A + (size_t)cur.pm * tstep; const char* cB = (const char*)g.Bt + (size_t)cur.pn * tstep;
    S.a_ready(cur);
    if constexpr (SP2) {
        PG8_STAGE(PG8_SB(0, 0), cB, voffB); PG8_STAGE(PG8_SB(0, 1), cB + hstep, voffB); PG8_STAGE(PG8_SA(0, 0), cA, voffA); PG8_STAGE(PG8_SA(0, 1), cA + hstep, voffA);
        if (wr == 1) PG8_BAR;
        PG8_WAIT_V(2); PG8_BAR;
        PG8_STAGE(PG8_SB(1, 0), cB + kstep, voffB); PG8_STAGE(PG8_SA(1, 0), cA + kstep, voffA); PG8_STAGE(PG8_SB(1, 1), cB + hstep + kstep, voffB);
        PG8_WAIT_V(6); PG8_BAR;
    } else {
        PG8_STAGE(PG8_SB(0, 0), cB, voffB); PG8_STAGE(PG8_SA(0, 0), cA, voffA); PG8_STAGE(PG8_SB(0, 1), cB + hstep, voffB); PG8_STAGE(PG8_SA(0, 1), cA + hstep, voffA);
        if (wr == 1) PG8_BAR;
        PG8_WAIT_V(4); PG8_BAR;
        PG8_STAGE(PG8_SB(1, 0), cB + kstep, voffB); PG8_STAGE(PG8_SA(1, 0), cA + kstep, voffA); PG8_STAGE(PG8_SB(1, 1), cB + hstep + kstep, voffB);
        PG8_WAIT_V(6); PG8_BAR;
    }
    for (;;) {
        const bool has_next = S.next(ui + 1, nxt);
        const char* nA = has_next ? (const char*)g.A + (size_t)nxt.pm * tstep : cA; const char* nB = has_next ? (const char*)g.Bt + (size_t)nxt.pn * tstep : cB;
        for (int t = 0; t < nt; t += 2) {
            const bool last = (t == nt - 2);
            const char* a1 = cA + (size_t)(t + 1) * kstep;
            const char* a2 = last ? nA : cA + (size_t)(t + 2) * kstep; const char* b2 = last ? nB : cB + (size_t)(t + 2) * kstep;
            const char* a3 = a2 + kstep; const char* b3 = b2 + kstep;
            if (last && has_next) S.a_ready(nxt);
            if constexpr (SP2) {
            PG8_LDB(B0, 0, 0); PG8_LDB(B1, 0, 1); PG8_SCHED; PG8_LDA(At, 0, 0); PG8_STAGE(PG8_SA(1, 1), a1 + hstep, voffA);
            PG8_WAIT_V(8); PG8_WAIT_L(0); PG8_BAR; PG8_MMA(0, 0, At, B0); PG8_MMA(0, 1, At, B1); PG8_BAR; PG8_SCHED;
            PG8_LDA(At, 0, 1); PG8_STAGE(PG8_SB(0, 0), b2, voffB); PG8_STAGE(PG8_SB(0, 1), b2 + hstep, voffB); PG8_STAGE(PG8_SA(0, 0), a2, voffA);
            PG8_WAIT_V(8); PG8_WAIT_L(0); PG8_BAR; PG8_MMA(1, 0, At, B0); PG8_MMA(1, 1, At, B1); PG8_BAR; PG8_SCHED;
            PG8_LDB(B0, 1, 0); PG8_LDB(B1, 1, 1); PG8_SCHED; PG8_LDA(At, 1, 0); PG8_STAGE(PG8_SA(0, 1), a2 + hstep, voffA);
            PG8_WAIT_V(8); PG8_WAIT_L(0); PG8_BAR; PG8_MMA(0, 0, At, B0); PG8_MMA(0, 1, At, B1); PG8_BAR; PG8_SCHED;
            PG8_LDA(At, 1, 1); PG8_STAGE(PG8_SB(1, 0), b3, voffB); PG8_STAGE(PG8_SB(1, 1), b3 + hstep, voffB); PG8_STAGE(PG8_SA(1, 0), a3, voffA);
            PG8_WAIT_V(8); PG8_WAIT_L(0); PG8_BAR; PG8_MMA(1, 0, At, B0); PG8_MMA(1, 1, At, B1); PG8_BAR; PG8_SCHED;
            } else {
            PG8_LDB(B0, 0, 0); PG8_SCHED; PG8_LDA(At, 0, 0); PG8_STAGE(PG8_SA(1, 1), a1 + hstep, voffA);
            PG8_WAIT_L(8); PG8_BAR; PG8_WAIT_L(0); PG8_MMA(0, 0, At, B0); PG8_BAR; PG8_SCHED;
            PG8_LDB(B1, 0, 1); PG8_STAGE(PG8_SB(0, 0), b2, voffB);
            PG8_BAR; PG8_WAIT_L(0); PG8_MMA(0, 1, At, B1); PG8_BAR;
            PG8_LDA(At, 0, 1); PG8_STAGE(PG8_SA(0, 0), a2, voffA);
            PG8_BAR; PG8_WAIT_L(0); PG8_MMA(1, 0, At, B0); PG8_BAR; PG8_SCHED;
            PG8_STAGE(PG8_SB(0, 1), b2 + hstep, voffB);
            PG8_WAIT_V(6); PG8_BAR; PG8_MMA(1, 1, At, B1); PG8_BAR;
            PG8_LDB(B0, 1, 0); PG8_SCHED; PG8_LDA(At, 1, 0); PG8_STAGE(PG8_SA(0, 1), a2 + hstep, voffA);
            PG8_WAIT_L(8); PG8_BAR; PG8_WAIT_L(0); PG8_MMA(0, 0, At, B0); PG8_BAR; PG8_SCHED;
            PG8_LDB(B1, 1, 1); PG8_STAGE(PG8_SB(1, 0), b3, voffB);
            PG8_BAR; PG8_WAIT_L(0); PG8_MMA(0, 1, At, B1); PG8_BAR;
            PG8_LDA(At, 1, 1); PG8_STAGE(PG8_SA(1, 0), a3, voffA);
            PG8_BAR; PG8_WAIT_L(0); PG8_MMA(1, 0, At, B0); PG8_BAR; PG8_SCHED;
            PG8_STAGE(PG8_SB(1, 1), b3 + hstep, voffB);
            PG8_WAIT_V(6); PG8_BAR; PG8_MMA(1, 1, At, B1); PG8_BAR;
            }
        }
        if constexpr (ALIGN_EPI) { if (wr == 0) PG8_BAR; }
        if constexpr (!Epi::AFTER_DRAIN) { E(acc, cur, wr, wc, fr, fq); S.done(cur); }
        if (!has_next) break;
#pragma unroll
        for (int a = 0; a < 2; ++a)
#pragma unroll
            for (int b = 0; b < 2; ++b)
#pragma unroll
                for (int m = 0; m < 4; ++m)
#pragma unroll
                    for (int n = 0; n < 2; ++n) acc[a][b][m][n] = (f32x4){0.f, 0.f, 0.f, 0.f};
        cur = nxt; cA = nA; cB = nB; ++ui;
        if constexpr (ALIGN_EPI) { if (wr == 1) PG8_BAR; }
    }
    PG8_WAIT_V(0);
    if constexpr (!ALIGN_EPI) { if (wr == 0) PG8_BAR; }
    PG8_BAR;
    if constexpr (Epi::AFTER_DRAIN) { E.fused(acc, cur, wr, wc, fr, fq, lds, wid, lane); S.done(cur); }
#undef PG8_SA
#undef PG8_SB
#undef PG8_STAGE
#undef PG8_LDA
#undef PG8_LDB
#undef PG8_MMA
#undef PG8_WAIT_V
#undef PG8_WAIT_L
#undef PG8_BAR
#undef PG8_SCHED
}
}
#define XB_TMO      128
#define XB_XCNT(j)  (256  + 64 * (j))
#define XB_XSUB(j)  (1280 + 64 * (j))
#define XB_XGEN(j)  (2304 + 64 * (j))
#define XB_TOP      3328
#define XB_TOPGEN   3392
#define XCD_BAR_WORDS 3456
#define XB_SPIN_CAP (1u << 18)

__device__ __forceinline__ unsigned xb_ld(unsigned* p)              { return __hip_atomic_load(p, __ATOMIC_RELAXED, __HIP_MEMORY_SCOPE_AGENT); }
__device__ __forceinline__ unsigned xb_add(unsigned* p, unsigned v) { return __hip_atomic_fetch_add(p, v, __ATOMIC_RELAXED, __HIP_MEMORY_SCOPE_AGENT); }
__device__ __forceinline__ unsigned xb_xcc_id() { return (unsigned)__builtin_amdgcn_s_getreg((3 << 11) | 20) & 0xFu; }
#define XB_SPIN(cond, bar) do { unsigned _sp = 0; while (cond) { __builtin_amdgcn_s_sleep(1); \
    if ((++_sp & 255u) == 0u) { if (xb_ld(&(bar)[XB_TMO])) break; if (_sp > XB_SPIN_CAP) { atomicAdd(&(bar)[XB_TMO], 1u); break; } } } } while (0)

struct XcdBarrier {
    unsigned* bar; unsigned x;
    volatile LAS unsigned* st;
    int w;
};

__device__ __forceinline__ bool xb_leader(int w) { unsigned l; asm volatile("v_mbcnt_lo_u32_b32 %0, -1, 0\n\tv_mbcnt_hi_u32_b32 %0, -1, %0" : "=v"(l)); return w == 0 && l == 0u; }
__device__ __forceinline__ XcdBarrier xcd_barrier_post(unsigned* bar, volatile LAS unsigned* st, int wave) {
    XcdBarrier b; b.bar = bar; b.x = xb_xcc_id(); b.st = st; b.w = wave;
    if (xb_leader(wave)) (void)xb_add(&bar[XB_XCNT(b.x)], 1u);
    return b;
}
__device__ __forceinline__ void xcd_barrier_complete(unsigned* bar, unsigned x, unsigned& nloc, unsigned& nx) {
    const unsigned G = gridDim.x * gridDim.y * gridDim.z;
    unsigned sum, cnt, mine, sp = 0u;
    for (;;) {
        sum = 0u; cnt = 0u; mine = 0u;
#pragma unroll
        for (unsigned j = 0; j < 16; ++j) { const unsigned c = xb_ld(&bar[XB_XCNT(j)]); sum += c; cnt += (c > 0u) ? 1u : 0u; mine = (j == x) ? c : mine; }
        if (sum == G) break;
        __builtin_amdgcn_s_sleep(1);
        if ((++sp & 255u) == 0u) { if (xb_ld(&bar[XB_TMO])) break; if (sp > XB_SPIN_CAP) { atomicAdd(&bar[XB_TMO], 1u); break; } }
    }
    nloc = mine > 0u ? mine : 1u; nx = cnt > 0u ? cnt : 1u;
}

__device__ __forceinline__ void xcd_barrier(const XcdBarrier& b) {
    asm volatile("s_waitcnt vmcnt(0)" ::: "memory");
    __syncthreads();
    if (xb_leader(b.w)) {
        unsigned* bar = b.bar;
        __builtin_amdgcn_s_waitcnt(0);
        unsigned nloc = b.st[0], nx = b.st[1];
        if (nloc == 0u) { xcd_barrier_complete(bar, b.x, nloc, nx); b.st[0] = nloc; b.st[1] = nx; }
        const unsigned old = xb_add(&bar[XB_XSUB(b.x)], 1u);
        const unsigned gen = old / nloc;
        if (old + 1u == (gen + 1u) * nloc) {
            __builtin_amdgcn_fence(__ATOMIC_RELEASE, "agent");
            asm volatile("s_waitcnt vmcnt(0)" ::: "memory");
            const unsigned og = xb_add(&bar[XB_TOP], 1u);
            const unsigned tg = og / nx;
            if (og + 1u == (tg + 1u) * nx) xb_add(&bar[XB_TOPGEN], 1u);
            else XB_SPIN(xb_ld(&bar[XB_TOPGEN]) == tg, bar);
            __builtin_amdgcn_fence(__ATOMIC_ACQUIRE, "agent");
            xb_add(&bar[XB_XGEN(b.x)], 1u);
            asm volatile("s_waitcnt vmcnt(0)" ::: "memory");
        } else {
            XB_SPIN(xb_ld(&bar[XB_XGEN(b.x)]) == gen, bar);
            __builtin_amdgcn_fence(__ATOMIC_ACQUIRE, "agent");
            asm volatile("s_waitcnt vmcnt(0)" ::: "memory");
        }
    }
    __syncthreads();
}
namespace da {
constexpr int SLOT_K = 8192, SLOT_V = 16384;
constexpr int LDS_K = 0, LDS_V = 3 * SLOT_K;
constexpr int LDS_BIAS = LDS_V + 3 * SLOT_V;
constexpr int TAB_NR = BIAS_TAB - 4, TAB_CL = 2304;
constexpr int LDS_TREV = LDS_BIAS + BIAS_TAB * 4;
constexpr int LDS_FLAG = LDS_TREV + 4 * TAB_CL * 4;
constexpr int LDS_END = LDS_FLAG + 16;
static_assert(LDS_END <= RING_BYTES && (LDS_TREV % 16) == 0 && (TAB_NR % 4) == 0, "attention LDS map");
constexpr float THR = 8.f;
__device__ __forceinline__ int crow(int r, int hi) { return (r & 3) + 8 * (r >> 2) + 4 * hi; }
__device__ __forceinline__ void glds16(const void* gbase  , unsigned voff  , unsigned lds_dst) { unsigned keep;
    asm volatile("s_mov_b32 %0, m0\n\ts_mov_b32 m0, %3\n\ts_nop 0\n\tglobal_load_lds_dwordx4 %1, %2\n\ts_mov_b32 m0, %0" : "=&s"(keep) : "v"(voff), "s"(gbase), "s"(lds_dst) : "memory"); }
typedef short v4i16_t __attribute__((ext_vector_type(4)));
__device__ __forceinline__ s16x4 vtr(const LAS char* p) { return __builtin_bit_cast(s16x4, __builtin_amdgcn_ds_read_tr16_b64_v4i16((LAS v4i16_t*)p)); }

struct Tensors { const bf16* Qd; const bf16* Kd; const bf16* Vd; float* stash; bf16* ya; const float* dlam; const float* subg; const float* relb; };

#define DA_SBAR() __builtin_amdgcn_sched_barrier(0)
#define DA_PIN(x) asm volatile("" : "+v"(x))
#define DA_MFMA(a, b, c) __builtin_amdgcn_mfma_f32_32x32x16_bf16(a, b, c, 0, 0, 0)
#define DA_MX3(a, b, c) __builtin_fmaxf(__builtin_fmaxf((a), (b)), (c))
__device__ __forceinline__ float rowmax(const f32x16& p0, const f32x16& p1) {
    float a = DA_MX3(p0[0], p0[1], p1[0]), b = DA_MX3(p0[2], p0[3], p1[1]); a = DA_MX3(a, p1[2], p1[3]);
#pragma unroll
    for (int r = 4; r < 16; r += 4) { a = DA_MX3(a, p0[r], p0[r + 1]); b = DA_MX3(b, p0[r + 2], p0[r + 3]); a = DA_MX3(a, p1[r], p1[r + 1]); b = DA_MX3(b, p1[r + 2], p1[r + 3]); }
    float mx = __builtin_fmaxf(a, b); auto rr = __builtin_amdgcn_permlane32_swap(__float_as_uint(mx), __float_as_uint(mx), false, false);
    return __builtin_fmaxf(__uint_as_float(rr[0]), __uint_as_float(rr[1])); }

#define DA_TABINIT(N0, N1, T_) do { int base_ = qabs - 64 * (T_) - 4 * hi + BIAS_GUARD; asm volatile("" : "+v"(base_)); \
        _Pragma("unroll") for (int r = 0; r < 16; ++r) { const int o_ = (r & 3) + 8 * (r >> 2); N0[r] = tb[base_ - o_] - m; N1[r] = tb[base_ - o_ - 32] - m; } } while (0)
#define DA_TREV4(N, j, off) do { const f32x4 t4_ = *(const LAS f32x4*)(ta_ + (off)); N[4 * (j)] = t4_[0]; N[4 * (j) + 1] = t4_[1]; N[4 * (j) + 2] = t4_[2]; N[4 * (j) + 3] = t4_[3]; } while (0)
#define DA_TREVINIT(N0, N1, T_) do { const LAS char* ta_ = trev0 + 256 * (T_); DA_TREV4(N0, 0, 0); DA_TREV4(N0, 1, 32); DA_TREV4(N0, 2, 64); DA_TREV4(N0, 3, 96); \
        DA_TREV4(N1, 0, 128); DA_TREV4(N1, 1, 160); DA_TREV4(N1, 2, 192); DA_TREV4(N1, 3, 224); } while (0)
#define DA_NEARINIT(N0, N1, T_) do { if (OPT) DA_TREVINIT(N0, N1, T_); else DA_TABINIT(N0, N1, T_); } while (0)
#define DA_MASK(C0, C1, T_) do { int base_ = qabs - 64 * (T_) - 4 * hi + BIAS_GUARD; asm volatile("" : "+v"(base_)); \
        _Pragma("unroll") for (int r = 0; r < 16; ++r) { const int o_ = (r & 3) + 8 * (r >> 2); if (base_ - o_ < BIAS_GUARD) C0[r] = -1e30f; if (base_ - o_ - 32 < BIAS_GUARD) C1[r] = -1e30f; } } while (0)
#define DA_FAR(T_) ((q0 - 64 * (T_) - 63) >= DFAR)
#define DA_PKW(P, i) cvtpk(P[i], P[(i) + 1])
#define DA_PAF(k) __builtin_bit_cast(bf16x8, pw[k])
#define DA_VOFF(g) ((2 * ((g) >> 3) + ((g) & 1)) * 4096 + (((g) >> 1) & 3) * 1024)
#define DA_VRD(g) do { vl[(g) % 5] = vtr(vp_ + DA_VOFF(g)); vh[(g) % 5] = vtr(vp_ + DA_VOFF(g) + 512); } while (0)
#define DA_VFR(g) (bf16x8){vl[(g) % 5][0], vl[(g) % 5][1], vl[(g) % 5][2], vl[(g) % 5][3], vh[(g) % 5][0], vh[(g) % 5][1], vh[(g) % 5][2], vh[(g) % 5][3]}
#define DA_KRD(G, j) do { if (G) kf[j] = *(const LAS bf16x8*)(kp_ + ((j) >> 1) * 2048 + ((j) & 1) * 512); } while (0)
#define DA_GAPA(MF, a0, a1, a2, a3, W0, W1, PW, G, j) do { MF; DA_KRD(G, j); sacc += a0; sacc += a1; sacc += a2; sacc += a3; W0; W1; DA_PIN(PW); DA_PIN(sacc); DA_SBAR(); } while (0)
#define DA_GAPB(g, X, i) do { o[2 * ((g) >> 3) + ((g) & 1)] = DA_MFMA(DA_VFR(g), DA_PAF(((g) >> 1) & 3), o[2 * ((g) >> 3) + ((g) & 1)]); \
        X[i] = __builtin_amdgcn_exp2f(X[i]); X[(i) + 1] = __builtin_amdgcn_exp2f(X[(i) + 1]); DA_PIN(X); DA_SBAR(); } while (0)
#define DA_STEP(OPT, C0, C1, P0, P1, T_, MASK, GK, GV, GL, FARV, NEARN) do { DA_SBAR(); const int t_ = (T_); \
    const LAS char* vp_ = vp0 + sl_prev * SLOT_V; const LAS char* kp_ = kp0 + sl_next * SLOT_K; const LAS char* ta_ = trev0 + 256 * (t_ + 1); (void)ta_; \
    if (!OPT && FARV) { const float cm_ = c31 - m; _Pragma("unroll") for (int r = 0; r < 16; ++r) { C0[r] = cm_; C1[r] = cm_; } }     \
    float sacc = P0[0] + P0[1]; \
                       DA_GAPA(C0 = DA_MFMA(kf[0], qr[0], (OPT && FARV) ? cinit : C0), P0[2], P0[3], P0[4], P0[5],     pw[0][0] = DA_PKW(P0, 0),  pw[0][1] = DA_PKW(P0, 2),  pw[0], GL, 0); \
                       DA_GAPA(C1 = DA_MFMA(kf[1], qr[0], (OPT && FARV) ? cinit : C1), P0[6], P0[7], P0[8], P0[9],     pw[0][2] = DA_PKW(P0, 4),  pw[0][3] = DA_PKW(P0, 6),  pw[0], GL, 1); \
                       DA_GAPA(C0 = DA_MFMA(kf[2], qr[1], C0),               P0[10], P0[11], P0[12], P0[13], pw[1][0] = DA_PKW(P0, 8),  pw[1][1] = DA_PKW(P0, 10), pw[1], GL, 2); \
                       DA_GAPA(C1 = DA_MFMA(kf[3], qr[1], C1),               P0[14], P0[15], P1[0], P1[1],   pw[1][2] = DA_PKW(P0, 12), pw[1][3] = DA_PKW(P0, 14), pw[1], GL, 3); \
    DA_VRD(0); DA_SBAR(); DA_GAPA(C0 = DA_MFMA(kf[4], qr[2], C0),               P1[2], P1[3], P1[4], P1[5],     pw[2][0] = DA_PKW(P1, 0),  pw[2][1] = DA_PKW(P1, 2),  pw[2], GL, 4); \
    DA_VRD(1); DA_SBAR(); DA_GAPA(C1 = DA_MFMA(kf[5], qr[2], C1),               P1[6], P1[7], P1[8], P1[9],     pw[2][2] = DA_PKW(P1, 4),  pw[2][3] = DA_PKW(P1, 6),  pw[2], GL, 5); \
    DA_VRD(2); DA_SBAR(); DA_GAPA(C0 = DA_MFMA(kf[6], qr[3], C0),               P1[10], P1[11], P1[12], P1[13], pw[3][0] = DA_PKW(P1, 8),  pw[3][1] = DA_PKW(P1, 10), pw[3], GL, 6); \
    DA_VRD(3); DA_SBAR(); DA_GAPA(C1 = DA_MFMA(kf[7], qr[3], C1),               P1[14], P1[15], 0.f, 0.f,       pw[3][2] = DA_PKW(P1, 12), pw[3][3] = DA_PKW(P1, 14), pw[3], GL, 7); \
    l += sacc; \
    if (MASK) { if (t_ >= NT - 4) DA_MASK(C0, C1, t_); } \
    if (!OPT) { const float rm_ = rowmax(C0, C1); resc = false; \
      if (__builtin_expect(__any(rm_ > THR), 0)) { const float dl_ = __builtin_fmaxf(rm_, 0.f); m += dl_; fsc = __builtin_amdgcn_exp2f(-dl_); l *= fsc; resc = true; \
          _Pragma("unroll") for (int r = 0; r < 16; ++r) { C0[r] -= dl_; C1[r] -= dl_; } \
          } } \
    DA_SBAR(); \
    DA_VRD(4);                  DA_SBAR(); DA_GAPB(0, C0, 0); \
    DA_VRD(5);                  DA_SBAR(); DA_GAPB(1, C0, 2); \
    DA_VRD(6);                  DA_SBAR(); DA_GAPB(2, C0, 4); \
    DA_VRD(7);                  DA_SBAR(); DA_GAPB(3, C0, 6); \
    DA_VRD(8);                  DA_SBAR(); DA_GAPB(4, C0, 8); \
    DA_VRD(9);                  DA_SBAR(); DA_GAPB(5, C0, 10); \
    DA_VRD(10);                 DA_SBAR(); DA_GAPB(6, C0, 12); \
    DA_VRD(11);                 DA_SBAR(); DA_GAPB(7, C0, 14); \
    DA_VRD(12);                 DA_SBAR(); DA_GAPB(8, C1, 0); \
    DA_VRD(13);                 DA_SBAR(); DA_GAPB(9, C1, 2); \
    DA_VRD(14);                 DA_SBAR(); DA_GAPB(10, C1, 4); \
    DA_VRD(15);                 DA_SBAR(); DA_GAPB(11, C1, 6); \
    if (OPT && NEARN) { DA_TREV4(P0, 0, 0);  DA_TREV4(P0, 1, 32); }  DA_SBAR(); DA_GAPB(12, C1, 8); \
    if (GK) DA_DMA_K(t_ + 3, sl_cur);                                                           \
    if (OPT && NEARN) { DA_TREV4(P0, 2, 64); DA_TREV4(P0, 3, 96); }  DA_SBAR(); DA_GAPB(13, C1, 10); \
    if (GV) DA_DMA_V(t_ + 1, sl_next);                                                          \
    if (OPT && NEARN) { DA_TREV4(P1, 0, 128); DA_TREV4(P1, 1, 160); } DA_SBAR(); DA_GAPB(14, C1, 12); \
    if (OPT && NEARN) { DA_TREV4(P1, 2, 192); DA_TREV4(P1, 3, 224); } DA_SBAR(); DA_GAPB(15, C1, 14); \
    if (!OPT && NEARN) DA_TABINIT(P0, P1, t_ + 1); \
    } while (0)
#define DA_RESC() do { if (resc) { _Pragma("unroll") for (int d0 = 0; d0 < 4; ++d0) _Pragma("unroll") for (int r = 0; r < 16; ++r) o[d0][r] *= fsc; } } while (0)
#define DA_WAITB(N) asm volatile("s_waitcnt vmcnt(" #N ") lgkmcnt(0)\n\ts_barrier" ::: "memory")
#define DA_ROT() do { sl_prev = sl_cur; sl_cur = sl_next; sl_next = (sl_next == 2) ? 0 : sl_next + 1; } while (0)
#define DA_ENDW(tt) do { if ((tt) + 3 < NT) { DA_WAITB(3); } else if ((tt) + 2 < NT) { DA_WAITB(2); } else { DA_WAITB(0); } } while (0)

template <bool OPT>
__device__ __forceinline__ void pass(const Tensors& X, int b, int h, int c, const int q0, const int NT, LAS unsigned char* lds, float c31, const int wid, f32x16 (&o)[4], float& l_out) {
    const unsigned lds0 = (unsigned)(uintptr_t)lds;
    const LAS float* tb = (const LAS float*)(lds + LDS_BIAS); (void)tb;
    {
        int lane = (int)__builtin_amdgcn_mbcnt_hi(~0u, __builtin_amdgcn_mbcnt_lo(~0u, 0u)); asm volatile("" : "+v"(lane));
        const int r32 = lane & 31, hi = lane >> 5;
        const unsigned lane16 = (unsigned)lane * 16u;
        const int qabs = q0 + wid * 32 + r32;
        const LAS char* vp0 = (const LAS char*)lds + LDS_V + ((lane >> 4) & 1) * 32 + (lane & 3) * 8 + (4 * hi + ((lane & 15) >> 2)) * 64;
        const LAS char* kp0 = (const LAS char*)lds + LDS_K + hi * 1024 + r32 * 16;
        const LAS char* trev0 = (const LAS char*)lds + LDS_TREV + (r32 & 3) * (TAB_CL * 4) + 4 * (TAB_NR - (qabs - (r32 & 3) - 4 * hi + BIAS_GUARD));
        const int bhc = (b * 4 + h) * 2 + c;
        const bf16* Qw = X.Qd + ((size_t)bhc * SEQ + q0 + wid * 32 + r32) * 64 + hi * 8;
        const char* Kt = (const char*)X.Kd + (size_t)bhc * NTILE * SLOT_K + wid * 1024;
        const char* Vt = (const char*)X.Vd + (size_t)(b * 4 + h) * NTILE * SLOT_V + wid * 1024;
#define DA_DMA_K(t, slot) glds16(Kt + (size_t)(t) * SLOT_K, lane16, (unsigned)__builtin_amdgcn_readfirstlane(lds0 + LDS_K + (slot) * SLOT_K + wid * 1024))
#define DA_DMA_V(t, slot) do { const unsigned sb_ = (unsigned)__builtin_amdgcn_readfirstlane(lds0 + LDS_V + (slot) * SLOT_V + wid * 1024); \
        glds16(Vt + (size_t)(t) * SLOT_V, lane16, sb_); glds16(Vt + (size_t)(t) * SLOT_V + 8192, lane16, sb_ + 8192); } while (0)
        DA_DMA_K(0, 0); DA_DMA_V(0, 0); DA_DMA_K(1, 1); DA_DMA_K(2, 2);
        bf16x8 qr[4];
#pragma unroll
        for (int d0 = 0; d0 < 4; ++d0) qr[d0] = *(const GAS bf16x8*)(Qw + d0 * 16);
#pragma unroll
        for (int d0 = 0; d0 < 4; ++d0)
#pragma unroll
            for (int r = 0; r < 16; ++r) o[d0][r] = 0.f;
        float m = 0.f, l = 0.f, fsc = 1.f; bool resc = false; (void)fsc; (void)resc;
        f32x16 pA0, pA1, pB0, pB1, cinit; bf16x8 kf[8]; s16x4 vl[5], vh[5]; v4u pw[4];
        int sl_prev = 0, sl_cur = 1, sl_next = 2;
        asm volatile("" :: "v"(qr[0]), "v"(qr[1]), "v"(qr[2]), "v"(qr[3]));
        DA_WAITB(4);
        {   const LAS char* kp_ = kp0;
#pragma unroll
            for (int j = 0; j < 8; ++j) DA_KRD(true, j);
            if (DA_FAR(0)) {
#pragma unroll
                for (int r = 0; r < 16; ++r) { pA0[r] = c31; pA1[r] = c31; }
            } else DA_NEARINIT(pA0, pA1, 0);
#pragma unroll
            for (int d0 = 0; d0 < 4; ++d0) { pA0 = DA_MFMA(kf[2 * d0], qr[d0], pA0); pA1 = DA_MFMA(kf[2 * d0 + 1], qr[d0], pA1); }
            if (NT == 4) DA_MASK(pA0, pA1, 0);
            if (!OPT) m = rowmax(pA0, pA1);
#pragma unroll
            for (int r = 0; r < 16; ++r) { pA0[r] = __builtin_amdgcn_exp2f(pA0[r] - m); pA1[r] = __builtin_amdgcn_exp2f(pA1[r] - m); }
        }
        DA_WAITB(0);
        DA_DMA_K(3, 0); DA_DMA_V(1, 1);
        {   const LAS char* kp_ = kp0 + SLOT_K;
#pragma unroll
            for (int j = 0; j < 8; ++j) DA_KRD(true, j);
        }
        DA_WAITB(3);
        {   const float cm = c31 - m;
#pragma unroll
            for (int r = 0; r < 16; ++r) cinit[r] = cm; }
        int t = 1;
        for (; t + 5 < NT && DA_FAR(t + 1); t += 2) {
            DA_STEP(OPT, pB0, pB1, pA0, pA1, t, false, true, true, true, true, false);     DA_WAITB(3); DA_RESC(); DA_ROT();
            DA_STEP(OPT, pA0, pA1, pB0, pB1, t + 1, false, true, true, true, true, false); DA_WAITB(3); DA_RESC(); DA_ROT();
        }
        DA_NEARINIT(pB0, pB1, t);
        for (; t + 5 < NT; t += 2) {
            DA_STEP(OPT, pB0, pB1, pA0, pA1, t, false, true, true, true, false, true);     DA_WAITB(3); DA_RESC(); DA_ROT();
            DA_STEP(OPT, pA0, pA1, pB0, pB1, t + 1, false, true, true, true, false, true); DA_WAITB(3); DA_RESC(); DA_ROT();
        }
        for (; t + 1 < NT; t += 2) {
            DA_STEP(OPT, pB0, pB1, pA0, pA1, t, true, (t + 3 < NT), (t + 1 < NT), (t + 1 < NT), false, true);         DA_ENDW(t);     DA_RESC(); DA_ROT();
            DA_STEP(OPT, pA0, pA1, pB0, pB1, t + 1, true, (t + 4 < NT), (t + 2 < NT), (t + 2 < NT), false, true);     DA_ENDW(t + 1); DA_RESC(); DA_ROT();
        }
        DA_STEP(OPT, pB0, pB1, pA0, pA1, NT - 1, true, false, false, false, false, false); DA_RESC();
        {   float sacc = pB0[0] + pB0[1];
#pragma unroll
            for (int r = 2; r < 16; ++r) sacc += pB0[r];
#pragma unroll
            for (int r = 0; r < 16; ++r) sacc += pB1[r];
            l += sacc;
            pw[0] = (v4u){DA_PKW(pB0, 0), DA_PKW(pB0, 2), DA_PKW(pB0, 4), DA_PKW(pB0, 6)}; pw[1] = (v4u){DA_PKW(pB0, 8), DA_PKW(pB0, 10), DA_PKW(pB0, 12), DA_PKW(pB0, 14)};
            pw[2] = (v4u){DA_PKW(pB1, 0), DA_PKW(pB1, 2), DA_PKW(pB1, 4), DA_PKW(pB1, 6)}; pw[3] = (v4u){DA_PKW(pB1, 8), DA_PKW(pB1, 10), DA_PKW(pB1, 12), DA_PKW(pB1, 14)};
            const LAS char* vb_ = vp0 + sl_cur * SLOT_V;
#pragma unroll
            for (int d0 = 0; d0 < 4; ++d0) {
#pragma unroll
                for (int ks = 0; ks < 4; ++ks) { const s16x4 lo_ = vtr(vb_ + d0 * 4096 + ks * 1024), hh_ = vtr(vb_ + d0 * 4096 + ks * 1024 + 512);
                    const bf16x8 vf_ = (bf16x8){lo_[0], lo_[1], lo_[2], lo_[3], hh_[0], hh_[1], hh_[2], hh_[3]};
                    o[d0] = DA_MFMA(vf_, DA_PAF(ks), o[d0]); }
                DA_SBAR(); }
        }
#undef DA_DMA_K
#undef DA_DMA_V
        l_out = l;
    }
}

__device__ __forceinline__ void unit(const Tensors& X, int b, int h, int qb, LAS unsigned char* lds, int wgslot, float lam, float c31, const int wid  ) {
    const int q0 = qb * 256, NT = 4 * (qb + 1);
    for (int c = 0; c < 2; ++c) {
        int lane = (int)__builtin_amdgcn_mbcnt_hi(~0u, __builtin_amdgcn_mbcnt_lo(~0u, 0u)); asm volatile("" : "+v"(lane));
        LAS unsigned* flag = (LAS unsigned*)(lds + LDS_FLAG);
        if (wid == 0 && lane == 0) *flag = 0u;
        f32x16 o[4]; float l;
        pass<true>(X, b, h, c, q0, NT, lds, c31, wid, o, l);
        { auto rr = __builtin_amdgcn_permlane32_swap(__float_as_uint(l), __float_as_uint(l), false, false); l = __uint_as_float(rr[0]) + __uint_as_float(rr[1]); }
        if (!__all(l > 1e-30f && l < 1e30f)) *flag = 1u;
        asm volatile("s_waitcnt vmcnt(0) lgkmcnt(0)\n\ts_barrier" ::: "memory");
        if (__builtin_expect(*(volatile LAS unsigned*)flag != 0u, 0)) {
            pass<false>(X, b, h, c, q0, NT, lds, c31, wid, o, l);
            { auto rr = __builtin_amdgcn_permlane32_swap(__float_as_uint(l), __float_as_uint(l), false, false); l = __uint_as_float(rr[0]) + __uint_as_float(rr[1]); }
        }
        const float inv = 1.f / l;
        int lane_e = lane; asm volatile("" : "+v"(lane_e));
        GAS unsigned* stg = (GAS unsigned*)((unsigned*)X.stash + ((size_t)(wgslot * 8 + wid) * 32) * 64 + lane_e);
        if (c == 0) {
#pragma unroll
            for (int d0 = 0; d0 < 4; ++d0)
#pragma unroll
                for (int r = 0; r < 16; r += 2) stg[(d0 * 8 + (r >> 1)) * 64] = cvtpk(o[d0][r] * inv, o[d0][r + 1] * inv);
        } else {
            float ss = 0.f;
#pragma unroll
            for (int d0 = 0; d0 < 4; ++d0)
#pragma unroll
                for (int r = 0; r < 16; r += 2) { const unsigned w1 = stg[(d0 * 8 + (r >> 1)) * 64]; const float dv0 = bf_lo(w1) - lam * (o[d0][r] * inv), dv1 = bf_hi(w1) - lam * (o[d0][r + 1] * inv);
                    o[d0][r] = dv0; o[d0][r + 1] = dv1; ss += dv0 * dv0 + dv1 * dv1; if (r == 14) asm volatile("" ::: "memory"); }
            { auto rr = __builtin_amdgcn_permlane32_swap(__float_as_uint(ss), __float_as_uint(ss), false, false); ss = __uint_as_float(rr[0]) + __uint_as_float(rr[1]); }
            const float rn = __builtin_amdgcn_rsqf(ss * (1.f / 128.f) + SUBLN_EPS) * (1.f - LAM_INIT);
            const int hi_e = lane_e >> 5, qabs_e = q0 + wid * 32 + (lane_e & 31);
            bf16* yrow = X.ya + ((size_t)b * SEQ + qabs_e) * 512 + h * 128 + 4 * hi_e; const float* sg = X.subg + 4 * hi_e;
#pragma unroll
            for (int d0 = 0; d0 < 4; ++d0)
#pragma unroll
                for (int r4 = 0; r4 < 4; ++r4) {
                    const int dd = 32 * d0 + 8 * r4; const f32x4 g = *(const GAS f32x4*)(sg + dd);
                    v2u w; w.x = pk2(o[d0][4 * r4] * rn * g[0], o[d0][4 * r4 + 1] * rn * g[1]); w.y = pk2(o[d0][4 * r4 + 2] * rn * g[2], o[d0][4 * r4 + 3] * rn * g[3]);
                    *(GAS v2u*)(yrow + dd) = w;
                }
        }
        asm volatile("s_waitcnt vmcnt(0) lgkmcnt(0)\n\ts_barrier" ::: "memory");
    }
}
#undef DA_STEP
#undef DA_GAPA
#undef DA_GAPB
#undef DA_KRD
#undef DA_VRD
#undef DA_VFR
#undef DA_VOFF
#undef DA_PAF
#undef DA_PKW
#undef DA_FAR
#undef DA_MASK
#undef DA_TREV4
#undef DA_TREVINIT
#undef DA_NEARINIT
#undef DA_TABINIT
#undef DA_RESC
#undef DA_WAITB
#undef DA_ROT
#undef DA_ENDW
#undef DA_MX3
#undef DA_MFMA
#undef DA_PIN
#undef DA_SBAR
}
namespace dil {
constexpr int BT = 1152, BT0 = 512;
constexpr int LDS_VST = 0, LDS_BL = 32768, LDS_END = LDS_BL + 3 * BT * 4;
constexpr float THR = 8.f;
struct Tensors { const bf16* LQ; const bf16* LK; const bf16* LV; bf16* yb; };
typedef short v4i16_t __attribute__((ext_vector_type(4)));
__device__ __forceinline__ s16x4 vtr(const LAS unsigned char* p) { return __builtin_bit_cast(s16x4, __builtin_amdgcn_ds_read_tr16_b64_v4i16((LAS v4i16_t*)p)); }

template <int G_, int QS_> __device__ __forceinline__ void group(const Tensors& X, size_t rowb, int h, int P0, int r, LAS unsigned char* vst, const LAS float* blg, int lane, f32x16 (&o)[2], float& m, float& l) {
    constexpr int DL = (G_ == 0) ? 1 : (G_ == 1) ? 4 : 16, MG = QS_ / DL, NKB = (31 * MG + 128) / 32 + 1;
    static_assert(QS_ % DL == 0, "query stride must be a multiple of the dilation");
    const int i = lane & 31, hi = lane >> 5;
    const int colb = G_ * 256 + h * 64;
    bf16x8 qr[4];
    { const bf16* qp = X.LQ + (rowb + P0 + r + QS_ * i) * 768 + colb + hi * 8;
#pragma unroll
      for (int d0 = 0; d0 < 4; ++d0) qr[d0] = *(const GAS bf16x8*)(qp + 16 * d0); }
    const int kpos0 = P0 + r - 128 * DL;
    const LAS unsigned char* vrd = vst + ((lane >> 4) & 1) * 32 + (lane & 3) * 8 + (4 * hi + ((lane & 15) >> 2)) * 64;
#define DIL_LOAD(KF, VR, KB) do { \
        { int kpos_ = kpos0 + (32 * (KB) + i) * DL; kpos_ = kpos_ < 0 ? 0 : (kpos_ > SEQ - 1 ? SEQ - 1 : kpos_); const bf16* kp_ = X.LK + (rowb + kpos_) * 768 + colb + hi * 8; \
          _Pragma("unroll") for (int d0 = 0; d0 < 4; ++d0) KF[d0] = *(const GAS bf16x8*)(kp_ + 16 * d0); } \
        _Pragma("unroll") for (int t = 0; t < 4; ++t) { const int qd = lane + 64 * t, key = qd >> 3, ch = qd & 7; int vpos_ = kpos0 + (32 * (KB) + key) * DL; vpos_ = vpos_ < 0 ? 0 : (vpos_ > SEQ - 1 ? SEQ - 1 : vpos_); \
            VR[t] = *(const GAS v4u*)(X.LV + (rowb + vpos_) * 768 + colb + ch * 8); } } while (0)
    bf16x8 kfn[4]; v4u vregn[4];
    DIL_LOAD(kfn, vregn, 0);
#pragma unroll 1
    for (int kb = 0; kb < NKB; ++kb) {
        bf16x8 kf[4]; v4u vreg[4];
#pragma unroll
        for (int d0 = 0; d0 < 4; ++d0) { kf[d0] = kfn[d0]; vreg[d0] = vregn[d0]; }
        if (kb + 1 < NKB) DIL_LOAD(kfn, vregn, kb + 1);
        const int jb = i * MG + 128 - 32 * kb - 4 * hi;
        f32x16 p;
#pragma unroll
        for (int rr = 0; rr < 16; ++rr) p[rr] = blg[jb - ((rr & 3) + 8 * (rr >> 2)) + BT0];
#pragma unroll
        for (int d0 = 0; d0 < 4; ++d0) p = __builtin_amdgcn_mfma_f32_32x32x16_bf16(kf[d0], qr[d0], p, 0, 0, 0);
        const int cb = 32 * kb + 4 * hi;
#pragma unroll
        for (int rr = 0; rr < 16; ++rr) { const int o_ = (rr & 3) + 8 * (rr >> 2); if ((unsigned)(jb - o_) > 128u || kpos0 + (cb + o_) * DL < 0) p[rr] = -3e38f; }
        float rm = p[0];
#pragma unroll
        for (int rr = 1; rr < 16; ++rr) rm = fmaxf(rm, p[rr]);
        { auto sw = __builtin_amdgcn_permlane32_swap(__float_as_uint(rm), __float_as_uint(rm), false, false); rm = fmaxf(__uint_as_float(sw[0]), __uint_as_float(sw[1])); }
        if (__any(rm > m + THR)) {
            const float mn = fmaxf(m, rm), f = __builtin_amdgcn_exp2f(m - mn);
#pragma unroll
            for (int d0 = 0; d0 < 2; ++d0)
#pragma unroll
                for (int rr = 0; rr < 16; ++rr) o[d0][rr] *= f;
            l *= f; m = mn;
        }
        float ls = 0.f;
#pragma unroll
        for (int rr = 0; rr < 16; ++rr) { p[rr] = __builtin_amdgcn_exp2f(p[rr] - m); ls += p[rr]; }
        l += ls;
        bf16x8 pw[2];
        { v4u w;
          w.x = cvtpk(p[0], p[1]); w.y = cvtpk(p[2], p[3]); w.z = cvtpk(p[4], p[5]); w.w = cvtpk(p[6], p[7]); pw[0] = __builtin_bit_cast(bf16x8, w);
          w.x = cvtpk(p[8], p[9]); w.y = cvtpk(p[10], p[11]); w.z = cvtpk(p[12], p[13]); w.w = cvtpk(p[14], p[15]); pw[1] = __builtin_bit_cast(bf16x8, w); }
#pragma unroll
        for (int t = 0; t < 4; ++t) { const int qd = lane + 64 * t, key = qd >> 3, ch = qd & 7;
            *(LAS v4u*)(vst + ((ch >> 2) * 2 + (key >> 4)) * 1024 + (key & 15) * 64 + (ch & 3) * 16) = vreg[t]; }
        asm volatile("s_waitcnt lgkmcnt(0)" ::: "memory");
#pragma unroll
        for (int d0 = 0; d0 < 2; ++d0)
#pragma unroll
            for (int ks = 0; ks < 2; ++ks) {
                const s16x4 lo = vtr(vrd + (d0 * 2 + ks) * 1024), hh = vtr(vrd + (d0 * 2 + ks) * 1024 + 512);
                const bf16x8 vf = (bf16x8){lo[0], lo[1], lo[2], lo[3], hh[0], hh[1], hh[2], hh[3]};
                o[d0] = __builtin_amdgcn_mfma_f32_32x32x16_bf16(vf, pw[ks], o[d0], 0, 0, 0);
            }
        asm volatile("s_waitcnt lgkmcnt(0)" ::: "memory");
    }
#undef DIL_LOAD
}
__device__ __forceinline__ void wave_tile_g0(const Tensors& X, float* lse0, int b, int h, int P0, LAS unsigned char* vst, const LAS float* bl, int lane) {
    const size_t rowb = (size_t)b * SEQ;
    f32x16 o[2];
#pragma unroll
    for (int d0 = 0; d0 < 2; ++d0)
#pragma unroll
        for (int rr = 0; rr < 16; ++rr) o[d0][rr] = 0.f;
    float m = -1e30f, l = 0.f;
    group<0, 1>(X, rowb, h, P0, 0, vst, bl, lane, o, m, l);
    { auto sw = __builtin_amdgcn_permlane32_swap(__float_as_uint(l), __float_as_uint(l), false, false); l = __uint_as_float(sw[0]) + __uint_as_float(sw[1]); }
    const float inv = 1.f / l; const int i = lane & 31, hi = lane >> 5;
    bf16* yrow = X.yb + (rowb + P0 + i) * 256 + h * 64 + 4 * hi;
#pragma unroll
    for (int d0 = 0; d0 < 2; ++d0)
#pragma unroll
        for (int r4 = 0; r4 < 4; ++r4) { v2u w; w.x = pk2(o[d0][4 * r4] * inv, o[d0][4 * r4 + 1] * inv); w.y = pk2(o[d0][4 * r4 + 2] * inv, o[d0][4 * r4 + 3] * inv); *(GAS v2u*)(yrow + 32 * d0 + 8 * r4) = w; }
    if (hi == 0) ((GAS float*)lse0)[(rowb + P0 + i) * 4 + h] = m + __builtin_amdgcn_logf(l);
}
__device__ __forceinline__ void wave_tile(const Tensors& X, const float* lse0, int b, int h, int P0, int r, LAS unsigned char* vst, const LAS float* bl, int lane) {
    const size_t rowb = (size_t)b * SEQ;
    f32x16 o[2];
#pragma unroll
    for (int d0 = 0; d0 < 2; ++d0)
#pragma unroll
        for (int rr = 0; rr < 16; ++rr) o[d0][rr] = 0.f;
    float m = -1e30f, l = 0.f;
    group<1, 16>(X, rowb, h, P0, r, vst, bl + BT, lane, o, m, l);
    group<2, 16>(X, rowb, h, P0, r, vst, bl + 2 * BT, lane, o, m, l);
    { auto sw = __builtin_amdgcn_permlane32_swap(__float_as_uint(l), __float_as_uint(l), false, false); l = __uint_as_float(sw[0]) + __uint_as_float(sw[1]); }
    const int i = lane & 31, hi = lane >> 5;
    const float w0 = __builtin_amdgcn_exp2f(((const GAS float*)lse0)[(rowb + P0 + r + 16 * i) * 4 + h] - m);
    const float inv = 1.f / (l + w0);
    bf16* yrow = X.yb + (rowb + P0 + r + 16 * i) * 256 + h * 64 + 4 * hi;
#pragma unroll
    for (int d0 = 0; d0 < 2; ++d0)
#pragma unroll
        for (int r4 = 0; r4 < 4; ++r4) { const v2u g0 = *(const GAS v2u*)(yrow + 32 * d0 + 8 * r4);
            v2u w; w.x = pk2((o[d0][4 * r4] + w0 * bf_lo(g0.x)) * inv, (o[d0][4 * r4 + 1] + w0 * bf_hi(g0.x)) * inv); w.y = pk2((o[d0][4 * r4 + 2] + w0 * bf_lo(g0.y)) * inv, (o[d0][4 * r4 + 3] + w0 * bf_hi(g0.y)) * inv);
            *(GAS v2u*)(yrow + 32 * d0 + 8 * r4) = w; }
}
}
__device__ __forceinline__ void p0_transpose_item(const float* W, int K, int N, bf16* WT, LAS float* scr, int item, int lane) {
    const int nblk = N / 32, kb = item / nblk, nb = item % nblk, k0 = 64 * kb, n0 = 32 * nb;
#pragma unroll 8
    for (int i = 0; i < 32; ++i) { const int kk = 2 * i + (lane >> 5); scr[kk * 33 + (lane & 31)] = W[(size_t)(k0 + kk) * N + n0 + (lane & 31)]; }
    LDS_WAIT(); asm volatile("" ::: "memory");
    const int c = lane & 7;
#pragma unroll
    for (int j = 0; j < 4; ++j) { const int n = (lane >> 3) + 8 * j; const LAS float* s = scr + (8 * c) * 33 + n;
        v4u o; o.x = pk2(s[0 * 33], s[1 * 33]); o.y = pk2(s[2 * 33], s[3 * 33]); o.z = pk2(s[4 * 33], s[5 * 33]); o.w = pk2(s[6 * 33], s[7 * 33]);
        *(v4u*)(WT + (size_t)(n0 + n) * K + k0 + 8 * c) = o; }
    LDS_WAIT(); asm volatile("" ::: "memory");
}
__device__ __forceinline__ void cast_bf16(const float* src, bf16* dst, size_t n8, size_t gtid, size_t gthreads) {
    for (size_t i = gtid; i < n8; i += gthreads) { const f32x4 a = *(const f32x4*)(src + i * 8), b = *(const f32x4*)(src + i * 8 + 4);
        v4u o; o.x = pk2(a[0], a[1]); o.y = pk2(a[2], a[3]); o.z = pk2(b[0], b[1]); o.w = pk2(b[2], b[3]); *(v4u*)(dst + i * 8) = o; }
}

struct Args { const float* in[16]; float* out; unsigned char* ws; int ph_lo, ph_hi; };
enum { I_X = 0, I_WIN, I_DLAM, I_SUBG, I_WBD, I_WBL, I_WO, I_LN1G, I_LN1B, I_PWQ, I_PKEYS, I_PU, I_PV, I_LN2G, I_LN2B, I_RELB };

__device__ __forceinline__ void p0_prologue(const Args& A, LAS unsigned char* lds, int vcu, int G, int wave, int lane) {
    unsigned char* ws = A.ws;
    const int gw = vcu * NWAVES + wave, NGW = G * NWAVES;
    const size_t gtid = (size_t)gw * 64 + lane, gthreads = (size_t)NGW * 64;
    LAS float* scr = (LAS float*)(lds + wave * 16384);
    constexpr int I_IN = (D / 64) * (INC / 32), I_BD = (512 / 64) * (D / 32), I_BL = (256 / 64) * (D / 32), I_O = (D / 64) * (D / 32);
    for (int it0 = gw; it0 < (I_IN + I_BD + I_BL + I_O) * NREP(32); it0 += NGW) {
        int r = it0 % (I_IN + I_BD + I_BL + I_O);
        if (r < I_IN) { p0_transpose_item(A.in[I_WIN], D, INC, (bf16*)(ws + WS_WIN), scr, r, lane); continue; } r -= I_IN;
        if (r < I_BD) { p0_transpose_item(A.in[I_WBD], 512, D, (bf16*)(ws + WS_WBD), scr, r, lane); continue; } r -= I_BD;
        if (r < I_BL) { p0_transpose_item(A.in[I_WBL], 256, D, (bf16*)(ws + WS_WBL), scr, r, lane); continue; } r -= I_BL;
        p0_transpose_item(A.in[I_WO], D, D, (bf16*)(ws + WS_WO), scr, r, lane);
    }
    for (int rep_ = 0; rep_ < NREP(31); ++rep_) cast_bf16(A.in[I_X], (bf16*)(ws + WS_A), (size_t)T * D / 8, gtid, gthreads);
    { const float* wq = A.in[I_PWQ]; const float* keys = A.in[I_PKEYS]; bf16* wp = (bf16*)(ws + WS_WP);
      for (int it0 = gw; it0 < 1024 * NREP(30); it0 += NGW) { const int it = it0 & 1023;
          const int hc = it >> 6, jb = (it >> 2) & 15, nq = it & 3, j = jb * 64 + lane;
          const f32x4* wr_ = (const f32x4*)(wq + (size_t)j * 2048 + hc * 128);
          f32x4 w[32];
#pragma unroll
          for (int d = 0; d < 32; ++d) w[d] = wr_[d];
#pragma unroll 1
          for (int n = nq * 32; n < nq * 32 + 32; ++n) {
              const f32x4* kr = (const f32x4*)(keys + (size_t)(hc * 128 + n) * 128);
              float a0 = 0.f, a1 = 0.f, a2 = 0.f, a3 = 0.f;
#pragma unroll
              for (int d = 0; d < 32; ++d) { const f32x4 k = kr[d]; a0 += w[d][0] * k[0]; a1 += w[d][1] * k[1]; a2 += w[d][2] * k[2]; a3 += w[d][3] * k[3]; }
              wp[(size_t)(hc * 128 + n) * 1024 + j] = (bf16)f2bf((a0 + a1) + (a2 + a3));
          }
      } }
    { const float* relb = A.in[I_RELB]; float* bd = (float*)(ws + WS_BIASD); float* bl = (float*)(ws + WS_BIASL);
      for (size_t i = gtid; i < 4 * BIAS_TAB; i += gthreads) { const int h = (int)(i / BIAS_TAB), dist = (int)(i % BIAS_TAB) - BIAS_GUARD; bd[i] = dist < 0 ? 0.f : relb[rel_bucket(dist) * 16 + h] * LOG2E; }
      for (size_t i = gtid; i < 12 * 132; i += gthreads) { const int gh = (int)(i / 132), j = (int)(i % 132), g = gh >> 2; const int dl = (g == 0) ? 1 : (g == 1) ? 4 : 16;
          bl[i] = relb[rel_bucket((j > 128 ? 128 : j) * dl) * 16 + 4 + gh] * LOG2E; } }
}

__device__ __forceinline__ void p5_ln1(const Args& A, int vcu, int G, int wave, int lane) {
    unsigned char* ws = A.ws;
    const int gw = vcu * NWAVES + wave, NGW = G * NWAVES;
    const float* R = (const float*)(ws + WS_R); bf16* x1b = (bf16*)(ws + WS_A);
    const float* gam = A.in[I_LN1G]; const float* bet = A.in[I_LN1B];
    f32x4 gv[4], bv[4];
#pragma unroll
    for (int j = 0; j < 4; ++j) { gv[j] = *(const f32x4*)(gam + 256 * j + 4 * lane); bv[j] = *(const f32x4*)(bet + 256 * j + 4 * lane); }
    f32x4 nx[4];
    if (gw < T) {
#pragma unroll
        for (int j = 0; j < 4; ++j) nx[j] = ((const f32x4*)(R + (size_t)gw * D) + lane)[64 * j]; }
#pragma unroll 1
    for (int mrow = gw; mrow < T; mrow += NGW) {
        f32x4 v[4]; float s = 0.f;
#pragma unroll
        for (int j = 0; j < 4; ++j) { v[j] = nx[j]; s += (v[j][0] + v[j][1]) + (v[j][2] + v[j][3]); }
        if (mrow + NGW < T) {
#pragma unroll
            for (int j = 0; j < 4; ++j) nx[j] = ((const f32x4*)(R + (size_t)(mrow + NGW) * D) + lane)[64 * j]; }
        const float mean = wave_sum(s) * (1.f / D); float s2 = 0.f;
#pragma unroll
        for (int j = 0; j < 4; ++j) { v[j] = v[j] - mean; s2 += (v[j][0] * v[j][0] + v[j][1] * v[j][1]) + (v[j][2] * v[j][2] + v[j][3] * v[j][3]); }
        const float rstd = __builtin_amdgcn_rsqf(wave_sum(s2) * (1.f / D) + LN_EPS);
        v2u* brow = (v2u*)(x1b + (size_t)mrow * D) + lane;
#pragma unroll
        for (int j = 0; j < 4; ++j) { const f32x4 y = v[j] * rstd * gv[j] + bv[j]; v2u w; w.x = pk2(y[0], y[1]); w.y = pk2(y[2], y[3]); brow[64 * j] = w; }
    }
}
namespace peer {
__device__ __forceinline__ int mono(float v) { const int b = __float_as_int(v); return b ^ ((b >> 31) & 0x7fffffff); }
__device__ __forceinline__ float unmono(int k) { return __int_as_float(k ^ ((k >> 31) & 0x7fffffff)); }
__device__ __forceinline__ int med3i(int a, int b, int c) { int r; asm("v_med3_i32 %0, %1, %2, %3" : "=v"(r) : "v"(a), "v"(b), "v"(c)); return r; }
#define PEER_INS16(a, x) do { _Pragma("unroll") for (int k_ = 15; k_ >= 1; --k_) a[k_] = med3i(a[k_ - 1], a[k_], (x)); a[0] = max(a[0], (x)); } while (0)
__device__ __forceinline__ unsigned byte_sel(const unsigned (&p)[4], int i) { const int w = i >> 2; const unsigned x = (w == 0) ? p[0] : (w == 1) ? p[1] : (w == 2) ? p[2] : p[3]; return (x >> ((i & 3) * 8)) & 0xffu; }
__device__ __forceinline__ float gelu_erf(float v) { return 0.5f * v * (1.f + erff(v * 0.7071067811865476f)); }

__device__ __forceinline__ void select(const float* ST, v2u* sel, int tok, int head) {
    int a0[16], a1[16];
#pragma unroll
    for (int k = 0; k < 16; ++k) { a0[k] = (int)0x80000000; a1[k] = (int)0x80000000; }
    const GAS float* s0 = (const GAS float*)ST + (size_t)(head * 256) * T + tok; const GAS float* s1 = s0 + (size_t)128 * T;
    float c0[8], c1[8];
#pragma unroll
    for (int i = 0; i < 8; ++i) { c0[i] = s0[(size_t)i * T]; c1[i] = s1[(size_t)i * T]; }
#pragma unroll 1
    for (int n = 0; n < 128; n += 8) {
        float x0[8], x1[8];
#pragma unroll
        for (int i = 0; i < 8; ++i) { x0[i] = c0[i]; x1[i] = c1[i]; }
        if (n + 8 < 128) {
#pragma unroll
            for (int i = 0; i < 8; ++i) { c0[i] = s0[(size_t)(n + 8 + i) * T]; c1[i] = s1[(size_t)(n + 8 + i) * T]; }
        }
#pragma unroll
        for (int i = 0; i < 8; ++i) { const int k0 = (mono(x0[i]) & ~127) | (127 - (n + i)), k1 = (mono(x1[i]) & ~127) | (127 - (n + i)); PEER_INS16(a0, k0); PEER_INS16(a1, k1); }
    }
    float v0[16], v1[16]; unsigned i0p[4] = {0u, 0u, 0u, 0u}, i1p[4] = {0u, 0u, 0u, 0u};
#pragma unroll
    for (int k = 0; k < 16; ++k) { v0[k] = unmono((a0[k] & ~127) | 64); v1[k] = unmono((a1[k] & ~127) | 64);
        i0p[k >> 2] |= (unsigned)(127 - (a0[k] & 127)) << (8 * (k & 3)); i1p[k >> 2] |= (unsigned)(127 - (a1[k] & 127)) << (8 * (k & 3)); }
    int cd[16];
#pragma unroll
    for (int k = 0; k < 16; ++k) cd[k] = (int)0x80000000;
#pragma unroll
    for (int i = 0; i < 16; ++i)
#pragma unroll
        for (int j = 0; j < 16; ++j)
            if ((i + 1) * (j + 1) <= 16) { const int k = (mono(v0[i] + v1[j]) & ~255) | (255 - (i * 16 + j)); PEER_INS16(cd, k); }
    float sv[16], ex[16], sum = 0.f; unsigned eid[16];
#pragma unroll
    for (int k = 0; k < 16; ++k) { const int code = 255 - (cd[k] & 255); eid[k] = byte_sel(i0p, code >> 4) * 128u + byte_sel(i1p, code & 15); sv[k] = unmono((cd[k] & ~255) | 128); }
#pragma unroll
    for (int k = 0; k < 16; ++k) { ex[k] = __expf(sv[k] - sv[0]); sum += ex[k]; }
    const float rs = 1.f / sum;
    GAS v4u* dst = (GAS v4u*)(sel + ((size_t)tok * 8 + head) * 16);
#pragma unroll
    for (int k = 0; k < 8; ++k) { v4u w; w.x = eid[2 * k]; w.y = __float_as_uint(ex[2 * k] * rs); w.z = eid[2 * k + 1]; w.w = __float_as_uint(ex[2 * k + 1] * rs); dst[k] = w; }
}

typedef float f32x2w __attribute__((ext_vector_type(2)));
struct G4 { const unsigned char* U8; const unsigned char* V8; const float* isu; const float* isv; };
__device__ __forceinline__ v2u peer_ec(const v2u lo, const v2u hi, int c) { const unsigned mk = (c < 4) ? 0xffffffffu : 0u; v2u r; r.x = (lo.x & mk) | (hi.x & ~mk); r.y = (lo.y & mk) | (hi.y & ~mk); return r; }
#define PEER_EC(en, c) peer_ec((en)[0], (en)[1], (c))
__device__ __forceinline__ void a_load(v4u (&uu)[16], const v2u ec, int c, const unsigned char* U8, int lane) {
#pragma unroll
    for (int j = 0; j < 16; ++j) { const unsigned e = __builtin_amdgcn_readlane(ec.x, 16 * (c & 3) + j); uu[j] = *(const GAS v4u*)(U8 + (size_t)e * D + 16 * lane); }
}
__device__ __forceinline__ void a_step(const v4u (&uu)[16], v2u (&en)[2], int c, const LAS f32x4* xl, const G4& T, int lane) {
    const v2u ec = PEER_EC(en, c);
    const int ls = 16 * (c & 3) + (lane >> 2);
    const unsigned eq = (unsigned)__shfl((int)ec.x, ls); const float gq = __uint_as_float((unsigned)__shfl((int)ec.y, ls));
    const float su = ((const GAS float*)T.isu)[eq], sv = ((const GAS float*)T.isv)[eq];
    f32x4 xv[4];
#pragma unroll
    for (int q = 0; q < 4; ++q) xv[q] = xl[q * 64];
    float part[16];
#pragma unroll
    for (int j = 0; j < 16; ++j) { f32x2w d = {0.f, 0.f};
#pragma unroll
        for (int q = 0; q < 4; ++q) { const unsigned w = uu[j][q]; const f32x2w a = __builtin_amdgcn_cvt_pk_f32_fp8((int)w, false), b = __builtin_amdgcn_cvt_pk_f32_fp8((int)w, true);
            d += (f32x2w){xv[q][0], xv[q][1]} * a; d += (f32x2w){xv[q][2], xv[q][3]} * b; }
        part[j] = d[0] + d[1]; }
    float r8[8], r4[4], r2[2], r1;
#pragma unroll
    for (int i = 0; i < 8; ++i) { auto sw = __builtin_amdgcn_permlane32_swap(__float_as_uint(part[i]), __float_as_uint(part[i + 8]), false, false); r8[i] = __uint_as_float(sw[0]) + __uint_as_float(sw[1]); }
#pragma unroll
    for (int i = 0; i < 4; ++i) { auto sw = __builtin_amdgcn_permlane16_swap(__float_as_uint(r8[i]), __float_as_uint(r8[i + 4]), false, false); r4[i] = __uint_as_float(sw[0]) + __uint_as_float(sw[1]); }
#pragma unroll
    for (int i = 0; i < 2; ++i) { const bool up = (lane & 8) != 0; const float send = up ? r4[i] : r4[i + 2], keep = up ? r4[i + 2] : r4[i]; r2[i] = keep + __shfl_xor(send, 8); }
    { const bool up = (lane & 4) != 0; const float send = up ? r2[0] : r2[1], keep = up ? r2[1] : r2[0]; r1 = keep + __shfl_xor(send, 4); }
    r1 += __shfl_xor(r1, 2); r1 += __shfl_xor(r1, 1);
    const float wgt = gq * gelu_erf(r1 * su) * sv;
    const int rel = lane - 16 * (c & 3);
    const float wv = __shfl(wgt, 4 * (rel & 15));
    const bool mine = (rel >= 0) && (rel < 16);
    const bool lo_ = mine && (c < 4), hi_ = mine && (c >= 4);
    en[0].y = lo_ ? __float_as_uint(wv) : en[0].y; en[1].y = hi_ ? __float_as_uint(wv) : en[1].y;
}
__device__ __forceinline__ void b_load8(v4u (&vv)[8], const v2u ec, int c, int h8, const unsigned char* V8, int lane) {
#pragma unroll
    for (int j = 0; j < 8; ++j) { const unsigned e = __builtin_amdgcn_readlane(ec.x, 16 * (c & 3) + 8 * h8 + j); vv[j] = *(const GAS v4u*)(V8 + (size_t)e * D + 16 * lane); }
}
__device__ __forceinline__ void b_step8(const v4u (&vv)[8], const v2u ec, int c, int h8, f32x2w (&acc)[8]) {
#pragma unroll
    for (int j = 0; j < 8; ++j) { const float w = __uint_as_float(__builtin_amdgcn_readlane(ec.y, 16 * (c & 3) + 8 * h8 + j)); const f32x2w w2 = {w, w};
#pragma unroll
        for (int q = 0; q < 4; ++q) { const unsigned x = vv[j][q]; const f32x2w a = __builtin_amdgcn_cvt_pk_f32_fp8((int)x, false), b = __builtin_amdgcn_cvt_pk_f32_fp8((int)x, true);
            acc[2 * q] += w2 * a; acc[2 * q + 1] += w2 * b; } }
}
__device__ __forceinline__ void b_load(v4u (&vv)[16], const v2u ec, int c, const unsigned char* V8, int lane) {
#pragma unroll
    for (int j = 0; j < 16; ++j) { const unsigned e = __builtin_amdgcn_readlane(ec.x, 16 * (c & 3) + j); vv[j] = *(const GAS v4u*)(V8 + (size_t)e * D + 16 * lane); }
}
__device__ __forceinline__ void b_step(const v4u (&vv)[16], const v2u ec, int c, f32x2w (&acc)[8]) {
#pragma unroll
    for (int j = 0; j < 16; ++j) { const float w = __uint_as_float(__builtin_amdgcn_readlane(ec.y, 16 * (c & 3) + j)); const f32x2w w2 = {w, w};
#pragma unroll
        for (int q = 0; q < 4; ++q) { const unsigned x = vv[j][q]; const f32x2w a = __builtin_amdgcn_cvt_pk_f32_fp8((int)x, false), b = __builtin_amdgcn_cvt_pk_f32_fp8((int)x, true);
            acc[2 * q] += w2 * a; acc[2 * q + 1] += w2 * b; } }
}
#define PEER_ROWLD(buf, j, ec, c, TAB) do { const unsigned e_ = __builtin_amdgcn_readlane((ec).x, 16 * ((c) & 3) + (j)); buf[j] = *(const GAS v4u*)((TAB) + (size_t)e_ * D + 16 * lane); } while (0)
template <bool NXT>
__device__ __forceinline__ void a_step_p(v4u (&uu)[16], v2u (&en)[2], int c, const int (&xq)[4], const float xis, const G4& T, int lane, const v2u ecn, int cn) {
    const v2u ec = PEER_EC(en, c);
    const int ls = 16 * (c & 3) + (lane >> 2);
    const unsigned eq = (unsigned)__shfl((int)ec.x, ls); const float gq = __uint_as_float((unsigned)__shfl((int)ec.y, ls));
    const float su = ((const GAS float*)T.isu)[eq], sv = ((const GAS float*)T.isv)[eq];
    int part[16];
#pragma unroll
    for (int j = 0; j < 16; ++j) {
        const int s0 = __builtin_amdgcn_sdot4((int)uu[j][0], xq[0], 0, false), s1 = __builtin_amdgcn_sdot4((int)uu[j][1], xq[1], 0, false);
        part[j] = __builtin_amdgcn_sdot4((int)uu[j][2], xq[2], s0, false) + __builtin_amdgcn_sdot4((int)uu[j][3], xq[3], s1, false); asm volatile("" : "+v"(part[j]));
        if (NXT) PEER_ROWLD(uu, j, ecn, cn, T.U8);
        __builtin_amdgcn_sched_barrier(0); }
    int r8[8], r4[4], r2[2], r1;
#pragma unroll
    for (int i = 0; i < 8; ++i) { auto sw = __builtin_amdgcn_permlane32_swap((unsigned)part[i], (unsigned)part[i + 8], false, false); r8[i] = (int)(sw[0] + sw[1]); }
#pragma unroll
    for (int i = 0; i < 4; ++i) { auto sw = __builtin_amdgcn_permlane16_swap((unsigned)r8[i], (unsigned)r8[i + 4], false, false); r4[i] = (int)(sw[0] + sw[1]); }
#pragma unroll
    for (int i = 0; i < 2; ++i) { const bool up = (lane & 8) != 0; const int send = up ? r4[i] : r4[i + 2], keep = up ? r4[i + 2] : r4[i]; r2[i] = keep + __shfl_xor(send, 8); }
    { const bool up = (lane & 4) != 0; const int send = up ? r2[0] : r2[1], keep = up ? r2[1] : r2[0]; r1 = keep + __shfl_xor(send, 4); }
    r1 += __shfl_xor(r1, 2); r1 += __shfl_xor(r1, 1);
    const float wgt = gq * gelu_erf((float)r1 * (xis * su)) * sv;
    const int rel = lane - 16 * (c & 3);
    const float wv = __shfl(wgt, 4 * (rel & 15));
    const bool mine = (rel >= 0) && (rel < 16);
    const bool lo_ = mine && (c < 4), hi_ = mine && (c >= 4);
    en[0].y = lo_ ? __float_as_uint(wv) : en[0].y; en[1].y = hi_ ? __float_as_uint(wv) : en[1].y;
}
template <bool NXT>
__device__ __forceinline__ void b_step_p(v4u (&vv)[16], const v2u ec, int c, f32x2w (&acc)[8], const unsigned char* V8, int lane, const v2u ecn, int cn) {
#pragma unroll
    for (int j = 0; j < 16; ++j) { const float w = __uint_as_float(__builtin_amdgcn_readlane(ec.y, 16 * (c & 3) + j)); const f32x2w w2 = {w, w};
#pragma unroll
        for (int q = 0; q < 4; ++q) { const unsigned x = vv[j][q]; const f32x2w a = __builtin_amdgcn_cvt_pk_f32_fp8((int)x, false), b = __builtin_amdgcn_cvt_pk_f32_fp8((int)x, true);
            acc[2 * q] += w2 * a; acc[2 * q + 1] += w2 * b; }
        if (NXT) PEER_ROWLD(vv, j, ecn, cn, V8);
        __builtin_amdgcn_sched_barrier(0); }
}
__device__ __forceinline__ void tok_finish(const LAS f32x4* xl, const f32x2w (&acc)[8], float* xrow, const float* gam, const float* bet, int lane) {
    float rr[16], s = 0.f;
#pragma unroll
    for (int q = 0; q < 4; ++q) { const f32x4 xv = xl[q * 64];
#pragma unroll
        for (int e = 0; e < 4; ++e) { const int k = 4 * q + e; rr[k] = ALPHA * xv[e] + acc[k >> 1][k & 1]; s += rr[k]; } }
    const float mean = wave_sum(s) * (1.f / D); float s2 = 0.f;
#pragma unroll
    for (int k = 0; k < 16; ++k) { rr[k] -= mean; s2 += rr[k] * rr[k]; }
    const float rstd = __builtin_amdgcn_rsqf(wave_sum(s2) * (1.f / D) + LN_EPS);
#pragma unroll
    for (int q = 0; q < 4; ++q) { const f32x4 g = *(const GAS f32x4*)(gam + 16 * lane + 4 * q), bb = *(const GAS f32x4*)(bet + 16 * lane + 4 * q);
        f32x4 y; y[0] = rr[4 * q] * rstd * g[0] + bb[0]; y[1] = rr[4 * q + 1] * rstd * g[1] + bb[1]; y[2] = rr[4 * q + 2] * rstd * g[2] + bb[2]; y[3] = rr[4 * q + 3] * rstd * g[3] + bb[3];
        *(GAS f32x4*)(xrow + 4 * q) = y; }
}
__device__ __forceinline__ void gather4(const v2u* sel, const G4& T, const float* rin, const float* g1, const float* b1, float* xo, const float* gam, const float* bet, int tok0, int lane, LAS f32x4* xl, LAS v2u* srt) {
    v2u en[4][2]; int xq[4][4]; float xis[4];
#pragma unroll
    for (int tt = 0; tt < 4; ++tt) { const float* rrow = rin + (size_t)(tok0 + tt) * D + 16 * lane;
        {
            f32x4 rv[4]; float s = 0.f;
#pragma unroll
            for (int q = 0; q < 4; ++q) { rv[q] = *(const GAS f32x4*)(rrow + 4 * q); s += (rv[q][0] + rv[q][1]) + (rv[q][2] + rv[q][3]); }
            const float mean = wave_sum(s) * (1.f / D); float s2 = 0.f;
#pragma unroll
            for (int q = 0; q < 4; ++q) { rv[q] = rv[q] - mean; s2 += (rv[q][0] * rv[q][0] + rv[q][1] * rv[q][1]) + (rv[q][2] * rv[q][2] + rv[q][3] * rv[q][3]); }
            const float rstd = __builtin_amdgcn_rsqf(wave_sum(s2) * (1.f / D) + LN_EPS);
#pragma unroll
            for (int q = 0; q < 4; ++q) { const f32x4 gg = *(const GAS f32x4*)(g1 + 16 * lane + 4 * q), bb = *(const GAS f32x4*)(b1 + 16 * lane + 4 * q); rv[q] = rv[q] * rstd * gg + bb; xl[tt * 256 + q * 64] = rv[q]; }
            float am = 0.f;
#pragma unroll
            for (int q = 0; q < 4; ++q) am = fmaxf(am, fmaxf(fmaxf(fabsf(rv[q][0]), fabsf(rv[q][1])), fmaxf(fabsf(rv[q][2]), fabsf(rv[q][3]))));
            am = fmaxf(wave_max(am), 1e-30f);
            const float qs = 127.f / am; xis[tt] = am * (1.f / 127.f);
#pragma unroll
            for (int q = 0; q < 4; ++q) { const int i0 = (int)__builtin_rintf(rv[q][0] * qs), i1 = (int)__builtin_rintf(rv[q][1] * qs), i2 = (int)__builtin_rintf(rv[q][2] * qs), i3 = (int)__builtin_rintf(rv[q][3] * qs);
                xq[tt][q] = (int)(((unsigned)i0 & 0xffu) | (((unsigned)i1 & 0xffu) << 8) | (((unsigned)i2 & 0xffu) << 16) | ((unsigned)i3 << 24)); }
        }
        const v2u e0 = ((const GAS v2u*)sel)[(size_t)(tok0 + tt) * 128 + lane], e1 = ((const GAS v2u*)sel)[(size_t)(tok0 + tt) * 128 + 64 + lane];
        const unsigned b0 = e0.x >> 9, b1 = e1.x >> 9; unsigned d0 = 0u, d1 = 0u, base = 0u;
#pragma unroll
        for (unsigned k = 0; k < 32; ++k) { const unsigned long long m0 = __ballot(b0 == k), m1 = __ballot(b1 == k);
            const unsigned c0 = (unsigned)__builtin_popcountll(m0), c1 = (unsigned)__builtin_popcountll(m1);
            const unsigned p0 = __builtin_amdgcn_mbcnt_hi((unsigned)(m0 >> 32), __builtin_amdgcn_mbcnt_lo((unsigned)m0, 0u)), p1 = __builtin_amdgcn_mbcnt_hi((unsigned)(m1 >> 32), __builtin_amdgcn_mbcnt_lo((unsigned)m1, 0u));
            d0 = (b0 == k) ? base + p0 : d0; d1 = (b1 == k) ? base + c0 + p1 : d1; base += c0 + c1; }
        srt[d0] = e0; srt[d1] = e1;
        asm volatile("s_waitcnt lgkmcnt(0)" ::: "memory");
        en[tt][0] = srt[lane]; en[tt][1] = srt[64 + lane];
        asm volatile("s_waitcnt lgkmcnt(0)" ::: "memory");
    }
    {
        v4u uu[16];
        { const v2u e0 = PEER_EC(en[0], 0);
#pragma unroll
          for (int j = 0; j < 16; ++j) PEER_ROWLD(uu, j, e0, 0, T.U8); }
#pragma unroll 1
        for (int c = 0; c < 7; ++c) {
            a_step_p<true>(uu, en[0], c, xq[0], xis[0], T, lane, PEER_EC(en[1], c), c);
            a_step_p<true>(uu, en[1], c, xq[1], xis[1], T, lane, PEER_EC(en[2], c), c);
            a_step_p<true>(uu, en[2], c, xq[2], xis[2], T, lane, PEER_EC(en[3], c), c);
            a_step_p<true>(uu, en[3], c, xq[3], xis[3], T, lane, PEER_EC(en[0], c + 1), c + 1);
        }
        a_step_p<true>(uu, en[0], 7, xq[0], xis[0], T, lane, PEER_EC(en[1], 7), 7);
        a_step_p<true>(uu, en[1], 7, xq[1], xis[1], T, lane, PEER_EC(en[2], 7), 7);
        a_step_p<true>(uu, en[2], 7, xq[2], xis[2], T, lane, PEER_EC(en[3], 7), 7);
        a_step_p<false>(uu, en[3], 7, xq[3], xis[3], T, lane, PEER_EC(en[3], 7), 7);
    }
    f32x2w acc[4][8];
#pragma unroll
    for (int tt = 0; tt < 4; ++tt)
#pragma unroll
        for (int q = 0; q < 8; ++q) acc[tt][q] = (f32x2w){0.f, 0.f};
    {
        v4u vv[16];
        { const v2u e0 = PEER_EC(en[0], 0);
#pragma unroll
          for (int j = 0; j < 16; ++j) PEER_ROWLD(vv, j, e0, 0, T.V8); }
#pragma unroll 1
        for (int c = 0; c < 7; ++c) {
            b_step_p<true>(vv, PEER_EC(en[0], c), c, acc[0], T.V8, lane, PEER_EC(en[1], c), c);
            b_step_p<true>(vv, PEER_EC(en[1], c), c, acc[1], T.V8, lane, PEER_EC(en[2], c), c);
            b_step_p<true>(vv, PEER_EC(en[2], c), c, acc[2], T.V8, lane, PEER_EC(en[3], c), c);
            b_step_p<true>(vv, PEER_EC(en[3], c), c, acc[3], T.V8, lane, PEER_EC(en[0], c + 1), c + 1);
        }
        b_step_p<true>(vv, PEER_EC(en[0], 7), 7, acc[0], T.V8, lane, PEER_EC(en[1], 7), 7);
        b_step_p<true>(vv, PEER_EC(en[1], 7), 7, acc[1], T.V8, lane, PEER_EC(en[2], 7), 7);
        b_step_p<true>(vv, PEER_EC(en[2], 7), 7, acc[2], T.V8, lane, PEER_EC(en[3], 7), 7);
        b_step_p<false>(vv, PEER_EC(en[3], 7), 7, acc[3], T.V8, lane, PEER_EC(en[3], 7), 7);
    }
#pragma unroll
    for (int tt = 0; tt < 4; ++tt) tok_finish(xl + tt * 256, acc[tt], xo + (size_t)(tok0 + tt) * D + 16 * lane, gam, bet, lane);
}

template <bool NXT>
__device__ __forceinline__ void a_step_l(v4u (&uu)[8]  , LAS v2u* et  , int c, v2u& ec  ,
                                         const LAS v2u* etn, int cn, const int (&xq)[4], const float xis, const G4& T, int lane) {
    const v2u eslot = et[16 * c + (lane >> 2)];
    const float su = ((const GAS float*)T.isu)[eslot.x], sv = ((const GAS float*)T.isv)[eslot.x];
    v2u ecn = ec; if (NXT) ecn = etn[16 * cn + (lane & 15)];
    int part[8], r8[8], r4[4], r2[2], r1;
#pragma unroll
    for (int j = 0; j < 16; ++j) {
        const int s0 = __builtin_amdgcn_sdot4((int)uu[j & 7][0], xq[0], 0, false), s1 = __builtin_amdgcn_sdot4((int)uu[j & 7][1], xq[1], 0, false);
        int pj = __builtin_amdgcn_sdot4((int)uu[j & 7][2], xq[2], s0, false) + __builtin_amdgcn_sdot4((int)uu[j & 7][3], xq[3], s1, false); asm volatile("" : "+v"(pj));
        if (j < 8) { unsigned e_ = __builtin_amdgcn_readlane(ec.x, j + 8); asm volatile("" : "+s"(e_) : "v"(pj)); uu[j & 7] = *(const GAS v4u*)(T.U8 + (size_t)e_ * D + 16 * lane); }
        else if (NXT) { unsigned e_ = __builtin_amdgcn_readlane(ecn.x, j - 8); asm volatile("" : "+s"(e_) : "v"(pj)); uu[j & 7] = *(const GAS v4u*)(T.U8 + (size_t)e_ * D + 16 * lane); }
        if (j < 8) part[j] = pj;
        else { auto sw = __builtin_amdgcn_permlane32_swap((unsigned)part[j - 8], (unsigned)pj, false, false); r8[j - 8] = (int)(sw[0] + sw[1]); }
        __builtin_amdgcn_sched_barrier(0); }
#pragma unroll
    for (int i = 0; i < 4; ++i) { auto sw = __builtin_amdgcn_permlane16_swap((unsigned)r8[i], (unsigned)r8[i + 4], false, false); r4[i] = (int)(sw[0] + sw[1]); }
#pragma unroll
    for (int i = 0; i < 2; ++i) { const bool up = (lane & 8) != 0; const int send = up ? r4[i] : r4[i + 2], keep = up ? r4[i + 2] : r4[i]; r2[i] = keep + __builtin_amdgcn_update_dpp(0, send, 0x128, 0xf, 0xf, false); }
    { const bool up = (lane & 4) != 0; const int send = up ? r2[0] : r2[1], keep = up ? r2[1] : r2[0]; r1 = keep + __builtin_amdgcn_ds_swizzle(send, 0x101F); }
    r1 += __builtin_amdgcn_update_dpp(0, r1, 0x4E, 0xf, 0xf, false); r1 += __builtin_amdgcn_update_dpp(0, r1, 0xB1, 0xf, 0xf, false);
    const float wgt = __uint_as_float(eslot.y) * gelu_erf((float)r1 * (xis * su)) * sv;
    if ((lane & 3) == 0) ((LAS float*)(et + 16 * c + (lane >> 2)))[1] = wgt;
    ec = ecn;
}
template <bool NXT>
__device__ __forceinline__ void b_step_l(v4u (&vv)[16], const LAS v2u* et, int c, v2u& ec, const LAS v2u* etn, int cn, f32x2w (&acc)[8], const unsigned char* V8, int lane) {
    v2u ecn = ec; if (NXT) ecn = etn[16 * cn + (lane & 15)];
#pragma unroll
    for (int j = 0; j < 16; ++j) { const float w = __uint_as_float(__builtin_amdgcn_readlane(ec.y, j)); const f32x2w w2 = {w, w};
#pragma unroll
        for (int q = 0; q < 4; ++q) { const unsigned x = vv[j][q]; const f32x2w a = __builtin_amdgcn_cvt_pk_f32_fp8((int)x, false), b = __builtin_amdgcn_cvt_pk_f32_fp8((int)x, true);
            acc[2 * q] += w2 * a; acc[2 * q + 1] += w2 * b; }
        if (NXT) { unsigned e_ = __builtin_amdgcn_readlane(ecn.x, j); asm volatile("" : "+s"(e_) : "v"(acc[0]), "v"(acc[1]), "v"(acc[2]), "v"(acc[3]), "v"(acc[4]), "v"(acc[5]), "v"(acc[6]), "v"(acc[7]));
            vv[j] = *(const GAS v4u*)(V8 + (size_t)e_ * D + 16 * lane); }
        __builtin_amdgcn_sched_barrier(0); }
    ec = ecn;
}
template <bool NXT>
__device__ __forceinline__ void b_step_r(v4u (&vv)[8], const LAS v2u* et, int c, v2u& ec, const LAS v2u* etn, int cn, f32x2w (&acc)[8], const unsigned char* V8, int lane) {
    v2u ecn = ec; if (NXT) ecn = etn[16 * cn + (lane & 15)];
#pragma unroll
    for (int j = 0; j < 16; ++j) { const float w = __uint_as_float(__builtin_amdgcn_readlane(ec.y, j)); const f32x2w w2 = {w, w};
#pragma unroll
        for (int q = 0; q < 4; ++q) { const unsigned x = vv[j & 7][q]; const f32x2w a = __builtin_amdgcn_cvt_pk_f32_fp8((int)x, false), b = __builtin_amdgcn_cvt_pk_f32_fp8((int)x, true);
            acc[2 * q] += w2 * a; acc[2 * q + 1] += w2 * b; }
        if (j < 8 || NXT) { unsigned e_ = (j < 8) ? __builtin_amdgcn_readlane(ec.x, j + 8) : __builtin_amdgcn_readlane(ecn.x, j - 8);
            asm volatile("" : "+s"(e_) : "v"(acc[0]), "v"(acc[1]), "v"(acc[2]), "v"(acc[3]), "v"(acc[4]), "v"(acc[5]), "v"(acc[6]), "v"(acc[7]));
            vv[j & 7] = *(const GAS v4u*)(V8 + (size_t)e_ * D + 16 * lane); }
        else if (j < 15) asm volatile("" : "+v"(vv[(j + 1) & 7]) : "v"(acc[0]), "v"(acc[1]), "v"(acc[2]), "v"(acc[3]), "v"(acc[4]), "v"(acc[5]), "v"(acc[6]), "v"(acc[7]));
        __builtin_amdgcn_sched_barrier(0); }
    ec = ecn;
}
template <bool NXT>
__device__ __forceinline__ void a_step8(v4u (&uu)[8], LAS v2u* et, int c, v2u& ec  ,
                                        const LAS v2u* etn, int cn, const int (&xq)[4], const float xis, const G4& T, int lane) {
    const v2u eslot = et[8 * c + (lane >> 3)];
    const float su = ((const GAS float*)T.isu)[eslot.x], sv = ((const GAS float*)T.isv)[eslot.x];
    v2u ecn = ec; if (NXT) ecn = etn[8 * cn + (lane & 7)];
    int part[4], r4[4], r2[2], r1;
#pragma unroll
    for (int j = 0; j < 8; ++j) {
        const int s0 = __builtin_amdgcn_sdot4((int)uu[j][0], xq[0], 0, false), s1 = __builtin_amdgcn_sdot4((int)uu[j][1], xq[1], 0, false);
        int pj = __builtin_amdgcn_sdot4((int)uu[j][2], xq[2], s0, false) + __builtin_amdgcn_sdot4((int)uu[j][3], xq[3], s1, false); asm volatile("" : "+v"(pj));
        if (NXT) { unsigned e_ = __builtin_amdgcn_readlane(ecn.x, j); asm volatile("" : "+s"(e_) : "v"(pj)); uu[j] = *(const GAS v4u*)(T.U8 + (size_t)e_ * D + 16 * lane); }
        if (j < 4) part[j] = pj;
        else { auto sw = __builtin_amdgcn_permlane32_swap((unsigned)part[j - 4], (unsigned)pj, false, false); r4[j - 4] = (int)(sw[0] + sw[1]); }
        __builtin_amdgcn_sched_barrier(0); }
#pragma unroll
    for (int i = 0; i < 2; ++i) { auto sw = __builtin_amdgcn_permlane16_swap((unsigned)r4[i], (unsigned)r4[i + 2], false, false); r2[i] = (int)(sw[0] + sw[1]); }
    { const bool up = (lane & 8) != 0; const int send = up ? r2[0] : r2[1], keep = up ? r2[1] : r2[0]; r1 = keep + __builtin_amdgcn_update_dpp(0, send, 0x128, 0xf, 0xf, false); }
    r1 += __builtin_amdgcn_ds_swizzle(r1, 0x101F); r1 += __builtin_amdgcn_update_dpp(0, r1, 0x4E, 0xf, 0xf, false); r1 += __builtin_amdgcn_update_dpp(0, r1, 0xB1, 0xf, 0xf, false);
    const float wgt = __uint_as_float(eslot.y) * gelu_erf((float)r1 * (xis * su)) * sv;
    if ((lane & 7) == 0) ((LAS float*)(et + 8 * c + (lane >> 3)))[1] = wgt;
    ec = ecn;
}
__device__ __forceinline__ void b_step8(v4u (&vv)[8], v2u& ec, const LAS v2u* etn, int cn, f32x2w (&acc)[8], const unsigned char* V8, int lane) {
    const v2u ecn = etn[8 * cn + (lane & 7)];
#pragma unroll
    for (int j = 0; j < 8; ++j) { const float w = __uint_as_float(__builtin_amdgcn_readlane(ec.y, j)); const f32x2w w2 = {w, w};
#pragma unroll
        for (int q = 0; q < 4; ++q) { const unsigned x = vv[j][q]; const f32x2w a = __builtin_amdgcn_cvt_pk_f32_fp8((int)x, false), b = __builtin_amdgcn_cvt_pk_f32_fp8((int)x, true);
            acc[2 * q] += w2 * a; acc[2 * q + 1] += w2 * b; }
        { unsigned e_ = __builtin_amdgcn_readlane(ecn.x, j);
          asm volatile("" : "+s"(e_) : "v"(acc[0]), "v"(acc[1]), "v"(acc[2]), "v"(acc[3]), "v"(acc[4]), "v"(acc[5]), "v"(acc[6]), "v"(acc[7]));
          vv[j] = *(const GAS v4u*)(V8 + (size_t)e_ * D + 16 * lane); }
        __builtin_amdgcn_sched_barrier(0); }
    ec = ecn;
}
__device__ __forceinline__ void tok_finish_r(const float* rrow, const float* g1, const float* b1, const f32x2w (&acc)[8], float* xrow, const float* gam, const float* bet, int lane) {
    asm volatile("" : "+v"(lane));
    f32x4 rv[4]; float s = 0.f;
#pragma unroll
    for (int q = 0; q < 4; ++q) { rv[q] = *(const GAS f32x4*)(rrow + 4 * q); s += (rv[q][0] + rv[q][1]) + (rv[q][2] + rv[q][3]); }
    const float mean1 = wave_sum(s) * (1.f / D); float s2 = 0.f;
#pragma unroll
    for (int q = 0; q < 4; ++q) { rv[q] = rv[q] - mean1; s2 += (rv[q][0] * rv[q][0] + rv[q][1] * rv[q][1]) + (rv[q][2] * rv[q][2] + rv[q][3] * rv[q][3]); }
    const float rstd1 = __builtin_amdgcn_rsqf(wave_sum(s2) * (1.f / D) + LN_EPS);
    float rr[16]; s = 0.f;
#pragma unroll
    for (int q = 0; q < 4; ++q) { const f32x4 gg = *(const GAS f32x4*)(g1 + 16 * lane + 4 * q), bb = *(const GAS f32x4*)(b1 + 16 * lane + 4 * q); const f32x4 xv = rv[q] * rstd1 * gg + bb;
#pragma unroll
        for (int e = 0; e < 4; ++e) { const int k = 4 * q + e; rr[k] = ALPHA * xv[e] + acc[k >> 1][k & 1]; s += rr[k]; }
        __builtin_amdgcn_sched_barrier(0); }
    const float mean = wave_sum(s) * (1.f / D); s2 = 0.f;
#pragma unroll
    for (int k = 0; k < 16; ++k) { rr[k] -= mean; s2 += rr[k] * rr[k]; }
    const float rstd = __builtin_amdgcn_rsqf(wave_sum(s2) * (1.f / D) + LN_EPS);
#pragma unroll
    for (int q = 0; q < 4; ++q) { const f32x4 g = *(const GAS f32x4*)(gam + 16 * lane + 4 * q), bb = *(const GAS f32x4*)(bet + 16 * lane + 4 * q);
        f32x4 y; y[0] = rr[4 * q] * rstd * g[0] + bb[0]; y[1] = rr[4 * q + 1] * rstd * g[1] + bb[1]; y[2] = rr[4 * q + 2] * rstd * g[2] + bb[2]; y[3] = rr[4 * q + 3] * rstd * g[3] + bb[3];
        *(GAS f32x4*)(xrow + 4 * q) = y; __builtin_amdgcn_sched_barrier(0); }
}
__device__ __forceinline__ void gather16(const v2u* sel, const G4& T, const float* rin, const float* g1, const float* b1, float* xo, const float* gam, const float* bet, int tok0, const int lane_in, LAS v2u* enl) {
    int lane = lane_in; asm volatile("" : "+v"(lane));
    int xq[16][4]; float xis[16];
#pragma unroll 1
    for (int tt = 0; tt < 16; ++tt) { int tk_ = tok0 + tt;
        const v2u e0 = ((const GAS v2u*)sel)[(size_t)tk_ * 128 + lane], e1 = ((const GAS v2u*)sel)[(size_t)tk_ * 128 + 64 + lane];
        const unsigned b0 = e0.x >> 9, b1 = e1.x >> 9; unsigned d0 = 0u, d1 = 0u, base = 0u;
#pragma unroll
        for (unsigned k = 0; k < 32; ++k) { const unsigned long long m0 = __ballot(b0 == k), m1 = __ballot(b1 == k);
            const unsigned c0 = (unsigned)__builtin_popcountll(m0), c1 = (unsigned)__builtin_popcountll(m1);
            const unsigned p0 = __builtin_amdgcn_mbcnt_hi((unsigned)(m0 >> 32), __builtin_amdgcn_mbcnt_lo((unsigned)m0, 0u)), p1 = __builtin_amdgcn_mbcnt_hi((unsigned)(m1 >> 32), __builtin_amdgcn_mbcnt_lo((unsigned)m1, 0u));
            d0 = (b0 == k) ? base + p0 : d0; d1 = (b1 == k) ? base + c0 + p1 : d1; base += c0 + c1; }
        enl[tt * 128 + d0] = e0; enl[tt * 128 + d1] = e1;
    }
#pragma unroll
    for (int tt = 0; tt < 16; ++tt) { const float* rrow = rin + (size_t)(tok0 + tt) * D + 16 * lane;
        {
            f32x4 rv[4]; float s = 0.f;
#pragma unroll
            for (int q = 0; q < 4; ++q) { rv[q] = *(const GAS f32x4*)(rrow + 4 * q); s += (rv[q][0] + rv[q][1]) + (rv[q][2] + rv[q][3]); }
            const float mean = wave_sum(s) * (1.f / D); float s2 = 0.f;
#pragma unroll
            for (int q = 0; q < 4; ++q) { rv[q] = rv[q] - mean; s2 += (rv[q][0] * rv[q][0] + rv[q][1] * rv[q][1]) + (rv[q][2] * rv[q][2] + rv[q][3] * rv[q][3]); }
            const float rstd = __builtin_amdgcn_rsqf(wave_sum(s2) * (1.f / D) + LN_EPS);
            float am = 0.f;
#pragma unroll
            for (int q = 0; q < 4; ++q) { const f32x4 gg = *(const GAS f32x4*)(g1 + 16 * lane + 4 * q), bb = *(const GAS f32x4*)(b1 + 16 * lane + 4 * q); rv[q] = rv[q] * rstd * gg + bb;
                am = fmaxf(am, fmaxf(fmaxf(fabsf(rv[q][0]), fabsf(rv[q][1])), fmaxf(fabsf(rv[q][2]), fabsf(rv[q][3])))); }
            am = fmaxf(wave_max(am), 1e-30f);
            const float qs = 127.f / am; xis[tt] = __uint_as_float(__builtin_amdgcn_readfirstlane(__float_as_uint(am * (1.f / 127.f))));
#pragma unroll
            for (int q = 0; q < 4; ++q) { const int i0 = (int)__builtin_rintf(rv[q][0] * qs), i1 = (int)__builtin_rintf(rv[q][1] * qs), i2 = (int)__builtin_rintf(rv[q][2] * qs), i3 = (int)__builtin_rintf(rv[q][3] * qs);
                xq[tt][q] = (int)(((unsigned)i0 & 0xffu) | (((unsigned)i1 & 0xffu) << 8) | (((unsigned)i2 & 0xffu) << 16) | ((unsigned)i3 << 24)); }
        }
        __builtin_amdgcn_sched_barrier(0);
    }
    asm volatile("s_waitcnt lgkmcnt(0)" ::: "memory");
    {
        v4u uu[8]; v2u ec = enl[lane & 7];
#pragma unroll
        for (int j = 0; j < 8; ++j) { const unsigned e_ = __builtin_amdgcn_readlane(ec.x, j); uu[j] = *(const GAS v4u*)(T.U8 + (size_t)e_ * D + 16 * lane); }
#pragma unroll 1
        for (int c = 0; c < 16; ++c) {
#pragma unroll
            for (int tt = 0; tt < 15; ++tt) a_step8<true>(uu, enl + tt * 128, c, ec, enl + (tt + 1) * 128, c, xq[tt], xis[tt], T, lane);
            if (c < 15) a_step8<true>(uu, enl + 15 * 128, c, ec, enl, c + 1, xq[15], xis[15], T, lane);
            else a_step8<false>(uu, enl + 15 * 128, c, ec, enl, c, xq[15], xis[15], T, lane);
        }
    }
    asm volatile("s_waitcnt lgkmcnt(0)" ::: "memory");
#pragma unroll 1
    for (int hf = 0; hf < 2; ++hf) {
        int lane = lane_in; asm volatile("" : "+v"(lane));
        LAS v2u* eh = enl + hf * 8 * 128;
        f32x2w acc[8][8];
#pragma unroll
        for (int tt = 0; tt < 8; ++tt)
#pragma unroll
            for (int q = 0; q < 8; ++q) acc[tt][q] = (f32x2w){0.f, 0.f};
        v4u va[8], vb[8]; v2u eca = eh[lane & 7], ecb = eh[128 + (lane & 7)];
#pragma unroll
        for (int j = 0; j < 8; ++j) { const unsigned e_ = __builtin_amdgcn_readlane(eca.x, j); va[j] = *(const GAS v4u*)(T.V8 + (size_t)e_ * D + 16 * lane); }
#pragma unroll
        for (int j = 0; j < 8; ++j) { const unsigned e_ = __builtin_amdgcn_readlane(ecb.x, j); vb[j] = *(const GAS v4u*)(T.V8 + (size_t)e_ * D + 16 * lane); }
#pragma unroll 1
        for (int c = 0; c < 16; ++c) {
            b_step8(va, eca, eh + 2 * 128, c, acc[0], T.V8, lane);
            b_step8(vb, ecb, eh + 3 * 128, c, acc[1], T.V8, lane);
            b_step8(va, eca, eh + 4 * 128, c, acc[2], T.V8, lane);
            b_step8(vb, ecb, eh + 5 * 128, c, acc[3], T.V8, lane);
            b_step8(va, eca, eh + 6 * 128, c, acc[4], T.V8, lane);
            b_step8(vb, ecb, eh + 7 * 128, c, acc[5], T.V8, lane);
            b_step8(va, eca, eh + 0 * 128, (c + 1) & 15, acc[6], T.V8, lane);
            b_step8(vb, ecb, eh + 1 * 128, (c + 1) & 15, acc[7], T.V8, lane);
        }
#pragma unroll
        for (int j = 0; j < 8; ++j) asm volatile("" :: "v"(va[j]), "v"(vb[j]));
#pragma unroll
        for (int tt = 0; tt < 8; ++tt) { int tok = tok0 + hf * 8 + tt; tok_finish_r(rin + (size_t)tok * D + 16 * lane, g1, b1, acc[tt], xo + (size_t)tok * D + 16 * lane, gam, bet, lane); __builtin_amdgcn_sched_barrier(0); }
    }
}
#undef PEER_ROWLD
#undef PEER_EC
__device__ __forceinline__ void rows_to_fp8(const float* usrc, const float* vsrc, unsigned char* udst, unsigned char* vdst, float* uinv, float* vinv, int row0, int stride, int lane) {
    f32x4 nx[4];
    if (row0 < 2 * NEXP) { const float* p = (row0 < NEXP ? usrc + (size_t)row0 * D : vsrc + (size_t)(row0 - NEXP) * D) + 16 * lane;
#pragma unroll
        for (int q = 0; q < 4; ++q) nx[q] = *(const f32x4*)(p + 4 * q); }
#pragma unroll 1
    for (int row = row0; row < 2 * NEXP; row += stride) {
        f32x4 v[4]; float am = 0.f;
#pragma unroll
        for (int q = 0; q < 4; ++q) { v[q] = nx[q]; am = fmaxf(am, fmaxf(fmaxf(fabsf(v[q][0]), fabsf(v[q][1])), fmaxf(fabsf(v[q][2]), fabsf(v[q][3])))); }
        const int rn = row + stride;
        if (rn < 2 * NEXP) { const float* p = (rn < NEXP ? usrc + (size_t)rn * D : vsrc + (size_t)(rn - NEXP) * D) + 16 * lane;
#pragma unroll
            for (int q = 0; q < 4; ++q) nx[q] = *(const f32x4*)(p + 4 * q); }
        am = wave_max(am);
        float s = 1.f, is = 1.f; v4u o;
        if (row < NEXP) {
            if (am > 1e-30f) { s = 127.f / am; is = am * (1.f / 127.f); }
#pragma unroll
            for (int q = 0; q < 4; ++q) { const int i0 = (int)__builtin_rintf(v[q][0] * s), i1 = (int)__builtin_rintf(v[q][1] * s), i2 = (int)__builtin_rintf(v[q][2] * s), i3 = (int)__builtin_rintf(v[q][3] * s);
                o[q] = ((unsigned)i0 & 0xffu) | (((unsigned)i1 & 0xffu) << 8) | (((unsigned)i2 & 0xffu) << 16) | ((unsigned)i3 << 24); }
        } else {
            if (am > 1e-30f) { const int eb = (__float_as_int(224.f / am) >> 23) & 0xff; if (eb > 0 && eb < 254) { s = __int_as_float(eb << 23); is = __int_as_float((254 - eb) << 23); } }
#pragma unroll
            for (int q = 0; q < 4; ++q) { int w = 0; w = __builtin_amdgcn_cvt_pk_fp8_f32(v[q][0] * s, v[q][1] * s, w, false); w = __builtin_amdgcn_cvt_pk_fp8_f32(v[q][2] * s, v[q][3] * s, w, true); o[q] = (unsigned)w; }
        }
        unsigned char* dst = (row < NEXP ? udst + (size_t)row * D : vdst + (size_t)(row - NEXP) * D) + 16 * lane;
        *(v4u*)dst = o;
        if (lane == 0) { if (row < NEXP) uinv[row] = is; else vinv[row - NEXP] = is; }
    }
}
}
constexpr int NPH = 8;
__global__ void __launch_bounds__(NWAVES * 64, 2) mk_fwd(Args args) {
    extern __shared__ __attribute__((aligned(16))) unsigned char lds_raw[];
    LAS unsigned char* lds = (LAS unsigned char*)lds_raw;
    volatile LAS unsigned* MISC = (volatile LAS unsigned*)(lds + MISC_OFF);
    const int tid0 = threadIdx.x, lane0 = tid0 & 63, wave = __builtin_amdgcn_readfirstlane(tid0 >> 6);
    const int G = gridDim.x, bx = blockIdx.x, vcu = (G % 8 == 0) ? (bx % 8) * (G / 8) + bx / 8 : bx;
    unsigned char* ws0 = args.ws;
    gu32* ctl = (gu32*)(ws0 + WS_CTL);
    for (int u = tid0; u < (LDS_BYTES - RING_BYTES) / 4; u += NWAVES * 64) ((LAS unsigned*)(lds + RING_BYTES))[u] = 0u;
    __syncthreads();
    XcdBarrier bar; bar.bar = (unsigned*)(ctl + CW_BAR); bar.x = 0; bar.st = nullptr;
    if (MK_N_LAUNCHES == 1) bar = xcd_barrier_post((unsigned*)(ctl + CW_BAR), MISC + 8, wave);
    const int lo = args.ph_lo, hi = args.ph_hi;
#ifndef PH_MASK
#define PH_MASK 0xFF
#endif
#define IN(k) ((((PH_MASK) >> (k)) & 1) && lo <= (k) && (k) < hi)
#define SEAM(k) do { if (IN(k) && IN((k) + 1)) xcd_barrier(bar); } while (0)
    const int NGW = G * NWAVES;
#define SUB_BEGIN() unsigned char* ws = ws0; asm volatile("" : "+s"(ws)); const int lane = (int)__builtin_amdgcn_mbcnt_hi(~0u, __builtin_amdgcn_mbcnt_lo(~0u, 0u)), tid = wave * 64 + lane; (void)tid; (void)lane
#define PHASE_BEGIN() unsigned char* ws = ws0; asm volatile("" : "+s"(ws)); const int lane = (int)__builtin_amdgcn_mbcnt_hi(~0u, __builtin_amdgcn_mbcnt_lo(~0u, 0u)), tid = wave * 64 + lane; const int gw = vcu * NWAVES + wave; (void)gw; (void)lane; (void)tid

    if (IN(0)) { PHASE_BEGIN(); p0_prologue(args, lds, vcu, G, wave, lane); VM_WAIT(); __syncthreads(); SEAM(0); }

    if (IN(1)) { PHASE_BEGIN();
        pg8::Gemm g{(const pg8::bf16_t*)(ws + WS_A), (const pg8::bf16_t*)(ws + WS_WIN), T, INC, D}; pg8::StaticOrder S; S.init(T, INC, G, bx); S.rep = NREP(1);
        pg8::EpiInProj E{(pg8::bf16_t*)(ws + WS_QD), (pg8::bf16_t*)(ws + WS_KD), (pg8::bf16_t*)(ws + WS_VD), (pg8::bf16_t*)(ws + WS_LQ), (pg8::bf16_t*)(ws + WS_LK), (pg8::bf16_t*)(ws + WS_LV),
                         (pg8::bf16_t*)(ws + WS_GA), (pg8::bf16_t*)(ws + WS_GB)};
        pg8::gemm_phase<pg8::EpiInProj, pg8::StaticOrder, true, true>(lds, g, S, E, wave);
        {
            const int nwg = (T / 256) * (INC / 256), rem = nwg % G, nshort = rem ? G - rem : G, first = rem ? rem : 0;
            if (bx >= first) peer::rows_to_fp8(args.in[I_PU], args.in[I_PV], ws + WS_UU, ws + WS_UV, (float*)(ws + WS_ISU), (float*)(ws + WS_ISV), (bx - first) * NWAVES + wave, nshort * NWAVES, lane);
        }
        SEAM(1);
    }

    if (IN(2)) { PHASE_BEGIN();
#ifndef NO_DIFF
        {   SUB_BEGIN();
            const da::Tensors X{(const bf16*)(ws + WS_QD), (const bf16*)(ws + WS_KD), (const bf16*)(ws + WS_VD), (float*)(ws + WS_STASH), (bf16*)(ws + WS_YA),
                                args.in[I_DLAM], args.in[I_SUBG], args.in[I_RELB]};
            int cur_h = -1;
            float lam; { const float* dl = args.in[I_DLAM]; const float p1 = dl[lane] * dl[64 + lane], p2 = dl[128 + lane] * dl[192 + lane];
                lam = __uint_as_float(__builtin_amdgcn_readfirstlane(__float_as_uint(__expf(wave_sum(p1)) - __expf(wave_sum(p2)) + LAM_INIT))); }
            for (int rep_ = 0; rep_ < NREP(20); ++rep_)
            for (int p = vcu; p < 256; p += G) {
                const int bh = p >> 5, s = p & 31, b = bh >> 2, h = bh & 3;
                if (h != cur_h) {
                    __syncthreads();
                    const float* bd = (const float*)(ws + WS_BIASD) + h * BIAS_TAB; asm volatile("" : "+s"(bd));
                    int ln2 = (int)__builtin_amdgcn_mbcnt_hi(~0u, __builtin_amdgcn_mbcnt_lo(~0u, 0u)); asm volatile("" : "+v"(ln2));
                    for (int i = wave * 64 + ln2; i < BIAS_TAB; i += NWAVES * 64) ((LAS float*)(lds + da::LDS_BIAS))[i] = bd[i];
                    for (int i = wave * 64 + ln2; i < 4 * da::TAB_CL; i += NWAVES * 64) {
                        const int a = i / da::TAB_CL, k = i % da::TAB_CL, idx = da::TAB_NR - k + a;
                        ((LAS float*)(lds + da::LDS_TREV))[i] = (idx >= 0 && idx < BIAS_TAB) ? bd[idx] : 0.f; }
                    __syncthreads(); cur_h = h;
                }
                const float c31 = args.in[I_RELB][31 * 16 + h] * LOG2E;
                for (int k2 = 0; k2 < 2; ++k2) da::unit(X, b, h, k2 ? 63 - s : s, lds, bx, lam, c31, wave);
            }
        }
#endif
#ifndef NO_DIL
        {   SUB_BEGIN();
            const dil::Tensors X{(const bf16*)(ws + WS_LQ), (const bf16*)(ws + WS_LK), (const bf16*)(ws + WS_LV), (bf16*)(ws + WS_YB)};
            int cur_h = -1;
            for (int rep_ = 0; rep_ < NREP(21); ++rep_)
            for (int u = vcu; u < 256; u += G) {
                const int bh = u >> 5, blk = u & 31, b = bh >> 2, h = bh & 3;
                if (h != cur_h) {
                    __syncthreads();
                    const float* blsrc = (const float*)(ws + WS_BIASL);
                    for (int i = tid; i < 3 * dil::BT; i += NWAVES * 64) { const int g = i / dil::BT, jj = i % dil::BT - dil::BT0;
                        ((LAS float*)(lds + dil::LDS_BL))[i] = (jj >= 0 && jj <= 128) ? blsrc[(g * 4 + h) * 132 + jj] : 0.f; }
                    __syncthreads(); cur_h = h;
                }
                float* lse0 = (float*)(ws + WS_LSE0);
                for (int k2 = 0; k2 < 2; ++k2) dil::wave_tile_g0(X, lse0, b, h, blk * 512 + (wave + 8 * k2) * 32, lds + dil::LDS_VST + wave * 4096, (const LAS float*)(lds + dil::LDS_BL), lane);
                VM_WAIT(); __syncthreads();
                for (int k2 = 0; k2 < 2; ++k2) dil::wave_tile(X, lse0, b, h, blk * 512, wave + 8 * k2, lds + dil::LDS_VST + wave * 4096, (const LAS float*)(lds + dil::LDS_BL), lane);
            }
            __syncthreads();
        }
#endif
        SEAM(2);
    }

    if (IN(3)) { PHASE_BEGIN();
        { pg8::Gemm g{(const pg8::bf16_t*)(ws + WS_YA), (const pg8::bf16_t*)(ws + WS_WBD), T, D, 512}; pg8::StaticOrder S; S.init(T, D, G, bx); S.rep = NREP(3);
          pg8::EpiGate1 E{(const pg8::bf16_t*)(ws + WS_GA), (pg8::bf16_t*)(ws + WS_GATED)};
          pg8::gemm_phase<pg8::EpiGate1, pg8::StaticOrder, true, true>(lds, g, S, E, wave); }
        VM_WAIT(); __syncthreads();
        { pg8::Gemm g{(const pg8::bf16_t*)(ws + WS_YB), (const pg8::bf16_t*)(ws + WS_WBL), T, D, 256}; pg8::StaticOrder S; S.init(T, D, G, bx);
          pg8::EpiGate2 E{(const pg8::bf16_t*)(ws + WS_GB), (pg8::bf16_t*)(ws + WS_GATED)};
          pg8::gemm_phase<pg8::EpiGate2, pg8::StaticOrder, true, true>(lds, g, S, E, wave); }
        SEAM(3);
    }

    if (IN(4)) { PHASE_BEGIN();
        pg8::Gemm g{(const pg8::bf16_t*)(ws + WS_GATED), (const pg8::bf16_t*)(ws + WS_WO), T, D, D}; pg8::StaticOrder S; S.init(T, D, G, bx); S.rep = NREP(4);
        pg8::EpiOut E{args.in[I_X], (float*)(ws + WS_R)};
        pg8::gemm_phase<pg8::EpiOut, pg8::StaticOrder, true, true>(lds, g, S, E, wave);
        SEAM(4);
    }

    if (IN(5)) { PHASE_BEGIN();
        p5_ln1(args, vcu, G, wave, lane);
        SEAM(5);
    }

    if (IN(6)) { PHASE_BEGIN();
        pg8::Gemm g{(const pg8::bf16_t*)(ws + WS_WP), (const pg8::bf16_t*)(ws + WS_A), 2048, T, D}; pg8::StaticOrder S; S.init(2048, T, G, bx); S.rep = NREP(6);
        pg8::EpiScoreT E{(float*)(ws + WS_ST)};
        pg8::gemm_phase<pg8::EpiScoreT, pg8::StaticOrder, true, true>(lds, g, S, E, wave);
        SEAM(6);
    }

    if (IN(7)) { PHASE_BEGIN();
        const float* ST = (const float*)(ws + WS_ST); v2u* sel = (v2u*)(ws + WS_SEL);
        for (int u = vcu; u < T / 128; u += G) {
            for (int p = 0; p < 2; ++p) peer::select(ST, sel, u * 128 + p * 64 + lane, wave);
            VM_WAIT(); __syncthreads();
            { const peer::G4 TB{ws + WS_UU, ws + WS_UV, (const float*)(ws + WS_ISU), (const float*)(ws + WS_ISV)};
              peer::gather16(sel, TB, (const float*)(ws + WS_R), args.in[I_LN1G], args.in[I_LN1B], args.out, args.in[I_LN2G], args.in[I_LN2B], u * 128 + wave * 16, lane, (LAS v2u*)(lds + wave * 16384)); }
            VM_WAIT(); __syncthreads();
        }
    }
#undef IN
#undef SEAM
}

extern "C" void kernel_launch(void* const* d_in, const int* in_sizes, int n_in, void* d_out, int out_size, void* d_ws, size_t ws_size, hipStream_t stream) {
    static int grid = 0;
    if (grid == 0) {
        if (n_in != 16 || in_sizes[0] != T * D || out_size != T * D || ws_size < WS_END) { fprintf(stderr, "kernel_launch: unexpected shapes (n_in %d, in0 %d, out %d, ws %zu); nothing launched\n", n_in, n_in > 0 ? in_sizes[0] : -1, out_size, ws_size); grid = -1; return; }
        int dev = 0, cus = 0, per_cu = 0;
        if (hipGetDevice(&dev) != hipSuccess || hipDeviceGetAttribute(&cus, hipDeviceAttributeMultiprocessorCount, dev) != hipSuccess) { grid = -1; return; }
        if (hipFuncSetAttribute((const void*)mk_fwd, hipFuncAttributeMaxDynamicSharedMemorySize, LDS_BYTES) != hipSuccess) { fprintf(stderr, "kernel_launch: hipFuncSetAttribute failed\n"); grid = -1; return; }
        if (hipOccupancyMaxActiveBlocksPerMultiprocessor(&per_cu, (const void*)mk_fwd, NWAVES * 64, LDS_BYTES) != hipSuccess || per_cu < 1) { fprintf(stderr, "kernel_launch: occupancy query reports %d\n", per_cu); per_cu = 1; }
        (void)hipGetLastError();
        grid = cus;
    }
    if (grid < 0) return;
    if (hipMemsetAsync((char*)d_ws + WS_CTL, 0, CTL_ZERO_BYTES, stream) != hipSuccess) return;
    Args a{};
    for (int i = 0; i < 16; ++i) a.in[i] = (const float*)d_in[i];
    a.out = (float*)d_out; a.ws = (unsigned char*)d_ws;
    for (int li = 0; li < MK_N_LAUNCHES; ++li) {
        a.ph_lo = (MK_N_LAUNCHES == 1) ? 0 : li; a.ph_hi = (MK_N_LAUNCHES == 1) ? NPH : li + 1;
        hipLaunchKernelGGL(mk_fwd, dim3(grid), dim3(NWAVES * 64), LDS_BYTES, stream, a);
    }
}
```

```cpp
#include <hip/hip_runtime.h>
#include <cstdio>
#include <cstdint>

#ifndef MK_N_LAUNCHES
#define MK_N_LAUNCHES 1
#endif

#ifndef REPEAT_PH
#define REPEAT_PH (-1)
#endif
#define NREP(k) ((REPEAT_PH) == (k) ? 2 : 1)

constexpr int BATCH = 2, SEQ = 16384, T = BATCH * SEQ, D = 1024, INC = 5888;
constexpr int OFF_DQ = 0, OFF_DK = 512, OFF_DV = 1024, OFF_LQ = 1536, OFF_LK = 2304, OFF_LV = 3072, OFF_GA = 3840, OFF_GB = 4864;
constexpr int NEXP = 16384;
constexpr float LOG2E = 1.4426950408889634f;
constexpr float QSCALE = 0.125f * LOG2E;
constexpr float ALPHA = 1.189207115002721f;
constexpr float LN_EPS = 1e-5f, SUBLN_EPS = 1e-5f;
constexpr float LAM_INIT = 0.2f;
constexpr int NTILE = SEQ / 64;
constexpr int BIAS_TAB = 2240, BIAS_GUARD = 256, DFAR = 1513;

constexpr size_t MiB = 1u << 20;
constexpr size_t WS_CTL = 0, CTL_ZERO_BYTES = 1 * MiB;
constexpr size_t WS_BIASD = 1 * MiB;
constexpr size_t WS_BIASL = 1 * MiB + 64 * 1024;
constexpr size_t WS_WIN = 8 * MiB, WS_WO = 20 * MiB, WS_WBD = 22 * MiB, WS_WBL = 23 * MiB, WS_WP = 24 * MiB;
constexpr size_t WS_A = 32 * MiB;
constexpr size_t WS_YA = WS_A, WS_YB = WS_A + 32 * MiB;
constexpr size_t WS_QD = 96 * MiB, WS_KD = 128 * MiB, WS_VD = 160 * MiB, WS_LQ = 192 * MiB, WS_LK = 240 * MiB, WS_LV = 288 * MiB, WS_GA = 336 * MiB, WS_GB = 400 * MiB;
constexpr size_t WS_STASH = 464 * MiB;
constexpr size_t WS_SEL = 32 * MiB;
constexpr size_t WS_GATED = 96 * MiB;
constexpr size_t WS_R = 352 * MiB;
constexpr size_t WS_ST = 96 * MiB;
constexpr size_t WS_UU = 480 * MiB, WS_UV = 496 * MiB;
constexpr size_t WS_LSE0 = 3 * MiB;
constexpr size_t WS_ISU = 2 * MiB, WS_ISV = 2 * MiB + 65536;
constexpr size_t WS_END = 512 * MiB;

constexpr int CW_BAR = 4096;
constexpr int NWAVES = 8;
constexpr int RING_BYTES = 131072, MISC_OFF = RING_BYTES + 320, LDS_BYTES = 147456;

#define GAS __attribute__((address_space(1)))
#define LAS __attribute__((address_space(3)))
typedef unsigned short bf16;
typedef unsigned v4u __attribute__((ext_vector_type(4)));
typedef unsigned v2u __attribute__((ext_vector_type(2)));
typedef float f32x4 __attribute__((ext_vector_type(4)));
typedef float f32x16 __attribute__((ext_vector_type(16)));
typedef short bf16x8 __attribute__((ext_vector_type(8)));
typedef short s16x4 __attribute__((ext_vector_type(4)));
typedef __bf16 bf16x2 __attribute__((ext_vector_type(2)));
typedef GAS unsigned gu32;
#define RLX_AGENT __ATOMIC_RELAXED, __HIP_MEMORY_SCOPE_AGENT
#define LDS_WAIT() asm volatile("s_waitcnt lgkmcnt(0)" ::: "memory")
#define VM_WAIT() asm volatile("s_waitcnt vmcnt(0)" ::: "memory")
__device__ __forceinline__ unsigned f2bf(float f) { unsigned u = __builtin_bit_cast(unsigned, f); return (u + 0x7fffu + ((u >> 16) & 1u)) >> 16; }
__device__ __forceinline__ unsigned pk2(float lo, float hi) { return f2bf(lo) | (f2bf(hi) << 16); }
typedef float f32x2_t __attribute__((ext_vector_type(2)));
__device__ __forceinline__ unsigned cvtpk(float lo, float hi) { f32x2_t v = {lo, hi}; bf16x2 b = __builtin_convertvector(v, bf16x2); return __builtin_bit_cast(unsigned, b); }
__device__ __forceinline__ float bf_lo(unsigned w) { return __builtin_bit_cast(float, w << 16); }
__device__ __forceinline__ float bf_hi(unsigned w) { return __builtin_bit_cast(float, w & 0xffff0000u); }
__device__ __forceinline__ float dot2bf(unsigned a, unsigned b, float acc) { return __builtin_amdgcn_fdot2_f32_bf16(__builtin_bit_cast(bf16x2, a), __builtin_bit_cast(bf16x2, b), acc, false); }
template <int CTRL> __device__ __forceinline__ float dpp_rot(float v) { return __builtin_bit_cast(float, __builtin_amdgcn_update_dpp(0, __builtin_bit_cast(int, v), CTRL, 0xf, 0xf, false)); }
__device__ __forceinline__ float wave_sum(float v) {
    v += dpp_rot<0x128>(v); v += dpp_rot<0x124>(v); v += dpp_rot<0x122>(v); v += dpp_rot<0x121>(v);
    { auto s = __builtin_amdgcn_permlane16_swap(__float_as_uint(v), __float_as_uint(v), false, false); v = __uint_as_float(s[0]) + __uint_as_float(s[1]); }
    { auto s = __builtin_amdgcn_permlane32_swap(__float_as_uint(v), __float_as_uint(v), false, false); v = __uint_as_float(s[0]) + __uint_as_float(s[1]); }
    return v;
}
__device__ __forceinline__ float wave_max(float v) {
    v = fmaxf(v, dpp_rot<0x128>(v)); v = fmaxf(v, dpp_rot<0x124>(v)); v = fmaxf(v, dpp_rot<0x122>(v)); v = fmaxf(v, dpp_rot<0x121>(v));
    { auto s = __builtin_amdgcn_permlane16_swap(__float_as_uint(v), __float_as_uint(v), false, false); v = fmaxf(__uint_as_float(s[0]), __uint_as_float(s[1])); }
    { auto s = __builtin_amdgcn_permlane32_swap(__float_as_uint(v), __float_as_uint(v), false, false); v = fmaxf(__uint_as_float(s[0]), __uint_as_float(s[1])); }
    return v;
}
__device__ __forceinline__ int rel_bucket(int n) {
    if (n < 16) return n < 0 ? 0 : n;
    return 16 + (n >= 22) + (n >= 30) + (n >= 40) + (n >= 54) + (n >= 73) + (n >= 99) + (n >= 134) + (n >= 182) + (n >= 246) + (n >= 332) + (n >= 450) + (n >= 609) + (n >= 825) + (n >= 1117) + (n >= 1513);
}
namespace pg8 {
#define PG8_LAS __attribute__((address_space(3)))
typedef unsigned short bf16_t;
typedef short bf16x8 __attribute__((ext_vector_type(8)));
typedef float f32x4 __attribute__((ext_vector_type(4)));
typedef unsigned u32x4 __attribute__((ext_vector_type(4)));
constexpr int BM = 256, BK = 64, HALF = 128, HTB = HALF * BK * 2  , STAGE_BYTES = 8 * HTB, NXCD = 8, WGM = 8;

__host__ __device__ __forceinline__ int lds_byte(int r, int c) { const int st = (r >> 4) * 2 + (c >> 5), rr = r & 15, cc = c & 31, ob = rr * 64 + cc * 2; return st * 1024 + (ob ^ (((ob >> 9) & 1) << 5)); }
__host__ __device__ __forceinline__ void stage_rc(int b, int& R, int& C) { const int st = b / 1024, sb = b % 1024, swz = sb ^ (((sb >> 9) & 1) << 5); R = (st >> 1) * 16 + swz / 64; C = (st & 1) * 32 + (swz % 64) / 2; }
__host__ __device__ __forceinline__ int perm32(int rho) { const int n = rho >> 4, i = rho & 15; return 8 * (i >> 2) + 4 * n + (i & 3); }

struct Unit { int pm, pn; };
struct Gemm { const bf16_t* A; const bf16_t* Bt; int M, N, K; };

struct StaticOrder {
    int nM, nN, nwg, G, c;
    __host__ __device__ void init(int M, int N, int G_, int c_) { nM = M / BM; nN = N / BM; nwg = nM * nN; G = G_; c = c_; }
    int rep = 1;
    __host__ __device__ bool next(int i0, Unit& u) const {
        const int i = i0 / rep;
        const long L = (long)i * G + c; if (L >= nwg) return false;
        int wgid = (int)L; { const int q = nwg / NXCD, r = nwg % NXCD, xcd = wgid % NXCD, off = wgid / NXCD; wgid = (xcd < r ? xcd * (q + 1) : r * (q + 1) + (xcd - r) * q) + off; }
        const int nig = WGM * nN, gid = wgid / nig, fm = gid * WGM, gsz = (nM - fm) < WGM ? (nM - fm) : WGM;
        u.pm = fm + ((wgid % nig) % gsz); u.pn = (wgid % nig) / gsz; return true;
    }
    __device__ __forceinline__ void a_ready(const Unit&) const {}
    __device__ __forceinline__ void done(const Unit&) const {}
};
__device__ __forceinline__ unsigned cvt_pk_bf16(float lo, float hi) { unsigned r; asm volatile("v_cvt_pk_bf16_f32 %0, %1, %2" : "=v"(r) : "v"(lo), "v"(hi)); return r; }
__device__ __forceinline__ u32x4 pack8(const f32x4 v0, const f32x4 v1) { u32x4 w; w.x = cvt_pk_bf16(v0[0], v0[1]); w.y = cvt_pk_bf16(v0[2], v0[3]); w.z = cvt_pk_bf16(v1[0], v1[1]); w.w = cvt_pk_bf16(v1[2], v1[3]); return w; }
__device__ __forceinline__ float blo(unsigned w) { return __builtin_bit_cast(float, w << 16); }
__device__ __forceinline__ float bhi(unsigned w) { return __builtin_bit_cast(float, w & 0xffff0000u); }
__device__ __forceinline__ float sigm(float v) { return __builtin_amdgcn_rcpf(1.f + __expf(-v)); }
template <class E> __device__ __forceinline__ void epi_loop(const E& e, const f32x4 (&acc)[2][2][4][2], const Unit& u, int wr, int wc, int fr, int fq) {
#pragma unroll
    for (int ai = 0; ai < 2; ++ai)
#pragma unroll
        for (int m = 0; m < 4; ++m) { const int row = u.pm * BM + ai * HALF + wr * 64 + m * 16 + fr;
#pragma unroll
            for (int bj = 0; bj < 2; ++bj) { const int col = u.pn * BM + bj * HALF + wc * 32 + 8 * fq; e.item(u.pn, row, col, acc[ai][bj][m][0], acc[ai][bj][m][1]); } }
}

struct EpiInProj {
    static constexpr bool PERM = true, AFTER_DRAIN = false;
    bf16_t *Qd, *Kd, *Vd, *LQ, *LK, *LV, *GA, *GB;
    __device__ __forceinline__ void operator()(const f32x4 (&acc)[2][2][4][2], const Unit& u, int wr, int wc, int fr, int fq) const { epi_loop(*this, acc, u, wr, wc, fr, fq); }
    __device__ __forceinline__ void item(int pn, int row, int col, f32x4 v0, f32x4 v1) const {
            const int b = row >> 14, s = row & 16383; bf16_t* dst;
            if (pn < 4) {
                const int cc = col & 511, h = cc >> 7, c = (cc >> 6) & 1, dd = cc & 63; const float sc = (pn < 2) ? 16.f * 0.18033688011112042f : 16.f;
                unsigned char* d8 = (pn < 2) ? (unsigned char*)Qd + ((size_t)((b * 4 + h) * 2 + c) * 16384 + s) * 64 + dd
                                             : (unsigned char*)Kd + ((size_t)((b * 4 + h) * 2 + c) * 256 + (s >> 6)) * 4096 + (dd >> 5) * 2048 + ((dd >> 4) & 1) * 1024 + (s & 63) * 16 + (dd & 15);
                float q[8];
#pragma unroll
                for (int i = 0; i < 4; ++i) { q[i] = __builtin_amdgcn_fmed3f(v0[i] * sc, -448.f, 448.f); q[4 + i] = __builtin_amdgcn_fmed3f(v1[i] * sc, -448.f, 448.f); }
                int w0 = 0, w1 = 0;
                w0 = __builtin_amdgcn_cvt_pk_fp8_f32(q[0], q[1], w0, false); w0 = __builtin_amdgcn_cvt_pk_fp8_f32(q[2], q[3], w0, true);
                w1 = __builtin_amdgcn_cvt_pk_fp8_f32(q[4], q[5], w1, false); w1 = __builtin_amdgcn_cvt_pk_fp8_f32(q[6], q[7], w1, true);
                typedef unsigned u32x2_t __attribute__((ext_vector_type(2)));
                *(u32x2_t*)d8 = (u32x2_t){(unsigned)w0, (unsigned)w1};
                return;
            } else if (pn < 6) {
                const int cc = col - 1024, h = cc >> 7, d = cc & 127;
                dst = Vd + ((size_t)(b * 4 + h) * 256 + (s >> 6)) * 8192 + ((d >> 5) * 4 + ((s & 63) >> 4)) * 512 + (s & 15) * 32 + (d & 31);
            } else if (pn < 9) {
                v0 = v0 * 0.18033688011112042f; v1 = v1 * 0.18033688011112042f; dst = LQ + (size_t)row * 768 + (col - 1536);
            } else if (pn < 12) { dst = LK + (size_t)row * 768 + (col - 2304);
            } else if (pn < 15) { dst = LV + (size_t)row * 768 + (col - 3072);
            } else {
#pragma unroll
                for (int i = 0; i < 4; ++i) { v0[i] = sigm(v0[i]); v1[i] = sigm(v1[i]); }
                dst = (pn < 19) ? GA + (size_t)row * 1024 + (col - 3840) : GB + (size_t)row * 1024 + (col - 4864);
            }
            *(u32x4*)dst = pack8(v0, v1);
        }
};
struct EpiGate1 {
    static constexpr bool PERM = true, AFTER_DRAIN = false;
    const bf16_t* GA; bf16_t* G;
    __device__ __forceinline__ void operator()(const f32x4 (&acc)[2][2][4][2], const Unit& u, int wr, int wc, int fr, int fq) const { epi_loop(*this, acc, u, wr, wc, fr, fq); }
    __device__ __forceinline__ void item(int pn, int row, int col, f32x4 v0, f32x4 v1) const {
            const size_t o = (size_t)row * 1024 + col; const u32x4 g = *(const u32x4*)(GA + o);
            v0[0] *= blo(g.x); v0[1] *= bhi(g.x); v0[2] *= blo(g.y); v0[3] *= bhi(g.y); v1[0] *= blo(g.z); v1[1] *= bhi(g.z); v1[2] *= blo(g.w); v1[3] *= bhi(g.w);
            *(u32x4*)(G + o) = pack8(v0, v1);
        }
};
struct EpiGate2 {
    static constexpr bool PERM = true, AFTER_DRAIN = false;
    const bf16_t* GB; bf16_t* G;
    __device__ __forceinline__ void operator()(const f32x4 (&acc)[2][2][4][2], const Unit& u, int wr, int wc, int fr, int fq) const { epi_loop(*this, acc, u, wr, wc, fr, fq); }
    __device__ __forceinline__ void item(int pn, int row, int col, f32x4 v0, f32x4 v1) const {
            const size_t o = (size_t)row * 1024 + col; const u32x4 g = *(const u32x4*)(GB + o); const u32x4 p = *(const u32x4*)(G + o);
            v0[0] = v0[0] * blo(g.x) + blo(p.x); v0[1] = v0[1] * bhi(g.x) + bhi(p.x); v0[2] = v0[2] * blo(g.y) + blo(p.y); v0[3] = v0[3] * bhi(g.y) + bhi(p.y);
            v1[0] = v1[0] * blo(g.z) + blo(p.z); v1[1] = v1[1] * bhi(g.z) + bhi(p.z); v1[2] = v1[2] * blo(g.w) + blo(p.w); v1[3] = v1[3] * bhi(g.w) + bhi(p.w);
            *(u32x4*)(G + o) = pack8(v0, v1);
        }
};
struct EpiOut {
    static constexpr bool PERM = true, AFTER_DRAIN = false;
    const float* X; float* R;
    __device__ __forceinline__ void operator()(const f32x4 (&acc)[2][2][4][2], const Unit& u, int wr, int wc, int fr, int fq) const { epi_loop(*this, acc, u, wr, wc, fr, fq); }
    __device__ __forceinline__ void item(int pn, int row, int col, f32x4 v0, f32x4 v1) const {
            const size_t o = (size_t)row * 1024 + col; const f32x4 x0 = *(const f32x4*)(X + o), x1 = *(const f32x4*)(X + o + 4);
            *(f32x4*)(R + o) = x0 * 1.189207115002721f + v0; *(f32x4*)(R + o + 4) = x1 * 1.189207115002721f + v1;
    }
};
struct EpiScoreT {
    static constexpr bool PERM = true, AFTER_DRAIN = false;
    float* ST;
    __device__ __forceinline__ void operator()(const f32x4 (&acc)[2][2][4][2], const Unit& u, int wr, int wc, int fr, int fq) const { epi_loop(*this, acc, u, wr, wc, fr, fq); }
    __device__ __forceinline__ void item(int pn, int row, int col, f32x4 v0, f32x4 v1) const { const size_t o = (size_t)row * 32768 + col; *(f32x4*)(ST + o) = v0; *(f32x4*)(ST + o + 4) = v1; }
};
template <class Epi, class Sched, bool ALIGN_EPI = false, bool SP2 = false>
__device__ __forceinline__ void gemm_phase(PG8_LAS unsigned char* lds, const Gemm g, const Sched& S, const Epi& E, const int wid  ) {
    const int lane = (int)__builtin_amdgcn_mbcnt_hi(~0u, __builtin_amdgcn_mbcnt_lo(~0u, 0u)), tid = wid * 64 + lane, wr = wid >> 2, wc = wid & 3, fr = lane & 15, fq = lane >> 4;
    const int K = g.K, nt = K / BK;
    unsigned voffA[2], voffB[2];
#pragma unroll
    for (int i = 0; i < 2; ++i) { int R, C; stage_rc(tid * 16 + i * 8192, R, C); const int Rb = Epi::PERM ? ((R & ~31) + perm32(R & 31)) : R;
        voffA[i] = (unsigned)(R * K + C) * 2u; voffB[i] = (unsigned)(Rb * K + C) * 2u; }
    const size_t kstep = (size_t)(BK * 2);
    const size_t hstep = (size_t)HALF * K * 2;
    const size_t tstep = 2 * hstep;
    const unsigned ldsw = (unsigned)wid * 1024u;
    const int aoff = lds_byte(wr * 64 + fr, fq * 8), boff = lds_byte(wc * 32 + fr, fq * 8);
#define PG8_SA(b, h) (((b) * 2 + (h)) * HTB)
#define PG8_SB(b, h) ((4 + (b) * 2 + (h)) * HTB)
#define PG8_STAGE(bufoff, gbase, voff) do { _Pragma("unroll") for (int _i = 0; _i < 2; ++_i) \
        __builtin_amdgcn_global_load_lds((const unsigned*)((const char*)(gbase) + (voff)[_i]), (PG8_LAS unsigned*)(lds + (bufoff) + ldsw + _i * 8192), 16, 0, 0); } while (0)
#define PG8_LDA(dst, b, h) do { _Pragma("unroll") for (int m = 0; m < 4; ++m) _Pragma("unroll") for (int k = 0; k < 2; ++k) dst[m][k] = *(const PG8_LAS bf16x8*)(lds + PG8_SA(b, h) + aoff + m * 2048 + k * 1024); } while (0)
#define PG8_LDB(dst, b, h) do { _Pragma("unroll") for (int n = 0; n < 2; ++n) _Pragma("unroll") for (int k = 0; k < 2; ++k) dst[n][k] = *(const PG8_LAS bf16x8*)(lds + PG8_SB(b, h) + boff + n * 2048 + k * 1024); } while (0)
#define PG8_MMA(ai, bj, At, Bt) do { __builtin_amdgcn_s_setprio(1); _Pragma("unroll") for (int m = 0; m < 4; ++m) _Pragma("unroll") for (int n = 0; n < 2; ++n) _Pragma("unroll") for (int k = 0; k < 2; ++k) \
        acc[ai][bj][m][n] = __builtin_amdgcn_mfma_f32_16x16x32_bf16(Bt[n][k], At[m][k], acc[ai][bj][m][n], 0, 0, 0); __builtin_amdgcn_s_setprio(0); } while (0)
#define PG8_WAIT_V(n) asm volatile("s_waitcnt vmcnt(" #n ")" ::: "memory")
#define PG8_WAIT_L(n) asm volatile("s_waitcnt lgkmcnt(" #n ")" ::: "memory")
#define PG8_BAR __builtin_amdgcn_s_barrier()
#define PG8_SCHED __builtin_amdgcn_sched_barrier(0)
    Unit cur, nxt; int ui = 0;
    if (!S.next(0, cur)) return;
    f32x4 acc[2][2][4][2];
#pragma unroll
    for (int a = 0; a < 2; ++a)
#pragma unroll
        for (int b = 0; b < 2; ++b)
#pragma unroll
            for (int m = 0; m < 4; ++m)
#pragma unroll
                for (int n = 0; n < 2; ++n) acc[a][b][m][n] = (f32x4){0.f, 0.f, 0.f, 0.f};
    bf16x8 At[4][2], B0[2][2], B1[2][2];
    const char* cA = (const char*)g.A + (size_t)cur.pm * tstep; const char* cB = (const char*)g.Bt + (size_t)cur.pn * tstep;
    S.a_ready(cur);
    if constexpr (SP2) {
        PG8_STAGE(PG8_SB(0, 0), cB, voffB); PG8_STAGE(PG8_SB(0, 1), cB + hstep, voffB); PG8_STAGE(PG8_SA(0, 0), cA, voffA); PG8_STAGE(PG8_SA(0, 1), cA + hstep, voffA);
        if (wr == 1) PG8_BAR;
        PG8_WAIT_V(2); PG8_BAR;
        PG8_STAGE(PG8_SB(1, 0), cB + kstep, voffB); PG8_STAGE(PG8_SA(1, 0), cA + kstep, voffA); PG8_STAGE(PG8_SB(1, 1), cB + hstep + kstep, voffB);
        PG8_WAIT_V(6); PG8_BAR;
    } else {
        PG8_STAGE(PG8_SB(0, 0), cB, voffB); PG8_STAGE(PG8_SA(0, 0), cA, voffA); PG8_STAGE(PG8_SB(0, 1), cB + hstep, voffB); PG8_STAGE(PG8_SA(0, 1), cA + hstep, voffA);
        if (wr == 1) PG8_BAR;
        PG8_WAIT_V(4); PG8_BAR;
        PG8_STAGE(PG8_SB(1, 0), cB + kstep, voffB); PG8_STAGE(PG8_SA(1, 0), cA + kstep, voffA); PG8_STAGE(PG8_SB(1, 1), cB + hstep + kstep, voffB);
        PG8_WAIT_V(6); PG8_BAR;
    }
    for (;;) {
        const bool has_next = S.next(ui + 1, nxt);
        const char* nA = has_next ? (const char*)g.A + (size_t)nxt.pm * tstep : cA; const char* nB = has_next ? (const char*)g.Bt + (size_t)nxt.pn * tstep : cB;
        for (int t = 0; t < nt; t += 2) {
            const bool last = (t == nt - 2);
            const char* a1 = cA + (size_t)(t + 1) * kstep;
            const char* a2 = last ? nA : cA + (size_t)(t + 2) * kstep; const char* b2 = last ? nB : cB + (size_t)(t + 2) * kstep;
            const char* a3 = a2 + kstep; const char* b3 = b2 + kstep;
            if (last && has_next) S.a_ready(nxt);
            if constexpr (SP2) {
            PG8_LDB(B0, 0, 0); PG8_LDB(B1, 0, 1); PG8_SCHED; PG8_LDA(At, 0, 0); PG8_STAGE(PG8_SA(1, 1), a1 + hstep, voffA);
            PG8_WAIT_V(8); PG8_WAIT_L(0); PG8_BAR; PG8_MMA(0, 0, At, B0); PG8_MMA(0, 1, At, B1); PG8_BAR; PG8_SCHED;
            PG8_LDA(At, 0, 1); PG8_STAGE(PG8_SB(0, 0), b2, voffB); PG8_STAGE(PG8_SB(0, 1), b2 + hstep, voffB); PG8_STAGE(PG8_SA(0, 0), a2, voffA);
            PG8_WAIT_V(8); PG8_WAIT_L(0); PG8_BAR; PG8_MMA(1, 0, At, B0); PG8_MMA(1, 1, At, B1); PG8_BAR; PG8_SCHED;
            PG8_LDB(B0, 1, 0); PG8_LDB(B1, 1, 1); PG8_SCHED; PG8_LDA(At, 1, 0); PG8_STAGE(PG8_SA(0, 1), a2 + hstep, voffA);
            PG8_WAIT_V(8); PG8_WAIT_L(0); PG8_BAR; PG8_MMA(0, 0, At, B0); PG8_MMA(0, 1, At, B1); PG8_BAR; PG8_SCHED;
            PG8_LDA(At, 1, 1); PG8_STAGE(PG8_SB(1, 0), b3, voffB); PG8_STAGE(PG8_SB(1, 1), b3 + hstep, voffB); PG8_STAGE(PG8_SA(1, 0), a3, voffA);
            PG8_WAIT_V(8); PG8_WAIT_L(0); PG8_BAR; PG8_MMA(1, 0, At, B0); PG8_MMA(1, 1, At, B1); PG8_BAR; PG8_SCHED;
            } else {
            PG8_LDB(B0, 0, 0); PG8_SCHED; PG8_LDA(At, 0, 0); PG8_STAGE(PG8_SA(1, 1), a1 + hstep, voffA);
            PG8_WAIT_L(8); PG8_BAR; PG8_WAIT_L(0); PG8_MMA(0, 0, At, B0); PG8_BAR; PG8_SCHED;
            PG8_LDB(B1, 0, 1); PG8_STAGE(PG8_SB(0, 0), b2, voffB);
            PG8_BAR; PG8_WAIT_L(0); PG8_MMA(0, 1, At, B1); PG8_BAR;
            PG8_LDA(At, 0, 1); PG8_STAGE(PG8_SA(0, 0), a2, voffA);
            PG8_BAR; PG8_WAIT_L(0); PG8_MMA(1, 0, At, B0); PG8_BAR; PG8_SCHED;
            PG8_STAGE(PG8_SB(0, 1), b2 + hstep, voffB);
            PG8_WAIT_V(6); PG8_BAR; PG8_MMA(1, 1, At, B1); PG8_BAR;
            PG8_LDB(B0, 1, 0); PG8_SCHED; PG8_LDA(At, 1, 0); PG8_STAGE(PG8_SA(0, 1), a2 + hstep, voffA);
            PG8_WAIT_L(8); PG8_BAR; PG8_WAIT_L(0); PG8_MMA(0, 0, At, B0); PG8_BAR; PG8_SCHED;
            PG8_LDB(B1, 1, 1); PG8_STAGE(PG8_SB(1, 0), b3, voffB);
            PG8_BAR; PG8_WAIT_L(0); PG8_MMA(0, 1, At, B1); PG8_BAR;
            PG8_LDA(At, 1, 1); PG8_STAGE(PG8_SA(1, 0), a3, voffA);
            PG8_BAR; PG8_WAIT_L(0); PG8_MMA(1, 0, At, B0); PG8_BAR; PG8_SCHED;
            PG8_STAGE(PG8_SB(1, 1), b3 + hstep, voffB);
            PG8_WAIT_V(6); PG8_BAR; PG8_MMA(1, 1, At, B1); PG8_BAR;
            }
        }
        if constexpr (ALIGN_EPI) { if (wr == 0) PG8_BAR; }
        if constexpr (!Epi::AFTER_DRAIN) { E(acc, cur, wr, wc, fr, fq); S.done(cur); }
        if (!has_next) break;
#pragma unroll
        for (int a = 0; a < 2; ++a)
#pragma unroll
            for (int b = 0; b < 2; ++b)
#pragma unroll
                for (int m = 0; m < 4; ++m)
#pragma unroll
                    for (int n = 0; n < 2; ++n) acc[a][b][m][n] = (f32x4){0.f, 0.f, 0.f, 0.f};
        cur = nxt; cA = nA; cB = nB; ++ui;
        if constexpr (ALIGN_EPI) { if (wr == 1) PG8_BAR; }
    }
    PG8_WAIT_V(0);
    if constexpr (!ALIGN_EPI) { if (wr == 0) PG8_BAR; }
    PG8_BAR;
    if constexpr (Epi::AFTER_DRAIN) { E.fused(acc, cur, wr, wc, fr, fq, lds, wid, lane); S.done(cur); }
#undef PG8_SA
#undef PG8_SB
#undef PG8_STAGE
#undef PG8_LDA
#undef PG8_LDB
#undef PG8_MMA
#undef PG8_WAIT_V
#undef PG8_WAIT_L
#undef PG8_BAR
#undef PG8_SCHED
}
}
#define XB_TMO      128
#define XB_XCNT(j)  (256  + 64 * (j))
#define XB_XSUB(j)  (1280 + 64 * (j))
#define XB_XGEN(j)  (2304 + 64 * (j))
#define XB_TOP      3328
#define XB_TOPGEN   3392
#define XCD_BAR_WORDS 3456
#define XB_SPIN_CAP (1u << 18)

__device__ __forceinline__ unsigned xb_ld(unsigned* p)              { return __hip_atomic_load(p, __ATOMIC_RELAXED, __HIP_MEMORY_SCOPE_AGENT); }
__device__ __forceinline__ unsigned xb_add(unsigned* p, unsigned v) { return __hip_atomic_fetch_add(p, v, __ATOMIC_RELAXED, __HIP_MEMORY_SCOPE_AGENT); }
__device__ __forceinline__ unsigned xb_xcc_id() { return (unsigned)__builtin_amdgcn_s_getreg((3 << 11) | 20) & 0xFu; }
#define XB_SPIN(cond, bar) do { unsigned _sp = 0; while (cond) { __builtin_amdgcn_s_sleep(1); \
    if ((++_sp & 255u) == 0u) { if (xb_ld(&(bar)[XB_TMO])) break; if (_sp > XB_SPIN_CAP) { atomicAdd(&(bar)[XB_TMO], 1u); break; } } } } while (0)

struct XcdBarrier {
    unsigned* bar; unsigned x;
    volatile LAS unsigned* st;
    int w;
};

__device__ __forceinline__ bool xb_leader(int w) { unsigned l; asm volatile("v_mbcnt_lo_u32_b32 %0, -1, 0\n\tv_mbcnt_hi_u32_b32 %0, -1, %0" : "=v"(l)); return w == 0 && l == 0u; }
__device__ __forceinline__ XcdBarrier xcd_barrier_post(unsigned* bar, volatile LAS unsigned* st, int wave) {
    XcdBarrier b; b.bar = bar; b.x = xb_xcc_id(); b.st = st; b.w = wave;
    if (xb_leader(wave)) (void)xb_add(&bar[XB_XCNT(b.x)], 1u);
    return b;
}
__device__ __forceinline__ void xcd_barrier_complete(unsigned* bar, unsigned x, unsigned& nloc, unsigned& nx) {
    const unsigned G = gridDim.x * gridDim.y * gridDim.z;
    unsigned sum, cnt, mine, sp = 0u;
    for (;;) {
        sum = 0u; cnt = 0u; mine = 0u;
#pragma unroll
        for (unsigned j = 0; j < 16; ++j) { const unsigned c = xb_ld(&bar[XB_XCNT(j)]); sum += c; cnt += (c > 0u) ? 1u : 0u; mine = (j == x) ? c : mine; }
        if (sum == G) break;
        __builtin_amdgcn_s_sleep(1);
        if ((++sp & 255u) == 0u) { if (xb_ld(&bar[XB_TMO])) break; if (sp > XB_SPIN_CAP) { atomicAdd(&bar[XB_TMO], 1u); break; } }
    }
    nloc = mine > 0u ? mine : 1u; nx = cnt > 0u ? cnt : 1u;
}

__device__ __forceinline__ void xcd_barrier(const XcdBarrier& b) {
    asm volatile("s_waitcnt vmcnt(0)" ::: "memory");
    __syncthreads();
    if (xb_leader(b.w)) {
        unsigned* bar = b.bar;
        __builtin_amdgcn_s_waitcnt(0);
        unsigned nloc = b.st[0], nx = b.st[1];
        if (nloc == 0u) { xcd_barrier_complete(bar, b.x, nloc, nx); b.st[0] = nloc; b.st[1] = nx; }
        const unsigned old = xb_add(&bar[XB_XSUB(b.x)], 1u);
        const unsigned gen = old / nloc;
        if (old + 1u == (gen + 1u) * nloc) {
            __builtin_amdgcn_fence(__ATOMIC_RELEASE, "agent");
            asm volatile("s_waitcnt vmcnt(0)" ::: "memory");
            const unsigned og = xb_add(&bar[XB_TOP], 1u);
            const unsigned tg = og / nx;
            if (og + 1u == (tg + 1u) * nx) xb_add(&bar[XB_TOPGEN], 1u);
            else XB_SPIN(xb_ld(&bar[XB_TOPGEN]) == tg, bar);
            __builtin_amdgcn_fence(__ATOMIC_ACQUIRE, "agent");
            xb_add(&bar[XB_XGEN(b.x)], 1u);
            asm volatile("s_waitcnt vmcnt(0)" ::: "memory");
        } else {
            XB_SPIN(xb_ld(&bar[XB_XGEN(b.x)]) == gen, bar);
            __builtin_amdgcn_fence(__ATOMIC_ACQUIRE, "agent");
            asm volatile("s_waitcnt vmcnt(0)" ::: "memory");
        }
    }
    __syncthreads();
}
namespace da {
constexpr int SLOT_K = 4096, SLOT_V = 16384;
constexpr int LDS_K = 0, LDS_V = 3 * SLOT_K;
constexpr int LDS_BIAS = LDS_V + 3 * SLOT_V;
constexpr int TAB_NR = BIAS_TAB - 4, TAB_CL = 2304;
constexpr int LDS_TREV = LDS_BIAS + BIAS_TAB * 4;
constexpr int LDS_FLAG = LDS_TREV + 4 * TAB_CL * 4;
constexpr int LDS_END = LDS_FLAG + 16;
static_assert(LDS_END <= RING_BYTES && (LDS_TREV % 16) == 0 && (TAB_NR % 4) == 0, "attention LDS map");
constexpr float THR = 8.f;
__device__ __forceinline__ int crow(int r, int hi) { return (r & 3) + 8 * (r >> 2) + 4 * hi; }
__device__ __forceinline__ void glds16(const void* gbase  , unsigned voff  , unsigned lds_dst) { unsigned keep;
    asm volatile("s_mov_b32 %0, m0\n\ts_mov_b32 m0, %3\n\ts_nop 0\n\tglobal_load_lds_dwordx4 %1, %2\n\ts_mov_b32 m0, %0" : "=&s"(keep) : "v"(voff), "s"(gbase), "s"(lds_dst) : "memory"); }
typedef short v4i16_t __attribute__((ext_vector_type(4)));
__device__ __forceinline__ s16x4 vtr(const LAS char* p) { return __builtin_bit_cast(s16x4, __builtin_amdgcn_ds_read_tr16_b64_v4i16((LAS v4i16_t*)p)); }

struct Tensors { const bf16* Qd; const bf16* Kd; const bf16* Vd; float* stash; bf16* ya; const float* dlam; const float* subg; const float* relb; };

#define DA_SBAR() __builtin_amdgcn_sched_barrier(0)
#define DA_PIN(x) asm volatile("" : "+v"(x))
#define DA_MFMA(a, b, c) __builtin_amdgcn_mfma_f32_32x32x16_bf16(a, b, c, 0, 0, 0)
typedef int v8i_t __attribute__((ext_vector_type(8))); typedef int v4i_t __attribute__((ext_vector_type(4)));
#define DA_MFS(a, b, c) __builtin_amdgcn_mfma_scale_f32_32x32x64_f8f6f4(a, b, c, 0, 0, 0, 0x7B7B7B7B, 0, 0x7B7B7B7B)
#define DA_K8(KP, kb) __builtin_shufflevector(*(const LAS v4i_t*)((KP) + (kb) * 512), *(const LAS v4i_t*)((KP) + 1024 + (kb) * 512), 0, 1, 2, 3, 4, 5, 6, 7)
#define DA_MX3(a, b, c) __builtin_fmaxf(__builtin_fmaxf((a), (b)), (c))
__device__ __forceinline__ float rowmax(const f32x16& p0, const f32x16& p1) {
    float a = DA_MX3(p0[0], p0[1], p1[0]), b = DA_MX3(p0[2], p0[3], p1[1]); a = DA_MX3(a, p1[2], p1[3]);
#pragma unroll
    for (int r = 4; r < 16; r += 4) { a = DA_MX3(a, p0[r], p0[r + 1]); b = DA_MX3(b, p0[r + 2], p0[r + 3]); a = DA_MX3(a, p1[r], p1[r + 1]); b = DA_MX3(b, p1[r + 2], p1[r + 3]); }
    float mx = __builtin_fmaxf(a, b); auto rr = __builtin_amdgcn_permlane32_swap(__float_as_uint(mx), __float_as_uint(mx), false, false);
    return __builtin_fmaxf(__uint_as_float(rr[0]), __uint_as_float(rr[1])); }

#define DA_TABINIT(N0, N1, T_) do { int base_ = qabs - 64 * (T_) - 4 * hi + BIAS_GUARD; asm volatile("" : "+v"(base_)); \
        _Pragma("unroll") for (int r = 0; r < 16; ++r) { const int o_ = (r & 3) + 8 * (r >> 2); N0[r] = tb[base_ - o_] - m; N1[r] = tb[base_ - o_ - 32] - m; } } while (0)
#define DA_TREV4(N, j, off) do { const f32x4 t4_ = *(const LAS f32x4*)(ta_ + (off)); N[4 * (j)] = t4_[0]; N[4 * (j) + 1] = t4_[1]; N[4 * (j) + 2] = t4_[2]; N[4 * (j) + 3] = t4_[3]; } while (0)
#define DA_TREVINIT(N0, N1, T_) do { const LAS char* ta_ = trev0 + 256 * (T_); DA_TREV4(N0, 0, 0); DA_TREV4(N0, 1, 32); DA_TREV4(N0, 2, 64); DA_TREV4(N0, 3, 96); \
        DA_TREV4(N1, 0, 128); DA_TREV4(N1, 1, 160); DA_TREV4(N1, 2, 192); DA_TREV4(N1, 3, 224); } while (0)
#define DA_NEARINIT(N0, N1, T_) do { if (OPT) DA_TREVINIT(N0, N1, T_); else DA_TABINIT(N0, N1, T_); } while (0)
#define DA_MASK(C0, C1, T_) do { int base_ = qabs - 64 * (T_) - 4 * hi + BIAS_GUARD; asm volatile("" : "+v"(base_)); \
        _Pragma("unroll") for (int r = 0; r < 16; ++r) { const int o_ = (r & 3) + 8 * (r >> 2); if (base_ - o_ < BIAS_GUARD) C0[r] = -1e30f; if (base_ - o_ - 32 < BIAS_GUARD) C1[r] = -1e30f; } } while (0)
#define DA_FAR(T_) ((q0 - 64 * (T_) - 63) >= DFAR)
#define DA_PKW(P, i) cvtpk(P[i], P[(i) + 1])
#define DA_PAF(k) __builtin_bit_cast(bf16x8, pw[k])
#define DA_VOFF(g) ((2 * ((g) >> 3) + ((g) & 1)) * 4096 + (((g) >> 1) & 3) * 1024)
#define DA_VRD(g) do { vl[(g) % 5] = vtr(vp_ + DA_VOFF(g)); vh[(g) % 5] = vtr(vp_ + DA_VOFF(g) + 512); } while (0)
#define DA_VFR(g) (bf16x8){vl[(g) % 5][0], vl[(g) % 5][1], vl[(g) % 5][2], vl[(g) % 5][3], vh[(g) % 5][0], vh[(g) % 5][1], vh[(g) % 5][2], vh[(g) % 5][3]}
#define DA_GAPA(C, kb, CI, G, F_) do { C = DA_MFS(kf##kb, qf, CI); if (G) kf##kb = DA_K8(kp_, kb); F_; DA_PIN(sacc); DA_SBAR(); } while (0)
#define DA_FILL(a0, a1, a2, a3, W0, W1, PW) do { sacc += a0; sacc += a1; sacc += a2; sacc += a3; W0; W1; DA_PIN(PW); } while (0)
#define DA_GAPB(g, X, i) do { o[2 * ((g) >> 3) + ((g) & 1)] = DA_MFMA(DA_VFR(g), DA_PAF(((g) >> 1) & 3), o[2 * ((g) >> 3) + ((g) & 1)]); \
        X[i] = __builtin_amdgcn_exp2f(X[i]); X[(i) + 1] = __builtin_amdgcn_exp2f(X[(i) + 1]); DA_PIN(X); DA_SBAR(); } while (0)
#define DA_GAPBF(g, X, i, F_) do { o[2 * ((g) >> 3) + ((g) & 1)] = DA_MFMA(DA_VFR(g), DA_PAF(((g) >> 1) & 3), o[2 * ((g) >> 3) + ((g) & 1)]); \
        X[i] = __builtin_amdgcn_exp2f(X[i]); X[(i) + 1] = __builtin_amdgcn_exp2f(X[(i) + 1]); DA_PIN(X); F_; DA_PIN(sacc); DA_SBAR(); } while (0)
#define DA_STEP(OPT, C0, C1, P0, P1, T_, MASK, GK, GV, GL, FARV, NEARN) do { DA_SBAR(); const int t_ = (T_); \
    const LAS char* vp_ = vp0 + sl_prev * SLOT_V; const LAS char* kp_ = kp0 + sl_next * SLOT_K; const LAS char* ta_ = trev0 + 256 * (t_ + 1); (void)ta_; \
    if (!OPT && FARV) { const float cm_ = c31 - m; _Pragma("unroll") for (int r = 0; r < 16; ++r) { C0[r] = cm_; C1[r] = cm_; } }     \
    float sacc = P0[0] + P0[1]; \
    DA_VRD(0); DA_VRD(1); DA_SBAR(); \
    DA_GAPA(C0, 0, (OPT && FARV) ? cinit : C0, GL, do { DA_FILL(P0[2], P0[3], P0[4], P0[5], pw[0][0] = DA_PKW(P0, 0), pw[0][1] = DA_PKW(P0, 2), pw[0]); DA_FILL(P0[6], P0[7], P0[8], P0[9], pw[0][2] = DA_PKW(P0, 4), pw[0][3] = DA_PKW(P0, 6), pw[0]); } while (0)); \
    DA_VRD(2); DA_VRD(3); DA_SBAR(); \
    DA_GAPA(C1, 1, (OPT && FARV) ? cinit : C1, GL, do { DA_FILL(P0[10], P0[11], P0[12], P0[13], pw[1][0] = DA_PKW(P0, 8), pw[1][1] = DA_PKW(P0, 10), pw[1]); DA_FILL(P0[14], P0[15], P1[0], P1[1], pw[1][2] = DA_PKW(P0, 12), pw[1][3] = DA_PKW(P0, 14), pw[1]); } while (0)); \
    if (MASK) { if (t_ >= NT - 4) DA_MASK(C0, C1, t_); } \
    if (!OPT) { const float rm_ = rowmax(C0, C1); resc = false; \
      if (__builtin_expect(__any(rm_ > THR), 0)) { const float dl_ = __builtin_fmaxf(rm_, 0.f); m += dl_; fsc = __builtin_amdgcn_exp2f(-dl_); l *= fsc; resc = true; \
          _Pragma("unroll") for (int r = 0; r < 16; ++r) { C0[r] -= dl_; C1[r] -= dl_; } \
          } } \
    DA_SBAR(); \
    DA_VRD(4);                  DA_SBAR(); DA_GAPBF(0, C0, 0, DA_FILL(P1[2], P1[3], P1[4], P1[5],     pw[2][0] = DA_PKW(P1, 0),  pw[2][1] = DA_PKW(P1, 2),  pw[2])); \
    DA_VRD(5);                  DA_SBAR(); DA_GAPBF(1, C0, 2, DA_FILL(P1[6], P1[7], P1[8], P1[9],     pw[2][2] = DA_PKW(P1, 4),  pw[2][3] = DA_PKW(P1, 6),  pw[2])); \
    DA_VRD(6);                  DA_SBAR(); DA_GAPBF(2, C0, 4, DA_FILL(P1[10], P1[11], P1[12], P1[13], pw[3][0] = DA_PKW(P1, 8),  pw[3][1] = DA_PKW(P1, 10), pw[3])); \
    DA_VRD(7);                  DA_SBAR(); DA_GAPBF(3, C0, 6, DA_FILL(P1[14], P1[15], 0.f, 0.f,       pw[3][2] = DA_PKW(P1, 12), pw[3][3] = DA_PKW(P1, 14), pw[3])); \
    l += (!OPT && resc) ? sacc * fsc : sacc;                                                    \
    DA_VRD(8);                  DA_SBAR(); DA_GAPB(4, C0, 8); \
    DA_VRD(9);                  DA_SBAR(); DA_GAPB(5, C0, 10); \
    DA_VRD(10);                 DA_SBAR(); DA_GAPB(6, C0, 12); \
    DA_VRD(11);                 DA_SBAR(); DA_GAPB(7, C0, 14); \
    DA_VRD(12);                 DA_SBAR(); DA_GAPB(8, C1, 0); \
    DA_VRD(13);                 DA_SBAR(); DA_GAPB(9, C1, 2); \
    DA_VRD(14);                 DA_SBAR(); DA_GAPB(10, C1, 4); \
    DA_VRD(15);                 DA_SBAR(); DA_GAPB(11, C1, 6); \
    if (OPT && NEARN) { DA_TREV4(P0, 0, 0);  DA_TREV4(P0, 1, 32); }  DA_SBAR(); DA_GAPB(12, C1, 8); \
    if (GK) DA_DMA_K(t_ + 3, sl_cur);                                                           \
    if (OPT && NEARN) { DA_TREV4(P0, 2, 64); DA_TREV4(P0, 3, 96); }  DA_SBAR(); DA_GAPB(13, C1, 10); \
    if (GV) DA_DMA_V(t_ + 1, sl_next);                                                          \
    if (OPT && NEARN) { DA_TREV4(P1, 0, 128); DA_TREV4(P1, 1, 160); } DA_SBAR(); DA_GAPB(14, C1, 12); \
    if (OPT && NEARN) { DA_TREV4(P1, 2, 192); DA_TREV4(P1, 3, 224); } DA_SBAR(); DA_GAPB(15, C1, 14); \
    if (!OPT && NEARN) DA_TABINIT(P0, P1, t_ + 1); \
    } while (0)
#define DA_RESC() do { if (resc) { _Pragma("unroll") for (int d0 = 0; d0 < 4; ++d0) _Pragma("unroll") for (int r = 0; r < 16; ++r) o[d0][r] *= fsc; } } while (0)
#define DA_WAITB(N) asm volatile("s_waitcnt vmcnt(" #N ") lgkmcnt(0)\n\ts_barrier" ::: "memory")
#define DA_ROT() do { sl_prev = sl_cur; sl_cur = sl_next; sl_next = (sl_next == 2) ? 0 : sl_next + 1; } while (0)
#define DA_WAITS(NK, NV) do { if (wid < 4) DA_WAITB(NK); else DA_WAITB(NV); } while (0)
#define DA_ENDW(tt) do { if ((tt) + 3 < NT) { DA_WAITS(3, 2); } else if ((tt) + 2 < NT) { DA_WAITB(2); } else { DA_WAITB(0); } } while (0)

template <bool OPT>
__device__ __forceinline__ void pass(const Tensors& X, int b, int h, int c, const int q0, const int NT, LAS unsigned char* lds, float c31, const int wid, f32x16 (&o)[4], float& l_out) {
    const unsigned lds0 = (unsigned)(uintptr_t)lds;
    const LAS float* tb = (const LAS float*)(lds + LDS_BIAS); (void)tb;
    {
        int lane = (int)__builtin_amdgcn_mbcnt_hi(~0u, __builtin_amdgcn_mbcnt_lo(~0u, 0u)); asm volatile("" : "+v"(lane));
        const int r32 = lane & 31, hi = lane >> 5;
        const unsigned lane16 = (unsigned)lane * 16u;
        const int qabs = q0 + wid * 32 + r32;
        const LAS char* vp0 = (const LAS char*)lds + LDS_V + ((lane >> 4) & 1) * 32 + (lane & 3) * 8 + (4 * hi + ((lane & 15) >> 2)) * 64;
        const LAS char* kp0 = (const LAS char*)lds + LDS_K + hi * 2048 + r32 * 16;
        const LAS char* trev0 = (const LAS char*)lds + LDS_TREV + (r32 & 3) * (TAB_CL * 4) + 4 * (TAB_NR - (qabs - (r32 & 3) - 4 * hi + BIAS_GUARD));
        const int bhc = (b * 4 + h) * 2 + c;
        const unsigned char* Qw = (const unsigned char*)X.Qd + ((size_t)bhc * SEQ + q0 + wid * 32 + r32) * 64 + hi * 32;
        const char* Kt = (const char*)X.Kd + (size_t)bhc * NTILE * SLOT_K + wid * 1024;
        const char* Vt = (const char*)X.Vd + (size_t)(b * 4 + h) * NTILE * SLOT_V + wid * 1024;
#define DA_DMA_K(t, slot) do { if (wid < 4) glds16(Kt + (size_t)(t) * SLOT_K, lane16, (unsigned)__builtin_amdgcn_readfirstlane(lds0 + LDS_K + (slot) * SLOT_K + wid * 1024)); } while (0)
#define DA_DMA_V(t, slot) do { const unsigned sb_ = (unsigned)__builtin_amdgcn_readfirstlane(lds0 + LDS_V + (slot) * SLOT_V + wid * 1024); \
        glds16(Vt + (size_t)(t) * SLOT_V, lane16, sb_); glds16(Vt + (size_t)(t) * SLOT_V + 8192, lane16, sb_ + 8192); } while (0)
        DA_DMA_K(0, 0); DA_DMA_V(0, 0); DA_DMA_K(1, 1); DA_DMA_K(2, 2);
        const v8i_t qf = __builtin_shufflevector(*(const GAS v4i_t*)Qw, *(const GAS v4i_t*)(Qw + 16), 0, 1, 2, 3, 4, 5, 6, 7);
#pragma unroll
        for (int d0 = 0; d0 < 4; ++d0)
#pragma unroll
            for (int r = 0; r < 16; ++r) o[d0][r] = 0.f;
        float m = 0.f, l = 0.f, fsc = 1.f; bool resc = false; (void)fsc; (void)resc;
        f32x16 pA0, pA1, pB0, pB1, cinit; v8i_t kf0, kf1; s16x4 vl[5], vh[5]; v4u pw[4];
        int sl_prev = 0, sl_cur = 1, sl_next = 2;
        asm volatile("" :: "v"(qf));
        DA_WAITB(0);
        {   const LAS char* kp_ = kp0;
            kf0 = DA_K8(kp_, 0); kf1 = DA_K8(kp_, 1);
            if (DA_FAR(0)) {
#pragma unroll
                for (int r = 0; r < 16; ++r) { pA0[r] = c31; pA1[r] = c31; }
            } else DA_NEARINIT(pA0, pA1, 0);
            pA0 = DA_MFS(kf0, qf, pA0); pA1 = DA_MFS(kf1, qf, pA1);
            if (NT == 4) DA_MASK(pA0, pA1, 0);
            if (!OPT) m = rowmax(pA0, pA1);
#pragma unroll
            for (int r = 0; r < 16; ++r) { pA0[r] = __builtin_amdgcn_exp2f(pA0[r] - m); pA1[r] = __builtin_amdgcn_exp2f(pA1[r] - m); }
        }
        DA_WAITB(0);
        DA_DMA_K(3, 0); DA_DMA_V(1, 1);
        {   const LAS char* kp_ = kp0 + SLOT_K;
            kf0 = DA_K8(kp_, 0); kf1 = DA_K8(kp_, 1);
        }
        DA_WAITS(3, 2);
        {   const float cm = c31 - m;
#pragma unroll
            for (int r = 0; r < 16; ++r) cinit[r] = cm; }
        int t = 1;
        for (; t + 5 < NT && DA_FAR(t + 1); t += 2) {
            DA_STEP(OPT, pB0, pB1, pA0, pA1, t, false, true, true, true, true, false);     DA_WAITS(3, 2); DA_RESC(); DA_ROT();
            DA_STEP(OPT, pA0, pA1, pB0, pB1, t + 1, false, true, true, true, true, false); DA_WAITS(3, 2); DA_RESC(); DA_ROT();
        }
        DA_NEARINIT(pB0, pB1, t);
        for (; t + 5 < NT; t += 2) {
            DA_STEP(OPT, pB0, pB1, pA0, pA1, t, false, true, true, true, false, true);     DA_WAITS(3, 2); DA_RESC(); DA_ROT();
            DA_STEP(OPT, pA0, pA1, pB0, pB1, t + 1, false, true, true, true, false, true); DA_WAITS(3, 2); DA_RESC(); DA_ROT();
        }
        for (; t + 1 < NT; t += 2) {
            DA_STEP(OPT, pB0, pB1, pA0, pA1, t, true, (t + 3 < NT), (t + 1 < NT), (t + 1 < NT), false, true);         DA_ENDW(t);     DA_RESC(); DA_ROT();
            DA_STEP(OPT, pA0, pA1, pB0, pB1, t + 1, true, (t + 4 < NT), (t + 2 < NT), (t + 2 < NT), false, true);     DA_ENDW(t + 1); DA_RESC(); DA_ROT();
        }
        DA_STEP(OPT, pB0, pB1, pA0, pA1, NT - 1, true, false, false, false, false, false); DA_RESC();
        {   float sacc = pB0[0] + pB0[1];
#pragma unroll
            for (int r = 2; r < 16; ++r) sacc += pB0[r];
#pragma unroll
            for (int r = 0; r < 16; ++r) sacc += pB1[r];
            l += sacc;
            pw[0] = (v4u){DA_PKW(pB0, 0), DA_PKW(pB0, 2), DA_PKW(pB0, 4), DA_PKW(pB0, 6)}; pw[1] = (v4u){DA_PKW(pB0, 8), DA_PKW(pB0, 10), DA_PKW(pB0, 12), DA_PKW(pB0, 14)};
            pw[2] = (v4u){DA_PKW(pB1, 0), DA_PKW(pB1, 2), DA_PKW(pB1, 4), DA_PKW(pB1, 6)}; pw[3] = (v4u){DA_PKW(pB1, 8), DA_PKW(pB1, 10), DA_PKW(pB1, 12), DA_PKW(pB1, 14)};
            const LAS char* vb_ = vp0 + sl_cur * SLOT_V;
#pragma unroll
            for (int d0 = 0; d0 < 4; ++d0) {
#pragma unroll
                for (int ks = 0; ks < 4; ++ks) { const s16x4 lo_ = vtr(vb_ + d0 * 4096 + ks * 1024), hh_ = vtr(vb_ + d0 * 4096 + ks * 1024 + 512);
                    const bf16x8 vf_ = (bf16x8){lo_[0], lo_[1], lo_[2], lo_[3], hh_[0], hh_[1], hh_[2], hh_[3]};
                    o[d0] = DA_MFMA(vf_, DA_PAF(ks), o[d0]); }
                DA_SBAR(); }
        }
#undef DA_DMA_K
#undef DA_DMA_V
        l_out = l;
    }
}

__device__ __forceinline__ void unit(const Tensors& X, int b, int h, int qb, LAS unsigned char* lds, int wgslot, float lam, float c31, const int wid  ) {
    const int q0 = qb * 256, NT = 4 * (qb + 1);
    for (int c = 0; c < 2; ++c) {
        int lane = (int)__builtin_amdgcn_mbcnt_hi(~0u, __builtin_amdgcn_mbcnt_lo(~0u, 0u)); asm volatile("" : "+v"(lane));
        LAS unsigned* flag = (LAS unsigned*)(lds + LDS_FLAG);
        if (wid == 0 && lane == 0) *flag = 0u;
        f32x16 o[4]; float l;
        pass<true>(X, b, h, c, q0, NT, lds, c31, wid, o, l);
        { auto rr = __builtin_amdgcn_permlane32_swap(__float_as_uint(l), __float_as_uint(l), false, false); l = __uint_as_float(rr[0]) + __uint_as_float(rr[1]); }
        if (!__all(l > 1e-30f && l < 1e30f)) *flag = 1u;
        asm volatile("s_waitcnt vmcnt(0) lgkmcnt(0)\n\ts_barrier" ::: "memory");
        if (__builtin_expect(*(volatile LAS unsigned*)flag != 0u, 0)) {
            pass<false>(X, b, h, c, q0, NT, lds, c31, wid, o, l);
            { auto rr = __builtin_amdgcn_permlane32_swap(__float_as_uint(l), __float_as_uint(l), false, false); l = __uint_as_float(rr[0]) + __uint_as_float(rr[1]); }
        }
        const float inv = 1.f / l;
        int lane_e = lane; asm volatile("" : "+v"(lane_e));
        GAS unsigned* stg = (GAS unsigned*)((unsigned*)X.stash + ((size_t)(wgslot * 8 + wid) * 32) * 64 + lane_e);
        if (c == 0) {
#pragma unroll
            for (int d0 = 0; d0 < 4; ++d0)
#pragma unroll
                for (int r = 0; r < 16; r += 2) stg[(d0 * 8 + (r >> 1)) * 64] = cvtpk(o[d0][r] * inv, o[d0][r + 1] * inv);
        } else {
            float ss = 0.f;
#pragma unroll
            for (int d0 = 0; d0 < 4; ++d0)
#pragma unroll
                for (int r = 0; r < 16; r += 2) { const unsigned w1 = stg[(d0 * 8 + (r >> 1)) * 64]; const float dv0 = bf_lo(w1) - lam * (o[d0][r] * inv), dv1 = bf_hi(w1) - lam * (o[d0][r + 1] * inv);
                    o[d0][r] = dv0; o[d0][r + 1] = dv1; ss += dv0 * dv0 + dv1 * dv1; if (r == 14) asm volatile("" ::: "memory"); }
            { auto rr = __builtin_amdgcn_permlane32_swap(__float_as_uint(ss), __float_as_uint(ss), false, false); ss = __uint_as_float(rr[0]) + __uint_as_float(rr[1]); }
            const float rn = __builtin_amdgcn_rsqf(ss * (1.f / 128.f) + SUBLN_EPS) * (1.f - LAM_INIT);
            const int hi_e = lane_e >> 5, qabs_e = q0 + wid * 32 + (lane_e & 31);
            bf16* yrow = X.ya + ((size_t)b * SEQ + qabs_e) * 512 + h * 128 + 4 * hi_e; const float* sg = X.subg + 4 * hi_e;
#pragma unroll
            for (int d0 = 0; d0 < 4; ++d0)
#pragma unroll
                for (int r4 = 0; r4 < 4; ++r4) {
                    const int dd = 32 * d0 + 8 * r4; const f32x4 g = *(const GAS f32x4*)(sg + dd);
                    v2u w; w.x = pk2(o[d0][4 * r4] * rn * g[0], o[d0][4 * r4 + 1] * rn * g[1]); w.y = pk2(o[d0][4 * r4 + 2] * rn * g[2], o[d0][4 * r4 + 3] * rn * g[3]);
                    *(GAS v2u*)(yrow + dd) = w;
                }
        }
        asm volatile("s_waitcnt vmcnt(0) lgkmcnt(0)\n\ts_barrier" ::: "memory");
    }
}
#undef DA_STEP
#undef DA_GAPA
#undef DA_GAPB
#undef DA_VRD
#undef DA_VFR
#undef DA_VOFF
#undef DA_PAF
#undef DA_PKW
#undef DA_FAR
#undef DA_MASK
#undef DA_TREV4
#undef DA_TREVINIT
#undef DA_NEARINIT
#undef DA_TABINIT
#undef DA_RESC
#undef DA_WAITB
#undef DA_ROT
#undef DA_ENDW
#undef DA_WAITS
#undef DA_MFS
#undef DA_K8
#undef DA_GAPBF
#undef DA_FILL
#undef DA_MX3
#undef DA_MFMA
#undef DA_PIN
#undef DA_SBAR
}
namespace dil {
constexpr int BT = 1152, BT0 = 512;
constexpr int LDS_VST = 0, LDS_BL = 32768, LDS_END = LDS_BL + 3 * BT * 4;
constexpr float THR = 8.f;
struct Tensors { const bf16* LQ; const bf16* LK; const bf16* LV; bf16* yb; };
typedef short v4i16_t __attribute__((ext_vector_type(4)));
__device__ __forceinline__ s16x4 vtr(const LAS unsigned char* p) { return __builtin_bit_cast(s16x4, __builtin_amdgcn_ds_read_tr16_b64_v4i16((LAS v4i16_t*)p)); }

template <int G_, int QS_> __device__ __forceinline__ void group(const Tensors& X, size_t rowb, int h, int P0, int r, LAS unsigned char* vst, const LAS float* blg, int lane, f32x16 (&o)[2], float& m, float& l) {
    constexpr int DL = (G_ == 0) ? 1 : (G_ == 1) ? 4 : 16, MG = QS_ / DL, NKB = (31 * MG + 128) / 32 + 1;
    static_assert(QS_ % DL == 0, "query stride must be a multiple of the dilation");
    const int i = lane & 31, hi = lane >> 5;
    const int colb = G_ * 256 + h * 64;
    bf16x8 qr[4];
    { const bf16* qp = X.LQ + (rowb + P0 + r + QS_ * i) * 768 + colb + hi * 8;
#pragma unroll
      for (int d0 = 0; d0 < 4; ++d0) qr[d0] = *(const GAS bf16x8*)(qp + 16 * d0); }
    const int kpos0 = P0 + r - 128 * DL;
    const LAS unsigned char* vrd = vst + ((lane >> 4) & 1) * 32 + (lane & 3) * 8 + (4 * hi + ((lane & 15) >> 2)) * 64;
#define DIL_LOAD(KF, VR, KB) do { \
        { int kpos_ = kpos0 + (32 * (KB) + i) * DL; kpos_ = kpos_ < 0 ? 0 : (kpos_ > SEQ - 1 ? SEQ - 1 : kpos_); const bf16* kp_ = X.LK + (rowb + kpos_) * 768 + colb + hi * 8; \
          _Pragma("unroll") for (int d0 = 0; d0 < 4; ++d0) KF[d0] = *(const GAS bf16x8*)(kp_ + 16 * d0); } \
        _Pragma("unroll") for (int t = 0; t < 4; ++t) { const int qd = lane + 64 * t, key = qd >> 3, ch = qd & 7; int vpos_ = kpos0 + (32 * (KB) + key) * DL; vpos_ = vpos_ < 0 ? 0 : (vpos_ > SEQ - 1 ? SEQ - 1 : vpos_); \
            VR[t] = *(const GAS v4u*)(X.LV + (rowb + vpos_) * 768 + colb + ch * 8); } } while (0)
    bf16x8 kfn[4]; v4u vregn[4];
    DIL_LOAD(kfn, vregn, 0);
#pragma unroll 1
    for (int kb = 0; kb < NKB; ++kb) {
        bf16x8 kf[4]; v4u vreg[4];
#pragma unroll
        for (int d0 = 0; d0 < 4; ++d0) { kf[d0] = kfn[d0]; vreg[d0] = vregn[d0]; }
        if (kb + 1 < NKB) DIL_LOAD(kfn, vregn, kb + 1);
        const int jb = i * MG + 128 - 32 * kb - 4 * hi;
        f32x16 p;
#pragma unroll
        for (int rr = 0; rr < 16; ++rr) p[rr] = blg[jb - ((rr & 3) + 8 * (rr >> 2)) + BT0];
#pragma unroll
        for (int d0 = 0; d0 < 4; ++d0) p = __builtin_amdgcn_mfma_f32_32x32x16_bf16(kf[d0], qr[d0], p, 0, 0, 0);
        const int cb = 32 * kb + 4 * hi;
#pragma unroll
        for (int rr = 0; rr < 16; ++rr) { const int o_ = (rr & 3) + 8 * (rr >> 2); if ((unsigned)(jb - o_) > 128u || kpos0 + (cb + o_) * DL < 0) p[rr] = -3e38f; }
        float rm = p[0];
#pragma unroll
        for (int rr = 1; rr < 16; ++rr) rm = fmaxf(rm, p[rr]);
        { auto sw = __builtin_amdgcn_permlane32_swap(__float_as_uint(rm), __float_as_uint(rm), false, false); rm = fmaxf(__uint_as_float(sw[0]), __uint_as_float(sw[1])); }
        if (__any(rm > m + THR)) {
            const float mn = fmaxf(m, rm), f = __builtin_amdgcn_exp2f(m - mn);
#pragma unroll
            for (int d0 = 0; d0 < 2; ++d0)
#pragma unroll
                for (int rr = 0; rr < 16; ++rr) o[d0][rr] *= f;
            l *= f; m = mn;
        }
        float ls = 0.f;
#pragma unroll
        for (int rr = 0; rr < 16; ++rr) { p[rr] = __builtin_amdgcn_exp2f(p[rr] - m); ls += p[rr]; }
        l += ls;
        bf16x8 pw[2];
        { v4u w;
          w.x = cvtpk(p[0], p[1]); w.y = cvtpk(p[2], p[3]); w.z = cvtpk(p[4], p[5]); w.w = cvtpk(p[6], p[7]); pw[0] = __builtin_bit_cast(bf16x8, w);
          w.x = cvtpk(p[8], p[9]); w.y = cvtpk(p[10], p[11]); w.z = cvtpk(p[12], p[13]); w.w = cvtpk(p[14], p[15]); pw[1] = __builtin_bit_cast(bf16x8, w); }
#pragma unroll
        for (int t = 0; t < 4; ++t) { const int qd = lane + 64 * t, key = qd >> 3, ch = qd & 7;
            *(LAS v4u*)(vst + ((ch >> 2) * 2 + (key >> 4)) * 1024 + (key & 15) * 64 + (ch & 3) * 16) = vreg[t]; }
        asm volatile("s_waitcnt lgkmcnt(0)" ::: "memory");
#pragma unroll
        for (int d0 = 0; d0 < 2; ++d0)
#pragma unroll
            for (int ks = 0; ks < 2; ++ks) {
                const s16x4 lo = vtr(vrd + (d0 * 2 + ks) * 1024), hh = vtr(vrd + (d0 * 2 + ks) * 1024 + 512);
                const bf16x8 vf = (bf16x8){lo[0], lo[1], lo[2], lo[3], hh[0], hh[1], hh[2], hh[3]};
                o[d0] = __builtin_amdgcn_mfma_f32_32x32x16_bf16(vf, pw[ks], o[d0], 0, 0, 0);
            }
        asm volatile("s_waitcnt lgkmcnt(0)" ::: "memory");
    }
#undef DIL_LOAD
}
__device__ __forceinline__ void wave_tile_g0(const Tensors& X, float* lse0, int b, int h, int P0, LAS unsigned char* vst, const LAS float* bl, int lane) {
    const size_t rowb = (size_t)b * SEQ;
    f32x16 o[2];
#pragma unroll
    for (int d0 = 0; d0 < 2; ++d0)
#pragma unroll
        for (int rr = 0; rr < 16; ++rr) o[d0][rr] = 0.f;
    float m = -1e30f, l = 0.f;
    group<0, 1>(X, rowb, h, P0, 0, vst, bl, lane, o, m, l);
    { auto sw = __builtin_amdgcn_permlane32_swap(__float_as_uint(l), __float_as_uint(l), false, false); l = __uint_as_float(sw[0]) + __uint_as_float(sw[1]); }
    const float inv = 1.f / l; const int i = lane & 31, hi = lane >> 5;
    bf16* yrow = X.yb + (rowb + P0 + i) * 256 + h * 64 + 4 * hi;
#pragma unroll
    for (int d0 = 0; d0 < 2; ++d0)
#pragma unroll
        for (int r4 = 0; r4 < 4; ++r4) { v2u w; w.x = pk2(o[d0][4 * r4] * inv, o[d0][4 * r4 + 1] * inv); w.y = pk2(o[d0][4 * r4 + 2] * inv, o[d0][4 * r4 + 3] * inv); *(GAS v2u*)(yrow + 32 * d0 + 8 * r4) = w; }
    if (hi == 0) ((GAS float*)lse0)[(rowb + P0 + i) * 4 + h] = m + __builtin_amdgcn_logf(l);
}
__device__ __forceinline__ void wave_tile(const Tensors& X, const float* lse0, int b, int h, int P0, int r, LAS unsigned char* vst, const LAS float* bl, int lane) {
    const size_t rowb = (size_t)b * SEQ;
    f32x16 o[2];
#pragma unroll
    for (int d0 = 0; d0 < 2; ++d0)
#pragma unroll
        for (int rr = 0; rr < 16; ++rr) o[d0][rr] = 0.f;
    float m = -1e30f, l = 0.f;
    group<1, 16>(X, rowb, h, P0, r, vst, bl + BT, lane, o, m, l);
    group<2, 16>(X, rowb, h, P0, r, vst, bl + 2 * BT, lane, o, m, l);
    { auto sw = __builtin_amdgcn_permlane32_swap(__float_as_uint(l), __float_as_uint(l), false, false); l = __uint_as_float(sw[0]) + __uint_as_float(sw[1]); }
    const int i = lane & 31, hi = lane >> 5;
    const float w0 = __builtin_amdgcn_exp2f(((const GAS float*)lse0)[(rowb + P0 + r + 16 * i) * 4 + h] - m);
    const float inv = 1.f / (l + w0);
    bf16* yrow = X.yb + (rowb + P0 + r + 16 * i) * 256 + h * 64 + 4 * hi;
#pragma unroll
    for (int d0 = 0; d0 < 2; ++d0)
#pragma unroll
        for (int r4 = 0; r4 < 4; ++r4) { const v2u g0 = *(const GAS v2u*)(yrow + 32 * d0 + 8 * r4);
            v2u w; w.x = pk2((o[d0][4 * r4] + w0 * bf_lo(g0.x)) * inv, (o[d0][4 * r4 + 1] + w0 * bf_hi(g0.x)) * inv); w.y = pk2((o[d0][4 * r4 + 2] + w0 * bf_lo(g0.y)) * inv, (o[d0][4 * r4 + 3] + w0 * bf_hi(g0.y)) * inv);
            *(GAS v2u*)(yrow + 32 * d0 + 8 * r4) = w; }
}
}
__device__ __forceinline__ void p0_transpose_item(const float* W, int K, int N, bf16* WT, LAS float* scr, int item, int lane) {
    const int nblk = N / 32, kb = item / nblk, nb = item % nblk, k0 = 64 * kb, n0 = 32 * nb;
#pragma unroll 8
    for (int i = 0; i < 32; ++i) { const int kk = 2 * i + (lane >> 5); scr[kk * 33 + (lane & 31)] = W[(size_t)(k0 + kk) * N + n0 + (lane & 31)]; }
    LDS_WAIT(); asm volatile("" ::: "memory");
    const int c = lane & 7;
#pragma unroll
    for (int j = 0; j < 4; ++j) { const int n = (lane >> 3) + 8 * j; const LAS float* s = scr + (8 * c) * 33 + n;
        v4u o; o.x = pk2(s[0 * 33], s[1 * 33]); o.y = pk2(s[2 * 33], s[3 * 33]); o.z = pk2(s[4 * 33], s[5 * 33]); o.w = pk2(s[6 * 33], s[7 * 33]);
        *(v4u*)(WT + (size_t)(n0 + n) * K + k0 + 8 * c) = o; }
    LDS_WAIT(); asm volatile("" ::: "memory");
}
__device__ __forceinline__ void cast_bf16(const float* src, bf16* dst, size_t n8, size_t gtid, size_t gthreads) {
    for (size_t i = gtid; i < n8; i += gthreads) { const f32x4 a = *(const f32x4*)(src + i * 8), b = *(const f32x4*)(src + i * 8 + 4);
        v4u o; o.x = pk2(a[0], a[1]); o.y = pk2(a[2], a[3]); o.z = pk2(b[0], b[1]); o.w = pk2(b[2], b[3]); *(v4u*)(dst + i * 8) = o; }
}

struct Args { const float* in[16]; float* out; unsigned char* ws; int ph_lo, ph_hi; };
enum { I_X = 0, I_WIN, I_DLAM, I_SUBG, I_WBD, I_WBL, I_WO, I_LN1G, I_LN1B, I_PWQ, I_PKEYS, I_PU, I_PV, I_LN2G, I_LN2B, I_RELB };

__device__ __forceinline__ void p0_prologue(const Args& A, LAS unsigned char* lds, int vcu, int G, int wave, int lane) {
    unsigned char* ws = A.ws;
    const int gw = vcu * NWAVES + wave, NGW = G * NWAVES;
    const size_t gtid = (size_t)gw * 64 + lane, gthreads = (size_t)NGW * 64;
    LAS float* scr = (LAS float*)(lds + wave * 16384);
    constexpr int I_IN = (D / 64) * (INC / 32), I_BD = (512 / 64) * (D / 32), I_BL = (256 / 64) * (D / 32), I_O = (D / 64) * (D / 32);
    for (int it0 = gw; it0 < (I_IN + I_BD + I_BL + I_O) * NREP(32); it0 += NGW) {
        int r = it0 % (I_IN + I_BD + I_BL + I_O);
        if (r < I_IN) { p0_transpose_item(A.in[I_WIN], D, INC, (bf16*)(ws + WS_WIN), scr, r, lane); continue; } r -= I_IN;
        if (r < I_BD) { p0_transpose_item(A.in[I_WBD], 512, D, (bf16*)(ws + WS_WBD), scr, r, lane); continue; } r -= I_BD;
        if (r < I_BL) { p0_transpose_item(A.in[I_WBL], 256, D, (bf16*)(ws + WS_WBL), scr, r, lane); continue; } r -= I_BL;
        p0_transpose_item(A.in[I_WO], D, D, (bf16*)(ws + WS_WO), scr, r, lane);
    }
    for (int rep_ = 0; rep_ < NREP(31); ++rep_) cast_bf16(A.in[I_X], (bf16*)(ws + WS_A), (size_t)T * D / 8, gtid, gthreads);
    { const float* wq = A.in[I_PWQ]; const float* keys = A.in[I_PKEYS]; bf16* wp = (bf16*)(ws + WS_WP);
      for (int it0 = gw; it0 < 1024 * NREP(30); it0 += NGW) { const int it = it0 & 1023;
          const int hc = it >> 6, jb = (it >> 2) & 15, nq = it & 3, j = jb * 64 + lane;
          const f32x4* wr_ = (const f32x4*)(wq + (size_t)j * 2048 + hc * 128);
          f32x4 w[32];
#pragma unroll
          for (int d = 0; d < 32; ++d) w[d] = wr_[d];
#pragma unroll 1
          for (int n = nq * 32; n < nq * 32 + 32; ++n) {
              const f32x4* kr = (const f32x4*)(keys + (size_t)(hc * 128 + n) * 128);
              float a0 = 0.f, a1 = 0.f, a2 = 0.f, a3 = 0.f;
#pragma unroll
              for (int d = 0; d < 32; ++d) { const f32x4 k = kr[d]; a0 += w[d][0] * k[0]; a1 += w[d][1] * k[1]; a2 += w[d][2] * k[2]; a3 += w[d][3] * k[3]; }
              wp[(size_t)(hc * 128 + n) * 1024 + j] = (bf16)f2bf((a0 + a1) + (a2 + a3));
          }
      } }
    { const float* relb = A.in[I_RELB]; float* bd = (float*)(ws + WS_BIASD); float* bl = (float*)(ws + WS_BIASL);
      for (size_t i = gtid; i < 4 * BIAS_TAB; i += gthreads) { const int h = (int)(i / BIAS_TAB), dist = (int)(i % BIAS_TAB) - BIAS_GUARD; bd[i] = dist < 0 ? 0.f : relb[rel_bucket(dist) * 16 + h] * LOG2E; }
      for (size_t i = gtid; i < 12 * 132; i += gthreads) { const int gh = (int)(i / 132), j = (int)(i % 132), g = gh >> 2; const int dl = (g == 0) ? 1 : (g == 1) ? 4 : 16;
          bl[i] = relb[rel_bucket((j > 128 ? 128 : j) * dl) * 16 + 4 + gh] * LOG2E; } }
}

__device__ __forceinline__ void p5_ln1(const Args& A, int vcu, int G, int wave, int lane) {
    unsigned char* ws = A.ws;
    const int gw = vcu * NWAVES + wave, NGW = G * NWAVES;
    const float* R = (const float*)(ws + WS_R); bf16* x1b = (bf16*)(ws + WS_A);
    const float* gam = A.in[I_LN1G]; const float* bet = A.in[I_LN1B];
    f32x4 gv[4], bv[4];
#pragma unroll
    for (int j = 0; j < 4; ++j) { gv[j] = *(const f32x4*)(gam + 256 * j + 4 * lane); bv[j] = *(const f32x4*)(bet + 256 * j + 4 * lane); }
    f32x4 nx[4];
    if (gw < T) {
#pragma unroll
        for (int j = 0; j < 4; ++j) nx[j] = ((const f32x4*)(R + (size_t)gw * D) + lane)[64 * j]; }
#pragma unroll 1
    for (int mrow = gw; mrow < T; mrow += NGW) {
        f32x4 v[4]; float s = 0.f;
#pragma unroll
        for (int j = 0; j < 4; ++j) { v[j] = nx[j]; s += (v[j][0] + v[j][1]) + (v[j][2] + v[j][3]); }
        if (mrow + NGW < T) {
#pragma unroll
            for (int j = 0; j < 4; ++j) nx[j] = ((const f32x4*)(R + (size_t)(mrow + NGW) * D) + lane)[64 * j]; }
        const float mean = wave_sum(s) * (1.f / D); float s2 = 0.f;
#pragma unroll
        for (int j = 0; j < 4; ++j) { v[j] = v[j] - mean; s2 += (v[j][0] * v[j][0] + v[j][1] * v[j][1]) + (v[j][2] * v[j][2] + v[j][3] * v[j][3]); }
        const float rstd = __builtin_amdgcn_rsqf(wave_sum(s2) * (1.f / D) + LN_EPS);
        v2u* brow = (v2u*)(x1b + (size_t)mrow * D) + lane;
#pragma unroll
        for (int j = 0; j < 4; ++j) { const f32x4 y = v[j] * rstd * gv[j] + bv[j]; v2u w; w.x = pk2(y[0], y[1]); w.y = pk2(y[2], y[3]); brow[64 * j] = w; }
    }
}
namespace peer {
__device__ __forceinline__ int mono(float v) { const int b = __float_as_int(v); return b ^ ((b >> 31) & 0x7fffffff); }
__device__ __forceinline__ float unmono(int k) { return __int_as_float(k ^ ((k >> 31) & 0x7fffffff)); }
__device__ __forceinline__ int med3i(int a, int b, int c) { int r; asm("v_med3_i32 %0, %1, %2, %3" : "=v"(r) : "v"(a), "v"(b), "v"(c)); return r; }
#define PEER_INS16(a, x) do { _Pragma("unroll") for (int k_ = 15; k_ >= 1; --k_) a[k_] = med3i(a[k_ - 1], a[k_], (x)); a[0] = max(a[0], (x)); } while (0)
__device__ __forceinline__ unsigned byte_sel(const unsigned (&p)[4], int i) { const int w = i >> 2; const unsigned x = (w == 0) ? p[0] : (w == 1) ? p[1] : (w == 2) ? p[2] : p[3]; return (x >> ((i & 3) * 8)) & 0xffu; }
__device__ __forceinline__ float gelu_erf(float v) { return 0.5f * v * (1.f + erff(v * 0.7071067811865476f)); }

__device__ __forceinline__ void select(const float* ST, v2u* sel, int tok, int head) {
    int a0[16], a1[16];
#pragma unroll
    for (int k = 0; k < 16; ++k) { a0[k] = (int)0x80000000; a1[k] = (int)0x80000000; }
    const GAS float* s0 = (const GAS float*)ST + (size_t)(head * 256) * T + tok; const GAS float* s1 = s0 + (size_t)128 * T;
    float c0[8], c1[8];
#pragma unroll
    for (int i = 0; i < 8; ++i) { c0[i] = s0[(size_t)i * T]; c1[i] = s1[(size_t)i * T]; }
#pragma unroll 1
    for (int n = 0; n < 128; n += 8) {
        float x0[8], x1[8];
#pragma unroll
        for (int i = 0; i < 8; ++i) { x0[i] = c0[i]; x1[i] = c1[i]; }
        if (n + 8 < 128) {
#pragma unroll
            for (int i = 0; i < 8; ++i) { c0[i] = s0[(size_t)(n + 8 + i) * T]; c1[i] = s1[(size_t)(n + 8 + i) * T]; }
        }
#pragma unroll
        for (int i = 0; i < 8; ++i) { const int k0 = (mono(x0[i]) & ~127) | (127 - (n + i)), k1 = (mono(x1[i]) & ~127) | (127 - (n + i)); PEER_INS16(a0, k0); PEER_INS16(a1, k1); }
    }
    float v0[16], v1[16]; unsigned i0p[4] = {0u, 0u, 0u, 0u}, i1p[4] = {0u, 0u, 0u, 0u};
#pragma unroll
    for (int k = 0; k < 16; ++k) { v0[k] = unmono((a0[k] & ~127) | 64); v1[k] = unmono((a1[k] & ~127) | 64);
        i0p[k >> 2] |= (unsigned)(127 - (a0[k] & 127)) << (8 * (k & 3)); i1p[k >> 2] |= (unsigned)(127 - (a1[k] & 127)) << (8 * (k & 3)); }
    int cd[16];
#pragma unroll
    for (int k = 0; k < 16; ++k) cd[k] = (int)0x80000000;
#pragma unroll
    for (int i = 0; i < 16; ++i)
#pragma unroll
        for (int j = 0; j < 16; ++j)
            if ((i + 1) * (j + 1) <= 16) { const int k = (mono(v0[i] + v1[j]) & ~255) | (255 - (i * 16 + j)); PEER_INS16(cd, k); }
    float sv[16], ex[16], sum = 0.f; unsigned eid[16];
#pragma unroll
    for (int k = 0; k < 16; ++k) { const int code = 255 - (cd[k] & 255); eid[k] = byte_sel(i0p, code >> 4) * 128u + byte_sel(i1p, code & 15); sv[k] = unmono((cd[k] & ~255) | 128); }
#pragma unroll
    for (int k = 0; k < 16; ++k) { ex[k] = __expf(sv[k] - sv[0]); sum += ex[k]; }
    const float rs = 1.f / sum;
    GAS v4u* dst = (GAS v4u*)(sel + ((size_t)tok * 8 + head) * 16);
#pragma unroll
    for (int k = 0; k < 8; ++k) { v4u w; w.x = eid[2 * k]; w.y = __float_as_uint(ex[2 * k] * rs); w.z = eid[2 * k + 1]; w.w = __float_as_uint(ex[2 * k + 1] * rs); dst[k] = w; }
}

typedef float f32x2w __attribute__((ext_vector_type(2)));
struct G4 { const unsigned char* U8; const unsigned char* V8; const float* isu; const float* isv; };
__device__ __forceinline__ v2u peer_ec(const v2u lo, const v2u hi, int c) { const unsigned mk = (c < 4) ? 0xffffffffu : 0u; v2u r; r.x = (lo.x & mk) | (hi.x & ~mk); r.y = (lo.y & mk) | (hi.y & ~mk); return r; }
#define PEER_EC(en, c) peer_ec((en)[0], (en)[1], (c))
__device__ __forceinline__ void a_load(v4u (&uu)[16], const v2u ec, int c, const unsigned char* U8, int lane) {
#pragma unroll
    for (int j = 0; j < 16; ++j) { const unsigned e = __builtin_amdgcn_readlane(ec.x, 16 * (c & 3) + j); uu[j] = *(const GAS v4u*)(U8 + (size_t)e * D + 16 * lane); }
}
__device__ __forceinline__ void a_step(const v4u (&uu)[16], v2u (&en)[2], int c, const LAS f32x4* xl, const G4& T, int lane) {
    const v2u ec = PEER_EC(en, c);
    const int ls = 16 * (c & 3) + (lane >> 2);
    const unsigned eq = (unsigned)__shfl((int)ec.x, ls); const float gq = __uint_as_float((unsigned)__shfl((int)ec.y, ls));
    const float su = ((const GAS float*)T.isu)[eq], sv = ((const GAS float*)T.isv)[eq];
    f32x4 xv[4];
#pragma unroll
    for (int q = 0; q < 4; ++q) xv[q] = xl[q * 64];
    float part[16];
#pragma unroll
    for (int j = 0; j < 16; ++j) { f32x2w d = {0.f, 0.f};
#pragma unroll
        for (int q = 0; q < 4; ++q) { const unsigned w = uu[j][q]; const f32x2w a = __builtin_amdgcn_cvt_pk_f32_fp8((int)w, false), b = __builtin_amdgcn_cvt_pk_f32_fp8((int)w, true);
            d += (f32x2w){xv[q][0], xv[q][1]} * a; d += (f32x2w){xv[q][2], xv[q][3]} * b; }
        part[j] = d[0] + d[1]; }
    float r8[8], r4[4], r2[2], r1;
#pragma unroll
    for (int i = 0; i < 8; ++i) { auto sw = __builtin_amdgcn_permlane32_swap(__float_as_uint(part[i]), __float_as_uint(part[i + 8]), false, false); r8[i] = __uint_as_float(sw[0]) + __uint_as_float(sw[1]); }
#pragma unroll
    for (int i = 0; i < 4; ++i) { auto sw = __builtin_amdgcn_permlane16_swap(__float_as_uint(r8[i]), __float_as_uint(r8[i + 4]), false, false); r4[i] = __uint_as_float(sw[0]) + __uint_as_float(sw[1]); }
#pragma unroll
    for (int i = 0; i < 2; ++i) { const bool up = (lane & 8) != 0; const float send = up ? r4[i] : r4[i + 2], keep = up ? r4[i + 2] : r4[i]; r2[i] = keep + __shfl_xor(send, 8); }
    { const bool up = (lane & 4) != 0; const float send = up ? r2[0] : r2[1], keep = up ? r2[1] : r2[0]; r1 = keep + __shfl_xor(send, 4); }
    r1 += __shfl_xor(r1, 2); r1 += __shfl_xor(r1, 1);
    const float wgt = gq * gelu_erf(r1 * su) * sv;
    const int rel = lane - 16 * (c & 3);
    const float wv = __shfl(wgt, 4 * (rel & 15));
    const bool mine = (rel >= 0) && (rel < 16);
    const bool lo_ = mine && (c < 4), hi_ = mine && (c >= 4);
    en[0].y = lo_ ? __float_as_uint(wv) : en[0].y; en[1].y = hi_ ? __float_as_uint(wv) : en[1].y;
}
__device__ __forceinline__ void b_load8(v4u (&vv)[8], const v2u ec, int c, int h8, const unsigned char* V8, int lane) {
#pragma unroll
    for (int j = 0; j < 8; ++j) { const unsigned e = __builtin_amdgcn_readlane(ec.x, 16 * (c & 3) + 8 * h8 + j); vv[j] = *(const GAS v4u*)(V8 + (size_t)e * D + 16 * lane); }
}
__device__ __forceinline__ void b_step8(const v4u (&vv)[8], const v2u ec, int c, int h8, f32x2w (&acc)[8]) {
#pragma unroll
    for (int j = 0; j < 8; ++j) { const float w = __uint_as_float(__builtin_amdgcn_readlane(ec.y, 16 * (c & 3) + 8 * h8 + j)); const f32x2w w2 = {w, w};
#pragma unroll
        for (int q = 0; q < 4; ++q) { const unsigned x = vv[j][q]; const f32x2w a = __builtin_amdgcn_cvt_pk_f32_fp8((int)x, false), b = __builtin_amdgcn_cvt_pk_f32_fp8((int)x, true);
            acc[2 * q] += w2 * a; acc[2 * q + 1] += w2 * b; } }
}
__device__ __forceinline__ void b_load(v4u (&vv)[16], const v2u ec, int c, const unsigned char* V8, int lane) {
#pragma unroll
    for (int j = 0; j < 16; ++j) { const unsigned e = __builtin_amdgcn_readlane(ec.x, 16 * (c & 3) + j); vv[j] = *(const GAS v4u*)(V8 + (size_t)e * D + 16 * lane); }
}
__device__ __forceinline__ void b_step(const v4u (&vv)[16], const v2u ec, int c, f32x2w (&acc)[8]) {
#pragma unroll
    for (int j = 0; j < 16; ++j) { const float w = __uint_as_float(__builtin_amdgcn_readlane(ec.y, 16 * (c & 3) + j)); const f32x2w w2 = {w, w};
#pragma unroll
        for (int q = 0; q < 4; ++q) { const unsigned x = vv[j][q]; const f32x2w a = __builtin_amdgcn_cvt_pk_f32_fp8((int)x, false), b = __builtin_amdgcn_cvt_pk_f32_fp8((int)x, true);
            acc[2 * q] += w2 * a; acc[2 * q + 1] += w2 * b; } }
}
#define PEER_ROWLD(buf, j, ec, c, TAB) do { const unsigned e_ = __builtin_amdgcn_readlane((ec).x, 16 * ((c) & 3) + (j)); buf[j] = *(const GAS v4u*)((TAB) + (size_t)e_ * D + 16 * lane); } while (0)
template <bool NXT>
__device__ __forceinline__ void a_step_p(v4u (&uu)[16], v2u (&en)[2], int c, const int (&xq)[4], const float xis, const G4& T, int lane, const v2u ecn, int cn) {
    const v2u ec = PEER_EC(en, c);
    const int ls = 16 * (c & 3) + (lane >> 2);
    const unsigned eq = (unsigned)__shfl((int)ec.x, ls); const float gq = __uint_as_float((unsigned)__shfl((int)ec.y, ls));
    const float su = ((const GAS float*)T.isu)[eq], sv = ((const GAS float*)T.isv)[eq];
    int part[16];
#pragma unroll
    for (int j = 0; j < 16; ++j) {
        const int s0 = __builtin_amdgcn_sdot4((int)uu[j][0], xq[0], 0, false), s1 = __builtin_amdgcn_sdot4((int)uu[j][1], xq[1], 0, false);
        part[j] = __builtin_amdgcn_sdot4((int)uu[j][2], xq[2], s0, false) + __builtin_amdgcn_sdot4((int)uu[j][3], xq[3], s1, false); asm volatile("" : "+v"(part[j]));
        if (NXT) PEER_ROWLD(uu, j, ecn, cn, T.U8);
        __builtin_amdgcn_sched_barrier(0); }
    int r8[8], r4[4], r2[2], r1;
#pragma unroll
    for (int i = 0; i < 8; ++i) { auto sw = __builtin_amdgcn_permlane32_swap((unsigned)part[i], (unsigned)part[i + 8], false, false); r8[i] = (int)(sw[0] + sw[1]); }
#pragma unroll
    for (int i = 0; i < 4; ++i) { auto sw = __builtin_amdgcn_permlane16_swap((unsigned)r8[i], (unsigned)r8[i + 4], false, false); r4[i] = (int)(sw[0] + sw[1]); }
#pragma unroll
    for (int i = 0; i < 2; ++i) { const bool up = (lane & 8) != 0; const int send = up ? r4[i] : r4[i + 2], keep = up ? r4[i + 2] : r4[i]; r2[i] = keep + __shfl_xor(send, 8); }
    { const bool up = (lane & 4) != 0; const int send = up ? r2[0] : r2[1], keep = up ? r2[1] : r2[0]; r1 = keep + __shfl_xor(send, 4); }
    r1 += __shfl_xor(r1, 2); r1 += __shfl_xor(r1, 1);
    const float wgt = gq * gelu_erf((float)r1 * (xis * su)) * sv;
    const int rel = lane - 16 * (c & 3);
    const float wv = __shfl(wgt, 4 * (rel & 15));
    const bool mine = (rel >= 0) && (rel < 16);
    const bool lo_ = mine && (c < 4), hi_ = mine && (c >= 4);
    en[0].y = lo_ ? __float_as_uint(wv) : en[0].y; en[1].y = hi_ ? __float_as_uint(wv) : en[1].y;
}
template <bool NXT>
__device__ __forceinline__ void b_step_p(v4u (&vv)[16], const v2u ec, int c, f32x2w (&acc)[8], const unsigned char* V8, int lane, const v2u ecn, int cn) {
#pragma unroll
    for (int j = 0; j < 16; ++j) { const float w = __uint_as_float(__builtin_amdgcn_readlane(ec.y, 16 * (c & 3) + j)); const f32x2w w2 = {w, w};
#pragma unroll
        for (int q = 0; q < 4; ++q) { const unsigned x = vv[j][q]; const f32x2w a = __builtin_amdgcn_cvt_pk_f32_fp8((int)x, false), b = __builtin_amdgcn_cvt_pk_f32_fp8((int)x, true);
            acc[2 * q] += w2 * a; acc[2 * q + 1] += w2 * b; }
        if (NXT) PEER_ROWLD(vv, j, ecn, cn, V8);
        __builtin_amdgcn_sched_barrier(0); }
}
__device__ __forceinline__ void tok_finish(const LAS f32x4* xl, const f32x2w (&acc)[8], float* xrow, const float* gam, const float* bet, int lane) {
    float rr[16], s = 0.f;
#pragma unroll
    for (int q = 0; q < 4; ++q) { const f32x4 xv = xl[q * 64];
#pragma unroll
        for (int e = 0; e < 4; ++e) { const int k = 4 * q + e; rr[k] = ALPHA * xv[e] + acc[k >> 1][k & 1]; s += rr[k]; } }
    const float mean = wave_sum(s) * (1.f / D); float s2 = 0.f;
#pragma unroll
    for (int k = 0; k < 16; ++k) { rr[k] -= mean; s2 += rr[k] * rr[k]; }
    const float rstd = __builtin_amdgcn_rsqf(wave_sum(s2) * (1.f / D) + LN_EPS);
#pragma unroll
    for (int q = 0; q < 4; ++q) { const f32x4 g = *(const GAS f32x4*)(gam + 16 * lane + 4 * q), bb = *(const GAS f32x4*)(bet + 16 * lane + 4 * q);
        f32x4 y; y[0] = rr[4 * q] * rstd * g[0] + bb[0]; y[1] = rr[4 * q + 1] * rstd * g[1] + bb[1]; y[2] = rr[4 * q + 2] * rstd * g[2] + bb[2]; y[3] = rr[4 * q + 3] * rstd * g[3] + bb[3];
        *(GAS f32x4*)(xrow + 4 * q) = y; }
}
__device__ __forceinline__ void gather4(const v2u* sel, const G4& T, const float* rin, const float* g1, const float* b1, float* xo, const float* gam, const float* bet, int tok0, int lane, LAS f32x4* xl, LAS v2u* srt) {
    v2u en[4][2]; int xq[4][4]; float xis[4];
#pragma unroll
    for (int tt = 0; tt < 4; ++tt) { const float* rrow = rin + (size_t)(tok0 + tt) * D + 16 * lane;
        {
            f32x4 rv[4]; float s = 0.f;
#pragma unroll
            for (int q = 0; q < 4; ++q) { rv[q] = *(const GAS f32x4*)(rrow + 4 * q); s += (rv[q][0] + rv[q][1]) + (rv[q][2] + rv[q][3]); }
            const float mean = wave_sum(s) * (1.f / D); float s2 = 0.f;
#pragma unroll
            for (int q = 0; q < 4; ++q) { rv[q] = rv[q] - mean; s2 += (rv[q][0] * rv[q][0] + rv[q][1] * rv[q][1]) + (rv[q][2] * rv[q][2] + rv[q][3] * rv[q][3]); }
            const float rstd = __builtin_amdgcn_rsqf(wave_sum(s2) * (1.f / D) + LN_EPS);
#pragma unroll
            for (int q = 0; q < 4; ++q) { const f32x4 gg = *(const GAS f32x4*)(g1 + 16 * lane + 4 * q), bb = *(const GAS f32x4*)(b1 + 16 * lane + 4 * q); rv[q] = rv[q] * rstd * gg + bb; xl[tt * 256 + q * 64] = rv[q]; }
            float am = 0.f;
#pragma unroll
            for (int q = 0; q < 4; ++q) am = fmaxf(am, fmaxf(fmaxf(fabsf(rv[q][0]), fabsf(rv[q][1])), fmaxf(fabsf(rv[q][2]), fabsf(rv[q][3]))));
            am = fmaxf(wave_max(am), 1e-30f);
            const float qs = 127.f / am; xis[tt] = am * (1.f / 127.f);
#pragma unroll
            for (int q = 0; q < 4; ++q) { const int i0 = (int)__builtin_rintf(rv[q][0] * qs), i1 = (int)__builtin_rintf(rv[q][1] * qs), i2 = (int)__builtin_rintf(rv[q][2] * qs), i3 = (int)__builtin_rintf(rv[q][3] * qs);
                xq[tt][q] = (int)(((unsigned)i0 & 0xffu) | (((unsigned)i1 & 0xffu) << 8) | (((unsigned)i2 & 0xffu) << 16) | ((unsigned)i3 << 24)); }
        }
        const v2u e0 = ((const GAS v2u*)sel)[(size_t)(tok0 + tt) * 128 + lane], e1 = ((const GAS v2u*)sel)[(size_t)(tok0 + tt) * 128 + 64 + lane];
        const unsigned b0 = e0.x >> 9, b1 = e1.x >> 9; unsigned d0 = 0u, d1 = 0u, base = 0u;
#pragma unroll
        for (unsigned k = 0; k < 32; ++k) { const unsigned long long m0 = __ballot(b0 == k), m1 = __ballot(b1 == k);
            const unsigned c0 = (unsigned)__builtin_popcountll(m0), c1 = (unsigned)__builtin_popcountll(m1);
            const unsigned p0 = __builtin_amdgcn_mbcnt_hi((unsigned)(m0 >> 32), __builtin_amdgcn_mbcnt_lo((unsigned)m0, 0u)), p1 = __builtin_amdgcn_mbcnt_hi((unsigned)(m1 >> 32), __builtin_amdgcn_mbcnt_lo((unsigned)m1, 0u));
            d0 = (b0 == k) ? base + p0 : d0; d1 = (b1 == k) ? base + c0 + p1 : d1; base += c0 + c1; }
        srt[d0] = e0; srt[d1] = e1;
        asm volatile("s_waitcnt lgkmcnt(0)" ::: "memory");
        en[tt][0] = srt[lane]; en[tt][1] = srt[64 + lane];
        asm volatile("s_waitcnt lgkmcnt(0)" ::: "memory");
    }
    {
        v4u uu[16];
        { const v2u e0 = PEER_EC(en[0], 0);
#pragma unroll
          for (int j = 0; j < 16; ++j) PEER_ROWLD(uu, j, e0, 0, T.U8); }
#pragma unroll 1
        for (int c = 0; c < 7; ++c) {
            a_step_p<true>(uu, en[0], c, xq[0], xis[0], T, lane, PEER_EC(en[1], c), c);
            a_step_p<true>(uu, en[1], c, xq[1], xis[1], T, lane, PEER_EC(en[2], c), c);
            a_step_p<true>(uu, en[2], c, xq[2], xis[2], T, lane, PEER_EC(en[3], c), c);
            a_step_p<true>(uu, en[3], c, xq[3], xis[3], T, lane, PEER_EC(en[0], c + 1), c + 1);
        }
        a_step_p<true>(uu, en[0], 7, xq[0], xis[0], T, lane, PEER_EC(en[1], 7), 7);
        a_step_p<true>(uu, en[1], 7, xq[1], xis[1], T, lane, PEER_EC(en[2], 7), 7);
        a_step_p<true>(uu, en[2], 7, xq[2], xis[2], T, lane, PEER_EC(en[3], 7), 7);
        a_step_p<false>(uu, en[3], 7, xq[3], xis[3], T, lane, PEER_EC(en[3], 7), 7);
    }
    f32x2w acc[4][8];
#pragma unroll
    for (int tt = 0; tt < 4; ++tt)
#pragma unroll
        for (int q = 0; q < 8; ++q) acc[tt][q] = (f32x2w){0.f, 0.f};
    {
        v4u vv[16];
        { const v2u e0 = PEER_EC(en[0], 0);
#pragma unroll
          for (int j = 0; j < 16; ++j) PEER_ROWLD(vv, j, e0, 0, T.V8); }
#pragma unroll 1
        for (int c = 0; c < 7; ++c) {
            b_step_p<true>(vv, PEER_EC(en[0], c), c, acc[0], T.V8, lane, PEER_EC(en[1], c), c);
            b_step_p<true>(vv, PEER_EC(en[1], c), c, acc[1], T.V8, lane, PEER_EC(en[2], c), c);
            b_step_p<true>(vv, PEER_EC(en[2], c), c, acc[2], T.V8, lane, PEER_EC(en[3], c), c);
            b_step_p<true>(vv, PEER_EC(en[3], c), c, acc[3], T.V8, lane, PEER_EC(en[0], c + 1), c + 1);
        }
        b_step_p<true>(vv, PEER_EC(en[0], 7), 7, acc[0], T.V8, lane, PEER_EC(en[1], 7), 7);
        b_step_p<true>(vv, PEER_EC(en[1], 7), 7, acc[1], T.V8, lane, PEER_EC(en[2], 7), 7);
        b_step_p<true>(vv, PEER_EC(en[2], 7), 7, acc[2], T.V8, lane, PEER_EC(en[3], 7), 7);
        b_step_p<false>(vv, PEER_EC(en[3], 7), 7, acc[3], T.V8, lane, PEER_EC(en[3], 7), 7);
    }
#pragma unroll
    for (int tt = 0; tt < 4; ++tt) tok_finish(xl + tt * 256, acc[tt], xo + (size_t)(tok0 + tt) * D + 16 * lane, gam, bet, lane);
}

template <bool NXT>
__device__ __forceinline__ void a_step_l(v4u (&uu)[8]  , LAS v2u* et  , int c, v2u& ec  ,
                                         const LAS v2u* etn, int cn, const int (&xq)[4], const float xis, const G4& T, int lane) {
    const v2u eslot = et[16 * c + (lane >> 2)];
    const float su = ((const GAS float*)T.isu)[eslot.x], sv = ((const GAS float*)T.isv)[eslot.x];
    v2u ecn = ec; if (NXT) ecn = etn[16 * cn + (lane & 15)];
    int part[8], r8[8], r4[4], r2[2], r1;
#pragma unroll
    for (int j = 0; j < 16; ++j) {
        const int s0 = __builtin_amdgcn_sdot4((int)uu[j & 7][0], xq[0], 0, false), s1 = __builtin_amdgcn_sdot4((int)uu[j & 7][1], xq[1], 0, false);
        int pj = __builtin_amdgcn_sdot4((int)uu[j & 7][2], xq[2], s0, false) + __builtin_amdgcn_sdot4((int)uu[j & 7][3], xq[3], s1, false); asm volatile("" : "+v"(pj));
        if (j < 8) { unsigned e_ = __builtin_amdgcn_readlane(ec.x, j + 8); asm volatile("" : "+s"(e_) : "v"(pj)); uu[j & 7] = *(const GAS v4u*)(T.U8 + (size_t)e_ * D + 16 * lane); }
        else if (NXT) { unsigned e_ = __builtin_amdgcn_readlane(ecn.x, j - 8); asm volatile("" : "+s"(e_) : "v"(pj)); uu[j & 7] = *(const GAS v4u*)(T.U8 + (size_t)e_ * D + 16 * lane); }
        if (j < 8) part[j] = pj;
        else { auto sw = __builtin_amdgcn_permlane32_swap((unsigned)part[j - 8], (unsigned)pj, false, false); r8[j - 8] = (int)(sw[0] + sw[1]); }
        __builtin_amdgcn_sched_barrier(0); }
#pragma unroll
    for (int i = 0; i < 4; ++i) { auto sw = __builtin_amdgcn_permlane16_swap((unsigned)r8[i], (unsigned)r8[i + 4], false, false); r4[i] = (int)(sw[0] + sw[1]); }
#pragma unroll
    for (int i = 0; i < 2; ++i) { const bool up = (lane & 8) != 0; const int send = up ? r4[i] : r4[i + 2], keep = up ? r4[i + 2] : r4[i]; r2[i] = keep + __builtin_amdgcn_update_dpp(0, send, 0x128, 0xf, 0xf, false); }
    { const bool up = (lane & 4) != 0; const int send = up ? r2[0] : r2[1], keep = up ? r2[1] : r2[0]; r1 = keep + __builtin_amdgcn_ds_swizzle(send, 0x101F); }
    r1 += __builtin_amdgcn_update_dpp(0, r1, 0x4E, 0xf, 0xf, false); r1 += __builtin_amdgcn_update_dpp(0, r1, 0xB1, 0xf, 0xf, false);
    const float wgt = __uint_as_float(eslot.y) * gelu_erf((float)r1 * (xis * su)) * sv;
    if ((lane & 3) == 0) ((LAS float*)(et + 16 * c + (lane >> 2)))[1] = wgt;
    ec = ecn;
}
template <bool NXT>
__device__ __forceinline__ void b_step_l(v4u (&vv)[16], const LAS v2u* et, int c, v2u& ec, const LAS v2u* etn, int cn, f32x2w (&acc)[8], const unsigned char* V8, int lane) {
    v2u ecn = ec; if (NXT) ecn = etn[16 * cn + (lane & 15)];
#pragma unroll
    for (int j = 0; j < 16; ++j) { const float w = __uint_as_float(__builtin_amdgcn_readlane(ec.y, j)); const f32x2w w2 = {w, w};
#pragma unroll
        for (int q = 0; q < 4; ++q) { const unsigned x = vv[j][q]; const f32x2w a = __builtin_amdgcn_cvt_pk_f32_fp8((int)x, false), b = __builtin_amdgcn_cvt_pk_f32_fp8((int)x, true);
            acc[2 * q] += w2 * a; acc[2 * q + 1] += w2 * b; }
        if (NXT) { unsigned e_ = __builtin_amdgcn_readlane(ecn.x, j); asm volatile("" : "+s"(e_) : "v"(acc[0]), "v"(acc[1]), "v"(acc[2]), "v"(acc[3]), "v"(acc[4]), "v"(acc[5]), "v"(acc[6]), "v"(acc[7]));
            vv[j] = *(const GAS v4u*)(V8 + (size_t)e_ * D + 16 * lane); }
        __builtin_amdgcn_sched_barrier(0); }
    ec = ecn;
}
template <bool NXT>
__device__ __forceinline__ void b_step_r(v4u (&vv)[8], const LAS v2u* et, int c, v2u& ec, const LAS v2u* etn, int cn, f32x2w (&acc)[8], const unsigned char* V8, int lane) {
    v2u ecn = ec; if (NXT) ecn = etn[16 * cn + (lane & 15)];
#pragma unroll
    for (int j = 0; j < 16; ++j) { const float w = __uint_as_float(__builtin_amdgcn_readlane(ec.y, j)); const f32x2w w2 = {w, w};
#pragma unroll
        for (int q = 0; q < 4; ++q) { const unsigned x = vv[j & 7][q]; const f32x2w a = __builtin_amdgcn_cvt_pk_f32_fp8((int)x, false), b = __builtin_amdgcn_cvt_pk_f32_fp8((int)x, true);
            acc[2 * q] += w2 * a; acc[2 * q + 1] += w2 * b; }
        if (j < 8 || NXT) { unsigned e_ = (j < 8) ? __builtin_amdgcn_readlane(ec.x, j + 8) : __builtin_amdgcn_readlane(ecn.x, j - 8);
            asm volatile("" : "+s"(e_) : "v"(acc[0]), "v"(acc[1]), "v"(acc[2]), "v"(acc[3]), "v"(acc[4]), "v"(acc[5]), "v"(acc[6]), "v"(acc[7]));
            vv[j & 7] = *(const GAS v4u*)(V8 + (size_t)e_ * D + 16 * lane); }
        else if (j < 15) asm volatile("" : "+v"(vv[(j + 1) & 7]) : "v"(acc[0]), "v"(acc[1]), "v"(acc[2]), "v"(acc[3]), "v"(acc[4]), "v"(acc[5]), "v"(acc[6]), "v"(acc[7]));
        __builtin_amdgcn_sched_barrier(0); }
    ec = ecn;
}
template <bool NXT>
__device__ __forceinline__ void a_step8(v4u (&uu)[8], LAS v2u* et, int c, v2u& ec  ,
                                        const LAS v2u* etn, int cn, const int (&xq)[4], const float xis, const G4& T, int lane) {
    const v2u eslot = et[8 * c + (lane >> 3)];
    const float su = ((const GAS float*)T.isu)[eslot.x], sv = ((const GAS float*)T.isv)[eslot.x];
    v2u ecn = ec; if (NXT) ecn = etn[8 * cn + (lane & 7)];
    int part[4], r4[4], r2[2], r1;
#pragma unroll
    for (int j = 0; j < 8; ++j) {
        const int s0 = __builtin_amdgcn_sdot4((int)uu[j][0], xq[0], 0, false), s1 = __builtin_amdgcn_sdot4((int)uu[j][1], xq[1], 0, false);
        int pj = __builtin_amdgcn_sdot4((int)uu[j][2], xq[2], s0, false) + __builtin_amdgcn_sdot4((int)uu[j][3], xq[3], s1, false); asm volatile("" : "+v"(pj));
        if (NXT) { unsigned e_ = __builtin_amdgcn_readlane(ecn.x, j); asm volatile("" : "+s"(e_) : "v"(pj)); uu[j] = *(const GAS v4u*)(T.U8 + (size_t)e_ * D + 16 * lane); }
        if (j < 4) part[j] = pj;
        else { auto sw = __builtin_amdgcn_permlane32_swap((unsigned)part[j - 4], (unsigned)pj, false, false); r4[j - 4] = (int)(sw[0] + sw[1]); }
        __builtin_amdgcn_sched_barrier(0); }
#pragma unroll
    for (int i = 0; i < 2; ++i) { auto sw = __builtin_amdgcn_permlane16_swap((unsigned)r4[i], (unsigned)r4[i + 2], false, false); r2[i] = (int)(sw[0] + sw[1]); }
    { const bool up = (lane & 8) != 0; const int send = up ? r2[0] : r2[1], keep = up ? r2[1] : r2[0]; r1 = keep + __builtin_amdgcn_update_dpp(0, send, 0x128, 0xf, 0xf, false); }
    r1 += __builtin_amdgcn_ds_swizzle(r1, 0x101F); r1 += __builtin_amdgcn_update_dpp(0, r1, 0x4E, 0xf, 0xf, false); r1 += __builtin_amdgcn_update_dpp(0, r1, 0xB1, 0xf, 0xf, false);
    const float wgt = __uint_as_float(eslot.y) * gelu_erf((float)r1 * (xis * su)) * sv;
    if ((lane & 7) == 0) ((LAS float*)(et + 8 * c + (lane >> 3)))[1] = wgt;
    ec = ecn;
}
__device__ __forceinline__ void b_step8(v4u (&vv)[8], v2u& ec, const LAS v2u* etn, int cn, f32x2w (&acc)[8], const unsigned char* V8, int lane) {
    const v2u ecn = etn[8 * cn + (lane & 7)];
#pragma unroll
    for (int j = 0; j < 8; ++j) { const float w = __uint_as_float(__builtin_amdgcn_readlane(ec.y, j)); const f32x2w w2 = {w, w};
#pragma unroll
        for (int q = 0; q < 4; ++q) { const unsigned x = vv[j][q]; const f32x2w a = __builtin_amdgcn_cvt_pk_f32_fp8((int)x, false), b = __builtin_amdgcn_cvt_pk_f32_fp8((int)x, true);
            acc[2 * q] += w2 * a; acc[2 * q + 1] += w2 * b; }
        { unsigned e_ = __builtin_amdgcn_readlane(ecn.x, j);
          asm volatile("" : "+s"(e_) : "v"(acc[0]), "v"(acc[1]), "v"(acc[2]), "v"(acc[3]), "v"(acc[4]), "v"(acc[5]), "v"(acc[6]), "v"(acc[7]));
          vv[j] = *(const GAS v4u*)(V8 + (size_t)e_ * D + 16 * lane); }
        __builtin_amdgcn_sched_barrier(0); }
    ec = ecn;
}
__device__ __forceinline__ void tok_finish_r(const float* rrow, const float* g1, const float* b1, const f32x2w (&acc)[8], float* xrow, const float* gam, const float* bet, int lane) {
    asm volatile("" : "+v"(lane));
    f32x4 rv[4]; float s = 0.f;
#pragma unroll
    for (int q = 0; q < 4; ++q) { rv[q] = *(const GAS f32x4*)(rrow + 4 * q); s += (rv[q][0] + rv[q][1]) + (rv[q][2] + rv[q][3]); }
    const float mean1 = wave_sum(s) * (1.f / D); float s2 = 0.f;
#pragma unroll
    for (int q = 0; q < 4; ++q) { rv[q] = rv[q] - mean1; s2 += (rv[q][0] * rv[q][0] + rv[q][1] * rv[q][1]) + (rv[q][2] * rv[q][2] + rv[q][3] * rv[q][3]); }
    const float rstd1 = __builtin_amdgcn_rsqf(wave_sum(s2) * (1.f / D) + LN_EPS);
    float rr[16]; s = 0.f;
#pragma unroll
    for (int q = 0; q < 4; ++q) { const f32x4 gg = *(const GAS f32x4*)(g1 + 16 * lane + 4 * q), bb = *(const GAS f32x4*)(b1 + 16 * lane + 4 * q); const f32x4 xv = rv[q] * rstd1 * gg + bb;
#pragma unroll
        for (int e = 0; e < 4; ++e) { const int k = 4 * q + e; rr[k] = ALPHA * xv[e] + acc[k >> 1][k & 1]; s += rr[k]; }
        __builtin_amdgcn_sched_barrier(0); }
    const float mean = wave_sum(s) * (1.f / D); s2 = 0.f;
#pragma unroll
    for (int k = 0; k < 16; ++k) { rr[k] -= mean; s2 += rr[k] * rr[k]; }
    const float rstd = __builtin_amdgcn_rsqf(wave_sum(s2) * (1.f / D) + LN_EPS);
#pragma unroll
    for (int q = 0; q < 4; ++q) { const f32x4 g = *(const GAS f32x4*)(gam + 16 * lane + 4 * q), bb = *(const GAS f32x4*)(bet + 16 * lane + 4 * q);
        f32x4 y; y[0] = rr[4 * q] * rstd * g[0] + bb[0]; y[1] = rr[4 * q + 1] * rstd * g[1] + bb[1]; y[2] = rr[4 * q + 2] * rstd * g[2] + bb[2]; y[3] = rr[4 * q + 3] * rstd * g[3] + bb[3];
        *(GAS f32x4*)(xrow + 4 * q) = y; __builtin_amdgcn_sched_barrier(0); }
}
__device__ __forceinline__ void gather16(const v2u* sel, const G4& T, const float* rin, const float* g1, const float* b1, float* xo, const float* gam, const float* bet, int tok0, const int lane_in, LAS v2u* enl) {
    int lane = lane_in; asm volatile("" : "+v"(lane));
    int xq[16][4]; float xis[16];
#pragma unroll 1
    for (int tt = 0; tt < 16; ++tt) { int tk_ = tok0 + tt;
        const v2u e0 = ((const GAS v2u*)sel)[(size_t)tk_ * 128 + lane], e1 = ((const GAS v2u*)sel)[(size_t)tk_ * 128 + 64 + lane];
        const unsigned b0 = e0.x >> 9, b1 = e1.x >> 9; unsigned d0 = 0u, d1 = 0u, base = 0u;
#pragma unroll
        for (unsigned k = 0; k < 32; ++k) { const unsigned long long m0 = __ballot(b0 == k), m1 = __ballot(b1 == k);
            const unsigned c0 = (unsigned)__builtin_popcountll(m0), c1 = (unsigned)__builtin_popcountll(m1);
            const unsigned p0 = __builtin_amdgcn_mbcnt_hi((unsigned)(m0 >> 32), __builtin_amdgcn_mbcnt_lo((unsigned)m0, 0u)), p1 = __builtin_amdgcn_mbcnt_hi((unsigned)(m1 >> 32), __builtin_amdgcn_mbcnt_lo((unsigned)m1, 0u));
            d0 = (b0 == k) ? base + p0 : d0; d1 = (b1 == k) ? base + c0 + p1 : d1; base += c0 + c1; }
        enl[tt * 128 + d0] = e0; enl[tt * 128 + d1] = e1;
    }
#pragma unroll
    for (int tt = 0; tt < 16; ++tt) { const float* rrow = rin + (size_t)(tok0 + tt) * D + 16 * lane;
        {
            f32x4 rv[4]; float s = 0.f;
#pragma unroll
            for (int q = 0; q < 4; ++q) { rv[q] = *(const GAS f32x4*)(rrow + 4 * q); s += (rv[q][0] + rv[q][1]) + (rv[q][2] + rv[q][3]); }
            const float mean = wave_sum(s) * (1.f / D); float s2 = 0.f;
#pragma unroll
            for (int q = 0; q < 4; ++q) { rv[q] = rv[q] - mean; s2 += (rv[q][0] * rv[q][0] + rv[q][1] * rv[q][1]) + (rv[q][2] * rv[q][2] + rv[q][3] * rv[q][3]); }
            const float rstd = __builtin_amdgcn_rsqf(wave_sum(s2) * (1.f / D) + LN_EPS);
            float am = 0.f;
#pragma unroll
            for (int q = 0; q < 4; ++q) { const f32x4 gg = *(const GAS f32x4*)(g1 + 16 * lane + 4 * q), bb = *(const GAS f32x4*)(b1 + 16 * lane + 4 * q); rv[q] = rv[q] * rstd * gg + bb;
                am = fmaxf(am, fmaxf(fmaxf(fabsf(rv[q][0]), fabsf(rv[q][1])), fmaxf(fabsf(rv[q][2]), fabsf(rv[q][3])))); }
            am = fmaxf(wave_max(am), 1e-30f);
            const float qs = 127.f / am; xis[tt] = __uint_as_float(__builtin_amdgcn_readfirstlane(__float_as_uint(am * (1.f / 127.f))));
#pragma unroll
            for (int q = 0; q < 4; ++q) { const int i0 = (int)__builtin_rintf(rv[q][0] * qs), i1 = (int)__builtin_rintf(rv[q][1] * qs), i2 = (int)__builtin_rintf(rv[q][2] * qs), i3 = (int)__builtin_rintf(rv[q][3] * qs);
                xq[tt][q] = (int)(((unsigned)i0 & 0xffu) | (((unsigned)i1 & 0xffu) << 8) | (((unsigned)i2 & 0xffu) << 16) | ((unsigned)i3 << 24)); }
        }
        __builtin_amdgcn_sched_barrier(0);
    }
    asm volatile("s_waitcnt lgkmcnt(0)" ::: "memory");
    {
        v4u uu[8]; v2u ec = enl[lane & 7];
#pragma unroll
        for (int j = 0; j < 8; ++j) { const unsigned e_ = __builtin_amdgcn_readlane(ec.x, j); uu[j] = *(const GAS v4u*)(T.U8 + (size_t)e_ * D + 16 * lane); }
#pragma unroll 1
        for (int c = 0; c < 16; ++c) {
#pragma unroll
            for (int tt = 0; tt < 15; ++tt) a_step8<true>(uu, enl + tt * 128, c, ec, enl + (tt + 1) * 128, c, xq[tt], xis[tt], T, lane);
            if (c < 15) a_step8<true>(uu, enl + 15 * 128, c, ec, enl, c + 1, xq[15], xis[15], T, lane);
            else a_step8<false>(uu, enl + 15 * 128, c, ec, enl, c, xq[15], xis[15], T, lane);
        }
    }
    asm volatile("s_waitcnt lgkmcnt(0)" ::: "memory");
#pragma unroll 1
    for (int hf = 0; hf < 2; ++hf) {
        int lane = lane_in; asm volatile("" : "+v"(lane));
        LAS v2u* eh = enl + hf * 8 * 128;
        f32x2w acc[8][8];
#pragma unroll
        for (int tt = 0; tt < 8; ++tt)
#pragma unroll
            for (int q = 0; q < 8; ++q) acc[tt][q] = (f32x2w){0.f, 0.f};
        v4u vv[8]; v2u ec = eh[lane & 7];
#pragma unroll
        for (int j = 0; j < 8; ++j) { const unsigned e_ = __builtin_amdgcn_readlane(ec.x, j); vv[j] = *(const GAS v4u*)(T.V8 + (size_t)e_ * D + 16 * lane); }
#pragma unroll 1
        for (int c = 0; c < 16; ++c) {
            b_step8(vv, ec, eh + 1 * 128, c, acc[0], T.V8, lane);
            b_step8(vv, ec, eh + 2 * 128, c, acc[1], T.V8, lane);
            b_step8(vv, ec, eh + 3 * 128, c, acc[2], T.V8, lane);
            b_step8(vv, ec, eh + 4 * 128, c, acc[3], T.V8, lane);
            b_step8(vv, ec, eh + 5 * 128, c, acc[4], T.V8, lane);
            b_step8(vv, ec, eh + 6 * 128, c, acc[5], T.V8, lane);
            b_step8(vv, ec, eh + 7 * 128, c, acc[6], T.V8, lane);
            b_step8(vv, ec, eh, (c + 1) & 15, acc[7], T.V8, lane);
        }
#pragma unroll
        for (int j = 0; j < 8; ++j) asm volatile("" :: "v"(vv[j]));
#pragma unroll
        for (int tt = 0; tt < 8; ++tt) { int tok = tok0 + hf * 8 + tt; tok_finish_r(rin + (size_t)tok * D + 16 * lane, g1, b1, acc[tt], xo + (size_t)tok * D + 16 * lane, gam, bet, lane); __builtin_amdgcn_sched_barrier(0); }
    }
}
#undef PEER_ROWLD
#undef PEER_EC
__device__ __forceinline__ void rows_to_fp8(const float* usrc, const float* vsrc, unsigned char* udst, unsigned char* vdst, float* uinv, float* vinv, int row0, int stride, int lane) {
    f32x4 nx[4];
    if (row0 < 2 * NEXP) { const float* p = (row0 < NEXP ? usrc + (size_t)row0 * D : vsrc + (size_t)(row0 - NEXP) * D) + 16 * lane;
#pragma unroll
        for (int q = 0; q < 4; ++q) nx[q] = *(const f32x4*)(p + 4 * q); }
#pragma unroll 1
    for (int row = row0; row < 2 * NEXP; row += stride) {
        f32x4 v[4]; float am = 0.f;
#pragma unroll
        for (int q = 0; q < 4; ++q) { v[q] = nx[q]; am = fmaxf(am, fmaxf(fmaxf(fabsf(v[q][0]), fabsf(v[q][1])), fmaxf(fabsf(v[q][2]), fabsf(v[q][3])))); }
        const int rn = row + stride;
        if (rn < 2 * NEXP) { const float* p = (rn < NEXP ? usrc + (size_t)rn * D : vsrc + (size_t)(rn - NEXP) * D) + 16 * lane;
#pragma unroll
            for (int q = 0; q < 4; ++q) nx[q] = *(const f32x4*)(p + 4 * q); }
        am = wave_max(am);
        float s = 1.f, is = 1.f; v4u o;
        if (row < NEXP) {
            if (am > 1e-30f) { s = 127.f / am; is = am * (1.f / 127.f); }
#pragma unroll
            for (int q = 0; q < 4; ++q) { const int i0 = (int)__builtin_rintf(v[q][0] * s), i1 = (int)__builtin_rintf(v[q][1] * s), i2 = (int)__builtin_rintf(v[q][2] * s), i3 = (int)__builtin_rintf(v[q][3] * s);
                o[q] = ((unsigned)i0 & 0xffu) | (((unsigned)i1 & 0xffu) << 8) | (((unsigned)i2 & 0xffu) << 16) | ((unsigned)i3 << 24); }
        } else {
            if (am > 1e-30f) { const int eb = (__float_as_int(224.f / am) >> 23) & 0xff; if (eb > 0 && eb < 254) { s = __int_as_float(eb << 23); is = __int_as_float((254 - eb) << 23); } }
#pragma unroll
            for (int q = 0; q < 4; ++q) { int w = 0; w = __builtin_amdgcn_cvt_pk_fp8_f32(v[q][0] * s, v[q][1] * s, w, false); w = __builtin_amdgcn_cvt_pk_fp8_f32(v[q][2] * s, v[q][3] * s, w, true); o[q] = (unsigned)w; }
        }
        unsigned char* dst = (row < NEXP ? udst + (size_t)row * D : vdst + (size_t)(row - NEXP) * D) + 16 * lane;
        *(v4u*)dst = o;
        if (lane == 0) { if (row < NEXP) uinv[row] = is; else vinv[row - NEXP] = is; }
    }
}
}
constexpr int NPH = 8;
__global__ void __launch_bounds__(NWAVES * 64, 2) mk_fwd(Args args) {
    extern __shared__ __attribute__((aligned(16))) unsigned char lds_raw[];
    LAS unsigned char* lds = (LAS unsigned char*)lds_raw;
    volatile LAS unsigned* MISC = (volatile LAS unsigned*)(lds + MISC_OFF);
    const int tid0 = threadIdx.x, lane0 = tid0 & 63, wave = __builtin_amdgcn_readfirstlane(tid0 >> 6);
    const int G = gridDim.x, bx = blockIdx.x, vcu = (G % 8 == 0) ? (bx % 8) * (G / 8) + bx / 8 : bx;
    unsigned char* ws0 = args.ws;
    gu32* ctl = (gu32*)(ws0 + WS_CTL);
    for (int u = tid0; u < (LDS_BYTES - RING_BYTES) / 4; u += NWAVES * 64) ((LAS unsigned*)(lds + RING_BYTES))[u] = 0u;
    __syncthreads();
    XcdBarrier bar; bar.bar = (unsigned*)(ctl + CW_BAR); bar.x = 0; bar.st = nullptr;
    if (MK_N_LAUNCHES == 1) bar = xcd_barrier_post((unsigned*)(ctl + CW_BAR), MISC + 8, wave);
    const int lo = args.ph_lo, hi = args.ph_hi;
#ifndef PH_MASK
#define PH_MASK 0xFF
#endif
#define IN(k) ((((PH_MASK) >> (k)) & 1) && lo <= (k) && (k) < hi)
#define SEAM(k) do { if (IN(k) && IN((k) + 1)) xcd_barrier(bar); } while (0)
    const int NGW = G * NWAVES;
#define SUB_BEGIN() unsigned char* ws = ws0; asm volatile("" : "+s"(ws)); const int lane = (int)__builtin_amdgcn_mbcnt_hi(~0u, __builtin_amdgcn_mbcnt_lo(~0u, 0u)), tid = wave * 64 + lane; (void)tid; (void)lane
#define PHASE_BEGIN() unsigned char* ws = ws0; asm volatile("" : "+s"(ws)); const int lane = (int)__builtin_amdgcn_mbcnt_hi(~0u, __builtin_amdgcn_mbcnt_lo(~0u, 0u)), tid = wave * 64 + lane; const int gw = vcu * NWAVES + wave; (void)gw; (void)lane; (void)tid

    if (IN(0)) { PHASE_BEGIN(); p0_prologue(args, lds, vcu, G, wave, lane); VM_WAIT(); __syncthreads(); SEAM(0); }

    if (IN(1)) { PHASE_BEGIN();
        pg8::Gemm g{(const pg8::bf16_t*)(ws + WS_A), (const pg8::bf16_t*)(ws + WS_WIN), T, INC, D}; pg8::StaticOrder S; S.init(T, INC, G, bx); S.rep = NREP(1);
        pg8::EpiInProj E{(pg8::bf16_t*)(ws + WS_QD), (pg8::bf16_t*)(ws + WS_KD), (pg8::bf16_t*)(ws + WS_VD), (pg8::bf16_t*)(ws + WS_LQ), (pg8::bf16_t*)(ws + WS_LK), (pg8::bf16_t*)(ws + WS_LV),
                         (pg8::bf16_t*)(ws + WS_GA), (pg8::bf16_t*)(ws + WS_GB)};
        pg8::gemm_phase<pg8::EpiInProj, pg8::StaticOrder, true, true>(lds, g, S, E, wave);
        {
            const int nwg = (T / 256) * (INC / 256), rem = nwg % G, nshort = rem ? G - rem : G, first = rem ? rem : 0;
            if (bx >= first) peer::rows_to_fp8(args.in[I_PU], args.in[I_PV], ws + WS_UU, ws + WS_UV, (float*)(ws + WS_ISU), (float*)(ws + WS_ISV), (bx - first) * NWAVES + wave, nshort * NWAVES, lane);
        }
        SEAM(1);
    }

    if (IN(2)) { PHASE_BEGIN();
#ifndef NO_DIFF
        {   SUB_BEGIN();
            const da::Tensors X{(const bf16*)(ws + WS_QD), (const bf16*)(ws + WS_KD), (const bf16*)(ws + WS_VD), (float*)(ws + WS_STASH), (bf16*)(ws + WS_YA),
                                args.in[I_DLAM], args.in[I_SUBG], args.in[I_RELB]};
            int cur_h = -1;
            float lam; { const float* dl = args.in[I_DLAM]; const float p1 = dl[lane] * dl[64 + lane], p2 = dl[128 + lane] * dl[192 + lane];
                lam = __uint_as_float(__builtin_amdgcn_readfirstlane(__float_as_uint(__expf(wave_sum(p1)) - __expf(wave_sum(p2)) + LAM_INIT))); }
            for (int rep_ = 0; rep_ < NREP(20); ++rep_)
            for (int p = vcu; p < 256; p += G) {
                const int bh = p >> 5, s = p & 31, b = bh >> 2, h = bh & 3;
                if (h != cur_h) {
                    __syncthreads();
                    const float* bd = (const float*)(ws + WS_BIASD) + h * BIAS_TAB; asm volatile("" : "+s"(bd));
                    int ln2 = (int)__builtin_amdgcn_mbcnt_hi(~0u, __builtin_amdgcn_mbcnt_lo(~0u, 0u)); asm volatile("" : "+v"(ln2));
                    for (int i = wave * 64 + ln2; i < BIAS_TAB; i += NWAVES * 64) ((LAS float*)(lds + da::LDS_BIAS))[i] = bd[i];
                    for (int i = wave * 64 + ln2; i < 4 * da::TAB_CL; i += NWAVES * 64) {
                        const int a = i / da::TAB_CL, k = i % da::TAB_CL, idx = da::TAB_NR - k + a;
                        ((LAS float*)(lds + da::LDS_TREV))[i] = (idx >= 0 && idx < BIAS_TAB) ? bd[idx] : 0.f; }
                    __syncthreads(); cur_h = h;
                }
                const float c31 = args.in[I_RELB][31 * 16 + h] * LOG2E;
                for (int k2 = 0; k2 < 2; ++k2) da::unit(X, b, h, k2 ? 63 - s : s, lds, bx, lam, c31, wave);
            }
        }
#endif
#ifndef NO_DIL
        {   SUB_BEGIN();
            const dil::Tensors X{(const bf16*)(ws + WS_LQ), (const bf16*)(ws + WS_LK), (const bf16*)(ws + WS_LV), (bf16*)(ws + WS_YB)};
            int cur_h = -1;
            for (int rep_ = 0; rep_ < NREP(21); ++rep_)
            for (int u = vcu; u < 256; u += G) {
                const int bh = u >> 5, blk = u & 31, b = bh >> 2, h = bh & 3;
                if (h != cur_h) {
                    __syncthreads();
                    const float* blsrc = (const float*)(ws + WS_BIASL);
                    for (int i = tid; i < 3 * dil::BT; i += NWAVES * 64) { const int g = i / dil::BT, jj = i % dil::BT - dil::BT0;
                        ((LAS float*)(lds + dil::LDS_BL))[i] = (jj >= 0 && jj <= 128) ? blsrc[(g * 4 + h) * 132 + jj] : 0.f; }
                    __syncthreads(); cur_h = h;
                }
                float* lse0 = (float*)(ws + WS_LSE0);
                for (int k2 = 0; k2 < 2; ++k2) dil::wave_tile_g0(X, lse0, b, h, blk * 512 + (wave + 8 * k2) * 32, lds + dil::LDS_VST + wave * 4096, (const LAS float*)(lds + dil::LDS_BL), lane);
                VM_WAIT(); __syncthreads();
                for (int k2 = 0; k2 < 2; ++k2) dil::wave_tile(X, lse0, b, h, blk * 512, wave + 8 * k2, lds + dil::LDS_VST + wave * 4096, (const LAS float*)(lds + dil::LDS_BL), lane);
            }
            __syncthreads();
        }
#endif
        SEAM(2);
    }

    if (IN(3)) { PHASE_BEGIN();
        { pg8::Gemm g{(const pg8::bf16_t*)(ws + WS_YA), (const pg8::bf16_t*)(ws + WS_WBD), T, D, 512}; pg8::StaticOrder S; S.init(T, D, G, bx); S.rep = NREP(3);
          pg8::EpiGate1 E{(const pg8::bf16_t*)(ws + WS_GA), (pg8::bf16_t*)(ws + WS_GATED)};
          pg8::gemm_phase<pg8::EpiGate1, pg8::StaticOrder, true, true>(lds, g, S, E, wave); }
        VM_WAIT(); __syncthreads();
        { pg8::Gemm g{(const pg8::bf16_t*)(ws + WS_YB), (const pg8::bf16_t*)(ws + WS_WBL), T, D, 256}; pg8::StaticOrder S; S.init(T, D, G, bx);
          pg8::EpiGate2 E{(const pg8::bf16_t*)(ws + WS_GB), (pg8::bf16_t*)(ws + WS_GATED)};
          pg8::gemm_phase<pg8::EpiGate2, pg8::StaticOrder, true, true>(lds, g, S, E, wave); }
        SEAM(3);
    }

    if (IN(4)) { PHASE_BEGIN();
        pg8::Gemm g{(const pg8::bf16_t*)(ws + WS_GATED), (const pg8::bf16_t*)(ws + WS_WO), T, D, D}; pg8::StaticOrder S; S.init(T, D, G, bx); S.rep = NREP(4);
        pg8::EpiOut E{args.in[I_X], (float*)(ws + WS_R)};
        pg8::gemm_phase<pg8::EpiOut, pg8::StaticOrder, true, true>(lds, g, S, E, wave);
        SEAM(4);
    }

    if (IN(5)) { PHASE_BEGIN();
        p5_ln1(args, vcu, G, wave, lane);
        SEAM(5);
    }

    if (IN(6)) { PHASE_BEGIN();
        pg8::Gemm g{(const pg8::bf16_t*)(ws + WS_WP), (const pg8::bf16_t*)(ws + WS_A), 2048, T, D}; pg8::StaticOrder S; S.init(2048, T, G, bx); S.rep = NREP(6);
        pg8::EpiScoreT E{(float*)(ws + WS_ST)};
        pg8::gemm_phase<pg8::EpiScoreT, pg8::StaticOrder, true, true>(lds, g, S, E, wave);
        SEAM(6);
    }

    if (IN(7)) { PHASE_BEGIN();
        const float* ST = (const float*)(ws + WS_ST); v2u* sel = (v2u*)(ws + WS_SEL);
        for (int u = vcu; u < T / 128; u += G) {
            for (int p = 0; p < 2; ++p) peer::select(ST, sel, u * 128 + p * 64 + lane, wave);
            VM_WAIT(); __syncthreads();
            { const peer::G4 TB{ws + WS_UU, ws + WS_UV, (const float*)(ws + WS_ISU), (const float*)(ws + WS_ISV)};
              peer::gather16(sel, TB, (const float*)(ws + WS_R), args.in[I_LN1G], args.in[I_LN1B], args.out, args.in[I_LN2G], args.in[I_LN2B], u * 128 + wave * 16, lane, (LAS v2u*)(lds + wave * 16384)); }
            VM_WAIT(); __syncthreads();
        }
    }
#undef IN
#undef SEAM
}

extern "C" void kernel_launch(void* const* d_in, const int* in_sizes, int n_in, void* d_out, int out_size, void* d_ws, size_t ws_size, hipStream_t stream) {
    static int grid = 0;
    if (grid == 0) {
        if (n_in != 16 || in_sizes[0] != T * D || out_size != T * D || ws_size < WS_END) { fprintf(stderr, "kernel_launch: unexpected shapes (n_in %d, in0 %d, out %d, ws %zu); nothing launched\n", n_in, n_in > 0 ? in_sizes[0] : -1, out_size, ws_size); grid = -1; return; }
        int dev = 0, cus = 0, per_cu = 0;
        if (hipGetDevice(&dev) != hipSuccess || hipDeviceGetAttribute(&cus, hipDeviceAttributeMultiprocessorCount, dev) != hipSuccess) { grid = -1; return; }
        if (hipFuncSetAttribute((const void*)mk_fwd, hipFuncAttributeMaxDynamicSharedMemorySize, LDS_BYTES) != hipSuccess) { fprintf(stderr, "kernel_launch: hipFuncSetAttribute failed\n"); grid = -1; return; }
        if (hipOccupancyMaxActiveBlocksPerMultiprocessor(&per_cu, (const void*)mk_fwd, NWAVES * 64, LDS_BYTES) != hipSuccess || per_cu < 1) { fprintf(stderr, "kernel_launch: occupancy query reports %d\n", per_cu); per_cu = 1; }
        (void)hipGetLastError();
        grid = cus;
    }
    if (grid < 0) return;
    if (hipMemsetAsync((char*)d_ws + WS_CTL, 0, CTL_ZERO_BYTES, stream) != hipSuccess) return;
    Args a{};
    for (int i = 0; i < 16; ++i) a.in[i] = (const float*)d_in[i];
    a.out = (float*)d_out; a.ws = (unsigned char*)d_ws;
    for (int li = 0; li < MK_N_LAUNCHES; ++li) {
        a.ph_lo = (MK_N_LAUNCHES == 1) ? 0 : li; a.ph_hi = (MK_N_LAUNCHES == 1) ? NPH : li + 1;
        hipLaunchKernelGGL(mk_fwd, dim3(grid), dim3(NWAVES * 64), LDS_BYTES, stream, a);
    }
}
```
